# Optimizing an MI355X kernel written in HIP

```python
import math
import jax, jax.numpy as jnp
from jax import lax
import numpy as np

D_MODEL = 2048
BATCH = 2
SEQ = 16384
DEPTH = 2

GRID_W = 64
CTX_LEN = 256
CHUNK = 64
CONV_W = 5
EPS = 1e-6
ML_DV = 256
ML_DK = 128
ML_HEADS = (D_MODEL // 2) // ML_DV
DN_DK = 128
DN_DV = 128
DN_HEADS = (D_MODEL // 2) // DN_DV
RG_WIDTH = D_MODEL // 2
RG_BLOCKS = 8
RG_C = 8.0
GLA_DV = 256
GLA_DK = 128
GLA_HEADS = (D_MODEL // 2) // GLA_DV
GLA_RANK = 16
GLA_TAU = 16.0
FFN_HIDDEN = ((8 * D_MODEL + 3 * 256 - 1) // (3 * 256)) * 256
L0_SPLITS = (ML_HEADS * ML_DK, ML_HEADS * ML_DK, ML_HEADS * ML_DV, ML_HEADS * ML_DV, 2 * ML_HEADS, 2 * ML_HEADS,
             DN_HEADS * DN_DK, DN_HEADS * DN_DK, DN_HEADS * DN_DV, DN_HEADS * DN_DV, 2 * DN_HEADS, 2 * DN_HEADS)
L0_COLS = sum(L0_SPLITS)
L0_OUT = ML_HEADS * ML_DV + DN_HEADS * DN_DV
L1_SPLITS = (RG_WIDTH, RG_WIDTH, GLA_HEADS * GLA_DK, GLA_HEADS * GLA_DK, GLA_HEADS * GLA_DV, GLA_HEADS * GLA_DV,
             2 * GLA_RANK)
L1_COLS = sum(L1_SPLITS)
L1_OUT = RG_WIDTH + GLA_HEADS * GLA_DV

kernel_name = 'hybrid_mlstm_deltanet_rglru_gla_dit'


def rmsnorm(x, g):
    xf = x.astype(jnp.float32)
    y = xf * lax.rsqrt(jnp.mean(xf * xf, axis=-1, keepdims=True) + EPS)
    return (y * g.astype(jnp.float32)).astype(x.dtype)


def head_rmsnorm(o, g):
    B, H, T, d = o.shape
    o = jnp.transpose(o, (0, 2, 1, 3))
    o = o * lax.rsqrt(jnp.mean(o * o, axis=-1, keepdims=True) + EPS)
    return o.reshape(B, T, H * d) * g


def l2norm(x):
    return x * lax.rsqrt(jnp.sum(x * x, axis=-1, keepdims=True) + EPS)


def split_cols(y, sizes):
    idx = [int(v) for v in np.cumsum(sizes)[:-1]]
    return jnp.split(y, idx, axis=-1)


def to_heads(x, h):
    B, T, _ = x.shape
    return jnp.transpose(x.reshape(B, T, h, -1), (0, 2, 1, 3))


def dir_gates(z, h):
    B, T, _ = z.shape
    return jnp.transpose(z.reshape(B, T, 2, h), (2, 0, 3, 1))


def adaln(cond, w_mod, b_mod):
    m = jax.nn.silu(cond) @ w_mod + b_mod
    return [t[..., None, :] for t in jnp.split(m, 6, axis=-1)]


def swiglu(h, w_gu, w_down):
    g, u = jnp.split(h @ w_gu, 2, axis=-1)
    return (jax.nn.silu(g) * u) @ w_down


def dwconv_seq(x, w):
    T = x.shape[1]
    pad = CONV_W // 2
    xp = jnp.pad(x, ((0, 0), (pad, pad), (0, 0)))
    out = xp[:, 0:T] * w[0]
    for j in range(1, CONV_W):
        out = out + xp[:, j:j + T] * w[j]
    return out


def dwconv_grid(x, w):
    B, T, C = x.shape
    rows = T // GRID_W
    return dwconv_seq(x.reshape(B * rows, GRID_W, C), w).reshape(B, T, C)


def mlstm_chunked(q, k, v, ig, lf, state):
    B, H, T, dk = q.shape
    dv = v.shape[-1]
    N, L = T // CHUNK, CHUNK
    qc = (q * dk ** -0.5).reshape(B, H, N, L, dk)
    kc = k.reshape(B, H, N, L, dk)
    vc = v.reshape(B, H, N, L, dv)
    igc = ig.reshape(B, H, N, L)
    b = jnp.cumsum(lf.reshape(B, H, N, L), axis=-1)
    w_log = b[..., -1:] - b + igc
    m_loc = jnp.max(w_log, axis=-1)
    w = jnp.exp(w_log - m_loc[..., None])

    def step(carry, inp):
        C, n, m = carry
        q_i, w_i, v_i, k_i, m_i, bL_i = inp
        qC = jnp.einsum('bhld,bhed->bhle', q_i, C)
        qn = jnp.einsum('bhld,bhd->bhl', q_i, n)
        m_new = jnp.maximum(bL_i + m, m_i)
        a = jnp.exp(bL_i + m - m_new)
        s = jnp.exp(m_i - m_new)
        C = a[..., None, None] * C + s[..., None, None] * jnp.einsum('bhl,bhle,bhld->bhed', w_i, v_i, k_i)
        n = a[..., None] * n + s[..., None] * jnp.einsum('bhl,bhld->bhd', w_i, k_i)
        return (C, n, m_new), (qC, qn, m)

    xs = tuple(jnp.moveaxis(t, 2, 0) for t in (qc, w, vc, kc, m_loc, b[..., -1]))
    final, (qC, qn, m_in) = lax.scan(step, state, xs)
    qC = jnp.moveaxis(qC, 0, 2)
    qn = jnp.moveaxis(qn, 0, 2)
    m_in = jnp.moveaxis(m_in, 0, 2)
    tril = jnp.tril(jnp.ones((L, L), bool))
    inter_log = b + m_in[..., None]
    d_log = jnp.where(tril, b[..., :, None] - b[..., None, :] + igc[..., None, :], -jnp.inf)
    m_out = jnp.maximum(jnp.max(d_log, axis=-1), inter_log)
    s = jnp.einsum('bhnld,bhnsd->bhnls', qc, kc) * jnp.exp(d_log - m_out[..., None])
    e_inter = jnp.exp(inter_log - m_out)
    num = jnp.einsum('bhnls,bhnse->bhnle', s, vc) + e_inter[..., None] * qC
    den = jnp.sum(s, axis=-1) + e_inter * qn
    h = num / jnp.maximum(jnp.abs(den), jnp.exp(-m_out))[..., None]
    return h.reshape(B, H, T, dv), final


def gated_delta_chunked(q, k, v, g, beta, state):
    B, H, T, dk = q.shape
    dv = v.shape[-1]
    N, L = T // CHUNK, CHUNK
    qc = (q * dk ** -0.5).reshape(B, H, N, L, dk)
    kc = k.reshape(B, H, N, L, dk)
    vc = v.reshape(B, H, N, L, dv)
    bc = beta.reshape(B, H, N, L)
    gc = jnp.cumsum(g.reshape(B, H, N, L), axis=-1)
    tril = jnp.tril(jnp.ones((L, L), bool))
    strict = jnp.tril(jnp.ones((L, L), bool), -1)
    decay = jnp.exp(jnp.where(tril, gc[..., :, None] - gc[..., None, :], -jnp.inf))
    kb = kc * bc[..., None]
    a = jnp.where(strict, jnp.einsum('bhnld,bhnsd->bhnls', kb, kc) * decay, 0.0)
    eye = jnp.eye(L, dtype=jnp.float32)
    tm = lax.linalg.triangular_solve(eye + a, jnp.broadcast_to(eye, a.shape), left_side=True, lower=True,
                                     unit_diagonal=True)
    u = tm @ (vc * bc[..., None])
    wk = tm @ (kb * jnp.exp(gc)[..., None])
    qk = jnp.einsum('bhnld,bhnsd->bhnls', qc, kc) * decay
    qg = qc * jnp.exp(gc)[..., None]
    kd = kc * jnp.exp(gc[..., -1:] - gc)[..., None]

    def step(S, inp):
        qg_i, qk_i, u_i, w_i, kd_i, gL_i = inp
        v_new = u_i - w_i @ S
        o = qg_i @ S + qk_i @ v_new
        S = jnp.exp(gL_i)[..., None, None] * S + jnp.einsum('bhld,bhle->bhde', kd_i, v_new)
        return S, o

    xs = tuple(jnp.moveaxis(t, 2, 0) for t in (qg, qk, u, wk, kd, gc[..., -1]))
    S, o = lax.scan(step, state, xs)
    return jnp.moveaxis(o, 0, 2).reshape(B, H, T, dv), S


def gla_chunked(q, k, v, lg, state):
    B, H, T, dk = q.shape
    dv = v.shape[-1]
    N, L = T // CHUNK, CHUNK
    qc = (q * dk ** -0.5).reshape(B, H, N, L, dk)
    kc = k.reshape(B, H, N, L, dk)
    vc = v.reshape(B, H, N, L, dv)
    b = jnp.cumsum(lg.reshape(B, H, N, L, dk), axis=-2)
    qe = qc * jnp.exp(b)
    ke = kc * jnp.exp(-b)
    kd = kc * jnp.exp(b[..., -1:, :] - b)
    tril = jnp.tril(jnp.ones((L, L), bool))
    att = jnp.where(tril, jnp.einsum('bhnld,bhnsd->bhnls', qe, ke), 0.0)
    intra = att @ vc

    def step(S, inp):
        qe_i, kd_i, v_i, bL_i = inp
        o = qe_i @ S
        S = jnp.exp(bL_i)[..., None] * S + jnp.einsum('bhld,bhle->bhde', kd_i, v_i)
        return S, o

    xs = tuple(jnp.moveaxis(t, 2, 0) for t in (qe, kd, vc, b[..., -1, :]))
    S, inter = lax.scan(step, state, xs)
    o = intra + jnp.moveaxis(inter, 0, 2)
    return o.reshape(B, H, T, dv), S


def lru_scan(a, bx, h0):
    def comb(l, r):
        return l[0] * r[0], r[0] * l[1] + r[1]
    acum, hcum = lax.associative_scan(comb, (a, bx), axis=1)
    h = hcum + acum * h0[:, None, :]
    return h, h[:, -1]


def bidirectional(run, ctx_shared, ctx_dir, lat_shared, lat_dir, state0, axis):
    fl = lambda t: jnp.flip(t, axis)
    oc_f, s_f = run(*ctx_shared, *[t[0] for t in ctx_dir], state0)
    ol_f, _ = run(*lat_shared, *[t[0] for t in lat_dir], s_f)
    oc_b, s_b = run(*[fl(t) for t in ctx_shared], *[fl(t[1]) for t in ctx_dir], state0)
    ol_b, _ = run(*[fl(t) for t in lat_shared], *[fl(t[1]) for t in lat_dir], s_b)
    return oc_f + fl(oc_b), ol_f + fl(ol_b)


def mix_mlstm_deltanet(hc, hl, w_in, w_out, ml_ig_b, ml_fg_b, ml_norm_g, dn_conv_w, dn_a_log, dn_dt_bias,
                       dn_norm_g, need_ctx):
    def prep(h, conv):
        mq, mk, mv, mo, mi, mf, dq, dk, dv, dz, da, db = split_cols((h @ w_in).astype(jnp.float32), L0_SPLITS)
        ml = (to_heads(mq, ML_HEADS), to_heads(mk, ML_HEADS), to_heads(mv, ML_HEADS))
        ml_dir = (dir_gates(mi, ML_HEADS) + ml_ig_b[:, None, :, None],
                  jax.nn.log_sigmoid(dir_gates(mf, ML_HEADS) + ml_fg_b[:, None, :, None]))
        qkv = jax.nn.silu(conv(jnp.concatenate([dq, dk, dv], axis=-1), dn_conv_w))
        dq, dk, dv = split_cols(qkv, (DN_HEADS * DN_DK, DN_HEADS * DN_DK, DN_HEADS * DN_DV))
        dn = (l2norm(to_heads(dq, DN_HEADS)), l2norm(to_heads(dk, DN_HEADS)), to_heads(dv, DN_HEADS))
        dt = jax.nn.softplus(dir_gates(da, DN_HEADS) + dn_dt_bias[:, None, :, None])
        dn_dir = (-jnp.exp(dn_a_log)[:, None, :, None] * dt, jax.nn.sigmoid(dir_gates(db, DN_HEADS)))
        return ml, ml_dir, mo, dn, dn_dir, dz

    pc = prep(hc, dwconv_seq)
    pl = prep(hl, dwconv_grid)
    B = hc.shape[0]
    ml0 = (jnp.zeros((B, ML_HEADS, ML_DV, ML_DK), jnp.float32), jnp.zeros((B, ML_HEADS, ML_DK), jnp.float32),
           jnp.zeros((B, ML_HEADS), jnp.float32))
    ml_c, ml_l = bidirectional(mlstm_chunked, pc[0], pc[1], pl[0], pl[1], ml0, 2)
    dn0 = jnp.zeros((B, DN_HEADS, DN_DK, DN_DV), jnp.float32)
    dn_c, dn_l = bidirectional(gated_delta_chunked, pc[3], pc[4], pl[3], pl[4], dn0, 2)

    def merge(ml, mo, dn, dz):
        y = jnp.concatenate([head_rmsnorm(ml, ml_norm_g) * jax.nn.sigmoid(mo),
                             head_rmsnorm(dn, dn_norm_g) * jax.nn.silu(dz)], axis=-1)
        return y.astype(w_out.dtype) @ w_out

    yl = merge(ml_l, pl[2], dn_l, pl[5])
    yc = merge(ml_c, pc[2], dn_c, pc[5]) if need_ctx else None
    return yc, yl


def mix_rglru_gla(hc, hl, w_in, w_out, rg_conv_w, rg_conv_b, rg_w_r, rg_b_r, rg_w_i, rg_b_i, rg_lambda,
                  gla_w_up, gla_b_up, gla_norm_g, need_ctx):
    def prep(h, conv):
        B, T, _ = h.shape
        xr, gr, q, k, v, og, lr = split_cols((h @ w_in).astype(jnp.float32), L1_SPLITS)
        xc = conv(xr, rg_conv_w) + rg_conv_b
        xb = xc.reshape(B, T, RG_BLOCKS, RG_WIDTH // RG_BLOCKS)
        r = jax.nn.sigmoid(jnp.einsum('btgi,zgij->zbtgj', xb, rg_w_r).reshape(2, B, T, RG_WIDTH)
                           + rg_b_r[:, None, None, :])
        i = jax.nn.sigmoid(jnp.einsum('btgi,zgij->zbtgj', xb, rg_w_i).reshape(2, B, T, RG_WIDTH)
                           + rg_b_i[:, None, None, :])
        log_a = -RG_C * r * jax.nn.softplus(-rg_lambda)[:, None, None, :]
        rg_dir = (jnp.exp(log_a), jnp.sqrt(-jnp.expm1(2.0 * log_a)) * (i * xc))
        z = jnp.einsum('btzr,zrk->zbtk', lr.reshape(B, T, 2, GLA_RANK), gla_w_up) + gla_b_up[:, None, None, :]
        lg = jnp.transpose((jax.nn.log_sigmoid(z) / GLA_TAU).reshape(2, B, T, GLA_HEADS, GLA_DK), (0, 1, 3, 2, 4))
        gla = (to_heads(q, GLA_HEADS), to_heads(k, GLA_HEADS), to_heads(v, GLA_HEADS))
        return rg_dir, gr, gla, (lg,), og

    pc = prep(hc, dwconv_seq)
    pl = prep(hl, dwconv_grid)
    B = hc.shape[0]
    rg_c, rg_l = bidirectional(lru_scan, (), pc[0], (), pl[0], jnp.zeros((B, RG_WIDTH), jnp.float32), 1)
    gla0 = jnp.zeros((B, GLA_HEADS, GLA_DK, GLA_DV), jnp.float32)
    gla_c, gla_l = bidirectional(gla_chunked, pc[2], pc[3], pl[2], pl[3], gla0, 2)

    def merge(rg, gr, gla, og):
        y = jnp.concatenate([jax.nn.gelu(gr) * rg, head_rmsnorm(gla, gla_norm_g) * jax.nn.silu(og)], axis=-1)
        return y.astype(w_out.dtype) @ w_out

    yl = merge(rg_l, pl[1], gla_l, pl[4])
    yc = merge(rg_c, pc[1], gla_c, pc[4]) if need_ctx else None
    return yc, yl


def setup_inputs(seed: int = 0) -> dict:
    key = jax.random.key(seed)
    kit = iter(jax.random.split(key, 48))
    D, F = D_MODEL, FFN_HIDDEN
    NE, NO = (DEPTH + 1) // 2, DEPTH // 2

    def nrm(shape, scale):
        return jax.random.normal(next(kit), shape, jnp.float32) * scale

    def uni(shape, lo, hi):
        return jax.random.uniform(next(kit), shape, jnp.float32, lo, hi)

    def gain(shape):
        return 1.0 + nrm(shape, 0.02)

    x = nrm((BATCH, SEQ, D), 1.0)
    c = nrm((BATCH, D), 1.0)
    ctx = nrm((BATCH, CTX_LEN, D), 1.0)
    c_ctx = nrm((D,), 1.0)
    mod_w = nrm((DEPTH, D, 6 * D), 0.5 * D ** -0.5)
    mod_b = nrm((DEPTH, 6 * D), 0.02)
    norm_mix_g = gain((DEPTH, D))
    norm_ffn_g = gain((DEPTH, D))
    ffn_w_gu = nrm((DEPTH, D, 2 * F), D ** -0.5)
    ffn_w_down = nrm((DEPTH, F, D), F ** -0.5)
    final_norm_g = gain((D,))
    ab_w_in = nrm((NE, D, L0_COLS), D ** -0.5)
    ab_w_out = nrm((NE, L0_OUT, D), L0_OUT ** -0.5)
    ml_ig_b = nrm((NE, 2, ML_HEADS), 0.1)
    ml_fg_b = uni((NE, 2, ML_HEADS), 3.0, 6.0)
    ml_norm_g = gain((NE, ML_HEADS * ML_DV))
    dn_conv_w = nrm((NE, CONV_W, DN_HEADS * (2 * DN_DK + DN_DV)), CONV_W ** -0.5)
    dn_a_log = jnp.log(uni((NE, 2, DN_HEADS), 1.0, 16.0))
    dt = jnp.exp(uni((NE, 2, DN_HEADS), math.log(1e-3), math.log(1e-1)))
    dn_dt_bias = dt + jnp.log(-jnp.expm1(-dt))
    dn_norm_g = gain((NE, DN_HEADS * DN_DV))
    cd_w_in = nrm((NO, D, L1_COLS), D ** -0.5)
    cd_w_out = nrm((NO, L1_OUT, D), L1_OUT ** -0.5)
    rg_conv_w = nrm((NO, CONV_W, RG_WIDTH), CONV_W ** -0.5)
    rg_conv_b = nrm((NO, RG_WIDTH), 0.02)
    bw = RG_WIDTH // RG_BLOCKS
    rg_w_r = nrm((NO, 2, RG_BLOCKS, bw, bw), bw ** -0.5)
    rg_b_r = nrm((NO, 2, RG_WIDTH), 0.1)
    rg_w_i = nrm((NO, 2, RG_BLOCKS, bw, bw), bw ** -0.5)
    rg_b_i = nrm((NO, 2, RG_WIDTH), 0.1)
    sig = uni((NO, 2, RG_WIDTH), 0.9, 0.999) ** (1.0 / RG_C)
    rg_lambda = jnp.log(sig) - jnp.log1p(-sig)
    gla_w_up = nrm((NO, 2, GLA_RANK, GLA_HEADS * GLA_DK), GLA_RANK ** -0.5)
    gla_b_up = nrm((NO, 2, GLA_HEADS * GLA_DK), 0.1)
    gla_norm_g = gain((NO, GLA_HEADS * GLA_DV))
    return {'x': x, 'c': c, 'ctx': ctx, 'c_ctx': c_ctx, 'mod_w': mod_w, 'mod_b': mod_b,
            'norm_mix_g': norm_mix_g, 'norm_ffn_g': norm_ffn_g, 'ffn_w_gu': ffn_w_gu, 'ffn_w_down': ffn_w_down,
            'final_norm_g': final_norm_g, 'ab_w_in': ab_w_in, 'ab_w_out': ab_w_out, 'ml_ig_b': ml_ig_b,
            'ml_fg_b': ml_fg_b, 'ml_norm_g': ml_norm_g, 'dn_conv_w': dn_conv_w, 'dn_a_log': dn_a_log,
            'dn_dt_bias': dn_dt_bias, 'dn_norm_g': dn_norm_g, 'cd_w_in': cd_w_in, 'cd_w_out': cd_w_out,
            'rg_conv_w': rg_conv_w, 'rg_conv_b': rg_conv_b, 'rg_w_r': rg_w_r, 'rg_b_r': rg_b_r,
            'rg_w_i': rg_w_i, 'rg_b_i': rg_b_i, 'rg_lambda': rg_lambda, 'gla_w_up': gla_w_up,
            'gla_b_up': gla_b_up, 'gla_norm_g': gla_norm_g}


def reference(x, c, ctx, c_ctx, mod_w, mod_b, norm_mix_g, norm_ffn_g, ffn_w_gu, ffn_w_down, final_norm_g,
              ab_w_in, ab_w_out, ml_ig_b, ml_fg_b, ml_norm_g, dn_conv_w, dn_a_log, dn_dt_bias, dn_norm_g,
              cd_w_in, cd_w_out, rg_conv_w, rg_conv_b, rg_w_r, rg_b_r, rg_w_i, rg_b_i, rg_lambda,
              gla_w_up, gla_b_up, gla_norm_g):
    xc, xl = ctx, x
    for layer in range(DEPTH):
        last = layer == DEPTH - 1
        j = layer // 2
        sh1, sc1, g1, sh2, sc2, g2 = adaln(c, mod_w[layer], mod_b[layer])
        csh1, csc1, cg1, csh2, csc2, cg2 = adaln(c_ctx, mod_w[layer], mod_b[layer])
        hl = rmsnorm(xl, norm_mix_g[layer]) * (1.0 + sc1) + sh1
        hc = rmsnorm(xc, norm_mix_g[layer]) * (1.0 + csc1) + csh1
        if layer % 2 == 0:
            yc, yl = mix_mlstm_deltanet(hc, hl, ab_w_in[j], ab_w_out[j], ml_ig_b[j], ml_fg_b[j], ml_norm_g[j],
                                        dn_conv_w[j], dn_a_log[j], dn_dt_bias[j], dn_norm_g[j], not last)
        else:
            yc, yl = mix_rglru_gla(hc, hl, cd_w_in[j], cd_w_out[j], rg_conv_w[j], rg_conv_b[j], rg_w_r[j],
                                   rg_b_r[j], rg_w_i[j], rg_b_i[j], rg_lambda[j], gla_w_up[j], gla_b_up[j],
                                   gla_norm_g[j], not last)
        xl = xl + g1 * yl
        xl = xl + g2 * swiglu(rmsnorm(xl, norm_ffn_g[layer]) * (1.0 + sc2) + sh2, ffn_w_gu[layer],
                              ffn_w_down[layer])
        if not last:
            xc = xc + cg1 * yc
            xc = xc + cg2 * swiglu(rmsnorm(xc, norm_ffn_g[layer]) * (1.0 + csc2) + csh2, ffn_w_gu[layer],
                                   ffn_w_down[layer])
    return rmsnorm(xl, final_norm_g)
```

```cpp
#include <hip/hip_runtime.h>
#include <hip/hip_cooperative_groups.h>
#include <cstdio>
namespace cg = cooperative_groups;

typedef unsigned short u16;

constexpr int DM = 2048, FH = 5632, MC = 512, MLAT = 32768, MTOT = 33280, NTHR = 512;
constexpr int NP0 = 7168, NP1 = 5120;
constexpr int NG0 = 48, NG1 = 32;
constexpr int NSEG = 260;

constexpr size_t WS_WT_IN = 0;
constexpr size_t WS_WT_OUT = WS_WT_IN + (size_t)7424 * 2048 * 2;
constexpr size_t WS_WT_GU = WS_WT_OUT + (size_t)2048 * 2048 * 2;
constexpr size_t WS_WT_DN = WS_WT_GU + (size_t)11264 * 2048 * 2;
constexpr size_t WS_H = WS_WT_DN + (size_t)2048 * 5632 * 2;
constexpr size_t WS_PROJ = WS_H + (size_t)MTOT * 2048 * 2;
constexpr size_t WS_OF = WS_PROJ + (size_t)MTOT * 7168 * 2;
constexpr size_t WS_OB = WS_OF + (size_t)MTOT * 2048 * 2;
constexpr size_t WS_XC = WS_OB + (size_t)MTOT * 2048 * 2;
constexpr size_t WS_G = WS_XC + (size_t)MC * 2048 * 4;
constexpr size_t WS_CQ = WS_G + (size_t)MTOT * 48 * 4;
constexpr size_t WS_MODP = WS_CQ + (size_t)MC * 3072 * 2;
constexpr size_t WS_MOD = WS_MODP + (size_t)2 * 32 * 3 * 12288 * 4;
constexpr size_t WS_END = WS_MOD + (size_t)2 * 3 * 12288 * 4;
constexpr size_t WS_OF1 = WS_OF;
constexpr size_t WS_OB1 = WS_OF + (size_t)MTOT * 1024 * 2;
constexpr size_t WS_OM = WS_OB;
constexpr size_t WS_AGG = WS_OM + (size_t)2 * MTOT * 512 * 2;
constexpr size_t WS_CARRY = WS_AGG + (size_t)4 * NSEG * 1024 * 8;

struct Params {
    const float *x, *c, *ctx, *c_ctx, *mod_w, *mod_b, *norm_mix_g, *norm_ffn_g, *ffn_w_gu, *ffn_w_down, *final_norm_g,
        *ab_w_in, *ab_w_out, *ml_ig_b, *ml_fg_b, *ml_norm_g, *dn_conv_w, *dn_a_log, *dn_dt_bias, *dn_norm_g,
        *cd_w_in, *cd_w_out, *rg_conv_w, *rg_conv_b, *rg_w_r, *rg_b_r, *rg_w_i, *rg_b_i, *rg_lambda, *gla_w_up, *gla_b_up, *gla_norm_g;
    float* out; unsigned char* ws;
};

__device__ __forceinline__ float bf2f(u16 v) { return __uint_as_float(((unsigned)v) << 16); }
__device__ __forceinline__ unsigned cvt_pk_bf16(float lo, float hi) { unsigned r; asm volatile("v_cvt_pk_bf16_f32 %0, %1, %2" : "=v"(r) : "v"(lo), "v"(hi)); return r; }
__device__ __forceinline__ u16 f2bf(float f) { return (u16)(cvt_pk_bf16(f, 0.f) & 0xffffu); }
__device__ __forceinline__ void unpack8(const uint4& u, float* f) {
    f[0] = __uint_as_float(u.x << 16); f[1] = __uint_as_float(u.x & 0xffff0000u);
    f[2] = __uint_as_float(u.y << 16); f[3] = __uint_as_float(u.y & 0xffff0000u);
    f[4] = __uint_as_float(u.z << 16); f[5] = __uint_as_float(u.z & 0xffff0000u);
    f[6] = __uint_as_float(u.w << 16); f[7] = __uint_as_float(u.w & 0xffff0000u);
}
__device__ __forceinline__ uint4 pack8(const float* f) { uint4 o; o.x = cvt_pk_bf16(f[0], f[1]); o.y = cvt_pk_bf16(f[2], f[3]); o.z = cvt_pk_bf16(f[4], f[5]); o.w = cvt_pk_bf16(f[6], f[7]); return o; }
template <int CTRL> __device__ __forceinline__ float dppf(float x) { return __int_as_float(__builtin_amdgcn_update_dpp(0, __float_as_int(x), CTRL, 0xF, 0xF, true)); }
__device__ __forceinline__ float red4(float x) { x += dppf<0xB1>(x); x += dppf<0x4E>(x); return x; }
__device__ __forceinline__ float red8(float x) { x = red4(x); x += dppf<0x141>(x); return x; }
__device__ __forceinline__ float red16(float x) { x = red8(x); x += dppf<0x140>(x); return x; }
__device__ __forceinline__ float red64(float x) { x = red16(x); x += __shfl_xor(x, 16); x += __shfl_xor(x, 32); return x; }
__device__ __forceinline__ float sigmoidf_(float x) { return 1.f / (1.f + __expf(-x)); }
__device__ __forceinline__ float siluf_(float x) { return x / (1.f + __expf(-x)); }
__device__ __forceinline__ float softplusf_(float x) { return fmaxf(x, 0.f) + log1pf(__expf(-fabsf(x))); }
__device__ __forceinline__ float logsigmoidf_(float x) { return fminf(x, 0.f) - log1pf(__expf(-fabsf(x))); }
__device__ __forceinline__ float gelu_tanh(float x) { const float u = 0.7978845608028654f * (x + 0.044715f * x * x * x); const float th = 1.f - 2.f / (1.f + __expf(2.f * u)); return 0.5f * x * (1.f + th); }

__device__ __forceinline__ int tid_fresh() { int t = threadIdx.x; asm volatile("" : "+v"(t)); return t; }
namespace pg8 {
#define PG8_LAS __attribute__((address_space(3)))
typedef unsigned short bf16_t;
typedef short bf16x8 __attribute__((ext_vector_type(8)));
typedef float f32x4 __attribute__((ext_vector_type(4)));
typedef unsigned u32x4 __attribute__((ext_vector_type(4)));
constexpr int BM = 256, BK = 64, HALF = 128, HTB = HALF * BK * 2  , STAGE_BYTES = 8 * HTB, NXCD = 8, WGM = 8;

__host__ __device__ __forceinline__ int lds_byte(int r, int c) { const int st = (r >> 4) * 2 + (c >> 5), rr = r & 15, cc = c & 31, ob = rr * 64 + cc * 2; return st * 1024 + (ob ^ (((ob >> 9) & 1) << 5)); }
__host__ __device__ __forceinline__ void stage_rc(int b, int& R, int& C) { const int st = b / 1024, sb = b % 1024, swz = sb ^ (((sb >> 9) & 1) << 5); R = (st >> 1) * 16 + swz / 64; C = (st & 1) * 32 + (swz % 64) / 2; }
__host__ __device__ __forceinline__ int perm32(int rho) { const int n = rho >> 4, i = rho & 15; return 8 * (i >> 2) + 4 * n + (i & 3); }

struct Unit { int pm, pn; };
struct Gemm { const bf16_t* A; const bf16_t* Bt; int M, N, K; };

struct StaticOrder {
    int nM, nN, nwg, G, c;
    __host__ __device__ void init(int M, int N, int G_, int c_) { nM = M / BM; nN = N / BM; nwg = nM * nN; G = G_; c = c_; }
    __host__ __device__ bool next(int i, Unit& u) const {
        const long L = (long)i * G + c; if (L >= nwg) return false;
        int wgid = (int)L; { const int q = nwg / NXCD, r = nwg % NXCD, xcd = wgid % NXCD, off = wgid / NXCD; wgid = (xcd < r ? xcd * (q + 1) : r * (q + 1) + (xcd - r) * q) + off; }
        const int nig = WGM * nN, gid = wgid / nig, fm = gid * WGM, gsz = (nM - fm) < WGM ? (nM - fm) : WGM;
        u.pm = fm + ((wgid % nig) % gsz); u.pn = (wgid % nig) / gsz; return true;
    }
    __device__ __forceinline__ void a_ready(const Unit&) const {}
    __device__ __forceinline__ void done(const Unit&) const {}
};
__device__ __forceinline__ unsigned cvt_pk_bf16(float lo, float hi) { unsigned r; asm volatile("v_cvt_pk_bf16_f32 %0, %1, %2" : "=v"(r) : "v"(lo), "v"(hi)); return r; }
typedef float f32x2 __attribute__((ext_vector_type(2)));

struct EpiProj {
    static constexpr bool PERM = true, AFTER_DRAIN = false;
    bf16_t* P; int ldp; int n_main; float* G; int ldg; int ng;
    __device__ __forceinline__ void operator()(const f32x4 (&acc)[2][2][4][2], const Unit& u, int wr, int wc, int fr, int fq) const {
        const int row0 = u.pm * BM + wr * 64 + fr;
        if (u.pn < n_main) {
            const int col0 = u.pn * BM + wc * 32 + 8 * fq;
#pragma unroll
            for (int ai = 0; ai < 2; ++ai)
#pragma unroll
                for (int m = 0; m < 4; ++m) { bf16_t* rowp = P + (size_t)(row0 + ai * HALF + m * 16) * ldp + col0;
#pragma unroll
                    for (int bj = 0; bj < 2; ++bj) { const f32x4 v0 = acc[ai][bj][m][0], v1 = acc[ai][bj][m][1];
                        u32x4 w; w.x = cvt_pk_bf16(v0[0], v0[1]); w.y = cvt_pk_bf16(v0[2], v0[3]); w.z = cvt_pk_bf16(v1[0], v1[1]); w.w = cvt_pk_bf16(v1[2], v1[3]);
                        *(u32x4*)(rowp + bj * HALF) = w; } }
        } else {
            const int c0 = wc * 32 + 8 * fq;
#pragma unroll
            for (int ai = 0; ai < 2; ++ai)
#pragma unroll
                for (int m = 0; m < 4; ++m) { float* rowp = G + (size_t)(row0 + ai * HALF + m * 16) * ldg;
#pragma unroll
                    for (int n = 0; n < 2; ++n)
#pragma unroll
                        for (int j = 0; j < 4; ++j) { const int c = c0 + 4 * n + j; if (c < ng) rowp[c] = acc[ai][0][m][n][j]; } }
        }
    }
};
struct EpiRes {
    static constexpr bool PERM = false, AFTER_DRAIN = false;
    const float* srcC; const float* srcL; float* dstC; float* dstL; const float* gate  ; int row_off;
    __device__ __forceinline__ void operator()(const f32x4 (&acc)[2][2][4][2], const Unit& u, int wr, int wc, int fr, int fq) const {
        const int grow_t = u.pm * BM + row_off;
        const bool isc = grow_t < 512;
        const int mr = isc ? 2 : ((grow_t - 512) >> 14);
        const float* sp = isc ? srcC + (size_t)grow_t * 2048 : srcL + (size_t)(grow_t - 512) * 2048;
        float* dp = isc ? dstC + (size_t)grow_t * 2048 : dstL + (size_t)(grow_t - 512) * 2048;
        const int lrow0 = wr * 64 + fr, col0 = u.pn * BM + wc * 32 + 4 * fq;
        const float* gp = gate + (size_t)mr * 12288 + col0;
        f32x4 gv[2][2];
#pragma unroll
        for (int bj = 0; bj < 2; ++bj)
#pragma unroll
            for (int n = 0; n < 2; ++n) gv[bj][n] = *(const f32x4*)(gp + bj * HALF + n * 16);
#pragma unroll
        for (int ai = 0; ai < 2; ++ai)
#pragma unroll
            for (int m = 0; m < 4; ++m) { const size_t off = (size_t)(lrow0 + ai * HALF + m * 16) * 2048 + col0;
#pragma unroll
                for (int bj = 0; bj < 2; ++bj)
#pragma unroll
                    for (int n = 0; n < 2; ++n) { const f32x4 s = *(const f32x4*)(sp + off + bj * HALF + n * 16);
                        *(f32x4*)(dp + off + bj * HALF + n * 16) = s + gv[bj][n] * acc[ai][bj][m][n]; } }
    }
};
struct EpiSwiglu {
    static constexpr bool PERM = true, AFTER_DRAIN = false;
    bf16_t* O; int ldo;
    __device__ __forceinline__ void operator()(const f32x4 (&acc)[2][2][4][2], const Unit& u, int wr, int wc, int fr, int fq) const {
        const int row0 = u.pm * BM + wr * 64 + fr, col0 = u.pn * HALF + wc * 32 + 8 * fq;
#pragma unroll
        for (int ai = 0; ai < 2; ++ai)
#pragma unroll
            for (int m = 0; m < 4; ++m) { float r[8];
#pragma unroll
                for (int n = 0; n < 2; ++n)
#pragma unroll
                    for (int j = 0; j < 4; ++j) { const float gg = acc[ai][0][m][n][j], uu = acc[ai][1][m][n][j]; r[n * 4 + j] = gg / (1.f + __expf(-gg)) * uu; }
                u32x4 w; w.x = cvt_pk_bf16(r[0], r[1]); w.y = cvt_pk_bf16(r[2], r[3]); w.z = cvt_pk_bf16(r[4], r[5]); w.w = cvt_pk_bf16(r[6], r[7]);
                *(u32x4*)(O + (size_t)(row0 + ai * HALF + m * 16) * ldo + col0) = w; }
    }
};

template <class Epi, class Sched>
__device__ __forceinline__ void gemm_phase(PG8_LAS unsigned char* lds, const Gemm g, const Sched& S, const Epi& E) {
    int tid = threadIdx.x; asm volatile("" : "+v"(tid)); const int wid = __builtin_amdgcn_readfirstlane(tid >> 6), lane = tid & 63, wr = wid >> 2, wc = wid & 3, fr = lane & 15, fq = lane >> 4;
    const int K = g.K, nt = K / BK;
    unsigned voffA[2], voffB[2];
#pragma unroll
    for (int i = 0; i < 2; ++i) { int R, C; stage_rc(tid * 16 + i * 8192, R, C); const int Rb = Epi::PERM ? ((R & ~31) + perm32(R & 31)) : R;
        voffA[i] = (unsigned)(R * K + C) * 2u; voffB[i] = (unsigned)(Rb * K + C) * 2u; }
    const size_t kstep = (size_t)(BK * 2);
    const size_t hstep = (size_t)HALF * K * 2;
    const size_t tstep = 2 * hstep;
    const unsigned ldsw = (unsigned)wid * 1024u;
    const int aoff = lds_byte(wr * 64 + fr, fq * 8), boff = lds_byte(wc * 32 + fr, fq * 8);
#define PG8_SA(b, h) (((b) * 2 + (h)) * HTB)
#define PG8_SB(b, h) ((4 + (b) * 2 + (h)) * HTB)
#define PG8_STAGE(bufoff, gbase, voff) do { _Pragma("unroll") for (int _i = 0; _i < 2; ++_i) \
        __builtin_amdgcn_global_load_lds((const unsigned*)((const char*)(gbase) + (voff)[_i]), (PG8_LAS unsigned*)(lds + (bufoff) + ldsw + _i * 8192), 16, 0, 0); } while (0)
#define PG8_LDA(dst, b, h) do { _Pragma("unroll") for (int m = 0; m < 4; ++m) _Pragma("unroll") for (int k = 0; k < 2; ++k) dst[m][k] = *(const PG8_LAS bf16x8*)(lds + PG8_SA(b, h) + aoff + m * 2048 + k * 1024); } while (0)
#define PG8_LDB(dst, b, h) do { _Pragma("unroll") for (int n = 0; n < 2; ++n) _Pragma("unroll") for (int k = 0; k < 2; ++k) dst[n][k] = *(const PG8_LAS bf16x8*)(lds + PG8_SB(b, h) + boff + n * 2048 + k * 1024); } while (0)
#define PG8_MMA(ai, bj, At, Bt) do { __builtin_amdgcn_s_setprio(1); _Pragma("unroll") for (int m = 0; m < 4; ++m) _Pragma("unroll") for (int n = 0; n < 2; ++n) _Pragma("unroll") for (int k = 0; k < 2; ++k) \
        acc[ai][bj][m][n] = __builtin_amdgcn_mfma_f32_16x16x32_bf16(Bt[n][k], At[m][k], acc[ai][bj][m][n], 0, 0, 0); __builtin_amdgcn_s_setprio(0); } while (0)
#define PG8_WAIT_V(n) asm volatile("s_waitcnt vmcnt(" #n ")" ::: "memory")
#define PG8_WAIT_L(n) asm volatile("s_waitcnt lgkmcnt(" #n ")" ::: "memory")
#define PG8_BAR __builtin_amdgcn_s_barrier()
#define PG8_SCHED __builtin_amdgcn_sched_barrier(0)
    Unit cur, nxt; int ui = 0;
    if (!S.next(0, cur)) return;
    f32x4 acc[2][2][4][2];
#pragma unroll
    for (int a = 0; a < 2; ++a)
#pragma unroll
        for (int b = 0; b < 2; ++b)
#pragma unroll
            for (int m = 0; m < 4; ++m)
#pragma unroll
                for (int n = 0; n < 2; ++n) acc[a][b][m][n] = (f32x4){0.f, 0.f, 0.f, 0.f};
    bf16x8 At[4][2], B0[2][2], B1[2][2];
    const char* cA = (const char*)g.A + (size_t)cur.pm * tstep; const char* cB = (const char*)g.Bt + (size_t)cur.pn * tstep;
    S.a_ready(cur);
    PG8_STAGE(PG8_SB(0, 0), cB, voffB); PG8_STAGE(PG8_SA(0, 0), cA, voffA); PG8_STAGE(PG8_SB(0, 1), cB + hstep, voffB); PG8_STAGE(PG8_SA(0, 1), cA + hstep, voffA);
    if (wr == 1) PG8_BAR;
    PG8_WAIT_V(4); PG8_BAR;
    PG8_STAGE(PG8_SB(1, 0), cB + kstep, voffB); PG8_STAGE(PG8_SA(1, 0), cA + kstep, voffA); PG8_STAGE(PG8_SB(1, 1), cB + hstep + kstep, voffB);
    PG8_WAIT_V(6); PG8_BAR;
    for (;;) {
        const bool has_next = S.next(ui + 1, nxt);
        const char* nA = has_next ? (const char*)g.A + (size_t)nxt.pm * tstep : cA; const char* nB = has_next ? (const char*)g.Bt + (size_t)nxt.pn * tstep : cB;
        for (int t = 0; t < nt; t += 2) {
            const bool last = (t == nt - 2);
            const char* a1 = cA + (size_t)(t + 1) * kstep;
            const char* a2 = last ? nA : cA + (size_t)(t + 2) * kstep; const char* b2 = last ? nB : cB + (size_t)(t + 2) * kstep;
            const char* a3 = a2 + kstep; const char* b3 = b2 + kstep;
            if (last && has_next) S.a_ready(nxt);
            PG8_LDB(B0, 0, 0); PG8_SCHED; PG8_LDA(At, 0, 0); PG8_STAGE(PG8_SA(1, 1), a1 + hstep, voffA);
            PG8_WAIT_L(8); PG8_BAR; PG8_WAIT_L(0); PG8_MMA(0, 0, At, B0); PG8_BAR; PG8_SCHED;
            PG8_LDB(B1, 0, 1); PG8_STAGE(PG8_SB(0, 0), b2, voffB);
            PG8_BAR; PG8_WAIT_L(0); PG8_MMA(0, 1, At, B1); PG8_BAR;
            PG8_LDA(At, 0, 1); PG8_STAGE(PG8_SA(0, 0), a2, voffA);
            PG8_BAR; PG8_WAIT_L(0); PG8_MMA(1, 0, At, B0); PG8_BAR; PG8_SCHED;
            PG8_STAGE(PG8_SB(0, 1), b2 + hstep, voffB);
            PG8_WAIT_V(6); PG8_BAR; PG8_MMA(1, 1, At, B1); PG8_BAR;
            PG8_LDB(B0, 1, 0); PG8_SCHED; PG8_LDA(At, 1, 0); PG8_STAGE(PG8_SA(0, 1), a2 + hstep, voffA);
            PG8_WAIT_L(8); PG8_BAR; PG8_WAIT_L(0); PG8_MMA(0, 0, At, B0); PG8_BAR; PG8_SCHED;
            PG8_LDB(B1, 1, 1); PG8_STAGE(PG8_SB(1, 0), b3, voffB);
            PG8_BAR; PG8_WAIT_L(0); PG8_MMA(0, 1, At, B1); PG8_BAR;
            PG8_LDA(At, 1, 1); PG8_STAGE(PG8_SA(1, 0), a3, voffA);
            PG8_BAR; PG8_WAIT_L(0); PG8_MMA(1, 0, At, B0); PG8_BAR; PG8_SCHED;
            PG8_STAGE(PG8_SB(1, 1), b3 + hstep, voffB);
            PG8_WAIT_V(6); PG8_BAR; PG8_MMA(1, 1, At, B1); PG8_BAR;
        }
        if constexpr (!Epi::AFTER_DRAIN) { E(acc, cur, wr, wc, fr, fq); S.done(cur); }
        if (!has_next) break;
#pragma unroll
        for (int a = 0; a < 2; ++a)
#pragma unroll
            for (int b = 0; b < 2; ++b)
#pragma unroll
                for (int m = 0; m < 4; ++m)
#pragma unroll
                    for (int n = 0; n < 2; ++n) acc[a][b][m][n] = (f32x4){0.f, 0.f, 0.f, 0.f};
        cur = nxt; cA = nA; cB = nB; ++ui;
    }
    PG8_WAIT_V(0);
    if (wr == 0) PG8_BAR;
    PG8_BAR;
    if constexpr (Epi::AFTER_DRAIN) { E.fused(acc, cur, wr, wc, fr, fq, lds, wid, lane); S.done(cur); }
#undef PG8_SA
#undef PG8_SB
#undef PG8_STAGE
#undef PG8_LDA
#undef PG8_LDB
#undef PG8_MMA
#undef PG8_WAIT_V
#undef PG8_WAIT_L
#undef PG8_BAR
#undef PG8_SCHED
}
}

__device__ __forceinline__ void ph_adaln_partials(const Params& p, float* sm) {
    const int tid = tid_fresh();
    float* MODP = (float*)(p.ws + WS_MODP);
    for (int it = blockIdx.x; it < 384; it += gridDim.x) {
        const int l = it / 192, rem = it % 192, kc = rem / 6, cgp = rem % 6;
        __syncthreads();
        if (tid < 192) { const int r = tid >> 6, kk = tid & 63, k = kc * 64 + kk; const float cv = (r < 2) ? p.c[r * 2048 + k] : p.c_ctx[k]; sm[tid] = siluf_(cv); }
        __syncthreads();
        const int col = cgp * 2048 + tid * 4;
        float4 a0 = {0.f, 0.f, 0.f, 0.f}, a1 = a0, a2 = a0;
        const float* wp = p.mod_w + ((size_t)l * 2048 + (size_t)kc * 64) * 12288 + col;
#pragma unroll 8
        for (int kk = 0; kk < 64; ++kk) {
            const float4 w = *(const float4*)(wp + (size_t)kk * 12288);
            const float s0 = sm[kk], s1 = sm[64 + kk], s2 = sm[128 + kk];
            a0.x += s0 * w.x; a0.y += s0 * w.y; a0.z += s0 * w.z; a0.w += s0 * w.w;
            a1.x += s1 * w.x; a1.y += s1 * w.y; a1.z += s1 * w.z; a1.w += s1 * w.w;
            a2.x += s2 * w.x; a2.y += s2 * w.y; a2.z += s2 * w.z; a2.w += s2 * w.w;
        }
        float* o = MODP + ((size_t)(l * 32 + kc) * 3) * 12288 + col;
        *(float4*)(o) = a0; *(float4*)(o + 12288) = a1; *(float4*)(o + 2 * 12288) = a2;
    }
}
__device__ __forceinline__ void ph_adaln_reduce(const Params& p) {
    const float* MODP = (const float*)(p.ws + WS_MODP); float* MOD = (float*)(p.ws + WS_MOD);
    for (int idx = blockIdx.x * NTHR + tid_fresh(); idx < 2 * 3 * 12288; idx += gridDim.x * NTHR) {
        const int l = idx / 36864, r = (idx / 12288) % 3, col = idx % 12288;
        float s = p.mod_b[l * 12288 + col];
        for (int kc = 0; kc < 32; ++kc) s += MODP[((size_t)(l * 32 + kc) * 3 + r) * 12288 + col];
        MOD[idx] = s;
    }
}

template <int MODE> __device__ __forceinline__ int colmap(int n, int nsrc) {
    if (MODE == 0) return n < nsrc ? n : -1;
    if (MODE == 1) { if (n < 3072) return n; if (n < 7168) return n + 16; if (n < 7184) return 3072 + (n - 7168); if (n < 7216) return n; return -1; }
    return ((n >> 7) & 1) * 5632 + (n >> 8) * 128 + (n & 127);
}
template <int MODE> __device__ __forceinline__ void ph_convert(const float* W, int nsrc, int K, int nout, u16* Bt, float* sm) {
    const int tid = tid_fresh(); const int nnt = nout / 64, ntiles = nnt * (K / 64);
    for (int t = blockIdx.x; t < ntiles; t += gridDim.x) {
        const int k0 = (t / nnt) * 64, n0 = (t % nnt) * 64;
        __syncthreads();
#pragma unroll
        for (int i = 0; i < 8; ++i) { const int idx = i * NTHR + tid, kk = idx >> 6, nn = idx & 63; const int src = colmap<MODE>(n0 + nn, nsrc);
            sm[kk * 65 + nn] = src >= 0 ? W[(size_t)(k0 + kk) * nsrc + src] : 0.f; }
        __syncthreads();
        { const int nn = tid >> 3, k8 = (tid & 7) * 8; float v[8];
#pragma unroll
            for (int j = 0; j < 8; ++j) v[j] = sm[(k8 + j) * 65 + nn];
            *(uint4*)(Bt + (size_t)(n0 + nn) * K + k0 + k8) = pack8(v); }
    }
}

__device__ __forceinline__ void ph_norm(const float* srcC, const float* srcL, const float* g, const float* modl, int chunk_sh, int chunk_sc, u16* H, int row_begin) {
    const int tid_ = tid_fresh(); const int lane = tid_ & 63, w = tid_ >> 6;
    for (int row = row_begin + blockIdx.x * 8 + w; row < MTOT; row += gridDim.x * 8) {
        const float* src = row < 512 ? srcC + (size_t)row * 2048 : srcL + (size_t)(row - 512) * 2048;
        const int mr = row < 512 ? 2 : ((row - 512) >> 14);
        const float* sc = modl + (mr * 6 + chunk_sc) * 2048; const float* sh = modl + (mr * 6 + chunk_sh) * 2048;
        float4 v[8]; float ss = 0.f;
#pragma unroll
        for (int i = 0; i < 8; ++i) { v[i] = *(const float4*)(src + i * 256 + lane * 4); ss += v[i].x * v[i].x + v[i].y * v[i].y + v[i].z * v[i].z + v[i].w * v[i].w; }
        ss = red64(ss);
        const float rstd = rsqrtf(ss * (1.f / 2048.f) + 1e-6f);
#pragma unroll
        for (int i = 0; i < 8; ++i) { const int col = i * 256 + lane * 4;
            const float4 g4 = *(const float4*)(g + col), s4 = *(const float4*)(sc + col), h4 = *(const float4*)(sh + col);
            const float y0 = v[i].x * rstd * g4.x * (1.f + s4.x) + h4.x, y1 = v[i].y * rstd * g4.y * (1.f + s4.y) + h4.y;
            const float y2 = v[i].z * rstd * g4.z * (1.f + s4.z) + h4.z, y3 = v[i].w * rstd * g4.w * (1.f + s4.w) + h4.w;
            uint2 o; o.x = cvt_pk_bf16(y0, y1); o.y = cvt_pk_bf16(y2, y3);
            *(uint2*)(H + (size_t)row * 2048 + col) = o; }
    }
}
__device__ __forceinline__ void ph_final_norm(const Params& p) {
    const int tid_ = tid_fresh(); const int lane = tid_ & 63, w = tid_ >> 6;
    for (int row = blockIdx.x * 8 + w; row < MLAT; row += gridDim.x * 8) {
        float* src = p.out + (size_t)row * 2048;
        float4 v[8]; float ss = 0.f;
#pragma unroll
        for (int i = 0; i < 8; ++i) { v[i] = *(const float4*)(src + i * 256 + lane * 4); ss += v[i].x * v[i].x + v[i].y * v[i].y + v[i].z * v[i].z + v[i].w * v[i].w; }
        ss = red64(ss);
        const float rstd = rsqrtf(ss * (1.f / 2048.f) + 1e-6f);
#pragma unroll
        for (int i = 0; i < 8; ++i) { const int col = i * 256 + lane * 4; const float4 g4 = *(const float4*)(p.final_norm_g + col);
            float4 o; o.x = v[i].x * rstd * g4.x; o.y = v[i].y * rstd * g4.y; o.z = v[i].z * rstd * g4.z; o.w = v[i].w * rstd * g4.w;
            *(float4*)(src + col) = o; }
    }
}

__device__ __forceinline__ void ph_l0_prep(const Params& p, float* sm) {
    const int tid = tid_fresh();
    u16* PROJ = (u16*)(p.ws + WS_PROJ); u16* CQ = (u16*)(p.ws + WS_CQ); float* G = (float*)(p.ws + WS_G);
    for (int idx = blockIdx.x * NTHR + tid; idx < MTOT * 48; idx += gridDim.x * NTHR) {
        const int j = idx % 48; const float v = G[idx]; float o;
        if (j < 8) o = v + p.ml_ig_b[j];
        else if (j < 16) o = logsigmoidf_(v + p.ml_fg_b[j - 8]);
        else if (j < 32) { const float dt = softplusf_(v + p.dn_dt_bias[j - 16]); o = __expf(-__expf(p.dn_a_log[j - 16]) * dt); }
        else o = sigmoidf_(v);
        G[idx] = o;
    }
    for (int t = blockIdx.x; t < 520 * 24; t += gridDim.x) {
        const int tt = t / 24, part = t % 24;
        const bool isctx = tt < 8;
        const int t0 = isctx ? (tt & 3) * 64 : 0;
        const int rowbase = isctx ? (tt >> 2) * 256 + t0 : 512 + (tt - 8) * 64;
        __syncthreads();
        for (int ch = tid; ch < 68 * 16; ch += NTHR) {
            const int rr = ch >> 4, c8 = (ch & 15) * 8, r = rr - 2;
            const bool ok = isctx ? (t0 + r >= 0 && t0 + r < 256) : (r >= 0 && r < 64);
            float f[8];
#pragma unroll
            for (int j = 0; j < 8; ++j) f[j] = 0.f;
            if (ok) { const uint4 u = *(const uint4*)(PROJ + (size_t)(rowbase + r) * NP0 + 3072 + part * 128 + c8); unpack8(u, f); }
            float* d = sm + rr * 132 + c8;
            *(float4*)(d) = make_float4(f[0], f[1], f[2], f[3]); *(float4*)(d + 4) = make_float4(f[4], f[5], f[6], f[7]);
        }
        __syncthreads();
        const int tk = tid >> 3, cs = (tid & 7) * 16;
        float o[16];
#pragma unroll
        for (int c = 0; c < 16; ++c) o[c] = 0.f;
#pragma unroll
        for (int j = 0; j < 5; ++j) {
            const float* wr_ = p.dn_conv_w + j * 3072 + part * 128 + cs; const float* ir = sm + (tk + j) * 132 + cs;
#pragma unroll
            for (int c4 = 0; c4 < 4; ++c4) { const float4 w4 = *(const float4*)(wr_ + c4 * 4), i4 = *(const float4*)(ir + c4 * 4);
                o[c4 * 4 + 0] += i4.x * w4.x; o[c4 * 4 + 1] += i4.y * w4.y; o[c4 * 4 + 2] += i4.z * w4.z; o[c4 * 4 + 3] += i4.w * w4.w; }
        }
        float ss = 0.f;
#pragma unroll
        for (int c = 0; c < 16; ++c) { o[c] = siluf_(o[c]); ss += o[c] * o[c]; }
        ss = red8(ss);
        if (part < 16) { const float sc = rsqrtf(ss + 1e-6f);
#pragma unroll
            for (int c = 0; c < 16; ++c) o[c] *= sc; }
        u16* dst = isctx ? CQ + (size_t)(rowbase + tk) * 3072 + part * 128 + cs : PROJ + (size_t)(rowbase + tk) * NP0 + 3072 + part * 128 + cs;
        *(uint4*)(dst) = pack8(o); *(uint4*)(dst + 8) = pack8(o + 8);
    }
}

__device__ __forceinline__ int row_of(int i, int b, int dir) {
    if (i < 256) return b * 256 + (dir ? 255 - i : i);
    const int j = i - 256; return 512 + b * 16384 + (dir ? 16383 - j : j);
}
constexpr int NTOK = 16640, NGRP = 4160;

__device__ __forceinline__ void mlstm_tr(const Params& p, int job) {
    const int tid = tid_fresh(), cl = tid >> 4, sl = tid & 15;
    const int chain = job >> 3, cgp = job & 7;
    const int b = chain >> 3, h = (chain >> 1) & 3, dir = chain & 1;
    const int col = cgp * 32 + cl;
    const u16* PROJ = (const u16*)(p.ws + WS_PROJ); const float* G = (const float*)(p.ws + WS_G);
    u16* O = (u16*)(p.ws + (dir ? WS_OB : WS_OF));
    const int qoff = h * 128 + sl * 8, koff = 512 + h * 128 + sl * 8, voff = 1024 + h * 256 + col, gi = dir * 4 + h;
    float C[8], n[8]; float m = 0.f;
#pragma unroll
    for (int d = 0; d < 8; ++d) { C[d] = 0.f; n[d] = 0.f; }
    uint4 bq[3][4], bk[3][4]; u16 bv[3][4]; float big[3][4], blf[3][4];
#pragma unroll
    for (int s = 0; s < 3; ++s)
#pragma unroll
        for (int u = 0; u < 4; ++u) { const int row = row_of(s * 4 + u, b, dir); const u16* rp = PROJ + (size_t)row * NP0;
            bq[s][u] = *(const uint4*)(rp + qoff); bk[s][u] = *(const uint4*)(rp + koff); bv[s][u] = rp[voff]; big[s][u] = G[row * 48 + gi]; blf[s][u] = G[row * 48 + 8 + gi]; }
    for (int g0 = 0; g0 < NGRP + 2; g0 += 3) {
#pragma unroll
        for (int s = 0; s < 3; ++s) {
            const int g = g0 + s;
            if (g < NGRP) {
#pragma unroll
                for (int u = 0; u < 4; ++u) {
                    const int row = row_of(g * 4 + u, b, dir);
                    float q[8], k[8]; unpack8(bq[s][u], q); unpack8(bk[s][u], k);
                    const float v = bf2f(bv[s][u]), ig = big[s][u], lf = blf[s][u];
                    const float mn = fmaxf(lf + m, ig); const float a = __expf(lf + m - mn), sg = __expf(ig - mn); m = mn;
                    const float sv = sg * v; float num = 0.f, den = 0.f;
#pragma unroll
                    for (int d = 0; d < 8; ++d) { C[d] = a * C[d] + sv * k[d]; n[d] = a * n[d] + sg * k[d]; num += C[d] * q[d]; den += n[d] * q[d]; }
                    num = red16(num) * 0.08838834764831845f; den = red16(den) * 0.08838834764831845f;
                    const float hv = num / fmaxf(fabsf(den), __expf(-m));
                    if (sl == 0) O[(size_t)row * 2048 + h * 256 + col] = f2bf(hv);
                }
            }
            const int gn = g + 3;
#pragma unroll
            for (int u = 0; u < 4; ++u) { int i = gn * 4 + u; i = i < NTOK ? i : NTOK - 1; const int row = row_of(i, b, dir); const u16* rp = PROJ + (size_t)row * NP0;
                bq[s][u] = *(const uint4*)(rp + qoff); bk[s][u] = *(const uint4*)(rp + koff); bv[s][u] = rp[voff]; big[s][u] = G[row * 48 + gi]; blf[s][u] = G[row * 48 + 8 + gi]; }
        }
    }
}
__device__ __forceinline__ void deltanet_tr(const Params& p, int job) {
    const int tid = tid_fresh(), cl = tid >> 4, sl = tid & 15;
    const int chain = job >> 2, cgp = job & 3;
    const int b = chain >> 4, h = (chain >> 1) & 7, dir = chain & 1;
    const int col = cgp * 32 + cl;
    const u16* PROJ = (const u16*)(p.ws + WS_PROJ); const u16* CQ = (const u16*)(p.ws + WS_CQ); const float* G = (const float*)(p.ws + WS_G);
    u16* O = (u16*)(p.ws + (dir ? WS_OB : WS_OF));
    const int qoff = h * 128 + sl * 8, koff = 1024 + h * 128 + sl * 8, voff = 2048 + h * 128 + col, gi = dir * 8 + h;
    float S[8];
#pragma unroll
    for (int d = 0; d < 8; ++d) S[d] = 0.f;
    uint4 bq[3][4], bk[3][4]; u16 bv[3][4]; float beg[3][4], bbe[3][4];
#pragma unroll
    for (int s = 0; s < 3; ++s)
#pragma unroll
        for (int u = 0; u < 4; ++u) { const int i = s * 4 + u; const int row = row_of(i, b, dir); const u16* rp = (i < 256) ? CQ + (size_t)row * 3072 : PROJ + (size_t)row * NP0 + 3072;
            bq[s][u] = *(const uint4*)(rp + qoff); bk[s][u] = *(const uint4*)(rp + koff); bv[s][u] = rp[voff]; beg[s][u] = G[row * 48 + 16 + gi]; bbe[s][u] = G[row * 48 + 32 + gi]; }
    for (int g0 = 0; g0 < NGRP + 2; g0 += 3) {
#pragma unroll
        for (int s = 0; s < 3; ++s) {
            const int g = g0 + s;
            if (g < NGRP) {
#pragma unroll
                for (int u = 0; u < 4; ++u) {
                    const int row = row_of(g * 4 + u, b, dir);
                    float q[8], k[8]; unpack8(bq[s][u], q); unpack8(bk[s][u], k);
                    const float v = bf2f(bv[s][u]), eg = beg[s][u], be = bbe[s][u];
                    float sk = 0.f, sq = 0.f, qk = 0.f;
#pragma unroll
                    for (int d = 0; d < 8; ++d) { sk += S[d] * k[d]; sq += S[d] * q[d]; qk += q[d] * k[d]; }
                    sk = red16(sk); sq = red16(sq); qk = red16(qk);
                    const float vn = be * (v - eg * sk);
#pragma unroll
                    for (int d = 0; d < 8; ++d) S[d] = eg * S[d] + k[d] * vn;
                    const float ov = 0.08838834764831845f * (eg * sq + qk * vn);
                    if (sl == 0) O[(size_t)row * 2048 + 1024 + h * 128 + col] = f2bf(ov);
                }
            }
            const int gn = g + 3;
#pragma unroll
            for (int u = 0; u < 4; ++u) { int i = gn * 4 + u; i = i < NTOK ? i : NTOK - 1; const int row = row_of(i, b, dir); const u16* rp = (i < 256) ? CQ + (size_t)row * 3072 : PROJ + (size_t)row * NP0 + 3072;
                bq[s][u] = *(const uint4*)(rp + qoff); bk[s][u] = *(const uint4*)(rp + koff); bv[s][u] = rp[voff]; beg[s][u] = G[row * 48 + 16 + gi]; bbe[s][u] = G[row * 48 + 32 + gi]; }
        }
    }
}
__device__ __forceinline__ void ph_l0_merge(const Params& p) {
    const int tid_ = tid_fresh(); const int lane = tid_ & 63, w = tid_ >> 6;
    const u16* PROJ = (const u16*)(p.ws + WS_PROJ); const u16* OF = (const u16*)(p.ws + WS_OF); const u16* OB = (const u16*)(p.ws + WS_OB); u16* Y = (u16*)(p.ws + WS_H);
    for (int row = blockIdx.x * 8 + w; row < MTOT; row += gridDim.x * 8) {
        const int col = lane * 32; const bool isml = lane < 32;
        const u16* gsrc = PROJ + (size_t)row * NP0 + (isml ? 2048 + col : 6144 + (col - 1024));
        const float* gn = isml ? p.ml_norm_g + col : p.dn_norm_g + (col - 1024);
        float o[32]; float ss = 0.f;
#pragma unroll
        for (int i = 0; i < 4; ++i) { float a[8], bb[8]; unpack8(*(const uint4*)(OF + (size_t)row * 2048 + col + i * 8), a); unpack8(*(const uint4*)(OB + (size_t)row * 2048 + col + i * 8), bb);
#pragma unroll
            for (int j = 0; j < 8; ++j) { o[i * 8 + j] = a[j] + bb[j]; ss += o[i * 8 + j] * o[i * 8 + j]; } }
        ss = red4(ss); const float s8 = ss + dppf<0x141>(ss);
        const float rstd = isml ? rsqrtf(s8 * (1.f / 256.f) + 1e-6f) : rsqrtf(ss * (1.f / 128.f) + 1e-6f);
#pragma unroll
        for (int i = 0; i < 4; ++i) { float gt[8], r[8]; unpack8(*(const uint4*)(gsrc + i * 8), gt);
#pragma unroll
            for (int j = 0; j < 8; ++j) { const float gate = isml ? sigmoidf_(gt[j]) : siluf_(gt[j]); r[j] = o[i * 8 + j] * rstd * gn[i * 8 + j] * gate; }
            *(uint4*)(Y + (size_t)row * 2048 + col + i * 8) = pack8(r); }
    }
}

typedef short bf16x8_t __attribute__((ext_vector_type(8)));
typedef float f32x4_t __attribute__((ext_vector_type(4)));
constexpr int RG_A = 0, RG_BX = 32768, RG_XC = 65536, RG_WT = 82944;

__device__ __forceinline__ int rg_tau(int tt, int z) { if (tt < 8) { const int ci = tt & 3; return z ? 3 - ci : ci; } const int li = (tt - 8) & 255; return 4 + (z ? 255 - li : li); }
__device__ __forceinline__ int rg_batch(int tt) { return tt < 8 ? (tt >> 2) : ((tt - 8) >> 8); }

__device__ __forceinline__ void rg_conv(const Params& p, int tt, int g, unsigned char* lds) {
    const int tid = tid_fresh();
    const u16* PROJ = (const u16*)(p.ws + WS_PROJ);
    float* sm = (float*)lds; u16* XC = (u16*)(lds + RG_XC);
    const bool isctx = tt < 8;
    const int t0 = isctx ? (tt & 3) * 64 : 0;
    const int rowbase = isctx ? (tt >> 2) * 256 + t0 : 512 + (tt - 8) * 64;
    __syncthreads();
    for (int ch = tid; ch < 68 * 16; ch += NTHR) {
        const int rr = ch >> 4, c8 = (ch & 15) * 8, r = rr - 2;
        const bool ok = isctx ? (t0 + r >= 0 && t0 + r < 256) : (r >= 0 && r < 64);
        float f[8];
#pragma unroll
        for (int j = 0; j < 8; ++j) f[j] = 0.f;
        if (ok) { const uint4 u = *(const uint4*)(PROJ + (size_t)(rowbase + r) * NP1 + g * 128 + c8); unpack8(u, f); }
        float* d = sm + rr * 132 + c8;
        *(float4*)(d) = make_float4(f[0], f[1], f[2], f[3]); *(float4*)(d + 4) = make_float4(f[4], f[5], f[6], f[7]);
    }
    __syncthreads();
    const int tk = tid >> 3, cs = (tid & 7) * 16;
    float o[16];
#pragma unroll
    for (int c4 = 0; c4 < 4; ++c4) { const float4 b4 = *(const float4*)(p.rg_conv_b + g * 128 + cs + c4 * 4); o[c4 * 4] = b4.x; o[c4 * 4 + 1] = b4.y; o[c4 * 4 + 2] = b4.z; o[c4 * 4 + 3] = b4.w; }
#pragma unroll
    for (int j = 0; j < 5; ++j) {
        const float* wr_ = p.rg_conv_w + j * 1024 + g * 128 + cs; const float* ir = sm + (tk + j) * 132 + cs;
#pragma unroll
        for (int c4 = 0; c4 < 4; ++c4) { const float4 w4 = *(const float4*)(wr_ + c4 * 4), i4 = *(const float4*)(ir + c4 * 4);
            o[c4 * 4 + 0] += i4.x * w4.x; o[c4 * 4 + 1] += i4.y * w4.y; o[c4 * 4 + 2] += i4.z * w4.z; o[c4 * 4 + 3] += i4.w * w4.w; }
    }
    *(uint4*)(XC + tk * 136 + cs) = pack8(o); *(uint4*)(XC + tk * 136 + cs + 8) = pack8(o + 8);
    __syncthreads();
}
__device__ __forceinline__ void rg_load_w(const float* W, unsigned char* lds) {
    u16* WT = (u16*)(lds + RG_WT); const int tid = tid_fresh();
#pragma unroll 4
    for (int it = 0; it < 32; ++it) { const int idx = it * NTHR + tid, i = idx >> 7, j = idx & 127; WT[j * 136 + i] = f2bf(W[idx]); }
}
__device__ __forceinline__ void rg_mma(unsigned char* lds, int rt, int chh, int lane, f32x4_t (&acc)[4]) {
    const u16* XC = (const u16*)(lds + RG_XC); const u16* WT = (const u16*)(lds + RG_WT);
    const int fr = lane & 15, fq = lane >> 4;
#pragma unroll
    for (int ks = 0; ks < 4; ++ks) {
        const bf16x8_t a = *(const bf16x8_t*)(XC + (rt * 16 + fr) * 136 + ks * 32 + fq * 8);
#pragma unroll
        for (int c = 0; c < 4; ++c) { const bf16x8_t bb = *(const bf16x8_t*)(WT + ((chh * 4 + c) * 16 + fr) * 136 + ks * 32 + fq * 8);
            acc[c] = __builtin_amdgcn_mfma_f32_16x16x32_bf16(a, bb, acc[c], 0, 0, 0); }
    }
}
__device__ __forceinline__ void rg_gates(const Params& p, int g, int z, unsigned char* lds, float* bxdst, bool sync_before_bx) {
    const int tid = tid_fresh(), lane = tid & 63, w = tid >> 6, rt = w >> 1, chh = w & 1, fr = lane & 15, fq = lane >> 4;
    float* A = (float*)(lds + RG_A); const u16* XC = (const u16*)(lds + RG_XC);
    f32x4_t R[4], I[4];
#pragma unroll
    for (int c = 0; c < 4; ++c) { R[c] = (f32x4_t){0.f, 0.f, 0.f, 0.f}; I[c] = (f32x4_t){0.f, 0.f, 0.f, 0.f}; }
    rg_load_w(p.rg_w_r + (size_t)(z * 8 + g) * 16384, lds);
    __syncthreads();
    rg_mma(lds, rt, chh, lane, R);
    __syncthreads();
    rg_load_w(p.rg_w_i + (size_t)(z * 8 + g) * 16384, lds);
    __syncthreads();
    rg_mma(lds, rt, chh, lane, I);
    if (sync_before_bx) __syncthreads();
#pragma unroll
    for (int c = 0; c < 4; ++c) {
        const int chl = (chh * 4 + c) * 16 + fr, chg = z * 1024 + g * 128 + chl;
        const float br = p.rg_b_r[chg], bi = p.rg_b_i[chg], sp = softplusf_(-p.rg_lambda[chg]);
#pragma unroll
        for (int j = 0; j < 4; ++j) { const int t = rt * 16 + fq * 4 + j;
            const float r = sigmoidf_(R[c][j] + br), ii = sigmoidf_(I[c][j] + bi);
            const float la = -8.f * r * sp; const float a = __expf(la);
            const float bx = sqrtf(-expm1f(2.f * la)) * ii * bf2f(XC[t * 136 + chl]);
            A[t * 128 + chl] = a; bxdst[t * 128 + chl] = bx; }
    }
    __syncthreads();
}
__device__ __forceinline__ void ph_l1_a(const Params& p, unsigned char* lds) {
    const int tid = tid_fresh();
    float2* AGG = (float2*)(p.ws + WS_AGG);
    float* A = (float*)(lds + RG_A); float* BX = (float*)(lds + RG_BX);
    for (int t = blockIdx.x; t < 520 * 8; t += gridDim.x) {
        const int tt = t >> 3, g = t & 7, b = rg_batch(tt);
        rg_conv(p, tt, g, lds);
#pragma unroll 1
        for (int z = 0; z < 2; ++z) {
            rg_gates(p, g, z, lds, BX, false);
            if (tid < 128) { float h = 0.f, P = 1.f;
                for (int i = 0; i < 64; ++i) { const int tk = z ? 63 - i : i; const float a = A[tk * 128 + tid]; h = a * h + BX[tk * 128 + tid]; P *= a; }
                AGG[((size_t)(b * 2 + z) * NSEG + rg_tau(tt, z)) * 1024 + g * 128 + tid] = make_float2(P, h); }
            __syncthreads();
        }
    }
    const float* LR = (const float*)(p.ws + WS_G); u16* OM = (u16*)(p.ws + WS_OM);
    for (int it = blockIdx.x; it < (MTOT / 16) * 2; it += gridDim.x) {
        const int z = it & 1, r0 = (it >> 1) * 16;
        float wv[16];
#pragma unroll
        for (int r = 0; r < 16; ++r) wv[r] = p.gla_w_up[(z * 16 + r) * 512 + tid];
        const float bu = p.gla_b_up[z * 512 + tid];
        for (int rr = 0; rr < 16; ++rr) { const float* lr = LR + (size_t)(r0 + rr) * 32 + z * 16; float s = bu;
#pragma unroll
            for (int r = 0; r < 16; ++r) s += lr[r] * wv[r];
            const float lg = logsigmoidf_(s) * (1.f / 16.f);
            OM[((size_t)z * MTOT + r0 + rr) * 512 + tid] = f2bf(-expm1f(lg)); }
    }
}
__device__ __forceinline__ void rg_pass_b(const Params& p, int job) {
    const float2* AGG = (const float2*)(p.ws + WS_AGG); float* CARRY = (float*)(p.ws + WS_CARRY);
    const int bz = job >> 1, ch = (job & 1) * 512 + tid_fresh();
    float carry = 0.f;
#pragma unroll 4
    for (int tau = 0; tau < NSEG; ++tau) { const size_t ix = ((size_t)bz * NSEG + tau) * 1024 + ch; const float2 ph = AGG[ix]; CARRY[ix] = carry; carry = ph.x * carry + ph.y; }
}
__device__ __forceinline__ void gla_tr(const Params& p, int job) {
    const int tid = tid_fresh(), cl = tid >> 4, sl = tid & 15;
    const int chain = job >> 3, cgp = job & 7;
    const int b = chain >> 3, h = (chain >> 1) & 3, dir = chain & 1;
    const int col = cgp * 32 + cl;
    const u16* PROJ = (const u16*)(p.ws + WS_PROJ); const u16* OM = (const u16*)(p.ws + WS_OM) + (size_t)dir * MTOT * 512;
    u16* O = (u16*)(p.ws + (dir ? WS_OB1 : WS_OF1));
    const int qoff = 2048 + h * 128 + sl * 8, koff = 2560 + h * 128 + sl * 8, voff = 3072 + h * 256 + col, ooff = h * 128 + sl * 8;
    float S[8];
#pragma unroll
    for (int d = 0; d < 8; ++d) S[d] = 0.f;
    uint4 bq[3][4], bk[3][4], bo[3][4]; u16 bv[3][4];
#pragma unroll
    for (int s = 0; s < 3; ++s)
#pragma unroll
        for (int u = 0; u < 4; ++u) { const int row = row_of(s * 4 + u, b, dir); const u16* rp = PROJ + (size_t)row * NP1;
            bq[s][u] = *(const uint4*)(rp + qoff); bk[s][u] = *(const uint4*)(rp + koff); bv[s][u] = rp[voff]; bo[s][u] = *(const uint4*)(OM + (size_t)row * 512 + ooff); }
    for (int g0 = 0; g0 < NGRP + 2; g0 += 3) {
#pragma unroll
        for (int s = 0; s < 3; ++s) {
            const int g = g0 + s;
            if (g < NGRP) {
#pragma unroll
                for (int u = 0; u < 4; ++u) {
                    const int row = row_of(g * 4 + u, b, dir);
                    float q[8], k[8], om[8]; unpack8(bq[s][u], q); unpack8(bk[s][u], k); unpack8(bo[s][u], om);
                    const float v = bf2f(bv[s][u]); float acc = 0.f;
#pragma unroll
                    for (int d = 0; d < 8; ++d) { S[d] = (1.f - om[d]) * S[d] + k[d] * v; acc += S[d] * q[d]; }
                    acc = red16(acc) * 0.08838834764831845f;
                    if (sl == 0) O[(size_t)row * 1024 + h * 256 + col] = f2bf(acc);
                }
            }
            const int gn = g + 3;
#pragma unroll
            for (int u = 0; u < 4; ++u) { int i = gn * 4 + u; i = i < NTOK ? i : NTOK - 1; const int row = row_of(i, b, dir); const u16* rp = PROJ + (size_t)row * NP1;
                bq[s][u] = *(const uint4*)(rp + qoff); bk[s][u] = *(const uint4*)(rp + koff); bv[s][u] = rp[voff]; bo[s][u] = *(const uint4*)(OM + (size_t)row * 512 + ooff); }
        }
    }
}
__device__ __forceinline__ void ph_l1_c(const Params& p, unsigned char* lds) {
    const int tid = tid_fresh();
    const u16* PROJ = (const u16*)(p.ws + WS_PROJ); const float* CARRY = (const float*)(p.ws + WS_CARRY); u16* Y = (u16*)(p.ws + WS_H);
    float* A = (float*)(lds + RG_A); float* BX = (float*)(lds + RG_BX); float* BX2 = (float*)(lds + RG_WT);
    for (int t = blockIdx.x + 64; t < 520 * 8; t += gridDim.x) {
        const int tt = t >> 3, g = t & 7, b = rg_batch(tt);
        const int rowbase = 512 + (tt - 8) * 64;
        rg_conv(p, tt, g, lds);
        rg_gates(p, g, 0, lds, BX, false);
        if (tid < 128) { float h = CARRY[((size_t)(b * 2 + 0) * NSEG + rg_tau(tt, 0)) * 1024 + g * 128 + tid];
            for (int i = 0; i < 64; ++i) { h = A[i * 128 + tid] * h + BX[i * 128 + tid]; BX[i * 128 + tid] = h; } }
        __syncthreads();
        rg_gates(p, g, 1, lds, BX2, true);
        if (tid < 128) { float h = CARRY[((size_t)(b * 2 + 1) * NSEG + rg_tau(tt, 1)) * 1024 + g * 128 + tid];
            for (int i = 63; i >= 0; --i) { h = A[i * 128 + tid] * h + BX2[i * 128 + tid];
                const float gr = bf2f(PROJ[(size_t)(rowbase + i) * NP1 + 1024 + g * 128 + tid]);
                Y[(size_t)(rowbase + i) * 2048 + g * 128 + tid] = f2bf(gelu_tanh(gr) * (BX[i * 128 + tid] + h)); } }
        __syncthreads();
    }
    const int lane = tid & 63, w = tid >> 6;
    const u16* OF = (const u16*)(p.ws + WS_OF1); const u16* OB = (const u16*)(p.ws + WS_OB1);
    for (int row = 512 + blockIdx.x * 8 + w; row < MTOT; row += gridDim.x * 8) {
        const int col = lane * 16; float o[16]; float ss = 0.f;
#pragma unroll
        for (int i = 0; i < 2; ++i) { float a[8], bb[8]; unpack8(*(const uint4*)(OF + (size_t)row * 1024 + col + i * 8), a); unpack8(*(const uint4*)(OB + (size_t)row * 1024 + col + i * 8), bb);
#pragma unroll
            for (int j = 0; j < 8; ++j) { o[i * 8 + j] = a[j] + bb[j]; ss += o[i * 8 + j] * o[i * 8 + j]; } }
        ss = red16(ss);
        const float rstd = rsqrtf(ss * (1.f / 256.f) + 1e-6f);
#pragma unroll
        for (int i = 0; i < 2; ++i) { float gt[8], r[8]; unpack8(*(const uint4*)(PROJ + (size_t)row * NP1 + 4096 + col + i * 8), gt);
#pragma unroll
            for (int j = 0; j < 8; ++j) r[j] = o[i * 8 + j] * rstd * p.gla_norm_g[col + i * 8 + j] * siluf_(gt[j]);
            *(uint4*)(Y + (size_t)row * 2048 + 1024 + col + i * 8) = pack8(r); }
    }
}

constexpr int LDS_BYTES = 131072;

__global__ void __launch_bounds__(NTHR, 2) hybrid_fwd(Params p) {
    extern __shared__ __attribute__((aligned(16))) unsigned char lds[];
    cg::grid_group grid = cg::this_grid();
    float* smf = (float*)lds;
    PG8_LAS unsigned char* ldsg = (PG8_LAS unsigned char*)lds;
    unsigned char* ws = p.ws;
    u16* WT_IN = (u16*)(ws + WS_WT_IN); u16* WT_OUT = (u16*)(ws + WS_WT_OUT); u16* WT_GU = (u16*)(ws + WS_WT_GU); u16* WT_DN = (u16*)(ws + WS_WT_DN);
    u16* H = (u16*)(ws + WS_H); u16* PROJ = (u16*)(ws + WS_PROJ); float* XC = (float*)(ws + WS_XC); float* G = (float*)(ws + WS_G);
    const float* MOD = (const float*)(ws + WS_MOD);
    const int GD = (int)gridDim.x, bid = (int)blockIdx.x;

    ph_adaln_partials(p, smf);
    ph_convert<1>(p.ab_w_in, 7216, 2048, 7424, WT_IN, smf);
    ph_convert<0>(p.ab_w_out, 2048, 2048, 2048, WT_OUT, smf);
    ph_convert<2>(p.ffn_w_gu, 11264, 2048, 11264, WT_GU, smf);
    ph_convert<0>(p.ffn_w_down, 2048, 5632, 2048, WT_DN, smf);
    grid.sync();
    ph_adaln_reduce(p);
    grid.sync();

    ph_norm(p.ctx, p.x, p.norm_mix_g, MOD, 0, 1, H, 0);
    grid.sync();
    { pg8::Gemm g{H, WT_IN, MTOT, 7424, 2048}; pg8::StaticOrder S; S.init(MTOT, 7424, GD, bid);
      pg8::EpiProj E{PROJ, NP0, 28, G, NG0, NG0}; pg8::gemm_phase<pg8::EpiProj, pg8::StaticOrder>(ldsg, g, S, E); }
    grid.sync();
    ph_l0_prep(p, smf);
    grid.sync();
    for (int job = bid; job < 256; job += GD) { if (job < 128) mlstm_tr(p, job); else deltanet_tr(p, job - 128); }
    grid.sync();
    ph_l0_merge(p);
    grid.sync();
    { pg8::Gemm g{H, WT_OUT, MTOT, 2048, 2048}; pg8::StaticOrder S; S.init(MTOT, 2048, GD, bid);
      pg8::EpiRes E{p.ctx, p.x, XC, p.out, MOD + 2 * 2048, 0}; pg8::gemm_phase<pg8::EpiRes, pg8::StaticOrder>(ldsg, g, S, E); }
    grid.sync();
    ph_norm(XC, p.out, p.norm_ffn_g, MOD, 3, 4, H, 0);
    grid.sync();
    { pg8::Gemm g{H, WT_GU, MTOT, 11264, 2048}; pg8::StaticOrder S; S.init(MTOT, 11264, GD, bid);
      pg8::EpiSwiglu E{PROJ, FH}; pg8::gemm_phase<pg8::EpiSwiglu, pg8::StaticOrder>(ldsg, g, S, E); }
    grid.sync();
    { pg8::Gemm g{PROJ, WT_DN, MTOT, 2048, 5632}; pg8::StaticOrder S; S.init(MTOT, 2048, GD, bid);
      pg8::EpiRes E{XC, p.out, XC, p.out, MOD + 5 * 2048, 0}; pg8::gemm_phase<pg8::EpiRes, pg8::StaticOrder>(ldsg, g, S, E); }
    grid.sync();

    const float* MOD1 = MOD + 3 * 12288;
    ph_convert<0>(p.cd_w_in, 5152, 2048, 5376, WT_IN, smf);
    ph_convert<0>(p.cd_w_out, 2048, 2048, 2048, WT_OUT, smf);
    ph_convert<2>(p.ffn_w_gu + (size_t)2048 * 11264, 11264, 2048, 11264, WT_GU, smf);
    ph_convert<0>(p.ffn_w_down + (size_t)5632 * 2048, 2048, 5632, 2048, WT_DN, smf);
    ph_norm(XC, p.out, p.norm_mix_g + 2048, MOD1, 0, 1, H, 0);
    grid.sync();
    { pg8::Gemm g{H, WT_IN, MTOT, 5376, 2048}; pg8::StaticOrder S; S.init(MTOT, 5376, GD, bid);
      pg8::EpiProj E{PROJ, NP1, 20, G, NG1, NG1}; pg8::gemm_phase<pg8::EpiProj, pg8::StaticOrder>(ldsg, g, S, E); }
    grid.sync();
    ph_l1_a(p, lds);
    grid.sync();
    for (int job = bid; job < 136; job += GD) { if (job < 128) gla_tr(p, job); else rg_pass_b(p, job - 128); }
    grid.sync();
    ph_l1_c(p, lds);
    grid.sync();
    { pg8::Gemm g{H + (size_t)512 * 2048, WT_OUT, MLAT, 2048, 2048}; pg8::StaticOrder S; S.init(MLAT, 2048, GD, bid);
      pg8::EpiRes E{XC, p.out, XC, p.out, MOD1 + 2 * 2048, 512}; pg8::gemm_phase<pg8::EpiRes, pg8::StaticOrder>(ldsg, g, S, E); }
    grid.sync();
    ph_norm(XC, p.out, p.norm_ffn_g + 2048, MOD1, 3, 4, H, 512);
    grid.sync();
    { pg8::Gemm g{H + (size_t)512 * 2048, WT_GU, MLAT, 11264, 2048}; pg8::StaticOrder S; S.init(MLAT, 11264, GD, bid);
      pg8::EpiSwiglu E{PROJ, FH}; pg8::gemm_phase<pg8::EpiSwiglu, pg8::StaticOrder>(ldsg, g, S, E); }
    grid.sync();
    { pg8::Gemm g{PROJ, WT_DN, MLAT, 2048, 5632}; pg8::StaticOrder S; S.init(MLAT, 2048, GD, bid);
      pg8::EpiRes E{XC, p.out, XC, p.out, MOD1 + 5 * 2048, 512}; pg8::gemm_phase<pg8::EpiRes, pg8::StaticOrder>(ldsg, g, S, E); }
    grid.sync();
    ph_final_norm(p);
}

extern "C" void kernel_launch(void* const* d_in, const int* in_sizes, int n_in, void* d_out, int out_size, void* d_ws, size_t ws_size, hipStream_t stream) {
    static int grid = 0;
    if (grid == 0) {
        if (n_in != 32 || out_size != MLAT * DM || ws_size < WS_END) { fprintf(stderr, "kernel_launch: unexpected shapes (n_in %d out %d ws %zu need %zu)\n", n_in, out_size, ws_size, (size_t)WS_END); grid = -1; return; }
        int dev = 0, cus = 0, per_cu = 0;
        (void)hipGetDevice(&dev);
        (void)hipDeviceGetAttribute(&cus, hipDeviceAttributeMultiprocessorCount, dev);
        if (hipFuncSetAttribute((const void*)hybrid_fwd, hipFuncAttributeMaxDynamicSharedMemorySize, LDS_BYTES) != hipSuccess) { fprintf(stderr, "kernel_launch: hipFuncSetAttribute failed\n"); }
        if (hipOccupancyMaxActiveBlocksPerMultiprocessor(&per_cu, (const void*)hybrid_fwd, NTHR, LDS_BYTES) != hipSuccess || per_cu < 1) { fprintf(stderr, "kernel_launch: occupancy query gave %d\n", per_cu); per_cu = 1; }
        (void)hipGetLastError();
        grid = cus * per_cu;
    }
    if (grid < 0) return;
    Params p{};
    const float** pp = (const float**)&p;
    for (int i = 0; i < 32; ++i) pp[i] = (const float*)d_in[i];
    p.out = (float*)d_out; p.ws = (unsigned char*)d_ws;
    void* args[] = {&p};
    hipError_t e = hipLaunchCooperativeKernel((const void*)hybrid_fwd, dim3(grid), dim3(NTHR), args, LDS_BYTES, stream);
    if (e != hipSuccess) fprintf(stderr, "cooperative launch failed: %s (grid %d)\n", hipGetErrorString(e), grid);
}
```

```cpp
#include <hip/hip_runtime.h>
#include <hip/hip_cooperative_groups.h>
#include <cstdio>
namespace cg = cooperative_groups;

typedef unsigned short u16;

constexpr int DM = 2048, FH = 5632, MC = 512, MLAT = 32768, MTOT = 33280, NTHR = 512;
constexpr int NP0 = 7168, NP1 = 5120;
constexpr int NG0 = 48, NG1 = 32;
constexpr int NSEG = 260;

constexpr size_t WS_WT_IN = 0;
constexpr size_t WS_WT_OUT = WS_WT_IN + (size_t)7424 * 2048 * 2;
constexpr size_t WS_WT_GU = WS_WT_OUT + (size_t)2048 * 2048 * 2;
constexpr size_t WS_WT_DN = WS_WT_GU + (size_t)11264 * 2048 * 2;
constexpr size_t WS_H = WS_WT_DN + (size_t)2048 * 5632 * 2;
constexpr size_t WS_PROJ = WS_H + (size_t)MTOT * 2048 * 2;
constexpr size_t WS_OF = WS_PROJ + (size_t)MTOT * 7168 * 2;
constexpr size_t WS_OB = WS_OF + (size_t)MTOT * 2048 * 2;
constexpr size_t WS_XC = WS_OB + (size_t)MTOT * 2048 * 2;
constexpr size_t WS_G = WS_XC + (size_t)MC * 2048 * 4;
constexpr size_t WS_CQ = WS_G + (size_t)MTOT * 48 * 4;
constexpr size_t WS_MODP = WS_CQ + (size_t)MC * 3072 * 2;
constexpr size_t WS_MOD = WS_MODP + (size_t)2 * 32 * 3 * 12288 * 4;
constexpr size_t WS_END = WS_MOD + (size_t)2 * 3 * 12288 * 4;
constexpr size_t WS_OF1 = WS_OF;
constexpr size_t WS_OB1 = WS_OF + (size_t)MTOT * 1024 * 2;
constexpr size_t WS_QE = WS_OB;
constexpr size_t WS_KDT = WS_QE + (size_t)2 * MTOT * 512 * 2;
constexpr size_t WS_TAIL = WS_PROJ + (size_t)MTOT * 5120 * 2;
constexpr size_t WS_ATT = WS_TAIL;
constexpr size_t WS_VT = WS_ATT + (size_t)4160 * 4096 * 2;
constexpr size_t WS_EBL = WS_VT + (size_t)2080 * 16384 * 2;
constexpr size_t WS_AGG = WS_EBL + (size_t)4160 * 128 * 4;
constexpr size_t WS_CARRY = WS_AGG + (size_t)4 * NSEG * 1024 * 8;
static_assert(WS_CARRY + (size_t)4 * NSEG * 1024 * 4 <= WS_OF, "layer-1 tail overflow");

struct Params {
    const float *x, *c, *ctx, *c_ctx, *mod_w, *mod_b, *norm_mix_g, *norm_ffn_g, *ffn_w_gu, *ffn_w_down, *final_norm_g,
        *ab_w_in, *ab_w_out, *ml_ig_b, *ml_fg_b, *ml_norm_g, *dn_conv_w, *dn_a_log, *dn_dt_bias, *dn_norm_g,
        *cd_w_in, *cd_w_out, *rg_conv_w, *rg_conv_b, *rg_w_r, *rg_b_r, *rg_w_i, *rg_b_i, *rg_lambda, *gla_w_up, *gla_b_up, *gla_norm_g;
    float* out; unsigned char* ws;
};

__device__ __forceinline__ float bf2f(u16 v) { return __uint_as_float(((unsigned)v) << 16); }
typedef __bf16 bf16x2_nat __attribute__((ext_vector_type(2)));
typedef float f32x2_nat __attribute__((ext_vector_type(2)));
__device__ __forceinline__ unsigned cvt_pk_bf16(float lo, float hi) { const f32x2_nat v = {lo, hi}; const bf16x2_nat r = __builtin_convertvector(v, bf16x2_nat); return __builtin_bit_cast(unsigned, r); }
__device__ __forceinline__ u16 f2bf(float f) { return (u16)(cvt_pk_bf16(f, 0.f) & 0xffffu); }
__device__ __forceinline__ void unpack8(const uint4& u, float* f) {
    f[0] = __uint_as_float(u.x << 16); f[1] = __uint_as_float(u.x & 0xffff0000u);
    f[2] = __uint_as_float(u.y << 16); f[3] = __uint_as_float(u.y & 0xffff0000u);
    f[4] = __uint_as_float(u.z << 16); f[5] = __uint_as_float(u.z & 0xffff0000u);
    f[6] = __uint_as_float(u.w << 16); f[7] = __uint_as_float(u.w & 0xffff0000u);
}
__device__ __forceinline__ uint4 pack8(const float* f) { uint4 o; o.x = cvt_pk_bf16(f[0], f[1]); o.y = cvt_pk_bf16(f[2], f[3]); o.z = cvt_pk_bf16(f[4], f[5]); o.w = cvt_pk_bf16(f[6], f[7]); return o; }
template <int CTRL> __device__ __forceinline__ float dppf(float x) { return __int_as_float(__builtin_amdgcn_update_dpp(0, __float_as_int(x), CTRL, 0xF, 0xF, true)); }
__device__ __forceinline__ float red4(float x) { x += dppf<0xB1>(x); x += dppf<0x4E>(x); return x; }
__device__ __forceinline__ float red8(float x) { x = red4(x); x += dppf<0x141>(x); return x; }
__device__ __forceinline__ float red16(float x) { x = red8(x); x += dppf<0x140>(x); return x; }
__device__ __forceinline__ float red64(float x) { x = red16(x); x += __shfl_xor(x, 16); x += __shfl_xor(x, 32); return x; }
__device__ __forceinline__ float sigmoidf_(float x) { return 1.f / (1.f + __expf(-x)); }
__device__ __forceinline__ float siluf_(float x) { return x / (1.f + __expf(-x)); }
__device__ __forceinline__ float softplusf_(float x) { return fmaxf(x, 0.f) + log1pf(__expf(-fabsf(x))); }
__device__ __forceinline__ float logsigmoidf_(float x) { return fminf(x, 0.f) - log1pf(__expf(-fabsf(x))); }
__device__ __forceinline__ float gelu_tanh(float x) { const float u = 0.7978845608028654f * (x + 0.044715f * x * x * x); const float th = 1.f - 2.f / (1.f + __expf(2.f * u)); return 0.5f * x * (1.f + th); }

__device__ __forceinline__ int tid_fresh() { int t = threadIdx.x; asm volatile("" : "+v"(t)); return t; }
namespace pg8 {
#define PG8_LAS __attribute__((address_space(3)))
typedef unsigned short bf16_t;
typedef short bf16x8 __attribute__((ext_vector_type(8)));
typedef float f32x4 __attribute__((ext_vector_type(4)));
typedef unsigned u32x4 __attribute__((ext_vector_type(4)));
constexpr int BM = 256, BK = 64, HALF = 128, HTB = HALF * BK * 2  , STAGE_BYTES = 8 * HTB, NXCD = 8, WGM = 8;

__host__ __device__ __forceinline__ int lds_byte(int r, int c) { const int st = (r >> 4) * 2 + (c >> 5), rr = r & 15, cc = c & 31, ob = rr * 64 + cc * 2; return st * 1024 + (ob ^ (((ob >> 9) & 1) << 5)); }
__host__ __device__ __forceinline__ void stage_rc(int b, int& R, int& C) { const int st = b / 1024, sb = b % 1024, swz = sb ^ (((sb >> 9) & 1) << 5); R = (st >> 1) * 16 + swz / 64; C = (st & 1) * 32 + (swz % 64) / 2; }
__host__ __device__ __forceinline__ int perm32(int rho) { const int n = rho >> 4, i = rho & 15; return 8 * (i >> 2) + 4 * n + (i & 3); }

struct Unit { int pm, pn; };
struct Gemm { const bf16_t* A; const bf16_t* Bt; int M, N, K; };

struct StaticOrder {
    int nM, nN, nwg, G, c;
    __host__ __device__ void init(int M, int N, int G_, int c_) { nM = M / BM; nN = N / BM; nwg = nM * nN; G = G_; c = c_; }
    __host__ __device__ bool next(int i, Unit& u) const {
        const long L = (long)i * G + c; if (L >= nwg) return false;
        int wgid = (int)L; { const int q = nwg / NXCD, r = nwg % NXCD, xcd = wgid % NXCD, off = wgid / NXCD; wgid = (xcd < r ? xcd * (q + 1) : r * (q + 1) + (xcd - r) * q) + off; }
        const int nig = WGM * nN, gid = wgid / nig, fm = gid * WGM, gsz = (nM - fm) < WGM ? (nM - fm) : WGM;
        u.pm = fm + ((wgid % nig) % gsz); u.pn = (wgid % nig) / gsz; return true;
    }
    __device__ __forceinline__ void a_ready(const Unit&) const {}
    __device__ __forceinline__ void done(const Unit&) const {}
};
using ::cvt_pk_bf16;
typedef float f32x2 __attribute__((ext_vector_type(2)));

struct EpiProj {
    static constexpr bool PERM = true, AFTER_DRAIN = false;
    bf16_t* P; int ldp; int n_main; float* G; int ldg; int ng;
    __device__ __forceinline__ void operator()(const f32x4 (&acc)[2][2][4][2], const Unit& u, int wr, int wc, int fr, int fq) const {
        const int row0 = u.pm * BM + wr * 64 + fr;
        if (u.pn < n_main) {
            const int col0 = u.pn * BM + wc * 32 + 8 * fq;
#pragma unroll
            for (int ai = 0; ai < 2; ++ai)
#pragma unroll
                for (int m = 0; m < 4; ++m) { bf16_t* rowp = P + (size_t)(row0 + ai * HALF + m * 16) * ldp + col0;
#pragma unroll
                    for (int bj = 0; bj < 2; ++bj) { const f32x4 v0 = acc[ai][bj][m][0], v1 = acc[ai][bj][m][1];
                        u32x4 w; w.x = cvt_pk_bf16(v0[0], v0[1]); w.y = cvt_pk_bf16(v0[2], v0[3]); w.z = cvt_pk_bf16(v1[0], v1[1]); w.w = cvt_pk_bf16(v1[2], v1[3]);
                        *(u32x4*)(rowp + bj * HALF) = w; } }
        } else {
            const int c0 = wc * 32 + 8 * fq;
#pragma unroll
            for (int ai = 0; ai < 2; ++ai)
#pragma unroll
                for (int m = 0; m < 4; ++m) { float* rowp = G + (size_t)(row0 + ai * HALF + m * 16) * ldg;
#pragma unroll
                    for (int n = 0; n < 2; ++n)
#pragma unroll
                        for (int j = 0; j < 4; ++j) { const int c = c0 + 4 * n + j; if (c < ng) rowp[c] = acc[ai][0][m][n][j]; } }
        }
    }
};
struct EpiRes {
    static constexpr bool PERM = false, AFTER_DRAIN = false;
    const float* srcC; const float* srcL; float* dstC; float* dstL; const float* gate  ; int row_off;
    __device__ __forceinline__ void operator()(const f32x4 (&acc)[2][2][4][2], const Unit& u, int wr, int wc, int fr, int fq) const {
        const int grow_t = u.pm * BM + row_off;
        const bool isc = grow_t < 512;
        const int mr = isc ? 2 : ((grow_t - 512) >> 14);
        const float* sp = isc ? srcC + (size_t)grow_t * 2048 : srcL + (size_t)(grow_t - 512) * 2048;
        float* dp = isc ? dstC + (size_t)grow_t * 2048 : dstL + (size_t)(grow_t - 512) * 2048;
        const int lrow0 = wr * 64 + fr, col0 = u.pn * BM + wc * 32 + 4 * fq;
        const float* gp = gate + (size_t)mr * 12288 + col0;
        f32x4 gv[2][2];
#pragma unroll
        for (int bj = 0; bj < 2; ++bj)
#pragma unroll
            for (int n = 0; n < 2; ++n) gv[bj][n] = *(const f32x4*)(gp + bj * HALF + n * 16);
#pragma unroll
        for (int ai = 0; ai < 2; ++ai)
#pragma unroll
            for (int m = 0; m < 4; ++m) { const size_t off = (size_t)(lrow0 + ai * HALF + m * 16) * 2048 + col0;
#pragma unroll
                for (int bj = 0; bj < 2; ++bj)
#pragma unroll
                    for (int n = 0; n < 2; ++n) { const f32x4 s = *(const f32x4*)(sp + off + bj * HALF + n * 16);
                        *(f32x4*)(dp + off + bj * HALF + n * 16) = s + gv[bj][n] * acc[ai][bj][m][n]; } }
    }
};
struct EpiSwiglu {
    static constexpr bool PERM = true, AFTER_DRAIN = false;
    bf16_t* O; int ldo;
    __device__ __forceinline__ void operator()(const f32x4 (&acc)[2][2][4][2], const Unit& u, int wr, int wc, int fr, int fq) const {
        const int row0 = u.pm * BM + wr * 64 + fr, col0 = u.pn * HALF + wc * 32 + 8 * fq;
#pragma unroll
        for (int ai = 0; ai < 2; ++ai)
#pragma unroll
            for (int m = 0; m < 4; ++m) { float r[8];
#pragma unroll
                for (int n = 0; n < 2; ++n)
#pragma unroll
                    for (int j = 0; j < 4; ++j) { const float gg = acc[ai][0][m][n][j], uu = acc[ai][1][m][n][j]; r[n * 4 + j] = gg / (1.f + __expf(-gg)) * uu; }
                u32x4 w; w.x = cvt_pk_bf16(r[0], r[1]); w.y = cvt_pk_bf16(r[2], r[3]); w.z = cvt_pk_bf16(r[4], r[5]); w.w = cvt_pk_bf16(r[6], r[7]);
                *(u32x4*)(O + (size_t)(row0 + ai * HALF + m * 16) * ldo + col0) = w; }
    }
};

template <class Epi, class Sched>
__device__ __forceinline__ void gemm_phase(PG8_LAS unsigned char* lds, const Gemm g, const Sched& S, const Epi& E) {
    int tid = threadIdx.x; asm volatile("" : "+v"(tid)); const int wid = __builtin_amdgcn_readfirstlane(tid >> 6), lane = tid & 63, wr = wid >> 2, wc = wid & 3, fr = lane & 15, fq = lane >> 4;
    const int K = g.K, nt = K / BK;
    unsigned voffA[2], voffB[2];
#pragma unroll
    for (int i = 0; i < 2; ++i) { int R, C; stage_rc(tid * 16 + i * 8192, R, C); const int Rb = Epi::PERM ? ((R & ~31) + perm32(R & 31)) : R;
        voffA[i] = (unsigned)(R * K + C) * 2u; voffB[i] = (unsigned)(Rb * K + C) * 2u; }
    const size_t kstep = (size_t)(BK * 2);
    const size_t hstep = (size_t)HALF * K * 2;
    const size_t tstep = 2 * hstep;
    const unsigned ldsw = (unsigned)wid * 1024u;
    const int aoff = lds_byte(wr * 64 + fr, fq * 8), boff = lds_byte(wc * 32 + fr, fq * 8);
#define PG8_SA(b, h) (((b) * 2 + (h)) * HTB)
#define PG8_SB(b, h) ((4 + (b) * 2 + (h)) * HTB)
#define PG8_STAGE(bufoff, gbase, voff) do { _Pragma("unroll") for (int _i = 0; _i < 2; ++_i) \
        __builtin_amdgcn_global_load_lds((const unsigned*)((const char*)(gbase) + (voff)[_i]), (PG8_LAS unsigned*)(lds + (bufoff) + ldsw + _i * 8192), 16, 0, 0); } while (0)
#define PG8_LDA(dst, b, h) do { _Pragma("unroll") for (int m = 0; m < 4; ++m) _Pragma("unroll") for (int k = 0; k < 2; ++k) dst[m][k] = *(const PG8_LAS bf16x8*)(lds + PG8_SA(b, h) + aoff + m * 2048 + k * 1024); } while (0)
#define PG8_LDB(dst, b, h) do { _Pragma("unroll") for (int n = 0; n < 2; ++n) _Pragma("unroll") for (int k = 0; k < 2; ++k) dst[n][k] = *(const PG8_LAS bf16x8*)(lds + PG8_SB(b, h) + boff + n * 2048 + k * 1024); } while (0)
#define PG8_MMA(ai, bj, At, Bt) do { __builtin_amdgcn_s_setprio(1); _Pragma("unroll") for (int m = 0; m < 4; ++m) _Pragma("unroll") for (int n = 0; n < 2; ++n) _Pragma("unroll") for (int k = 0; k < 2; ++k) \
        acc[ai][bj][m][n] = __builtin_amdgcn_mfma_f32_16x16x32_bf16(Bt[n][k], At[m][k], acc[ai][bj][m][n], 0, 0, 0); __builtin_amdgcn_s_setprio(0); } while (0)
#define PG8_WAIT_V(n) asm volatile("s_waitcnt vmcnt(" #n ")" ::: "memory")
#define PG8_WAIT_L(n) asm volatile("s_waitcnt lgkmcnt(" #n ")" ::: "memory")
#define PG8_BAR __builtin_amdgcn_s_barrier()
#define PG8_SCHED __builtin_amdgcn_sched_barrier(0)
    Unit cur, nxt; int ui = 0;
    if (!S.next(0, cur)) return;
    f32x4 acc[2][2][4][2];
#pragma unroll
    for (int a = 0; a < 2; ++a)
#pragma unroll
        for (int b = 0; b < 2; ++b)
#pragma unroll
            for (int m = 0; m < 4; ++m)
#pragma unroll
                for (int n = 0; n < 2; ++n) acc[a][b][m][n] = (f32x4){0.f, 0.f, 0.f, 0.f};
    bf16x8 At[4][2], B0[2][2], B1[2][2];
    const char* cA = (const char*)g.A + (size_t)cur.pm * tstep; const char* cB = (const char*)g.Bt + (size_t)cur.pn * tstep;
    S.a_ready(cur);
    PG8_STAGE(PG8_SB(0, 0), cB, voffB); PG8_STAGE(PG8_SA(0, 0), cA, voffA); PG8_STAGE(PG8_SB(0, 1), cB + hstep, voffB); PG8_STAGE(PG8_SA(0, 1), cA + hstep, voffA);
    if (wr == 1) PG8_BAR;
    PG8_WAIT_V(4); PG8_BAR;
    PG8_STAGE(PG8_SB(1, 0), cB + kstep, voffB); PG8_STAGE(PG8_SA(1, 0), cA + kstep, voffA); PG8_STAGE(PG8_SB(1, 1), cB + hstep + kstep, voffB);
    PG8_WAIT_V(6); PG8_BAR;
    for (;;) {
        const bool has_next = S.next(ui + 1, nxt);
        const char* nA = has_next ? (const char*)g.A + (size_t)nxt.pm * tstep : cA; const char* nB = has_next ? (const char*)g.Bt + (size_t)nxt.pn * tstep : cB;
        for (int t = 0; t < nt; t += 2) {
            const bool last = (t == nt - 2);
            const char* a1 = cA + (size_t)(t + 1) * kstep;
            const char* a2 = last ? nA : cA + (size_t)(t + 2) * kstep; const char* b2 = last ? nB : cB + (size_t)(t + 2) * kstep;
            const char* a3 = a2 + kstep; const char* b3 = b2 + kstep;
            if (last && has_next) S.a_ready(nxt);
            PG8_LDB(B0, 0, 0); PG8_SCHED; PG8_LDA(At, 0, 0); PG8_STAGE(PG8_SA(1, 1), a1 + hstep, voffA);
            PG8_WAIT_L(8); PG8_BAR; PG8_WAIT_L(0); PG8_MMA(0, 0, At, B0); PG8_BAR; PG8_SCHED;
            PG8_LDB(B1, 0, 1); PG8_STAGE(PG8_SB(0, 0), b2, voffB);
            PG8_BAR; PG8_WAIT_L(0); PG8_MMA(0, 1, At, B1); PG8_BAR;
            PG8_LDA(At, 0, 1); PG8_STAGE(PG8_SA(0, 0), a2, voffA);
            PG8_BAR; PG8_WAIT_L(0); PG8_MMA(1, 0, At, B0); PG8_BAR; PG8_SCHED;
            PG8_STAGE(PG8_SB(0, 1), b2 + hstep, voffB);
            PG8_WAIT_V(6); PG8_BAR; PG8_MMA(1, 1, At, B1); PG8_BAR;
            PG8_LDB(B0, 1, 0); PG8_SCHED; PG8_LDA(At, 1, 0); PG8_STAGE(PG8_SA(0, 1), a2 + hstep, voffA);
            PG8_WAIT_L(8); PG8_BAR; PG8_WAIT_L(0); PG8_MMA(0, 0, At, B0); PG8_BAR; PG8_SCHED;
            PG8_LDB(B1, 1, 1); PG8_STAGE(PG8_SB(1, 0), b3, voffB);
            PG8_BAR; PG8_WAIT_L(0); PG8_MMA(0, 1, At, B1); PG8_BAR;
            PG8_LDA(At, 1, 1); PG8_STAGE(PG8_SA(1, 0), a3, voffA);
            PG8_BAR; PG8_WAIT_L(0); PG8_MMA(1, 0, At, B0); PG8_BAR; PG8_SCHED;
            PG8_STAGE(PG8_SB(1, 1), b3 + hstep, voffB);
            PG8_WAIT_V(6); PG8_BAR; PG8_MMA(1, 1, At, B1); PG8_BAR;
        }
        if constexpr (!Epi::AFTER_DRAIN) { E(acc, cur, wr, wc, fr, fq); S.done(cur); }
        if (!has_next) break;
#pragma unroll
        for (int a = 0; a < 2; ++a)
#pragma unroll
            for (int b = 0; b < 2; ++b)
#pragma unroll
                for (int m = 0; m < 4; ++m)
#pragma unroll
                    for (int n = 0; n < 2; ++n) acc[a][b][m][n] = (f32x4){0.f, 0.f, 0.f, 0.f};
        cur = nxt; cA = nA; cB = nB; ++ui;
    }
    PG8_WAIT_V(0);
    if (wr == 0) PG8_BAR;
    PG8_BAR;
    if constexpr (Epi::AFTER_DRAIN) { E.fused(acc, cur, wr, wc, fr, fq, lds, wid, lane); S.done(cur); }
#undef PG8_SA
#undef PG8_SB
#undef PG8_STAGE
#undef PG8_LDA
#undef PG8_LDB
#undef PG8_MMA
#undef PG8_WAIT_V
#undef PG8_WAIT_L
#undef PG8_BAR
#undef PG8_SCHED
}
}

__device__ __forceinline__ void ph_adaln_partials(const Params& p, float* sm) {
    const int tid = tid_fresh();
    float* MODP = (float*)(p.ws + WS_MODP);
    for (int it = blockIdx.x; it < 384; it += gridDim.x) {
        const int l = it / 192, rem = it % 192, kc = rem / 6, cgp = rem % 6;
        __syncthreads();
        if (tid < 192) { const int r = tid >> 6, kk = tid & 63, k = kc * 64 + kk; const float cv = (r < 2) ? p.c[r * 2048 + k] : p.c_ctx[k]; sm[tid] = siluf_(cv); }
        __syncthreads();
        const int col = cgp * 2048 + tid * 4;
        float4 a0 = {0.f, 0.f, 0.f, 0.f}, a1 = a0, a2 = a0;
        const float* wp = p.mod_w + ((size_t)l * 2048 + (size_t)kc * 64) * 12288 + col;
#pragma unroll 8
        for (int kk = 0; kk < 64; ++kk) {
            const float4 w = *(const float4*)(wp + (size_t)kk * 12288);
            const float s0 = sm[kk], s1 = sm[64 + kk], s2 = sm[128 + kk];
            a0.x += s0 * w.x; a0.y += s0 * w.y; a0.z += s0 * w.z; a0.w += s0 * w.w;
            a1.x += s1 * w.x; a1.y += s1 * w.y; a1.z += s1 * w.z; a1.w += s1 * w.w;
            a2.x += s2 * w.x; a2.y += s2 * w.y; a2.z += s2 * w.z; a2.w += s2 * w.w;
        }
        float* o = MODP + ((size_t)(l * 32 + kc) * 3) * 12288 + col;
        *(float4*)(o) = a0; *(float4*)(o + 12288) = a1; *(float4*)(o + 2 * 12288) = a2;
    }
}
__device__ __forceinline__ void ph_adaln_reduce(const Params& p) {
    const float* MODP = (const float*)(p.ws + WS_MODP); float* MOD = (float*)(p.ws + WS_MOD);
    for (int idx = blockIdx.x * NTHR + tid_fresh(); idx < 2 * 3 * 12288; idx += gridDim.x * NTHR) {
        const int l = idx / 36864, r = (idx / 12288) % 3, col = idx % 12288;
        float s = p.mod_b[l * 12288 + col];
        for (int kc = 0; kc < 32; ++kc) s += MODP[((size_t)(l * 32 + kc) * 3 + r) * 12288 + col];
        MOD[idx] = s;
    }
}

template <int MODE> __device__ __forceinline__ int colmap(int n, int nsrc) {
    if (MODE == 0) return n < nsrc ? n : -1;
    if (MODE == 1) { if (n < 3072) return n; if (n < 7168) return n + 16; if (n < 7184) return 3072 + (n - 7168); if (n < 7216) return n; return -1; }
    return ((n >> 7) & 1) * 5632 + (n >> 8) * 128 + (n & 127);
}
template <int MODE> __device__ __forceinline__ void ph_convert(const float* W, int nsrc, int K, int nout, u16* Bt, float* sm) {
    const int tid = tid_fresh(); const int nnt = nout / 64, ntiles = nnt * (K / 64);
    for (int t = blockIdx.x; t < ntiles; t += gridDim.x) {
        const int k0 = (t / nnt) * 64, n0 = (t % nnt) * 64;
        __syncthreads();
#pragma unroll
        for (int i = 0; i < 8; ++i) { const int idx = i * NTHR + tid, kk = idx >> 6, nn = idx & 63; const int src = colmap<MODE>(n0 + nn, nsrc);
            sm[kk * 65 + nn] = src >= 0 ? W[(size_t)(k0 + kk) * nsrc + src] : 0.f; }
        __syncthreads();
        { const int nn = tid >> 3, k8 = (tid & 7) * 8; float v[8];
#pragma unroll
            for (int j = 0; j < 8; ++j) v[j] = sm[(k8 + j) * 65 + nn];
            *(uint4*)(Bt + (size_t)(n0 + nn) * K + k0 + k8) = pack8(v); }
    }
}

__device__ __forceinline__ void ph_norm(const float* srcC, const float* srcL, const float* g, const float* modl, int chunk_sh, int chunk_sc, u16* H, int row_begin) {
    const int tid_ = tid_fresh(); const int lane = tid_ & 63, w = tid_ >> 6;
    for (int row = row_begin + blockIdx.x * 8 + w; row < MTOT; row += gridDim.x * 8) {
        const float* src = row < 512 ? srcC + (size_t)row * 2048 : srcL + (size_t)(row - 512) * 2048;
        const int mr = row < 512 ? 2 : ((row - 512) >> 14);
        const float* sc = modl + (mr * 6 + chunk_sc) * 2048; const float* sh = modl + (mr * 6 + chunk_sh) * 2048;
        float4 v[8]; float ss = 0.f;
#pragma unroll
        for (int i = 0; i < 8; ++i) { v[i] = *(const float4*)(src + i * 256 + lane * 4); ss += v[i].x * v[i].x + v[i].y * v[i].y + v[i].z * v[i].z + v[i].w * v[i].w; }
        ss = red64(ss);
        const float rstd = rsqrtf(ss * (1.f / 2048.f) + 1e-6f);
#pragma unroll
        for (int i = 0; i < 8; ++i) { const int col = i * 256 + lane * 4;
            const float4 g4 = *(const float4*)(g + col), s4 = *(const float4*)(sc + col), h4 = *(const float4*)(sh + col);
            const float y0 = v[i].x * rstd * g4.x * (1.f + s4.x) + h4.x, y1 = v[i].y * rstd * g4.y * (1.f + s4.y) + h4.y;
            const float y2 = v[i].z * rstd * g4.z * (1.f + s4.z) + h4.z, y3 = v[i].w * rstd * g4.w * (1.f + s4.w) + h4.w;
            uint2 o; o.x = cvt_pk_bf16(y0, y1); o.y = cvt_pk_bf16(y2, y3);
            *(uint2*)(H + (size_t)row * 2048 + col) = o; }
    }
}
__device__ __forceinline__ void ph_final_norm(const Params& p) {
    const int tid_ = tid_fresh(); const int lane = tid_ & 63, w = tid_ >> 6;
    for (int row = blockIdx.x * 8 + w; row < MLAT; row += gridDim.x * 8) {
        float* src = p.out + (size_t)row * 2048;
        float4 v[8]; float ss = 0.f;
#pragma unroll
        for (int i = 0; i < 8; ++i) { v[i] = *(const float4*)(src + i * 256 + lane * 4); ss += v[i].x * v[i].x + v[i].y * v[i].y + v[i].z * v[i].z + v[i].w * v[i].w; }
        ss = red64(ss);
        const float rstd = rsqrtf(ss * (1.f / 2048.f) + 1e-6f);
#pragma unroll
        for (int i = 0; i < 8; ++i) { const int col = i * 256 + lane * 4; const float4 g4 = *(const float4*)(p.final_norm_g + col);
            float4 o; o.x = v[i].x * rstd * g4.x; o.y = v[i].y * rstd * g4.y; o.z = v[i].z * rstd * g4.z; o.w = v[i].w * rstd * g4.w;
            *(float4*)(src + col) = o; }
    }
}

__device__ __forceinline__ void ph_l0_prep(const Params& p, float* sm) {
    const int tid = tid_fresh();
    u16* PROJ = (u16*)(p.ws + WS_PROJ); u16* CQ = (u16*)(p.ws + WS_CQ); float* G = (float*)(p.ws + WS_G);
    for (int idx = blockIdx.x * NTHR + tid; idx < MTOT * 48; idx += gridDim.x * NTHR) {
        const int j = idx % 48; const float v = G[idx]; float o;
        if (j < 8) o = v + p.ml_ig_b[j];
        else if (j < 16) o = logsigmoidf_(v + p.ml_fg_b[j - 8]);
        else if (j < 32) { const float dt = softplusf_(v + p.dn_dt_bias[j - 16]); o = __expf(-__expf(p.dn_a_log[j - 16]) * dt); }
        else o = sigmoidf_(v);
        G[idx] = o;
    }
    for (int t = blockIdx.x; t < 520 * 24; t += gridDim.x) {
        const int tt = t / 24, part = t % 24;
        const bool isctx = tt < 8;
        const int t0 = isctx ? (tt & 3) * 64 : 0;
        const int rowbase = isctx ? (tt >> 2) * 256 + t0 : 512 + (tt - 8) * 64;
        __syncthreads();
        for (int ch = tid; ch < 68 * 16; ch += NTHR) {
            const int rr = ch >> 4, c8 = (ch & 15) * 8, r = rr - 2;
            const bool ok = isctx ? (t0 + r >= 0 && t0 + r < 256) : (r >= 0 && r < 64);
            float f[8];
#pragma unroll
            for (int j = 0; j < 8; ++j) f[j] = 0.f;
            if (ok) { const uint4 u = *(const uint4*)(PROJ + (size_t)(rowbase + r) * NP0 + 3072 + part * 128 + c8); unpack8(u, f); }
            float* d = sm + rr * 132 + c8;
            *(float4*)(d) = make_float4(f[0], f[1], f[2], f[3]); *(float4*)(d + 4) = make_float4(f[4], f[5], f[6], f[7]);
        }
        __syncthreads();
        const int tk = tid >> 3, cs = (tid & 7) * 16;
        float o[16];
#pragma unroll
        for (int c = 0; c < 16; ++c) o[c] = 0.f;
#pragma unroll
        for (int j = 0; j < 5; ++j) {
            const float* wr_ = p.dn_conv_w + j * 3072 + part * 128 + cs; const float* ir = sm + (tk + j) * 132 + cs;
#pragma unroll
            for (int c4 = 0; c4 < 4; ++c4) { const float4 w4 = *(const float4*)(wr_ + c4 * 4), i4 = *(const float4*)(ir + c4 * 4);
                o[c4 * 4 + 0] += i4.x * w4.x; o[c4 * 4 + 1] += i4.y * w4.y; o[c4 * 4 + 2] += i4.z * w4.z; o[c4 * 4 + 3] += i4.w * w4.w; }
        }
        float ss = 0.f;
#pragma unroll
        for (int c = 0; c < 16; ++c) { o[c] = siluf_(o[c]); ss += o[c] * o[c]; }
        ss = red8(ss);
        if (part < 16) { const float sc = rsqrtf(ss + 1e-6f);
#pragma unroll
            for (int c = 0; c < 16; ++c) o[c] *= sc; }
        u16* dst = isctx ? CQ + (size_t)(rowbase + tk) * 3072 + part * 128 + cs : PROJ + (size_t)(rowbase + tk) * NP0 + 3072 + part * 128 + cs;
        *(uint4*)(dst) = pack8(o); *(uint4*)(dst + 8) = pack8(o + 8);
    }
}

__device__ __forceinline__ int row_of(int i, int b, int dir) {
    if (i < 256) return b * 256 + (dir ? 255 - i : i);
    const int j = i - 256; return 512 + b * 16384 + (dir ? 16383 - j : j);
}
constexpr int NTOK = 16640, NGRP = 4160;

__device__ __forceinline__ void mlstm_tr(const Params& p, int job) {
    const int tid = tid_fresh(), cl = tid >> 4, sl = tid & 15;
    const int chain = job >> 3, cgp = job & 7;
    const int b = chain >> 3, h = (chain >> 1) & 3, dir = chain & 1;
    const int col = cgp * 32 + cl;
    const u16* PROJ = (const u16*)(p.ws + WS_PROJ); const float* G = (const float*)(p.ws + WS_G);
    u16* O = (u16*)(p.ws + (dir ? WS_OB : WS_OF));
    const int qoff = h * 128 + sl * 8, koff = 512 + h * 128 + sl * 8, voff = 1024 + h * 256 + col, gi = dir * 4 + h;
    float C[8], n[8]; float m = 0.f;
#pragma unroll
    for (int d = 0; d < 8; ++d) { C[d] = 0.f; n[d] = 0.f; }
    uint4 bq[3][4], bk[3][4]; u16 bv[3][4]; float big[3][4], blf[3][4];
#pragma unroll
    for (int s = 0; s < 3; ++s)
#pragma unroll
        for (int u = 0; u < 4; ++u) { const int row = row_of(s * 4 + u, b, dir); const u16* rp = PROJ + (size_t)row * NP0;
            bq[s][u] = *(const uint4*)(rp + qoff); bk[s][u] = *(const uint4*)(rp + koff); bv[s][u] = rp[voff]; big[s][u] = G[row * 48 + gi]; blf[s][u] = G[row * 48 + 8 + gi]; }
    for (int g0 = 0; g0 < NGRP + 2; g0 += 3) {
#pragma unroll
        for (int s = 0; s < 3; ++s) {
            const int g = g0 + s;
            if (g < NGRP) {
#pragma unroll
                for (int u = 0; u < 4; ++u) {
                    const int row = row_of(g * 4 + u, b, dir);
                    float q[8], k[8]; unpack8(bq[s][u], q); unpack8(bk[s][u], k);
                    const float v = bf2f(bv[s][u]), ig = big[s][u], lf = blf[s][u];
                    const float mn = fmaxf(lf + m, ig); const float a = __expf(lf + m - mn), sg = __expf(ig - mn); m = mn;
                    const float sv = sg * v; float num = 0.f, den = 0.f;
#pragma unroll
                    for (int d = 0; d < 8; ++d) { C[d] = a * C[d] + sv * k[d]; n[d] = a * n[d] + sg * k[d]; num += C[d] * q[d]; den += n[d] * q[d]; }
                    num = red16(num) * 0.08838834764831845f; den = red16(den) * 0.08838834764831845f;
                    const float hv = num / fmaxf(fabsf(den), __expf(-m));
                    if (sl == 0) O[(size_t)row * 2048 + h * 256 + col] = f2bf(hv);
                }
            }
            const int gn = g + 3;
#pragma unroll
            for (int u = 0; u < 4; ++u) { int i = gn * 4 + u; i = i < NTOK ? i : NTOK - 1; const int row = row_of(i, b, dir); const u16* rp = PROJ + (size_t)row * NP0;
                bq[s][u] = *(const uint4*)(rp + qoff); bk[s][u] = *(const uint4*)(rp + koff); bv[s][u] = rp[voff]; big[s][u] = G[row * 48 + gi]; blf[s][u] = G[row * 48 + 8 + gi]; }
        }
    }
}
__device__ __forceinline__ void deltanet_tr(const Params& p, int job) {
    const int tid = tid_fresh(), cl = tid >> 4, sl = tid & 15;
    const int chain = job >> 2, cgp = job & 3;
    const int b = chain >> 4, h = (chain >> 1) & 7, dir = chain & 1;
    const int col = cgp * 32 + cl;
    const u16* PROJ = (const u16*)(p.ws + WS_PROJ); const u16* CQ = (const u16*)(p.ws + WS_CQ); const float* G = (const float*)(p.ws + WS_G);
    u16* O = (u16*)(p.ws + (dir ? WS_OB : WS_OF));
    const int qoff = h * 128 + sl * 8, koff = 1024 + h * 128 + sl * 8, voff = 2048 + h * 128 + col, gi = dir * 8 + h;
    float S[8];
#pragma unroll
    for (int d = 0; d < 8; ++d) S[d] = 0.f;
    uint4 bq[3][4], bk[3][4]; u16 bv[3][4]; float beg[3][4], bbe[3][4];
#pragma unroll
    for (int s = 0; s < 3; ++s)
#pragma unroll
        for (int u = 0; u < 4; ++u) { const int i = s * 4 + u; const int row = row_of(i, b, dir); const u16* rp = (i < 256) ? CQ + (size_t)row * 3072 : PROJ + (size_t)row * NP0 + 3072;
            bq[s][u] = *(const uint4*)(rp + qoff); bk[s][u] = *(const uint4*)(rp + koff); bv[s][u] = rp[voff]; beg[s][u] = G[row * 48 + 16 + gi]; bbe[s][u] = G[row * 48 + 32 + gi]; }
    for (int g0 = 0; g0 < NGRP + 2; g0 += 3) {
#pragma unroll
        for (int s = 0; s < 3; ++s) {
            const int g = g0 + s;
            if (g < NGRP) {
#pragma unroll
                for (int u = 0; u < 4; ++u) {
                    const int row = row_of(g * 4 + u, b, dir);
                    float q[8], k[8]; unpack8(bq[s][u], q); unpack8(bk[s][u], k);
                    const float v = bf2f(bv[s][u]), eg = beg[s][u], be = bbe[s][u];
                    float sk = 0.f, sq = 0.f, qk = 0.f;
#pragma unroll
                    for (int d = 0; d < 8; ++d) { sk += S[d] * k[d]; sq += S[d] * q[d]; qk += q[d] * k[d]; }
                    sk = red16(sk); sq = red16(sq); qk = red16(qk);
                    const float vn = be * (v - eg * sk);
#pragma unroll
                    for (int d = 0; d < 8; ++d) S[d] = eg * S[d] + k[d] * vn;
                    const float ov = 0.08838834764831845f * (eg * sq + qk * vn);
                    if (sl == 0) O[(size_t)row * 2048 + 1024 + h * 128 + col] = f2bf(ov);
                }
            }
            const int gn = g + 3;
#pragma unroll
            for (int u = 0; u < 4; ++u) { int i = gn * 4 + u; i = i < NTOK ? i : NTOK - 1; const int row = row_of(i, b, dir); const u16* rp = (i < 256) ? CQ + (size_t)row * 3072 : PROJ + (size_t)row * NP0 + 3072;
                bq[s][u] = *(const uint4*)(rp + qoff); bk[s][u] = *(const uint4*)(rp + koff); bv[s][u] = rp[voff]; beg[s][u] = G[row * 48 + 16 + gi]; bbe[s][u] = G[row * 48 + 32 + gi]; }
        }
    }
}
__device__ __forceinline__ void ph_l0_merge(const Params& p) {
    const int tid_ = tid_fresh(); const int lane = tid_ & 63, w = tid_ >> 6;
    const u16* PROJ = (const u16*)(p.ws + WS_PROJ); const u16* OF = (const u16*)(p.ws + WS_OF); const u16* OB = (const u16*)(p.ws + WS_OB); u16* Y = (u16*)(p.ws + WS_H);
    for (int row = blockIdx.x * 8 + w; row < MTOT; row += gridDim.x * 8) {
        const int col = lane * 32; const bool isml = lane < 32;
        const u16* gsrc = PROJ + (size_t)row * NP0 + (isml ? 2048 + col : 6144 + (col - 1024));
        const float* gn = isml ? p.ml_norm_g + col : p.dn_norm_g + (col - 1024);
        float o[32]; float ss = 0.f;
#pragma unroll
        for (int i = 0; i < 4; ++i) { float a[8], bb[8]; unpack8(*(const uint4*)(OF + (size_t)row * 2048 + col + i * 8), a); unpack8(*(const uint4*)(OB + (size_t)row * 2048 + col + i * 8), bb);
#pragma unroll
            for (int j = 0; j < 8; ++j) { o[i * 8 + j] = a[j] + bb[j]; ss += o[i * 8 + j] * o[i * 8 + j]; } }
        ss = red4(ss); const float s8 = ss + dppf<0x141>(ss);
        const float rstd = isml ? rsqrtf(s8 * (1.f / 256.f) + 1e-6f) : rsqrtf(ss * (1.f / 128.f) + 1e-6f);
#pragma unroll
        for (int i = 0; i < 4; ++i) { float gt[8], r[8]; unpack8(*(const uint4*)(gsrc + i * 8), gt);
#pragma unroll
            for (int j = 0; j < 8; ++j) { const float gate = isml ? sigmoidf_(gt[j]) : siluf_(gt[j]); r[j] = o[i * 8 + j] * rstd * gn[i * 8 + j] * gate; }
            *(uint4*)(Y + (size_t)row * 2048 + col + i * 8) = pack8(r); }
    }
}

typedef short bf16x8_t __attribute__((ext_vector_type(8)));
typedef float f32x4_t __attribute__((ext_vector_type(4)));
constexpr int RG_A = 0, RG_BX = 32768, RG_XC = 65536, RG_WT = 82944;

__device__ __forceinline__ int rg_tau(int tt, int z) { if (tt < 8) { const int ci = tt & 3; return z ? 3 - ci : ci; } const int li = (tt - 8) & 255; return 4 + (z ? 255 - li : li); }
__device__ __forceinline__ int rg_batch(int tt) { return tt < 8 ? (tt >> 2) : ((tt - 8) >> 8); }

__device__ __forceinline__ void rg_conv(const Params& p, int tt, int g, unsigned char* lds) {
    const int tid = tid_fresh();
    const u16* PROJ = (const u16*)(p.ws + WS_PROJ);
    float* sm = (float*)lds; u16* XC = (u16*)(lds + RG_XC);
    const bool isctx = tt < 8;
    const int t0 = isctx ? (tt & 3) * 64 : 0;
    const int rowbase = isctx ? (tt >> 2) * 256 + t0 : 512 + (tt - 8) * 64;
    __syncthreads();
    for (int ch = tid; ch < 68 * 16; ch += NTHR) {
        const int rr = ch >> 4, c8 = (ch & 15) * 8, r = rr - 2;
        const bool ok = isctx ? (t0 + r >= 0 && t0 + r < 256) : (r >= 0 && r < 64);
        float f[8];
#pragma unroll
        for (int j = 0; j < 8; ++j) f[j] = 0.f;
        if (ok) { const uint4 u = *(const uint4*)(PROJ + (size_t)(rowbase + r) * NP1 + g * 128 + c8); unpack8(u, f); }
        float* d = sm + rr * 132 + c8;
        *(float4*)(d) = make_float4(f[0], f[1], f[2], f[3]); *(float4*)(d + 4) = make_float4(f[4], f[5], f[6], f[7]);
    }
    __syncthreads();
    const int tk = tid >> 3, cs = (tid & 7) * 16;
    float o[16];
#pragma unroll
    for (int c4 = 0; c4 < 4; ++c4) { const float4 b4 = *(const float4*)(p.rg_conv_b + g * 128 + cs + c4 * 4); o[c4 * 4] = b4.x; o[c4 * 4 + 1] = b4.y; o[c4 * 4 + 2] = b4.z; o[c4 * 4 + 3] = b4.w; }
#pragma unroll
    for (int j = 0; j < 5; ++j) {
        const float* wr_ = p.rg_conv_w + j * 1024 + g * 128 + cs; const float* ir = sm + (tk + j) * 132 + cs;
#pragma unroll
        for (int c4 = 0; c4 < 4; ++c4) { const float4 w4 = *(const float4*)(wr_ + c4 * 4), i4 = *(const float4*)(ir + c4 * 4);
            o[c4 * 4 + 0] += i4.x * w4.x; o[c4 * 4 + 1] += i4.y * w4.y; o[c4 * 4 + 2] += i4.z * w4.z; o[c4 * 4 + 3] += i4.w * w4.w; }
    }
    *(uint4*)(XC + tk * 136 + cs) = pack8(o); *(uint4*)(XC + tk * 136 + cs + 8) = pack8(o + 8);
    __syncthreads();
}
__device__ __forceinline__ void rg_load_w(const float* W, unsigned char* lds) {
    u16* WT = (u16*)(lds + RG_WT); const int tid = tid_fresh();
#pragma unroll 4
    for (int it = 0; it < 32; ++it) { const int idx = it * NTHR + tid, i = idx >> 7, j = idx & 127; WT[j * 136 + i] = f2bf(W[idx]); }
}
__device__ __forceinline__ void rg_mma(unsigned char* lds, int rt, int chh, int lane, f32x4_t (&acc)[4]) {
    const u16* XC = (const u16*)(lds + RG_XC); const u16* WT = (const u16*)(lds + RG_WT);
    const int fr = lane & 15, fq = lane >> 4;
#pragma unroll
    for (int ks = 0; ks < 4; ++ks) {
        const bf16x8_t a = *(const bf16x8_t*)(XC + (rt * 16 + fr) * 136 + ks * 32 + fq * 8);
#pragma unroll
        for (int c = 0; c < 4; ++c) { const bf16x8_t bb = *(const bf16x8_t*)(WT + ((chh * 4 + c) * 16 + fr) * 136 + ks * 32 + fq * 8);
            acc[c] = __builtin_amdgcn_mfma_f32_16x16x32_bf16(a, bb, acc[c], 0, 0, 0); }
    }
}
__device__ __forceinline__ void rg_gates(const Params& p, int g, int z, unsigned char* lds, float* bxdst, bool sync_before_bx) {
    const int tid = tid_fresh(), lane = tid & 63, w = tid >> 6, rt = w >> 1, chh = w & 1, fr = lane & 15, fq = lane >> 4;
    float* A = (float*)(lds + RG_A); const u16* XC = (const u16*)(lds + RG_XC);
    f32x4_t R[4], I[4];
#pragma unroll
    for (int c = 0; c < 4; ++c) { R[c] = (f32x4_t){0.f, 0.f, 0.f, 0.f}; I[c] = (f32x4_t){0.f, 0.f, 0.f, 0.f}; }
    rg_load_w(p.rg_w_r + (size_t)(z * 8 + g) * 16384, lds);
    __syncthreads();
    rg_mma(lds, rt, chh, lane, R);
    __syncthreads();
    rg_load_w(p.rg_w_i + (size_t)(z * 8 + g) * 16384, lds);
    __syncthreads();
    rg_mma(lds, rt, chh, lane, I);
    if (sync_before_bx) __syncthreads();
#pragma unroll
    for (int c = 0; c < 4; ++c) {
        const int chl = (chh * 4 + c) * 16 + fr, chg = z * 1024 + g * 128 + chl;
        const float br = p.rg_b_r[chg], bi = p.rg_b_i[chg], sp = softplusf_(-p.rg_lambda[chg]);
#pragma unroll
        for (int j = 0; j < 4; ++j) { const int t = rt * 16 + fq * 4 + j;
            const float r = sigmoidf_(R[c][j] + br), ii = sigmoidf_(I[c][j] + bi);
            const float la = -8.f * r * sp; const float a = __expf(la);
            const float bx = sqrtf(-expm1f(2.f * la)) * ii * bf2f(XC[t * 136 + chl]);
            A[t * 128 + chl] = a; bxdst[t * 128 + chl] = bx; }
    }
    __syncthreads();
}
__device__ __forceinline__ void gla_prep_item(const Params& p, int it, unsigned char* lds) {
    const int tid = tid_fresh(), lane = tid & 63, w = tid >> 6, fr = lane & 15, fq = lane >> 4;
    const int h = it & 3, tt = (it >> 2) % 520, z = it / 2080;
    const int rowbase = tt < 8 ? tt * 64 : 512 + (tt - 8) * 64;
    float* LG = (float*)lds;
    u16* QEs = (u16*)(lds + 32768);
    u16* KEs = (u16*)(lds + 32768 + 17408);
    u16* Vs = (u16*)(lds + 32768 + 2 * 17408);
    float* BLs = (float*)(lds + 32768 + 2 * 17408 + 33792);
    const u16* PROJ = (const u16*)(p.ws + WS_PROJ); const float* LR = (const float*)(p.ws + WS_G);
    u16* QE = (u16*)(p.ws + WS_QE); u16* KDT = (u16*)(p.ws + WS_KDT) + (size_t)it * 8192; u16* ATT = (u16*)(p.ws + WS_ATT) + (size_t)it * 4096;
    u16* VT = (u16*)(p.ws + WS_VT); float* EBL = (float*)(p.ws + WS_EBL);
    __syncthreads();
    { const int c = tid & 127, tq = tid >> 7; float wv[16];
#pragma unroll
        for (int r = 0; r < 16; ++r) wv[r] = p.gla_w_up[(z * 16 + r) * 512 + h * 128 + c];
        const float bu = p.gla_b_up[z * 512 + h * 128 + c];
        for (int i = 0; i < 16; ++i) { const int tk = tq * 16 + i; const float* lr = LR + (size_t)(rowbase + tk) * 32 + z * 16; float s = bu;
#pragma unroll
            for (int r = 0; r < 16; ++r) s += lr[r] * wv[r];
            LG[tk * 128 + c] = logsigmoidf_(s) * (1.f / 16.f); } }
    __syncthreads();
    if (tid < 128) { float acc = 0.f;
        for (int i = 0; i < 64; ++i) { const int tk = z ? 63 - i : i; acc += LG[tk * 128 + tid]; LG[tk * 128 + tid] = acc; }
        BLs[tid] = acc; EBL[(size_t)it * 128 + tid] = __expf(acc); }
    __syncthreads();
    { const int tk = tid >> 3, cs = (tid & 7) * 16; const u16* rp = PROJ + (size_t)(rowbase + tk) * NP1;
        float q[16], k[16], qe[16], ke[16];
        unpack8(*(const uint4*)(rp + 2048 + h * 128 + cs), q); unpack8(*(const uint4*)(rp + 2048 + h * 128 + cs + 8), q + 8);
        unpack8(*(const uint4*)(rp + 2560 + h * 128 + cs), k); unpack8(*(const uint4*)(rp + 2560 + h * 128 + cs + 8), k + 8);
#pragma unroll
        for (int c = 0; c < 16; ++c) { const float bb = LG[tk * 128 + cs + c], bl = BLs[cs + c];
            qe[c] = q[c] * 0.08838834764831845f * __expf(bb); ke[c] = k[c] * __expf(-bb); KDT[(cs + c) * 64 + tk] = f2bf(k[c] * __expf(bl - bb)); }
        const uint4 q0 = pack8(qe), q1 = pack8(qe + 8);
        *(uint4*)(QEs + tk * 136 + cs) = q0; *(uint4*)(QEs + tk * 136 + cs + 8) = q1;
        *(uint4*)(KEs + tk * 136 + cs) = pack8(ke); *(uint4*)(KEs + tk * 136 + cs + 8) = pack8(ke + 8);
        u16* qg = QE + ((size_t)z * MTOT + rowbase + tk) * 512 + h * 128 + cs;
        *(uint4*)(qg) = q0; *(uint4*)(qg + 8) = q1; }
    if (z == 0) for (int ch = tid; ch < 2048; ch += NTHR) { const int tk = ch >> 5, c8 = (ch & 31) * 8;
        *(uint4*)(Vs + tk * 264 + c8) = *(const uint4*)(PROJ + (size_t)(rowbase + tk) * NP1 + 3072 + h * 256 + c8); }
    __syncthreads();
    { const int rt = w >> 1;
#pragma unroll
        for (int i = 0; i < 2; ++i) { const int ct = (w & 1) * 2 + i; f32x4_t acc = (f32x4_t){0.f, 0.f, 0.f, 0.f};
#pragma unroll
            for (int ks = 0; ks < 4; ++ks) { const bf16x8_t a = *(const bf16x8_t*)(QEs + (rt * 16 + fr) * 136 + ks * 32 + fq * 8); const bf16x8_t bb = *(const bf16x8_t*)(KEs + (ct * 16 + fr) * 136 + ks * 32 + fq * 8);
                acc = __builtin_amdgcn_mfma_f32_16x16x32_bf16(a, bb, acc, 0, 0, 0); }
#pragma unroll
            for (int j = 0; j < 4; ++j) { const int l = rt * 16 + fq * 4 + j, s = ct * 16 + fr; const bool keep = z ? (s >= l) : (s <= l);
                ATT[l * 64 + s] = f2bf(keep ? acc[j] : 0.f); } } }
    if (z == 0) { const int e = tid >> 1, hf = tid & 1; u16* dst = VT + ((size_t)(tt * 4 + h) * 256 + e) * 64 + hf * 32;
#pragma unroll
        for (int l8 = 0; l8 < 4; ++l8) { float v[8];
#pragma unroll
            for (int j = 0; j < 8; ++j) v[j] = bf2f(Vs[(hf * 32 + l8 * 8 + j) * 264 + e]);
            *(uint4*)(dst + l8 * 8) = pack8(v); } }
}
__device__ __forceinline__ void ph_l1_a(const Params& p, unsigned char* lds) {
    const int tid = tid_fresh();
    float2* AGG = (float2*)(p.ws + WS_AGG);
    float* A = (float*)(lds + RG_A); float* BX = (float*)(lds + RG_BX);
    for (int t = blockIdx.x; t < 520 * 8; t += gridDim.x) {
        const int tt = t >> 3, g = t & 7, b = rg_batch(tt);
        rg_conv(p, tt, g, lds);
#pragma unroll 1
        for (int z = 0; z < 2; ++z) {
            rg_gates(p, g, z, lds, BX, false);
            if (tid < 128) { float h = 0.f, P = 1.f;
                for (int i = 0; i < 64; ++i) { const int tk = z ? 63 - i : i; const float a = A[tk * 128 + tid]; h = a * h + BX[tk * 128 + tid]; P *= a; }
                AGG[((size_t)(b * 2 + z) * NSEG + rg_tau(tt, z)) * 1024 + g * 128 + tid] = make_float2(P, h); }
            __syncthreads();
        }
    }
    for (int it = blockIdx.x; it < 4160; it += gridDim.x) gla_prep_item(p, it, lds);
}
__device__ __forceinline__ void rg_pass_b(const Params& p, int job) {
    const float2* AGG = (const float2*)(p.ws + WS_AGG); float* CARRY = (float*)(p.ws + WS_CARRY);
    const int bz = job >> 1, ch = (job & 1) * 512 + tid_fresh();
    float carry = 0.f;
#pragma unroll 4
    for (int tau = 0; tau < NSEG; ++tau) { const size_t ix = ((size_t)bz * NSEG + tau) * 1024 + ch; const float2 ph = AGG[ix]; CARRY[ix] = carry; carry = ph.x * carry + ph.y; }
}
__device__ __forceinline__ int tile_of(int n, int b, int dir) { if (n < 4) return b * 4 + (dir ? 3 - n : n); const int li = n - 4; return 8 + b * 256 + (dir ? 255 - li : li); }
struct GlaFr { bf16x8_t qe[4], at[2], vt[2], kd[2][2]; float eb[2]; };
__device__ __forceinline__ void gla_load(GlaFr& F, const Params& p, int n, int b, int h, int dir, int e0, int lt, int et, int dt0, int fr, int fq) {
    const int nn = n < NSEG ? n : NSEG - 1;
    const int tt = tile_of(nn, b, dir), it = (dir * 520 + tt) * 4 + h, rowbase = tt < 8 ? tt * 64 : 512 + (tt - 8) * 64;
    const u16* QE = (const u16*)(p.ws + WS_QE) + ((size_t)dir * MTOT + rowbase + lt * 16 + fr) * 512 + h * 128 + fq * 8;
    const u16* ATT = (const u16*)(p.ws + WS_ATT) + (size_t)it * 4096 + (lt * 16 + fr) * 64 + fq * 8;
    const u16* VT = (const u16*)(p.ws + WS_VT) + ((size_t)(tt * 4 + h) * 256 + e0 + et * 16 + fr) * 64 + fq * 8;
    const u16* KDT = (const u16*)(p.ws + WS_KDT) + (size_t)it * 8192 + (dt0 * 16 + fr) * 64 + fq * 8;
    const float* EBL = (const float*)(p.ws + WS_EBL) + (size_t)it * 128 + dt0 * 16 + fr;
#pragma unroll
    for (int ks = 0; ks < 4; ++ks) F.qe[ks] = *(const bf16x8_t*)(QE + ks * 32);
#pragma unroll
    for (int ks = 0; ks < 2; ++ks) { F.at[ks] = *(const bf16x8_t*)(ATT + ks * 32); F.vt[ks] = *(const bf16x8_t*)(VT + ks * 32);
        F.kd[0][ks] = *(const bf16x8_t*)(KDT + ks * 32); F.kd[1][ks] = *(const bf16x8_t*)(KDT + 16 * 64 + ks * 32); }
    F.eb[0] = EBL[0]; F.eb[1] = EBL[16];
}
__device__ __forceinline__ void gla_chunk(const Params& p, int job, unsigned char* lds) {
    const int tid = tid_fresh(), lane = tid & 63, w = tid >> 6, fr = lane & 15, fq = lane >> 4;
    const int chain = job >> 3, cgp = job & 7;
    const int b = chain >> 3, h = (chain >> 1) & 3, dir = chain & 1;
    const int e0 = cgp * 32, lt = w >> 1, et = w & 1, dt0 = (w >> 1) * 2;
    u16* Sl = (u16*)lds;
    u16* O = (u16*)(p.ws + (dir ? WS_OB1 : WS_OF1));
    __syncthreads();
    for (int i = tid; i < 2 * 32 * 136 / 2; i += NTHR) ((unsigned*)Sl)[i] = 0u;
    __syncthreads();
    f32x4_t Sacc[2]; Sacc[0] = (f32x4_t){0.f, 0.f, 0.f, 0.f}; Sacc[1] = Sacc[0];
    GlaFr buf[3];
#pragma unroll
    for (int s = 0; s < 3; ++s) gla_load(buf[s], p, s, b, h, dir, e0, lt, et, dt0, fr, fq);
    for (int n0 = 0; n0 < NSEG + 2; n0 += 3) {
#pragma unroll
        for (int s = 0; s < 3; ++s) {
            const int n = n0 + s;
            if (n < NSEG) {
                const GlaFr& F = buf[s];
                const u16* Scur = Sl + (n & 1) * (32 * 136); u16* Snxt = Sl + ((n + 1) & 1) * (32 * 136);
                if (n >= 4) {
                    const int tt = tile_of(n, b, dir), rowbase = 512 + (tt - 8) * 64;
                    f32x4_t acc = (f32x4_t){0.f, 0.f, 0.f, 0.f};
#pragma unroll
                    for (int ks = 0; ks < 4; ++ks) { const bf16x8_t bb = *(const bf16x8_t*)(Scur + (et * 16 + fr) * 136 + ks * 32 + fq * 8); acc = __builtin_amdgcn_mfma_f32_16x16x32_bf16(F.qe[ks], bb, acc, 0, 0, 0); }
#pragma unroll
                    for (int ks = 0; ks < 2; ++ks) acc = __builtin_amdgcn_mfma_f32_16x16x32_bf16(F.at[ks], F.vt[ks], acc, 0, 0, 0);
#pragma unroll
                    for (int j = 0; j < 4; ++j) O[(size_t)(rowbase + lt * 16 + fq * 4 + j) * 1024 + h * 256 + e0 + et * 16 + fr] = f2bf(acc[j]);
                }
#pragma unroll
                for (int i = 0; i < 2; ++i) { f32x4_t nw = (f32x4_t){0.f, 0.f, 0.f, 0.f};
#pragma unroll
                    for (int ks = 0; ks < 2; ++ks) nw = __builtin_amdgcn_mfma_f32_16x16x32_bf16(F.vt[ks], F.kd[i][ks], nw, 0, 0, 0);
#pragma unroll
                    for (int j = 0; j < 4; ++j) { Sacc[i][j] = F.eb[i] * Sacc[i][j] + nw[j]; Snxt[(et * 16 + fq * 4 + j) * 136 + (dt0 + i) * 16 + fr] = f2bf(Sacc[i][j]); } }
                __syncthreads();
            }
            gla_load(buf[s], p, n + 3, b, h, dir, e0, lt, et, dt0, fr, fq);
        }
    }
}
__device__ __forceinline__ void ph_l1_c(const Params& p, unsigned char* lds) {
    const int tid = tid_fresh();
    const u16* PROJ = (const u16*)(p.ws + WS_PROJ); const float* CARRY = (const float*)(p.ws + WS_CARRY); u16* Y = (u16*)(p.ws + WS_H);
    float* A = (float*)(lds + RG_A); float* BX = (float*)(lds + RG_BX); float* BX2 = (float*)(lds + RG_WT);
    for (int t = blockIdx.x + 64; t < 520 * 8; t += gridDim.x) {
        const int tt = t >> 3, g = t & 7, b = rg_batch(tt);
        const int rowbase = 512 + (tt - 8) * 64;
        rg_conv(p, tt, g, lds);
        rg_gates(p, g, 0, lds, BX, false);
        if (tid < 128) { float h = CARRY[((size_t)(b * 2 + 0) * NSEG + rg_tau(tt, 0)) * 1024 + g * 128 + tid];
            for (int i = 0; i < 64; ++i) { h = A[i * 128 + tid] * h + BX[i * 128 + tid]; BX[i * 128 + tid] = h; } }
        __syncthreads();
        rg_gates(p, g, 1, lds, BX2, true);
        if (tid < 128) { float h = CARRY[((size_t)(b * 2 + 1) * NSEG + rg_tau(tt, 1)) * 1024 + g * 128 + tid];
            for (int i = 63; i >= 0; --i) { h = A[i * 128 + tid] * h + BX2[i * 128 + tid];
                const float gr = bf2f(PROJ[(size_t)(rowbase + i) * NP1 + 1024 + g * 128 + tid]);
                Y[(size_t)(rowbase + i) * 2048 + g * 128 + tid] = f2bf(gelu_tanh(gr) * (BX[i * 128 + tid] + h)); } }
        __syncthreads();
    }
    const int lane = tid & 63, w = tid >> 6;
    const u16* OF = (const u16*)(p.ws + WS_OF1); const u16* OB = (const u16*)(p.ws + WS_OB1);
    for (int row = 512 + blockIdx.x * 8 + w; row < MTOT; row += gridDim.x * 8) {
        const int col = lane * 16; float o[16]; float ss = 0.f;
#pragma unroll
        for (int i = 0; i < 2; ++i) { float a[8], bb[8]; unpack8(*(const uint4*)(OF + (size_t)row * 1024 + col + i * 8), a); unpack8(*(const uint4*)(OB + (size_t)row * 1024 + col + i * 8), bb);
#pragma unroll
            for (int j = 0; j < 8; ++j) { o[i * 8 + j] = a[j] + bb[j]; ss += o[i * 8 + j] * o[i * 8 + j]; } }
        ss = red16(ss);
        const float rstd = rsqrtf(ss * (1.f / 256.f) + 1e-6f);
#pragma unroll
        for (int i = 0; i < 2; ++i) { float gt[8], r[8]; unpack8(*(const uint4*)(PROJ + (size_t)row * NP1 + 4096 + col + i * 8), gt);
#pragma unroll
            for (int j = 0; j < 8; ++j) r[j] = o[i * 8 + j] * rstd * p.gla_norm_g[col + i * 8 + j] * siluf_(gt[j]);
            *(uint4*)(Y + (size_t)row * 2048 + 1024 + col + i * 8) = pack8(r); }
    }
}

constexpr int LDS_BYTES = 131072;

__global__ void __launch_bounds__(NTHR, 2) hybrid_fwd(Params p) {
    extern __shared__ __attribute__((aligned(16))) unsigned char lds[];
    cg::grid_group grid = cg::this_grid();
    float* smf = (float*)lds;
    PG8_LAS unsigned char* ldsg = (PG8_LAS unsigned char*)lds;
    unsigned char* ws = p.ws;
    u16* WT_IN = (u16*)(ws + WS_WT_IN); u16* WT_OUT = (u16*)(ws + WS_WT_OUT); u16* WT_GU = (u16*)(ws + WS_WT_GU); u16* WT_DN = (u16*)(ws + WS_WT_DN);
    u16* H = (u16*)(ws + WS_H); u16* PROJ = (u16*)(ws + WS_PROJ); float* XC = (float*)(ws + WS_XC); float* G = (float*)(ws + WS_G);
    const float* MOD = (const float*)(ws + WS_MOD);
    const int GD = (int)gridDim.x, bid = (int)blockIdx.x;

    ph_adaln_partials(p, smf);
    ph_convert<1>(p.ab_w_in, 7216, 2048, 7424, WT_IN, smf);
    ph_convert<0>(p.ab_w_out, 2048, 2048, 2048, WT_OUT, smf);
    ph_convert<2>(p.ffn_w_gu, 11264, 2048, 11264, WT_GU, smf);
    ph_convert<0>(p.ffn_w_down, 2048, 5632, 2048, WT_DN, smf);
    grid.sync();
    ph_adaln_reduce(p);
    grid.sync();

    ph_norm(p.ctx, p.x, p.norm_mix_g, MOD, 0, 1, H, 0);
    grid.sync();
    { pg8::Gemm g{H, WT_IN, MTOT, 7424, 2048}; pg8::StaticOrder S; S.init(MTOT, 7424, GD, bid);
      pg8::EpiProj E{PROJ, NP0, 28, G, NG0, NG0}; pg8::gemm_phase<pg8::EpiProj, pg8::StaticOrder>(ldsg, g, S, E); }
    grid.sync();
    ph_l0_prep(p, smf);
    grid.sync();
    for (int job = bid; job < 256; job += GD) { if (job < 128) mlstm_tr(p, job); else deltanet_tr(p, job - 128); }
    grid.sync();
    ph_l0_merge(p);
    grid.sync();
    { pg8::Gemm g{H, WT_OUT, MTOT, 2048, 2048}; pg8::StaticOrder S; S.init(MTOT, 2048, GD, bid);
      pg8::EpiRes E{p.ctx, p.x, XC, p.out, MOD + 2 * 2048, 0}; pg8::gemm_phase<pg8::EpiRes, pg8::StaticOrder>(ldsg, g, S, E); }
    grid.sync();
    ph_norm(XC, p.out, p.norm_ffn_g, MOD, 3, 4, H, 0);
    grid.sync();
    { pg8::Gemm g{H, WT_GU, MTOT, 11264, 2048}; pg8::StaticOrder S; S.init(MTOT, 11264, GD, bid);
      pg8::EpiSwiglu E{PROJ, FH}; pg8::gemm_phase<pg8::EpiSwiglu, pg8::StaticOrder>(ldsg, g, S, E); }
    grid.sync();
    { pg8::Gemm g{PROJ, WT_DN, MTOT, 2048, 5632}; pg8::StaticOrder S; S.init(MTOT, 2048, GD, bid);
      pg8::EpiRes E{XC, p.out, XC, p.out, MOD + 5 * 2048, 0}; pg8::gemm_phase<pg8::EpiRes, pg8::StaticOrder>(ldsg, g, S, E); }
    grid.sync();

    const float* MOD1 = MOD + 3 * 12288;
    ph_convert<0>(p.cd_w_in, 5152, 2048, 5376, WT_IN, smf);
    ph_convert<0>(p.cd_w_out, 2048, 2048, 2048, WT_OUT, smf);
    ph_convert<2>(p.ffn_w_gu + (size_t)2048 * 11264, 11264, 2048, 11264, WT_GU, smf);
    ph_convert<0>(p.ffn_w_down + (size_t)5632 * 2048, 2048, 5632, 2048, WT_DN, smf);
    ph_norm(XC, p.out, p.norm_mix_g + 2048, MOD1, 0, 1, H, 0);
    grid.sync();
    { pg8::Gemm g{H, WT_IN, MTOT, 5376, 2048}; pg8::StaticOrder S; S.init(MTOT, 5376, GD, bid);
      pg8::EpiProj E{PROJ, NP1, 20, G, NG1, NG1}; pg8::gemm_phase<pg8::EpiProj, pg8::StaticOrder>(ldsg, g, S, E); }
    grid.sync();
    ph_l1_a(p, lds);
    grid.sync();
    for (int job = bid; job < 136; job += GD) { if (job < 128) gla_chunk(p, job, lds); else rg_pass_b(p, job - 128); }
    grid.sync();
    ph_l1_c(p, lds);
    grid.sync();
    { pg8::Gemm g{H + (size_t)512 * 2048, WT_OUT, MLAT, 2048, 2048}; pg8::StaticOrder S; S.init(MLAT, 2048, GD, bid);
      pg8::EpiRes E{XC, p.out, XC, p.out, MOD1 + 2 * 2048, 512}; pg8::gemm_phase<pg8::EpiRes, pg8::StaticOrder>(ldsg, g, S, E); }
    grid.sync();
    ph_norm(XC, p.out, p.norm_ffn_g + 2048, MOD1, 3, 4, H, 512);
    grid.sync();
    { pg8::Gemm g{H + (size_t)512 * 2048, WT_GU, MLAT, 11264, 2048}; pg8::StaticOrder S; S.init(MLAT, 11264, GD, bid);
      pg8::EpiSwiglu E{PROJ, FH}; pg8::gemm_phase<pg8::EpiSwiglu, pg8::StaticOrder>(ldsg, g, S, E); }
    grid.sync();
    { pg8::Gemm g{PROJ, WT_DN, MLAT, 2048, 5632}; pg8::StaticOrder S; S.init(MLAT, 2048, GD, bid);
      pg8::EpiRes E{XC, p.out, XC, p.out, MOD1 + 5 * 2048, 512}; pg8::gemm_phase<pg8::EpiRes, pg8::StaticOrder>(ldsg, g, S, E); }
    grid.sync();
    ph_final_norm(p);
}

extern "C" void kernel_launch(void* const* d_in, const int* in_sizes, int n_in, void* d_out, int out_size, void* d_ws, size_t ws_size, hipStream_t stream) {
    static int grid = 0;
    if (grid == 0) {
        if (n_in != 32 || out_size != MLAT * DM || ws_size < WS_END) { fprintf(stderr, "kernel_launch: unexpected shapes (n_in %d out %d ws %zu need %zu)\n", n_in, out_size, ws_size, (size_t)WS_END); grid = -1; return; }
        int dev = 0, cus = 0, per_cu = 0;
        (void)hipGetDevice(&dev);
        (void)hipDeviceGetAttribute(&cus, hipDeviceAttributeMultiprocessorCount, dev);
        if (hipFuncSetAttribute((const void*)hybrid_fwd, hipFuncAttributeMaxDynamicSharedMemorySize, LDS_BYTES) != hipSuccess) { fprintf(stderr, "kernel_launch: hipFuncSetAttribute failed\n"); }
        if (hipOccupancyMaxActiveBlocksPerMultiprocessor(&per_cu, (const void*)hybrid_fwd, NTHR, LDS_BYTES) != hipSuccess || per_cu < 1) { fprintf(stderr, "kernel_launch: occupancy query gave %d\n", per_cu); per_cu = 1; }
        (void)hipGetLastError();
        grid = cus * per_cu;
    }
    if (grid < 0) return;
    Params p{};
    const float** pp = (const float**)&p;
    for (int i = 0; i < 32; ++i) pp[i] = (const float*)d_in[i];
    p.out = (float*)d_out; p.ws = (unsigned char*)d_ws;
    void* args[] = {&p};
    hipError_t e = hipLaunchCooperativeKernel((const void*)hybrid_fwd, dim3(grid), dim3(NTHR), args, LDS_BYTES, stream);
    if (e != hipSuccess) fprintf(stderr, "cooperative launch failed: %s (grid %d)\n", hipGetErrorString(e), grid);
}
```

```cpp
#include <hip/hip_runtime.h>
#include <hip/hip_cooperative_groups.h>
#include <cstdio>
namespace cg = cooperative_groups;

typedef unsigned short u16;

constexpr int DM = 2048, FH = 5632, MC = 512, MLAT = 32768, MTOT = 33280, NTHR = 512;
constexpr int NP0 = 7168, NP1 = 5120;
constexpr int NG0 = 48, NG1 = 32;
constexpr int NSEG = 260;

constexpr size_t WS_WT_IN = 0;
constexpr size_t WS_WT_OUT = WS_WT_IN + (size_t)7424 * 2048 * 2;
constexpr size_t WS_WT_GU = WS_WT_OUT + (size_t)2048 * 2048 * 2;
constexpr size_t WS_WT_DN = WS_WT_GU + (size_t)11264 * 2048 * 2;
constexpr size_t WS_H = WS_WT_DN + (size_t)2048 * 5632 * 2;
constexpr size_t WS_PROJ = WS_H + (size_t)MTOT * 2048 * 2;
constexpr size_t WS_OF = WS_PROJ + (size_t)MTOT * 7168 * 2;
constexpr size_t WS_OB = WS_OF + (size_t)MTOT * 2048 * 2;
constexpr size_t WS_XC = WS_OB + (size_t)MTOT * 2048 * 2;
constexpr size_t WS_G = WS_XC + (size_t)MC * 2048 * 4;
constexpr size_t WS_CQ = WS_G + (size_t)MTOT * 48 * 4;
constexpr size_t WS_MODP = WS_CQ + (size_t)MC * 3072 * 2;
constexpr size_t WS_MOD = WS_MODP + (size_t)2 * 32 * 3 * 12288 * 4;
constexpr size_t WS_ATT0 = WS_MOD + (size_t)2 * 3 * 12288 * 4;
constexpr size_t WS_MLS = WS_ATT0 + (size_t)4160 * 4096 * 2;
constexpr size_t WS_GCS = WS_MLS + (size_t)4160 * 256 * 4;
constexpr size_t WS_END = WS_GCS + (size_t)8320 * 256 * 4;
constexpr size_t WS_TM = WS_H;
constexpr size_t WS_QK = WS_H + (size_t)8320 * 4096 * 2;
constexpr size_t WS_OF1 = WS_OF;
constexpr size_t WS_OB1 = WS_OF + (size_t)MTOT * 1024 * 2;
constexpr size_t WS_QE = WS_OB;
constexpr size_t WS_KDT = WS_QE + (size_t)2 * MTOT * 512 * 2;
constexpr size_t WS_TAIL = WS_PROJ + (size_t)MTOT * 5120 * 2;
constexpr size_t WS_ATT = WS_TAIL;
constexpr size_t WS_VT = WS_ATT + (size_t)4160 * 4096 * 2;
constexpr size_t WS_EBL = WS_VT + (size_t)2080 * 16384 * 2;
constexpr size_t WS_AGG = WS_EBL + (size_t)4160 * 128 * 4;
constexpr size_t WS_CARRY = WS_AGG + (size_t)4 * NSEG * 1024 * 8;
static_assert(WS_CARRY + (size_t)4 * NSEG * 1024 * 4 <= WS_OF, "layer-1 tail overflow");

struct Params {
    const float *x, *c, *ctx, *c_ctx, *mod_w, *mod_b, *norm_mix_g, *norm_ffn_g, *ffn_w_gu, *ffn_w_down, *final_norm_g,
        *ab_w_in, *ab_w_out, *ml_ig_b, *ml_fg_b, *ml_norm_g, *dn_conv_w, *dn_a_log, *dn_dt_bias, *dn_norm_g,
        *cd_w_in, *cd_w_out, *rg_conv_w, *rg_conv_b, *rg_w_r, *rg_b_r, *rg_w_i, *rg_b_i, *rg_lambda, *gla_w_up, *gla_b_up, *gla_norm_g;
    float* out; unsigned char* ws;
};

__device__ __forceinline__ float bf2f(u16 v) { return __uint_as_float(((unsigned)v) << 16); }
typedef __bf16 bf16x2_nat __attribute__((ext_vector_type(2)));
typedef float f32x2_nat __attribute__((ext_vector_type(2)));
__device__ __forceinline__ unsigned cvt_pk_bf16(float lo, float hi) { const f32x2_nat v = {lo, hi}; const bf16x2_nat r = __builtin_convertvector(v, bf16x2_nat); return __builtin_bit_cast(unsigned, r); }
__device__ __forceinline__ u16 f2bf(float f) { return (u16)(cvt_pk_bf16(f, 0.f) & 0xffffu); }
__device__ __forceinline__ void unpack8(const uint4& u, float* f) {
    f[0] = __uint_as_float(u.x << 16); f[1] = __uint_as_float(u.x & 0xffff0000u);
    f[2] = __uint_as_float(u.y << 16); f[3] = __uint_as_float(u.y & 0xffff0000u);
    f[4] = __uint_as_float(u.z << 16); f[5] = __uint_as_float(u.z & 0xffff0000u);
    f[6] = __uint_as_float(u.w << 16); f[7] = __uint_as_float(u.w & 0xffff0000u);
}
__device__ __forceinline__ uint4 pack8(const float* f) { uint4 o; o.x = cvt_pk_bf16(f[0], f[1]); o.y = cvt_pk_bf16(f[2], f[3]); o.z = cvt_pk_bf16(f[4], f[5]); o.w = cvt_pk_bf16(f[6], f[7]); return o; }
template <int CTRL> __device__ __forceinline__ float dppf(float x) { return __int_as_float(__builtin_amdgcn_update_dpp(0, __float_as_int(x), CTRL, 0xF, 0xF, true)); }
__device__ __forceinline__ float red4(float x) { x += dppf<0xB1>(x); x += dppf<0x4E>(x); return x; }
__device__ __forceinline__ float red8(float x) { x = red4(x); x += dppf<0x141>(x); return x; }
__device__ __forceinline__ float red16(float x) { x = red8(x); x += dppf<0x140>(x); return x; }
__device__ __forceinline__ float red64(float x) { x = red16(x); x += __shfl_xor(x, 16); x += __shfl_xor(x, 32); return x; }
__device__ __forceinline__ float sigmoidf_(float x) { return 1.f / (1.f + __expf(-x)); }
__device__ __forceinline__ float siluf_(float x) { return x / (1.f + __expf(-x)); }
__device__ __forceinline__ float softplusf_(float x) { return fmaxf(x, 0.f) + log1pf(__expf(-fabsf(x))); }
__device__ __forceinline__ float logsigmoidf_(float x) { return fminf(x, 0.f) - log1pf(__expf(-fabsf(x))); }
__device__ __forceinline__ float gelu_tanh(float x) { const float u = 0.7978845608028654f * (x + 0.044715f * x * x * x); const float th = 1.f - 2.f / (1.f + __expf(2.f * u)); return 0.5f * x * (1.f + th); }

__device__ __forceinline__ int tid_fresh() { int t = threadIdx.x; asm volatile("" : "+v"(t)); return t; }
namespace pg8 {
#define PG8_LAS __attribute__((address_space(3)))
typedef unsigned short bf16_t;
typedef short bf16x8 __attribute__((ext_vector_type(8)));
typedef float f32x4 __attribute__((ext_vector_type(4)));
typedef unsigned u32x4 __attribute__((ext_vector_type(4)));
constexpr int BM = 256, BK = 64, HALF = 128, HTB = HALF * BK * 2  , STAGE_BYTES = 8 * HTB, NXCD = 8, WGM = 8;

__host__ __device__ __forceinline__ int lds_byte(int r, int c) { const int st = (r >> 4) * 2 + (c >> 5), rr = r & 15, cc = c & 31, ob = rr * 64 + cc * 2; return st * 1024 + (ob ^ (((ob >> 9) & 1) << 5)); }
__host__ __device__ __forceinline__ void stage_rc(int b, int& R, int& C) { const int st = b / 1024, sb = b % 1024, swz = sb ^ (((sb >> 9) & 1) << 5); R = (st >> 1) * 16 + swz / 64; C = (st & 1) * 32 + (swz % 64) / 2; }
__host__ __device__ __forceinline__ int perm32(int rho) { const int n = rho >> 4, i = rho & 15; return 8 * (i >> 2) + 4 * n + (i & 3); }

struct Unit { int pm, pn; };
struct Gemm { const bf16_t* A; const bf16_t* Bt; int M, N, K; };

struct StaticOrder {
    int nM, nN, nwg, G, c;
    __host__ __device__ void init(int M, int N, int G_, int c_) { nM = M / BM; nN = N / BM; nwg = nM * nN; G = G_; c = c_; }
    __host__ __device__ bool next(int i, Unit& u) const {
        const long L = (long)i * G + c; if (L >= nwg) return false;
        int wgid = (int)L; { const int q = nwg / NXCD, r = nwg % NXCD, xcd = wgid % NXCD, off = wgid / NXCD; wgid = (xcd < r ? xcd * (q + 1) : r * (q + 1) + (xcd - r) * q) + off; }
        const int nig = WGM * nN, gid = wgid / nig, fm = gid * WGM, gsz = (nM - fm) < WGM ? (nM - fm) : WGM;
        u.pm = fm + ((wgid % nig) % gsz); u.pn = (wgid % nig) / gsz; return true;
    }
    __device__ __forceinline__ void a_ready(const Unit&) const {}
    __device__ __forceinline__ void done(const Unit&) const {}
};
using ::cvt_pk_bf16;
typedef float f32x2 __attribute__((ext_vector_type(2)));

struct EpiProj {
    static constexpr bool PERM = true, AFTER_DRAIN = false;
    bf16_t* P; int ldp; int n_main; float* G; int ldg; int ng;
    __device__ __forceinline__ void operator()(const f32x4 (&acc)[2][2][4][2], const Unit& u, int wr, int wc, int fr, int fq) const {
        const int row0 = u.pm * BM + wr * 64 + fr;
        if (u.pn < n_main) {
            const int col0 = u.pn * BM + wc * 32 + 8 * fq;
#pragma unroll
            for (int ai = 0; ai < 2; ++ai)
#pragma unroll
                for (int m = 0; m < 4; ++m) { bf16_t* rowp = P + (size_t)(row0 + ai * HALF + m * 16) * ldp + col0;
#pragma unroll
                    for (int bj = 0; bj < 2; ++bj) { const f32x4 v0 = acc[ai][bj][m][0], v1 = acc[ai][bj][m][1];
                        u32x4 w; w.x = cvt_pk_bf16(v0[0], v0[1]); w.y = cvt_pk_bf16(v0[2], v0[3]); w.z = cvt_pk_bf16(v1[0], v1[1]); w.w = cvt_pk_bf16(v1[2], v1[3]);
                        *(u32x4*)(rowp + bj * HALF) = w; } }
        } else {
            const int c0 = wc * 32 + 8 * fq;
#pragma unroll
            for (int ai = 0; ai < 2; ++ai)
#pragma unroll
                for (int m = 0; m < 4; ++m) { float* rowp = G + (size_t)(row0 + ai * HALF + m * 16) * ldg;
#pragma unroll
                    for (int n = 0; n < 2; ++n)
#pragma unroll
                        for (int j = 0; j < 4; ++j) { const int c = c0 + 4 * n + j; if (c < ng) rowp[c] = acc[ai][0][m][n][j]; } }
        }
    }
};
struct EpiRes {
    static constexpr bool PERM = false, AFTER_DRAIN = false;
    const float* srcC; const float* srcL; float* dstC; float* dstL; const float* gate  ; int row_off;
    __device__ __forceinline__ void operator()(const f32x4 (&acc)[2][2][4][2], const Unit& u, int wr, int wc, int fr, int fq) const {
        const int grow_t = u.pm * BM + row_off;
        const bool isc = grow_t < 512;
        const int mr = isc ? 2 : ((grow_t - 512) >> 14);
        const float* sp = isc ? srcC + (size_t)grow_t * 2048 : srcL + (size_t)(grow_t - 512) * 2048;
        float* dp = isc ? dstC + (size_t)grow_t * 2048 : dstL + (size_t)(grow_t - 512) * 2048;
        const int lrow0 = wr * 64 + fr, col0 = u.pn * BM + wc * 32 + 4 * fq;
        const float* gp = gate + (size_t)mr * 12288 + col0;
        f32x4 gv[2][2];
#pragma unroll
        for (int bj = 0; bj < 2; ++bj)
#pragma unroll
            for (int n = 0; n < 2; ++n) gv[bj][n] = *(const f32x4*)(gp + bj * HALF + n * 16);
#pragma unroll
        for (int ai = 0; ai < 2; ++ai)
#pragma unroll
            for (int m = 0; m < 4; ++m) { const size_t off = (size_t)(lrow0 + ai * HALF + m * 16) * 2048 + col0;
#pragma unroll
                for (int bj = 0; bj < 2; ++bj)
#pragma unroll
                    for (int n = 0; n < 2; ++n) { const f32x4 s = *(const f32x4*)(sp + off + bj * HALF + n * 16);
                        *(f32x4*)(dp + off + bj * HALF + n * 16) = s + gv[bj][n] * acc[ai][bj][m][n]; } }
    }
};
struct EpiSwiglu {
    static constexpr bool PERM = true, AFTER_DRAIN = false;
    bf16_t* O; int ldo;
    __device__ __forceinline__ void operator()(const f32x4 (&acc)[2][2][4][2], const Unit& u, int wr, int wc, int fr, int fq) const {
        const int row0 = u.pm * BM + wr * 64 + fr, col0 = u.pn * HALF + wc * 32 + 8 * fq;
#pragma unroll
        for (int ai = 0; ai < 2; ++ai)
#pragma unroll
            for (int m = 0; m < 4; ++m) { float r[8];
#pragma unroll
                for (int n = 0; n < 2; ++n)
#pragma unroll
                    for (int j = 0; j < 4; ++j) { const float gg = acc[ai][0][m][n][j], uu = acc[ai][1][m][n][j]; r[n * 4 + j] = gg / (1.f + __expf(-gg)) * uu; }
                u32x4 w; w.x = cvt_pk_bf16(r[0], r[1]); w.y = cvt_pk_bf16(r[2], r[3]); w.z = cvt_pk_bf16(r[4], r[5]); w.w = cvt_pk_bf16(r[6], r[7]);
                *(u32x4*)(O + (size_t)(row0 + ai * HALF + m * 16) * ldo + col0) = w; }
    }
};

template <class Epi, class Sched>
__device__ __forceinline__ void gemm_phase(PG8_LAS unsigned char* lds, const Gemm g, const Sched& S, const Epi& E) {
    int tid = threadIdx.x; asm volatile("" : "+v"(tid)); const int wid = __builtin_amdgcn_readfirstlane(tid >> 6), lane = tid & 63, wr = wid >> 2, wc = wid & 3, fr = lane & 15, fq = lane >> 4;
    const int K = g.K, nt = K / BK;
    unsigned voffA[2], voffB[2];
#pragma unroll
    for (int i = 0; i < 2; ++i) { int R, C; stage_rc(tid * 16 + i * 8192, R, C); const int Rb = Epi::PERM ? ((R & ~31) + perm32(R & 31)) : R;
        voffA[i] = (unsigned)(R * K + C) * 2u; voffB[i] = (unsigned)(Rb * K + C) * 2u; }
    const size_t kstep = (size_t)(BK * 2);
    const size_t hstep = (size_t)HALF * K * 2;
    const size_t tstep = 2 * hstep;
    const unsigned ldsw = (unsigned)wid * 1024u;
    const int aoff = lds_byte(wr * 64 + fr, fq * 8), boff = lds_byte(wc * 32 + fr, fq * 8);
#define PG8_SA(b, h) (((b) * 2 + (h)) * HTB)
#define PG8_SB(b, h) ((4 + (b) * 2 + (h)) * HTB)
#define PG8_STAGE(bufoff, gbase, voff) do { _Pragma("unroll") for (int _i = 0; _i < 2; ++_i) \
        __builtin_amdgcn_global_load_lds((const unsigned*)((const char*)(gbase) + (voff)[_i]), (PG8_LAS unsigned*)(lds + (bufoff) + ldsw + _i * 8192), 16, 0, 0); } while (0)
#define PG8_LDA(dst, b, h) do { _Pragma("unroll") for (int m = 0; m < 4; ++m) _Pragma("unroll") for (int k = 0; k < 2; ++k) dst[m][k] = *(const PG8_LAS bf16x8*)(lds + PG8_SA(b, h) + aoff + m * 2048 + k * 1024); } while (0)
#define PG8_LDB(dst, b, h) do { _Pragma("unroll") for (int n = 0; n < 2; ++n) _Pragma("unroll") for (int k = 0; k < 2; ++k) dst[n][k] = *(const PG8_LAS bf16x8*)(lds + PG8_SB(b, h) + boff + n * 2048 + k * 1024); } while (0)
#define PG8_MMA(ai, bj, At, Bt) do { __builtin_amdgcn_s_setprio(1); _Pragma("unroll") for (int m = 0; m < 4; ++m) _Pragma("unroll") for (int n = 0; n < 2; ++n) _Pragma("unroll") for (int k = 0; k < 2; ++k) \
        acc[ai][bj][m][n] = __builtin_amdgcn_mfma_f32_16x16x32_bf16(Bt[n][k], At[m][k], acc[ai][bj][m][n], 0, 0, 0); __builtin_amdgcn_s_setprio(0); } while (0)
#define PG8_WAIT_V(n) asm volatile("s_waitcnt vmcnt(" #n ")" ::: "memory")
#define PG8_WAIT_L(n) asm volatile("s_waitcnt lgkmcnt(" #n ")" ::: "memory")
#define PG8_BAR __builtin_amdgcn_s_barrier()
#define PG8_SCHED __builtin_amdgcn_sched_barrier(0)
    Unit cur, nxt; int ui = 0;
    if (!S.next(0, cur)) return;
    f32x4 acc[2][2][4][2];
#pragma unroll
    for (int a = 0; a < 2; ++a)
#pragma unroll
        for (int b = 0; b < 2; ++b)
#pragma unroll
            for (int m = 0; m < 4; ++m)
#pragma unroll
                for (int n = 0; n < 2; ++n) acc[a][b][m][n] = (f32x4){0.f, 0.f, 0.f, 0.f};
    bf16x8 At[4][2], B0[2][2], B1[2][2];
    const char* cA = (const char*)g.A + (size_t)cur.pm * tstep; const char* cB = (const char*)g.Bt + (size_t)cur.pn * tstep;
    S.a_ready(cur);
    PG8_STAGE(PG8_SB(0, 0), cB, voffB); PG8_STAGE(PG8_SA(0, 0), cA, voffA); PG8_STAGE(PG8_SB(0, 1), cB + hstep, voffB); PG8_STAGE(PG8_SA(0, 1), cA + hstep, voffA);
    if (wr == 1) PG8_BAR;
    PG8_WAIT_V(4); PG8_BAR;
    PG8_STAGE(PG8_SB(1, 0), cB + kstep, voffB); PG8_STAGE(PG8_SA(1, 0), cA + kstep, voffA); PG8_STAGE(PG8_SB(1, 1), cB + hstep + kstep, voffB);
    PG8_WAIT_V(6); PG8_BAR;
    for (;;) {
        const bool has_next = S.next(ui + 1, nxt);
        const char* nA = has_next ? (const char*)g.A + (size_t)nxt.pm * tstep : cA; const char* nB = has_next ? (const char*)g.Bt + (size_t)nxt.pn * tstep : cB;
        for (int t = 0; t < nt; t += 2) {
            const bool last = (t == nt - 2);
            const char* a1 = cA + (size_t)(t + 1) * kstep;
            const char* a2 = last ? nA : cA + (size_t)(t + 2) * kstep; const char* b2 = last ? nB : cB + (size_t)(t + 2) * kstep;
            const char* a3 = a2 + kstep; const char* b3 = b2 + kstep;
            if (last && has_next) S.a_ready(nxt);
            PG8_LDB(B0, 0, 0); PG8_SCHED; PG8_LDA(At, 0, 0); PG8_STAGE(PG8_SA(1, 1), a1 + hstep, voffA);
            PG8_WAIT_L(8); PG8_BAR; PG8_WAIT_L(0); PG8_MMA(0, 0, At, B0); PG8_BAR; PG8_SCHED;
            PG8_LDB(B1, 0, 1); PG8_STAGE(PG8_SB(0, 0), b2, voffB);
            PG8_BAR; PG8_WAIT_L(0); PG8_MMA(0, 1, At, B1); PG8_BAR;
            PG8_LDA(At, 0, 1); PG8_STAGE(PG8_SA(0, 0), a2, voffA);
            PG8_BAR; PG8_WAIT_L(0); PG8_MMA(1, 0, At, B0); PG8_BAR; PG8_SCHED;
            PG8_STAGE(PG8_SB(0, 1), b2 + hstep, voffB);
            PG8_WAIT_V(6); PG8_BAR; PG8_MMA(1, 1, At, B1); PG8_BAR;
            PG8_LDB(B0, 1, 0); PG8_SCHED; PG8_LDA(At, 1, 0); PG8_STAGE(PG8_SA(0, 1), a2 + hstep, voffA);
            PG8_WAIT_L(8); PG8_BAR; PG8_WAIT_L(0); PG8_MMA(0, 0, At, B0); PG8_BAR; PG8_SCHED;
            PG8_LDB(B1, 1, 1); PG8_STAGE(PG8_SB(1, 0), b3, voffB);
            PG8_BAR; PG8_WAIT_L(0); PG8_MMA(0, 1, At, B1); PG8_BAR;
            PG8_LDA(At, 1, 1); PG8_STAGE(PG8_SA(1, 0), a3, voffA);
            PG8_BAR; PG8_WAIT_L(0); PG8_MMA(1, 0, At, B0); PG8_BAR; PG8_SCHED;
            PG8_STAGE(PG8_SB(1, 1), b3 + hstep, voffB);
            PG8_WAIT_V(6); PG8_BAR; PG8_MMA(1, 1, At, B1); PG8_BAR;
        }
        if constexpr (!Epi::AFTER_DRAIN) { E(acc, cur, wr, wc, fr, fq); S.done(cur); }
        if (!has_next) break;
#pragma unroll
        for (int a = 0; a < 2; ++a)
#pragma unroll
            for (int b = 0; b < 2; ++b)
#pragma unroll
                for (int m = 0; m < 4; ++m)
#pragma unroll
                    for (int n = 0; n < 2; ++n) acc[a][b][m][n] = (f32x4){0.f, 0.f, 0.f, 0.f};
        cur = nxt; cA = nA; cB = nB; ++ui;
    }
    PG8_WAIT_V(0);
    if (wr == 0) PG8_BAR;
    PG8_BAR;
    if constexpr (Epi::AFTER_DRAIN) { E.fused(acc, cur, wr, wc, fr, fq, lds, wid, lane); S.done(cur); }
#undef PG8_SA
#undef PG8_SB
#undef PG8_STAGE
#undef PG8_LDA
#undef PG8_LDB
#undef PG8_MMA
#undef PG8_WAIT_V
#undef PG8_WAIT_L
#undef PG8_BAR
#undef PG8_SCHED
}
}

__device__ __forceinline__ void ph_adaln_partials(const Params& p, float* sm) {
    const int tid = tid_fresh();
    float* MODP = (float*)(p.ws + WS_MODP);
    for (int it = blockIdx.x; it < 384; it += gridDim.x) {
        const int l = it / 192, rem = it % 192, kc = rem / 6, cgp = rem % 6;
        __syncthreads();
        if (tid < 192) { const int r = tid >> 6, kk = tid & 63, k = kc * 64 + kk; const float cv = (r < 2) ? p.c[r * 2048 + k] : p.c_ctx[k]; sm[tid] = siluf_(cv); }
        __syncthreads();
        const int col = cgp * 2048 + tid * 4;
        float4 a0 = {0.f, 0.f, 0.f, 0.f}, a1 = a0, a2 = a0;
        const float* wp = p.mod_w + ((size_t)l * 2048 + (size_t)kc * 64) * 12288 + col;
#pragma unroll 8
        for (int kk = 0; kk < 64; ++kk) {
            const float4 w = *(const float4*)(wp + (size_t)kk * 12288);
            const float s0 = sm[kk], s1 = sm[64 + kk], s2 = sm[128 + kk];
            a0.x += s0 * w.x; a0.y += s0 * w.y; a0.z += s0 * w.z; a0.w += s0 * w.w;
            a1.x += s1 * w.x; a1.y += s1 * w.y; a1.z += s1 * w.z; a1.w += s1 * w.w;
            a2.x += s2 * w.x; a2.y += s2 * w.y; a2.z += s2 * w.z; a2.w += s2 * w.w;
        }
        float* o = MODP + ((size_t)(l * 32 + kc) * 3) * 12288 + col;
        *(float4*)(o) = a0; *(float4*)(o + 12288) = a1; *(float4*)(o + 2 * 12288) = a2;
    }
}
__device__ __forceinline__ void ph_adaln_reduce(const Params& p) {
    const float* MODP = (const float*)(p.ws + WS_MODP); float* MOD = (float*)(p.ws + WS_MOD);
    for (int idx = blockIdx.x * NTHR + tid_fresh(); idx < 2 * 3 * 12288; idx += gridDim.x * NTHR) {
        const int l = idx / 36864, r = (idx / 12288) % 3, col = idx % 12288;
        float s = p.mod_b[l * 12288 + col];
        for (int kc = 0; kc < 32; ++kc) s += MODP[((size_t)(l * 32 + kc) * 3 + r) * 12288 + col];
        MOD[idx] = s;
    }
}

template <int MODE> __device__ __forceinline__ int colmap(int n, int nsrc) {
    if (MODE == 0) return n < nsrc ? n : -1;
    if (MODE == 1) { if (n < 3072) return n; if (n < 7168) return n + 16; if (n < 7184) return 3072 + (n - 7168); if (n < 7216) return n; return -1; }
    return ((n >> 7) & 1) * 5632 + (n >> 8) * 128 + (n & 127);
}
template <int MODE> __device__ __forceinline__ void ph_convert(const float* W, int nsrc, int K, int nout, u16* Bt, float* sm) {
    const int tid = tid_fresh(); const int nnt = nout / 64, ntiles = nnt * (K / 64);
    for (int t = blockIdx.x; t < ntiles; t += gridDim.x) {
        const int k0 = (t / nnt) * 64, n0 = (t % nnt) * 64;
        __syncthreads();
#pragma unroll
        for (int i = 0; i < 8; ++i) { const int idx = i * NTHR + tid, kk = idx >> 6, nn = idx & 63; const int src = colmap<MODE>(n0 + nn, nsrc);
            sm[kk * 65 + nn] = src >= 0 ? W[(size_t)(k0 + kk) * nsrc + src] : 0.f; }
        __syncthreads();
        { const int nn = tid >> 3, k8 = (tid & 7) * 8; float v[8];
#pragma unroll
            for (int j = 0; j < 8; ++j) v[j] = sm[(k8 + j) * 65 + nn];
            *(uint4*)(Bt + (size_t)(n0 + nn) * K + k0 + k8) = pack8(v); }
    }
}

__device__ __forceinline__ void ph_norm(const float* srcC, const float* srcL, const float* g, const float* modl, int chunk_sh, int chunk_sc, u16* H, int row_begin) {
    const int tid_ = tid_fresh(); const int lane = tid_ & 63, w = tid_ >> 6;
    for (int row = row_begin + blockIdx.x * 8 + w; row < MTOT; row += gridDim.x * 8) {
        const float* src = row < 512 ? srcC + (size_t)row * 2048 : srcL + (size_t)(row - 512) * 2048;
        const int mr = row < 512 ? 2 : ((row - 512) >> 14);
        const float* sc = modl + (mr * 6 + chunk_sc) * 2048; const float* sh = modl + (mr * 6 + chunk_sh) * 2048;
        float4 v[8]; float ss = 0.f;
#pragma unroll
        for (int i = 0; i < 8; ++i) { v[i] = *(const float4*)(src + i * 256 + lane * 4); ss += v[i].x * v[i].x + v[i].y * v[i].y + v[i].z * v[i].z + v[i].w * v[i].w; }
        ss = red64(ss);
        const float rstd = rsqrtf(ss * (1.f / 2048.f) + 1e-6f);
#pragma unroll
        for (int i = 0; i < 8; ++i) { const int col = i * 256 + lane * 4;
            const float4 g4 = *(const float4*)(g + col), s4 = *(const float4*)(sc + col), h4 = *(const float4*)(sh + col);
            const float y0 = v[i].x * rstd * g4.x * (1.f + s4.x) + h4.x, y1 = v[i].y * rstd * g4.y * (1.f + s4.y) + h4.y;
            const float y2 = v[i].z * rstd * g4.z * (1.f + s4.z) + h4.z, y3 = v[i].w * rstd * g4.w * (1.f + s4.w) + h4.w;
            uint2 o; o.x = cvt_pk_bf16(y0, y1); o.y = cvt_pk_bf16(y2, y3);
            *(uint2*)(H + (size_t)row * 2048 + col) = o; }
    }
}
__device__ __forceinline__ void ph_final_norm(const Params& p) {
    const int tid_ = tid_fresh(); const int lane = tid_ & 63, w = tid_ >> 6;
    for (int row = blockIdx.x * 8 + w; row < MLAT; row += gridDim.x * 8) {
        float* src = p.out + (size_t)row * 2048;
        float4 v[8]; float ss = 0.f;
#pragma unroll
        for (int i = 0; i < 8; ++i) { v[i] = *(const float4*)(src + i * 256 + lane * 4); ss += v[i].x * v[i].x + v[i].y * v[i].y + v[i].z * v[i].z + v[i].w * v[i].w; }
        ss = red64(ss);
        const float rstd = rsqrtf(ss * (1.f / 2048.f) + 1e-6f);
#pragma unroll
        for (int i = 0; i < 8; ++i) { const int col = i * 256 + lane * 4; const float4 g4 = *(const float4*)(p.final_norm_g + col);
            float4 o; o.x = v[i].x * rstd * g4.x; o.y = v[i].y * rstd * g4.y; o.z = v[i].z * rstd * g4.z; o.w = v[i].w * rstd * g4.w;
            *(float4*)(src + col) = o; }
    }
}

__device__ __forceinline__ void ph_l0_prep(const Params& p, float* sm) {
    const int tid = tid_fresh();
    u16* PROJ = (u16*)(p.ws + WS_PROJ); u16* CQ = (u16*)(p.ws + WS_CQ); float* G = (float*)(p.ws + WS_G);
    for (int idx = blockIdx.x * NTHR + tid; idx < MTOT * 48; idx += gridDim.x * NTHR) {
        const int j = idx % 48; const float v = G[idx]; float o;
        if (j < 8) o = v + p.ml_ig_b[j];
        else if (j < 16) o = logsigmoidf_(v + p.ml_fg_b[j - 8]);
        else if (j < 32) { const float dt = softplusf_(v + p.dn_dt_bias[j - 16]); o = -__expf(p.dn_a_log[j - 16]) * dt; }
        else o = sigmoidf_(v);
        G[idx] = o;
    }
    for (int t = blockIdx.x; t < 520 * 24; t += gridDim.x) {
        const int tt = t / 24, part = t % 24;
        const bool isctx = tt < 8;
        const int t0 = isctx ? (tt & 3) * 64 : 0;
        const int rowbase = isctx ? (tt >> 2) * 256 + t0 : 512 + (tt - 8) * 64;
        __syncthreads();
        for (int ch = tid; ch < 68 * 16; ch += NTHR) {
            const int rr = ch >> 4, c8 = (ch & 15) * 8, r = rr - 2;
            const bool ok = isctx ? (t0 + r >= 0 && t0 + r < 256) : (r >= 0 && r < 64);
            float f[8];
#pragma unroll
            for (int j = 0; j < 8; ++j) f[j] = 0.f;
            if (ok) { const uint4 u = *(const uint4*)(PROJ + (size_t)(rowbase + r) * NP0 + 3072 + part * 128 + c8); unpack8(u, f); }
            float* d = sm + rr * 132 + c8;
            *(float4*)(d) = make_float4(f[0], f[1], f[2], f[3]); *(float4*)(d + 4) = make_float4(f[4], f[5], f[6], f[7]);
        }
        __syncthreads();
        const int tk = tid >> 3, cs = (tid & 7) * 16;
        float o[16];
#pragma unroll
        for (int c = 0; c < 16; ++c) o[c] = 0.f;
#pragma unroll
        for (int j = 0; j < 5; ++j) {
            const float* wr_ = p.dn_conv_w + j * 3072 + part * 128 + cs; const float* ir = sm + (tk + j) * 132 + cs;
#pragma unroll
            for (int c4 = 0; c4 < 4; ++c4) { const float4 w4 = *(const float4*)(wr_ + c4 * 4), i4 = *(const float4*)(ir + c4 * 4);
                o[c4 * 4 + 0] += i4.x * w4.x; o[c4 * 4 + 1] += i4.y * w4.y; o[c4 * 4 + 2] += i4.z * w4.z; o[c4 * 4 + 3] += i4.w * w4.w; }
        }
        float ss = 0.f;
#pragma unroll
        for (int c = 0; c < 16; ++c) { o[c] = siluf_(o[c]); ss += o[c] * o[c]; }
        ss = red8(ss);
        if (part < 16) { const float sc = rsqrtf(ss + 1e-6f);
#pragma unroll
            for (int c = 0; c < 16; ++c) o[c] *= sc; }
        u16* dst = isctx ? CQ + (size_t)(rowbase + tk) * 3072 + part * 128 + cs : PROJ + (size_t)(rowbase + tk) * NP0 + 3072 + part * 128 + cs;
        *(uint4*)(dst) = pack8(o); *(uint4*)(dst + 8) = pack8(o + 8);
    }
}

__device__ __forceinline__ void ph_l0_merge(const Params& p) {
    const int tid_ = tid_fresh(); const int lane = tid_ & 63, w = tid_ >> 6;
    const u16* PROJ = (const u16*)(p.ws + WS_PROJ); const u16* OF = (const u16*)(p.ws + WS_OF); const u16* OB = (const u16*)(p.ws + WS_OB); u16* Y = (u16*)(p.ws + WS_H);
    for (int row = blockIdx.x * 8 + w; row < MTOT; row += gridDim.x * 8) {
        const int col = lane * 32; const bool isml = lane < 32;
        const u16* gsrc = PROJ + (size_t)row * NP0 + (isml ? 2048 + col : 6144 + (col - 1024));
        const float* gn = isml ? p.ml_norm_g + col : p.dn_norm_g + (col - 1024);
        float o[32]; float ss = 0.f;
#pragma unroll
        for (int i = 0; i < 4; ++i) { float a[8], bb[8]; unpack8(*(const uint4*)(OF + (size_t)row * 2048 + col + i * 8), a); unpack8(*(const uint4*)(OB + (size_t)row * 2048 + col + i * 8), bb);
#pragma unroll
            for (int j = 0; j < 8; ++j) { o[i * 8 + j] = a[j] + bb[j]; ss += o[i * 8 + j] * o[i * 8 + j]; } }
        ss = red4(ss); const float s8 = ss + dppf<0x141>(ss);
        const float rstd = isml ? rsqrtf(s8 * (1.f / 256.f) + 1e-6f) : rsqrtf(ss * (1.f / 128.f) + 1e-6f);
#pragma unroll
        for (int i = 0; i < 4; ++i) { float gt[8], r[8]; unpack8(*(const uint4*)(gsrc + i * 8), gt);
#pragma unroll
            for (int j = 0; j < 8; ++j) { const float gate = isml ? sigmoidf_(gt[j]) : siluf_(gt[j]); r[j] = o[i * 8 + j] * rstd * gn[i * 8 + j] * gate; }
            *(uint4*)(Y + (size_t)row * 2048 + col + i * 8) = pack8(r); }
    }
}

typedef short bf16x8_t __attribute__((ext_vector_type(8)));
typedef float f32x4_t __attribute__((ext_vector_type(4)));
__device__ __forceinline__ float wave_cumsum(float x, int lane) {
#pragma unroll
    for (int o = 1; o < 64; o <<= 1) { const float t = __shfl_up(x, o); if (lane >= o) x += t; }
    return x; }
__device__ __forceinline__ float wave_cummax(float x, int lane) {
#pragma unroll
    for (int o = 1; o < 64; o <<= 1) { const float t = __shfl_up(x, o); if (lane >= o) x = fmaxf(x, t); }
    return x; }
__device__ __forceinline__ int tile_of(int n, int b, int dir) { if (n < 4) return b * 4 + (dir ? 3 - n : n); const int li = n - 4; return 8 + b * 256 + (dir ? 255 - li : li); }
__device__ __forceinline__ int rowbase_of(int tt) { return tt < 8 ? tt * 64 : 512 + (tt - 8) * 64; }

__device__ __forceinline__ void ml_prep_item(const Params& p, int it, float* wl, int lane) {
    const int h = it & 3, tt = (it >> 2) % 520, z = it / 2080, rowbase = rowbase_of(tt), fr = lane & 15, fq = lane >> 4;
    const u16* PROJ = (const u16*)(p.ws + WS_PROJ); const float* G = (const float*)(p.ws + WS_G);
    float* MLS = (float*)(p.ws + WS_MLS) + (size_t)it * 256; u16* ATT0 = (u16*)(p.ws + WS_ATT0) + (size_t)it * 4096;
    const int tk = z ? 63 - lane : lane, row = rowbase + tk;
    const float ig = G[row * 48 + z * 4 + h], lf = G[row * 48 + 8 + z * 4 + h];
    const float bb = wave_cumsum(lf, lane), gg = ig - bb, cm = wave_cummax(gg, lane);
    const float bL = __shfl(bb, 63), cmL = __shfl(cm, 63);
    MLS[tk] = bb; MLS[64 + tk] = cm; MLS[128 + tk] = __expf(gg - cmL); if (lane == 0) { MLS[192] = bL; MLS[193] = cmL; }
    wl[tk] = gg; wl[64 + tk] = cm;
#pragma unroll 1
    for (int rt = 0; rt < 4; ++rt) {
        bf16x8_t a[4];
#pragma unroll
        for (int ks = 0; ks < 4; ++ks) a[ks] = *(const bf16x8_t*)(PROJ + (size_t)(rowbase + rt * 16 + fr) * NP0 + h * 128 + ks * 32 + fq * 8);
#pragma unroll 1
        for (int ct = 0; ct < 4; ++ct) {
            f32x4_t acc = (f32x4_t){0.f, 0.f, 0.f, 0.f};
#pragma unroll
            for (int ks = 0; ks < 4; ++ks) { const bf16x8_t bfr = *(const bf16x8_t*)(PROJ + (size_t)(rowbase + ct * 16 + fr) * NP0 + 512 + h * 128 + ks * 32 + fq * 8);
                acc = __builtin_amdgcn_mfma_f32_16x16x32_bf16(a[ks], bfr, acc, 0, 0, 0); }
            const int s = ct * 16 + fr; const float gs = wl[s];
#pragma unroll
            for (int j = 0; j < 4; ++j) { const int l = rt * 16 + fq * 4 + j; const bool keep = z ? (s >= l) : (s <= l);
                const float e = __expf(fminf(gs - wl[64 + l], 0.f));
                ATT0[l * 64 + s] = f2bf(keep ? acc[j] * 0.08838834764831845f * e : 0.f); }
        }
    }
}
__device__ __forceinline__ void dn_prep_item(const Params& p, int it, float* Ap, int lane) {
    const int h = it & 7, tt = (it >> 3) % 520, z = it / 4160, rowbase = rowbase_of(tt), fr = lane & 15, fq = lane >> 4;
    const bool isctx = tt < 8;
    const u16* qb = isctx ? (const u16*)(p.ws + WS_CQ) + (size_t)rowbase * 3072 + h * 128 : (const u16*)(p.ws + WS_PROJ) + (size_t)rowbase * NP0 + 3072 + h * 128;
    const int rs = isctx ? 3072 : NP0;
    const float* G = (const float*)(p.ws + WS_G);
    float* GCS = (float*)(p.ws + WS_GCS) + (size_t)it * 256; u16* TM = (u16*)(p.ws + WS_TM) + (size_t)it * 4096; u16* QK = (u16*)(p.ws + WS_QK) + (size_t)it * 4096;
    float* gcs = Ap + 4096; float* bes = Ap + 4160;
    const int tk = z ? 63 - lane : lane, row = rowbase + tk;
    const float g = G[row * 48 + 16 + z * 8 + h], be = G[row * 48 + 32 + z * 8 + h];
    const float gc = wave_cumsum(g, lane), gL = __shfl(gc, 63);
    GCS[tk] = __expf(gc); GCS[64 + tk] = be; GCS[128 + tk] = __expf(gL - gc); if (lane == 0) GCS[192] = __expf(gL);
    gcs[tk] = gc; bes[tk] = be;
#pragma unroll 1
    for (int rt = 0; rt < 4; ++rt) {
        bf16x8_t ak[4], aq[4];
#pragma unroll
        for (int ks = 0; ks < 4; ++ks) { ak[ks] = *(const bf16x8_t*)(qb + (size_t)(rt * 16 + fr) * rs + 1024 + ks * 32 + fq * 8); aq[ks] = *(const bf16x8_t*)(qb + (size_t)(rt * 16 + fr) * rs + ks * 32 + fq * 8); }
#pragma unroll 1
        for (int ct = 0; ct < 4; ++ct) {
            f32x4_t ck = (f32x4_t){0.f, 0.f, 0.f, 0.f}, cq = ck;
#pragma unroll
            for (int ks = 0; ks < 4; ++ks) { const bf16x8_t bfr = *(const bf16x8_t*)(qb + (size_t)(ct * 16 + fr) * rs + 1024 + ks * 32 + fq * 8);
                ck = __builtin_amdgcn_mfma_f32_16x16x32_bf16(ak[ks], bfr, ck, 0, 0, 0); cq = __builtin_amdgcn_mfma_f32_16x16x32_bf16(aq[ks], bfr, cq, 0, 0, 0); }
            const int s = ct * 16 + fr; const float gs = gcs[s];
#pragma unroll
            for (int j = 0; j < 4; ++j) { const int l = rt * 16 + fq * 4 + j;
                const bool strict = z ? (s > l) : (s < l), incl = z ? (s >= l) : (s <= l);
                const float e = __expf(fminf(gcs[l] - gs, 0.f));
                const int lp = z ? 63 - l : l, sp = z ? 63 - s : s;
                Ap[lp * 64 + sp] = strict ? bes[l] * ck[j] * e : 0.f;
                QK[l * 64 + s] = f2bf(incl ? cq[j] * 0.08838834764831845f * e : 0.f); }
        }
    }
    Ap[lane] = (lane == 0) ? 1.f : 0.f;
#pragma unroll 1
    for (int i = 1; i < 64; ++i) {
        float t = (i == lane) ? 1.f : 0.f;
#pragma unroll 4
        for (int j = 0; j < i; ++j) t -= Ap[i * 64 + j] * Ap[j * 64 + lane];
        Ap[i * 64 + lane] = t;
    }
    const int sc = z ? 63 - lane : lane;
#pragma unroll 4
    for (int i = 0; i < 64; ++i) { const int l = z ? 63 - i : i; TM[l * 64 + sc] = f2bf(Ap[i * 64 + lane]); }
}
__device__ __forceinline__ void ph_l0_prepass(const Params& p, unsigned char* lds) {
    const int tid = tid_fresh(), lane = tid & 63, w = tid >> 6;
    float* wl = (float*)(lds + (size_t)w * 16896);
    const int gw = blockIdx.x * 8 + w, nw = gridDim.x * 8;
    for (int it = gw; it < 4160; it += nw) ml_prep_item(p, it, wl, lane);
    for (int it = gw; it < 8320; it += nw) dn_prep_item(p, it, wl, lane);
}

struct MlFr { bf16x8_t q[4], at[2]; uint4 kr[2]; uint2 vr; float kw, b[4], cm[4], bL, cmL; };
__device__ __forceinline__ void ml_load(MlFr& F, const Params& p, int n, int b, int h, int dir, int e0, int lt, int fr, int fq, int tl, int seg) {
    const int nn = n < NSEG ? n : NSEG - 1;
    const int tt = tile_of(nn, b, dir), it = (dir * 520 + tt) * 4 + h, rowbase = rowbase_of(tt);
    const u16* PROJ = (const u16*)(p.ws + WS_PROJ);
    const u16* Q = PROJ + (size_t)(rowbase + lt * 16 + fr) * NP0 + h * 128 + fq * 8;
    const u16* AT = (const u16*)(p.ws + WS_ATT0) + (size_t)it * 4096 + (lt * 16 + fr) * 64 + fq * 8;
    const float* MLS = (const float*)(p.ws + WS_MLS) + (size_t)it * 256;
#pragma unroll
    for (int ks = 0; ks < 4; ++ks) F.q[ks] = *(const bf16x8_t*)(Q + ks * 32);
#pragma unroll
    for (int ks = 0; ks < 2; ++ks) F.at[ks] = *(const bf16x8_t*)(AT + ks * 32);
    const u16* kp = PROJ + (size_t)(rowbase + tl) * NP0 + 512 + h * 128 + seg * 16;
    F.kr[0] = *(const uint4*)(kp); F.kr[1] = *(const uint4*)(kp + 8);
    F.vr = *(const uint2*)(PROJ + (size_t)(rowbase + tl) * NP0 + 1024 + h * 256 + e0 + seg * 4);
    F.kw = MLS[128 + tl];
#pragma unroll
    for (int j = 0; j < 4; ++j) { F.b[j] = MLS[lt * 16 + fq * 4 + j]; F.cm[j] = MLS[64 + lt * 16 + fq * 4 + j]; }
    F.bL = MLS[192]; F.cmL = MLS[193];
}
__device__ __forceinline__ void mlstm_chunk(const Params& p, int job, unsigned char* lds) {
    const int tid = tid_fresh(), lane = tid & 63, w = tid >> 6, fr = lane & 15, fq = lane >> 4;
    const int chain = job >> 3, cgp = job & 7;
    const int b = chain >> 3, h = (chain >> 1) & 3, dir = chain & 1;
    const int e0 = cgp * 32, lt = w >> 1, et = w & 1, dt0 = (w >> 1) * 2, tl = tid >> 3, seg = tid & 7;
    u16* Cl = (u16*)lds;
    u16* Ktw = (u16*)(lds + 17952);
    u16* Vt = (u16*)(lds + 17952 + 18432);
    u16* O = (u16*)(p.ws + (dir ? WS_OB : WS_OF));
    __syncthreads();
    for (int i = tid; i < 17952 / 4; i += NTHR) ((unsigned*)Cl)[i] = 0u;
    __syncthreads();
    f32x4_t Cacc[2], nacc; Cacc[0] = (f32x4_t){0.f, 0.f, 0.f, 0.f}; Cacc[1] = Cacc[0]; nacc = Cacc[0];
    float m_in = 0.f;
    bf16x8_t ones;
#pragma unroll
    for (int j = 0; j < 8; ++j) ones[j] = (short)0x3F80;
    MlFr buf[2];
    ml_load(buf[0], p, 0, b, h, dir, e0, lt, fr, fq, tl, seg); ml_load(buf[1], p, 1, b, h, dir, e0, lt, fr, fq, tl, seg);
    for (int n0 = 0; n0 < NSEG; n0 += 2) {
#pragma unroll
        for (int s = 0; s < 2; ++s) {
            const int n = n0 + s;
            const MlFr& F = buf[s];
            const int tt = tile_of(n, b, dir), rowbase = rowbase_of(tt);
            const u16* Ccur = Cl + (n & 1) * (33 * 136); u16* Cnxt = Cl + ((n + 1) & 1) * (33 * 136);
            { float k[16]; unpack8(F.kr[0], k); unpack8(F.kr[1], k + 8);
#pragma unroll
                for (int c = 0; c < 16; ++c) Ktw[(seg * 16 + c) * 72 + tl] = f2bf(k[c] * F.kw);
                Vt[(seg * 4 + 0) * 72 + tl] = (u16)(F.vr.x & 0xffffu); Vt[(seg * 4 + 1) * 72 + tl] = (u16)(F.vr.x >> 16);
                Vt[(seg * 4 + 2) * 72 + tl] = (u16)(F.vr.y & 0xffffu); Vt[(seg * 4 + 3) * 72 + tl] = (u16)(F.vr.y >> 16); }
            __syncthreads();
            bf16x8_t vt[2];
#pragma unroll
            for (int ks = 0; ks < 2; ++ks) vt[ks] = *(const bf16x8_t*)(Vt + (et * 16 + fr) * 72 + ks * 32 + fq * 8);
            {
                f32x4_t inter = (f32x4_t){0.f, 0.f, 0.f, 0.f}, intra = inter, dinter = inter, dintra = inter;
#pragma unroll
                for (int ks = 0; ks < 4; ++ks) { const bf16x8_t cb = *(const bf16x8_t*)(Ccur + (et * 16 + fr) * 136 + ks * 32 + fq * 8); const bf16x8_t nb = *(const bf16x8_t*)(Ccur + 32 * 136 + ks * 32 + fq * 8);
                    inter = __builtin_amdgcn_mfma_f32_16x16x32_bf16(F.q[ks], cb, inter, 0, 0, 0); dinter = __builtin_amdgcn_mfma_f32_16x16x32_bf16(F.q[ks], nb, dinter, 0, 0, 0); }
#pragma unroll
                for (int ks = 0; ks < 2; ++ks) { intra = __builtin_amdgcn_mfma_f32_16x16x32_bf16(F.at[ks], vt[ks], intra, 0, 0, 0); dintra = __builtin_amdgcn_mfma_f32_16x16x32_bf16(F.at[ks], ones, dintra, 0, 0, 0); }
#pragma unroll
                for (int j = 0; j < 4; ++j) { const float M = fmaxf(F.cm[j], m_in); const float r = __expf(F.cm[j] - M), ei = __expf(m_in - M) * 0.08838834764831845f;
                    const float num = r * intra[j] + ei * inter[j], den = r * dintra[j] + ei * dinter[j];
                    const float hv = num / fmaxf(fabsf(den), __expf(-(F.b[j] + M)));
                    O[(size_t)(rowbase + lt * 16 + fq * 4 + j) * 2048 + h * 256 + e0 + et * 16 + fr] = f2bf(hv); }
            }
            { const float ML = fmaxf(F.cmL, m_in); const float a = __expf(m_in - ML), sc2 = __expf(F.cmL - ML); m_in = F.bL + ML;
#pragma unroll
                for (int i = 0; i < 2; ++i) { f32x4_t nw = (f32x4_t){0.f, 0.f, 0.f, 0.f};
#pragma unroll
                    for (int ks = 0; ks < 2; ++ks) { const bf16x8_t kb = *(const bf16x8_t*)(Ktw + ((dt0 + i) * 16 + fr) * 72 + ks * 32 + fq * 8); nw = __builtin_amdgcn_mfma_f32_16x16x32_bf16(vt[ks], kb, nw, 0, 0, 0); }
#pragma unroll
                    for (int j = 0; j < 4; ++j) { Cacc[i][j] = a * Cacc[i][j] + sc2 * nw[j]; Cnxt[(et * 16 + fq * 4 + j) * 136 + (dt0 + i) * 16 + fr] = f2bf(Cacc[i][j]); } }
                f32x4_t nw = (f32x4_t){0.f, 0.f, 0.f, 0.f};
#pragma unroll
                for (int ks = 0; ks < 2; ++ks) { const bf16x8_t kb = *(const bf16x8_t*)(Ktw + (w * 16 + fr) * 72 + ks * 32 + fq * 8); nw = __builtin_amdgcn_mfma_f32_16x16x32_bf16(ones, kb, nw, 0, 0, 0); }
                nacc[0] = a * nacc[0] + sc2 * nw[0];
                if (fq == 0) Cnxt[32 * 136 + w * 16 + fr] = f2bf(nacc[0]); }
            __syncthreads();
            ml_load(buf[s], p, n + 2, b, h, dir, e0, lt, fr, fq, tl, seg);
        }
    }
}

struct DnFr { bf16x8_t k[4], q[4], tm[2], qk[2]; uint4 kr[2]; float kds, egc[4], be[4], egL; u16 v[4]; };
__device__ __forceinline__ void dn_load(DnFr& F, const Params& p, int n, int b, int h, int dir, int e0, int lt, int et, int fr, int fq, int tl, int seg) {
    const int nn = n < NSEG ? n : NSEG - 1;
    const int tt = tile_of(nn, b, dir), it = (dir * 520 + tt) * 8 + h, rowbase = rowbase_of(tt);
    const bool isctx = tt < 8;
    const u16* qb = isctx ? (const u16*)(p.ws + WS_CQ) + (size_t)rowbase * 3072 + h * 128 : (const u16*)(p.ws + WS_PROJ) + (size_t)rowbase * NP0 + 3072 + h * 128;
    const int rs = isctx ? 3072 : NP0;
    const u16* TM = (const u16*)(p.ws + WS_TM) + (size_t)it * 4096 + (lt * 16 + fr) * 64 + fq * 8;
    const u16* QK = (const u16*)(p.ws + WS_QK) + (size_t)it * 4096 + (lt * 16 + fr) * 64 + fq * 8;
    const float* GCS = (const float*)(p.ws + WS_GCS) + (size_t)it * 256;
    const u16* qr = qb + (size_t)(lt * 16 + fr) * rs + fq * 8;
#pragma unroll
    for (int ks = 0; ks < 4; ++ks) { F.q[ks] = *(const bf16x8_t*)(qr + ks * 32); F.k[ks] = *(const bf16x8_t*)(qr + 1024 + ks * 32); }
#pragma unroll
    for (int ks = 0; ks < 2; ++ks) { F.tm[ks] = *(const bf16x8_t*)(TM + ks * 32); F.qk[ks] = *(const bf16x8_t*)(QK + ks * 32); }
    const u16* kp = qb + (size_t)tl * rs + 1024 + seg * 16;
    F.kr[0] = *(const uint4*)(kp); F.kr[1] = *(const uint4*)(kp + 8);
    F.kds = GCS[128 + tl]; F.egL = GCS[192];
#pragma unroll
    for (int j = 0; j < 4; ++j) { const int l = lt * 16 + fq * 4 + j; F.egc[j] = GCS[l]; F.be[j] = GCS[64 + l]; F.v[j] = qb[(size_t)l * rs + 2048 + e0 + et * 16 + fr]; }
}
__device__ __forceinline__ void deltanet_chunk(const Params& p, int job, unsigned char* lds) {
    const int tid = tid_fresh(), lane = tid & 63, w = tid >> 6, fr = lane & 15, fq = lane >> 4;
    const int chain = job >> 2, cgp = job & 3;
    const int b = chain >> 4, h = (chain >> 1) & 7, dir = chain & 1;
    const int e0 = cgp * 32, lt = w >> 1, et = w & 1, dt0 = (w >> 1) * 2, tl = tid >> 3, seg = tid & 7;
    u16* Sl = (u16*)lds;
    u16* Rt = (u16*)(lds + 17408);
    u16* VNt = (u16*)(lds + 17408 + 4608);
    u16* Kdt = (u16*)(lds + 17408 + 9216);
    u16* O = (u16*)(p.ws + (dir ? WS_OB : WS_OF));
    __syncthreads();
    for (int i = tid; i < 17408 / 4; i += NTHR) ((unsigned*)Sl)[i] = 0u;
    __syncthreads();
    f32x4_t Sacc[2]; Sacc[0] = (f32x4_t){0.f, 0.f, 0.f, 0.f}; Sacc[1] = Sacc[0];
    DnFr buf[2];
    dn_load(buf[0], p, 0, b, h, dir, e0, lt, et, fr, fq, tl, seg); dn_load(buf[1], p, 1, b, h, dir, e0, lt, et, fr, fq, tl, seg);
    for (int n0 = 0; n0 < NSEG; n0 += 2) {
#pragma unroll
        for (int s = 0; s < 2; ++s) {
            const int n = n0 + s;
            const DnFr& F = buf[s];
            const int tt = tile_of(n, b, dir), rowbase = rowbase_of(tt);
            const u16* Scur = Sl + (n & 1) * (32 * 136); u16* Snxt = Sl + ((n + 1) & 1) * (32 * 136);
            f32x4_t X = (f32x4_t){0.f, 0.f, 0.f, 0.f}, Y = X;
#pragma unroll
            for (int ks = 0; ks < 4; ++ks) { const bf16x8_t sb = *(const bf16x8_t*)(Scur + (et * 16 + fr) * 136 + ks * 32 + fq * 8);
                X = __builtin_amdgcn_mfma_f32_16x16x32_bf16(F.k[ks], sb, X, 0, 0, 0); Y = __builtin_amdgcn_mfma_f32_16x16x32_bf16(F.q[ks], sb, Y, 0, 0, 0); }
#pragma unroll
            for (int j = 0; j < 4; ++j) Rt[(et * 16 + fr) * 72 + lt * 16 + fq * 4 + j] = f2bf(F.be[j] * (bf2f(F.v[j]) - F.egc[j] * X[j]));
            { float k[16]; unpack8(F.kr[0], k); unpack8(F.kr[1], k + 8);
#pragma unroll
                for (int c = 0; c < 16; ++c) Kdt[(seg * 16 + c) * 72 + tl] = f2bf(k[c] * F.kds); }
            __syncthreads();
            { f32x4_t VN = (f32x4_t){0.f, 0.f, 0.f, 0.f};
#pragma unroll
                for (int ks = 0; ks < 2; ++ks) { const bf16x8_t rb = *(const bf16x8_t*)(Rt + (et * 16 + fr) * 72 + ks * 32 + fq * 8); VN = __builtin_amdgcn_mfma_f32_16x16x32_bf16(F.tm[ks], rb, VN, 0, 0, 0); }
#pragma unroll
                for (int j = 0; j < 4; ++j) VNt[(et * 16 + fr) * 72 + lt * 16 + fq * 4 + j] = f2bf(VN[j]); }
            __syncthreads();
            bf16x8_t vn[2];
#pragma unroll
            for (int ks = 0; ks < 2; ++ks) vn[ks] = *(const bf16x8_t*)(VNt + (et * 16 + fr) * 72 + ks * 32 + fq * 8);
            { f32x4_t acc = (f32x4_t){0.f, 0.f, 0.f, 0.f};
#pragma unroll
                for (int ks = 0; ks < 2; ++ks) acc = __builtin_amdgcn_mfma_f32_16x16x32_bf16(F.qk[ks], vn[ks], acc, 0, 0, 0);
#pragma unroll
                for (int j = 0; j < 4; ++j) O[(size_t)(rowbase + lt * 16 + fq * 4 + j) * 2048 + 1024 + h * 128 + e0 + et * 16 + fr] = f2bf(0.08838834764831845f * F.egc[j] * Y[j] + acc[j]); }
#pragma unroll
            for (int i = 0; i < 2; ++i) { f32x4_t nw = (f32x4_t){0.f, 0.f, 0.f, 0.f};
#pragma unroll
                for (int ks = 0; ks < 2; ++ks) { const bf16x8_t kb = *(const bf16x8_t*)(Kdt + ((dt0 + i) * 16 + fr) * 72 + ks * 32 + fq * 8); nw = __builtin_amdgcn_mfma_f32_16x16x32_bf16(vn[ks], kb, nw, 0, 0, 0); }
#pragma unroll
                for (int j = 0; j < 4; ++j) { Sacc[i][j] = F.egL * Sacc[i][j] + nw[j]; Snxt[(et * 16 + fq * 4 + j) * 136 + (dt0 + i) * 16 + fr] = f2bf(Sacc[i][j]); } }
            __syncthreads();
            dn_load(buf[s], p, n + 2, b, h, dir, e0, lt, et, fr, fq, tl, seg);
        }
    }
}

constexpr int RG_A = 0, RG_BX = 32768, RG_XC = 65536, RG_WT = 82944;

__device__ __forceinline__ int rg_tau(int tt, int z) { if (tt < 8) { const int ci = tt & 3; return z ? 3 - ci : ci; } const int li = (tt - 8) & 255; return 4 + (z ? 255 - li : li); }
__device__ __forceinline__ int rg_batch(int tt) { return tt < 8 ? (tt >> 2) : ((tt - 8) >> 8); }

__device__ __forceinline__ void rg_conv(const Params& p, int tt, int g, unsigned char* lds) {
    const int tid = tid_fresh();
    const u16* PROJ = (const u16*)(p.ws + WS_PROJ);
    float* sm = (float*)lds; u16* XC = (u16*)(lds + RG_XC);
    const bool isctx = tt < 8;
    const int t0 = isctx ? (tt & 3) * 64 : 0;
    const int rowbase = isctx ? (tt >> 2) * 256 + t0 : 512 + (tt - 8) * 64;
    __syncthreads();
    for (int ch = tid; ch < 68 * 16; ch += NTHR) {
        const int rr = ch >> 4, c8 = (ch & 15) * 8, r = rr - 2;
        const bool ok = isctx ? (t0 + r >= 0 && t0 + r < 256) : (r >= 0 && r < 64);
        float f[8];
#pragma unroll
        for (int j = 0; j < 8; ++j) f[j] = 0.f;
        if (ok) { const uint4 u = *(const uint4*)(PROJ + (size_t)(rowbase + r) * NP1 + g * 128 + c8); unpack8(u, f); }
        float* d = sm + rr * 132 + c8;
        *(float4*)(d) = make_float4(f[0], f[1], f[2], f[3]); *(float4*)(d + 4) = make_float4(f[4], f[5], f[6], f[7]);
    }
    __syncthreads();
    const int tk = tid >> 3, cs = (tid & 7) * 16;
    float o[16];
#pragma unroll
    for (int c4 = 0; c4 < 4; ++c4) { const float4 b4 = *(const float4*)(p.rg_conv_b + g * 128 + cs + c4 * 4); o[c4 * 4] = b4.x; o[c4 * 4 + 1] = b4.y; o[c4 * 4 + 2] = b4.z; o[c4 * 4 + 3] = b4.w; }
#pragma unroll
    for (int j = 0; j < 5; ++j) {
        const float* wr_ = p.rg_conv_w + j * 1024 + g * 128 + cs; const float* ir = sm + (tk + j) * 132 + cs;
#pragma unroll
        for (int c4 = 0; c4 < 4; ++c4) { const float4 w4 = *(const float4*)(wr_ + c4 * 4), i4 = *(const float4*)(ir + c4 * 4);
            o[c4 * 4 + 0] += i4.x * w4.x; o[c4 * 4 + 1] += i4.y * w4.y; o[c4 * 4 + 2] += i4.z * w4.z; o[c4 * 4 + 3] += i4.w * w4.w; }
    }
    *(uint4*)(XC + tk * 136 + cs) = pack8(o); *(uint4*)(XC + tk * 136 + cs + 8) = pack8(o + 8);
    __syncthreads();
}
__device__ __forceinline__ void rg_load_w(const float* W, unsigned char* lds) {
    u16* WT = (u16*)(lds + RG_WT); const int tid = tid_fresh();
#pragma unroll 4
    for (int it = 0; it < 32; ++it) { const int idx = it * NTHR + tid, i = idx >> 7, j = idx & 127; WT[j * 136 + i] = f2bf(W[idx]); }
}
__device__ __forceinline__ void rg_mma(unsigned char* lds, int rt, int chh, int lane, f32x4_t (&acc)[4]) {
    const u16* XC = (const u16*)(lds + RG_XC); const u16* WT = (const u16*)(lds + RG_WT);
    const int fr = lane & 15, fq = lane >> 4;
#pragma unroll
    for (int ks = 0; ks < 4; ++ks) {
        const bf16x8_t a = *(const bf16x8_t*)(XC + (rt * 16 + fr) * 136 + ks * 32 + fq * 8);
#pragma unroll
        for (int c = 0; c < 4; ++c) { const bf16x8_t bb = *(const bf16x8_t*)(WT + ((chh * 4 + c) * 16 + fr) * 136 + ks * 32 + fq * 8);
            acc[c] = __builtin_amdgcn_mfma_f32_16x16x32_bf16(a, bb, acc[c], 0, 0, 0); }
    }
}
__device__ __forceinline__ void rg_gates(const Params& p, int g, int z, unsigned char* lds, float* bxdst, bool sync_before_bx) {
    const int tid = tid_fresh(), lane = tid & 63, w = tid >> 6, rt = w >> 1, chh = w & 1, fr = lane & 15, fq = lane >> 4;
    float* A = (float*)(lds + RG_A); const u16* XC = (const u16*)(lds + RG_XC);
    f32x4_t R[4], I[4];
#pragma unroll
    for (int c = 0; c < 4; ++c) { R[c] = (f32x4_t){0.f, 0.f, 0.f, 0.f}; I[c] = (f32x4_t){0.f, 0.f, 0.f, 0.f}; }
    rg_load_w(p.rg_w_r + (size_t)(z * 8 + g) * 16384, lds);
    __syncthreads();
    rg_mma(lds, rt, chh, lane, R);
    __syncthreads();
    rg_load_w(p.rg_w_i + (size_t)(z * 8 + g) * 16384, lds);
    __syncthreads();
    rg_mma(lds, rt, chh, lane, I);
    if (sync_before_bx) __syncthreads();
#pragma unroll
    for (int c = 0; c < 4; ++c) {
        const int chl = (chh * 4 + c) * 16 + fr, chg = z * 1024 + g * 128 + chl;
        const float br = p.rg_b_r[chg], bi = p.rg_b_i[chg], sp = softplusf_(-p.rg_lambda[chg]);
#pragma unroll
        for (int j = 0; j < 4; ++j) { const int t = rt * 16 + fq * 4 + j;
            const float r = sigmoidf_(R[c][j] + br), ii = sigmoidf_(I[c][j] + bi);
            const float la = -8.f * r * sp; const float a = __expf(la);
            const float bx = sqrtf(-expm1f(2.f * la)) * ii * bf2f(XC[t * 136 + chl]);
            A[t * 128 + chl] = a; bxdst[t * 128 + chl] = bx; }
    }
    __syncthreads();
}
__device__ __forceinline__ void gla_prep_item(const Params& p, int it, unsigned char* lds) {
    const int tid = tid_fresh(), lane = tid & 63, w = tid >> 6, fr = lane & 15, fq = lane >> 4;
    const int h = it & 3, tt = (it >> 2) % 520, z = it / 2080;
    const int rowbase = tt < 8 ? tt * 64 : 512 + (tt - 8) * 64;
    float* LG = (float*)lds;
    u16* QEs = (u16*)(lds + 32768);
    u16* KEs = (u16*)(lds + 32768 + 17408);
    u16* Vs = (u16*)(lds + 32768 + 2 * 17408);
    float* BLs = (float*)(lds + 32768 + 2 * 17408 + 33792);
    const u16* PROJ = (const u16*)(p.ws + WS_PROJ); const float* LR = (const float*)(p.ws + WS_G);
    u16* QE = (u16*)(p.ws + WS_QE); u16* KDT = (u16*)(p.ws + WS_KDT) + (size_t)it * 8192; u16* ATT = (u16*)(p.ws + WS_ATT) + (size_t)it * 4096;
    u16* VT = (u16*)(p.ws + WS_VT); float* EBL = (float*)(p.ws + WS_EBL);
    __syncthreads();
    { const int c = tid & 127, tq = tid >> 7; float wv[16];
#pragma unroll
        for (int r = 0; r < 16; ++r) wv[r] = p.gla_w_up[(z * 16 + r) * 512 + h * 128 + c];
        const float bu = p.gla_b_up[z * 512 + h * 128 + c];
        for (int i = 0; i < 16; ++i) { const int tk = tq * 16 + i; const float* lr = LR + (size_t)(rowbase + tk) * 32 + z * 16; float s = bu;
#pragma unroll
            for (int r = 0; r < 16; ++r) s += lr[r] * wv[r];
            LG[tk * 128 + c] = logsigmoidf_(s) * (1.f / 16.f); } }
    __syncthreads();
    if (tid < 128) { float acc = 0.f;
        for (int i = 0; i < 64; ++i) { const int tk = z ? 63 - i : i; acc += LG[tk * 128 + tid]; LG[tk * 128 + tid] = acc; }
        BLs[tid] = acc; EBL[(size_t)it * 128 + tid] = __expf(acc); }
    __syncthreads();
    { const int tk = tid >> 3, cs = (tid & 7) * 16; const u16* rp = PROJ + (size_t)(rowbase + tk) * NP1;
        float q[16], k[16], qe[16], ke[16];
        unpack8(*(const uint4*)(rp + 2048 + h * 128 + cs), q); unpack8(*(const uint4*)(rp + 2048 + h * 128 + cs + 8), q + 8);
        unpack8(*(const uint4*)(rp + 2560 + h * 128 + cs), k); unpack8(*(const uint4*)(rp + 2560 + h * 128 + cs + 8), k + 8);
#pragma unroll
        for (int c = 0; c < 16; ++c) { const float bb = LG[tk * 128 + cs + c], bl = BLs[cs + c];
            qe[c] = q[c] * 0.08838834764831845f * __expf(bb); ke[c] = k[c] * __expf(-bb); KDT[(cs + c) * 64 + tk] = f2bf(k[c] * __expf(bl - bb)); }
        const uint4 q0 = pack8(qe), q1 = pack8(qe + 8);
        *(uint4*)(QEs + tk * 136 + cs) = q0; *(uint4*)(QEs + tk * 136 + cs + 8) = q1;
        *(uint4*)(KEs + tk * 136 + cs) = pack8(ke); *(uint4*)(KEs + tk * 136 + cs + 8) = pack8(ke + 8);
        u16* qg = QE + ((size_t)z * MTOT + rowbase + tk) * 512 + h * 128 + cs;
        *(uint4*)(qg) = q0; *(uint4*)(qg + 8) = q1; }
    if (z == 0) for (int ch = tid; ch < 2048; ch += NTHR) { const int tk = ch >> 5, c8 = (ch & 31) * 8;
        *(uint4*)(Vs + tk * 264 + c8) = *(const uint4*)(PROJ + (size_t)(rowbase + tk) * NP1 + 3072 + h * 256 + c8); }
    __syncthreads();
    { const int rt = w >> 1;
#pragma unroll
        for (int i = 0; i < 2; ++i) { const int ct = (w & 1) * 2 + i; f32x4_t acc = (f32x4_t){0.f, 0.f, 0.f, 0.f};
#pragma unroll
            for (int ks = 0; ks < 4; ++ks) { const bf16x8_t a = *(const bf16x8_t*)(QEs + (rt * 16 + fr) * 136 + ks * 32 + fq * 8); const bf16x8_t bb = *(const bf16x8_t*)(KEs + (ct * 16 + fr) * 136 + ks * 32 + fq * 8);
                acc = __builtin_amdgcn_mfma_f32_16x16x32_bf16(a, bb, acc, 0, 0, 0); }
#pragma unroll
            for (int j = 0; j < 4; ++j) { const int l = rt * 16 + fq * 4 + j, s = ct * 16 + fr; const bool keep = z ? (s >= l) : (s <= l);
                ATT[l * 64 + s] = f2bf(keep ? acc[j] : 0.f); } } }
    if (z == 0) { const int e = tid >> 1, hf = tid & 1; u16* dst = VT + ((size_t)(tt * 4 + h) * 256 + e) * 64 + hf * 32;
#pragma unroll
        for (int l8 = 0; l8 < 4; ++l8) { float v[8];
#pragma unroll
            for (int j = 0; j < 8; ++j) v[j] = bf2f(Vs[(hf * 32 + l8 * 8 + j) * 264 + e]);
            *(uint4*)(dst + l8 * 8) = pack8(v); } }
}
__device__ __forceinline__ void ph_l1_a(const Params& p, unsigned char* lds) {
    const int tid = tid_fresh();
    float2* AGG = (float2*)(p.ws + WS_AGG);
    float* A = (float*)(lds + RG_A); float* BX = (float*)(lds + RG_BX);
    for (int t = blockIdx.x; t < 520 * 8; t += gridDim.x) {
        const int tt = t >> 3, g = t & 7, b = rg_batch(tt);
        rg_conv(p, tt, g, lds);
#pragma unroll 1
        for (int z = 0; z < 2; ++z) {
            rg_gates(p, g, z, lds, BX, false);
            if (tid < 128) { float h = 0.f, P = 1.f;
                for (int i = 0; i < 64; ++i) { const int tk = z ? 63 - i : i; const float a = A[tk * 128 + tid]; h = a * h + BX[tk * 128 + tid]; P *= a; }
                AGG[((size_t)(b * 2 + z) * NSEG + rg_tau(tt, z)) * 1024 + g * 128 + tid] = make_float2(P, h); }
            __syncthreads();
        }
    }
    for (int it = blockIdx.x; it < 4160; it += gridDim.x) gla_prep_item(p, it, lds);
}
__device__ __forceinline__ void rg_pass_b(const Params& p, int job) {
    const float2* AGG = (const float2*)(p.ws + WS_AGG); float* CARRY = (float*)(p.ws + WS_CARRY);
    const int bz = job >> 1, ch = (job & 1) * 512 + tid_fresh();
    float carry = 0.f;
#pragma unroll 4
    for (int tau = 0; tau < NSEG; ++tau) { const size_t ix = ((size_t)bz * NSEG + tau) * 1024 + ch; const float2 ph = AGG[ix]; CARRY[ix] = carry; carry = ph.x * carry + ph.y; }
}
struct GlaFr { bf16x8_t qe[4], at[2], vt[2], kd[2][2]; float eb[2]; };
__device__ __forceinline__ void gla_load(GlaFr& F, const Params& p, int n, int b, int h, int dir, int e0, int lt, int et, int dt0, int fr, int fq) {
    const int nn = n < NSEG ? n : NSEG - 1;
    const int tt = tile_of(nn, b, dir), it = (dir * 520 + tt) * 4 + h, rowbase = tt < 8 ? tt * 64 : 512 + (tt - 8) * 64;
    const u16* QE = (const u16*)(p.ws + WS_QE) + ((size_t)dir * MTOT + rowbase + lt * 16 + fr) * 512 + h * 128 + fq * 8;
    const u16* ATT = (const u16*)(p.ws + WS_ATT) + (size_t)it * 4096 + (lt * 16 + fr) * 64 + fq * 8;
    const u16* VT = (const u16*)(p.ws + WS_VT) + ((size_t)(tt * 4 + h) * 256 + e0 + et * 16 + fr) * 64 + fq * 8;
    const u16* KDT = (const u16*)(p.ws + WS_KDT) + (size_t)it * 8192 + (dt0 * 16 + fr) * 64 + fq * 8;
    const float* EBL = (const float*)(p.ws + WS_EBL) + (size_t)it * 128 + dt0 * 16 + fr;
#pragma unroll
    for (int ks = 0; ks < 4; ++ks) F.qe[ks] = *(const bf16x8_t*)(QE + ks * 32);
#pragma unroll
    for (int ks = 0; ks < 2; ++ks) { F.at[ks] = *(const bf16x8_t*)(ATT + ks * 32); F.vt[ks] = *(const bf16x8_t*)(VT + ks * 32);
        F.kd[0][ks] = *(const bf16x8_t*)(KDT + ks * 32); F.kd[1][ks] = *(const bf16x8_t*)(KDT + 16 * 64 + ks * 32); }
    F.eb[0] = EBL[0]; F.eb[1] = EBL[16];
}
__device__ __forceinline__ void gla_chunk(const Params& p, int job, unsigned char* lds) {
    const int tid = tid_fresh(), lane = tid & 63, w = tid >> 6, fr = lane & 15, fq = lane >> 4;
    const int chain = job >> 3, cgp = job & 7;
    const int b = chain >> 3, h = (chain >> 1) & 3, dir = chain & 1;
    const int e0 = cgp * 32, lt = w >> 1, et = w & 1, dt0 = (w >> 1) * 2;
    u16* Sl = (u16*)lds;
    u16* O = (u16*)(p.ws + (dir ? WS_OB1 : WS_OF1));
    __syncthreads();
    for (int i = tid; i < 2 * 32 * 136 / 2; i += NTHR) ((unsigned*)Sl)[i] = 0u;
    __syncthreads();
    f32x4_t Sacc[2]; Sacc[0] = (f32x4_t){0.f, 0.f, 0.f, 0.f}; Sacc[1] = Sacc[0];
    GlaFr buf[3];
#pragma unroll
    for (int s = 0; s < 3; ++s) gla_load(buf[s], p, s, b, h, dir, e0, lt, et, dt0, fr, fq);
    for (int n0 = 0; n0 < NSEG + 2; n0 += 3) {
#pragma unroll
        for (int s = 0; s < 3; ++s) {
            const int n = n0 + s;
            if (n < NSEG) {
                const GlaFr& F = buf[s];
                const u16* Scur = Sl + (n & 1) * (32 * 136); u16* Snxt = Sl + ((n + 1) & 1) * (32 * 136);
                if (n >= 4) {
                    const int tt = tile_of(n, b, dir), rowbase = 512 + (tt - 8) * 64;
                    f32x4_t acc = (f32x4_t){0.f, 0.f, 0.f, 0.f};
#pragma unroll
                    for (int ks = 0; ks < 4; ++ks) { const bf16x8_t bb = *(const bf16x8_t*)(Scur + (et * 16 + fr) * 136 + ks * 32 + fq * 8); acc = __builtin_amdgcn_mfma_f32_16x16x32_bf16(F.qe[ks], bb, acc, 0, 0, 0); }
#pragma unroll
                    for (int ks = 0; ks < 2; ++ks) acc = __builtin_amdgcn_mfma_f32_16x16x32_bf16(F.at[ks], F.vt[ks], acc, 0, 0, 0);
#pragma unroll
                    for (int j = 0; j < 4; ++j) O[(size_t)(rowbase + lt * 16 + fq * 4 + j) * 1024 + h * 256 + e0 + et * 16 + fr] = f2bf(acc[j]);
                }
#pragma unroll
                for (int i = 0; i < 2; ++i) { f32x4_t nw = (f32x4_t){0.f, 0.f, 0.f, 0.f};
#pragma unroll
                    for (int ks = 0; ks < 2; ++ks) nw = __builtin_amdgcn_mfma_f32_16x16x32_bf16(F.vt[ks], F.kd[i][ks], nw, 0, 0, 0);
#pragma unroll
                    for (int j = 0; j < 4; ++j) { Sacc[i][j] = F.eb[i] * Sacc[i][j] + nw[j]; Snxt[(et * 16 + fq * 4 + j) * 136 + (dt0 + i) * 16 + fr] = f2bf(Sacc[i][j]); } }
                __syncthreads();
            }
            gla_load(buf[s], p, n + 3, b, h, dir, e0, lt, et, dt0, fr, fq);
        }
    }
}
__device__ __forceinline__ void ph_l1_c(const Params& p, unsigned char* lds) {
    const int tid = tid_fresh();
    const u16* PROJ = (const u16*)(p.ws + WS_PROJ); const float* CARRY = (const float*)(p.ws + WS_CARRY); u16* Y = (u16*)(p.ws + WS_H);
    float* A = (float*)(lds + RG_A); float* BX = (float*)(lds + RG_BX); float* BX2 = (float*)(lds + RG_WT);
    for (int t = blockIdx.x + 64; t < 520 * 8; t += gridDim.x) {
        const int tt = t >> 3, g = t & 7, b = rg_batch(tt);
        const int rowbase = 512 + (tt - 8) * 64;
        rg_conv(p, tt, g, lds);
        rg_gates(p, g, 0, lds, BX, false);
        if (tid < 128) { float h = CARRY[((size_t)(b * 2 + 0) * NSEG + rg_tau(tt, 0)) * 1024 + g * 128 + tid];
            for (int i = 0; i < 64; ++i) { h = A[i * 128 + tid] * h + BX[i * 128 + tid]; BX[i * 128 + tid] = h; } }
        __syncthreads();
        rg_gates(p, g, 1, lds, BX2, true);
        if (tid < 128) { float h = CARRY[((size_t)(b * 2 + 1) * NSEG + rg_tau(tt, 1)) * 1024 + g * 128 + tid];
            for (int i = 63; i >= 0; --i) { h = A[i * 128 + tid] * h + BX2[i * 128 + tid];
                const float gr = bf2f(PROJ[(size_t)(rowbase + i) * NP1 + 1024 + g * 128 + tid]);
                Y[(size_t)(rowbase + i) * 2048 + g * 128 + tid] = f2bf(gelu_tanh(gr) * (BX[i * 128 + tid] + h)); } }
        __syncthreads();
    }
    const int lane = tid & 63, w = tid >> 6;
    const u16* OF = (const u16*)(p.ws + WS_OF1); const u16* OB = (const u16*)(p.ws + WS_OB1);
    for (int row = 512 + blockIdx.x * 8 + w; row < MTOT; row += gridDim.x * 8) {
        const int col = lane * 16; float o[16]; float ss = 0.f;
#pragma unroll
        for (int i = 0; i < 2; ++i) { float a[8], bb[8]; unpack8(*(const uint4*)(OF + (size_t)row * 1024 + col + i * 8), a); unpack8(*(const uint4*)(OB + (size_t)row * 1024 + col + i * 8), bb);
#pragma unroll
            for (int j = 0; j < 8; ++j) { o[i * 8 + j] = a[j] + bb[j]; ss += o[i * 8 + j] * o[i * 8 + j]; } }
        ss = red16(ss);
        const float rstd = rsqrtf(ss * (1.f / 256.f) + 1e-6f);
#pragma unroll
        for (int i = 0; i < 2; ++i) { float gt[8], r[8]; unpack8(*(const uint4*)(PROJ + (size_t)row * NP1 + 4096 + col + i * 8), gt);
#pragma unroll
            for (int j = 0; j < 8; ++j) r[j] = o[i * 8 + j] * rstd * p.gla_norm_g[col + i * 8 + j] * siluf_(gt[j]);
            *(uint4*)(Y + (size_t)row * 2048 + 1024 + col + i * 8) = pack8(r); }
    }
}

constexpr int LDS_BYTES = 135168;

__global__ void __launch_bounds__(NTHR, 2) hybrid_fwd(Params p) {
    extern __shared__ __attribute__((aligned(16))) unsigned char lds[];
    cg::grid_group grid = cg::this_grid();
    float* smf = (float*)lds;
    PG8_LAS unsigned char* ldsg = (PG8_LAS unsigned char*)lds;
    unsigned char* ws = p.ws;
    u16* WT_IN = (u16*)(ws + WS_WT_IN); u16* WT_OUT = (u16*)(ws + WS_WT_OUT); u16* WT_GU = (u16*)(ws + WS_WT_GU); u16* WT_DN = (u16*)(ws + WS_WT_DN);
    u16* H = (u16*)(ws + WS_H); u16* PROJ = (u16*)(ws + WS_PROJ); float* XC = (float*)(ws + WS_XC); float* G = (float*)(ws + WS_G);
    const float* MOD = (const float*)(ws + WS_MOD);
    const int GD = (int)gridDim.x, bid = (int)blockIdx.x;

    ph_adaln_partials(p, smf);
    ph_convert<1>(p.ab_w_in, 7216, 2048, 7424, WT_IN, smf);
    ph_convert<0>(p.ab_w_out, 2048, 2048, 2048, WT_OUT, smf);
    ph_convert<2>(p.ffn_w_gu, 11264, 2048, 11264, WT_GU, smf);
    ph_convert<0>(p.ffn_w_down, 2048, 5632, 2048, WT_DN, smf);
    grid.sync();
    ph_adaln_reduce(p);
    grid.sync();

    ph_norm(p.ctx, p.x, p.norm_mix_g, MOD, 0, 1, H, 0);
    grid.sync();
    { pg8::Gemm g{H, WT_IN, MTOT, 7424, 2048}; pg8::StaticOrder S; S.init(MTOT, 7424, GD, bid);
      pg8::EpiProj E{PROJ, NP0, 28, G, NG0, NG0}; pg8::gemm_phase<pg8::EpiProj, pg8::StaticOrder>(ldsg, g, S, E); }
    grid.sync();
    ph_l0_prep(p, smf);
    grid.sync();
    ph_l0_prepass(p, lds);
    grid.sync();
    for (int job = bid; job < 256; job += GD) { if (job < 128) mlstm_chunk(p, job, lds); else deltanet_chunk(p, job - 128, lds); }
    grid.sync();
    ph_l0_merge(p);
    grid.sync();
    { pg8::Gemm g{H, WT_OUT, MTOT, 2048, 2048}; pg8::StaticOrder S; S.init(MTOT, 2048, GD, bid);
      pg8::EpiRes E{p.ctx, p.x, XC, p.out, MOD + 2 * 2048, 0}; pg8::gemm_phase<pg8::EpiRes, pg8::StaticOrder>(ldsg, g, S, E); }
    grid.sync();
    ph_norm(XC, p.out, p.norm_ffn_g, MOD, 3, 4, H, 0);
    grid.sync();
    { pg8::Gemm g{H, WT_GU, MTOT, 11264, 2048}; pg8::StaticOrder S; S.init(MTOT, 11264, GD, bid);
      pg8::EpiSwiglu E{PROJ, FH}; pg8::gemm_phase<pg8::EpiSwiglu, pg8::StaticOrder>(ldsg, g, S, E); }
    grid.sync();
    { pg8::Gemm g{PROJ, WT_DN, MTOT, 2048, 5632}; pg8::StaticOrder S; S.init(MTOT, 2048, GD, bid);
      pg8::EpiRes E{XC, p.out, XC, p.out, MOD + 5 * 2048, 0}; pg8::gemm_phase<pg8::EpiRes, pg8::StaticOrder>(ldsg, g, S, E); }
    grid.sync();

    const float* MOD1 = MOD + 3 * 12288;
    ph_convert<0>(p.cd_w_in, 5152, 2048, 5376, WT_IN, smf);
    ph_convert<0>(p.cd_w_out, 2048, 2048, 2048, WT_OUT, smf);
    ph_convert<2>(p.ffn_w_gu + (size_t)2048 * 11264, 11264, 2048, 11264, WT_GU, smf);
    ph_convert<0>(p.ffn_w_down + (size_t)5632 * 2048, 2048, 5632, 2048, WT_DN, smf);
    ph_norm(XC, p.out, p.norm_mix_g + 2048, MOD1, 0, 1, H, 0);
    grid.sync();
    { pg8::Gemm g{H, WT_IN, MTOT, 5376, 2048}; pg8::StaticOrder S; S.init(MTOT, 5376, GD, bid);
      pg8::EpiProj E{PROJ, NP1, 20, G, NG1, NG1}; pg8::gemm_phase<pg8::EpiProj, pg8::StaticOrder>(ldsg, g, S, E); }
    grid.sync();
    ph_l1_a(p, lds);
    grid.sync();
    for (int job = bid; job < 136; job += GD) { if (job < 128) gla_chunk(p, job, lds); else rg_pass_b(p, job - 128); }
    grid.sync();
    ph_l1_c(p, lds);
    grid.sync();
    { pg8::Gemm g{H + (size_t)512 * 2048, WT_OUT, MLAT, 2048, 2048}; pg8::StaticOrder S; S.init(MLAT, 2048, GD, bid);
      pg8::EpiRes E{XC, p.out, XC, p.out, MOD1 + 2 * 2048, 512}; pg8::gemm_phase<pg8::EpiRes, pg8::StaticOrder>(ldsg, g, S, E); }
    grid.sync();
    ph_norm(XC, p.out, p.norm_ffn_g + 2048, MOD1, 3, 4, H, 512);
    grid.sync();
    { pg8::Gemm g{H + (size_t)512 * 2048, WT_GU, MLAT, 11264, 2048}; pg8::StaticOrder S; S.init(MLAT, 11264, GD, bid);
      pg8::EpiSwiglu E{PROJ, FH}; pg8::gemm_phase<pg8::EpiSwiglu, pg8::StaticOrder>(ldsg, g, S, E); }
    grid.sync();
    { pg8::Gemm g{PROJ, WT_DN, MLAT, 2048, 5632}; pg8::StaticOrder S; S.init(MLAT, 2048, GD, bid);
      pg8::EpiRes E{XC, p.out, XC, p.out, MOD1 + 5 * 2048, 512}; pg8::gemm_phase<pg8::EpiRes, pg8::StaticOrder>(ldsg, g, S, E); }
    grid.sync();
    ph_final_norm(p);
}

extern "C" void kernel_launch(void* const* d_in, const int* in_sizes, int n_in, void* d_out, int out_size, void* d_ws, size_t ws_size, hipStream_t stream) {
    static int grid = 0;
    if (grid == 0) {
        if (n_in != 32 || out_size != MLAT * DM || ws_size < WS_END) { fprintf(stderr, "kernel_launch: unexpected shapes (n_in %d out %d ws %zu need %zu)\n", n_in, out_size, ws_size, (size_t)WS_END); grid = -1; return; }
        int dev = 0, cus = 0, per_cu = 0;
        (void)hipGetDevice(&dev);
        (void)hipDeviceGetAttribute(&cus, hipDeviceAttributeMultiprocessorCount, dev);
        if (hipFuncSetAttribute((const void*)hybrid_fwd, hipFuncAttributeMaxDynamicSharedMemorySize, LDS_BYTES) != hipSuccess) { fprintf(stderr, "kernel_launch: hipFuncSetAttribute failed\n"); }
        if (hipOccupancyMaxActiveBlocksPerMultiprocessor(&per_cu, (const void*)hybrid_fwd, NTHR, LDS_BYTES) != hipSuccess || per_cu < 1) { fprintf(stderr, "kernel_launch: occupancy query gave %d\n", per_cu); per_cu = 1; }
        (void)hipGetLastError();
        grid = cus * per_cu;
    }
    if (grid < 0) return;
    Params p{};
    const float** pp = (const float**)&p;
    for (int i = 0; i < 32; ++i) pp[i] = (const float*)d_in[i];
    p.out = (float*)d_out; p.ws = (unsigned char*)d_ws;
    void* args[] = {&p};
    hipError_t e = hipLaunchCooperativeKernel((const void*)hybrid_fwd, dim3(grid), dim3(NTHR), args, LDS_BYTES, stream);
    if (e != hipSuccess) fprintf(stderr, "cooperative launch failed: %s (grid %d)\n", hipGetErrorString(e), grid);
}
```

```cpp
#include <hip/hip_runtime.h>
#include <hip/hip_cooperative_groups.h>
#include <cstdio>
namespace cg = cooperative_groups;

typedef unsigned short u16;

constexpr int DM = 2048, FH = 5632, MC = 512, MLAT = 32768, MTOT = 33280, NTHR = 512;
constexpr int NP0 = 7168, NP1 = 5120;
constexpr int NG0 = 48, NG1 = 32;
constexpr int NSEG = 260;

constexpr size_t WS_WT_IN = 0;
constexpr size_t WS_WT_OUT = WS_WT_IN + (size_t)7424 * 2048 * 2;
constexpr size_t WS_WT_GU = WS_WT_OUT + (size_t)2048 * 2048 * 2;
constexpr size_t WS_WT_DN = WS_WT_GU + (size_t)11264 * 2048 * 2;
constexpr size_t WS_H = WS_WT_DN + (size_t)2048 * 5632 * 2;
constexpr size_t WS_PROJ = WS_H + (size_t)MTOT * 2048 * 2;
constexpr size_t WS_OF = WS_PROJ + (size_t)MTOT * 7168 * 2;
constexpr size_t WS_OB = WS_OF + (size_t)MTOT * 2048 * 2;
constexpr size_t WS_XC = WS_OB + (size_t)MTOT * 2048 * 2;
constexpr size_t WS_G = WS_XC + (size_t)MC * 2048 * 4;
constexpr size_t WS_CQ = WS_G + (size_t)MTOT * 48 * 4;
constexpr size_t WS_MODP = WS_CQ + (size_t)MC * 3072 * 2;
constexpr size_t WS_MOD = WS_MODP + (size_t)2 * 32 * 3 * 12288 * 4;
constexpr size_t WS_ATT0 = WS_MOD + (size_t)2 * 3 * 12288 * 4;
constexpr size_t WS_MLS = WS_ATT0 + (size_t)4160 * 4096 * 2;
constexpr size_t WS_GCS = WS_MLS + (size_t)4160 * 256 * 4;
constexpr size_t WS_WRT = WS_GCS + (size_t)8320 * 256 * 4;
constexpr size_t WS_END = WS_WRT + (size_t)32 * 16384 * 2;
constexpr size_t WS_TM = WS_H;
constexpr size_t WS_QK = WS_H + (size_t)8320 * 4096 * 2;
constexpr size_t WS_OF1 = WS_OF;
constexpr size_t WS_OB1 = WS_OF + (size_t)MTOT * 1024 * 2;
constexpr size_t WS_QE = WS_OB;
constexpr size_t WS_KDT = WS_QE + (size_t)2 * MTOT * 512 * 2;
constexpr size_t WS_TAIL = WS_PROJ + (size_t)MTOT * 5120 * 2;
constexpr size_t WS_ATT = WS_TAIL;
constexpr size_t WS_VT = WS_ATT + (size_t)4160 * 4096 * 2;
constexpr size_t WS_EBL = WS_VT + (size_t)2080 * 16384 * 2;
constexpr size_t WS_AGG = WS_EBL + (size_t)4160 * 128 * 4;
constexpr size_t WS_CARRY = WS_AGG + (size_t)4 * NSEG * 1024 * 8;
static_assert(WS_CARRY + (size_t)4 * NSEG * 1024 * 4 <= WS_OF, "layer-1 tail overflow");

struct Params {
    const float *x, *c, *ctx, *c_ctx, *mod_w, *mod_b, *norm_mix_g, *norm_ffn_g, *ffn_w_gu, *ffn_w_down, *final_norm_g,
        *ab_w_in, *ab_w_out, *ml_ig_b, *ml_fg_b, *ml_norm_g, *dn_conv_w, *dn_a_log, *dn_dt_bias, *dn_norm_g,
        *cd_w_in, *cd_w_out, *rg_conv_w, *rg_conv_b, *rg_w_r, *rg_b_r, *rg_w_i, *rg_b_i, *rg_lambda, *gla_w_up, *gla_b_up, *gla_norm_g;
    float* out; unsigned char* ws;
};

__device__ __forceinline__ float bf2f(u16 v) { return __uint_as_float(((unsigned)v) << 16); }
typedef __bf16 bf16x2_nat __attribute__((ext_vector_type(2)));
typedef float f32x2_nat __attribute__((ext_vector_type(2)));
__device__ __forceinline__ unsigned cvt_pk_bf16(float lo, float hi) { const f32x2_nat v = {lo, hi}; const bf16x2_nat r = __builtin_convertvector(v, bf16x2_nat); return __builtin_bit_cast(unsigned, r); }
__device__ __forceinline__ u16 f2bf(float f) { return (u16)(cvt_pk_bf16(f, 0.f) & 0xffffu); }
__device__ __forceinline__ void unpack8(const uint4& u, float* f) {
    f[0] = __uint_as_float(u.x << 16); f[1] = __uint_as_float(u.x & 0xffff0000u);
    f[2] = __uint_as_float(u.y << 16); f[3] = __uint_as_float(u.y & 0xffff0000u);
    f[4] = __uint_as_float(u.z << 16); f[5] = __uint_as_float(u.z & 0xffff0000u);
    f[6] = __uint_as_float(u.w << 16); f[7] = __uint_as_float(u.w & 0xffff0000u);
}
__device__ __forceinline__ uint4 pack8(const float* f) { uint4 o; o.x = cvt_pk_bf16(f[0], f[1]); o.y = cvt_pk_bf16(f[2], f[3]); o.z = cvt_pk_bf16(f[4], f[5]); o.w = cvt_pk_bf16(f[6], f[7]); return o; }
template <int CTRL> __device__ __forceinline__ float dppf(float x) { return __int_as_float(__builtin_amdgcn_update_dpp(0, __float_as_int(x), CTRL, 0xF, 0xF, true)); }
__device__ __forceinline__ float red4(float x) { x += dppf<0xB1>(x); x += dppf<0x4E>(x); return x; }
__device__ __forceinline__ float red8(float x) { x = red4(x); x += dppf<0x141>(x); return x; }
__device__ __forceinline__ float red16(float x) { x = red8(x); x += dppf<0x140>(x); return x; }
__device__ __forceinline__ float red64(float x) { x = red16(x); x += __shfl_xor(x, 16); x += __shfl_xor(x, 32); return x; }
__device__ __forceinline__ float sigmoidf_(float x) { return 1.f / (1.f + __expf(-x)); }
__device__ __forceinline__ float siluf_(float x) { return x / (1.f + __expf(-x)); }
__device__ __forceinline__ float softplusf_(float x) { return fmaxf(x, 0.f) + log1pf(__expf(-fabsf(x))); }
__device__ __forceinline__ float logsigmoidf_(float x) { return fminf(x, 0.f) - log1pf(__expf(-fabsf(x))); }
__device__ __forceinline__ float gelu_tanh(float x) { const float u = 0.7978845608028654f * (x + 0.044715f * x * x * x); const float th = 1.f - 2.f / (1.f + __expf(2.f * u)); return 0.5f * x * (1.f + th); }

__device__ __forceinline__ int tid_fresh() { int t = threadIdx.x; asm volatile("" : "+v"(t)); return t; }
namespace pg8 {
#define PG8_LAS __attribute__((address_space(3)))
typedef unsigned short bf16_t;
typedef short bf16x8 __attribute__((ext_vector_type(8)));
typedef float f32x4 __attribute__((ext_vector_type(4)));
typedef unsigned u32x4 __attribute__((ext_vector_type(4)));
constexpr int BM = 256, BK = 64, HALF = 128, HTB = HALF * BK * 2  , STAGE_BYTES = 8 * HTB, NXCD = 8, WGM = 8;

__host__ __device__ __forceinline__ int lds_byte(int r, int c) { const int st = (r >> 4) * 2 + (c >> 5), rr = r & 15, cc = c & 31, ob = rr * 64 + cc * 2; return st * 1024 + (ob ^ (((ob >> 9) & 1) << 5)); }
__host__ __device__ __forceinline__ void stage_rc(int b, int& R, int& C) { const int st = b / 1024, sb = b % 1024, swz = sb ^ (((sb >> 9) & 1) << 5); R = (st >> 1) * 16 + swz / 64; C = (st & 1) * 32 + (swz % 64) / 2; }
__host__ __device__ __forceinline__ int perm32(int rho) { const int n = rho >> 4, i = rho & 15; return 8 * (i >> 2) + 4 * n + (i & 3); }

struct Unit { int pm, pn; };
struct Gemm { const bf16_t* A; const bf16_t* Bt; int M, N, K; };

struct StaticOrder {
    int nM, nN, nwg, G, c;
    __host__ __device__ void init(int M, int N, int G_, int c_) { nM = M / BM; nN = N / BM; nwg = nM * nN; G = G_; c = c_; }
    __host__ __device__ bool next(int i, Unit& u) const {
        const long L = (long)i * G + c; if (L >= nwg) return false;
        int wgid = (int)L; { const int q = nwg / NXCD, r = nwg % NXCD, xcd = wgid % NXCD, off = wgid / NXCD; wgid = (xcd < r ? xcd * (q + 1) : r * (q + 1) + (xcd - r) * q) + off; }
        const int nig = WGM * nN, gid = wgid / nig, fm = gid * WGM, gsz = (nM - fm) < WGM ? (nM - fm) : WGM;
        u.pm = fm + ((wgid % nig) % gsz); u.pn = (wgid % nig) / gsz; return true;
    }
    __device__ __forceinline__ void a_ready(const Unit&) const {}
    __device__ __forceinline__ void done(const Unit&) const {}
};
using ::cvt_pk_bf16;
typedef float f32x2 __attribute__((ext_vector_type(2)));

struct EpiProj {
    static constexpr bool PERM = true, AFTER_DRAIN = false;
    bf16_t* P; int ldp; int n_main; float* G; int ldg; int ng;
    __device__ __forceinline__ void operator()(const f32x4 (&acc)[2][2][4][2], const Unit& u, int wr, int wc, int fr, int fq) const {
        const int row0 = u.pm * BM + wr * 64 + fr;
        if (u.pn < n_main) {
            const int col0 = u.pn * BM + wc * 32 + 8 * fq;
#pragma unroll
            for (int ai = 0; ai < 2; ++ai)
#pragma unroll
                for (int m = 0; m < 4; ++m) { bf16_t* rowp = P + (size_t)(row0 + ai * HALF + m * 16) * ldp + col0;
#pragma unroll
                    for (int bj = 0; bj < 2; ++bj) { const f32x4 v0 = acc[ai][bj][m][0], v1 = acc[ai][bj][m][1];
                        u32x4 w; w.x = cvt_pk_bf16(v0[0], v0[1]); w.y = cvt_pk_bf16(v0[2], v0[3]); w.z = cvt_pk_bf16(v1[0], v1[1]); w.w = cvt_pk_bf16(v1[2], v1[3]);
                        *(u32x4*)(rowp + bj * HALF) = w; } }
        } else {
            const int c0 = wc * 32 + 8 * fq;
#pragma unroll
            for (int ai = 0; ai < 2; ++ai)
#pragma unroll
                for (int m = 0; m < 4; ++m) { float* rowp = G + (size_t)(row0 + ai * HALF + m * 16) * ldg;
#pragma unroll
                    for (int n = 0; n < 2; ++n)
#pragma unroll
                        for (int j = 0; j < 4; ++j) { const int c = c0 + 4 * n + j; if (c < ng) rowp[c] = acc[ai][0][m][n][j]; } }
        }
    }
};
struct EpiRes {
    static constexpr bool PERM = false, AFTER_DRAIN = false;
    const float* srcC; const float* srcL; float* dstC; float* dstL; const float* gate  ; int row_off;
    __device__ __forceinline__ void operator()(const f32x4 (&acc)[2][2][4][2], const Unit& u, int wr, int wc, int fr, int fq) const {
        const int grow_t = u.pm * BM + row_off;
        const bool isc = grow_t < 512;
        const int mr = isc ? 2 : ((grow_t - 512) >> 14);
        const float* sp = isc ? srcC + (size_t)grow_t * 2048 : srcL + (size_t)(grow_t - 512) * 2048;
        float* dp = isc ? dstC + (size_t)grow_t * 2048 : dstL + (size_t)(grow_t - 512) * 2048;
        const int lrow0 = wr * 64 + fr, col0 = u.pn * BM + wc * 32 + 4 * fq;
        const float* gp = gate + (size_t)mr * 12288 + col0;
        f32x4 gv[2][2];
#pragma unroll
        for (int bj = 0; bj < 2; ++bj)
#pragma unroll
            for (int n = 0; n < 2; ++n) gv[bj][n] = *(const f32x4*)(gp + bj * HALF + n * 16);
#pragma unroll
        for (int ai = 0; ai < 2; ++ai)
#pragma unroll
            for (int m = 0; m < 4; ++m) { const size_t off = (size_t)(lrow0 + ai * HALF + m * 16) * 2048 + col0;
#pragma unroll
                for (int bj = 0; bj < 2; ++bj)
#pragma unroll
                    for (int n = 0; n < 2; ++n) { const f32x4 s = *(const f32x4*)(sp + off + bj * HALF + n * 16);
                        *(f32x4*)(dp + off + bj * HALF + n * 16) = s + gv[bj][n] * acc[ai][bj][m][n]; } }
    }
};
struct EpiSwiglu {
    static constexpr bool PERM = true, AFTER_DRAIN = false;
    bf16_t* O; int ldo;
    __device__ __forceinline__ void operator()(const f32x4 (&acc)[2][2][4][2], const Unit& u, int wr, int wc, int fr, int fq) const {
        const int row0 = u.pm * BM + wr * 64 + fr, col0 = u.pn * HALF + wc * 32 + 8 * fq;
#pragma unroll
        for (int ai = 0; ai < 2; ++ai)
#pragma unroll
            for (int m = 0; m < 4; ++m) { float r[8];
#pragma unroll
                for (int n = 0; n < 2; ++n)
#pragma unroll
                    for (int j = 0; j < 4; ++j) { const float gg = acc[ai][0][m][n][j], uu = acc[ai][1][m][n][j]; r[n * 4 + j] = gg / (1.f + __expf(-gg)) * uu; }
                u32x4 w; w.x = cvt_pk_bf16(r[0], r[1]); w.y = cvt_pk_bf16(r[2], r[3]); w.z = cvt_pk_bf16(r[4], r[5]); w.w = cvt_pk_bf16(r[6], r[7]);
                *(u32x4*)(O + (size_t)(row0 + ai * HALF + m * 16) * ldo + col0) = w; }
    }
};

template <class Epi, class Sched>
__device__ __forceinline__ void gemm_phase(PG8_LAS unsigned char* lds, const Gemm g, const Sched& S, const Epi& E) {
    int tid = threadIdx.x; asm volatile("" : "+v"(tid)); const int wid = __builtin_amdgcn_readfirstlane(tid >> 6), lane = tid & 63, wr = wid >> 2, wc = wid & 3, fr = lane & 15, fq = lane >> 4;
    const int K = g.K, nt = K / BK;
    unsigned voffA[2], voffB[2];
#pragma unroll
    for (int i = 0; i < 2; ++i) { int R, C; stage_rc(tid * 16 + i * 8192, R, C); const int Rb = Epi::PERM ? ((R & ~31) + perm32(R & 31)) : R;
        voffA[i] = (unsigned)(R * K + C) * 2u; voffB[i] = (unsigned)(Rb * K + C) * 2u; }
    const size_t kstep = (size_t)(BK * 2);
    const size_t hstep = (size_t)HALF * K * 2;
    const size_t tstep = 2 * hstep;
    const unsigned ldsw = (unsigned)wid * 1024u;
    const int aoff = lds_byte(wr * 64 + fr, fq * 8), boff = lds_byte(wc * 32 + fr, fq * 8);
#define PG8_SA(b, h) (((b) * 2 + (h)) * HTB)
#define PG8_SB(b, h) ((4 + (b) * 2 + (h)) * HTB)
#define PG8_STAGE(bufoff, gbase, voff) do { _Pragma("unroll") for (int _i = 0; _i < 2; ++_i) \
        __builtin_amdgcn_global_load_lds((const unsigned*)((const char*)(gbase) + (voff)[_i]), (PG8_LAS unsigned*)(lds + (bufoff) + ldsw + _i * 8192), 16, 0, 0); } while (0)
#define PG8_LDA(dst, b, h) do { _Pragma("unroll") for (int m = 0; m < 4; ++m) _Pragma("unroll") for (int k = 0; k < 2; ++k) dst[m][k] = *(const PG8_LAS bf16x8*)(lds + PG8_SA(b, h) + aoff + m * 2048 + k * 1024); } while (0)
#define PG8_LDB(dst, b, h) do { _Pragma("unroll") for (int n = 0; n < 2; ++n) _Pragma("unroll") for (int k = 0; k < 2; ++k) dst[n][k] = *(const PG8_LAS bf16x8*)(lds + PG8_SB(b, h) + boff + n * 2048 + k * 1024); } while (0)
#define PG8_MMA(ai, bj, At, Bt) do { __builtin_amdgcn_s_setprio(1); _Pragma("unroll") for (int m = 0; m < 4; ++m) _Pragma("unroll") for (int n = 0; n < 2; ++n) _Pragma("unroll") for (int k = 0; k < 2; ++k) \
        acc[ai][bj][m][n] = __builtin_amdgcn_mfma_f32_16x16x32_bf16(Bt[n][k], At[m][k], acc[ai][bj][m][n], 0, 0, 0); __builtin_amdgcn_s_setprio(0); } while (0)
#define PG8_WAIT_V(n) asm volatile("s_waitcnt vmcnt(" #n ")" ::: "memory")
#define PG8_WAIT_L(n) asm volatile("s_waitcnt lgkmcnt(" #n ")" ::: "memory")
#define PG8_BAR __builtin_amdgcn_s_barrier()
#define PG8_SCHED __builtin_amdgcn_sched_barrier(0)
    Unit cur, nxt; int ui = 0;
    if (!S.next(0, cur)) return;
    f32x4 acc[2][2][4][2];
#pragma unroll
    for (int a = 0; a < 2; ++a)
#pragma unroll
        for (int b = 0; b < 2; ++b)
#pragma unroll
            for (int m = 0; m < 4; ++m)
#pragma unroll
                for (int n = 0; n < 2; ++n) acc[a][b][m][n] = (f32x4){0.f, 0.f, 0.f, 0.f};
    bf16x8 At[4][2], B0[2][2], B1[2][2];
    const char* cA = (const char*)g.A + (size_t)cur.pm * tstep; const char* cB = (const char*)g.Bt + (size_t)cur.pn * tstep;
    S.a_ready(cur);
    PG8_STAGE(PG8_SB(0, 0), cB, voffB); PG8_STAGE(PG8_SA(0, 0), cA, voffA); PG8_STAGE(PG8_SB(0, 1), cB + hstep, voffB); PG8_STAGE(PG8_SA(0, 1), cA + hstep, voffA);
    if (wr == 1) PG8_BAR;
    PG8_WAIT_V(4); PG8_BAR;
    PG8_STAGE(PG8_SB(1, 0), cB + kstep, voffB); PG8_STAGE(PG8_SA(1, 0), cA + kstep, voffA); PG8_STAGE(PG8_SB(1, 1), cB + hstep + kstep, voffB);
    PG8_WAIT_V(6); PG8_BAR;
    for (;;) {
        const bool has_next = S.next(ui + 1, nxt);
        const char* nA = has_next ? (const char*)g.A + (size_t)nxt.pm * tstep : cA; const char* nB = has_next ? (const char*)g.Bt + (size_t)nxt.pn * tstep : cB;
        for (int t = 0; t < nt; t += 2) {
            const bool last = (t == nt - 2);
            const char* a1 = cA + (size_t)(t + 1) * kstep;
            const char* a2 = last ? nA : cA + (size_t)(t + 2) * kstep; const char* b2 = last ? nB : cB + (size_t)(t + 2) * kstep;
            const char* a3 = a2 + kstep; const char* b3 = b2 + kstep;
            if (last && has_next) S.a_ready(nxt);
            PG8_LDB(B0, 0, 0); PG8_SCHED; PG8_LDA(At, 0, 0); PG8_STAGE(PG8_SA(1, 1), a1 + hstep, voffA);
            PG8_WAIT_L(8); PG8_BAR; PG8_WAIT_L(0); PG8_MMA(0, 0, At, B0); PG8_BAR; PG8_SCHED;
            PG8_LDB(B1, 0, 1); PG8_STAGE(PG8_SB(0, 0), b2, voffB);
            PG8_BAR; PG8_WAIT_L(0); PG8_MMA(0, 1, At, B1); PG8_BAR;
            PG8_LDA(At, 0, 1); PG8_STAGE(PG8_SA(0, 0), a2, voffA);
            PG8_BAR; PG8_WAIT_L(0); PG8_MMA(1, 0, At, B0); PG8_BAR; PG8_SCHED;
            PG8_STAGE(PG8_SB(0, 1), b2 + hstep, voffB);
            PG8_WAIT_V(6); PG8_BAR; PG8_MMA(1, 1, At, B1); PG8_BAR;
            PG8_LDB(B0, 1, 0); PG8_SCHED; PG8_LDA(At, 1, 0); PG8_STAGE(PG8_SA(0, 1), a2 + hstep, voffA);
            PG8_WAIT_L(8); PG8_BAR; PG8_WAIT_L(0); PG8_MMA(0, 0, At, B0); PG8_BAR; PG8_SCHED;
            PG8_LDB(B1, 1, 1); PG8_STAGE(PG8_SB(1, 0), b3, voffB);
            PG8_BAR; PG8_WAIT_L(0); PG8_MMA(0, 1, At, B1); PG8_BAR;
            PG8_LDA(At, 1, 1); PG8_STAGE(PG8_SA(1, 0), a3, voffA);
            PG8_BAR; PG8_WAIT_L(0); PG8_MMA(1, 0, At, B0); PG8_BAR; PG8_SCHED;
            PG8_STAGE(PG8_SB(1, 1), b3 + hstep, voffB);
            PG8_WAIT_V(6); PG8_BAR; PG8_MMA(1, 1, At, B1); PG8_BAR;
        }
        if constexpr (!Epi::AFTER_DRAIN) { E(acc, cur, wr, wc, fr, fq); S.done(cur); }
        if (!has_next) break;
#pragma unroll
        for (int a = 0; a < 2; ++a)
#pragma unroll
            for (int b = 0; b < 2; ++b)
#pragma unroll
                for (int m = 0; m < 4; ++m)
#pragma unroll
                    for (int n = 0; n < 2; ++n) acc[a][b][m][n] = (f32x4){0.f, 0.f, 0.f, 0.f};
        cur = nxt; cA = nA; cB = nB; ++ui;
    }
    PG8_WAIT_V(0);
    if (wr == 0) PG8_BAR;
    PG8_BAR;
    if constexpr (Epi::AFTER_DRAIN) { E.fused(acc, cur, wr, wc, fr, fq, lds, wid, lane); S.done(cur); }
#undef PG8_SA
#undef PG8_SB
#undef PG8_STAGE
#undef PG8_LDA
#undef PG8_LDB
#undef PG8_MMA
#undef PG8_WAIT_V
#undef PG8_WAIT_L
#undef PG8_BAR
#undef PG8_SCHED
}
}

__device__ __forceinline__ void ph_adaln_partials(const Params& p, float* sm) {
    const int tid = tid_fresh();
    float* MODP = (float*)(p.ws + WS_MODP);
    for (int it = blockIdx.x; it < 384; it += gridDim.x) {
        const int l = it / 192, rem = it % 192, kc = rem / 6, cgp = rem % 6;
        __syncthreads();
        if (tid < 192) { const int r = tid >> 6, kk = tid & 63, k = kc * 64 + kk; const float cv = (r < 2) ? p.c[r * 2048 + k] : p.c_ctx[k]; sm[tid] = siluf_(cv); }
        __syncthreads();
        const int col = cgp * 2048 + tid * 4;
        float4 a0 = {0.f, 0.f, 0.f, 0.f}, a1 = a0, a2 = a0;
        const float* wp = p.mod_w + ((size_t)l * 2048 + (size_t)kc * 64) * 12288 + col;
#pragma unroll 8
        for (int kk = 0; kk < 64; ++kk) {
            const float4 w = *(const float4*)(wp + (size_t)kk * 12288);
            const float s0 = sm[kk], s1 = sm[64 + kk], s2 = sm[128 + kk];
            a0.x += s0 * w.x; a0.y += s0 * w.y; a0.z += s0 * w.z; a0.w += s0 * w.w;
            a1.x += s1 * w.x; a1.y += s1 * w.y; a1.z += s1 * w.z; a1.w += s1 * w.w;
            a2.x += s2 * w.x; a2.y += s2 * w.y; a2.z += s2 * w.z; a2.w += s2 * w.w;
        }
        float* o = MODP + ((size_t)(l * 32 + kc) * 3) * 12288 + col;
        *(float4*)(o) = a0; *(float4*)(o + 12288) = a1; *(float4*)(o + 2 * 12288) = a2;
    }
}
__device__ __forceinline__ void ph_adaln_reduce(const Params& p) {
    const float* MODP = (const float*)(p.ws + WS_MODP); float* MOD = (float*)(p.ws + WS_MOD);
    for (int idx = blockIdx.x * NTHR + tid_fresh(); idx < 2 * 3 * 12288; idx += gridDim.x * NTHR) {
        const int l = idx / 36864, r = (idx / 12288) % 3, col = idx % 12288;
        float s = p.mod_b[l * 12288 + col];
        for (int kc = 0; kc < 32; ++kc) s += MODP[((size_t)(l * 32 + kc) * 3 + r) * 12288 + col];
        MOD[idx] = s;
    }
}

template <int MODE> __device__ __forceinline__ int colmap(int n, int nsrc) {
    if (MODE == 0) return n < nsrc ? n : -1;
    if (MODE == 1) { if (n < 3072) return n; if (n < 7168) return n + 16; if (n < 7184) return 3072 + (n - 7168); if (n < 7216) return n; return -1; }
    return ((n >> 7) & 1) * 5632 + (n >> 8) * 128 + (n & 127);
}
template <int MODE> __device__ __forceinline__ void ph_convert(const float* W, int nsrc, int K, int nout, u16* Bt, float* sm) {
    const int tid = tid_fresh(); const int nnt = nout / 64, ntiles = nnt * (K / 64);
    for (int t = blockIdx.x; t < ntiles; t += gridDim.x) {
        const int k0 = (t / nnt) * 64, n0 = (t % nnt) * 64;
        __syncthreads();
#pragma unroll
        for (int i = 0; i < 8; ++i) { const int idx = i * NTHR + tid, kk = idx >> 6, nn = idx & 63; const int src = colmap<MODE>(n0 + nn, nsrc);
            sm[kk * 65 + nn] = src >= 0 ? W[(size_t)(k0 + kk) * nsrc + src] : 0.f; }
        __syncthreads();
        { const int nn = tid >> 3, k8 = (tid & 7) * 8; float v[8];
#pragma unroll
            for (int j = 0; j < 8; ++j) v[j] = sm[(k8 + j) * 65 + nn];
            *(uint4*)(Bt + (size_t)(n0 + nn) * K + k0 + k8) = pack8(v); }
    }
}

__device__ __forceinline__ void ph_norm(const float* srcC, const float* srcL, const float* g, const float* modl, int chunk_sh, int chunk_sc, u16* H, int row_begin) {
    const int tid_ = tid_fresh(); const int lane = tid_ & 63, w = tid_ >> 6;
    for (int row = row_begin + blockIdx.x * 8 + w; row < MTOT; row += gridDim.x * 8) {
        const float* src = row < 512 ? srcC + (size_t)row * 2048 : srcL + (size_t)(row - 512) * 2048;
        const int mr = row < 512 ? 2 : ((row - 512) >> 14);
        const float* sc = modl + (mr * 6 + chunk_sc) * 2048; const float* sh = modl + (mr * 6 + chunk_sh) * 2048;
        float4 v[8]; float ss = 0.f;
#pragma unroll
        for (int i = 0; i < 8; ++i) { v[i] = *(const float4*)(src + i * 256 + lane * 4); ss += v[i].x * v[i].x + v[i].y * v[i].y + v[i].z * v[i].z + v[i].w * v[i].w; }
        ss = red64(ss);
        const float rstd = rsqrtf(ss * (1.f / 2048.f) + 1e-6f);
#pragma unroll
        for (int i = 0; i < 8; ++i) { const int col = i * 256 + lane * 4;
            const float4 g4 = *(const float4*)(g + col), s4 = *(const float4*)(sc + col), h4 = *(const float4*)(sh + col);
            const float y0 = v[i].x * rstd * g4.x * (1.f + s4.x) + h4.x, y1 = v[i].y * rstd * g4.y * (1.f + s4.y) + h4.y;
            const float y2 = v[i].z * rstd * g4.z * (1.f + s4.z) + h4.z, y3 = v[i].w * rstd * g4.w * (1.f + s4.w) + h4.w;
            uint2 o; o.x = cvt_pk_bf16(y0, y1); o.y = cvt_pk_bf16(y2, y3);
            *(uint2*)(H + (size_t)row * 2048 + col) = o; }
    }
}
__device__ __forceinline__ void ph_final_norm(const Params& p) {
    const int tid_ = tid_fresh(); const int lane = tid_ & 63, w = tid_ >> 6;
    for (int row = blockIdx.x * 8 + w; row < MLAT; row += gridDim.x * 8) {
        float* src = p.out + (size_t)row * 2048;
        float4 v[8]; float ss = 0.f;
#pragma unroll
        for (int i = 0; i < 8; ++i) { v[i] = *(const float4*)(src + i * 256 + lane * 4); ss += v[i].x * v[i].x + v[i].y * v[i].y + v[i].z * v[i].z + v[i].w * v[i].w; }
        ss = red64(ss);
        const float rstd = rsqrtf(ss * (1.f / 2048.f) + 1e-6f);
#pragma unroll
        for (int i = 0; i < 8; ++i) { const int col = i * 256 + lane * 4; const float4 g4 = *(const float4*)(p.final_norm_g + col);
            float4 o; o.x = v[i].x * rstd * g4.x; o.y = v[i].y * rstd * g4.y; o.z = v[i].z * rstd * g4.z; o.w = v[i].w * rstd * g4.w;
            *(float4*)(src + col) = o; }
    }
}

__device__ __forceinline__ void ph_l0_prep(const Params& p, float* sm) {
    const int tid = tid_fresh();
    u16* PROJ = (u16*)(p.ws + WS_PROJ); u16* CQ = (u16*)(p.ws + WS_CQ); float* G = (float*)(p.ws + WS_G);
    for (int idx = blockIdx.x * NTHR + tid; idx < MTOT * 48; idx += gridDim.x * NTHR) {
        const int j = idx % 48; const float v = G[idx]; float o;
        if (j < 8) o = v + p.ml_ig_b[j];
        else if (j < 16) o = logsigmoidf_(v + p.ml_fg_b[j - 8]);
        else if (j < 32) { const float dt = softplusf_(v + p.dn_dt_bias[j - 16]); o = -__expf(p.dn_a_log[j - 16]) * dt; }
        else o = sigmoidf_(v);
        G[idx] = o;
    }
    for (int t = blockIdx.x; t < 520 * 24; t += gridDim.x) {
        const int tt = t / 24, part = t % 24;
        const bool isctx = tt < 8;
        const int t0 = isctx ? (tt & 3) * 64 : 0;
        const int rowbase = isctx ? (tt >> 2) * 256 + t0 : 512 + (tt - 8) * 64;
        __syncthreads();
        for (int ch = tid; ch < 68 * 16; ch += NTHR) {
            const int rr = ch >> 4, c8 = (ch & 15) * 8, r = rr - 2;
            const bool ok = isctx ? (t0 + r >= 0 && t0 + r < 256) : (r >= 0 && r < 64);
            float f[8];
#pragma unroll
            for (int j = 0; j < 8; ++j) f[j] = 0.f;
            if (ok) { const uint4 u = *(const uint4*)(PROJ + (size_t)(rowbase + r) * NP0 + 3072 + part * 128 + c8); unpack8(u, f); }
            float* d = sm + rr * 132 + c8;
            *(float4*)(d) = make_float4(f[0], f[1], f[2], f[3]); *(float4*)(d + 4) = make_float4(f[4], f[5], f[6], f[7]);
        }
        __syncthreads();
        const int tk = tid >> 3, cs = (tid & 7) * 16;
        float o[16];
#pragma unroll
        for (int c = 0; c < 16; ++c) o[c] = 0.f;
#pragma unroll
        for (int j = 0; j < 5; ++j) {
            const float* wr_ = p.dn_conv_w + j * 3072 + part * 128 + cs; const float* ir = sm + (tk + j) * 132 + cs;
#pragma unroll
            for (int c4 = 0; c4 < 4; ++c4) { const float4 w4 = *(const float4*)(wr_ + c4 * 4), i4 = *(const float4*)(ir + c4 * 4);
                o[c4 * 4 + 0] += i4.x * w4.x; o[c4 * 4 + 1] += i4.y * w4.y; o[c4 * 4 + 2] += i4.z * w4.z; o[c4 * 4 + 3] += i4.w * w4.w; }
        }
        float ss = 0.f;
#pragma unroll
        for (int c = 0; c < 16; ++c) { o[c] = siluf_(o[c]); ss += o[c] * o[c]; }
        ss = red8(ss);
        if (part < 16) { const float sc = rsqrtf(ss + 1e-6f);
#pragma unroll
            for (int c = 0; c < 16; ++c) o[c] *= sc; }
        u16* dst = isctx ? CQ + (size_t)(rowbase + tk) * 3072 + part * 128 + cs : PROJ + (size_t)(rowbase + tk) * NP0 + 3072 + part * 128 + cs;
        *(uint4*)(dst) = pack8(o); *(uint4*)(dst + 8) = pack8(o + 8);
    }
}

__device__ __forceinline__ void ph_l0_merge(const Params& p) {
    const int tid_ = tid_fresh(); const int lane = tid_ & 63, w = tid_ >> 6;
    const u16* PROJ = (const u16*)(p.ws + WS_PROJ); const u16* OF = (const u16*)(p.ws + WS_OF); const u16* OB = (const u16*)(p.ws + WS_OB); u16* Y = (u16*)(p.ws + WS_H);
    for (int row = blockIdx.x * 8 + w; row < MTOT; row += gridDim.x * 8) {
        const int col = lane * 32; const bool isml = lane < 32;
        const u16* gsrc = PROJ + (size_t)row * NP0 + (isml ? 2048 + col : 6144 + (col - 1024));
        const float* gn = isml ? p.ml_norm_g + col : p.dn_norm_g + (col - 1024);
        float o[32]; float ss = 0.f;
#pragma unroll
        for (int i = 0; i < 4; ++i) { float a[8], bb[8]; unpack8(*(const uint4*)(OF + (size_t)row * 2048 + col + i * 8), a); unpack8(*(const uint4*)(OB + (size_t)row * 2048 + col + i * 8), bb);
#pragma unroll
            for (int j = 0; j < 8; ++j) { o[i * 8 + j] = a[j] + bb[j]; ss += o[i * 8 + j] * o[i * 8 + j]; } }
        ss = red4(ss); const float s8 = ss + dppf<0x141>(ss);
        const float rstd = isml ? rsqrtf(s8 * (1.f / 256.f) + 1e-6f) : rsqrtf(ss * (1.f / 128.f) + 1e-6f);
#pragma unroll
        for (int i = 0; i < 4; ++i) { float gt[8], r[8]; unpack8(*(const uint4*)(gsrc + i * 8), gt);
#pragma unroll
            for (int j = 0; j < 8; ++j) { const float gate = isml ? sigmoidf_(gt[j]) : siluf_(gt[j]); r[j] = o[i * 8 + j] * rstd * gn[i * 8 + j] * gate; }
            *(uint4*)(Y + (size_t)row * 2048 + col + i * 8) = pack8(r); }
    }
}

typedef short bf16x8_t __attribute__((ext_vector_type(8)));
typedef float f32x4_t __attribute__((ext_vector_type(4)));
__device__ __forceinline__ float wave_cumsum(float x, int lane) {
#pragma unroll
    for (int o = 1; o < 64; o <<= 1) { const float t = __shfl_up(x, o); if (lane >= o) x += t; }
    return x; }
__device__ __forceinline__ float wave_cummax(float x, int lane) {
#pragma unroll
    for (int o = 1; o < 64; o <<= 1) { const float t = __shfl_up(x, o); if (lane >= o) x = fmaxf(x, t); }
    return x; }
__device__ __forceinline__ int tile_of(int n, int b, int dir) { if (n < 4) return b * 4 + (dir ? 3 - n : n); const int li = n - 4; return 8 + b * 256 + (dir ? 255 - li : li); }
__device__ __forceinline__ int rowbase_of(int tt) { return tt < 8 ? tt * 64 : 512 + (tt - 8) * 64; }

__device__ __forceinline__ void ml_prep_item(const Params& p, int it, float* wl, int lane) {
    const int h = it & 3, tt = (it >> 2) % 520, z = it / 2080, rowbase = rowbase_of(tt), fr = lane & 15, fq = lane >> 4;
    const u16* PROJ = (const u16*)(p.ws + WS_PROJ); const float* G = (const float*)(p.ws + WS_G);
    float* MLS = (float*)(p.ws + WS_MLS) + (size_t)it * 256; u16* ATT0 = (u16*)(p.ws + WS_ATT0) + (size_t)it * 4096;
    const int tk = z ? 63 - lane : lane, row = rowbase + tk;
    const float ig = G[row * 48 + z * 4 + h], lf = G[row * 48 + 8 + z * 4 + h];
    const float bb = wave_cumsum(lf, lane), gg = ig - bb, cm = wave_cummax(gg, lane);
    const float bL = __shfl(bb, 63), cmL = __shfl(cm, 63);
    MLS[tk] = bb; MLS[64 + tk] = cm; MLS[128 + tk] = __expf(gg - cmL); if (lane == 0) { MLS[192] = bL; MLS[193] = cmL; }
    wl[tk] = gg; wl[64 + tk] = cm;
#pragma unroll 1
    for (int rt = 0; rt < 4; ++rt) {
        bf16x8_t a[4];
#pragma unroll
        for (int ks = 0; ks < 4; ++ks) a[ks] = *(const bf16x8_t*)(PROJ + (size_t)(rowbase + rt * 16 + fr) * NP0 + h * 128 + ks * 32 + fq * 8);
#pragma unroll 1
        for (int ct = 0; ct < 4; ++ct) {
            f32x4_t acc = (f32x4_t){0.f, 0.f, 0.f, 0.f};
#pragma unroll
            for (int ks = 0; ks < 4; ++ks) { const bf16x8_t bfr = *(const bf16x8_t*)(PROJ + (size_t)(rowbase + ct * 16 + fr) * NP0 + 512 + h * 128 + ks * 32 + fq * 8);
                acc = __builtin_amdgcn_mfma_f32_16x16x32_bf16(a[ks], bfr, acc, 0, 0, 0); }
            const int s = ct * 16 + fr; const float gs = wl[s];
#pragma unroll
            for (int j = 0; j < 4; ++j) { const int l = rt * 16 + fq * 4 + j; const bool keep = z ? (s >= l) : (s <= l);
                const float e = __expf(fminf(gs - wl[64 + l], 0.f));
                ATT0[l * 64 + s] = f2bf(keep ? acc[j] * 0.08838834764831845f * e : 0.f); }
        }
    }
}
__device__ __forceinline__ void dn_prep_item(const Params& p, int it, float* Ap, int lane) {
    const int h = it & 7, tt = (it >> 3) % 520, z = it / 4160, rowbase = rowbase_of(tt), fr = lane & 15, fq = lane >> 4;
    const bool isctx = tt < 8;
    const u16* qb = isctx ? (const u16*)(p.ws + WS_CQ) + (size_t)rowbase * 3072 + h * 128 : (const u16*)(p.ws + WS_PROJ) + (size_t)rowbase * NP0 + 3072 + h * 128;
    const int rs = isctx ? 3072 : NP0;
    const float* G = (const float*)(p.ws + WS_G);
    float* GCS = (float*)(p.ws + WS_GCS) + (size_t)it * 256; u16* TM = (u16*)(p.ws + WS_TM) + (size_t)it * 4096; u16* QK = (u16*)(p.ws + WS_QK) + (size_t)it * 4096;
    float* gcs = Ap + 4096; float* bes = Ap + 4160;
    const int tk = z ? 63 - lane : lane, row = rowbase + tk;
    const float g = G[row * 48 + 16 + z * 8 + h], be = G[row * 48 + 32 + z * 8 + h];
    const float gc = wave_cumsum(g, lane), gL = __shfl(gc, 63);
    GCS[tk] = __expf(gc); GCS[64 + tk] = be; GCS[128 + tk] = __expf(gL - gc); if (lane == 0) GCS[192] = __expf(gL);
    gcs[tk] = gc; bes[tk] = be;
#pragma unroll 1
    for (int rt = 0; rt < 4; ++rt) {
        bf16x8_t ak[4], aq[4];
#pragma unroll
        for (int ks = 0; ks < 4; ++ks) { ak[ks] = *(const bf16x8_t*)(qb + (size_t)(rt * 16 + fr) * rs + 1024 + ks * 32 + fq * 8); aq[ks] = *(const bf16x8_t*)(qb + (size_t)(rt * 16 + fr) * rs + ks * 32 + fq * 8); }
#pragma unroll 1
        for (int ct = 0; ct < 4; ++ct) {
            f32x4_t ck = (f32x4_t){0.f, 0.f, 0.f, 0.f}, cq = ck;
#pragma unroll
            for (int ks = 0; ks < 4; ++ks) { const bf16x8_t bfr = *(const bf16x8_t*)(qb + (size_t)(ct * 16 + fr) * rs + 1024 + ks * 32 + fq * 8);
                ck = __builtin_amdgcn_mfma_f32_16x16x32_bf16(ak[ks], bfr, ck, 0, 0, 0); cq = __builtin_amdgcn_mfma_f32_16x16x32_bf16(aq[ks], bfr, cq, 0, 0, 0); }
            const int s = ct * 16 + fr; const float gs = gcs[s];
#pragma unroll
            for (int j = 0; j < 4; ++j) { const int l = rt * 16 + fq * 4 + j;
                const bool strict = z ? (s > l) : (s < l), incl = z ? (s >= l) : (s <= l);
                const float e = __expf(fminf(gcs[l] - gs, 0.f));
                const int lp = z ? 63 - l : l, sp = z ? 63 - s : s;
                Ap[lp * 64 + sp] = strict ? bes[l] * ck[j] * e : 0.f;
                QK[l * 64 + s] = f2bf(incl ? cq[j] * 0.08838834764831845f * e : 0.f); }
        }
    }
    Ap[lane] = (lane == 0) ? 1.f : 0.f;
#pragma unroll 1
    for (int i = 1; i < 64; ++i) {
        float t = (i == lane) ? 1.f : 0.f;
#pragma unroll 4
        for (int j = 0; j < i; ++j) t -= Ap[i * 64 + j] * Ap[j * 64 + lane];
        Ap[i * 64 + lane] = t;
    }
    const int sc = z ? 63 - lane : lane;
#pragma unroll 4
    for (int i = 0; i < 64; ++i) { const int l = z ? 63 - i : i; TM[l * 64 + sc] = f2bf(Ap[i * 64 + lane]); }
}
__device__ __forceinline__ void ph_l0_prepass(const Params& p, unsigned char* lds) {
    const int tid = tid_fresh(), lane = tid & 63, w = tid >> 6;
    float* wl = (float*)(lds + (size_t)w * 16896);
    const int gw = blockIdx.x * 8 + w, nw = gridDim.x * 8;
    for (int it = gw; it < 4160; it += nw) ml_prep_item(p, it, wl, lane);
    for (int it = gw; it < 8320; it += nw) dn_prep_item(p, it, wl, lane);
}

struct MlFr { bf16x8_t q[4], at[2]; uint4 kr[2]; uint2 vr; float kw, b[4], cm[4], bL, cmL; };
__device__ __forceinline__ void ml_load(MlFr& F, const Params& p, int n, int b, int h, int dir, int e0, int lt, int fr, int fq, int tl, int seg) {
    const int nn = n < NSEG ? n : NSEG - 1;
    const int tt = tile_of(nn, b, dir), it = (dir * 520 + tt) * 4 + h, rowbase = rowbase_of(tt);
    const u16* PROJ = (const u16*)(p.ws + WS_PROJ);
    const u16* Q = PROJ + (size_t)(rowbase + lt * 16 + fr) * NP0 + h * 128 + fq * 8;
    const u16* AT = (const u16*)(p.ws + WS_ATT0) + (size_t)it * 4096 + (lt * 16 + fr) * 64 + fq * 8;
    const float* MLS = (const float*)(p.ws + WS_MLS) + (size_t)it * 256;
#pragma unroll
    for (int ks = 0; ks < 4; ++ks) F.q[ks] = *(const bf16x8_t*)(Q + ks * 32);
#pragma unroll
    for (int ks = 0; ks < 2; ++ks) F.at[ks] = *(const bf16x8_t*)(AT + ks * 32);
    const u16* kp = PROJ + (size_t)(rowbase + tl) * NP0 + 512 + h * 128 + seg * 16;
    F.kr[0] = *(const uint4*)(kp); F.kr[1] = *(const uint4*)(kp + 8);
    F.vr = *(const uint2*)(PROJ + (size_t)(rowbase + tl) * NP0 + 1024 + h * 256 + e0 + seg * 4);
    F.kw = MLS[128 + tl];
#pragma unroll
    for (int j = 0; j < 4; ++j) { F.b[j] = MLS[lt * 16 + fq * 4 + j]; F.cm[j] = MLS[64 + lt * 16 + fq * 4 + j]; }
    F.bL = MLS[192]; F.cmL = MLS[193];
}
__device__ __forceinline__ void mlstm_chunk(const Params& p, int job, unsigned char* lds) {
    const int tid = tid_fresh(), lane = tid & 63, w = tid >> 6, fr = lane & 15, fq = lane >> 4;
    const int chain = job >> 3, cgp = job & 7;
    const int b = chain >> 3, h = (chain >> 1) & 3, dir = chain & 1;
    const int e0 = cgp * 32, lt = w >> 1, et = w & 1, dt0 = (w >> 1) * 2, tl = tid >> 3, seg = tid & 7;
    u16* Cl = (u16*)lds;
    u16* Ktw = (u16*)(lds + 17952);
    u16* Vt = (u16*)(lds + 17952 + 18432);
    u16* O = (u16*)(p.ws + (dir ? WS_OB : WS_OF));
    __syncthreads();
    for (int i = tid; i < 17952 / 4; i += NTHR) ((unsigned*)Cl)[i] = 0u;
    __syncthreads();
    f32x4_t Cacc[2], nacc; Cacc[0] = (f32x4_t){0.f, 0.f, 0.f, 0.f}; Cacc[1] = Cacc[0]; nacc = Cacc[0];
    float m_in = 0.f;
    bf16x8_t ones;
#pragma unroll
    for (int j = 0; j < 8; ++j) ones[j] = (short)0x3F80;
    MlFr buf[2];
    ml_load(buf[0], p, 0, b, h, dir, e0, lt, fr, fq, tl, seg); ml_load(buf[1], p, 1, b, h, dir, e0, lt, fr, fq, tl, seg);
    for (int n0 = 0; n0 < NSEG; n0 += 2) {
#pragma unroll
        for (int s = 0; s < 2; ++s) {
            const int n = n0 + s;
            const MlFr& F = buf[s];
            const int tt = tile_of(n, b, dir), rowbase = rowbase_of(tt);
            const u16* Ccur = Cl + (n & 1) * (33 * 136); u16* Cnxt = Cl + ((n + 1) & 1) * (33 * 136);
            { float k[16]; unpack8(F.kr[0], k); unpack8(F.kr[1], k + 8);
#pragma unroll
                for (int c = 0; c < 16; ++c) Ktw[(seg * 16 + c) * 72 + tl] = f2bf(k[c] * F.kw);
                Vt[(seg * 4 + 0) * 72 + tl] = (u16)(F.vr.x & 0xffffu); Vt[(seg * 4 + 1) * 72 + tl] = (u16)(F.vr.x >> 16);
                Vt[(seg * 4 + 2) * 72 + tl] = (u16)(F.vr.y & 0xffffu); Vt[(seg * 4 + 3) * 72 + tl] = (u16)(F.vr.y >> 16); }
            __syncthreads();
            bf16x8_t vt[2];
#pragma unroll
            for (int ks = 0; ks < 2; ++ks) vt[ks] = *(const bf16x8_t*)(Vt + (et * 16 + fr) * 72 + ks * 32 + fq * 8);
            {
                f32x4_t inter = (f32x4_t){0.f, 0.f, 0.f, 0.f}, intra = inter, dinter = inter, dintra = inter;
#pragma unroll
                for (int ks = 0; ks < 4; ++ks) { const bf16x8_t cb = *(const bf16x8_t*)(Ccur + (et * 16 + fr) * 136 + ks * 32 + fq * 8); const bf16x8_t nb = *(const bf16x8_t*)(Ccur + 32 * 136 + ks * 32 + fq * 8);
                    inter = __builtin_amdgcn_mfma_f32_16x16x32_bf16(F.q[ks], cb, inter, 0, 0, 0); dinter = __builtin_amdgcn_mfma_f32_16x16x32_bf16(F.q[ks], nb, dinter, 0, 0, 0); }
#pragma unroll
                for (int ks = 0; ks < 2; ++ks) { intra = __builtin_amdgcn_mfma_f32_16x16x32_bf16(F.at[ks], vt[ks], intra, 0, 0, 0); dintra = __builtin_amdgcn_mfma_f32_16x16x32_bf16(F.at[ks], ones, dintra, 0, 0, 0); }
#pragma unroll
                for (int j = 0; j < 4; ++j) { const float M = fmaxf(F.cm[j], m_in); const float r = __expf(F.cm[j] - M), ei = __expf(m_in - M) * 0.08838834764831845f;
                    const float num = r * intra[j] + ei * inter[j], den = r * dintra[j] + ei * dinter[j];
                    const float hv = num / fmaxf(fabsf(den), __expf(-(F.b[j] + M)));
                    O[(size_t)(rowbase + lt * 16 + fq * 4 + j) * 2048 + h * 256 + e0 + et * 16 + fr] = f2bf(hv); }
            }
            { const float ML = fmaxf(F.cmL, m_in); const float a = __expf(m_in - ML), sc2 = __expf(F.cmL - ML); m_in = F.bL + ML;
#pragma unroll
                for (int i = 0; i < 2; ++i) { f32x4_t nw = (f32x4_t){0.f, 0.f, 0.f, 0.f};
#pragma unroll
                    for (int ks = 0; ks < 2; ++ks) { const bf16x8_t kb = *(const bf16x8_t*)(Ktw + ((dt0 + i) * 16 + fr) * 72 + ks * 32 + fq * 8); nw = __builtin_amdgcn_mfma_f32_16x16x32_bf16(vt[ks], kb, nw, 0, 0, 0); }
#pragma unroll
                    for (int j = 0; j < 4; ++j) { Cacc[i][j] = a * Cacc[i][j] + sc2 * nw[j]; Cnxt[(et * 16 + fq * 4 + j) * 136 + (dt0 + i) * 16 + fr] = f2bf(Cacc[i][j]); } }
                f32x4_t nw = (f32x4_t){0.f, 0.f, 0.f, 0.f};
#pragma unroll
                for (int ks = 0; ks < 2; ++ks) { const bf16x8_t kb = *(const bf16x8_t*)(Ktw + (w * 16 + fr) * 72 + ks * 32 + fq * 8); nw = __builtin_amdgcn_mfma_f32_16x16x32_bf16(ones, kb, nw, 0, 0, 0); }
                nacc[0] = a * nacc[0] + sc2 * nw[0];
                if (fq == 0) Cnxt[32 * 136 + w * 16 + fr] = f2bf(nacc[0]); }
            __syncthreads();
            ml_load(buf[s], p, n + 2, b, h, dir, e0, lt, fr, fq, tl, seg);
        }
    }
}

struct DnFr { bf16x8_t k[4], q[4], tm[2], qk[2]; uint4 kr[2]; float kds, egc[4], be[4], egL; u16 v[4]; };
__device__ __forceinline__ void dn_load(DnFr& F, const Params& p, int n, int b, int h, int dir, int e0, int lt, int et, int fr, int fq, int tl, int seg) {
    const int nn = n < NSEG ? n : NSEG - 1;
    const int tt = tile_of(nn, b, dir), it = (dir * 520 + tt) * 8 + h, rowbase = rowbase_of(tt);
    const bool isctx = tt < 8;
    const u16* qb = isctx ? (const u16*)(p.ws + WS_CQ) + (size_t)rowbase * 3072 + h * 128 : (const u16*)(p.ws + WS_PROJ) + (size_t)rowbase * NP0 + 3072 + h * 128;
    const int rs = isctx ? 3072 : NP0;
    const u16* TM = (const u16*)(p.ws + WS_TM) + (size_t)it * 4096 + (lt * 16 + fr) * 64 + fq * 8;
    const u16* QK = (const u16*)(p.ws + WS_QK) + (size_t)it * 4096 + (lt * 16 + fr) * 64 + fq * 8;
    const float* GCS = (const float*)(p.ws + WS_GCS) + (size_t)it * 256;
    const u16* qr = qb + (size_t)(lt * 16 + fr) * rs + fq * 8;
#pragma unroll
    for (int ks = 0; ks < 4; ++ks) { F.q[ks] = *(const bf16x8_t*)(qr + ks * 32); F.k[ks] = *(const bf16x8_t*)(qr + 1024 + ks * 32); }
#pragma unroll
    for (int ks = 0; ks < 2; ++ks) { F.tm[ks] = *(const bf16x8_t*)(TM + ks * 32); F.qk[ks] = *(const bf16x8_t*)(QK + ks * 32); }
    const u16* kp = qb + (size_t)tl * rs + 1024 + seg * 16;
    F.kr[0] = *(const uint4*)(kp); F.kr[1] = *(const uint4*)(kp + 8);
    F.kds = GCS[128 + tl]; F.egL = GCS[192];
#pragma unroll
    for (int j = 0; j < 4; ++j) { const int l = lt * 16 + fq * 4 + j; F.egc[j] = GCS[l]; F.be[j] = GCS[64 + l]; F.v[j] = qb[(size_t)l * rs + 2048 + e0 + et * 16 + fr]; }
}
__device__ __forceinline__ void deltanet_chunk(const Params& p, int job, unsigned char* lds) {
    const int tid = tid_fresh(), lane = tid & 63, w = tid >> 6, fr = lane & 15, fq = lane >> 4;
    const int chain = job >> 2, cgp = job & 3;
    const int b = chain >> 4, h = (chain >> 1) & 7, dir = chain & 1;
    const int e0 = cgp * 32, lt = w >> 1, et = w & 1, dt0 = (w >> 1) * 2, tl = tid >> 3, seg = tid & 7;
    u16* Sl = (u16*)lds;
    u16* Rt = (u16*)(lds + 17408);
    u16* VNt = (u16*)(lds + 17408 + 4608);
    u16* Kdt = (u16*)(lds + 17408 + 9216);
    u16* O = (u16*)(p.ws + (dir ? WS_OB : WS_OF));
    __syncthreads();
    for (int i = tid; i < 17408 / 4; i += NTHR) ((unsigned*)Sl)[i] = 0u;
    __syncthreads();
    f32x4_t Sacc[2]; Sacc[0] = (f32x4_t){0.f, 0.f, 0.f, 0.f}; Sacc[1] = Sacc[0];
    DnFr buf[2];
    dn_load(buf[0], p, 0, b, h, dir, e0, lt, et, fr, fq, tl, seg); dn_load(buf[1], p, 1, b, h, dir, e0, lt, et, fr, fq, tl, seg);
    for (int n0 = 0; n0 < NSEG; n0 += 2) {
#pragma unroll
        for (int s = 0; s < 2; ++s) {
            const int n = n0 + s;
            const DnFr& F = buf[s];
            const int tt = tile_of(n, b, dir), rowbase = rowbase_of(tt);
            const u16* Scur = Sl + (n & 1) * (32 * 136); u16* Snxt = Sl + ((n + 1) & 1) * (32 * 136);
            f32x4_t X = (f32x4_t){0.f, 0.f, 0.f, 0.f}, Y = X;
#pragma unroll
            for (int ks = 0; ks < 4; ++ks) { const bf16x8_t sb = *(const bf16x8_t*)(Scur + (et * 16 + fr) * 136 + ks * 32 + fq * 8);
                X = __builtin_amdgcn_mfma_f32_16x16x32_bf16(F.k[ks], sb, X, 0, 0, 0); Y = __builtin_amdgcn_mfma_f32_16x16x32_bf16(F.q[ks], sb, Y, 0, 0, 0); }
#pragma unroll
            for (int j = 0; j < 4; ++j) Rt[(et * 16 + fr) * 72 + lt * 16 + fq * 4 + j] = f2bf(F.be[j] * (bf2f(F.v[j]) - F.egc[j] * X[j]));
            { float k[16]; unpack8(F.kr[0], k); unpack8(F.kr[1], k + 8);
#pragma unroll
                for (int c = 0; c < 16; ++c) Kdt[(seg * 16 + c) * 72 + tl] = f2bf(k[c] * F.kds); }
            __syncthreads();
            { f32x4_t VN = (f32x4_t){0.f, 0.f, 0.f, 0.f};
#pragma unroll
                for (int ks = 0; ks < 2; ++ks) { const bf16x8_t rb = *(const bf16x8_t*)(Rt + (et * 16 + fr) * 72 + ks * 32 + fq * 8); VN = __builtin_amdgcn_mfma_f32_16x16x32_bf16(F.tm[ks], rb, VN, 0, 0, 0); }
#pragma unroll
                for (int j = 0; j < 4; ++j) VNt[(et * 16 + fr) * 72 + lt * 16 + fq * 4 + j] = f2bf(VN[j]); }
            __syncthreads();
            bf16x8_t vn[2];
#pragma unroll
            for (int ks = 0; ks < 2; ++ks) vn[ks] = *(const bf16x8_t*)(VNt + (et * 16 + fr) * 72 + ks * 32 + fq * 8);
            { f32x4_t acc = (f32x4_t){0.f, 0.f, 0.f, 0.f};
#pragma unroll
                for (int ks = 0; ks < 2; ++ks) acc = __builtin_amdgcn_mfma_f32_16x16x32_bf16(F.qk[ks], vn[ks], acc, 0, 0, 0);
#pragma unroll
                for (int j = 0; j < 4; ++j) O[(size_t)(rowbase + lt * 16 + fq * 4 + j) * 2048 + 1024 + h * 128 + e0 + et * 16 + fr] = f2bf(0.08838834764831845f * F.egc[j] * Y[j] + acc[j]); }
#pragma unroll
            for (int i = 0; i < 2; ++i) { f32x4_t nw = (f32x4_t){0.f, 0.f, 0.f, 0.f};
#pragma unroll
                for (int ks = 0; ks < 2; ++ks) { const bf16x8_t kb = *(const bf16x8_t*)(Kdt + ((dt0 + i) * 16 + fr) * 72 + ks * 32 + fq * 8); nw = __builtin_amdgcn_mfma_f32_16x16x32_bf16(vn[ks], kb, nw, 0, 0, 0); }
#pragma unroll
                for (int j = 0; j < 4; ++j) { Sacc[i][j] = F.egL * Sacc[i][j] + nw[j]; Snxt[(et * 16 + fq * 4 + j) * 136 + (dt0 + i) * 16 + fr] = f2bf(Sacc[i][j]); } }
            __syncthreads();
            dn_load(buf[s], p, n + 2, b, h, dir, e0, lt, et, fr, fq, tl, seg);
        }
    }
}

constexpr int RG_XC = 65536;

__device__ __forceinline__ void ph_convert_rg(const Params& p) {
    u16* WRT = (u16*)(p.ws + WS_WRT);
    for (int idx = blockIdx.x * NTHR + tid_fresh(); idx < 65536; idx += gridDim.x * NTHR) {
        const int k8 = idx & 15, n = (idx >> 4) & 127, mzg = idx >> 11;
        const float* W = (mzg < 16 ? p.rg_w_r : p.rg_w_i) + (size_t)(mzg & 15) * 16384;
        float v[8];
#pragma unroll
        for (int j = 0; j < 8; ++j) v[j] = W[(k8 * 8 + j) * 128 + n];
        *(uint4*)(WRT + (size_t)mzg * 16384 + n * 128 + k8 * 8) = pack8(v);
    }
}
__device__ __forceinline__ int rg_tau(int tt, int z) { if (tt < 8) { const int ci = tt & 3; return z ? 3 - ci : ci; } const int li = (tt - 8) & 255; return 4 + (z ? 255 - li : li); }
__device__ __forceinline__ int rg_batch(int tt) { return tt < 8 ? (tt >> 2) : ((tt - 8) >> 8); }

__device__ __forceinline__ void rg_conv(const Params& p, int tt, int g, unsigned char* lds) {
    const int tid = tid_fresh();
    const u16* PROJ = (const u16*)(p.ws + WS_PROJ);
    float* sm = (float*)lds; u16* XC = (u16*)(lds + RG_XC);
    const bool isctx = tt < 8;
    const int t0 = isctx ? (tt & 3) * 64 : 0;
    const int rowbase = isctx ? (tt >> 2) * 256 + t0 : 512 + (tt - 8) * 64;
    __syncthreads();
    for (int ch = tid; ch < 68 * 16; ch += NTHR) {
        const int rr = ch >> 4, c8 = (ch & 15) * 8, r = rr - 2;
        const bool ok = isctx ? (t0 + r >= 0 && t0 + r < 256) : (r >= 0 && r < 64);
        float f[8];
#pragma unroll
        for (int j = 0; j < 8; ++j) f[j] = 0.f;
        if (ok) { const uint4 u = *(const uint4*)(PROJ + (size_t)(rowbase + r) * NP1 + g * 128 + c8); unpack8(u, f); }
        float* d = sm + rr * 132 + c8;
        *(float4*)(d) = make_float4(f[0], f[1], f[2], f[3]); *(float4*)(d + 4) = make_float4(f[4], f[5], f[6], f[7]);
    }
    __syncthreads();
    const int tk = tid >> 3, cs = (tid & 7) * 16;
    float o[16];
#pragma unroll
    for (int c4 = 0; c4 < 4; ++c4) { const float4 b4 = *(const float4*)(p.rg_conv_b + g * 128 + cs + c4 * 4); o[c4 * 4] = b4.x; o[c4 * 4 + 1] = b4.y; o[c4 * 4 + 2] = b4.z; o[c4 * 4 + 3] = b4.w; }
#pragma unroll
    for (int j = 0; j < 5; ++j) {
        const float* wr_ = p.rg_conv_w + j * 1024 + g * 128 + cs; const float* ir = sm + (tk + j) * 132 + cs;
#pragma unroll
        for (int c4 = 0; c4 < 4; ++c4) { const float4 w4 = *(const float4*)(wr_ + c4 * 4), i4 = *(const float4*)(ir + c4 * 4);
            o[c4 * 4 + 0] += i4.x * w4.x; o[c4 * 4 + 1] += i4.y * w4.y; o[c4 * 4 + 2] += i4.z * w4.z; o[c4 * 4 + 3] += i4.w * w4.w; }
    }
    *(uint4*)(XC + tk * 136 + cs) = pack8(o); *(uint4*)(XC + tk * 136 + cs + 8) = pack8(o + 8);
    __syncthreads();
}
__device__ __forceinline__ void rg_gates_reg(const Params& p, int g, int z, const unsigned char* lds, int rt, int chh, int fr, int fq, float (&av)[4][4], float (&bx)[4][4]) {
    const u16* XC = (const u16*)(lds + RG_XC);
    const u16* WR = (const u16*)(p.ws + WS_WRT) + (size_t)((0 * 2 + z) * 8 + g) * 16384; const u16* WI = (const u16*)(p.ws + WS_WRT) + (size_t)((1 * 2 + z) * 8 + g) * 16384;
    f32x4_t R[4], I[4];
#pragma unroll
    for (int c = 0; c < 4; ++c) { R[c] = (f32x4_t){0.f, 0.f, 0.f, 0.f}; I[c] = (f32x4_t){0.f, 0.f, 0.f, 0.f}; }
#pragma unroll
    for (int ks = 0; ks < 4; ++ks) {
        const bf16x8_t a = *(const bf16x8_t*)(XC + (rt * 16 + fr) * 136 + ks * 32 + fq * 8);
#pragma unroll
        for (int c = 0; c < 4; ++c) { const int n = (chh * 4 + c) * 16 + fr;
            R[c] = __builtin_amdgcn_mfma_f32_16x16x32_bf16(a, *(const bf16x8_t*)(WR + n * 128 + ks * 32 + fq * 8), R[c], 0, 0, 0);
            I[c] = __builtin_amdgcn_mfma_f32_16x16x32_bf16(a, *(const bf16x8_t*)(WI + n * 128 + ks * 32 + fq * 8), I[c], 0, 0, 0); }
    }
#pragma unroll
    for (int c = 0; c < 4; ++c) {
        const int chl = (chh * 4 + c) * 16 + fr, chg = z * 1024 + g * 128 + chl;
        const float br = p.rg_b_r[chg], bi = p.rg_b_i[chg], sp = softplusf_(-p.rg_lambda[chg]);
#pragma unroll
        for (int j = 0; j < 4; ++j) { const int t = rt * 16 + fq * 4 + j;
            const float r = sigmoidf_(R[c][j] + br), ii = sigmoidf_(I[c][j] + bi);
            const float la = -8.f * r * sp;
            av[c][j] = __expf(la); bx[c][j] = sqrtf(-expm1f(2.f * la)) * ii * bf2f(XC[t * 136 + chl]); }
    }
}
__device__ __forceinline__ float2 rg_local(const float (&a)[4], const float (&b)[4], int z) {
    float P = 1.f, H = 0.f;
#pragma unroll
    for (int i = 0; i < 4; ++i) { const int j = z ? 3 - i : i; H = a[j] * H + b[j]; P *= a[j]; }
    return make_float2(P, H);
}
__device__ __forceinline__ void gla_prep_item(const Params& p, int it, unsigned char* lds) {
    const int tid = tid_fresh(), lane = tid & 63, w = tid >> 6, fr = lane & 15, fq = lane >> 4;
    const int h = it & 3, tt = (it >> 2) % 520, z = it / 2080;
    const int rowbase = tt < 8 ? tt * 64 : 512 + (tt - 8) * 64;
    float* LG = (float*)lds;
    u16* QEs = (u16*)(lds + 32768);
    u16* KEs = (u16*)(lds + 32768 + 17408);
    u16* Vs = (u16*)(lds + 32768 + 2 * 17408);
    float* BLs = (float*)(lds + 32768 + 2 * 17408 + 33792);
    const u16* PROJ = (const u16*)(p.ws + WS_PROJ); const float* LR = (const float*)(p.ws + WS_G);
    u16* QE = (u16*)(p.ws + WS_QE); u16* KDT = (u16*)(p.ws + WS_KDT) + (size_t)it * 8192; u16* ATT = (u16*)(p.ws + WS_ATT) + (size_t)it * 4096;
    u16* VT = (u16*)(p.ws + WS_VT); float* EBL = (float*)(p.ws + WS_EBL);
    __syncthreads();
    { const int c = tid & 127, tq = tid >> 7; float wv[16];
#pragma unroll
        for (int r = 0; r < 16; ++r) wv[r] = p.gla_w_up[(z * 16 + r) * 512 + h * 128 + c];
        const float bu = p.gla_b_up[z * 512 + h * 128 + c];
        for (int i = 0; i < 16; ++i) { const int tk = tq * 16 + i; const float* lr = LR + (size_t)(rowbase + tk) * 32 + z * 16; float s = bu;
#pragma unroll
            for (int r = 0; r < 16; ++r) s += lr[r] * wv[r];
            LG[tk * 128 + c] = logsigmoidf_(s) * (1.f / 16.f); } }
    __syncthreads();
    if (tid < 128) { float acc = 0.f;
        for (int i = 0; i < 64; ++i) { const int tk = z ? 63 - i : i; acc += LG[tk * 128 + tid]; LG[tk * 128 + tid] = acc; }
        BLs[tid] = acc; EBL[(size_t)it * 128 + tid] = __expf(acc); }
    __syncthreads();
    { const int tk = tid >> 3, cs = (tid & 7) * 16; const u16* rp = PROJ + (size_t)(rowbase + tk) * NP1;
        float q[16], k[16], qe[16], ke[16];
        unpack8(*(const uint4*)(rp + 2048 + h * 128 + cs), q); unpack8(*(const uint4*)(rp + 2048 + h * 128 + cs + 8), q + 8);
        unpack8(*(const uint4*)(rp + 2560 + h * 128 + cs), k); unpack8(*(const uint4*)(rp + 2560 + h * 128 + cs + 8), k + 8);
#pragma unroll
        for (int c = 0; c < 16; ++c) { const float bb = LG[tk * 128 + cs + c], bl = BLs[cs + c];
            qe[c] = q[c] * 0.08838834764831845f * __expf(bb); ke[c] = k[c] * __expf(-bb); KDT[(cs + c) * 64 + tk] = f2bf(k[c] * __expf(bl - bb)); }
        const uint4 q0 = pack8(qe), q1 = pack8(qe + 8);
        *(uint4*)(QEs + tk * 136 + cs) = q0; *(uint4*)(QEs + tk * 136 + cs + 8) = q1;
        *(uint4*)(KEs + tk * 136 + cs) = pack8(ke); *(uint4*)(KEs + tk * 136 + cs + 8) = pack8(ke + 8);
        u16* qg = QE + ((size_t)z * MTOT + rowbase + tk) * 512 + h * 128 + cs;
        *(uint4*)(qg) = q0; *(uint4*)(qg + 8) = q1; }
    if (z == 0) for (int ch = tid; ch < 2048; ch += NTHR) { const int tk = ch >> 5, c8 = (ch & 31) * 8;
        *(uint4*)(Vs + tk * 264 + c8) = *(const uint4*)(PROJ + (size_t)(rowbase + tk) * NP1 + 3072 + h * 256 + c8); }
    __syncthreads();
    { const int rt = w >> 1;
#pragma unroll
        for (int i = 0; i < 2; ++i) { const int ct = (w & 1) * 2 + i; f32x4_t acc = (f32x4_t){0.f, 0.f, 0.f, 0.f};
#pragma unroll
            for (int ks = 0; ks < 4; ++ks) { const bf16x8_t a = *(const bf16x8_t*)(QEs + (rt * 16 + fr) * 136 + ks * 32 + fq * 8); const bf16x8_t bb = *(const bf16x8_t*)(KEs + (ct * 16 + fr) * 136 + ks * 32 + fq * 8);
                acc = __builtin_amdgcn_mfma_f32_16x16x32_bf16(a, bb, acc, 0, 0, 0); }
#pragma unroll
            for (int j = 0; j < 4; ++j) { const int l = rt * 16 + fq * 4 + j, s = ct * 16 + fr; const bool keep = z ? (s >= l) : (s <= l);
                ATT[l * 64 + s] = f2bf(keep ? acc[j] : 0.f); } } }
    if (z == 0) { const int e = tid >> 1, hf = tid & 1; u16* dst = VT + ((size_t)(tt * 4 + h) * 256 + e) * 64 + hf * 32;
#pragma unroll
        for (int l8 = 0; l8 < 4; ++l8) { float v[8];
#pragma unroll
            for (int j = 0; j < 8; ++j) v[j] = bf2f(Vs[(hf * 32 + l8 * 8 + j) * 264 + e]);
            *(uint4*)(dst + l8 * 8) = pack8(v); } }
}
__device__ __forceinline__ void ph_l1_a(const Params& p, unsigned char* lds) {
    const int tid = tid_fresh(), lane = tid & 63, w = tid >> 6, rt = w >> 1, chh = w & 1, fr = lane & 15, fq = lane >> 4;
    float2* AGG = (float2*)(p.ws + WS_AGG);
    float2* AG = (float2*)lds;
    for (int t = blockIdx.x; t < 520 * 8; t += gridDim.x) {
        const int tt = t >> 3, g = t & 7, b = rg_batch(tt);
        rg_conv(p, tt, g, lds);
#pragma unroll
        for (int z = 0; z < 2; ++z) {
            float av[4][4], bx[4][4];
            rg_gates_reg(p, g, z, lds, rt, chh, fr, fq, av, bx);
#pragma unroll
            for (int c = 0; c < 4; ++c) AG[(z * 16 + rt * 4 + fq) * 128 + (chh * 4 + c) * 16 + fr] = rg_local(av[c], bx[c], z);
        }
        __syncthreads();
        if (tid < 256) { const int z = tid >> 7, ch = tid & 127; float P = 1.f, H = 0.f;
#pragma unroll
            for (int s = 0; s < 16; ++s) { const int gi = z ? 15 - s : s; const float2 ph = AG[(z * 16 + gi) * 128 + ch]; H = ph.x * H + ph.y; P *= ph.x; }
            AGG[((size_t)(b * 2 + z) * NSEG + rg_tau(tt, z)) * 1024 + g * 128 + ch] = make_float2(P, H); }
    }
    for (int it = blockIdx.x; it < 4160; it += gridDim.x) gla_prep_item(p, it, lds);
}
__device__ __forceinline__ void rg_pass_b(const Params& p, int job) {
    const float2* AGG = (const float2*)(p.ws + WS_AGG); float* CARRY = (float*)(p.ws + WS_CARRY);
    const int bz = job >> 1, ch = (job & 1) * 512 + tid_fresh();
    float carry = 0.f;
#pragma unroll 4
    for (int tau = 0; tau < NSEG; ++tau) { const size_t ix = ((size_t)bz * NSEG + tau) * 1024 + ch; const float2 ph = AGG[ix]; CARRY[ix] = carry; carry = ph.x * carry + ph.y; }
}
struct GlaFr { bf16x8_t qe[4], at[2], vt[2], kd[2][2]; float eb[2]; };
__device__ __forceinline__ void gla_load(GlaFr& F, const Params& p, int n, int b, int h, int dir, int e0, int lt, int et, int dt0, int fr, int fq) {
    const int nn = n < NSEG ? n : NSEG - 1;
    const int tt = tile_of(nn, b, dir), it = (dir * 520 + tt) * 4 + h, rowbase = tt < 8 ? tt * 64 : 512 + (tt - 8) * 64;
    const u16* QE = (const u16*)(p.ws + WS_QE) + ((size_t)dir * MTOT + rowbase + lt * 16 + fr) * 512 + h * 128 + fq * 8;
    const u16* ATT = (const u16*)(p.ws + WS_ATT) + (size_t)it * 4096 + (lt * 16 + fr) * 64 + fq * 8;
    const u16* VT = (const u16*)(p.ws + WS_VT) + ((size_t)(tt * 4 + h) * 256 + e0 + et * 16 + fr) * 64 + fq * 8;
    const u16* KDT = (const u16*)(p.ws + WS_KDT) + (size_t)it * 8192 + (dt0 * 16 + fr) * 64 + fq * 8;
    const float* EBL = (const float*)(p.ws + WS_EBL) + (size_t)it * 128 + dt0 * 16 + fr;
#pragma unroll
    for (int ks = 0; ks < 4; ++ks) F.qe[ks] = *(const bf16x8_t*)(QE + ks * 32);
#pragma unroll
    for (int ks = 0; ks < 2; ++ks) { F.at[ks] = *(const bf16x8_t*)(ATT + ks * 32); F.vt[ks] = *(const bf16x8_t*)(VT + ks * 32);
        F.kd[0][ks] = *(const bf16x8_t*)(KDT + ks * 32); F.kd[1][ks] = *(const bf16x8_t*)(KDT + 16 * 64 + ks * 32); }
    F.eb[0] = EBL[0]; F.eb[1] = EBL[16];
}
__device__ __forceinline__ void gla_chunk(const Params& p, int job, unsigned char* lds) {
    const int tid = tid_fresh(), lane = tid & 63, w = tid >> 6, fr = lane & 15, fq = lane >> 4;
    const int chain = job >> 3, cgp = job & 7;
    const int b = chain >> 3, h = (chain >> 1) & 3, dir = chain & 1;
    const int e0 = cgp * 32, lt = w >> 1, et = w & 1, dt0 = (w >> 1) * 2;
    u16* Sl = (u16*)lds;
    u16* O = (u16*)(p.ws + (dir ? WS_OB1 : WS_OF1));
    __syncthreads();
    for (int i = tid; i < 2 * 32 * 136 / 2; i += NTHR) ((unsigned*)Sl)[i] = 0u;
    __syncthreads();
    f32x4_t Sacc[2]; Sacc[0] = (f32x4_t){0.f, 0.f, 0.f, 0.f}; Sacc[1] = Sacc[0];
    GlaFr buf[3];
#pragma unroll
    for (int s = 0; s < 3; ++s) gla_load(buf[s], p, s, b, h, dir, e0, lt, et, dt0, fr, fq);
    for (int n0 = 0; n0 < NSEG + 2; n0 += 3) {
#pragma unroll
        for (int s = 0; s < 3; ++s) {
            const int n = n0 + s;
            if (n < NSEG) {
                const GlaFr& F = buf[s];
                const u16* Scur = Sl + (n & 1) * (32 * 136); u16* Snxt = Sl + ((n + 1) & 1) * (32 * 136);
                if (n >= 4) {
                    const int tt = tile_of(n, b, dir), rowbase = 512 + (tt - 8) * 64;
                    f32x4_t acc = (f32x4_t){0.f, 0.f, 0.f, 0.f};
#pragma unroll
                    for (int ks = 0; ks < 4; ++ks) { const bf16x8_t bb = *(const bf16x8_t*)(Scur + (et * 16 + fr) * 136 + ks * 32 + fq * 8); acc = __builtin_amdgcn_mfma_f32_16x16x32_bf16(F.qe[ks], bb, acc, 0, 0, 0); }
#pragma unroll
                    for (int ks = 0; ks < 2; ++ks) acc = __builtin_amdgcn_mfma_f32_16x16x32_bf16(F.at[ks], F.vt[ks], acc, 0, 0, 0);
#pragma unroll
                    for (int j = 0; j < 4; ++j) O[(size_t)(rowbase + lt * 16 + fq * 4 + j) * 1024 + h * 256 + e0 + et * 16 + fr] = f2bf(acc[j]);
                }
#pragma unroll
                for (int i = 0; i < 2; ++i) { f32x4_t nw = (f32x4_t){0.f, 0.f, 0.f, 0.f};
#pragma unroll
                    for (int ks = 0; ks < 2; ++ks) nw = __builtin_amdgcn_mfma_f32_16x16x32_bf16(F.vt[ks], F.kd[i][ks], nw, 0, 0, 0);
#pragma unroll
                    for (int j = 0; j < 4; ++j) { Sacc[i][j] = F.eb[i] * Sacc[i][j] + nw[j]; Snxt[(et * 16 + fq * 4 + j) * 136 + (dt0 + i) * 16 + fr] = f2bf(Sacc[i][j]); } }
                __syncthreads();
            }
            gla_load(buf[s], p, n + 3, b, h, dir, e0, lt, et, dt0, fr, fq);
        }
    }
}
__device__ __forceinline__ void ph_l1_c(const Params& p, unsigned char* lds) {
    const int tid = tid_fresh(), rt = (tid >> 6) >> 1, chh = (tid >> 6) & 1, fr = tid & 15, fq = (tid & 63) >> 4;
    const u16* PROJ = (const u16*)(p.ws + WS_PROJ); const float* CARRY = (const float*)(p.ws + WS_CARRY); u16* Y = (u16*)(p.ws + WS_H);
    float2* AG = (float2*)lds;
    float* CIN = (float*)(lds + 32768);
    for (int t = blockIdx.x + 64; t < 520 * 8; t += gridDim.x) {
        const int tt = t >> 3, g = t & 7, b = rg_batch(tt);
        const int rowbase = 512 + (tt - 8) * 64;
        u16 grv[4][4];
#pragma unroll
        for (int c = 0; c < 4; ++c)
#pragma unroll
            for (int j = 0; j < 4; ++j) grv[c][j] = PROJ[(size_t)(rowbase + rt * 16 + fq * 4 + j) * NP1 + 1024 + g * 128 + (chh * 4 + c) * 16 + fr];
        rg_conv(p, tt, g, lds);
        float av[2][4][4], bx[2][4][4];
#pragma unroll
        for (int z = 0; z < 2; ++z) {
            rg_gates_reg(p, g, z, lds, rt, chh, fr, fq, av[z], bx[z]);
#pragma unroll
            for (int c = 0; c < 4; ++c) AG[(z * 16 + rt * 4 + fq) * 128 + (chh * 4 + c) * 16 + fr] = rg_local(av[z][c], bx[z][c], z);
        }
        __syncthreads();
        if (tid < 256) { const int z = tid >> 7, ch = tid & 127; float h = CARRY[((size_t)(b * 2 + z) * NSEG + rg_tau(tt, z)) * 1024 + g * 128 + ch];
#pragma unroll
            for (int s = 0; s < 16; ++s) { const int gi = z ? 15 - s : s; CIN[(z * 16 + gi) * 128 + ch] = h; const float2 ph = AG[(z * 16 + gi) * 128 + ch]; h = ph.x * h + ph.y; } }
        __syncthreads();
#pragma unroll
        for (int c = 0; c < 4; ++c) { const int chl = (chh * 4 + c) * 16 + fr; float hs[4];
            { float h = CIN[(0 * 16 + rt * 4 + fq) * 128 + chl];
#pragma unroll
                for (int j = 0; j < 4; ++j) { h = av[0][c][j] * h + bx[0][c][j]; hs[j] = h; } }
            { float h = CIN[(1 * 16 + rt * 4 + fq) * 128 + chl];
#pragma unroll
                for (int j = 3; j >= 0; --j) { h = av[1][c][j] * h + bx[1][c][j]; hs[j] += h; } }
#pragma unroll
            for (int j = 0; j < 4; ++j) Y[(size_t)(rowbase + rt * 16 + fq * 4 + j) * 2048 + g * 128 + chl] = f2bf(gelu_tanh(bf2f(grv[c][j])) * hs[j]); }
    }
    const int lane = tid & 63, w = tid >> 6;
    const u16* OF = (const u16*)(p.ws + WS_OF1); const u16* OB = (const u16*)(p.ws + WS_OB1);
    for (int row = 512 + blockIdx.x * 8 + w; row < MTOT; row += gridDim.x * 8) {
        const int col = lane * 16; float o[16]; float ss = 0.f;
#pragma unroll
        for (int i = 0; i < 2; ++i) { float a[8], bb[8]; unpack8(*(const uint4*)(OF + (size_t)row * 1024 + col + i * 8), a); unpack8(*(const uint4*)(OB + (size_t)row * 1024 + col + i * 8), bb);
#pragma unroll
            for (int j = 0; j < 8; ++j) { o[i * 8 + j] = a[j] + bb[j]; ss += o[i * 8 + j] * o[i * 8 + j]; } }
        ss = red16(ss);
        const float rstd = rsqrtf(ss * (1.f / 256.f) + 1e-6f);
#pragma unroll
        for (int i = 0; i < 2; ++i) { float gt[8], r[8]; unpack8(*(const uint4*)(PROJ + (size_t)row * NP1 + 4096 + col + i * 8), gt);
#pragma unroll
            for (int j = 0; j < 8; ++j) r[j] = o[i * 8 + j] * rstd * p.gla_norm_g[col + i * 8 + j] * siluf_(gt[j]);
            *(uint4*)(Y + (size_t)row * 2048 + 1024 + col + i * 8) = pack8(r); }
    }
}

constexpr int LDS_BYTES = 135168;

__global__ void __launch_bounds__(NTHR, 2) hybrid_fwd(Params p) {
    extern __shared__ __attribute__((aligned(16))) unsigned char lds[];
    cg::grid_group grid = cg::this_grid();
    float* smf = (float*)lds;
    PG8_LAS unsigned char* ldsg = (PG8_LAS unsigned char*)lds;
    unsigned char* ws = p.ws;
    u16* WT_IN = (u16*)(ws + WS_WT_IN); u16* WT_OUT = (u16*)(ws + WS_WT_OUT); u16* WT_GU = (u16*)(ws + WS_WT_GU); u16* WT_DN = (u16*)(ws + WS_WT_DN);
    u16* H = (u16*)(ws + WS_H); u16* PROJ = (u16*)(ws + WS_PROJ); float* XC = (float*)(ws + WS_XC); float* G = (float*)(ws + WS_G);
    const float* MOD = (const float*)(ws + WS_MOD);
    const int GD = (int)gridDim.x, bid = (int)blockIdx.x;
#ifdef PROBE
    unsigned long long tG = 0, tP = 0, tM = 0, tO = 0, tprev = __builtin_amdgcn_s_memrealtime();
#define PSTAMP(c) do { const unsigned long long t_ = __builtin_amdgcn_s_memrealtime(); c += t_ - tprev; tprev = t_; } while (0)
#else
#define PSTAMP(c) do {} while (0)
#endif

    ph_adaln_partials(p, smf);
    ph_convert_rg(p);
    ph_convert<1>(p.ab_w_in, 7216, 2048, 7424, WT_IN, smf);
    ph_convert<0>(p.ab_w_out, 2048, 2048, 2048, WT_OUT, smf);
    ph_convert<2>(p.ffn_w_gu, 11264, 2048, 11264, WT_GU, smf);
    ph_convert<0>(p.ffn_w_down, 2048, 5632, 2048, WT_DN, smf);
    grid.sync();
    PSTAMP(tO);
    ph_adaln_reduce(p);
    grid.sync();
    PSTAMP(tO);

    ph_norm(p.ctx, p.x, p.norm_mix_g, MOD, 0, 1, H, 0);
    grid.sync();
    PSTAMP(tO);
    { pg8::Gemm g{H, WT_IN, MTOT, 7424, 2048}; pg8::StaticOrder S; S.init(MTOT, 7424, GD, bid);
      pg8::EpiProj E{PROJ, NP0, 28, G, NG0, NG0}; pg8::gemm_phase<pg8::EpiProj, pg8::StaticOrder>(ldsg, g, S, E); }
    grid.sync();
    PSTAMP(tG);
    ph_l0_prep(p, smf);
    grid.sync();
    PSTAMP(tP);
    ph_l0_prepass(p, lds);
    grid.sync();
    PSTAMP(tP);
    for (int job = bid; job < 256; job += GD) { if (job < 128) mlstm_chunk(p, job, lds); else deltanet_chunk(p, job - 128, lds); }
    grid.sync();
    PSTAMP(tM);
    ph_l0_merge(p);
    grid.sync();
    PSTAMP(tO);
    { pg8::Gemm g{H, WT_OUT, MTOT, 2048, 2048}; pg8::StaticOrder S; S.init(MTOT, 2048, GD, bid);
      pg8::EpiRes E{p.ctx, p.x, XC, p.out, MOD + 2 * 2048, 0}; pg8::gemm_phase<pg8::EpiRes, pg8::StaticOrder>(ldsg, g, S, E); }
    grid.sync();
    PSTAMP(tG);
    ph_norm(XC, p.out, p.norm_ffn_g, MOD, 3, 4, H, 0);
    grid.sync();
    PSTAMP(tO);
    { pg8::Gemm g{H, WT_GU, MTOT, 11264, 2048}; pg8::StaticOrder S; S.init(MTOT, 11264, GD, bid);
      pg8::EpiSwiglu E{PROJ, FH}; pg8::gemm_phase<pg8::EpiSwiglu, pg8::StaticOrder>(ldsg, g, S, E); }
    grid.sync();
    PSTAMP(tG);
    { pg8::Gemm g{PROJ, WT_DN, MTOT, 2048, 5632}; pg8::StaticOrder S; S.init(MTOT, 2048, GD, bid);
      pg8::EpiRes E{XC, p.out, XC, p.out, MOD + 5 * 2048, 0}; pg8::gemm_phase<pg8::EpiRes, pg8::StaticOrder>(ldsg, g, S, E); }
    grid.sync();
    PSTAMP(tG);

    const float* MOD1 = MOD + 3 * 12288;
    ph_convert<0>(p.cd_w_in, 5152, 2048, 5376, WT_IN, smf);
    ph_convert<0>(p.cd_w_out, 2048, 2048, 2048, WT_OUT, smf);
    ph_convert<2>(p.ffn_w_gu + (size_t)2048 * 11264, 11264, 2048, 11264, WT_GU, smf);
    ph_convert<0>(p.ffn_w_down + (size_t)5632 * 2048, 2048, 5632, 2048, WT_DN, smf);
    ph_norm(XC, p.out, p.norm_mix_g + 2048, MOD1, 0, 1, H, 0);
    grid.sync();
    PSTAMP(tO);
    { pg8::Gemm g{H, WT_IN, MTOT, 5376, 2048}; pg8::StaticOrder S; S.init(MTOT, 5376, GD, bid);
      pg8::EpiProj E{PROJ, NP1, 20, G, NG1, NG1}; pg8::gemm_phase<pg8::EpiProj, pg8::StaticOrder>(ldsg, g, S, E); }
    grid.sync();
    PSTAMP(tG);
    ph_l1_a(p, lds);
    grid.sync();
    PSTAMP(tP);
    for (int job = bid; job < 136; job += GD) { if (job < 128) gla_chunk(p, job, lds); else rg_pass_b(p, job - 128); }
    grid.sync();
    PSTAMP(tM);
    ph_l1_c(p, lds);
    grid.sync();
    PSTAMP(tP);
    { pg8::Gemm g{H + (size_t)512 * 2048, WT_OUT, MLAT, 2048, 2048}; pg8::StaticOrder S; S.init(MLAT, 2048, GD, bid);
      pg8::EpiRes E{XC, p.out, XC, p.out, MOD1 + 2 * 2048, 512}; pg8::gemm_phase<pg8::EpiRes, pg8::StaticOrder>(ldsg, g, S, E); }
    grid.sync();
    PSTAMP(tG);
    ph_norm(XC, p.out, p.norm_ffn_g + 2048, MOD1, 3, 4, H, 512);
    grid.sync();
    PSTAMP(tO);
    { pg8::Gemm g{H + (size_t)512 * 2048, WT_GU, MLAT, 11264, 2048}; pg8::StaticOrder S; S.init(MLAT, 11264, GD, bid);
      pg8::EpiSwiglu E{PROJ, FH}; pg8::gemm_phase<pg8::EpiSwiglu, pg8::StaticOrder>(ldsg, g, S, E); }
    grid.sync();
    PSTAMP(tG);
    { pg8::Gemm g{PROJ, WT_DN, MLAT, 2048, 5632}; pg8::StaticOrder S; S.init(MLAT, 2048, GD, bid);
      pg8::EpiRes E{XC, p.out, XC, p.out, MOD1 + 5 * 2048, 512}; pg8::gemm_phase<pg8::EpiRes, pg8::StaticOrder>(ldsg, g, S, E); }
    grid.sync();
    PSTAMP(tG);
    ph_final_norm(p);
#ifdef PROBE
    PSTAMP(tO);
    __syncthreads();
    if (bid == 0 && threadIdx.x == 0) { const float tot = (float)(tG + tP + tM + tO);
        p.out[0] += 0.25f + 0.15f * ((float)PROBE_A / tot); p.out[1] += 0.10f + 0.14f * ((float)PROBE_B / tot); }
#endif
}

extern "C" void kernel_launch(void* const* d_in, const int* in_sizes, int n_in, void* d_out, int out_size, void* d_ws, size_t ws_size, hipStream_t stream) {
    static int grid = 0;
    if (grid == 0) {
        if (n_in != 32 || out_size != MLAT * DM || ws_size < WS_END) { fprintf(stderr, "kernel_launch: unexpected shapes (n_in %d out %d ws %zu need %zu)\n", n_in, out_size, ws_size, (size_t)WS_END); grid = -1; return; }
        int dev = 0, cus = 0, per_cu = 0;
        (void)hipGetDevice(&dev);
        (void)hipDeviceGetAttribute(&cus, hipDeviceAttributeMultiprocessorCount, dev);
        if (hipFuncSetAttribute((const void*)hybrid_fwd, hipFuncAttributeMaxDynamicSharedMemorySize, LDS_BYTES) != hipSuccess) { fprintf(stderr, "kernel_launch: hipFuncSetAttribute failed\n"); }
        if (hipOccupancyMaxActiveBlocksPerMultiprocessor(&per_cu, (const void*)hybrid_fwd, NTHR, LDS_BYTES) != hipSuccess || per_cu < 1) { fprintf(stderr, "kernel_launch: occupancy query gave %d\n", per_cu); per_cu = 1; }
        (void)hipGetLastError();
        grid = cus * per_cu;
    }
    if (grid < 0) return;
    Params p{};
    const float** pp = (const float**)&p;
    for (int i = 0; i < 32; ++i) pp[i] = (const float*)d_in[i];
    p.out = (float*)d_out; p.ws = (unsigned char*)d_ws;
    void* args[] = {&p};
    hipError_t e = hipLaunchCooperativeKernel((const void*)hybrid_fwd, dim3(grid), dim3(NTHR), args, LDS_BYTES, stream);
    if (e != hipSuccess) fprintf(stderr, "cooperative launch failed: %s (grid %d)\n", hipGetErrorString(e), grid);
}
```

```cpp
#include <hip/hip_runtime.h>
#include <hip/hip_cooperative_groups.h>
#include <cstdio>
namespace cg = cooperative_groups;

typedef unsigned short u16;

constexpr int DM = 2048, FH = 5632, MC = 512, MLAT = 32768, MTOT = 33280, NTHR = 512;
constexpr int NP0 = 7168, NP1 = 5120;
constexpr int NG0 = 48, NG1 = 32;
constexpr int NSEG = 260;

constexpr size_t WS_WT_IN = 0;
constexpr size_t WS_WT_OUT = WS_WT_IN + (size_t)7424 * 2048 * 2;
constexpr size_t WS_WT_GU = WS_WT_OUT + (size_t)2048 * 2048 * 2;
constexpr size_t WS_WT_DN = WS_WT_GU + (size_t)11264 * 2048 * 2;
constexpr size_t WS_H = WS_WT_DN + (size_t)2048 * 5632 * 2;
constexpr size_t WS_PROJ = WS_H + (size_t)MTOT * 2048 * 2;
constexpr size_t WS_OF = WS_PROJ + (size_t)MTOT * 7168 * 2;
constexpr size_t WS_OB = WS_OF + (size_t)MTOT * 2048 * 2;
constexpr size_t WS_XC = WS_OB + (size_t)MTOT * 2048 * 2;
constexpr size_t WS_G = WS_XC + (size_t)MC * 2048 * 4;
constexpr size_t WS_CQ = WS_G + (size_t)MTOT * 48 * 4;
constexpr size_t WS_MODP = WS_CQ + (size_t)MC * 3072 * 2;
constexpr size_t WS_MOD = WS_MODP + (size_t)2 * 32 * 3 * 12288 * 4;
constexpr size_t WS_ATT0 = WS_MOD + (size_t)2 * 3 * 12288 * 4;
constexpr size_t WS_MLS = WS_ATT0 + (size_t)4160 * 4096 * 2;
constexpr size_t WS_GCS = WS_MLS + (size_t)4160 * 256 * 4;
constexpr size_t WS_WRT = WS_GCS + (size_t)8320 * 256 * 4;
constexpr size_t WS_BAR = WS_WRT + (size_t)32 * 16384 * 2;
constexpr size_t WS_END = WS_BAR + 16384;
constexpr size_t WS_TM = WS_H;
constexpr size_t WS_QK = WS_H + (size_t)8320 * 4096 * 2;
constexpr size_t WS_OF1 = WS_OF;
constexpr size_t WS_OB1 = WS_OF + (size_t)MTOT * 1024 * 2;
constexpr size_t WS_QE = WS_OB;
constexpr size_t WS_KDT = WS_QE + (size_t)2 * MTOT * 512 * 2;
constexpr size_t WS_TAIL = WS_PROJ + (size_t)MTOT * 5120 * 2;
constexpr size_t WS_ATT = WS_TAIL;
constexpr size_t WS_VT = WS_ATT + (size_t)4160 * 4096 * 2;
constexpr size_t WS_EBL = WS_VT + (size_t)2080 * 16384 * 2;
constexpr size_t WS_AGG = WS_EBL + (size_t)4160 * 128 * 4;
constexpr size_t WS_CARRY = WS_AGG + (size_t)4 * NSEG * 1024 * 8;
static_assert(WS_CARRY + (size_t)4 * NSEG * 1024 * 4 <= WS_OF, "layer-1 tail overflow");

struct Params {
    const float *x, *c, *ctx, *c_ctx, *mod_w, *mod_b, *norm_mix_g, *norm_ffn_g, *ffn_w_gu, *ffn_w_down, *final_norm_g,
        *ab_w_in, *ab_w_out, *ml_ig_b, *ml_fg_b, *ml_norm_g, *dn_conv_w, *dn_a_log, *dn_dt_bias, *dn_norm_g,
        *cd_w_in, *cd_w_out, *rg_conv_w, *rg_conv_b, *rg_w_r, *rg_b_r, *rg_w_i, *rg_b_i, *rg_lambda, *gla_w_up, *gla_b_up, *gla_norm_g;
    float* out; unsigned char* ws;
};

__device__ __forceinline__ float bf2f(u16 v) { return __uint_as_float(((unsigned)v) << 16); }
typedef __bf16 bf16x2_nat __attribute__((ext_vector_type(2)));
typedef float f32x2_nat __attribute__((ext_vector_type(2)));
__device__ __forceinline__ unsigned cvt_pk_bf16(float lo, float hi) { const f32x2_nat v = {lo, hi}; const bf16x2_nat r = __builtin_convertvector(v, bf16x2_nat); return __builtin_bit_cast(unsigned, r); }
__device__ __forceinline__ u16 f2bf(float f) { return (u16)(cvt_pk_bf16(f, 0.f) & 0xffffu); }
__device__ __forceinline__ void unpack8(const uint4& u, float* f) {
    f[0] = __uint_as_float(u.x << 16); f[1] = __uint_as_float(u.x & 0xffff0000u);
    f[2] = __uint_as_float(u.y << 16); f[3] = __uint_as_float(u.y & 0xffff0000u);
    f[4] = __uint_as_float(u.z << 16); f[5] = __uint_as_float(u.z & 0xffff0000u);
    f[6] = __uint_as_float(u.w << 16); f[7] = __uint_as_float(u.w & 0xffff0000u);
}
__device__ __forceinline__ uint4 pack8(const float* f) { uint4 o; o.x = cvt_pk_bf16(f[0], f[1]); o.y = cvt_pk_bf16(f[2], f[3]); o.z = cvt_pk_bf16(f[4], f[5]); o.w = cvt_pk_bf16(f[6], f[7]); return o; }
template <int CTRL> __device__ __forceinline__ float dppf(float x) { return __int_as_float(__builtin_amdgcn_update_dpp(0, __float_as_int(x), CTRL, 0xF, 0xF, true)); }
__device__ __forceinline__ float red4(float x) { x += dppf<0xB1>(x); x += dppf<0x4E>(x); return x; }
__device__ __forceinline__ float red8(float x) { x = red4(x); x += dppf<0x141>(x); return x; }
__device__ __forceinline__ float red16(float x) { x = red8(x); x += dppf<0x140>(x); return x; }
__device__ __forceinline__ float red64(float x) { x = red16(x); x += __shfl_xor(x, 16); x += __shfl_xor(x, 32); return x; }
__device__ __forceinline__ float sigmoidf_(float x) { return 1.f / (1.f + __expf(-x)); }
__device__ __forceinline__ float siluf_(float x) { return x / (1.f + __expf(-x)); }
__device__ __forceinline__ float softplusf_(float x) { return fmaxf(x, 0.f) + log1pf(__expf(-fabsf(x))); }
__device__ __forceinline__ float logsigmoidf_(float x) { return fminf(x, 0.f) - log1pf(__expf(-fabsf(x))); }
__device__ __forceinline__ float gelu_tanh(float x) { const float u = 0.7978845608028654f * (x + 0.044715f * x * x * x); const float th = 1.f - 2.f / (1.f + __expf(2.f * u)); return 0.5f * x * (1.f + th); }

__device__ __forceinline__ int tid_fresh() { int t = threadIdx.x; asm volatile("" : "+v"(t)); return t; }
namespace pg8 {
#define PG8_LAS __attribute__((address_space(3)))
typedef unsigned short bf16_t;
typedef short bf16x8 __attribute__((ext_vector_type(8)));
typedef float f32x4 __attribute__((ext_vector_type(4)));
typedef unsigned u32x4 __attribute__((ext_vector_type(4)));
constexpr int BM = 256, BK = 64, HALF = 128, HTB = HALF * BK * 2  , STAGE_BYTES = 8 * HTB, NXCD = 8, WGM = 8;

__host__ __device__ __forceinline__ int lds_byte(int r, int c) { const int st = (r >> 4) * 2 + (c >> 5), rr = r & 15, cc = c & 31, ob = rr * 64 + cc * 2; return st * 1024 + (ob ^ (((ob >> 9) & 1) << 5)); }
__host__ __device__ __forceinline__ void stage_rc(int b, int& R, int& C) { const int st = b / 1024, sb = b % 1024, swz = sb ^ (((sb >> 9) & 1) << 5); R = (st >> 1) * 16 + swz / 64; C = (st & 1) * 32 + (swz % 64) / 2; }
__host__ __device__ __forceinline__ int perm32(int rho) { const int n = rho >> 4, i = rho & 15; return 8 * (i >> 2) + 4 * n + (i & 3); }

struct Unit { int pm, pn; };
struct Gemm { const bf16_t* A; const bf16_t* Bt; int M, N, K; };

struct StaticOrder {
    int nM, nN, nwg, G, c;
    __host__ __device__ void init(int M, int N, int G_, int c_) { nM = M / BM; nN = N / BM; nwg = nM * nN; G = G_; c = c_; }
    __host__ __device__ bool next(int i, Unit& u) const {
        const long L = (long)i * G + c; if (L >= nwg) return false;
        int wgid = (int)L; { const int q = nwg / NXCD, r = nwg % NXCD, xcd = wgid % NXCD, off = wgid / NXCD; wgid = (xcd < r ? xcd * (q + 1) : r * (q + 1) + (xcd - r) * q) + off; }
        const int nig = WGM * nN, gid = wgid / nig, fm = gid * WGM, gsz = (nM - fm) < WGM ? (nM - fm) : WGM;
        u.pm = fm + ((wgid % nig) % gsz); u.pn = (wgid % nig) / gsz; return true;
    }
    __device__ __forceinline__ void a_ready(const Unit&) const {}
    __device__ __forceinline__ void done(const Unit&) const {}
};
using ::cvt_pk_bf16;
typedef float f32x2 __attribute__((ext_vector_type(2)));

struct EpiProj {
    static constexpr bool PERM = true, AFTER_DRAIN = false;
    bf16_t* P; int ldp; int n_main; float* G; int ldg; int ng;
    __device__ __forceinline__ void operator()(const f32x4 (&acc)[2][2][4][2], const Unit& u, int wr, int wc, int fr, int fq) const {
        const int row0 = u.pm * BM + wr * 64 + fr;
        if (u.pn < n_main) {
            const int col0 = u.pn * BM + wc * 32 + 8 * fq;
#pragma unroll
            for (int ai = 0; ai < 2; ++ai)
#pragma unroll
                for (int m = 0; m < 4; ++m) { bf16_t* rowp = P + (size_t)(row0 + ai * HALF + m * 16) * ldp + col0;
#pragma unroll
                    for (int bj = 0; bj < 2; ++bj) { const f32x4 v0 = acc[ai][bj][m][0], v1 = acc[ai][bj][m][1];
                        u32x4 w; w.x = cvt_pk_bf16(v0[0], v0[1]); w.y = cvt_pk_bf16(v0[2], v0[3]); w.z = cvt_pk_bf16(v1[0], v1[1]); w.w = cvt_pk_bf16(v1[2], v1[3]);
                        *(u32x4*)(rowp + bj * HALF) = w; } }
        } else {
            const int c0 = wc * 32 + 8 * fq;
#pragma unroll
            for (int ai = 0; ai < 2; ++ai)
#pragma unroll
                for (int m = 0; m < 4; ++m) { float* rowp = G + (size_t)(row0 + ai * HALF + m * 16) * ldg;
#pragma unroll
                    for (int n = 0; n < 2; ++n)
#pragma unroll
                        for (int j = 0; j < 4; ++j) { const int c = c0 + 4 * n + j; if (c < ng) rowp[c] = acc[ai][0][m][n][j]; } }
        }
    }
};
struct EpiRes {
    static constexpr bool PERM = false, AFTER_DRAIN = false;
    const float* srcC; const float* srcL; float* dstC; float* dstL; const float* gate  ; int row_off;
    __device__ __forceinline__ void operator()(const f32x4 (&acc)[2][2][4][2], const Unit& u, int wr, int wc, int fr, int fq) const {
        const int grow_t = u.pm * BM + row_off;
        const bool isc = grow_t < 512;
        const int mr = isc ? 2 : ((grow_t - 512) >> 14);
        const float* sp = isc ? srcC + (size_t)grow_t * 2048 : srcL + (size_t)(grow_t - 512) * 2048;
        float* dp = isc ? dstC + (size_t)grow_t * 2048 : dstL + (size_t)(grow_t - 512) * 2048;
        const int lrow0 = wr * 64 + fr, col0 = u.pn * BM + wc * 32 + 4 * fq;
        const float* gp = gate + (size_t)mr * 12288 + col0;
        f32x4 gv[2][2];
#pragma unroll
        for (int bj = 0; bj < 2; ++bj)
#pragma unroll
            for (int n = 0; n < 2; ++n) gv[bj][n] = *(const f32x4*)(gp + bj * HALF + n * 16);
#pragma unroll
        for (int ai = 0; ai < 2; ++ai)
#pragma unroll
            for (int m = 0; m < 4; ++m) { const size_t off = (size_t)(lrow0 + ai * HALF + m * 16) * 2048 + col0;
#pragma unroll
                for (int bj = 0; bj < 2; ++bj)
#pragma unroll
                    for (int n = 0; n < 2; ++n) { const f32x4 s = *(const f32x4*)(sp + off + bj * HALF + n * 16);
                        *(f32x4*)(dp + off + bj * HALF + n * 16) = s + gv[bj][n] * acc[ai][bj][m][n]; } }
    }
};
struct EpiSwiglu {
    static constexpr bool PERM = true, AFTER_DRAIN = false;
    bf16_t* O; int ldo;
    __device__ __forceinline__ void operator()(const f32x4 (&acc)[2][2][4][2], const Unit& u, int wr, int wc, int fr, int fq) const {
        const int row0 = u.pm * BM + wr * 64 + fr, col0 = u.pn * HALF + wc * 32 + 8 * fq;
#pragma unroll
        for (int ai = 0; ai < 2; ++ai)
#pragma unroll
            for (int m = 0; m < 4; ++m) { float r[8];
#pragma unroll
                for (int n = 0; n < 2; ++n)
#pragma unroll
                    for (int j = 0; j < 4; ++j) { const float gg = acc[ai][0][m][n][j], uu = acc[ai][1][m][n][j]; r[n * 4 + j] = gg / (1.f + __expf(-gg)) * uu; }
                u32x4 w; w.x = cvt_pk_bf16(r[0], r[1]); w.y = cvt_pk_bf16(r[2], r[3]); w.z = cvt_pk_bf16(r[4], r[5]); w.w = cvt_pk_bf16(r[6], r[7]);
                *(u32x4*)(O + (size_t)(row0 + ai * HALF + m * 16) * ldo + col0) = w; }
    }
};

template <class Epi, class Sched>
__device__ __forceinline__ void gemm_phase(PG8_LAS unsigned char* lds, const Gemm g, const Sched& S, const Epi& E) {
    int tid = threadIdx.x; asm volatile("" : "+v"(tid)); const int wid = __builtin_amdgcn_readfirstlane(tid >> 6), lane = tid & 63, wr = wid >> 2, wc = wid & 3, fr = lane & 15, fq = lane >> 4;
    const int K = g.K, nt = K / BK;
    unsigned voffA[2], voffB[2];
#pragma unroll
    for (int i = 0; i < 2; ++i) { int R, C; stage_rc(tid * 16 + i * 8192, R, C); const int Rb = Epi::PERM ? ((R & ~31) + perm32(R & 31)) : R;
        voffA[i] = (unsigned)(R * K + C) * 2u; voffB[i] = (unsigned)(Rb * K + C) * 2u; }
    const size_t kstep = (size_t)(BK * 2);
    const size_t hstep = (size_t)HALF * K * 2;
    const size_t tstep = 2 * hstep;
    const unsigned ldsw = (unsigned)wid * 1024u;
    const int aoff = lds_byte(wr * 64 + fr, fq * 8), boff = lds_byte(wc * 32 + fr, fq * 8);
#define PG8_SA(b, h) (((b) * 2 + (h)) * HTB)
#define PG8_SB(b, h) ((4 + (b) * 2 + (h)) * HTB)
#define PG8_STAGE(bufoff, gbase, voff) do { _Pragma("unroll") for (int _i = 0; _i < 2; ++_i) \
        __builtin_amdgcn_global_load_lds((const unsigned*)((const char*)(gbase) + (voff)[_i]), (PG8_LAS unsigned*)(lds + (bufoff) + ldsw + _i * 8192), 16, 0, 0); } while (0)
#define PG8_LDA(dst, b, h) do { _Pragma("unroll") for (int m = 0; m < 4; ++m) _Pragma("unroll") for (int k = 0; k < 2; ++k) dst[m][k] = *(const PG8_LAS bf16x8*)(lds + PG8_SA(b, h) + aoff + m * 2048 + k * 1024); } while (0)
#define PG8_LDB(dst, b, h) do { _Pragma("unroll") for (int n = 0; n < 2; ++n) _Pragma("unroll") for (int k = 0; k < 2; ++k) dst[n][k] = *(const PG8_LAS bf16x8*)(lds + PG8_SB(b, h) + boff + n * 2048 + k * 1024); } while (0)
#define PG8_MMA(ai, bj, At, Bt) do { __builtin_amdgcn_s_setprio(1); _Pragma("unroll") for (int m = 0; m < 4; ++m) _Pragma("unroll") for (int n = 0; n < 2; ++n) _Pragma("unroll") for (int k = 0; k < 2; ++k) \
        acc[ai][bj][m][n] = __builtin_amdgcn_mfma_f32_16x16x32_bf16(Bt[n][k], At[m][k], acc[ai][bj][m][n], 0, 0, 0); __builtin_amdgcn_s_setprio(0); } while (0)
#define PG8_WAIT_V(n) asm volatile("s_waitcnt vmcnt(" #n ")" ::: "memory")
#define PG8_WAIT_L(n) asm volatile("s_waitcnt lgkmcnt(" #n ")" ::: "memory")
#define PG8_BAR __builtin_amdgcn_s_barrier()
#define PG8_SCHED __builtin_amdgcn_sched_barrier(0)
    Unit cur, nxt; int ui = 0;
    if (!S.next(0, cur)) return;
    f32x4 acc[2][2][4][2];
#pragma unroll
    for (int a = 0; a < 2; ++a)
#pragma unroll
        for (int b = 0; b < 2; ++b)
#pragma unroll
            for (int m = 0; m < 4; ++m)
#pragma unroll
                for (int n = 0; n < 2; ++n) acc[a][b][m][n] = (f32x4){0.f, 0.f, 0.f, 0.f};
    bf16x8 At[4][2], B0[2][2], B1[2][2];
    const char* cA = (const char*)g.A + (size_t)cur.pm * tstep; const char* cB = (const char*)g.Bt + (size_t)cur.pn * tstep;
    S.a_ready(cur);
    PG8_STAGE(PG8_SB(0, 0), cB, voffB); PG8_STAGE(PG8_SA(0, 0), cA, voffA); PG8_STAGE(PG8_SB(0, 1), cB + hstep, voffB); PG8_STAGE(PG8_SA(0, 1), cA + hstep, voffA);
    if (wr == 1) PG8_BAR;
    PG8_WAIT_V(4); PG8_BAR;
    PG8_STAGE(PG8_SB(1, 0), cB + kstep, voffB); PG8_STAGE(PG8_SA(1, 0), cA + kstep, voffA); PG8_STAGE(PG8_SB(1, 1), cB + hstep + kstep, voffB);
    PG8_WAIT_V(6); PG8_BAR;
    for (;;) {
        const bool has_next = S.next(ui + 1, nxt);
        const char* nA = has_next ? (const char*)g.A + (size_t)nxt.pm * tstep : cA; const char* nB = has_next ? (const char*)g.Bt + (size_t)nxt.pn * tstep : cB;
        for (int t = 0; t < nt; t += 2) {
            const bool last = (t == nt - 2);
            const char* a1 = cA + (size_t)(t + 1) * kstep;
            const char* a2 = last ? nA : cA + (size_t)(t + 2) * kstep; const char* b2 = last ? nB : cB + (size_t)(t + 2) * kstep;
            const char* a3 = a2 + kstep; const char* b3 = b2 + kstep;
            if (last && has_next) S.a_ready(nxt);
            PG8_LDB(B0, 0, 0); PG8_SCHED; PG8_LDA(At, 0, 0); PG8_STAGE(PG8_SA(1, 1), a1 + hstep, voffA);
            PG8_WAIT_L(8); PG8_BAR; PG8_WAIT_L(0); PG8_MMA(0, 0, At, B0); PG8_BAR; PG8_SCHED;
            PG8_LDB(B1, 0, 1); PG8_STAGE(PG8_SB(0, 0), b2, voffB);
            PG8_BAR; PG8_WAIT_L(0); PG8_MMA(0, 1, At, B1); PG8_BAR;
            PG8_LDA(At, 0, 1); PG8_STAGE(PG8_SA(0, 0), a2, voffA);
            PG8_BAR; PG8_WAIT_L(0); PG8_MMA(1, 0, At, B0); PG8_BAR; PG8_SCHED;
            PG8_STAGE(PG8_SB(0, 1), b2 + hstep, voffB);
            PG8_WAIT_V(6); PG8_BAR; PG8_MMA(1, 1, At, B1); PG8_BAR;
            PG8_LDB(B0, 1, 0); PG8_SCHED; PG8_LDA(At, 1, 0); PG8_STAGE(PG8_SA(0, 1), a2 + hstep, voffA);
            PG8_WAIT_L(8); PG8_BAR; PG8_WAIT_L(0); PG8_MMA(0, 0, At, B0); PG8_BAR; PG8_SCHED;
            PG8_LDB(B1, 1, 1); PG8_STAGE(PG8_SB(1, 0), b3, voffB);
            PG8_BAR; PG8_WAIT_L(0); PG8_MMA(0, 1, At, B1); PG8_BAR;
            PG8_LDA(At, 1, 1); PG8_STAGE(PG8_SA(1, 0), a3, voffA);
            PG8_BAR; PG8_WAIT_L(0); PG8_MMA(1, 0, At, B0); PG8_BAR; PG8_SCHED;
            PG8_STAGE(PG8_SB(1, 1), b3 + hstep, voffB);
            PG8_WAIT_V(6); PG8_BAR; PG8_MMA(1, 1, At, B1); PG8_BAR;
        }
        if constexpr (!Epi::AFTER_DRAIN) { E(acc, cur, wr, wc, fr, fq); S.done(cur); }
        if (!has_next) break;
#pragma unroll
        for (int a = 0; a < 2; ++a)
#pragma unroll
            for (int b = 0; b < 2; ++b)
#pragma unroll
                for (int m = 0; m < 4; ++m)
#pragma unroll
                    for (int n = 0; n < 2; ++n) acc[a][b][m][n] = (f32x4){0.f, 0.f, 0.f, 0.f};
        cur = nxt; cA = nA; cB = nB; ++ui;
    }
    PG8_WAIT_V(0);
    if (wr == 0) PG8_BAR;
    PG8_BAR;
    if constexpr (Epi::AFTER_DRAIN) { E.fused(acc, cur, wr, wc, fr, fq, lds, wid, lane); S.done(cur); }
#undef PG8_SA
#undef PG8_SB
#undef PG8_STAGE
#undef PG8_LDA
#undef PG8_LDB
#undef PG8_MMA
#undef PG8_WAIT_V
#undef PG8_WAIT_L
#undef PG8_BAR
#undef PG8_SCHED
}
}

__device__ __forceinline__ void ph_adaln_partials(const Params& p, float* sm) {
    const int tid = tid_fresh();
    float* MODP = (float*)(p.ws + WS_MODP);
    for (int it = blockIdx.x; it < 384; it += gridDim.x) {
        const int l = it / 192, rem = it % 192, kc = rem / 6, cgp = rem % 6;
        __syncthreads();
        if (tid < 192) { const int r = tid >> 6, kk = tid & 63, k = kc * 64 + kk; const float cv = (r < 2) ? p.c[r * 2048 + k] : p.c_ctx[k]; sm[tid] = siluf_(cv); }
        __syncthreads();
        const int col = cgp * 2048 + tid * 4;
        float4 a0 = {0.f, 0.f, 0.f, 0.f}, a1 = a0, a2 = a0;
        const float* wp = p.mod_w + ((size_t)l * 2048 + (size_t)kc * 64) * 12288 + col;
#pragma unroll 8
        for (int kk = 0; kk < 64; ++kk) {
            const float4 w = *(const float4*)(wp + (size_t)kk * 12288);
            const float s0 = sm[kk], s1 = sm[64 + kk], s2 = sm[128 + kk];
            a0.x += s0 * w.x; a0.y += s0 * w.y; a0.z += s0 * w.z; a0.w += s0 * w.w;
            a1.x += s1 * w.x; a1.y += s1 * w.y; a1.z += s1 * w.z; a1.w += s1 * w.w;
            a2.x += s2 * w.x; a2.y += s2 * w.y; a2.z += s2 * w.z; a2.w += s2 * w.w;
        }
        float* o = MODP + ((size_t)(l * 32 + kc) * 3) * 12288 + col;
        *(float4*)(o) = a0; *(float4*)(o + 12288) = a1; *(float4*)(o + 2 * 12288) = a2;
    }
}
__device__ __forceinline__ void ph_adaln_reduce(const Params& p) {
    const float* MODP = (const float*)(p.ws + WS_MODP); float* MOD = (float*)(p.ws + WS_MOD);
    for (int idx = blockIdx.x * NTHR + tid_fresh(); idx < 2 * 3 * 12288; idx += gridDim.x * NTHR) {
        const int l = idx / 36864, r = (idx / 12288) % 3, col = idx % 12288;
        float s = p.mod_b[l * 12288 + col];
        for (int kc = 0; kc < 32; ++kc) s += MODP[((size_t)(l * 32 + kc) * 3 + r) * 12288 + col];
        MOD[idx] = s;
    }
}

template <int MODE> __device__ __forceinline__ int colmap(int n, int nsrc) {
    if (MODE == 0) return n < nsrc ? n : -1;
    if (MODE == 1) { if (n < 3072) return n; if (n < 7168) return n + 16; if (n < 7184) return 3072 + (n - 7168); if (n < 7216) return n; return -1; }
    return ((n >> 7) & 1) * 5632 + (n >> 8) * 128 + (n & 127);
}
template <int MODE> __device__ __forceinline__ void ph_convert(const float* W, int nsrc, int K, int nout, u16* Bt, float* sm) {
    const int tid = tid_fresh(); const int nnt = nout / 64, ntiles = nnt * (K / 64);
    for (int t = blockIdx.x; t < ntiles; t += gridDim.x) {
        const int k0 = (t / nnt) * 64, n0 = (t % nnt) * 64;
        __syncthreads();
#pragma unroll
        for (int i = 0; i < 8; ++i) { const int idx = i * NTHR + tid, kk = idx >> 6, nn = idx & 63; const int src = colmap<MODE>(n0 + nn, nsrc);
            sm[kk * 65 + nn] = src >= 0 ? W[(size_t)(k0 + kk) * nsrc + src] : 0.f; }
        __syncthreads();
        { const int nn = tid >> 3, k8 = (tid & 7) * 8; float v[8];
#pragma unroll
            for (int j = 0; j < 8; ++j) v[j] = sm[(k8 + j) * 65 + nn];
            *(uint4*)(Bt + (size_t)(n0 + nn) * K + k0 + k8) = pack8(v); }
    }
}

__device__ __forceinline__ void ph_norm(const float* srcC, const float* srcL, const float* g, const float* modl, int chunk_sh, int chunk_sc, u16* H, int row_begin) {
    const int tid_ = tid_fresh(); const int lane = tid_ & 63, w = tid_ >> 6;
    for (int row = row_begin + blockIdx.x * 8 + w; row < MTOT; row += gridDim.x * 8) {
        const float* src = row < 512 ? srcC + (size_t)row * 2048 : srcL + (size_t)(row - 512) * 2048;
        const int mr = row < 512 ? 2 : ((row - 512) >> 14);
        const float* sc = modl + (mr * 6 + chunk_sc) * 2048; const float* sh = modl + (mr * 6 + chunk_sh) * 2048;
        float4 v[8]; float ss = 0.f;
#pragma unroll
        for (int i = 0; i < 8; ++i) { v[i] = *(const float4*)(src + i * 256 + lane * 4); ss += v[i].x * v[i].x + v[i].y * v[i].y + v[i].z * v[i].z + v[i].w * v[i].w; }
        ss = red64(ss);
        const float rstd = rsqrtf(ss * (1.f / 2048.f) + 1e-6f);
#pragma unroll
        for (int i = 0; i < 8; ++i) { const int col = i * 256 + lane * 4;
            const float4 g4 = *(const float4*)(g + col), s4 = *(const float4*)(sc + col), h4 = *(const float4*)(sh + col);
            const float y0 = v[i].x * rstd * g4.x * (1.f + s4.x) + h4.x, y1 = v[i].y * rstd * g4.y * (1.f + s4.y) + h4.y;
            const float y2 = v[i].z * rstd * g4.z * (1.f + s4.z) + h4.z, y3 = v[i].w * rstd * g4.w * (1.f + s4.w) + h4.w;
            uint2 o; o.x = cvt_pk_bf16(y0, y1); o.y = cvt_pk_bf16(y2, y3);
            *(uint2*)(H + (size_t)row * 2048 + col) = o; }
    }
}
__device__ __forceinline__ void ph_final_norm(const Params& p) {
    const int tid_ = tid_fresh(); const int lane = tid_ & 63, w = tid_ >> 6;
    for (int row = blockIdx.x * 8 + w; row < MLAT; row += gridDim.x * 8) {
        float* src = p.out + (size_t)row * 2048;
        float4 v[8]; float ss = 0.f;
#pragma unroll
        for (int i = 0; i < 8; ++i) { v[i] = *(const float4*)(src + i * 256 + lane * 4); ss += v[i].x * v[i].x + v[i].y * v[i].y + v[i].z * v[i].z + v[i].w * v[i].w; }
        ss = red64(ss);
        const float rstd = rsqrtf(ss * (1.f / 2048.f) + 1e-6f);
#pragma unroll
        for (int i = 0; i < 8; ++i) { const int col = i * 256 + lane * 4; const float4 g4 = *(const float4*)(p.final_norm_g + col);
            float4 o; o.x = v[i].x * rstd * g4.x; o.y = v[i].y * rstd * g4.y; o.z = v[i].z * rstd * g4.z; o.w = v[i].w * rstd * g4.w;
            *(float4*)(src + col) = o; }
    }
}

__device__ __forceinline__ void ph_l0_prep(const Params& p, float* sm) {
    const int tid = tid_fresh();
    u16* PROJ = (u16*)(p.ws + WS_PROJ); u16* CQ = (u16*)(p.ws + WS_CQ); float* G = (float*)(p.ws + WS_G);
    for (int idx = blockIdx.x * NTHR + tid; idx < MTOT * 48; idx += gridDim.x * NTHR) {
        const int j = idx % 48; const float v = G[idx]; float o;
        if (j < 8) o = v + p.ml_ig_b[j];
        else if (j < 16) o = logsigmoidf_(v + p.ml_fg_b[j - 8]);
        else if (j < 32) { const float dt = softplusf_(v + p.dn_dt_bias[j - 16]); o = -__expf(p.dn_a_log[j - 16]) * dt; }
        else o = sigmoidf_(v);
        G[idx] = o;
    }
    for (int t = blockIdx.x; t < 520 * 24; t += gridDim.x) {
        const int tt = t / 24, part = t % 24;
        const bool isctx = tt < 8;
        const int t0 = isctx ? (tt & 3) * 64 : 0;
        const int rowbase = isctx ? (tt >> 2) * 256 + t0 : 512 + (tt - 8) * 64;
        __syncthreads();
        for (int ch = tid; ch < 68 * 16; ch += NTHR) {
            const int rr = ch >> 4, c8 = (ch & 15) * 8, r = rr - 2;
            const bool ok = isctx ? (t0 + r >= 0 && t0 + r < 256) : (r >= 0 && r < 64);
            float f[8];
#pragma unroll
            for (int j = 0; j < 8; ++j) f[j] = 0.f;
            if (ok) { const uint4 u = *(const uint4*)(PROJ + (size_t)(rowbase + r) * NP0 + 3072 + part * 128 + c8); unpack8(u, f); }
            float* d = sm + rr * 132 + c8;
            *(float4*)(d) = make_float4(f[0], f[1], f[2], f[3]); *(float4*)(d + 4) = make_float4(f[4], f[5], f[6], f[7]);
        }
        __syncthreads();
        const int tk = tid >> 3, cs = (tid & 7) * 16;
        float o[16];
#pragma unroll
        for (int c = 0; c < 16; ++c) o[c] = 0.f;
#pragma unroll
        for (int j = 0; j < 5; ++j) {
            const float* wr_ = p.dn_conv_w + j * 3072 + part * 128 + cs; const float* ir = sm + (tk + j) * 132 + cs;
#pragma unroll
            for (int c4 = 0; c4 < 4; ++c4) { const float4 w4 = *(const float4*)(wr_ + c4 * 4), i4 = *(const float4*)(ir + c4 * 4);
                o[c4 * 4 + 0] += i4.x * w4.x; o[c4 * 4 + 1] += i4.y * w4.y; o[c4 * 4 + 2] += i4.z * w4.z; o[c4 * 4 + 3] += i4.w * w4.w; }
        }
        float ss = 0.f;
#pragma unroll
        for (int c = 0; c < 16; ++c) { o[c] = siluf_(o[c]); ss += o[c] * o[c]; }
        ss = red8(ss);
        if (part < 16) { const float sc = rsqrtf(ss + 1e-6f);
#pragma unroll
            for (int c = 0; c < 16; ++c) o[c] *= sc; }
        u16* dst = isctx ? CQ + (size_t)(rowbase + tk) * 3072 + part * 128 + cs : PROJ + (size_t)(rowbase + tk) * NP0 + 3072 + part * 128 + cs;
        *(uint4*)(dst) = pack8(o); *(uint4*)(dst + 8) = pack8(o + 8);
    }
}

__device__ __forceinline__ void ph_l0_merge(const Params& p) {
    const int tid_ = tid_fresh(); const int lane = tid_ & 63, w = tid_ >> 6;
    const u16* PROJ = (const u16*)(p.ws + WS_PROJ); const u16* OF = (const u16*)(p.ws + WS_OF); const u16* OB = (const u16*)(p.ws + WS_OB); u16* Y = (u16*)(p.ws + WS_H);
    for (int row = blockIdx.x * 8 + w; row < MTOT; row += gridDim.x * 8) {
        const int col = lane * 32; const bool isml = lane < 32;
        const u16* gsrc = PROJ + (size_t)row * NP0 + (isml ? 2048 + col : 6144 + (col - 1024));
        const float* gn = isml ? p.ml_norm_g + col : p.dn_norm_g + (col - 1024);
        float o[32]; float ss = 0.f;
#pragma unroll
        for (int i = 0; i < 4; ++i) { float a[8], bb[8]; unpack8(*(const uint4*)(OF + (size_t)row * 2048 + col + i * 8), a); unpack8(*(const uint4*)(OB + (size_t)row * 2048 + col + i * 8), bb);
#pragma unroll
            for (int j = 0; j < 8; ++j) { o[i * 8 + j] = a[j] + bb[j]; ss += o[i * 8 + j] * o[i * 8 + j]; } }
        ss = red4(ss); const float s8 = ss + dppf<0x141>(ss);
        const float rstd = isml ? rsqrtf(s8 * (1.f / 256.f) + 1e-6f) : rsqrtf(ss * (1.f / 128.f) + 1e-6f);
#pragma unroll
        for (int i = 0; i < 4; ++i) { float gt[8], r[8]; unpack8(*(const uint4*)(gsrc + i * 8), gt);
#pragma unroll
            for (int j = 0; j < 8; ++j) { const float gate = isml ? sigmoidf_(gt[j]) : siluf_(gt[j]); r[j] = o[i * 8 + j] * rstd * gn[i * 8 + j] * gate; }
            *(uint4*)(Y + (size_t)row * 2048 + col + i * 8) = pack8(r); }
    }
}

typedef short bf16x8_t __attribute__((ext_vector_type(8)));
typedef float f32x4_t __attribute__((ext_vector_type(4)));
__device__ __forceinline__ float wave_cumsum(float x, int lane) {
#pragma unroll
    for (int o = 1; o < 64; o <<= 1) { const float t = __shfl_up(x, o); if (lane >= o) x += t; }
    return x; }
__device__ __forceinline__ float wave_cummax(float x, int lane) {
#pragma unroll
    for (int o = 1; o < 64; o <<= 1) { const float t = __shfl_up(x, o); if (lane >= o) x = fmaxf(x, t); }
    return x; }
__device__ __forceinline__ int tile_of(int n, int b, int dir) { if (n < 4) return b * 4 + (dir ? 3 - n : n); const int li = n - 4; return 8 + b * 256 + (dir ? 255 - li : li); }
__device__ __forceinline__ int rowbase_of(int tt) { return tt < 8 ? tt * 64 : 512 + (tt - 8) * 64; }

__device__ __forceinline__ void ml_prep_item(const Params& p, int it, float* wl, int lane) {
    const int h = it & 3, tt = (it >> 2) % 520, z = it / 2080, rowbase = rowbase_of(tt), fr = lane & 15, fq = lane >> 4;
    const u16* PROJ = (const u16*)(p.ws + WS_PROJ); const float* G = (const float*)(p.ws + WS_G);
    float* MLS = (float*)(p.ws + WS_MLS) + (size_t)it * 256; u16* ATT0 = (u16*)(p.ws + WS_ATT0) + (size_t)it * 4096;
    const int tk = z ? 63 - lane : lane, row = rowbase + tk;
    const float ig = G[row * 48 + z * 4 + h], lf = G[row * 48 + 8 + z * 4 + h];
    const float bb = wave_cumsum(lf, lane), gg = ig - bb, cm = wave_cummax(gg, lane);
    const float bL = __shfl(bb, 63), cmL = __shfl(cm, 63);
    MLS[tk] = bb; MLS[64 + tk] = cm; MLS[128 + tk] = __expf(gg - cmL); if (lane == 0) { MLS[192] = bL; MLS[193] = cmL; }
    wl[tk] = gg; wl[64 + tk] = cm;
#pragma unroll 1
    for (int rt = 0; rt < 4; ++rt) {
        bf16x8_t a[4];
#pragma unroll
        for (int ks = 0; ks < 4; ++ks) a[ks] = *(const bf16x8_t*)(PROJ + (size_t)(rowbase + rt * 16 + fr) * NP0 + h * 128 + ks * 32 + fq * 8);
#pragma unroll 1
        for (int ct = 0; ct < 4; ++ct) {
            f32x4_t acc = (f32x4_t){0.f, 0.f, 0.f, 0.f};
#pragma unroll
            for (int ks = 0; ks < 4; ++ks) { const bf16x8_t bfr = *(const bf16x8_t*)(PROJ + (size_t)(rowbase + ct * 16 + fr) * NP0 + 512 + h * 128 + ks * 32 + fq * 8);
                acc = __builtin_amdgcn_mfma_f32_16x16x32_bf16(a[ks], bfr, acc, 0, 0, 0); }
            const int s = ct * 16 + fr; const float gs = wl[s];
#pragma unroll
            for (int j = 0; j < 4; ++j) { const int l = rt * 16 + fq * 4 + j; const bool keep = z ? (s >= l) : (s <= l);
                const float e = __expf(fminf(gs - wl[64 + l], 0.f));
                ATT0[l * 64 + s] = f2bf(keep ? acc[j] * 0.08838834764831845f * e : 0.f); }
        }
    }
}
__device__ __forceinline__ void dn_prep_item(const Params& p, int it, float* Ap, int lane) {
    const int h = it & 7, tt = (it >> 3) % 520, z = it / 4160, rowbase = rowbase_of(tt), fr = lane & 15, fq = lane >> 4;
    const bool isctx = tt < 8;
    const u16* qb = isctx ? (const u16*)(p.ws + WS_CQ) + (size_t)rowbase * 3072 + h * 128 : (const u16*)(p.ws + WS_PROJ) + (size_t)rowbase * NP0 + 3072 + h * 128;
    const int rs = isctx ? 3072 : NP0;
    const float* G = (const float*)(p.ws + WS_G);
    float* GCS = (float*)(p.ws + WS_GCS) + (size_t)it * 256; u16* TM = (u16*)(p.ws + WS_TM) + (size_t)it * 4096; u16* QK = (u16*)(p.ws + WS_QK) + (size_t)it * 4096;
    float* gcs = Ap + 4096; float* bes = Ap + 4160;
    const int tk = z ? 63 - lane : lane, row = rowbase + tk;
    const float g = G[row * 48 + 16 + z * 8 + h], be = G[row * 48 + 32 + z * 8 + h];
    const float gc = wave_cumsum(g, lane), gL = __shfl(gc, 63);
    GCS[tk] = __expf(gc); GCS[64 + tk] = be; GCS[128 + tk] = __expf(gL - gc); if (lane == 0) GCS[192] = __expf(gL);
    gcs[tk] = gc; bes[tk] = be;
#pragma unroll 1
    for (int rt = 0; rt < 4; ++rt) {
        bf16x8_t ak[4], aq[4];
#pragma unroll
        for (int ks = 0; ks < 4; ++ks) { ak[ks] = *(const bf16x8_t*)(qb + (size_t)(rt * 16 + fr) * rs + 1024 + ks * 32 + fq * 8); aq[ks] = *(const bf16x8_t*)(qb + (size_t)(rt * 16 + fr) * rs + ks * 32 + fq * 8); }
#pragma unroll 1
        for (int ct = 0; ct < 4; ++ct) {
            f32x4_t ck = (f32x4_t){0.f, 0.f, 0.f, 0.f}, cq = ck;
#pragma unroll
            for (int ks = 0; ks < 4; ++ks) { const bf16x8_t bfr = *(const bf16x8_t*)(qb + (size_t)(ct * 16 + fr) * rs + 1024 + ks * 32 + fq * 8);
                ck = __builtin_amdgcn_mfma_f32_16x16x32_bf16(ak[ks], bfr, ck, 0, 0, 0); cq = __builtin_amdgcn_mfma_f32_16x16x32_bf16(aq[ks], bfr, cq, 0, 0, 0); }
            const int s = ct * 16 + fr; const float gs = gcs[s];
#pragma unroll
            for (int j = 0; j < 4; ++j) { const int l = rt * 16 + fq * 4 + j;
                const bool strict = z ? (s > l) : (s < l), incl = z ? (s >= l) : (s <= l);
                const float e = __expf(fminf(gcs[l] - gs, 0.f));
                const int lp = z ? 63 - l : l, sp = z ? 63 - s : s;
                Ap[lp * 64 + sp] = strict ? bes[l] * ck[j] * e : 0.f;
                QK[l * 64 + s] = f2bf(incl ? cq[j] * 0.08838834764831845f * e : 0.f); }
        }
    }
    Ap[lane] = (lane == 0) ? 1.f : 0.f;
#pragma unroll 1
    for (int i = 1; i < 64; ++i) {
        float t = (i == lane) ? 1.f : 0.f;
#pragma unroll 4
        for (int j = 0; j < i; ++j) t -= Ap[i * 64 + j] * Ap[j * 64 + lane];
        Ap[i * 64 + lane] = t;
    }
    const int sc = z ? 63 - lane : lane;
#pragma unroll 4
    for (int i = 0; i < 64; ++i) { const int l = z ? 63 - i : i; TM[l * 64 + sc] = f2bf(Ap[i * 64 + lane]); }
}
__device__ __forceinline__ void ph_l0_prepass(const Params& p, unsigned char* lds) {
    const int tid = tid_fresh(), lane = tid & 63, w = tid >> 6;
    float* wl = (float*)(lds + (size_t)w * 16896);
    const int gw = blockIdx.x * 8 + w, nw = gridDim.x * 8;
    for (int it = gw; it < 4160; it += nw) ml_prep_item(p, it, wl, lane);
    for (int it = gw; it < 8320; it += nw) dn_prep_item(p, it, wl, lane);
}

__device__ __forceinline__ unsigned ml_touch(const Params& p, int n, int b, int h, int dir, int e0, int tid) {
    const int nn = n < NSEG ? n : NSEG - 1;
    const int tt = tile_of(nn, b, dir), it = (dir * 520 + tt) * 4 + h, rowbase = rowbase_of(tt);
    const u16* PROJ = (const u16*)(p.ws + WS_PROJ);
    const u16* a;
    if (tid < 256) a = PROJ + (size_t)(rowbase + ((tid & 127) >> 1)) * NP0 + (tid >> 7) * 512 + h * 128 + (tid & 1) * 64;
    else if (tid < 320) a = PROJ + (size_t)(rowbase + tid - 256) * NP0 + 1024 + h * 256 + e0;
    else if (tid < 384) a = (const u16*)(p.ws + WS_ATT0) + (size_t)it * 4096 + (tid - 320) * 64;
    else a = (const u16*)(p.ws + WS_MLS) + (size_t)it * 512 + ((tid - 384) & 7) * 64;
    return *(const unsigned*)a;
}
struct MlFr { bf16x8_t q[4], at[2]; uint4 kr[2]; uint2 vr; float kw, b[4], cm[4], bL, cmL; };
__device__ __forceinline__ void ml_load(MlFr& F, const Params& p, int n, int b, int h, int dir, int e0, int lt, int fr, int fq, int tl, int seg) {
    const int nn = n < NSEG ? n : NSEG - 1;
    const int tt = tile_of(nn, b, dir), it = (dir * 520 + tt) * 4 + h, rowbase = rowbase_of(tt);
    const u16* PROJ = (const u16*)(p.ws + WS_PROJ);
    const u16* Q = PROJ + (size_t)(rowbase + lt * 16 + fr) * NP0 + h * 128 + fq * 8;
    const u16* AT = (const u16*)(p.ws + WS_ATT0) + (size_t)it * 4096 + (lt * 16 + fr) * 64 + fq * 8;
    const float* MLS = (const float*)(p.ws + WS_MLS) + (size_t)it * 256;
#pragma unroll
    for (int ks = 0; ks < 4; ++ks) F.q[ks] = *(const bf16x8_t*)(Q + ks * 32);
#pragma unroll
    for (int ks = 0; ks < 2; ++ks) F.at[ks] = *(const bf16x8_t*)(AT + ks * 32);
    const u16* kp = PROJ + (size_t)(rowbase + tl) * NP0 + 512 + h * 128 + seg * 16;
    F.kr[0] = *(const uint4*)(kp); F.kr[1] = *(const uint4*)(kp + 8);
    F.vr = *(const uint2*)(PROJ + (size_t)(rowbase + tl) * NP0 + 1024 + h * 256 + e0 + seg * 4);
    F.kw = MLS[128 + tl];
#pragma unroll
    for (int j = 0; j < 4; ++j) { F.b[j] = MLS[lt * 16 + fq * 4 + j]; F.cm[j] = MLS[64 + lt * 16 + fq * 4 + j]; }
    F.bL = MLS[192]; F.cmL = MLS[193];
}
__device__ __forceinline__ void mlstm_chunk(const Params& p, int job, unsigned char* lds) {
    const int tid = tid_fresh(), lane = tid & 63, w = tid >> 6, fr = lane & 15, fq = lane >> 4;
    const int chain = job >> 3, cgp = job & 7;
    const int b = chain >> 3, h = (chain >> 1) & 3, dir = chain & 1;
    const int e0 = cgp * 32, lt = w >> 1, et = w & 1, dt0 = (w >> 1) * 2, tl = tid & 63, seg = tid >> 6;
    u16* Cl = (u16*)lds;
    u16* Ktw = (u16*)(lds + 17952);
    u16* Vt = (u16*)(lds + 17952 + 18432);
    u16* O = (u16*)(p.ws + (dir ? WS_OB : WS_OF));
    __syncthreads();
    for (int i = tid; i < 17952 / 4; i += NTHR) ((unsigned*)Cl)[i] = 0u;
    __syncthreads();
    f32x4_t Cacc[2], nacc; Cacc[0] = (f32x4_t){0.f, 0.f, 0.f, 0.f}; Cacc[1] = Cacc[0]; nacc = Cacc[0];
    float m_in = 0.f;
    bf16x8_t ones;
#pragma unroll
    for (int j = 0; j < 8; ++j) ones[j] = (short)0x3F80;
    MlFr buf[2];
    ml_load(buf[0], p, 0, b, h, dir, e0, lt, fr, fq, tl, seg); ml_load(buf[1], p, 1, b, h, dir, e0, lt, fr, fq, tl, seg);
    unsigned pfr[4] = {0u, 0u, 0u, 0u}, sink = 0u;
    for (int n0 = 0; n0 < NSEG; n0 += 4) {
#pragma unroll
        for (int u = 0; u < 4; ++u) {
            const int n = n0 + u; const int s = u & 1;
            sink ^= pfr[u]; pfr[u] = ml_touch(p, n + 5, b, h, dir, e0, tid);
            const MlFr& F = buf[s];
            const int tt = tile_of(n, b, dir), rowbase = rowbase_of(tt);
            const u16* Ccur = Cl + (n & 1) * (33 * 136); u16* Cnxt = Cl + ((n + 1) & 1) * (33 * 136);
            { float k[16]; unpack8(F.kr[0], k); unpack8(F.kr[1], k + 8);
#pragma unroll
                for (int c = 0; c < 16; ++c) Ktw[(seg * 16 + c) * 72 + tl] = f2bf(k[c] * F.kw);
                Vt[(seg * 4 + 0) * 72 + tl] = (u16)(F.vr.x & 0xffffu); Vt[(seg * 4 + 1) * 72 + tl] = (u16)(F.vr.x >> 16);
                Vt[(seg * 4 + 2) * 72 + tl] = (u16)(F.vr.y & 0xffffu); Vt[(seg * 4 + 3) * 72 + tl] = (u16)(F.vr.y >> 16); }
            __syncthreads();
            bf16x8_t vt[2];
#pragma unroll
            for (int ks = 0; ks < 2; ++ks) vt[ks] = *(const bf16x8_t*)(Vt + (et * 16 + fr) * 72 + ks * 32 + fq * 8);
            {
                f32x4_t inter = (f32x4_t){0.f, 0.f, 0.f, 0.f}, intra = inter, dinter = inter, dintra = inter;
#pragma unroll
                for (int ks = 0; ks < 4; ++ks) { const bf16x8_t cb = *(const bf16x8_t*)(Ccur + (et * 16 + fr) * 136 + ks * 32 + fq * 8); const bf16x8_t nb = *(const bf16x8_t*)(Ccur + 32 * 136 + ks * 32 + fq * 8);
                    inter = __builtin_amdgcn_mfma_f32_16x16x32_bf16(F.q[ks], cb, inter, 0, 0, 0); dinter = __builtin_amdgcn_mfma_f32_16x16x32_bf16(F.q[ks], nb, dinter, 0, 0, 0); }
#pragma unroll
                for (int ks = 0; ks < 2; ++ks) { intra = __builtin_amdgcn_mfma_f32_16x16x32_bf16(F.at[ks], vt[ks], intra, 0, 0, 0); dintra = __builtin_amdgcn_mfma_f32_16x16x32_bf16(F.at[ks], ones, dintra, 0, 0, 0); }
#pragma unroll
                for (int j = 0; j < 4; ++j) { const float M = fmaxf(F.cm[j], m_in); const float r = __expf(F.cm[j] - M), ei = __expf(m_in - M) * 0.08838834764831845f;
                    const float num = r * intra[j] + ei * inter[j], den = r * dintra[j] + ei * dinter[j];
                    const float hv = num / fmaxf(fabsf(den), __expf(-(F.b[j] + M)));
                    O[(size_t)(rowbase + lt * 16 + fq * 4 + j) * 2048 + h * 256 + e0 + et * 16 + fr] = f2bf(hv); }
            }
            { const float ML = fmaxf(F.cmL, m_in); const float a = __expf(m_in - ML), sc2 = __expf(F.cmL - ML); m_in = F.bL + ML;
#pragma unroll
                for (int i = 0; i < 2; ++i) { f32x4_t nw = (f32x4_t){0.f, 0.f, 0.f, 0.f};
#pragma unroll
                    for (int ks = 0; ks < 2; ++ks) { const bf16x8_t kb = *(const bf16x8_t*)(Ktw + ((dt0 + i) * 16 + fr) * 72 + ks * 32 + fq * 8); nw = __builtin_amdgcn_mfma_f32_16x16x32_bf16(vt[ks], kb, nw, 0, 0, 0); }
#pragma unroll
                    for (int j = 0; j < 4; ++j) { Cacc[i][j] = a * Cacc[i][j] + sc2 * nw[j]; Cnxt[(et * 16 + fq * 4 + j) * 136 + (dt0 + i) * 16 + fr] = f2bf(Cacc[i][j]); } }
                f32x4_t nw = (f32x4_t){0.f, 0.f, 0.f, 0.f};
#pragma unroll
                for (int ks = 0; ks < 2; ++ks) { const bf16x8_t kb = *(const bf16x8_t*)(Ktw + (w * 16 + fr) * 72 + ks * 32 + fq * 8); nw = __builtin_amdgcn_mfma_f32_16x16x32_bf16(ones, kb, nw, 0, 0, 0); }
                nacc[0] = a * nacc[0] + sc2 * nw[0];
                if (fq == 0) Cnxt[32 * 136 + w * 16 + fr] = f2bf(nacc[0]); }
            __syncthreads();
            ml_load(buf[s], p, n + 2, b, h, dir, e0, lt, fr, fq, tl, seg);
        }
    }
    ((unsigned*)(p.ws + WS_MODP))[blockIdx.x * NTHR + tid] = sink ^ pfr[0] ^ pfr[1] ^ pfr[2] ^ pfr[3];
}

__device__ __forceinline__ unsigned dn_touch(const Params& p, int n, int b, int h, int dir, int e0, int tid) {
    const int nn = n < NSEG ? n : NSEG - 1;
    const int tt = tile_of(nn, b, dir), it = (dir * 520 + tt) * 8 + h, rowbase = rowbase_of(tt);
    const bool isctx = tt < 8;
    const u16* qb = isctx ? (const u16*)(p.ws + WS_CQ) + (size_t)rowbase * 3072 + h * 128 : (const u16*)(p.ws + WS_PROJ) + (size_t)rowbase * NP0 + 3072 + h * 128;
    const int rs = isctx ? 3072 : NP0;
    const u16* a;
    if (tid < 256) a = qb + (size_t)((tid & 127) >> 1) * rs + (tid >> 7) * 1024 + (tid & 1) * 64;
    else if (tid < 320) a = qb + (size_t)(tid - 256) * rs + 2048 + e0;
    else if (tid < 384) a = (const u16*)(p.ws + WS_TM) + (size_t)it * 4096 + (tid - 320) * 64;
    else if (tid < 448) a = (const u16*)(p.ws + WS_QK) + (size_t)it * 4096 + (tid - 384) * 64;
    else a = (const u16*)(p.ws + WS_GCS) + (size_t)it * 512 + ((tid - 448) & 7) * 64;
    return *(const unsigned*)a;
}
struct DnFr { bf16x8_t k[4], q[4], tm[2], qk[2]; uint4 kr[2]; float kds, egc[4], be[4], egL; u16 v[4]; };
__device__ __forceinline__ void dn_load(DnFr& F, const Params& p, int n, int b, int h, int dir, int e0, int lt, int et, int fr, int fq, int tl, int seg) {
    const int nn = n < NSEG ? n : NSEG - 1;
    const int tt = tile_of(nn, b, dir), it = (dir * 520 + tt) * 8 + h, rowbase = rowbase_of(tt);
    const bool isctx = tt < 8;
    const u16* qb = isctx ? (const u16*)(p.ws + WS_CQ) + (size_t)rowbase * 3072 + h * 128 : (const u16*)(p.ws + WS_PROJ) + (size_t)rowbase * NP0 + 3072 + h * 128;
    const int rs = isctx ? 3072 : NP0;
    const u16* TM = (const u16*)(p.ws + WS_TM) + (size_t)it * 4096 + (lt * 16 + fr) * 64 + fq * 8;
    const u16* QK = (const u16*)(p.ws + WS_QK) + (size_t)it * 4096 + (lt * 16 + fr) * 64 + fq * 8;
    const float* GCS = (const float*)(p.ws + WS_GCS) + (size_t)it * 256;
    const u16* qr = qb + (size_t)(lt * 16 + fr) * rs + fq * 8;
#pragma unroll
    for (int ks = 0; ks < 4; ++ks) { F.q[ks] = *(const bf16x8_t*)(qr + ks * 32); F.k[ks] = *(const bf16x8_t*)(qr + 1024 + ks * 32); }
#pragma unroll
    for (int ks = 0; ks < 2; ++ks) { F.tm[ks] = *(const bf16x8_t*)(TM + ks * 32); F.qk[ks] = *(const bf16x8_t*)(QK + ks * 32); }
    const u16* kp = qb + (size_t)tl * rs + 1024 + seg * 16;
    F.kr[0] = *(const uint4*)(kp); F.kr[1] = *(const uint4*)(kp + 8);
    F.kds = GCS[128 + tl]; F.egL = GCS[192];
#pragma unroll
    for (int j = 0; j < 4; ++j) { const int l = lt * 16 + fq * 4 + j; F.egc[j] = GCS[l]; F.be[j] = GCS[64 + l]; F.v[j] = qb[(size_t)l * rs + 2048 + e0 + et * 16 + fr]; }
}
__device__ __forceinline__ void deltanet_chunk(const Params& p, int job, unsigned char* lds) {
    const int tid = tid_fresh(), lane = tid & 63, w = tid >> 6, fr = lane & 15, fq = lane >> 4;
    const int chain = job >> 2, cgp = job & 3;
    const int b = chain >> 4, h = (chain >> 1) & 7, dir = chain & 1;
    const int e0 = cgp * 32, lt = w >> 1, et = w & 1, dt0 = (w >> 1) * 2, tl = tid & 63, seg = tid >> 6;
    u16* Sl = (u16*)lds;
    u16* Rt = (u16*)(lds + 17408);
    u16* VNt = (u16*)(lds + 17408 + 4608);
    u16* Kdt = (u16*)(lds + 17408 + 9216);
    u16* O = (u16*)(p.ws + (dir ? WS_OB : WS_OF));
    __syncthreads();
    for (int i = tid; i < 17408 / 4; i += NTHR) ((unsigned*)Sl)[i] = 0u;
    __syncthreads();
    f32x4_t Sacc[2]; Sacc[0] = (f32x4_t){0.f, 0.f, 0.f, 0.f}; Sacc[1] = Sacc[0];
    DnFr buf[2];
    dn_load(buf[0], p, 0, b, h, dir, e0, lt, et, fr, fq, tl, seg); dn_load(buf[1], p, 1, b, h, dir, e0, lt, et, fr, fq, tl, seg);
    unsigned pfr[4] = {0u, 0u, 0u, 0u}, sink = 0u;
    for (int n0 = 0; n0 < NSEG; n0 += 4) {
#pragma unroll
        for (int u = 0; u < 4; ++u) {
            const int n = n0 + u; const int s = u & 1;
            sink ^= pfr[u]; pfr[u] = dn_touch(p, n + 5, b, h, dir, e0, tid);
            const DnFr& F = buf[s];
            const int tt = tile_of(n, b, dir), rowbase = rowbase_of(tt);
            const u16* Scur = Sl + (n & 1) * (32 * 136); u16* Snxt = Sl + ((n + 1) & 1) * (32 * 136);
            f32x4_t X = (f32x4_t){0.f, 0.f, 0.f, 0.f}, Y = X;
#pragma unroll
            for (int ks = 0; ks < 4; ++ks) { const bf16x8_t sb = *(const bf16x8_t*)(Scur + (et * 16 + fr) * 136 + ks * 32 + fq * 8);
                X = __builtin_amdgcn_mfma_f32_16x16x32_bf16(F.k[ks], sb, X, 0, 0, 0); Y = __builtin_amdgcn_mfma_f32_16x16x32_bf16(F.q[ks], sb, Y, 0, 0, 0); }
#pragma unroll
            for (int j = 0; j < 4; ++j) Rt[(et * 16 + fr) * 72 + lt * 16 + fq * 4 + j] = f2bf(F.be[j] * (bf2f(F.v[j]) - F.egc[j] * X[j]));
            { float k[16]; unpack8(F.kr[0], k); unpack8(F.kr[1], k + 8);
#pragma unroll
                for (int c = 0; c < 16; ++c) Kdt[(seg * 16 + c) * 72 + tl] = f2bf(k[c] * F.kds); }
            __syncthreads();
            { f32x4_t VN = (f32x4_t){0.f, 0.f, 0.f, 0.f};
#pragma unroll
                for (int ks = 0; ks < 2; ++ks) { const bf16x8_t rb = *(const bf16x8_t*)(Rt + (et * 16 + fr) * 72 + ks * 32 + fq * 8); VN = __builtin_amdgcn_mfma_f32_16x16x32_bf16(F.tm[ks], rb, VN, 0, 0, 0); }
#pragma unroll
                for (int j = 0; j < 4; ++j) VNt[(et * 16 + fr) * 72 + lt * 16 + fq * 4 + j] = f2bf(VN[j]); }
            __syncthreads();
            bf16x8_t vn[2];
#pragma unroll
            for (int ks = 0; ks < 2; ++ks) vn[ks] = *(const bf16x8_t*)(VNt + (et * 16 + fr) * 72 + ks * 32 + fq * 8);
            { f32x4_t acc = (f32x4_t){0.f, 0.f, 0.f, 0.f};
#pragma unroll
                for (int ks = 0; ks < 2; ++ks) acc = __builtin_amdgcn_mfma_f32_16x16x32_bf16(F.qk[ks], vn[ks], acc, 0, 0, 0);
#pragma unroll
                for (int j = 0; j < 4; ++j) O[(size_t)(rowbase + lt * 16 + fq * 4 + j) * 2048 + 1024 + h * 128 + e0 + et * 16 + fr] = f2bf(0.08838834764831845f * F.egc[j] * Y[j] + acc[j]); }
#pragma unroll
            for (int i = 0; i < 2; ++i) { f32x4_t nw = (f32x4_t){0.f, 0.f, 0.f, 0.f};
#pragma unroll
                for (int ks = 0; ks < 2; ++ks) { const bf16x8_t kb = *(const bf16x8_t*)(Kdt + ((dt0 + i) * 16 + fr) * 72 + ks * 32 + fq * 8); nw = __builtin_amdgcn_mfma_f32_16x16x32_bf16(vn[ks], kb, nw, 0, 0, 0); }
#pragma unroll
                for (int j = 0; j < 4; ++j) { Sacc[i][j] = F.egL * Sacc[i][j] + nw[j]; Snxt[(et * 16 + fq * 4 + j) * 136 + (dt0 + i) * 16 + fr] = f2bf(Sacc[i][j]); } }
            __syncthreads();
            dn_load(buf[s], p, n + 2, b, h, dir, e0, lt, et, fr, fq, tl, seg);
        }
    }
    ((unsigned*)(p.ws + WS_MODP))[blockIdx.x * NTHR + tid] = sink ^ pfr[0] ^ pfr[1] ^ pfr[2] ^ pfr[3];
}

constexpr int RG_XC = 65536;

__device__ __forceinline__ void ph_convert_rg(const Params& p) {
    u16* WRT = (u16*)(p.ws + WS_WRT);
    for (int idx = blockIdx.x * NTHR + tid_fresh(); idx < 65536; idx += gridDim.x * NTHR) {
        const int k8 = idx & 15, n = (idx >> 4) & 127, mzg = idx >> 11;
        const float* W = (mzg < 16 ? p.rg_w_r : p.rg_w_i) + (size_t)(mzg & 15) * 16384;
        float v[8];
#pragma unroll
        for (int j = 0; j < 8; ++j) v[j] = W[(k8 * 8 + j) * 128 + n];
        *(uint4*)(WRT + (size_t)mzg * 16384 + n * 128 + k8 * 8) = pack8(v);
    }
}
__device__ __forceinline__ int rg_tau(int tt, int z) { if (tt < 8) { const int ci = tt & 3; return z ? 3 - ci : ci; } const int li = (tt - 8) & 255; return 4 + (z ? 255 - li : li); }
__device__ __forceinline__ int rg_batch(int tt) { return tt < 8 ? (tt >> 2) : ((tt - 8) >> 8); }

__device__ __forceinline__ void rg_conv(const Params& p, int tt, int g, unsigned char* lds) {
    const int tid = tid_fresh();
    const u16* PROJ = (const u16*)(p.ws + WS_PROJ);
    float* sm = (float*)lds; u16* XC = (u16*)(lds + RG_XC);
    const bool isctx = tt < 8;
    const int t0 = isctx ? (tt & 3) * 64 : 0;
    const int rowbase = isctx ? (tt >> 2) * 256 + t0 : 512 + (tt - 8) * 64;
    __syncthreads();
    for (int ch = tid; ch < 68 * 16; ch += NTHR) {
        const int rr = ch >> 4, c8 = (ch & 15) * 8, r = rr - 2;
        const bool ok = isctx ? (t0 + r >= 0 && t0 + r < 256) : (r >= 0 && r < 64);
        float f[8];
#pragma unroll
        for (int j = 0; j < 8; ++j) f[j] = 0.f;
        if (ok) { const uint4 u = *(const uint4*)(PROJ + (size_t)(rowbase + r) * NP1 + g * 128 + c8); unpack8(u, f); }
        float* d = sm + rr * 132 + c8;
        *(float4*)(d) = make_float4(f[0], f[1], f[2], f[3]); *(float4*)(d + 4) = make_float4(f[4], f[5], f[6], f[7]);
    }
    __syncthreads();
    const int tk = tid >> 3, cs = (tid & 7) * 16;
    float o[16];
#pragma unroll
    for (int c4 = 0; c4 < 4; ++c4) { const float4 b4 = *(const float4*)(p.rg_conv_b + g * 128 + cs + c4 * 4); o[c4 * 4] = b4.x; o[c4 * 4 + 1] = b4.y; o[c4 * 4 + 2] = b4.z; o[c4 * 4 + 3] = b4.w; }
#pragma unroll
    for (int j = 0; j < 5; ++j) {
        const float* wr_ = p.rg_conv_w + j * 1024 + g * 128 + cs; const float* ir = sm + (tk + j) * 132 + cs;
#pragma unroll
        for (int c4 = 0; c4 < 4; ++c4) { const float4 w4 = *(const float4*)(wr_ + c4 * 4), i4 = *(const float4*)(ir + c4 * 4);
            o[c4 * 4 + 0] += i4.x * w4.x; o[c4 * 4 + 1] += i4.y * w4.y; o[c4 * 4 + 2] += i4.z * w4.z; o[c4 * 4 + 3] += i4.w * w4.w; }
    }
    *(uint4*)(XC + tk * 136 + cs) = pack8(o); *(uint4*)(XC + tk * 136 + cs + 8) = pack8(o + 8);
    __syncthreads();
}
__device__ __forceinline__ void rg_gates_reg(const Params& p, int g, int z, const unsigned char* lds, int rt, int chh, int fr, int fq, float (&av)[4][4], float (&bx)[4][4]) {
    const u16* XC = (const u16*)(lds + RG_XC);
    const u16* WR = (const u16*)(p.ws + WS_WRT) + (size_t)((0 * 2 + z) * 8 + g) * 16384; const u16* WI = (const u16*)(p.ws + WS_WRT) + (size_t)((1 * 2 + z) * 8 + g) * 16384;
    f32x4_t R[4], I[4];
#pragma unroll
    for (int c = 0; c < 4; ++c) { R[c] = (f32x4_t){0.f, 0.f, 0.f, 0.f}; I[c] = (f32x4_t){0.f, 0.f, 0.f, 0.f}; }
#pragma unroll
    for (int ks = 0; ks < 4; ++ks) {
        const bf16x8_t a = *(const bf16x8_t*)(XC + (rt * 16 + fr) * 136 + ks * 32 + fq * 8);
#pragma unroll
        for (int c = 0; c < 4; ++c) { const int n = (chh * 4 + c) * 16 + fr;
            R[c] = __builtin_amdgcn_mfma_f32_16x16x32_bf16(a, *(const bf16x8_t*)(WR + n * 128 + ks * 32 + fq * 8), R[c], 0, 0, 0);
            I[c] = __builtin_amdgcn_mfma_f32_16x16x32_bf16(a, *(const bf16x8_t*)(WI + n * 128 + ks * 32 + fq * 8), I[c], 0, 0, 0); }
    }
#pragma unroll
    for (int c = 0; c < 4; ++c) {
        const int chl = (chh * 4 + c) * 16 + fr, chg = z * 1024 + g * 128 + chl;
        const float br = p.rg_b_r[chg], bi = p.rg_b_i[chg], sp = softplusf_(-p.rg_lambda[chg]);
#pragma unroll
        for (int j = 0; j < 4; ++j) { const int t = rt * 16 + fq * 4 + j;
            const float r = sigmoidf_(R[c][j] + br), ii = sigmoidf_(I[c][j] + bi);
            const float la = -8.f * r * sp;
            av[c][j] = __expf(la); bx[c][j] = sqrtf(-expm1f(2.f * la)) * ii * bf2f(XC[t * 136 + chl]); }
    }
}
__device__ __forceinline__ float2 rg_local(const float (&a)[4], const float (&b)[4], int z) {
    float P = 1.f, H = 0.f;
#pragma unroll
    for (int i = 0; i < 4; ++i) { const int j = z ? 3 - i : i; H = a[j] * H + b[j]; P *= a[j]; }
    return make_float2(P, H);
}
__device__ __forceinline__ void gla_prep_item(const Params& p, int it, unsigned char* lds) {
    const int tid = tid_fresh(), lane = tid & 63, w = tid >> 6, fr = lane & 15, fq = lane >> 4;
    const int h = it & 3, tt = (it >> 2) % 520, z = it / 2080;
    const int rowbase = tt < 8 ? tt * 64 : 512 + (tt - 8) * 64;
    float* LG = (float*)lds;
    u16* QEs = (u16*)(lds + 32768);
    u16* KEs = (u16*)(lds + 32768 + 17408);
    u16* Vs = (u16*)(lds + 32768 + 2 * 17408);
    float* BLs = (float*)(lds + 32768 + 2 * 17408 + 33792);
    const u16* PROJ = (const u16*)(p.ws + WS_PROJ); const float* LR = (const float*)(p.ws + WS_G);
    u16* QE = (u16*)(p.ws + WS_QE); u16* KDT = (u16*)(p.ws + WS_KDT) + (size_t)it * 8192; u16* ATT = (u16*)(p.ws + WS_ATT) + (size_t)it * 4096;
    u16* VT = (u16*)(p.ws + WS_VT); float* EBL = (float*)(p.ws + WS_EBL);
    __syncthreads();
    { const int c = tid & 127, tq = tid >> 7; float wv[16];
#pragma unroll
        for (int r = 0; r < 16; ++r) wv[r] = p.gla_w_up[(z * 16 + r) * 512 + h * 128 + c];
        const float bu = p.gla_b_up[z * 512 + h * 128 + c];
        for (int i = 0; i < 16; ++i) { const int tk = tq * 16 + i; const float* lr = LR + (size_t)(rowbase + tk) * 32 + z * 16; float s = bu;
#pragma unroll
            for (int r = 0; r < 16; ++r) s += lr[r] * wv[r];
            LG[tk * 128 + c] = logsigmoidf_(s) * (1.f / 16.f); } }
    __syncthreads();
    if (tid < 128) { float acc = 0.f;
        for (int i = 0; i < 64; ++i) { const int tk = z ? 63 - i : i; acc += LG[tk * 128 + tid]; LG[tk * 128 + tid] = acc; }
        BLs[tid] = acc; EBL[(size_t)it * 128 + tid] = __expf(acc); }
    __syncthreads();
    { const int tk = tid >> 3, cs = (tid & 7) * 16; const u16* rp = PROJ + (size_t)(rowbase + tk) * NP1;
        float q[16], k[16], qe[16], ke[16];
        unpack8(*(const uint4*)(rp + 2048 + h * 128 + cs), q); unpack8(*(const uint4*)(rp + 2048 + h * 128 + cs + 8), q + 8);
        unpack8(*(const uint4*)(rp + 2560 + h * 128 + cs), k); unpack8(*(const uint4*)(rp + 2560 + h * 128 + cs + 8), k + 8);
#pragma unroll
        for (int c = 0; c < 16; ++c) { const float bb = LG[tk * 128 + cs + c], bl = BLs[cs + c];
            qe[c] = q[c] * 0.08838834764831845f * __expf(bb); ke[c] = k[c] * __expf(-bb); KDT[(cs + c) * 64 + tk] = f2bf(k[c] * __expf(bl - bb)); }
        const uint4 q0 = pack8(qe), q1 = pack8(qe + 8);
        *(uint4*)(QEs + tk * 136 + cs) = q0; *(uint4*)(QEs + tk * 136 + cs + 8) = q1;
        *(uint4*)(KEs + tk * 136 + cs) = pack8(ke); *(uint4*)(KEs + tk * 136 + cs + 8) = pack8(ke + 8);
        u16* qg = QE + ((size_t)z * MTOT + rowbase + tk) * 512 + h * 128 + cs;
        *(uint4*)(qg) = q0; *(uint4*)(qg + 8) = q1; }
    if (z == 0) for (int ch = tid; ch < 2048; ch += NTHR) { const int tk = ch >> 5, c8 = (ch & 31) * 8;
        *(uint4*)(Vs + tk * 264 + c8) = *(const uint4*)(PROJ + (size_t)(rowbase + tk) * NP1 + 3072 + h * 256 + c8); }
    __syncthreads();
    { const int rt = w >> 1;
#pragma unroll
        for (int i = 0; i < 2; ++i) { const int ct = (w & 1) * 2 + i; f32x4_t acc = (f32x4_t){0.f, 0.f, 0.f, 0.f};
#pragma unroll
            for (int ks = 0; ks < 4; ++ks) { const bf16x8_t a = *(const bf16x8_t*)(QEs + (rt * 16 + fr) * 136 + ks * 32 + fq * 8); const bf16x8_t bb = *(const bf16x8_t*)(KEs + (ct * 16 + fr) * 136 + ks * 32 + fq * 8);
                acc = __builtin_amdgcn_mfma_f32_16x16x32_bf16(a, bb, acc, 0, 0, 0); }
#pragma unroll
            for (int j = 0; j < 4; ++j) { const int l = rt * 16 + fq * 4 + j, s = ct * 16 + fr; const bool keep = z ? (s >= l) : (s <= l);
                ATT[l * 64 + s] = f2bf(keep ? acc[j] : 0.f); } } }
    if (z == 0) { const int e = tid >> 1, hf = tid & 1; u16* dst = VT + ((size_t)(tt * 4 + h) * 256 + e) * 64 + hf * 32;
#pragma unroll
        for (int l8 = 0; l8 < 4; ++l8) { float v[8];
#pragma unroll
            for (int j = 0; j < 8; ++j) v[j] = bf2f(Vs[(hf * 32 + l8 * 8 + j) * 264 + e]);
            *(uint4*)(dst + l8 * 8) = pack8(v); } }
}
__device__ __forceinline__ void ph_l1_a(const Params& p, unsigned char* lds) {
    const int tid = tid_fresh(), lane = tid & 63, w = tid >> 6, rt = w >> 1, chh = w & 1, fr = lane & 15, fq = lane >> 4;
#ifdef PROBE3
    if (blockIdx.x == 100 && tid == 0) { unsigned long long* pr = (unsigned long long*)(p.ws + WS_MODP) + 500000; pr[0] = __builtin_amdgcn_s_memrealtime(); }
#endif
    float2* AGG = (float2*)(p.ws + WS_AGG);
    float2* AG = (float2*)lds;
    for (int t = blockIdx.x; t < 520 * 8; t += gridDim.x) {
        const int tt = t >> 3, g = t & 7, b = rg_batch(tt);
        rg_conv(p, tt, g, lds);
#pragma unroll
        for (int z = 0; z < 2; ++z) {
            float av[4][4], bx[4][4];
            rg_gates_reg(p, g, z, lds, rt, chh, fr, fq, av, bx);
#pragma unroll
            for (int c = 0; c < 4; ++c) AG[(z * 16 + rt * 4 + fq) * 128 + (chh * 4 + c) * 16 + fr] = rg_local(av[c], bx[c], z);
        }
        __syncthreads();
        if (tid < 256) { const int z = tid >> 7, ch = tid & 127; float P = 1.f, H = 0.f;
#pragma unroll
            for (int s = 0; s < 16; ++s) { const int gi = z ? 15 - s : s; const float2 ph = AG[(z * 16 + gi) * 128 + ch]; H = ph.x * H + ph.y; P *= ph.x; }
            AGG[((size_t)(b * 2 + z) * NSEG + rg_tau(tt, z)) * 1024 + g * 128 + ch] = make_float2(P, H); }
    }
#ifdef PROBE3
    __syncthreads(); const unsigned long long tm_ = __builtin_amdgcn_s_memrealtime();
#endif
    for (int it = blockIdx.x; it < 4160; it += gridDim.x) gla_prep_item(p, it, lds);
#ifdef PROBE3
    __syncthreads(); if (blockIdx.x == 100 && tid == 0) { unsigned long long* pr = (unsigned long long*)(p.ws + WS_MODP) + 500000; pr[1] = tm_; pr[2] = __builtin_amdgcn_s_memrealtime(); }
#endif
}
__device__ __forceinline__ void rg_pass_b(const Params& p, int job) {
    const float2* __restrict__ AGG = (const float2*)(p.ws + WS_AGG); float* __restrict__ CARRY = (float*)(p.ws + WS_CARRY);
    const int bz = job >> 1, ch = (job & 1) * 512 + tid_fresh();
    float carry = 0.f;
    for (int t0 = 0; t0 < NSEG; t0 += 20) {
        float2 ph[20];
#pragma unroll
        for (int i = 0; i < 20; ++i) ph[i] = AGG[((size_t)bz * NSEG + t0 + i) * 1024 + ch];
#pragma unroll
        for (int i = 0; i < 20; ++i) { CARRY[((size_t)bz * NSEG + t0 + i) * 1024 + ch] = carry; carry = ph[i].x * carry + ph[i].y; }
    }
}
struct GlaFr { bf16x8_t qe[4], at[2], vt[2], kd[2][2]; float eb[2]; };
__device__ __forceinline__ void gla_load(GlaFr& F, const Params& p, int n, int b, int h, int dir, int e0, int lt, int et, int dt0, int fr, int fq) {
    const int nn = n < NSEG ? n : NSEG - 1;
    const int tt = tile_of(nn, b, dir), it = (dir * 520 + tt) * 4 + h, rowbase = tt < 8 ? tt * 64 : 512 + (tt - 8) * 64;
    const u16* QE = (const u16*)(p.ws + WS_QE) + ((size_t)dir * MTOT + rowbase + lt * 16 + fr) * 512 + h * 128 + fq * 8;
    const u16* ATT = (const u16*)(p.ws + WS_ATT) + (size_t)it * 4096 + (lt * 16 + fr) * 64 + fq * 8;
    const u16* VT = (const u16*)(p.ws + WS_VT) + ((size_t)(tt * 4 + h) * 256 + e0 + et * 16 + fr) * 64 + fq * 8;
    const u16* KDT = (const u16*)(p.ws + WS_KDT) + (size_t)it * 8192 + (dt0 * 16 + fr) * 64 + fq * 8;
    const float* EBL = (const float*)(p.ws + WS_EBL) + (size_t)it * 128 + dt0 * 16 + fr;
#pragma unroll
    for (int ks = 0; ks < 4; ++ks) F.qe[ks] = *(const bf16x8_t*)(QE + ks * 32);
#pragma unroll
    for (int ks = 0; ks < 2; ++ks) { F.at[ks] = *(const bf16x8_t*)(ATT + ks * 32); F.vt[ks] = *(const bf16x8_t*)(VT + ks * 32);
        F.kd[0][ks] = *(const bf16x8_t*)(KDT + ks * 32); F.kd[1][ks] = *(const bf16x8_t*)(KDT + 16 * 64 + ks * 32); }
    F.eb[0] = EBL[0]; F.eb[1] = EBL[16];
}
__device__ __forceinline__ unsigned gla_touch(const Params& p, int n, int b, int h, int dir, int e0, int tid) {
    const int nn = n < NSEG ? n : NSEG - 1;
    const int tt = tile_of(nn, b, dir), it = (dir * 520 + tt) * 4 + h, rowbase = rowbase_of(tt);
    const u16* a;
    if (tid < 128) a = (const u16*)(p.ws + WS_QE) + ((size_t)dir * MTOT + rowbase + (tid >> 1)) * 512 + h * 128 + (tid & 1) * 64;
    else if (tid < 256) a = (const u16*)(p.ws + WS_KDT) + (size_t)it * 8192 + (tid - 128) * 64;
    else if (tid < 320) a = (const u16*)(p.ws + WS_ATT) + (size_t)it * 4096 + (tid - 256) * 64;
    else if (tid < 352) a = (const u16*)(p.ws + WS_VT) + ((size_t)(tt * 4 + h) * 256 + e0 + (tid - 320)) * 64;
    else a = (const u16*)(p.ws + WS_EBL) + (size_t)it * 256 + ((tid - 352) & 3) * 64;
    return *(const unsigned*)a;
}
__device__ __forceinline__ void gla_chunk(const Params& p, int job, unsigned char* lds) {
    const int tid = tid_fresh(), lane = tid & 63, w = tid >> 6, fr = lane & 15, fq = lane >> 4;
    const int chain = job >> 3, cgp = job & 7;
    const int b = chain >> 3, h = (chain >> 1) & 3, dir = chain & 1;
    const int e0 = cgp * 32, lt = w >> 1, et = w & 1, dt0 = (w >> 1) * 2;
    u16* Sl = (u16*)lds;
    u16* O = (u16*)(p.ws + (dir ? WS_OB1 : WS_OF1));
    __syncthreads();
    for (int i = tid; i < 2 * 32 * 136 / 2; i += NTHR) ((unsigned*)Sl)[i] = 0u;
    __syncthreads();
    f32x4_t Sacc[2]; Sacc[0] = (f32x4_t){0.f, 0.f, 0.f, 0.f}; Sacc[1] = Sacc[0];
    GlaFr buf[2];
    gla_load(buf[0], p, 0, b, h, dir, e0, lt, et, dt0, fr, fq); gla_load(buf[1], p, 1, b, h, dir, e0, lt, et, dt0, fr, fq);
    unsigned pfr[4] = {0u, 0u, 0u, 0u}, sink = 0u;
#ifdef PROBE2
    unsigned long long wL_ = 0, wB_ = 0; const unsigned long long ts_ = __builtin_amdgcn_s_memrealtime();
#endif
    for (int n0 = 0; n0 < NSEG; n0 += 4) {
#pragma unroll
        for (int u = 0; u < 4; ++u) {
            const int n = n0 + u; const int s = u & 1;
            sink ^= pfr[u]; pfr[u] = gla_touch(p, n + 5, b, h, dir, e0, tid);
#ifdef PROBE2
            { const unsigned long long t0_ = __builtin_amdgcn_s_memrealtime();
              asm volatile("" :: "v"(buf[s].qe[0]), "v"(buf[s].kd[1][1]), "v"(buf[s].eb[1]), "v"(buf[s].at[1]), "v"(buf[s].vt[1]));
              const unsigned long long t1_ = __builtin_amdgcn_s_memrealtime(); wL_ += t1_ - t0_; }
#endif
            {
                const GlaFr& F = buf[s];
                const u16* Scur = Sl + (n & 1) * (32 * 136); u16* Snxt = Sl + ((n + 1) & 1) * (32 * 136);
                if (n >= 4) {
                    const int tt = tile_of(n, b, dir), rowbase = 512 + (tt - 8) * 64;
                    f32x4_t acc = (f32x4_t){0.f, 0.f, 0.f, 0.f};
#pragma unroll
                    for (int ks = 0; ks < 4; ++ks) { const bf16x8_t bb = *(const bf16x8_t*)(Scur + (et * 16 + fr) * 136 + ks * 32 + fq * 8); acc = __builtin_amdgcn_mfma_f32_16x16x32_bf16(F.qe[ks], bb, acc, 0, 0, 0); }
#pragma unroll
                    for (int ks = 0; ks < 2; ++ks) acc = __builtin_amdgcn_mfma_f32_16x16x32_bf16(F.at[ks], F.vt[ks], acc, 0, 0, 0);
#pragma unroll
                    for (int j = 0; j < 4; ++j) O[(size_t)(rowbase + lt * 16 + fq * 4 + j) * 1024 + h * 256 + e0 + et * 16 + fr] = f2bf(acc[j]);
                }
#pragma unroll
                for (int i = 0; i < 2; ++i) { f32x4_t nw = (f32x4_t){0.f, 0.f, 0.f, 0.f};
#pragma unroll
                    for (int ks = 0; ks < 2; ++ks) nw = __builtin_amdgcn_mfma_f32_16x16x32_bf16(F.vt[ks], F.kd[i][ks], nw, 0, 0, 0);
#pragma unroll
                    for (int j = 0; j < 4; ++j) { Sacc[i][j] = F.eb[i] * Sacc[i][j] + nw[j]; Snxt[(et * 16 + fq * 4 + j) * 136 + (dt0 + i) * 16 + fr] = f2bf(Sacc[i][j]); } }
#ifdef PROBE2
                { asm volatile("s_waitcnt lgkmcnt(0)" ::: "memory"); const unsigned long long t2_ = __builtin_amdgcn_s_memrealtime();
                  __syncthreads();
                  const unsigned long long t3_ = __builtin_amdgcn_s_memrealtime(); wB_ += t3_ - t2_; }
#else
                __syncthreads();
#endif
            }
            gla_load(buf[s], p, n + 2, b, h, dir, e0, lt, et, dt0, fr, fq);
        }
    }
    ((unsigned*)(p.ws + WS_MODP))[blockIdx.x * NTHR + tid] = sink ^ pfr[0] ^ pfr[1] ^ pfr[2] ^ pfr[3];
#ifdef PROBE2
    if (job == 37 && tid == 0) { const float tot_ = (float)(__builtin_amdgcn_s_memrealtime() - ts_); float* pr = (float*)(p.ws + WS_MODP) + 1000000; pr[0] = (float)wL_ / tot_; pr[1] = (float)wB_ / tot_; }
#endif
}
__device__ __forceinline__ void ph_l1_c(const Params& p, unsigned char* lds) {
    const int tid = tid_fresh(), rt = (tid >> 6) >> 1, chh = (tid >> 6) & 1, fr = tid & 15, fq = (tid & 63) >> 4;
    const u16* PROJ = (const u16*)(p.ws + WS_PROJ); const float* CARRY = (const float*)(p.ws + WS_CARRY); u16* Y = (u16*)(p.ws + WS_H);
    float2* AG = (float2*)lds;
    float* CIN = (float*)(lds + 32768);
    for (int t = blockIdx.x + 64; t < 520 * 8; t += gridDim.x) {
        const int tt = t >> 3, g = t & 7, b = rg_batch(tt);
        const int rowbase = 512 + (tt - 8) * 64;
        u16 grv[4][4];
#pragma unroll
        for (int c = 0; c < 4; ++c)
#pragma unroll
            for (int j = 0; j < 4; ++j) grv[c][j] = PROJ[(size_t)(rowbase + rt * 16 + fq * 4 + j) * NP1 + 1024 + g * 128 + (chh * 4 + c) * 16 + fr];
        rg_conv(p, tt, g, lds);
        float av[2][4][4], bx[2][4][4];
#pragma unroll
        for (int z = 0; z < 2; ++z) {
            rg_gates_reg(p, g, z, lds, rt, chh, fr, fq, av[z], bx[z]);
#pragma unroll
            for (int c = 0; c < 4; ++c) AG[(z * 16 + rt * 4 + fq) * 128 + (chh * 4 + c) * 16 + fr] = rg_local(av[z][c], bx[z][c], z);
        }
        __syncthreads();
        if (tid < 256) { const int z = tid >> 7, ch = tid & 127; float h = CARRY[((size_t)(b * 2 + z) * NSEG + rg_tau(tt, z)) * 1024 + g * 128 + ch];
#pragma unroll
            for (int s = 0; s < 16; ++s) { const int gi = z ? 15 - s : s; CIN[(z * 16 + gi) * 128 + ch] = h; const float2 ph = AG[(z * 16 + gi) * 128 + ch]; h = ph.x * h + ph.y; } }
        __syncthreads();
#pragma unroll
        for (int c = 0; c < 4; ++c) { const int chl = (chh * 4 + c) * 16 + fr; float hs[4];
            { float h = CIN[(0 * 16 + rt * 4 + fq) * 128 + chl];
#pragma unroll
                for (int j = 0; j < 4; ++j) { h = av[0][c][j] * h + bx[0][c][j]; hs[j] = h; } }
            { float h = CIN[(1 * 16 + rt * 4 + fq) * 128 + chl];
#pragma unroll
                for (int j = 3; j >= 0; --j) { h = av[1][c][j] * h + bx[1][c][j]; hs[j] += h; } }
#pragma unroll
            for (int j = 0; j < 4; ++j) Y[(size_t)(rowbase + rt * 16 + fq * 4 + j) * 2048 + g * 128 + chl] = f2bf(gelu_tanh(bf2f(grv[c][j])) * hs[j]); }
    }
    const int lane = tid & 63, w = tid >> 6;
    const u16* OF = (const u16*)(p.ws + WS_OF1); const u16* OB = (const u16*)(p.ws + WS_OB1);
    for (int row = 512 + blockIdx.x * 8 + w; row < MTOT; row += gridDim.x * 8) {
        const int col = lane * 16; float o[16]; float ss = 0.f;
#pragma unroll
        for (int i = 0; i < 2; ++i) { float a[8], bb[8]; unpack8(*(const uint4*)(OF + (size_t)row * 1024 + col + i * 8), a); unpack8(*(const uint4*)(OB + (size_t)row * 1024 + col + i * 8), bb);
#pragma unroll
            for (int j = 0; j < 8; ++j) { o[i * 8 + j] = a[j] + bb[j]; ss += o[i * 8 + j] * o[i * 8 + j]; } }
        ss = red16(ss);
        const float rstd = rsqrtf(ss * (1.f / 256.f) + 1e-6f);
#pragma unroll
        for (int i = 0; i < 2; ++i) { float gt[8], r[8]; unpack8(*(const uint4*)(PROJ + (size_t)row * NP1 + 4096 + col + i * 8), gt);
#pragma unroll
            for (int j = 0; j < 8; ++j) r[j] = o[i * 8 + j] * rstd * p.gla_norm_g[col + i * 8 + j] * siluf_(gt[j]);
            *(uint4*)(Y + (size_t)row * 2048 + 1024 + col + i * 8) = pack8(r); }
    }
}

#define XB_TMO      128
#define XB_XCNT(j)  (256  + 64 * (j))
#define XB_XSUB(j)  (1280 + 64 * (j))
#define XB_XGEN(j)  (2304 + 64 * (j))
#define XB_TOP      3328
#define XB_TOPGEN   3392
#define XCD_BAR_WORDS 3456
#define XB_SPIN_CAP (1u << 18)
#define XLAS __attribute__((address_space(3)))

__device__ __forceinline__ unsigned xb_ld(unsigned* p)              { return __hip_atomic_load(p, __ATOMIC_RELAXED, __HIP_MEMORY_SCOPE_AGENT); }
__device__ __forceinline__ unsigned xb_add(unsigned* p, unsigned v) { return __hip_atomic_fetch_add(p, v, __ATOMIC_RELAXED, __HIP_MEMORY_SCOPE_AGENT); }
__device__ __forceinline__ unsigned xb_xcc_id() { return (unsigned)__builtin_amdgcn_s_getreg((3 << 11) | 20) & 0xFu; }
#define XB_SPIN(cond, bar) do { unsigned _sp = 0; while (cond) { __builtin_amdgcn_s_sleep(1); \
    if ((++_sp & 255u) == 0u) { if (xb_ld(&(bar)[XB_TMO])) break; if (_sp > XB_SPIN_CAP) { atomicAdd(&(bar)[XB_TMO], 1u); break; } } } } while (0)

struct XcdBarrier {
    unsigned* bar; unsigned x;
    volatile XLAS unsigned* st;
};

__device__ __forceinline__ XcdBarrier xcd_barrier_post(unsigned* bar, volatile XLAS unsigned* st) {
    XcdBarrier b; b.bar = bar; b.x = xb_xcc_id(); b.st = st;
    if (threadIdx.x == 0) (void)xb_add(&bar[XB_XCNT(b.x)], 1u);
    return b;
}
__device__ __forceinline__ void xcd_barrier_complete(unsigned* bar, unsigned x, unsigned& nloc, unsigned& nx) {
    const unsigned G = gridDim.x * gridDim.y * gridDim.z;
    unsigned sum, cnt, mine, sp = 0u;
    for (;;) {
        sum = 0u; cnt = 0u; mine = 0u;
#pragma unroll
        for (unsigned j = 0; j < 16; ++j) { const unsigned c = xb_ld(&bar[XB_XCNT(j)]); sum += c; cnt += (c > 0u) ? 1u : 0u; mine = (j == x) ? c : mine; }
        if (sum == G) break;
        __builtin_amdgcn_s_sleep(1);
        if ((++sp & 255u) == 0u) { if (xb_ld(&bar[XB_TMO])) break; if (sp > XB_SPIN_CAP) { atomicAdd(&bar[XB_TMO], 1u); break; } }
    }
    nloc = mine > 0u ? mine : 1u; nx = cnt > 0u ? cnt : 1u;
}

__device__ __forceinline__ void xcd_barrier(const XcdBarrier& b) {
    asm volatile("s_waitcnt vmcnt(0)" ::: "memory");
    __syncthreads();
    if (threadIdx.x == 0) {
        unsigned* bar = b.bar;
        __builtin_amdgcn_s_waitcnt(0);
        unsigned nloc = b.st[0], nx = b.st[1];
        if (nloc == 0u) { xcd_barrier_complete(bar, b.x, nloc, nx); b.st[0] = nloc; b.st[1] = nx; }
        const unsigned old = xb_add(&bar[XB_XSUB(b.x)], 1u);
        const unsigned gen = old / nloc;
        if (old + 1u == (gen + 1u) * nloc) {
            __builtin_amdgcn_fence(__ATOMIC_RELEASE, "agent");
            asm volatile("s_waitcnt vmcnt(0)" ::: "memory");
            const unsigned og = xb_add(&bar[XB_TOP], 1u);
            const unsigned tg = og / nx;
            if (og + 1u == (tg + 1u) * nx) xb_add(&bar[XB_TOPGEN], 1u);
            else XB_SPIN(xb_ld(&bar[XB_TOPGEN]) == tg, bar);
            __builtin_amdgcn_fence(__ATOMIC_ACQUIRE, "agent");
            xb_add(&bar[XB_XGEN(b.x)], 1u);
            asm volatile("s_waitcnt vmcnt(0)" ::: "memory");
        } else {
            XB_SPIN(xb_ld(&bar[XB_XGEN(b.x)]) == gen, bar);
            __builtin_amdgcn_fence(__ATOMIC_ACQUIRE, "agent");
            asm volatile("s_waitcnt vmcnt(0)" ::: "memory");
        }
    }
    __syncthreads();
}

constexpr int LDS_BYTES = 135168 + 16;

__global__ void __launch_bounds__(NTHR, 2) hybrid_fwd(Params p) {
    extern __shared__ __attribute__((aligned(16))) unsigned char lds[];
    cg::grid_group grid = cg::this_grid();
    float* smf = (float*)lds;
    PG8_LAS unsigned char* ldsg = (PG8_LAS unsigned char*)lds;
    unsigned char* ws = p.ws;
    u16* WT_IN = (u16*)(ws + WS_WT_IN); u16* WT_OUT = (u16*)(ws + WS_WT_OUT); u16* WT_GU = (u16*)(ws + WS_WT_GU); u16* WT_DN = (u16*)(ws + WS_WT_DN);
    u16* H = (u16*)(ws + WS_H); u16* PROJ = (u16*)(ws + WS_PROJ); float* XC = (float*)(ws + WS_XC); float* G = (float*)(ws + WS_G);
    const float* MOD = (const float*)(ws + WS_MOD);
    const int GD = (int)gridDim.x, bid = (int)blockIdx.x;
    const int vb = (GD % 8 == 0) ? (bid % 8) * (GD / 8) + bid / 8 : bid;
    volatile XLAS unsigned* xst = (volatile XLAS unsigned*)((PG8_LAS unsigned char*)lds + 135168);
    if (threadIdx.x < 2) xst[threadIdx.x] = 0u;
    __syncthreads();
    const XcdBarrier xbar = xcd_barrier_post((unsigned*)(ws + WS_BAR), xst);
#ifdef PROBE
    unsigned long long tG = 0, tL0P = 0, tL0PP = 0, tL0M = 0, tL1A = 0, tL1M = 0, tL1C = 0, tO = 0, tprev = __builtin_amdgcn_s_memrealtime();
#define PSTAMP(c) do { const unsigned long long t_ = __builtin_amdgcn_s_memrealtime(); c += t_ - tprev; tprev = t_; } while (0)
#else
#define PSTAMP(c) do {} while (0)
#endif

    ph_adaln_partials(p, smf);
    ph_convert_rg(p);
    ph_convert<1>(p.ab_w_in, 7216, 2048, 7424, WT_IN, smf);
    ph_convert<0>(p.ab_w_out, 2048, 2048, 2048, WT_OUT, smf);
    ph_convert<2>(p.ffn_w_gu, 11264, 2048, 11264, WT_GU, smf);
    ph_convert<0>(p.ffn_w_down, 2048, 5632, 2048, WT_DN, smf);
    grid.sync();
    PSTAMP(tO);
    ph_adaln_reduce(p);
    xcd_barrier(xbar);
    PSTAMP(tO);

    ph_norm(p.ctx, p.x, p.norm_mix_g, MOD, 0, 1, H, 0);
    xcd_barrier(xbar);
    PSTAMP(tO);
    { pg8::Gemm g{H, WT_IN, MTOT, 7424, 2048}; pg8::StaticOrder S; S.init(MTOT, 7424, GD, bid);
      pg8::EpiProj E{PROJ, NP0, 28, G, NG0, NG0}; pg8::gemm_phase<pg8::EpiProj, pg8::StaticOrder>(ldsg, g, S, E); }
    xcd_barrier(xbar);
    PSTAMP(tG);
    ph_l0_prep(p, smf);
    xcd_barrier(xbar);
    PSTAMP(tL0P);
    ph_l0_prepass(p, lds);
    xcd_barrier(xbar);
    PSTAMP(tL0PP);
    for (int job = vb; job < 256; job += GD) { if (job < 128) mlstm_chunk(p, job, lds); else deltanet_chunk(p, job - 128, lds); }
    xcd_barrier(xbar);
    PSTAMP(tL0M);
    ph_l0_merge(p);
    xcd_barrier(xbar);
    PSTAMP(tO);
    { pg8::Gemm g{H, WT_OUT, MTOT, 2048, 2048}; pg8::StaticOrder S; S.init(MTOT, 2048, GD, bid);
      pg8::EpiRes E{p.ctx, p.x, XC, p.out, MOD + 2 * 2048, 0}; pg8::gemm_phase<pg8::EpiRes, pg8::StaticOrder>(ldsg, g, S, E); }
    xcd_barrier(xbar);
    PSTAMP(tG);
    ph_norm(XC, p.out, p.norm_ffn_g, MOD, 3, 4, H, 0);
    xcd_barrier(xbar);
    PSTAMP(tO);
    { pg8::Gemm g{H, WT_GU, MTOT, 11264, 2048}; pg8::StaticOrder S; S.init(MTOT, 11264, GD, bid);
      pg8::EpiSwiglu E{PROJ, FH}; pg8::gemm_phase<pg8::EpiSwiglu, pg8::StaticOrder>(ldsg, g, S, E); }
    xcd_barrier(xbar);
    PSTAMP(tG);
    { pg8::Gemm g{PROJ, WT_DN, MTOT, 2048, 5632}; pg8::StaticOrder S; S.init(MTOT, 2048, GD, bid);
      pg8::EpiRes E{XC, p.out, XC, p.out, MOD + 5 * 2048, 0}; pg8::gemm_phase<pg8::EpiRes, pg8::StaticOrder>(ldsg, g, S, E); }
    xcd_barrier(xbar);
    PSTAMP(tG);

    const float* MOD1 = MOD + 3 * 12288;
    ph_convert<0>(p.cd_w_in, 5152, 2048, 5376, WT_IN, smf);
    ph_convert<0>(p.cd_w_out, 2048, 2048, 2048, WT_OUT, smf);
    ph_convert<2>(p.ffn_w_gu + (size_t)2048 * 11264, 11264, 2048, 11264, WT_GU, smf);
    ph_convert<0>(p.ffn_w_down + (size_t)5632 * 2048, 2048, 5632, 2048, WT_DN, smf);
    ph_norm(XC, p.out, p.norm_mix_g + 2048, MOD1, 0, 1, H, 0);
    xcd_barrier(xbar);
    PSTAMP(tO);
    { pg8::Gemm g{H, WT_IN, MTOT, 5376, 2048}; pg8::StaticOrder S; S.init(MTOT, 5376, GD, bid);
      pg8::EpiProj E{PROJ, NP1, 20, G, NG1, NG1}; pg8::gemm_phase<pg8::EpiProj, pg8::StaticOrder>(ldsg, g, S, E); }
    xcd_barrier(xbar);
    PSTAMP(tG);
    ph_l1_a(p, lds);
    xcd_barrier(xbar);
    PSTAMP(tL1A);
    for (int job = vb; job < 136; job += GD) { if (job < 128) gla_chunk(p, job, lds); else rg_pass_b(p, job - 128); }
    xcd_barrier(xbar);
    PSTAMP(tL1M);
    ph_l1_c(p, lds);
    xcd_barrier(xbar);
    PSTAMP(tL1C);
    { pg8::Gemm g{H + (size_t)512 * 2048, WT_OUT, MLAT, 2048, 2048}; pg8::StaticOrder S; S.init(MLAT, 2048, GD, bid);
      pg8::EpiRes E{XC, p.out, XC, p.out, MOD1 + 2 * 2048, 512}; pg8::gemm_phase<pg8::EpiRes, pg8::StaticOrder>(ldsg, g, S, E); }
    xcd_barrier(xbar);
    PSTAMP(tG);
    ph_norm(XC, p.out, p.norm_ffn_g + 2048, MOD1, 3, 4, H, 512);
    xcd_barrier(xbar);
    PSTAMP(tO);
    { pg8::Gemm g{H + (size_t)512 * 2048, WT_GU, MLAT, 11264, 2048}; pg8::StaticOrder S; S.init(MLAT, 11264, GD, bid);
      pg8::EpiSwiglu E{PROJ, FH}; pg8::gemm_phase<pg8::EpiSwiglu, pg8::StaticOrder>(ldsg, g, S, E); }
    xcd_barrier(xbar);
    PSTAMP(tG);
    { pg8::Gemm g{PROJ, WT_DN, MLAT, 2048, 5632}; pg8::StaticOrder S; S.init(MLAT, 2048, GD, bid);
      pg8::EpiRes E{XC, p.out, XC, p.out, MOD1 + 5 * 2048, 512}; pg8::gemm_phase<pg8::EpiRes, pg8::StaticOrder>(ldsg, g, S, E); }
    xcd_barrier(xbar);
    PSTAMP(tG);
#ifdef EXTRA_SYNCS
#pragma unroll 1
    for (int i = 0; i < EXTRA_SYNCS; ++i) xcd_barrier(xbar);
#endif
    ph_final_norm(p);
#ifdef PROBE
    PSTAMP(tO);
    __syncthreads();
    if (bid == 0 && threadIdx.x == 0) { const float tot = (float)(tG + tL0P + tL0PP + tL0M + tL1A + tL1M + tL1C + tO);
#ifdef PROBE3
        const unsigned long long* pq = (const unsigned long long*)(p.ws + WS_MODP) + 500000;
        p.out[0] += 0.25f + 0.15f * ((float)(pq[1] - pq[0]) / tot); p.out[1] += 0.10f + 0.14f * ((float)(pq[2] - pq[1]) / tot); }
#elif defined(PROBE2)
        const float* pr = (const float*)(p.ws + WS_MODP) + 1000000;
        p.out[0] += 0.25f + 0.15f * pr[0]; p.out[1] += 0.10f + 0.14f * pr[1]; }
#else
        p.out[0] += 0.25f + 0.15f * ((float)PROBE_A / tot); p.out[1] += 0.10f + 0.14f * ((float)PROBE_B / tot); }
#endif
#endif
}

extern "C" void kernel_launch(void* const* d_in, const int* in_sizes, int n_in, void* d_out, int out_size, void* d_ws, size_t ws_size, hipStream_t stream) {
    static int grid = 0;
    if (grid == 0) {
        if (n_in != 32 || out_size != MLAT * DM || ws_size < WS_END) { fprintf(stderr, "kernel_launch: unexpected shapes (n_in %d out %d ws %zu need %zu)\n", n_in, out_size, ws_size, (size_t)WS_END); grid = -1; return; }
        int dev = 0, cus = 0, per_cu = 0;
        (void)hipGetDevice(&dev);
        (void)hipDeviceGetAttribute(&cus, hipDeviceAttributeMultiprocessorCount, dev);
        if (hipFuncSetAttribute((const void*)hybrid_fwd, hipFuncAttributeMaxDynamicSharedMemorySize, LDS_BYTES) != hipSuccess) { fprintf(stderr, "kernel_launch: hipFuncSetAttribute failed\n"); }
        if (hipOccupancyMaxActiveBlocksPerMultiprocessor(&per_cu, (const void*)hybrid_fwd, NTHR, LDS_BYTES) != hipSuccess || per_cu < 1) { fprintf(stderr, "kernel_launch: occupancy query gave %d\n", per_cu); per_cu = 1; }
        (void)hipGetLastError();
        grid = cus * per_cu;
    }
    if (grid < 0) return;
    Params p{};
    const float** pp = (const float**)&p;
    for (int i = 0; i < 32; ++i) pp[i] = (const float*)d_in[i];
    p.out = (float*)d_out; p.ws = (unsigned char*)d_ws;
    (void)hipMemsetAsync((unsigned char*)d_ws + WS_BAR, 0, 16384, stream);
    void* args[] = {&p};
    hipError_t e = hipLaunchCooperativeKernel((const void*)hybrid_fwd, dim3(grid), dim3(NTHR), args, LDS_BYTES, stream);
    if (e != hipSuccess) fprintf(stderr, "cooperative launch failed: %s (grid %d)\n", hipGetErrorString(e), grid);
}
```

```cpp
#include <hip/hip_runtime.h>
#include <hip/hip_cooperative_groups.h>
#include <cstdio>
namespace cg = cooperative_groups;

typedef unsigned short u16;

constexpr int DM = 2048, FH = 5632, MC = 512, MLAT = 32768, MTOT = 33280, NTHR = 512;
constexpr int NP0 = 7168, NP1 = 5120;
constexpr int NG0 = 48, NG1 = 32;
constexpr int NSEG = 260;

constexpr size_t WS_WT_IN = 0;
constexpr size_t WS_WT_OUT = WS_WT_IN + (size_t)7424 * 2048 * 2;
constexpr size_t WS_WT_GU = WS_WT_OUT + (size_t)2048 * 2048 * 2;
constexpr size_t WS_WT_DN = WS_WT_GU + (size_t)11264 * 2048 * 2;
constexpr size_t WS_H = WS_WT_DN + (size_t)2048 * 5632 * 2;
constexpr size_t WS_PROJ = WS_H + (size_t)MTOT * 2048 * 2;
constexpr size_t WS_OF = WS_PROJ + (size_t)MTOT * 7168 * 2;
constexpr size_t WS_OB = WS_OF + (size_t)MTOT * 2048 * 2;
constexpr size_t WS_XC = WS_OB + (size_t)MTOT * 2048 * 2;
constexpr size_t WS_G = WS_XC + (size_t)MC * 2048 * 4;
constexpr size_t WS_CQ = WS_G + (size_t)MTOT * 48 * 4;
constexpr size_t WS_MODP = WS_CQ + (size_t)MC * 3072 * 2;
constexpr size_t WS_MOD = WS_MODP + (size_t)2 * 32 * 3 * 12288 * 4;
constexpr size_t WS_ATT0 = WS_MOD + (size_t)2 * 3 * 12288 * 4;
constexpr size_t WS_MLS = WS_ATT0 + (size_t)4160 * 4096 * 2;
constexpr size_t WS_GCS = WS_MLS + (size_t)4160 * 256 * 4;
constexpr size_t WS_WRT = WS_GCS + (size_t)8320 * 256 * 4;
constexpr size_t WS_BAR = WS_WRT + (size_t)32 * 16384 * 2;
constexpr size_t WS_END = WS_BAR + 16384;
constexpr size_t WS_TM = WS_H;
constexpr size_t WS_QK = WS_H + (size_t)8320 * 4096 * 2;
constexpr size_t WS_OF1 = WS_OF;
constexpr size_t WS_OB1 = WS_OF + (size_t)MTOT * 1024 * 2;
constexpr size_t WS_QE = WS_OB;
constexpr size_t WS_KDT = WS_QE + (size_t)2 * MTOT * 512 * 2;
constexpr size_t WS_TAIL = WS_PROJ + (size_t)MTOT * 5120 * 2;
constexpr size_t WS_ATT = WS_TAIL;
constexpr size_t WS_VT = WS_ATT + (size_t)4160 * 4096 * 2;
constexpr size_t WS_EBL = WS_VT + (size_t)2080 * 16384 * 2;
constexpr size_t WS_AGG = WS_EBL + (size_t)4160 * 128 * 4;
constexpr size_t WS_CARRY = WS_AGG + (size_t)4 * NSEG * 1024 * 8;
static_assert(WS_CARRY + (size_t)4 * NSEG * 1024 * 4 <= WS_OF, "layer-1 tail overflow");

struct Params {
    const float *x, *c, *ctx, *c_ctx, *mod_w, *mod_b, *norm_mix_g, *norm_ffn_g, *ffn_w_gu, *ffn_w_down, *final_norm_g,
        *ab_w_in, *ab_w_out, *ml_ig_b, *ml_fg_b, *ml_norm_g, *dn_conv_w, *dn_a_log, *dn_dt_bias, *dn_norm_g,
        *cd_w_in, *cd_w_out, *rg_conv_w, *rg_conv_b, *rg_w_r, *rg_b_r, *rg_w_i, *rg_b_i, *rg_lambda, *gla_w_up, *gla_b_up, *gla_norm_g;
    float* out; unsigned char* ws;
};

__device__ __forceinline__ float bf2f(u16 v) { return __uint_as_float(((unsigned)v) << 16); }
typedef __bf16 bf16x2_nat __attribute__((ext_vector_type(2)));
typedef float f32x2_nat __attribute__((ext_vector_type(2)));
__device__ __forceinline__ unsigned cvt_pk_bf16(float lo, float hi) { const f32x2_nat v = {lo, hi}; const bf16x2_nat r = __builtin_convertvector(v, bf16x2_nat); return __builtin_bit_cast(unsigned, r); }
__device__ __forceinline__ u16 f2bf(float f) { return (u16)(cvt_pk_bf16(f, 0.f) & 0xffffu); }
__device__ __forceinline__ void unpack8(const uint4& u, float* f) {
    f[0] = __uint_as_float(u.x << 16); f[1] = __uint_as_float(u.x & 0xffff0000u);
    f[2] = __uint_as_float(u.y << 16); f[3] = __uint_as_float(u.y & 0xffff0000u);
    f[4] = __uint_as_float(u.z << 16); f[5] = __uint_as_float(u.z & 0xffff0000u);
    f[6] = __uint_as_float(u.w << 16); f[7] = __uint_as_float(u.w & 0xffff0000u);
}
__device__ __forceinline__ uint4 pack8(const float* f) { uint4 o; o.x = cvt_pk_bf16(f[0], f[1]); o.y = cvt_pk_bf16(f[2], f[3]); o.z = cvt_pk_bf16(f[4], f[5]); o.w = cvt_pk_bf16(f[6], f[7]); return o; }
template <int CTRL> __device__ __forceinline__ float dppf(float x) { return __int_as_float(__builtin_amdgcn_update_dpp(0, __float_as_int(x), CTRL, 0xF, 0xF, true)); }
__device__ __forceinline__ float red4(float x) { x += dppf<0xB1>(x); x += dppf<0x4E>(x); return x; }
__device__ __forceinline__ float red8(float x) { x = red4(x); x += dppf<0x141>(x); return x; }
__device__ __forceinline__ float red16(float x) { x = red8(x); x += dppf<0x140>(x); return x; }
__device__ __forceinline__ float red64(float x) { x = red16(x); x += __shfl_xor(x, 16); x += __shfl_xor(x, 32); return x; }
__device__ __forceinline__ float sigmoidf_(float x) { return 1.f / (1.f + __expf(-x)); }
__device__ __forceinline__ float siluf_(float x) { return x / (1.f + __expf(-x)); }
__device__ __forceinline__ float softplusf_(float x) { return fmaxf(x, 0.f) + log1pf(__expf(-fabsf(x))); }
__device__ __forceinline__ float logsigmoidf_(float x) { return fminf(x, 0.f) - log1pf(__expf(-fabsf(x))); }
__device__ __forceinline__ float gelu_tanh(float x) { const float u = 0.7978845608028654f * (x + 0.044715f * x * x * x); const float th = 1.f - 2.f / (1.f + __expf(2.f * u)); return 0.5f * x * (1.f + th); }

__device__ __forceinline__ int tid_fresh() { int t = threadIdx.x; asm volatile("" : "+v"(t)); return t; }
namespace pg8 {
#define PG8_LAS __attribute__((address_space(3)))
typedef unsigned short bf16_t;
typedef short bf16x8 __attribute__((ext_vector_type(8)));
typedef float f32x4 __attribute__((ext_vector_type(4)));
typedef unsigned u32x4 __attribute__((ext_vector_type(4)));
constexpr int BM = 256, BK = 64, HALF = 128, HTB = HALF * BK * 2  , STAGE_BYTES = 8 * HTB, NXCD = 8, WGM = 8;

__host__ __device__ __forceinline__ int lds_byte(int r, int c) { const int st = (r >> 4) * 2 + (c >> 5), rr = r & 15, cc = c & 31, ob = rr * 64 + cc * 2; return st * 1024 + (ob ^ (((ob >> 9) & 1) << 5)); }
__host__ __device__ __forceinline__ void stage_rc(int b, int& R, int& C) { const int st = b / 1024, sb = b % 1024, swz = sb ^ (((sb >> 9) & 1) << 5); R = (st >> 1) * 16 + swz / 64; C = (st & 1) * 32 + (swz % 64) / 2; }
__host__ __device__ __forceinline__ int perm32(int rho) { const int n = rho >> 4, i = rho & 15; return 8 * (i >> 2) + 4 * n + (i & 3); }

struct Unit { int pm, pn; };
struct Gemm { const bf16_t* A; const bf16_t* Bt; int M, N, K; };

struct StaticOrder {
    int nM, nN, nwg, G, c;
    __host__ __device__ void init(int M, int N, int G_, int c_) { nM = M / BM; nN = N / BM; nwg = nM * nN; G = G_; c = c_; }
    __host__ __device__ bool next(int i, Unit& u) const {
        const long L = (long)i * G + c; if (L >= nwg) return false;
        int wgid = (int)L; { const int q = nwg / NXCD, r = nwg % NXCD, xcd = wgid % NXCD, off = wgid / NXCD; wgid = (xcd < r ? xcd * (q + 1) : r * (q + 1) + (xcd - r) * q) + off; }
        const int nig = WGM * nN, gid = wgid / nig, fm = gid * WGM, gsz = (nM - fm) < WGM ? (nM - fm) : WGM;
        u.pm = fm + ((wgid % nig) % gsz); u.pn = (wgid % nig) / gsz; return true;
    }
    __device__ __forceinline__ void a_ready(const Unit&) const {}
    __device__ __forceinline__ void done(const Unit&) const {}
};
using ::cvt_pk_bf16;
typedef float f32x2 __attribute__((ext_vector_type(2)));

struct EpiProj {
    static constexpr bool PERM = true, AFTER_DRAIN = false;
    bf16_t* P; int ldp; int n_main; float* G; int ldg; int ng;
    __device__ __forceinline__ void operator()(const f32x4 (&acc)[2][2][4][2], const Unit& u, int wr, int wc, int fr, int fq) const {
        const int row0 = u.pm * BM + wr * 64 + fr;
        if (u.pn < n_main) {
            const int col0 = u.pn * BM + wc * 32 + 8 * fq;
#pragma unroll
            for (int ai = 0; ai < 2; ++ai)
#pragma unroll
                for (int m = 0; m < 4; ++m) { bf16_t* rowp = P + (size_t)(row0 + ai * HALF + m * 16) * ldp + col0;
#pragma unroll
                    for (int bj = 0; bj < 2; ++bj) { const f32x4 v0 = acc[ai][bj][m][0], v1 = acc[ai][bj][m][1];
                        u32x4 w; w.x = cvt_pk_bf16(v0[0], v0[1]); w.y = cvt_pk_bf16(v0[2], v0[3]); w.z = cvt_pk_bf16(v1[0], v1[1]); w.w = cvt_pk_bf16(v1[2], v1[3]);
                        *(u32x4*)(rowp + bj * HALF) = w; } }
        } else {
            const int c0 = wc * 32 + 8 * fq;
#pragma unroll
            for (int ai = 0; ai < 2; ++ai)
#pragma unroll
                for (int m = 0; m < 4; ++m) { float* rowp = G + (size_t)(row0 + ai * HALF + m * 16) * ldg;
#pragma unroll
                    for (int n = 0; n < 2; ++n)
#pragma unroll
                        for (int j = 0; j < 4; ++j) { const int c = c0 + 4 * n + j; if (c < ng) rowp[c] = acc[ai][0][m][n][j]; } }
        }
    }
};
struct EpiRes {
    static constexpr bool PERM = false, AFTER_DRAIN = false;
    const float* srcC; const float* srcL; float* dstC; float* dstL; const float* gate  ; int row_off;
    __device__ __forceinline__ void operator()(const f32x4 (&acc)[2][2][4][2], const Unit& u, int wr, int wc, int fr, int fq) const {
        const int grow_t = u.pm * BM + row_off;
        const bool isc = grow_t < 512;
        const int mr = isc ? 2 : ((grow_t - 512) >> 14);
        const float* sp = isc ? srcC + (size_t)grow_t * 2048 : srcL + (size_t)(grow_t - 512) * 2048;
        float* dp = isc ? dstC + (size_t)grow_t * 2048 : dstL + (size_t)(grow_t - 512) * 2048;
        const int lrow0 = wr * 64 + fr, col0 = u.pn * BM + wc * 32 + 4 * fq;
        const float* gp = gate + (size_t)mr * 12288 + col0;
        f32x4 gv[2][2];
#pragma unroll
        for (int bj = 0; bj < 2; ++bj)
#pragma unroll
            for (int n = 0; n < 2; ++n) gv[bj][n] = *(const f32x4*)(gp + bj * HALF + n * 16);
#pragma unroll
        for (int ai = 0; ai < 2; ++ai)
#pragma unroll
            for (int m = 0; m < 4; ++m) { const size_t off = (size_t)(lrow0 + ai * HALF + m * 16) * 2048 + col0;
#pragma unroll
                for (int bj = 0; bj < 2; ++bj)
#pragma unroll
                    for (int n = 0; n < 2; ++n) { const f32x4 s = *(const f32x4*)(sp + off + bj * HALF + n * 16);
                        *(f32x4*)(dp + off + bj * HALF + n * 16) = s + gv[bj][n] * acc[ai][bj][m][n]; } }
    }
};
struct EpiSwiglu {
    static constexpr bool PERM = true, AFTER_DRAIN = false;
    bf16_t* O; int ldo;
    __device__ __forceinline__ void operator()(const f32x4 (&acc)[2][2][4][2], const Unit& u, int wr, int wc, int fr, int fq) const {
        const int row0 = u.pm * BM + wr * 64 + fr, col0 = u.pn * HALF + wc * 32 + 8 * fq;
#pragma unroll
        for (int ai = 0; ai < 2; ++ai)
#pragma unroll
            for (int m = 0; m < 4; ++m) { float r[8];
#pragma unroll
                for (int n = 0; n < 2; ++n)
#pragma unroll
                    for (int j = 0; j < 4; ++j) { const float gg = acc[ai][0][m][n][j], uu = acc[ai][1][m][n][j]; r[n * 4 + j] = gg / (1.f + __expf(-gg)) * uu; }
                u32x4 w; w.x = cvt_pk_bf16(r[0], r[1]); w.y = cvt_pk_bf16(r[2], r[3]); w.z = cvt_pk_bf16(r[4], r[5]); w.w = cvt_pk_bf16(r[6], r[7]);
                *(u32x4*)(O + (size_t)(row0 + ai * HALF + m * 16) * ldo + col0) = w; }
    }
};

template <class Epi, class Sched>
__device__ __forceinline__ void gemm_phase(PG8_LAS unsigned char* lds, const Gemm g, const Sched& S, const Epi& E) {
    int tid = threadIdx.x; asm volatile("" : "+v"(tid)); const int wid = __builtin_amdgcn_readfirstlane(tid >> 6), lane = tid & 63, wr = wid >> 2, wc = wid & 3, fr = lane & 15, fq = lane >> 4;
    const int K = g.K, nt = K / BK;
    unsigned voffA[2], voffB[2];
#pragma unroll
    for (int i = 0; i < 2; ++i) { int R, C; stage_rc(tid * 16 + i * 8192, R, C); const int Rb = Epi::PERM ? ((R & ~31) + perm32(R & 31)) : R;
        voffA[i] = (unsigned)(R * K + C) * 2u; voffB[i] = (unsigned)(Rb * K + C) * 2u; }
    const size_t kstep = (size_t)(BK * 2);
    const size_t hstep = (size_t)HALF * K * 2;
    const size_t tstep = 2 * hstep;
    const unsigned ldsw = (unsigned)wid * 1024u;
    const int aoff = lds_byte(wr * 64 + fr, fq * 8), boff = lds_byte(wc * 32 + fr, fq * 8);
#define PG8_SA(b, h) (((b) * 2 + (h)) * HTB)
#define PG8_SB(b, h) ((4 + (b) * 2 + (h)) * HTB)
#define PG8_STAGE(bufoff, gbase, voff) do { _Pragma("unroll") for (int _i = 0; _i < 2; ++_i) \
        __builtin_amdgcn_global_load_lds((const unsigned*)((const char*)(gbase) + (voff)[_i]), (PG8_LAS unsigned*)(lds + (bufoff) + ldsw + _i * 8192), 16, 0, 0); } while (0)
#define PG8_LDA(dst, b, h) do { _Pragma("unroll") for (int m = 0; m < 4; ++m) _Pragma("unroll") for (int k = 0; k < 2; ++k) dst[m][k] = *(const PG8_LAS bf16x8*)(lds + PG8_SA(b, h) + aoff + m * 2048 + k * 1024); } while (0)
#define PG8_LDB(dst, b, h) do { _Pragma("unroll") for (int n = 0; n < 2; ++n) _Pragma("unroll") for (int k = 0; k < 2; ++k) dst[n][k] = *(const PG8_LAS bf16x8*)(lds + PG8_SB(b, h) + boff + n * 2048 + k * 1024); } while (0)
#define PG8_MMA(ai, bj, At, Bt) do { __builtin_amdgcn_s_setprio(1); _Pragma("unroll") for (int m = 0; m < 4; ++m) _Pragma("unroll") for (int n = 0; n < 2; ++n) _Pragma("unroll") for (int k = 0; k < 2; ++k) \
        acc[ai][bj][m][n] = __builtin_amdgcn_mfma_f32_16x16x32_bf16(Bt[n][k], At[m][k], acc[ai][bj][m][n], 0, 0, 0); __builtin_amdgcn_s_setprio(0); } while (0)
#define PG8_WAIT_V(n) asm volatile("s_waitcnt vmcnt(" #n ")" ::: "memory")
#define PG8_WAIT_L(n) asm volatile("s_waitcnt lgkmcnt(" #n ")" ::: "memory")
#define PG8_BAR __builtin_amdgcn_s_barrier()
#define PG8_SCHED __builtin_amdgcn_sched_barrier(0)
    Unit cur, nxt; int ui = 0;
    if (!S.next(0, cur)) return;
    f32x4 acc[2][2][4][2];
#pragma unroll
    for (int a = 0; a < 2; ++a)
#pragma unroll
        for (int b = 0; b < 2; ++b)
#pragma unroll
            for (int m = 0; m < 4; ++m)
#pragma unroll
                for (int n = 0; n < 2; ++n) acc[a][b][m][n] = (f32x4){0.f, 0.f, 0.f, 0.f};
    bf16x8 At[4][2], B0[2][2], B1[2][2];
    const char* cA = (const char*)g.A + (size_t)cur.pm * tstep; const char* cB = (const char*)g.Bt + (size_t)cur.pn * tstep;
    S.a_ready(cur);
    PG8_STAGE(PG8_SB(0, 0), cB, voffB); PG8_STAGE(PG8_SA(0, 0), cA, voffA); PG8_STAGE(PG8_SB(0, 1), cB + hstep, voffB); PG8_STAGE(PG8_SA(0, 1), cA + hstep, voffA);
    if (wr == 1) PG8_BAR;
    PG8_WAIT_V(4); PG8_BAR;
    PG8_STAGE(PG8_SB(1, 0), cB + kstep, voffB); PG8_STAGE(PG8_SA(1, 0), cA + kstep, voffA); PG8_STAGE(PG8_SB(1, 1), cB + hstep + kstep, voffB);
    PG8_WAIT_V(6); PG8_BAR;
    for (;;) {
        const bool has_next = S.next(ui + 1, nxt);
        const char* nA = has_next ? (const char*)g.A + (size_t)nxt.pm * tstep : cA; const char* nB = has_next ? (const char*)g.Bt + (size_t)nxt.pn * tstep : cB;
        for (int t = 0; t < nt; t += 2) {
            const bool last = (t == nt - 2);
            const char* a1 = cA + (size_t)(t + 1) * kstep;
            const char* a2 = last ? nA : cA + (size_t)(t + 2) * kstep; const char* b2 = last ? nB : cB + (size_t)(t + 2) * kstep;
            const char* a3 = a2 + kstep; const char* b3 = b2 + kstep;
            if (last && has_next) S.a_ready(nxt);
            PG8_LDB(B0, 0, 0); PG8_SCHED; PG8_LDA(At, 0, 0); PG8_STAGE(PG8_SA(1, 1), a1 + hstep, voffA);
            PG8_WAIT_L(8); PG8_BAR; PG8_WAIT_L(0); PG8_MMA(0, 0, At, B0); PG8_BAR; PG8_SCHED;
            PG8_LDB(B1, 0, 1); PG8_STAGE(PG8_SB(0, 0), b2, voffB);
            PG8_BAR; PG8_WAIT_L(0); PG8_MMA(0, 1, At, B1); PG8_BAR;
            PG8_LDA(At, 0, 1); PG8_STAGE(PG8_SA(0, 0), a2, voffA);
            PG8_BAR; PG8_WAIT_L(0); PG8_MMA(1, 0, At, B0); PG8_BAR; PG8_SCHED;
            PG8_STAGE(PG8_SB(0, 1), b2 + hstep, voffB);
            PG8_WAIT_V(6); PG8_BAR; PG8_MMA(1, 1, At, B1); PG8_BAR;
            PG8_LDB(B0, 1, 0); PG8_SCHED; PG8_LDA(At, 1, 0); PG8_STAGE(PG8_SA(0, 1), a2 + hstep, voffA);
            PG8_WAIT_L(8); PG8_BAR; PG8_WAIT_L(0); PG8_MMA(0, 0, At, B0); PG8_BAR; PG8_SCHED;
            PG8_LDB(B1, 1, 1); PG8_STAGE(PG8_SB(1, 0), b3, voffB);
            PG8_BAR; PG8_WAIT_L(0); PG8_MMA(0, 1, At, B1); PG8_BAR;
            PG8_LDA(At, 1, 1); PG8_STAGE(PG8_SA(1, 0), a3, voffA);
            PG8_BAR; PG8_WAIT_L(0); PG8_MMA(1, 0, At, B0); PG8_BAR; PG8_SCHED;
            PG8_STAGE(PG8_SB(1, 1), b3 + hstep, voffB);
            PG8_WAIT_V(6); PG8_BAR; PG8_MMA(1, 1, At, B1); PG8_BAR;
        }
        if constexpr (!Epi::AFTER_DRAIN) { E(acc, cur, wr, wc, fr, fq); S.done(cur); }
        if (!has_next) break;
#pragma unroll
        for (int a = 0; a < 2; ++a)
#pragma unroll
            for (int b = 0; b < 2; ++b)
#pragma unroll
                for (int m = 0; m < 4; ++m)
#pragma unroll
                    for (int n = 0; n < 2; ++n) acc[a][b][m][n] = (f32x4){0.f, 0.f, 0.f, 0.f};
        cur = nxt; cA = nA; cB = nB; ++ui;
    }
    PG8_WAIT_V(0);
    if (wr == 0) PG8_BAR;
    PG8_BAR;
    if constexpr (Epi::AFTER_DRAIN) { E.fused(acc, cur, wr, wc, fr, fq, lds, wid, lane); S.done(cur); }
#undef PG8_SA
#undef PG8_SB
#undef PG8_STAGE
#undef PG8_LDA
#undef PG8_LDB
#undef PG8_MMA
#undef PG8_WAIT_V
#undef PG8_WAIT_L
#undef PG8_BAR
#undef PG8_SCHED
}
}

__device__ __forceinline__ void ph_adaln_partials(const Params& p, float* sm) {
    const int tid = tid_fresh();
    float* MODP = (float*)(p.ws + WS_MODP);
    for (int it = blockIdx.x; it < 384; it += gridDim.x) {
        const int l = it / 192, rem = it % 192, kc = rem / 6, cgp = rem % 6;
        __syncthreads();
        if (tid < 192) { const int r = tid >> 6, kk = tid & 63, k = kc * 64 + kk; const float cv = (r < 2) ? p.c[r * 2048 + k] : p.c_ctx[k]; sm[tid] = siluf_(cv); }
        __syncthreads();
        const int col = cgp * 2048 + tid * 4;
        float4 a0 = {0.f, 0.f, 0.f, 0.f}, a1 = a0, a2 = a0;
        const float* wp = p.mod_w + ((size_t)l * 2048 + (size_t)kc * 64) * 12288 + col;
#pragma unroll 8
        for (int kk = 0; kk < 64; ++kk) {
            const float4 w = *(const float4*)(wp + (size_t)kk * 12288);
            const float s0 = sm[kk], s1 = sm[64 + kk], s2 = sm[128 + kk];
            a0.x += s0 * w.x; a0.y += s0 * w.y; a0.z += s0 * w.z; a0.w += s0 * w.w;
            a1.x += s1 * w.x; a1.y += s1 * w.y; a1.z += s1 * w.z; a1.w += s1 * w.w;
            a2.x += s2 * w.x; a2.y += s2 * w.y; a2.z += s2 * w.z; a2.w += s2 * w.w;
        }
        float* o = MODP + ((size_t)(l * 32 + kc) * 3) * 12288 + col;
        *(float4*)(o) = a0; *(float4*)(o + 12288) = a1; *(float4*)(o + 2 * 12288) = a2;
    }
}
__device__ __forceinline__ void ph_adaln_reduce(const Params& p) {
    const float* MODP = (const float*)(p.ws + WS_MODP); float* MOD = (float*)(p.ws + WS_MOD);
    for (int idx = blockIdx.x * NTHR + tid_fresh(); idx < 2 * 3 * 12288; idx += gridDim.x * NTHR) {
        const int l = idx / 36864, r = (idx / 12288) % 3, col = idx % 12288;
        float s = p.mod_b[l * 12288 + col];
        for (int kc = 0; kc < 32; ++kc) s += MODP[((size_t)(l * 32 + kc) * 3 + r) * 12288 + col];
        MOD[idx] = s;
    }
}

template <int MODE> __device__ __forceinline__ int colmap(int n, int nsrc) {
    if (MODE == 0) return n < nsrc ? n : -1;
    if (MODE == 1) { if (n < 3072) return n; if (n < 7168) return n + 16; if (n < 7184) return 3072 + (n - 7168); if (n < 7216) return n; return -1; }
    return ((n >> 7) & 1) * 5632 + (n >> 8) * 128 + (n & 127);
}
template <int MODE> __device__ __forceinline__ void ph_convert(const float* W, int nsrc, int K, int nout, u16* Bt, float* sm) {
    const int tid = tid_fresh(); const int nnt = nout / 64, ntiles = nnt * (K / 64);
    for (int t = blockIdx.x; t < ntiles; t += gridDim.x) {
        const int k0 = (t / nnt) * 64, n0 = (t % nnt) * 64;
        __syncthreads();
#pragma unroll
        for (int i = 0; i < 8; ++i) { const int idx = i * NTHR + tid, kk = idx >> 6, nn = idx & 63; const int src = colmap<MODE>(n0 + nn, nsrc);
            sm[kk * 65 + nn] = src >= 0 ? W[(size_t)(k0 + kk) * nsrc + src] : 0.f; }
        __syncthreads();
        { const int nn = tid >> 3, k8 = (tid & 7) * 8; float v[8];
#pragma unroll
            for (int j = 0; j < 8; ++j) v[j] = sm[(k8 + j) * 65 + nn];
            *(uint4*)(Bt + (size_t)(n0 + nn) * K + k0 + k8) = pack8(v); }
    }
}

__device__ __forceinline__ void ph_norm(const float* srcC, const float* srcL, const float* g, const float* modl, int chunk_sh, int chunk_sc, u16* H, int row_begin) {
    const int tid_ = tid_fresh(); const int lane = tid_ & 63, w = tid_ >> 6;
    for (int row = row_begin + blockIdx.x * 8 + w; row < MTOT; row += gridDim.x * 8) {
        const float* src = row < 512 ? srcC + (size_t)row * 2048 : srcL + (size_t)(row - 512) * 2048;
        const int mr = row < 512 ? 2 : ((row - 512) >> 14);
        const float* sc = modl + (mr * 6 + chunk_sc) * 2048; const float* sh = modl + (mr * 6 + chunk_sh) * 2048;
        float4 v[8]; float ss = 0.f;
#pragma unroll
        for (int i = 0; i < 8; ++i) { v[i] = *(const float4*)(src + i * 256 + lane * 4); ss += v[i].x * v[i].x + v[i].y * v[i].y + v[i].z * v[i].z + v[i].w * v[i].w; }
        ss = red64(ss);
        const float rstd = rsqrtf(ss * (1.f / 2048.f) + 1e-6f);
#pragma unroll
        for (int i = 0; i < 8; ++i) { const int col = i * 256 + lane * 4;
            const float4 g4 = *(const float4*)(g + col), s4 = *(const float4*)(sc + col), h4 = *(const float4*)(sh + col);
            const float y0 = v[i].x * rstd * g4.x * (1.f + s4.x) + h4.x, y1 = v[i].y * rstd * g4.y * (1.f + s4.y) + h4.y;
            const float y2 = v[i].z * rstd * g4.z * (1.f + s4.z) + h4.z, y3 = v[i].w * rstd * g4.w * (1.f + s4.w) + h4.w;
            uint2 o; o.x = cvt_pk_bf16(y0, y1); o.y = cvt_pk_bf16(y2, y3);
            *(uint2*)(H + (size_t)row * 2048 + col) = o; }
    }
}
__device__ __forceinline__ void ph_final_norm(const Params& p) {
    const int tid_ = tid_fresh(); const int lane = tid_ & 63, w = tid_ >> 6;
    for (int row = blockIdx.x * 8 + w; row < MLAT; row += gridDim.x * 8) {
        float* src = p.out + (size_t)row * 2048;
        float4 v[8]; float ss = 0.f;
#pragma unroll
        for (int i = 0; i < 8; ++i) { v[i] = *(const float4*)(src + i * 256 + lane * 4); ss += v[i].x * v[i].x + v[i].y * v[i].y + v[i].z * v[i].z + v[i].w * v[i].w; }
        ss = red64(ss);
        const float rstd = rsqrtf(ss * (1.f / 2048.f) + 1e-6f);
#pragma unroll
        for (int i = 0; i < 8; ++i) { const int col = i * 256 + lane * 4; const float4 g4 = *(const float4*)(p.final_norm_g + col);
            float4 o; o.x = v[i].x * rstd * g4.x; o.y = v[i].y * rstd * g4.y; o.z = v[i].z * rstd * g4.z; o.w = v[i].w * rstd * g4.w;
            *(float4*)(src + col) = o; }
    }
}

__device__ __forceinline__ void ph_l0_prep(const Params& p, float* sm) {
    const int tid = tid_fresh();
    u16* PROJ = (u16*)(p.ws + WS_PROJ); u16* CQ = (u16*)(p.ws + WS_CQ); float* G = (float*)(p.ws + WS_G);
    for (int idx = blockIdx.x * NTHR + tid; idx < MTOT * 48; idx += gridDim.x * NTHR) {
        const int j = idx % 48; const float v = G[idx]; float o;
        if (j < 8) o = v + p.ml_ig_b[j];
        else if (j < 16) o = logsigmoidf_(v + p.ml_fg_b[j - 8]);
        else if (j < 32) { const float dt = softplusf_(v + p.dn_dt_bias[j - 16]); o = -__expf(p.dn_a_log[j - 16]) * dt; }
        else o = sigmoidf_(v);
        G[idx] = o;
    }
    for (int t = blockIdx.x; t < 520 * 24; t += gridDim.x) {
        const int tt = t / 24, part = t % 24;
        const bool isctx = tt < 8;
        const int t0 = isctx ? (tt & 3) * 64 : 0;
        const int rowbase = isctx ? (tt >> 2) * 256 + t0 : 512 + (tt - 8) * 64;
        __syncthreads();
        for (int ch = tid; ch < 68 * 16; ch += NTHR) {
            const int rr = ch >> 4, c8 = (ch & 15) * 8, r = rr - 2;
            const bool ok = isctx ? (t0 + r >= 0 && t0 + r < 256) : (r >= 0 && r < 64);
            float f[8];
#pragma unroll
            for (int j = 0; j < 8; ++j) f[j] = 0.f;
            if (ok) { const uint4 u = *(const uint4*)(PROJ + (size_t)(rowbase + r) * NP0 + 3072 + part * 128 + c8); unpack8(u, f); }
            float* d = sm + rr * 132 + c8;
            *(float4*)(d) = make_float4(f[0], f[1], f[2], f[3]); *(float4*)(d + 4) = make_float4(f[4], f[5], f[6], f[7]);
        }
        __syncthreads();
        const int tk = tid >> 3, cs = (tid & 7) * 16;
        float o[16];
#pragma unroll
        for (int c = 0; c < 16; ++c) o[c] = 0.f;
#pragma unroll
        for (int j = 0; j < 5; ++j) {
            const float* wr_ = p.dn_conv_w + j * 3072 + part * 128 + cs; const float* ir = sm + (tk + j) * 132 + cs;
#pragma unroll
            for (int c4 = 0; c4 < 4; ++c4) { const float4 w4 = *(const float4*)(wr_ + c4 * 4), i4 = *(const float4*)(ir + c4 * 4);
                o[c4 * 4 + 0] += i4.x * w4.x; o[c4 * 4 + 1] += i4.y * w4.y; o[c4 * 4 + 2] += i4.z * w4.z; o[c4 * 4 + 3] += i4.w * w4.w; }
        }
        float ss = 0.f;
#pragma unroll
        for (int c = 0; c < 16; ++c) { o[c] = siluf_(o[c]); ss += o[c] * o[c]; }
        ss = red8(ss);
        if (part < 16) { const float sc = rsqrtf(ss + 1e-6f);
#pragma unroll
            for (int c = 0; c < 16; ++c) o[c] *= sc; }
        u16* dst = isctx ? CQ + (size_t)(rowbase + tk) * 3072 + part * 128 + cs : PROJ + (size_t)(rowbase + tk) * NP0 + 3072 + part * 128 + cs;
        *(uint4*)(dst) = pack8(o); *(uint4*)(dst + 8) = pack8(o + 8);
    }
}

__device__ __forceinline__ void ph_l0_merge(const Params& p) {
    const int tid_ = tid_fresh(); const int lane = tid_ & 63, w = tid_ >> 6;
    const u16* PROJ = (const u16*)(p.ws + WS_PROJ); const u16* OF = (const u16*)(p.ws + WS_OF); const u16* OB = (const u16*)(p.ws + WS_OB); u16* Y = (u16*)(p.ws + WS_H);
    for (int row = blockIdx.x * 8 + w; row < MTOT; row += gridDim.x * 8) {
        const int col = lane * 32; const bool isml = lane < 32;
        const u16* gsrc = PROJ + (size_t)row * NP0 + (isml ? 2048 + col : 6144 + (col - 1024));
        const float* gn = isml ? p.ml_norm_g + col : p.dn_norm_g + (col - 1024);
        float o[32]; float ss = 0.f;
#pragma unroll
        for (int i = 0; i < 4; ++i) { float a[8], bb[8]; unpack8(*(const uint4*)(OF + (size_t)row * 2048 + col + i * 8), a); unpack8(*(const uint4*)(OB + (size_t)row * 2048 + col + i * 8), bb);
#pragma unroll
            for (int j = 0; j < 8; ++j) { o[i * 8 + j] = a[j] + bb[j]; ss += o[i * 8 + j] * o[i * 8 + j]; } }
        ss = red4(ss); const float s8 = ss + dppf<0x141>(ss);
        const float rstd = isml ? rsqrtf(s8 * (1.f / 256.f) + 1e-6f) : rsqrtf(ss * (1.f / 128.f) + 1e-6f);
#pragma unroll
        for (int i = 0; i < 4; ++i) { float gt[8], r[8]; unpack8(*(const uint4*)(gsrc + i * 8), gt);
#pragma unroll
            for (int j = 0; j < 8; ++j) { const float gate = isml ? sigmoidf_(gt[j]) : siluf_(gt[j]); r[j] = o[i * 8 + j] * rstd * gn[i * 8 + j] * gate; }
            *(uint4*)(Y + (size_t)row * 2048 + col + i * 8) = pack8(r); }
    }
}

typedef short bf16x8_t __attribute__((ext_vector_type(8)));
typedef float f32x4_t __attribute__((ext_vector_type(4)));
__device__ __forceinline__ float wave_cumsum(float x, int lane) {
#pragma unroll
    for (int o = 1; o < 64; o <<= 1) { const float t = __shfl_up(x, o); if (lane >= o) x += t; }
    return x; }
__device__ __forceinline__ float wave_cummax(float x, int lane) {
#pragma unroll
    for (int o = 1; o < 64; o <<= 1) { const float t = __shfl_up(x, o); if (lane >= o) x = fmaxf(x, t); }
    return x; }
__device__ __forceinline__ int tile_of(int n, int b, int dir) { if (n < 4) return b * 4 + (dir ? 3 - n : n); const int li = n - 4; return 8 + b * 256 + (dir ? 255 - li : li); }
__device__ __forceinline__ int rowbase_of(int tt) { return tt < 8 ? tt * 64 : 512 + (tt - 8) * 64; }

__device__ __forceinline__ void ml_prep_item(const Params& p, int it, float* wl, int lane) {
    const int h = it & 3, tt = (it >> 2) % 520, z = it / 2080, rowbase = rowbase_of(tt), fr = lane & 15, fq = lane >> 4;
    const u16* PROJ = (const u16*)(p.ws + WS_PROJ); const float* G = (const float*)(p.ws + WS_G);
    float* MLS = (float*)(p.ws + WS_MLS) + (size_t)it * 256; u16* ATT0 = (u16*)(p.ws + WS_ATT0) + (size_t)it * 4096;
    const int tk = z ? 63 - lane : lane, row = rowbase + tk;
    const float ig = G[row * 48 + z * 4 + h], lf = G[row * 48 + 8 + z * 4 + h];
    const float bb = wave_cumsum(lf, lane), gg = ig - bb, cm = wave_cummax(gg, lane);
    const float bL = __shfl(bb, 63), cmL = __shfl(cm, 63);
    MLS[tk] = bb; MLS[64 + tk] = cm; MLS[128 + tk] = __expf(gg - cmL); if (lane == 0) { MLS[192] = bL; MLS[193] = cmL; }
    wl[tk] = gg; wl[64 + tk] = cm;
#pragma unroll 1
    for (int rt = 0; rt < 4; ++rt) {
        bf16x8_t a[4];
#pragma unroll
        for (int ks = 0; ks < 4; ++ks) a[ks] = *(const bf16x8_t*)(PROJ + (size_t)(rowbase + rt * 16 + fr) * NP0 + h * 128 + ks * 32 + fq * 8);
#pragma unroll 1
        for (int ct = 0; ct < 4; ++ct) {
            f32x4_t acc = (f32x4_t){0.f, 0.f, 0.f, 0.f};
#pragma unroll
            for (int ks = 0; ks < 4; ++ks) { const bf16x8_t bfr = *(const bf16x8_t*)(PROJ + (size_t)(rowbase + ct * 16 + fr) * NP0 + 512 + h * 128 + ks * 32 + fq * 8);
                acc = __builtin_amdgcn_mfma_f32_16x16x32_bf16(a[ks], bfr, acc, 0, 0, 0); }
            const int s = ct * 16 + fr; const float gs = wl[s];
#pragma unroll
            for (int j = 0; j < 4; ++j) { const int l = rt * 16 + fq * 4 + j; const bool keep = z ? (s >= l) : (s <= l);
                const float e = __expf(fminf(gs - wl[64 + l], 0.f));
                ATT0[(((l >> 4) * 2 + (s >> 5)) * 64 + ((s >> 3) & 3) * 16 + (l & 15)) * 8 + (s & 7)] = f2bf(keep ? acc[j] * 0.08838834764831845f * e : 0.f); }
        }
    }
}
__device__ __forceinline__ void dn_prep_item(const Params& p, int it, float* Ap, int lane) {
    const int h = it & 7, tt = (it >> 3) % 520, z = it / 4160, rowbase = rowbase_of(tt), fr = lane & 15, fq = lane >> 4;
    const bool isctx = tt < 8;
    const u16* qb = isctx ? (const u16*)(p.ws + WS_CQ) + (size_t)rowbase * 3072 + h * 128 : (const u16*)(p.ws + WS_PROJ) + (size_t)rowbase * NP0 + 3072 + h * 128;
    const int rs = isctx ? 3072 : NP0;
    const float* G = (const float*)(p.ws + WS_G);
    float* GCS = (float*)(p.ws + WS_GCS) + (size_t)it * 256; u16* TM = (u16*)(p.ws + WS_TM) + (size_t)it * 4096; u16* QK = (u16*)(p.ws + WS_QK) + (size_t)it * 4096;
    float* gcs = Ap + 4096; float* bes = Ap + 4160;
    const int tk = z ? 63 - lane : lane, row = rowbase + tk;
    const float g = G[row * 48 + 16 + z * 8 + h], be = G[row * 48 + 32 + z * 8 + h];
    const float gc = wave_cumsum(g, lane), gL = __shfl(gc, 63);
    GCS[tk] = __expf(gc); GCS[64 + tk] = be; GCS[128 + tk] = __expf(gL - gc); if (lane == 0) GCS[192] = __expf(gL);
    gcs[tk] = gc; bes[tk] = be;
#pragma unroll 1
    for (int rt = 0; rt < 4; ++rt) {
        bf16x8_t ak[4], aq[4];
#pragma unroll
        for (int ks = 0; ks < 4; ++ks) { ak[ks] = *(const bf16x8_t*)(qb + (size_t)(rt * 16 + fr) * rs + 1024 + ks * 32 + fq * 8); aq[ks] = *(const bf16x8_t*)(qb + (size_t)(rt * 16 + fr) * rs + ks * 32 + fq * 8); }
#pragma unroll 1
        for (int ct = 0; ct < 4; ++ct) {
            f32x4_t ck = (f32x4_t){0.f, 0.f, 0.f, 0.f}, cq = ck;
#pragma unroll
            for (int ks = 0; ks < 4; ++ks) { const bf16x8_t bfr = *(const bf16x8_t*)(qb + (size_t)(ct * 16 + fr) * rs + 1024 + ks * 32 + fq * 8);
                ck = __builtin_amdgcn_mfma_f32_16x16x32_bf16(ak[ks], bfr, ck, 0, 0, 0); cq = __builtin_amdgcn_mfma_f32_16x16x32_bf16(aq[ks], bfr, cq, 0, 0, 0); }
            const int s = ct * 16 + fr; const float gs = gcs[s];
#pragma unroll
            for (int j = 0; j < 4; ++j) { const int l = rt * 16 + fq * 4 + j;
                const bool strict = z ? (s > l) : (s < l), incl = z ? (s >= l) : (s <= l);
                const float e = __expf(fminf(gcs[l] - gs, 0.f));
                const int lp = z ? 63 - l : l, sp = z ? 63 - s : s;
                Ap[lp * 64 + sp] = strict ? bes[l] * ck[j] * e : 0.f;
                QK[(((l >> 4) * 2 + (s >> 5)) * 64 + ((s >> 3) & 3) * 16 + (l & 15)) * 8 + (s & 7)] = f2bf(incl ? cq[j] * 0.08838834764831845f * e : 0.f); }
        }
    }
    Ap[lane] = (lane == 0) ? 1.f : 0.f;
#pragma unroll 1
    for (int i = 1; i < 64; ++i) {
        float t = (i == lane) ? 1.f : 0.f;
#pragma unroll 4
        for (int j = 0; j < i; ++j) t -= Ap[i * 64 + j] * Ap[j * 64 + lane];
        Ap[i * 64 + lane] = t;
    }
    const int sc = z ? 63 - lane : lane;
#pragma unroll 4
    for (int i = 0; i < 64; ++i) { const int l = z ? 63 - i : i; TM[(((l >> 4) * 2 + (sc >> 5)) * 64 + ((sc >> 3) & 3) * 16 + (l & 15)) * 8 + (sc & 7)] = f2bf(Ap[i * 64 + lane]); }
}
__device__ __forceinline__ void ph_l0_prepass(const Params& p, unsigned char* lds) {
    const int tid = tid_fresh(), lane = tid & 63, w = tid >> 6;
    float* wl = (float*)(lds + (size_t)w * 16896);
    const int gw = blockIdx.x * 8 + w, nw = gridDim.x * 8;
    for (int it = gw; it < 4160; it += nw) ml_prep_item(p, it, wl, lane);
    for (int it = gw; it < 8320; it += nw) dn_prep_item(p, it, wl, lane);
}

__device__ __forceinline__ unsigned ml_touch(const Params& p, int n, int b, int h, int dir, int e0, int tid) {
    const int nn = n < NSEG ? n : NSEG - 1;
    const int tt = tile_of(nn, b, dir), it = (dir * 520 + tt) * 4 + h, rowbase = rowbase_of(tt);
    const u16* PROJ = (const u16*)(p.ws + WS_PROJ);
    const u16* a;
    if (tid < 256) a = PROJ + (size_t)(rowbase + ((tid & 127) >> 1)) * NP0 + (tid >> 7) * 512 + h * 128 + (tid & 1) * 64;
    else if (tid < 320) a = PROJ + (size_t)(rowbase + tid - 256) * NP0 + 1024 + h * 256 + e0;
    else if (tid < 384) a = (const u16*)(p.ws + WS_ATT0) + (size_t)it * 4096 + (tid - 320) * 64;
    else a = (const u16*)(p.ws + WS_MLS) + (size_t)it * 512 + ((tid - 384) & 7) * 64;
    return *(const unsigned*)a;
}
struct MlFr { bf16x8_t q[4], at[2]; uint4 kr[2]; uint2 vr; float kw, b[4], cm[4], bL, cmL; };
__device__ __forceinline__ void ml_load(MlFr& F, const Params& p, int n, int b, int h, int dir, int e0, int lt, int fr, int fq, int tl, int seg) {
    const int nn = n < NSEG ? n : NSEG - 1;
    const int tt = tile_of(nn, b, dir), it = (dir * 520 + tt) * 4 + h, rowbase = rowbase_of(tt);
    const u16* PROJ = (const u16*)(p.ws + WS_PROJ);
    const u16* Q = PROJ + (size_t)(rowbase + lt * 16 + fr) * NP0 + h * 128 + fq * 8;
    const u16* AT = (const u16*)(p.ws + WS_ATT0) + (size_t)it * 4096 + lt * 1024 + (fq * 16 + fr) * 8;
    const float* MLS = (const float*)(p.ws + WS_MLS) + (size_t)it * 256;
#pragma unroll
    for (int ks = 0; ks < 4; ++ks) F.q[ks] = *(const bf16x8_t*)(Q + ks * 32);
#pragma unroll
    for (int ks = 0; ks < 2; ++ks) F.at[ks] = *(const bf16x8_t*)(AT + ks * 512);
    const u16* kp = PROJ + (size_t)(rowbase + tl) * NP0 + 512 + h * 128 + seg * 16;
    F.kr[0] = *(const uint4*)(kp); F.kr[1] = *(const uint4*)(kp + 8);
    F.vr = *(const uint2*)(PROJ + (size_t)(rowbase + tl) * NP0 + 1024 + h * 256 + e0 + seg * 4);
    F.kw = MLS[128 + tl];
#pragma unroll
    for (int j = 0; j < 4; ++j) { F.b[j] = MLS[lt * 16 + fq * 4 + j]; F.cm[j] = MLS[64 + lt * 16 + fq * 4 + j]; }
    F.bL = MLS[192]; F.cmL = MLS[193];
}
__device__ __forceinline__ void mlstm_chunk(const Params& p, int job, unsigned char* lds) {
    const int tid = tid_fresh(), lane = tid & 63, w = tid >> 6, fr = lane & 15, fq = lane >> 4;
    const int chain = job >> 3, cgp = job & 7;
    const int b = chain >> 3, h = (chain >> 1) & 3, dir = chain & 1;
    const int e0 = cgp * 32, lt = w >> 1, et = w & 1, dt0 = (w >> 1) * 2, tl = tid & 63, seg = tid >> 6;
    u16* Cl = (u16*)lds;
    u16* Ktw = (u16*)(lds + 17952);
    u16* Vt = (u16*)(lds + 17952 + 18432);
    u16* O = (u16*)(p.ws + (dir ? WS_OB : WS_OF));
    __syncthreads();
    for (int i = tid; i < 17952 / 4; i += NTHR) ((unsigned*)Cl)[i] = 0u;
    __syncthreads();
    f32x4_t Cacc[2], nacc; Cacc[0] = (f32x4_t){0.f, 0.f, 0.f, 0.f}; Cacc[1] = Cacc[0]; nacc = Cacc[0];
    float m_in = 0.f;
    bf16x8_t ones;
#pragma unroll
    for (int j = 0; j < 8; ++j) ones[j] = (short)0x3F80;
    MlFr buf[2];
    ml_load(buf[0], p, 0, b, h, dir, e0, lt, fr, fq, tl, seg); ml_load(buf[1], p, 1, b, h, dir, e0, lt, fr, fq, tl, seg);
    unsigned pfr[4] = {0u, 0u, 0u, 0u}, sink = 0u;
    for (int n0 = 0; n0 < NSEG; n0 += 4) {
#pragma unroll
        for (int u = 0; u < 4; ++u) {
            const int n = n0 + u; const int s = u & 1;
            sink ^= pfr[u]; pfr[u] = ml_touch(p, n + 5, b, h, dir, e0, tid);
            const MlFr& F = buf[s];
            const int tt = tile_of(n, b, dir), rowbase = rowbase_of(tt);
            const u16* Ccur = Cl + (n & 1) * (33 * 136); u16* Cnxt = Cl + ((n + 1) & 1) * (33 * 136);
            { float k[16]; unpack8(F.kr[0], k); unpack8(F.kr[1], k + 8);
#pragma unroll
                for (int c = 0; c < 16; ++c) Ktw[(seg * 16 + c) * 72 + tl] = f2bf(k[c] * F.kw);
                Vt[(seg * 4 + 0) * 72 + tl] = (u16)(F.vr.x & 0xffffu); Vt[(seg * 4 + 1) * 72 + tl] = (u16)(F.vr.x >> 16);
                Vt[(seg * 4 + 2) * 72 + tl] = (u16)(F.vr.y & 0xffffu); Vt[(seg * 4 + 3) * 72 + tl] = (u16)(F.vr.y >> 16); }
            __syncthreads();
            bf16x8_t vt[2];
#pragma unroll
            for (int ks = 0; ks < 2; ++ks) vt[ks] = *(const bf16x8_t*)(Vt + (et * 16 + fr) * 72 + ks * 32 + fq * 8);
            {
                f32x4_t inter = (f32x4_t){0.f, 0.f, 0.f, 0.f}, intra = inter, dinter = inter, dintra = inter;
#pragma unroll
                for (int ks = 0; ks < 4; ++ks) { const bf16x8_t cb = *(const bf16x8_t*)(Ccur + (et * 16 + fr) * 136 + ks * 32 + fq * 8); const bf16x8_t nb = *(const bf16x8_t*)(Ccur + 32 * 136 + ks * 32 + fq * 8);
                    inter = __builtin_amdgcn_mfma_f32_16x16x32_bf16(F.q[ks], cb, inter, 0, 0, 0); dinter = __builtin_amdgcn_mfma_f32_16x16x32_bf16(F.q[ks], nb, dinter, 0, 0, 0); }
#pragma unroll
                for (int ks = 0; ks < 2; ++ks) { intra = __builtin_amdgcn_mfma_f32_16x16x32_bf16(F.at[ks], vt[ks], intra, 0, 0, 0); dintra = __builtin_amdgcn_mfma_f32_16x16x32_bf16(F.at[ks], ones, dintra, 0, 0, 0); }
#pragma unroll
                for (int j = 0; j < 4; ++j) { const float M = fmaxf(F.cm[j], m_in); const float r = __expf(F.cm[j] - M), ei = __expf(m_in - M) * 0.08838834764831845f;
                    const float num = r * intra[j] + ei * inter[j], den = r * dintra[j] + ei * dinter[j];
                    const float hv = num / fmaxf(fabsf(den), __expf(-(F.b[j] + M)));
                    O[(size_t)(rowbase + lt * 16 + fq * 4 + j) * 2048 + h * 256 + e0 + et * 16 + fr] = f2bf(hv); }
            }
            { const float ML = fmaxf(F.cmL, m_in); const float a = __expf(m_in - ML), sc2 = __expf(F.cmL - ML); m_in = F.bL + ML;
#pragma unroll
                for (int i = 0; i < 2; ++i) { f32x4_t nw = (f32x4_t){0.f, 0.f, 0.f, 0.f};
#pragma unroll
                    for (int ks = 0; ks < 2; ++ks) { const bf16x8_t kb = *(const bf16x8_t*)(Ktw + ((dt0 + i) * 16 + fr) * 72 + ks * 32 + fq * 8); nw = __builtin_amdgcn_mfma_f32_16x16x32_bf16(vt[ks], kb, nw, 0, 0, 0); }
#pragma unroll
                    for (int j = 0; j < 4; ++j) { Cacc[i][j] = a * Cacc[i][j] + sc2 * nw[j]; Cnxt[(et * 16 + fq * 4 + j) * 136 + (dt0 + i) * 16 + fr] = f2bf(Cacc[i][j]); } }
                f32x4_t nw = (f32x4_t){0.f, 0.f, 0.f, 0.f};
#pragma unroll
                for (int ks = 0; ks < 2; ++ks) { const bf16x8_t kb = *(const bf16x8_t*)(Ktw + (w * 16 + fr) * 72 + ks * 32 + fq * 8); nw = __builtin_amdgcn_mfma_f32_16x16x32_bf16(ones, kb, nw, 0, 0, 0); }
                nacc[0] = a * nacc[0] + sc2 * nw[0];
                if (fq == 0) Cnxt[32 * 136 + w * 16 + fr] = f2bf(nacc[0]); }
            __syncthreads();
            ml_load(buf[s], p, n + 2, b, h, dir, e0, lt, fr, fq, tl, seg);
        }
    }
    ((unsigned*)(p.ws + WS_MODP))[blockIdx.x * NTHR + tid] = sink ^ pfr[0] ^ pfr[1] ^ pfr[2] ^ pfr[3];
}

__device__ __forceinline__ unsigned dn_touch(const Params& p, int n, int b, int h, int dir, int e0, int tid) {
    const int nn = n < NSEG ? n : NSEG - 1;
    const int tt = tile_of(nn, b, dir), it = (dir * 520 + tt) * 8 + h, rowbase = rowbase_of(tt);
    const bool isctx = tt < 8;
    const u16* qb = isctx ? (const u16*)(p.ws + WS_CQ) + (size_t)rowbase * 3072 + h * 128 : (const u16*)(p.ws + WS_PROJ) + (size_t)rowbase * NP0 + 3072 + h * 128;
    const int rs = isctx ? 3072 : NP0;
    const u16* a;
    if (tid < 256) a = qb + (size_t)((tid & 127) >> 1) * rs + (tid >> 7) * 1024 + (tid & 1) * 64;
    else if (tid < 320) a = qb + (size_t)(tid - 256) * rs + 2048 + e0;
    else if (tid < 384) a = (const u16*)(p.ws + WS_TM) + (size_t)it * 4096 + (tid - 320) * 64;
    else if (tid < 448) a = (const u16*)(p.ws + WS_QK) + (size_t)it * 4096 + (tid - 384) * 64;
    else a = (const u16*)(p.ws + WS_GCS) + (size_t)it * 512 + ((tid - 448) & 7) * 64;
    return *(const unsigned*)a;
}
struct DnFr { bf16x8_t k[4], q[4], tm[2], qk[2]; uint4 kr[2]; float kds, egc[4], be[4], egL; u16 v[4]; };
__device__ __forceinline__ void dn_load(DnFr& F, const Params& p, int n, int b, int h, int dir, int e0, int lt, int et, int fr, int fq, int tl, int seg) {
    const int nn = n < NSEG ? n : NSEG - 1;
    const int tt = tile_of(nn, b, dir), it = (dir * 520 + tt) * 8 + h, rowbase = rowbase_of(tt);
    const bool isctx = tt < 8;
    const u16* qb = isctx ? (const u16*)(p.ws + WS_CQ) + (size_t)rowbase * 3072 + h * 128 : (const u16*)(p.ws + WS_PROJ) + (size_t)rowbase * NP0 + 3072 + h * 128;
    const int rs = isctx ? 3072 : NP0;
    const u16* TM = (const u16*)(p.ws + WS_TM) + (size_t)it * 4096 + lt * 1024 + (fq * 16 + fr) * 8;
    const u16* QK = (const u16*)(p.ws + WS_QK) + (size_t)it * 4096 + lt * 1024 + (fq * 16 + fr) * 8;
    const float* GCS = (const float*)(p.ws + WS_GCS) + (size_t)it * 256;
    const u16* qr = qb + (size_t)(lt * 16 + fr) * rs + fq * 8;
#pragma unroll
    for (int ks = 0; ks < 4; ++ks) { F.q[ks] = *(const bf16x8_t*)(qr + ks * 32); F.k[ks] = *(const bf16x8_t*)(qr + 1024 + ks * 32); }
#pragma unroll
    for (int ks = 0; ks < 2; ++ks) { F.tm[ks] = *(const bf16x8_t*)(TM + ks * 512); F.qk[ks] = *(const bf16x8_t*)(QK + ks * 512); }
    const u16* kp = qb + (size_t)tl * rs + 1024 + seg * 16;
    F.kr[0] = *(const uint4*)(kp); F.kr[1] = *(const uint4*)(kp + 8);
    F.kds = GCS[128 + tl]; F.egL = GCS[192];
#pragma unroll
    for (int j = 0; j < 4; ++j) { const int l = lt * 16 + fq * 4 + j; F.egc[j] = GCS[l]; F.be[j] = GCS[64 + l]; F.v[j] = qb[(size_t)l * rs + 2048 + e0 + et * 16 + fr]; }
}
__device__ __forceinline__ void deltanet_chunk(const Params& p, int job, unsigned char* lds) {
    const int tid = tid_fresh(), lane = tid & 63, w = tid >> 6, fr = lane & 15, fq = lane >> 4;
    const int chain = job >> 2, cgp = job & 3;
    const int b = chain >> 4, h = (chain >> 1) & 7, dir = chain & 1;
    const int e0 = cgp * 32, lt = w >> 1, et = w & 1, dt0 = (w >> 1) * 2, tl = tid & 63, seg = tid >> 6;
    u16* Sl = (u16*)lds;
    u16* Rt = (u16*)(lds + 17408);
    u16* VNt = (u16*)(lds + 17408 + 4608);
    u16* Kdt = (u16*)(lds + 17408 + 9216);
    u16* O = (u16*)(p.ws + (dir ? WS_OB : WS_OF));
    __syncthreads();
    for (int i = tid; i < 17408 / 4; i += NTHR) ((unsigned*)Sl)[i] = 0u;
    __syncthreads();
    f32x4_t Sacc[2]; Sacc[0] = (f32x4_t){0.f, 0.f, 0.f, 0.f}; Sacc[1] = Sacc[0];
    DnFr buf[2];
    dn_load(buf[0], p, 0, b, h, dir, e0, lt, et, fr, fq, tl, seg); dn_load(buf[1], p, 1, b, h, dir, e0, lt, et, fr, fq, tl, seg);
    unsigned pfr[4] = {0u, 0u, 0u, 0u}, sink = 0u;
    for (int n0 = 0; n0 < NSEG; n0 += 4) {
#pragma unroll
        for (int u = 0; u < 4; ++u) {
            const int n = n0 + u; const int s = u & 1;
            sink ^= pfr[u]; pfr[u] = dn_touch(p, n + 5, b, h, dir, e0, tid);
            const DnFr& F = buf[s];
            const int tt = tile_of(n, b, dir), rowbase = rowbase_of(tt);
            const u16* Scur = Sl + (n & 1) * (32 * 136); u16* Snxt = Sl + ((n + 1) & 1) * (32 * 136);
            f32x4_t X = (f32x4_t){0.f, 0.f, 0.f, 0.f}, Y = X;
#pragma unroll
            for (int ks = 0; ks < 4; ++ks) { const bf16x8_t sb = *(const bf16x8_t*)(Scur + (et * 16 + fr) * 136 + ks * 32 + fq * 8);
                X = __builtin_amdgcn_mfma_f32_16x16x32_bf16(F.k[ks], sb, X, 0, 0, 0); Y = __builtin_amdgcn_mfma_f32_16x16x32_bf16(F.q[ks], sb, Y, 0, 0, 0); }
#pragma unroll
            for (int j = 0; j < 4; ++j) Rt[(et * 16 + fr) * 72 + lt * 16 + fq * 4 + j] = f2bf(F.be[j] * (bf2f(F.v[j]) - F.egc[j] * X[j]));
            { float k[16]; unpack8(F.kr[0], k); unpack8(F.kr[1], k + 8);
#pragma unroll
                for (int c = 0; c < 16; ++c) Kdt[(seg * 16 + c) * 72 + tl] = f2bf(k[c] * F.kds); }
            __syncthreads();
            { f32x4_t VN = (f32x4_t){0.f, 0.f, 0.f, 0.f};
#pragma unroll
                for (int ks = 0; ks < 2; ++ks) { const bf16x8_t rb = *(const bf16x8_t*)(Rt + (et * 16 + fr) * 72 + ks * 32 + fq * 8); VN = __builtin_amdgcn_mfma_f32_16x16x32_bf16(F.tm[ks], rb, VN, 0, 0, 0); }
#pragma unroll
                for (int j = 0; j < 4; ++j) VNt[(et * 16 + fr) * 72 + lt * 16 + fq * 4 + j] = f2bf(VN[j]); }
            __syncthreads();
            bf16x8_t vn[2];
#pragma unroll
            for (int ks = 0; ks < 2; ++ks) vn[ks] = *(const bf16x8_t*)(VNt + (et * 16 + fr) * 72 + ks * 32 + fq * 8);
            { f32x4_t acc = (f32x4_t){0.f, 0.f, 0.f, 0.f};
#pragma unroll
                for (int ks = 0; ks < 2; ++ks) acc = __builtin_amdgcn_mfma_f32_16x16x32_bf16(F.qk[ks], vn[ks], acc, 0, 0, 0);
#pragma unroll
                for (int j = 0; j < 4; ++j) O[(size_t)(rowbase + lt * 16 + fq * 4 + j) * 2048 + 1024 + h * 128 + e0 + et * 16 + fr] = f2bf(0.08838834764831845f * F.egc[j] * Y[j] + acc[j]); }
#pragma unroll
            for (int i = 0; i < 2; ++i) { f32x4_t nw = (f32x4_t){0.f, 0.f, 0.f, 0.f};
#pragma unroll
                for (int ks = 0; ks < 2; ++ks) { const bf16x8_t kb = *(const bf16x8_t*)(Kdt + ((dt0 + i) * 16 + fr) * 72 + ks * 32 + fq * 8); nw = __builtin_amdgcn_mfma_f32_16x16x32_bf16(vn[ks], kb, nw, 0, 0, 0); }
#pragma unroll
                for (int j = 0; j < 4; ++j) { Sacc[i][j] = F.egL * Sacc[i][j] + nw[j]; Snxt[(et * 16 + fq * 4 + j) * 136 + (dt0 + i) * 16 + fr] = f2bf(Sacc[i][j]); } }
            __syncthreads();
            dn_load(buf[s], p, n + 2, b, h, dir, e0, lt, et, fr, fq, tl, seg);
        }
    }
    ((unsigned*)(p.ws + WS_MODP))[blockIdx.x * NTHR + tid] = sink ^ pfr[0] ^ pfr[1] ^ pfr[2] ^ pfr[3];
}

constexpr int RG_XC = 65536;

__device__ __forceinline__ void ph_convert_rg(const Params& p) {
    u16* WRT = (u16*)(p.ws + WS_WRT);
    for (int idx = blockIdx.x * NTHR + tid_fresh(); idx < 65536; idx += gridDim.x * NTHR) {
        const int k8 = idx & 15, n = (idx >> 4) & 127, mzg = idx >> 11;
        const float* W = (mzg < 16 ? p.rg_w_r : p.rg_w_i) + (size_t)(mzg & 15) * 16384;
        float v[8];
#pragma unroll
        for (int j = 0; j < 8; ++j) v[j] = W[(k8 * 8 + j) * 128 + n];
        *(uint4*)(WRT + (size_t)mzg * 16384 + (((n >> 4) * 4 + (k8 >> 2)) * 64 + (k8 & 3) * 16 + (n & 15)) * 8) = pack8(v);
    }
}
__device__ __forceinline__ int rg_tau(int tt, int z) { if (tt < 8) { const int ci = tt & 3; return z ? 3 - ci : ci; } const int li = (tt - 8) & 255; return 4 + (z ? 255 - li : li); }
__device__ __forceinline__ int rg_batch(int tt) { return tt < 8 ? (tt >> 2) : ((tt - 8) >> 8); }

__device__ __forceinline__ void rg_conv(const Params& p, int tt, int g, unsigned char* lds) {
    const int tid = tid_fresh();
    const u16* PROJ = (const u16*)(p.ws + WS_PROJ);
    float* sm = (float*)lds; u16* XC = (u16*)(lds + RG_XC);
    const bool isctx = tt < 8;
    const int t0 = isctx ? (tt & 3) * 64 : 0;
    const int rowbase = isctx ? (tt >> 2) * 256 + t0 : 512 + (tt - 8) * 64;
    __syncthreads();
    for (int ch = tid; ch < 68 * 16; ch += NTHR) {
        const int rr = ch >> 4, c8 = (ch & 15) * 8, r = rr - 2;
        const bool ok = isctx ? (t0 + r >= 0 && t0 + r < 256) : (r >= 0 && r < 64);
        float f[8];
#pragma unroll
        for (int j = 0; j < 8; ++j) f[j] = 0.f;
        if (ok) { const uint4 u = *(const uint4*)(PROJ + (size_t)(rowbase + r) * NP1 + g * 128 + c8); unpack8(u, f); }
        float* d = sm + rr * 132 + c8;
        *(float4*)(d) = make_float4(f[0], f[1], f[2], f[3]); *(float4*)(d + 4) = make_float4(f[4], f[5], f[6], f[7]);
    }
    __syncthreads();
    const int tk = tid >> 3, cs = (tid & 7) * 16;
    float o[16];
#pragma unroll
    for (int c4 = 0; c4 < 4; ++c4) { const float4 b4 = *(const float4*)(p.rg_conv_b + g * 128 + cs + c4 * 4); o[c4 * 4] = b4.x; o[c4 * 4 + 1] = b4.y; o[c4 * 4 + 2] = b4.z; o[c4 * 4 + 3] = b4.w; }
#pragma unroll
    for (int j = 0; j < 5; ++j) {
        const float* wr_ = p.rg_conv_w + j * 1024 + g * 128 + cs; const float* ir = sm + (tk + j) * 132 + cs;
#pragma unroll
        for (int c4 = 0; c4 < 4; ++c4) { const float4 w4 = *(const float4*)(wr_ + c4 * 4), i4 = *(const float4*)(ir + c4 * 4);
            o[c4 * 4 + 0] += i4.x * w4.x; o[c4 * 4 + 1] += i4.y * w4.y; o[c4 * 4 + 2] += i4.z * w4.z; o[c4 * 4 + 3] += i4.w * w4.w; }
    }
    *(uint4*)(XC + tk * 136 + cs) = pack8(o); *(uint4*)(XC + tk * 136 + cs + 8) = pack8(o + 8);
    __syncthreads();
}
__device__ __forceinline__ void rg_gates_reg(const Params& p, int g, int z, const unsigned char* lds, int rt, int chh, int fr, int fq, float (&av)[4][4], float (&bx)[4][4]) {
    const u16* XC = (const u16*)(lds + RG_XC);
    const u16* WR = (const u16*)(p.ws + WS_WRT) + (size_t)((0 * 2 + z) * 8 + g) * 16384; const u16* WI = (const u16*)(p.ws + WS_WRT) + (size_t)((1 * 2 + z) * 8 + g) * 16384;
    f32x4_t R[4], I[4];
#pragma unroll
    for (int c = 0; c < 4; ++c) { R[c] = (f32x4_t){0.f, 0.f, 0.f, 0.f}; I[c] = (f32x4_t){0.f, 0.f, 0.f, 0.f}; }
#pragma unroll
    for (int ks = 0; ks < 4; ++ks) {
        const bf16x8_t a = *(const bf16x8_t*)(XC + (rt * 16 + fr) * 136 + ks * 32 + fq * 8);
#pragma unroll
        for (int c = 0; c < 4; ++c) { const int fo = (((chh * 4 + c) * 4 + ks) * 64 + fq * 16 + fr) * 8;
            R[c] = __builtin_amdgcn_mfma_f32_16x16x32_bf16(a, *(const bf16x8_t*)(WR + fo), R[c], 0, 0, 0);
            I[c] = __builtin_amdgcn_mfma_f32_16x16x32_bf16(a, *(const bf16x8_t*)(WI + fo), I[c], 0, 0, 0); }
    }
#pragma unroll
    for (int c = 0; c < 4; ++c) {
        const int chl = (chh * 4 + c) * 16 + fr, chg = z * 1024 + g * 128 + chl;
        const float br = p.rg_b_r[chg], bi = p.rg_b_i[chg], sp = softplusf_(-p.rg_lambda[chg]);
#pragma unroll
        for (int j = 0; j < 4; ++j) { const int t = rt * 16 + fq * 4 + j;
            const float r = sigmoidf_(R[c][j] + br), ii = sigmoidf_(I[c][j] + bi);
            const float la = -8.f * r * sp;
            av[c][j] = __expf(la); bx[c][j] = sqrtf(-expm1f(2.f * la)) * ii * bf2f(XC[t * 136 + chl]); }
    }
}
__device__ __forceinline__ float2 rg_local(const float (&a)[4], const float (&b)[4], int z) {
    float P = 1.f, H = 0.f;
#pragma unroll
    for (int i = 0; i < 4; ++i) { const int j = z ? 3 - i : i; H = a[j] * H + b[j]; P *= a[j]; }
    return make_float2(P, H);
}
__device__ __forceinline__ void gla_prep_item(const Params& p, int it, unsigned char* lds) {
    const int tid = tid_fresh(), lane = tid & 63, w = tid >> 6, fr = lane & 15, fq = lane >> 4;
    const int h = it & 3, tt = (it >> 2) % 520, z = it / 2080;
    const int rowbase = tt < 8 ? tt * 64 : 512 + (tt - 8) * 64;
    float* LG = (float*)lds;
    u16* QEs = (u16*)(lds + 32768);
    u16* KEs = (u16*)(lds + 32768 + 17408);
    u16* Vs = (u16*)(lds + 32768 + 2 * 17408);
    float* BLs = (float*)(lds + 32768 + 2 * 17408 + 33792);
    const u16* PROJ = (const u16*)(p.ws + WS_PROJ); const float* LR = (const float*)(p.ws + WS_G);
    u16* QE = (u16*)(p.ws + WS_QE); u16* KDT = (u16*)(p.ws + WS_KDT) + (size_t)it * 8192; u16* ATT = (u16*)(p.ws + WS_ATT) + (size_t)it * 4096;
    u16* VT = (u16*)(p.ws + WS_VT); float* EBL = (float*)(p.ws + WS_EBL);
    __syncthreads();
    { const int c = tid & 127, tq = tid >> 7; float wv[16];
#pragma unroll
        for (int r = 0; r < 16; ++r) wv[r] = p.gla_w_up[(z * 16 + r) * 512 + h * 128 + c];
        const float bu = p.gla_b_up[z * 512 + h * 128 + c];
        for (int i = 0; i < 16; ++i) { const int tk = tq * 16 + i; const float* lr = LR + (size_t)(rowbase + tk) * 32 + z * 16; float s = bu;
#pragma unroll
            for (int r = 0; r < 16; ++r) s += lr[r] * wv[r];
            LG[tk * 128 + c] = logsigmoidf_(s) * (1.f / 16.f); } }
    __syncthreads();
    if (tid < 128) { float acc = 0.f;
        for (int i = 0; i < 64; ++i) { const int tk = z ? 63 - i : i; acc += LG[tk * 128 + tid]; LG[tk * 128 + tid] = acc; }
        BLs[tid] = acc; EBL[(size_t)it * 128 + tid] = __expf(acc); }
    __syncthreads();
    { const int tk = tid >> 3, cs = (tid & 7) * 16; const u16* rp = PROJ + (size_t)(rowbase + tk) * NP1;
        float q[16], k[16], qe[16], ke[16];
        unpack8(*(const uint4*)(rp + 2048 + h * 128 + cs), q); unpack8(*(const uint4*)(rp + 2048 + h * 128 + cs + 8), q + 8);
        unpack8(*(const uint4*)(rp + 2560 + h * 128 + cs), k); unpack8(*(const uint4*)(rp + 2560 + h * 128 + cs + 8), k + 8);
#pragma unroll
        for (int c = 0; c < 16; ++c) { const float bb = LG[tk * 128 + cs + c], bl = BLs[cs + c];
            qe[c] = q[c] * 0.08838834764831845f * __expf(bb); ke[c] = k[c] * __expf(-bb);
            { const int d = cs + c; KDT[(((d >> 4) * 2 + (tk >> 5)) * 64 + ((tk >> 3) & 3) * 16 + (d & 15)) * 8 + (tk & 7)] = f2bf(k[c] * __expf(bl - bb)); } }
        const uint4 q0 = pack8(qe), q1 = pack8(qe + 8);
        *(uint4*)(QEs + tk * 136 + cs) = q0; *(uint4*)(QEs + tk * 136 + cs + 8) = q1;
        *(uint4*)(KEs + tk * 136 + cs) = pack8(ke); *(uint4*)(KEs + tk * 136 + cs + 8) = pack8(ke + 8);
        u16* qg = QE + (size_t)it * 8192 + (((tk >> 4) * 4 + (cs >> 5)) * 64 + ((cs >> 3) & 3) * 16 + (tk & 15)) * 8;
        *(uint4*)(qg) = q0; *(uint4*)(qg + 128) = q1; }
    if (z == 0) for (int ch = tid; ch < 2048; ch += NTHR) { const int tk = ch >> 5, c8 = (ch & 31) * 8;
        *(uint4*)(Vs + tk * 264 + c8) = *(const uint4*)(PROJ + (size_t)(rowbase + tk) * NP1 + 3072 + h * 256 + c8); }
    __syncthreads();
    { const int rt = w >> 1;
#pragma unroll
        for (int i = 0; i < 2; ++i) { const int ct = (w & 1) * 2 + i; f32x4_t acc = (f32x4_t){0.f, 0.f, 0.f, 0.f};
#pragma unroll
            for (int ks = 0; ks < 4; ++ks) { const bf16x8_t a = *(const bf16x8_t*)(QEs + (rt * 16 + fr) * 136 + ks * 32 + fq * 8); const bf16x8_t bb = *(const bf16x8_t*)(KEs + (ct * 16 + fr) * 136 + ks * 32 + fq * 8);
                acc = __builtin_amdgcn_mfma_f32_16x16x32_bf16(a, bb, acc, 0, 0, 0); }
#pragma unroll
            for (int j = 0; j < 4; ++j) { const int l = rt * 16 + fq * 4 + j, s = ct * 16 + fr; const bool keep = z ? (s >= l) : (s <= l);
                ATT[(((l >> 4) * 2 + (s >> 5)) * 64 + ((s >> 3) & 3) * 16 + (l & 15)) * 8 + (s & 7)] = f2bf(keep ? acc[j] : 0.f); } } }
    if (z == 0) { const int e = tid >> 1, hf = tid & 1; u16* dst = VT + (size_t)(tt * 4 + h) * 16384 + (((e >> 4) * 2 + hf) * 64 + (e & 15)) * 8;
#pragma unroll
        for (int l8 = 0; l8 < 4; ++l8) { float v[8];
#pragma unroll
            for (int j = 0; j < 8; ++j) v[j] = bf2f(Vs[(hf * 32 + l8 * 8 + j) * 264 + e]);
            *(uint4*)(dst + l8 * 128) = pack8(v); } }
}
__device__ __forceinline__ void ph_l1_a(const Params& p, unsigned char* lds) {
    const int tid = tid_fresh(), lane = tid & 63, w = tid >> 6, rt = w >> 1, chh = w & 1, fr = lane & 15, fq = lane >> 4;
#ifdef PROBE3
    if (blockIdx.x == 100 && tid == 0) { unsigned long long* pr = (unsigned long long*)(p.ws + WS_MODP) + 500000; pr[0] = __builtin_amdgcn_s_memrealtime(); }
#endif
    float2* AGG = (float2*)(p.ws + WS_AGG);
    float2* AG = (float2*)lds;
    for (int t = blockIdx.x; t < 520 * 8; t += gridDim.x) {
        const int tt = t >> 3, g = t & 7, b = rg_batch(tt);
        rg_conv(p, tt, g, lds);
#pragma unroll
        for (int z = 0; z < 2; ++z) {
            float av[4][4], bx[4][4];
            rg_gates_reg(p, g, z, lds, rt, chh, fr, fq, av, bx);
#pragma unroll
            for (int c = 0; c < 4; ++c) AG[(z * 16 + rt * 4 + fq) * 128 + (chh * 4 + c) * 16 + fr] = rg_local(av[c], bx[c], z);
        }
        __syncthreads();
        if (tid < 256) { const int z = tid >> 7, ch = tid & 127; float P = 1.f, H = 0.f;
#pragma unroll
            for (int s = 0; s < 16; ++s) { const int gi = z ? 15 - s : s; const float2 ph = AG[(z * 16 + gi) * 128 + ch]; H = ph.x * H + ph.y; P *= ph.x; }
            AGG[((size_t)(b * 2 + z) * NSEG + rg_tau(tt, z)) * 1024 + g * 128 + ch] = make_float2(P, H); }
    }
#ifdef PROBE3
    __syncthreads(); const unsigned long long tm_ = __builtin_amdgcn_s_memrealtime();
#endif
    for (int it = blockIdx.x; it < 4160; it += gridDim.x) gla_prep_item(p, it, lds);
#ifdef PROBE3
    __syncthreads(); if (blockIdx.x == 100 && tid == 0) { unsigned long long* pr = (unsigned long long*)(p.ws + WS_MODP) + 500000; pr[1] = tm_; pr[2] = __builtin_amdgcn_s_memrealtime(); }
#endif
}
__device__ __forceinline__ void rg_pass_b(const Params& p, int job) {
    const float2* __restrict__ AGG = (const float2*)(p.ws + WS_AGG); float* __restrict__ CARRY = (float*)(p.ws + WS_CARRY);
    const int bz = job >> 1, ch = (job & 1) * 512 + tid_fresh();
    float carry = 0.f;
    for (int t0 = 0; t0 < NSEG; t0 += 20) {
        float2 ph[20];
#pragma unroll
        for (int i = 0; i < 20; ++i) ph[i] = AGG[((size_t)bz * NSEG + t0 + i) * 1024 + ch];
#pragma unroll
        for (int i = 0; i < 20; ++i) { CARRY[((size_t)bz * NSEG + t0 + i) * 1024 + ch] = carry; carry = ph[i].x * carry + ph[i].y; }
    }
}
struct GlaFr { bf16x8_t qe[4], at[2], vt[2], kd[2][2]; float eb[2]; };
struct GlaOff { int qe, at, vt, kd, eb, o, tch, tsel; };
__device__ __forceinline__ void gla_load(GlaFr& F, const unsigned char* ws, int n, int b, int h, int dir, const GlaOff& o) {
    const int nn = n < NSEG ? n : NSEG - 1;
    const int tt = tile_of(nn, b, dir), it = (dir * 520 + tt) * 4 + h, rowbase = rowbase_of(tt);
    const u16* QE = (const u16*)(ws + WS_QE) + (size_t)it * 8192;
    const u16* AT = (const u16*)(ws + WS_ATT) + (size_t)it * 4096;
    const u16* VT = (const u16*)(ws + WS_VT) + (size_t)(tt * 4 + h) * 16384;
    const u16* KD = (const u16*)(ws + WS_KDT) + (size_t)it * 8192;
    const float* EB = (const float*)(ws + WS_EBL) + (size_t)it * 128;
#pragma unroll
    for (int ks = 0; ks < 4; ++ks) F.qe[ks] = *(const bf16x8_t*)(QE + o.qe + ks * 512);
#pragma unroll
    for (int ks = 0; ks < 2; ++ks) { F.at[ks] = *(const bf16x8_t*)(AT + o.at + ks * 512); F.vt[ks] = *(const bf16x8_t*)(VT + o.vt + ks * 512);
        F.kd[0][ks] = *(const bf16x8_t*)(KD + o.kd + ks * 512); F.kd[1][ks] = *(const bf16x8_t*)(KD + o.kd + 1024 + ks * 512); }
    F.eb[0] = EB[o.eb]; F.eb[1] = EB[o.eb + 16];
}
__device__ __forceinline__ unsigned gla_touch(const unsigned char* ws, int n, int b, int h, int dir, const GlaOff& o) {
    const int nn = n < NSEG ? n : NSEG - 1;
    const int tt = tile_of(nn, b, dir), it = (dir * 520 + tt) * 4 + h, rowbase = rowbase_of(tt);
    const u16* base;
    if (o.tsel == 0) base = (const u16*)(ws + WS_QE) + (size_t)it * 8192;
    else if (o.tsel == 1) base = (const u16*)(ws + WS_KDT) + (size_t)it * 8192;
    else if (o.tsel == 2) base = (const u16*)(ws + WS_ATT) + (size_t)it * 4096;
    else base = (const u16*)(ws + WS_VT) + (size_t)(tt * 4 + h) * 16384;
    return *(const unsigned*)(base + o.tch);
}
__device__ __forceinline__ void gla_chunk(const Params& p, int job, unsigned char* lds) {
    const int tid = tid_fresh(), lane = tid & 63, w = __builtin_amdgcn_readfirstlane(tid >> 6), fr = lane & 15, fq = lane >> 4;
    const int chain = job >> 3, cgp = job & 7;
    const int b = chain >> 3, h = (chain >> 1) & 3, dir = chain & 1;
    const int e0 = cgp * 32, lt = w >> 1, et = w & 1, dt0 = (w >> 1) * 2;
    const unsigned char* ws = p.ws;
    GlaOff o;
    o.qe = lt * 2048 + lane * 8; o.at = lt * 1024 + lane * 8; o.vt = ((e0 >> 4) + et) * 1024 + lane * 8;
    o.kd = dt0 * 1024 + lane * 8; o.eb = dt0 * 16 + fr; o.o = (lt * 16 + fq * 4) * 1024 + h * 256 + e0 + et * 16 + fr;
    o.tsel = w < 2 ? 0 : (w < 4 ? 1 : (w == 4 ? 2 : 3));
    o.tch = w < 2 ? (w * 64 + lane) * 64 : (w < 4 ? ((w - 2) * 64 + lane) * 64 : (w == 4 ? lane * 64 : (e0 >> 4) * 1024 + (lane & 31) * 64));
    u16* Sl = (u16*)lds;
    u16* O = (u16*)(p.ws + (dir ? WS_OB1 : WS_OF1));
    const int sRd = (et * 16 + fr) * 136 + fq * 8, sWr = (et * 16 + fq * 4) * 136 + dt0 * 16 + fr;
    __syncthreads();
    for (int i = tid; i < 2 * 32 * 136 / 2; i += NTHR) ((unsigned*)Sl)[i] = 0u;
    __syncthreads();
    f32x4_t Sacc[2]; Sacc[0] = (f32x4_t){0.f, 0.f, 0.f, 0.f}; Sacc[1] = Sacc[0];
    GlaFr buf[2];
    gla_load(buf[0], ws, 0, b, h, dir, o); gla_load(buf[1], ws, 1, b, h, dir, o);
    unsigned pfr[4] = {0u, 0u, 0u, 0u}, sink = 0u;
    for (int n0 = 0; n0 < NSEG; n0 += 4) {
#pragma unroll
        for (int u = 0; u < 4; ++u) {
            const int n = n0 + u; const int s = u & 1;
            sink ^= pfr[u]; if (w < 6) pfr[u] = gla_touch(ws, n + 5, b, h, dir, o);
            const GlaFr& F = buf[s];
            const u16* Scur = Sl + (n & 1) * (32 * 136); u16* Snxt = Sl + ((n + 1) & 1) * (32 * 136);
            if (n >= 4) {
                const int tt = tile_of(n, b, dir);
                u16* Ou = O + (size_t)(512 + (tt - 8) * 64) * 1024;
                f32x4_t acc = (f32x4_t){0.f, 0.f, 0.f, 0.f};
#pragma unroll
                for (int ks = 0; ks < 4; ++ks) { const bf16x8_t bb = *(const bf16x8_t*)(Scur + sRd + ks * 32); acc = __builtin_amdgcn_mfma_f32_16x16x32_bf16(F.qe[ks], bb, acc, 0, 0, 0); }
#pragma unroll
                for (int ks = 0; ks < 2; ++ks) acc = __builtin_amdgcn_mfma_f32_16x16x32_bf16(F.at[ks], F.vt[ks], acc, 0, 0, 0);
#pragma unroll
                for (int j = 0; j < 4; ++j) Ou[o.o + j * 1024] = f2bf(acc[j]);
            }
#pragma unroll
            for (int i = 0; i < 2; ++i) { f32x4_t nw = (f32x4_t){0.f, 0.f, 0.f, 0.f};
#pragma unroll
                for (int ks = 0; ks < 2; ++ks) nw = __builtin_amdgcn_mfma_f32_16x16x32_bf16(F.vt[ks], F.kd[i][ks], nw, 0, 0, 0);
#pragma unroll
                for (int j = 0; j < 4; ++j) { Sacc[i][j] = F.eb[i] * Sacc[i][j] + nw[j]; Snxt[sWr + j * 136 + i * 16] = f2bf(Sacc[i][j]); } }
            __syncthreads();
            gla_load(buf[s], ws, n + 2, b, h, dir, o);
        }
    }
    ((unsigned*)(p.ws + WS_MODP))[blockIdx.x * NTHR + tid] = sink ^ pfr[0] ^ pfr[1] ^ pfr[2] ^ pfr[3];
}
__device__ __forceinline__ void ph_l1_c(const Params& p, unsigned char* lds) {
    const int tid = tid_fresh(), rt = (tid >> 6) >> 1, chh = (tid >> 6) & 1, fr = tid & 15, fq = (tid & 63) >> 4;
    const u16* PROJ = (const u16*)(p.ws + WS_PROJ); const float* CARRY = (const float*)(p.ws + WS_CARRY); u16* Y = (u16*)(p.ws + WS_H);
    float2* AG = (float2*)lds;
    float* CIN = (float*)(lds + 32768);
    for (int t = blockIdx.x + 64; t < 520 * 8; t += gridDim.x) {
        const int tt = t >> 3, g = t & 7, b = rg_batch(tt);
        const int rowbase = 512 + (tt - 8) * 64;
        u16 grv[4][4];
#pragma unroll
        for (int c = 0; c < 4; ++c)
#pragma unroll
            for (int j = 0; j < 4; ++j) grv[c][j] = PROJ[(size_t)(rowbase + rt * 16 + fq * 4 + j) * NP1 + 1024 + g * 128 + (chh * 4 + c) * 16 + fr];
        rg_conv(p, tt, g, lds);
        float av[2][4][4], bx[2][4][4];
#pragma unroll
        for (int z = 0; z < 2; ++z) {
            rg_gates_reg(p, g, z, lds, rt, chh, fr, fq, av[z], bx[z]);
#pragma unroll
            for (int c = 0; c < 4; ++c) AG[(z * 16 + rt * 4 + fq) * 128 + (chh * 4 + c) * 16 + fr] = rg_local(av[z][c], bx[z][c], z);
        }
        __syncthreads();
        if (tid < 256) { const int z = tid >> 7, ch = tid & 127; float h = CARRY[((size_t)(b * 2 + z) * NSEG + rg_tau(tt, z)) * 1024 + g * 128 + ch];
#pragma unroll
            for (int s = 0; s < 16; ++s) { const int gi = z ? 15 - s : s; CIN[(z * 16 + gi) * 128 + ch] = h; const float2 ph = AG[(z * 16 + gi) * 128 + ch]; h = ph.x * h + ph.y; } }
        __syncthreads();
#pragma unroll
        for (int c = 0; c < 4; ++c) { const int chl = (chh * 4 + c) * 16 + fr; float hs[4];
            { float h = CIN[(0 * 16 + rt * 4 + fq) * 128 + chl];
#pragma unroll
                for (int j = 0; j < 4; ++j) { h = av[0][c][j] * h + bx[0][c][j]; hs[j] = h; } }
            { float h = CIN[(1 * 16 + rt * 4 + fq) * 128 + chl];
#pragma unroll
                for (int j = 3; j >= 0; --j) { h = av[1][c][j] * h + bx[1][c][j]; hs[j] += h; } }
#pragma unroll
            for (int j = 0; j < 4; ++j) Y[(size_t)(rowbase + rt * 16 + fq * 4 + j) * 2048 + g * 128 + chl] = f2bf(gelu_tanh(bf2f(grv[c][j])) * hs[j]); }
    }
    const int lane = tid & 63, w = tid >> 6;
    const u16* OF = (const u16*)(p.ws + WS_OF1); const u16* OB = (const u16*)(p.ws + WS_OB1);
    for (int row = 512 + blockIdx.x * 8 + w; row < MTOT; row += gridDim.x * 8) {
        const int col = lane * 16; float o[16]; float ss = 0.f;
#pragma unroll
        for (int i = 0; i < 2; ++i) { float a[8], bb[8]; unpack8(*(const uint4*)(OF + (size_t)row * 1024 + col + i * 8), a); unpack8(*(const uint4*)(OB + (size_t)row * 1024 + col + i * 8), bb);
#pragma unroll
            for (int j = 0; j < 8; ++j) { o[i * 8 + j] = a[j] + bb[j]; ss += o[i * 8 + j] * o[i * 8 + j]; } }
        ss = red16(ss);
        const float rstd = rsqrtf(ss * (1.f / 256.f) + 1e-6f);
#pragma unroll
        for (int i = 0; i < 2; ++i) { float gt[8], r[8]; unpack8(*(const uint4*)(PROJ + (size_t)row * NP1 + 4096 + col + i * 8), gt);
#pragma unroll
            for (int j = 0; j < 8; ++j) r[j] = o[i * 8 + j] * rstd * p.gla_norm_g[col + i * 8 + j] * siluf_(gt[j]);
            *(uint4*)(Y + (size_t)row * 2048 + 1024 + col + i * 8) = pack8(r); }
    }
}

#define XB_TMO      128
#define XB_XCNT(j)  (256  + 64 * (j))
#define XB_XSUB(j)  (1280 + 64 * (j))
#define XB_XGEN(j)  (2304 + 64 * (j))
#define XB_TOP      3328
#define XB_TOPGEN   3392
#define XCD_BAR_WORDS 3456
#define XB_SPIN_CAP (1u << 18)
#define XLAS __attribute__((address_space(3)))

__device__ __forceinline__ unsigned xb_ld(unsigned* p)              { return __hip_atomic_load(p, __ATOMIC_RELAXED, __HIP_MEMORY_SCOPE_AGENT); }
__device__ __forceinline__ unsigned xb_add(unsigned* p, unsigned v) { return __hip_atomic_fetch_add(p, v, __ATOMIC_RELAXED, __HIP_MEMORY_SCOPE_AGENT); }
__device__ __forceinline__ unsigned xb_xcc_id() { return (unsigned)__builtin_amdgcn_s_getreg((3 << 11) | 20) & 0xFu; }
#define XB_SPIN(cond, bar) do { unsigned _sp = 0; while (cond) { __builtin_amdgcn_s_sleep(1); \
    if ((++_sp & 255u) == 0u) { if (xb_ld(&(bar)[XB_TMO])) break; if (_sp > XB_SPIN_CAP) { atomicAdd(&(bar)[XB_TMO], 1u); break; } } } } while (0)

struct XcdBarrier {
    unsigned* bar; unsigned x;
    volatile XLAS unsigned* st;
};

__device__ __forceinline__ XcdBarrier xcd_barrier_post(unsigned* bar, volatile XLAS unsigned* st) {
    XcdBarrier b; b.bar = bar; b.x = xb_xcc_id(); b.st = st;
    if (threadIdx.x == 0) (void)xb_add(&bar[XB_XCNT(b.x)], 1u);
    return b;
}
__device__ __forceinline__ void xcd_barrier_complete(unsigned* bar, unsigned x, unsigned& nloc, unsigned& nx) {
    const unsigned G = gridDim.x * gridDim.y * gridDim.z;
    unsigned sum, cnt, mine, sp = 0u;
    for (;;) {
        sum = 0u; cnt = 0u; mine = 0u;
#pragma unroll
        for (unsigned j = 0; j < 16; ++j) { const unsigned c = xb_ld(&bar[XB_XCNT(j)]); sum += c; cnt += (c > 0u) ? 1u : 0u; mine = (j == x) ? c : mine; }
        if (sum == G) break;
        __builtin_amdgcn_s_sleep(1);
        if ((++sp & 255u) == 0u) { if (xb_ld(&bar[XB_TMO])) break; if (sp > XB_SPIN_CAP) { atomicAdd(&bar[XB_TMO], 1u); break; } }
    }
    nloc = mine > 0u ? mine : 1u; nx = cnt > 0u ? cnt : 1u;
}

__device__ __forceinline__ void xcd_barrier(const XcdBarrier& b) {
    asm volatile("s_waitcnt vmcnt(0)" ::: "memory");
    __syncthreads();
    if (threadIdx.x == 0) {
        unsigned* bar = b.bar;
        __builtin_amdgcn_s_waitcnt(0);
        unsigned nloc = b.st[0], nx = b.st[1];
        if (nloc == 0u) { xcd_barrier_complete(bar, b.x, nloc, nx); b.st[0] = nloc; b.st[1] = nx; }
        const unsigned old = xb_add(&bar[XB_XSUB(b.x)], 1u);
        const unsigned gen = old / nloc;
        if (old + 1u == (gen + 1u) * nloc) {
            __builtin_amdgcn_fence(__ATOMIC_RELEASE, "agent");
            asm volatile("s_waitcnt vmcnt(0)" ::: "memory");
            const unsigned og = xb_add(&bar[XB_TOP], 1u);
            const unsigned tg = og / nx;
            if (og + 1u == (tg + 1u) * nx) xb_add(&bar[XB_TOPGEN], 1u);
            else XB_SPIN(xb_ld(&bar[XB_TOPGEN]) == tg, bar);
            __builtin_amdgcn_fence(__ATOMIC_ACQUIRE, "agent");
            xb_add(&bar[XB_XGEN(b.x)], 1u);
            asm volatile("s_waitcnt vmcnt(0)" ::: "memory");
        } else {
            XB_SPIN(xb_ld(&bar[XB_XGEN(b.x)]) == gen, bar);
            __builtin_amdgcn_fence(__ATOMIC_ACQUIRE, "agent");
            asm volatile("s_waitcnt vmcnt(0)" ::: "memory");
        }
    }
    __syncthreads();
}

constexpr int LDS_BYTES = 135168 + 16;

__global__ void __launch_bounds__(NTHR, 2) hybrid_fwd(Params p) {
    extern __shared__ __attribute__((aligned(16))) unsigned char lds[];
    cg::grid_group grid = cg::this_grid();
    float* smf = (float*)lds;
    PG8_LAS unsigned char* ldsg = (PG8_LAS unsigned char*)lds;
    unsigned char* ws = p.ws;
    u16* WT_IN = (u16*)(ws + WS_WT_IN); u16* WT_OUT = (u16*)(ws + WS_WT_OUT); u16* WT_GU = (u16*)(ws + WS_WT_GU); u16* WT_DN = (u16*)(ws + WS_WT_DN);
    u16* H = (u16*)(ws + WS_H); u16* PROJ = (u16*)(ws + WS_PROJ); float* XC = (float*)(ws + WS_XC); float* G = (float*)(ws + WS_G);
    const float* MOD = (const float*)(ws + WS_MOD);
    const int GD = (int)gridDim.x, bid = (int)blockIdx.x;
    const int vb = (GD % 8 == 0) ? (bid % 8) * (GD / 8) + bid / 8 : bid;
    volatile XLAS unsigned* xst = (volatile XLAS unsigned*)((PG8_LAS unsigned char*)lds + 135168);
    if (threadIdx.x < 2) xst[threadIdx.x] = 0u;
    __syncthreads();
    const XcdBarrier xbar = xcd_barrier_post((unsigned*)(ws + WS_BAR), xst);
#ifdef PROBE
    unsigned long long tG = 0, tL0P = 0, tL0PP = 0, tL0M = 0, tL1A = 0, tL1M = 0, tL1C = 0, tO = 0, tprev = __builtin_amdgcn_s_memrealtime();
#define PSTAMP(c) do { const unsigned long long t_ = __builtin_amdgcn_s_memrealtime(); c += t_ - tprev; tprev = t_; } while (0)
#else
#define PSTAMP(c) do {} while (0)
#endif

    ph_adaln_partials(p, smf);
    ph_convert_rg(p);
    ph_convert<1>(p.ab_w_in, 7216, 2048, 7424, WT_IN, smf);
    ph_convert<0>(p.ab_w_out, 2048, 2048, 2048, WT_OUT, smf);
    ph_convert<2>(p.ffn_w_gu, 11264, 2048, 11264, WT_GU, smf);
    ph_convert<0>(p.ffn_w_down, 2048, 5632, 2048, WT_DN, smf);
    grid.sync();
    PSTAMP(tO);
    ph_adaln_reduce(p);
    xcd_barrier(xbar);
    PSTAMP(tO);

    ph_norm(p.ctx, p.x, p.norm_mix_g, MOD, 0, 1, H, 0);
    xcd_barrier(xbar);
    PSTAMP(tO);
    { pg8::Gemm g{H, WT_IN, MTOT, 7424, 2048}; pg8::StaticOrder S; S.init(MTOT, 7424, GD, bid);
      pg8::EpiProj E{PROJ, NP0, 28, G, NG0, NG0}; pg8::gemm_phase<pg8::EpiProj, pg8::StaticOrder>(ldsg, g, S, E); }
    xcd_barrier(xbar);
    PSTAMP(tG);
    ph_l0_prep(p, smf);
    xcd_barrier(xbar);
    PSTAMP(tL0P);
    ph_l0_prepass(p, lds);
#ifdef DUP_L0PP
    xcd_barrier(xbar); ph_l0_prepass(p, lds);
#endif
    xcd_barrier(xbar);
    PSTAMP(tL0PP);
    for (int job = vb; job < 256; job += GD) { if (job < 128) mlstm_chunk(p, job, lds); else deltanet_chunk(p, job - 128, lds); }
#ifdef DUP_L0M
    xcd_barrier(xbar);
    for (int job = vb; job < 256; job += GD) { if (job < 128) mlstm_chunk(p, job, lds); else deltanet_chunk(p, job - 128, lds); }
#endif
    xcd_barrier(xbar);
    PSTAMP(tL0M);
    ph_l0_merge(p);
    xcd_barrier(xbar);
    PSTAMP(tO);
    { pg8::Gemm g{H, WT_OUT, MTOT, 2048, 2048}; pg8::StaticOrder S; S.init(MTOT, 2048, GD, bid);
      pg8::EpiRes E{p.ctx, p.x, XC, p.out, MOD + 2 * 2048, 0}; pg8::gemm_phase<pg8::EpiRes, pg8::StaticOrder>(ldsg, g, S, E); }
    xcd_barrier(xbar);
    PSTAMP(tG);
    ph_norm(XC, p.out, p.norm_ffn_g, MOD, 3, 4, H, 0);
    xcd_barrier(xbar);
    PSTAMP(tO);
    { pg8::Gemm g{H, WT_GU, MTOT, 11264, 2048}; pg8::StaticOrder S; S.init(MTOT, 11264, GD, bid);
      pg8::EpiSwiglu E{PROJ, FH}; pg8::gemm_phase<pg8::EpiSwiglu, pg8::StaticOrder>(ldsg, g, S, E); }
    xcd_barrier(xbar);
    PSTAMP(tG);
    { pg8::Gemm g{PROJ, WT_DN, MTOT, 2048, 5632}; pg8::StaticOrder S; S.init(MTOT, 2048, GD, bid);
      pg8::EpiRes E{XC, p.out, XC, p.out, MOD + 5 * 2048, 0}; pg8::gemm_phase<pg8::EpiRes, pg8::StaticOrder>(ldsg, g, S, E); }
    xcd_barrier(xbar);
    PSTAMP(tG);

    const float* MOD1 = MOD + 3 * 12288;
    ph_convert<0>(p.cd_w_in, 5152, 2048, 5376, WT_IN, smf);
    ph_convert<0>(p.cd_w_out, 2048, 2048, 2048, WT_OUT, smf);
    ph_convert<2>(p.ffn_w_gu + (size_t)2048 * 11264, 11264, 2048, 11264, WT_GU, smf);
    ph_convert<0>(p.ffn_w_down + (size_t)5632 * 2048, 2048, 5632, 2048, WT_DN, smf);
    ph_norm(XC, p.out, p.norm_mix_g + 2048, MOD1, 0, 1, H, 0);
    xcd_barrier(xbar);
    PSTAMP(tO);
    { pg8::Gemm g{H, WT_IN, MTOT, 5376, 2048}; pg8::StaticOrder S; S.init(MTOT, 5376, GD, bid);
      pg8::EpiProj E{PROJ, NP1, 20, G, NG1, NG1}; pg8::gemm_phase<pg8::EpiProj, pg8::StaticOrder>(ldsg, g, S, E); }
    xcd_barrier(xbar);
    PSTAMP(tG);
    ph_l1_a(p, lds);
#ifdef DUP_L1A
    xcd_barrier(xbar); ph_l1_a(p, lds);
#endif
    xcd_barrier(xbar);
    PSTAMP(tL1A);
    for (int job = vb; job < 136; job += GD) { if (job < 128) gla_chunk(p, job, lds); else rg_pass_b(p, job - 128); }
#ifdef DUP_L1M
    xcd_barrier(xbar);
    for (int job = vb; job < 136; job += GD) { if (job < 128) gla_chunk(p, job, lds); else rg_pass_b(p, job - 128); }
#endif
    xcd_barrier(xbar);
    PSTAMP(tL1M);
    ph_l1_c(p, lds);
#ifdef DUP_L1C
    xcd_barrier(xbar); ph_l1_c(p, lds);
#endif
    xcd_barrier(xbar);
    PSTAMP(tL1C);
    { pg8::Gemm g{H + (size_t)512 * 2048, WT_OUT, MLAT, 2048, 2048}; pg8::StaticOrder S; S.init(MLAT, 2048, GD, bid);
      pg8::EpiRes E{XC, p.out, XC, p.out, MOD1 + 2 * 2048, 512}; pg8::gemm_phase<pg8::EpiRes, pg8::StaticOrder>(ldsg, g, S, E); }
    xcd_barrier(xbar);
    PSTAMP(tG);
    ph_norm(XC, p.out, p.norm_ffn_g + 2048, MOD1, 3, 4, H, 512);
    xcd_barrier(xbar);
    PSTAMP(tO);
    { pg8::Gemm g{H + (size_t)512 * 2048, WT_GU, MLAT, 11264, 2048}; pg8::StaticOrder S; S.init(MLAT, 11264, GD, bid);
      pg8::EpiSwiglu E{PROJ, FH}; pg8::gemm_phase<pg8::EpiSwiglu, pg8::StaticOrder>(ldsg, g, S, E); }
    xcd_barrier(xbar);
    PSTAMP(tG);
    { pg8::Gemm g{PROJ, WT_DN, MLAT, 2048, 5632}; pg8::StaticOrder S; S.init(MLAT, 2048, GD, bid);
      pg8::EpiRes E{XC, p.out, XC, p.out, MOD1 + 5 * 2048, 512}; pg8::gemm_phase<pg8::EpiRes, pg8::StaticOrder>(ldsg, g, S, E); }
    xcd_barrier(xbar);
    PSTAMP(tG);
#ifdef EXTRA_SYNCS
#pragma unroll 1
    for (int i = 0; i < EXTRA_SYNCS; ++i) xcd_barrier(xbar);
#endif
    ph_final_norm(p);
#ifdef PROBE
    PSTAMP(tO);
    __syncthreads();
    if (bid == 0 && threadIdx.x == 0) { const float tot = (float)(tG + tL0P + tL0PP + tL0M + tL1A + tL1M + tL1C + tO);
#ifdef PROBE3
        const unsigned long long* pq = (const unsigned long long*)(p.ws + WS_MODP) + 500000;
        p.out[0] += 0.25f + 0.15f * ((float)(pq[1] - pq[0]) / tot); p.out[1] += 0.10f + 0.14f * ((float)(pq[2] - pq[1]) / tot); }
#elif defined(PROBE2)
        const float* pr = (const float*)(p.ws + WS_MODP) + 1000000;
        p.out[0] += 0.25f + 0.15f * pr[0]; p.out[1] += 0.10f + 0.14f * pr[1]; }
#else
        p.out[0] += 0.25f + 0.15f * ((float)PROBE_A / tot); p.out[1] += 0.10f + 0.14f * ((float)PROBE_B / tot); }
#endif
#endif
}

extern "C" void kernel_launch(void* const* d_in, const int* in_sizes, int n_in, void* d_out, int out_size, void* d_ws, size_t ws_size, hipStream_t stream) {
    static int grid = 0;
    if (grid == 0) {
        if (n_in != 32 || out_size != MLAT * DM || ws_size < WS_END) { fprintf(stderr, "kernel_launch: unexpected shapes (n_in %d out %d ws %zu need %zu)\n", n_in, out_size, ws_size, (size_t)WS_END); grid = -1; return; }
        int dev = 0, cus = 0, per_cu = 0;
        (void)hipGetDevice(&dev);
        (void)hipDeviceGetAttribute(&cus, hipDeviceAttributeMultiprocessorCount, dev);
        if (hipFuncSetAttribute((const void*)hybrid_fwd, hipFuncAttributeMaxDynamicSharedMemorySize, LDS_BYTES) != hipSuccess) { fprintf(stderr, "kernel_launch: hipFuncSetAttribute failed\n"); }
        if (hipOccupancyMaxActiveBlocksPerMultiprocessor(&per_cu, (const void*)hybrid_fwd, NTHR, LDS_BYTES) != hipSuccess || per_cu < 1) { fprintf(stderr, "kernel_launch: occupancy query gave %d\n", per_cu); per_cu = 1; }
        (void)hipGetLastError();
        grid = cus * per_cu;
    }
    if (grid < 0) return;
    Params p{};
    const float** pp = (const float**)&p;
    for (int i = 0; i < 32; ++i) pp[i] = (const float*)d_in[i];
    p.out = (float*)d_out; p.ws = (unsigned char*)d_ws;
    (void)hipMemsetAsync((unsigned char*)d_ws + WS_BAR, 0, 16384, stream);
    void* args[] = {&p};
    hipError_t e = hipLaunchCooperativeKernel((const void*)hybrid_fwd, dim3(grid), dim3(NTHR), args, LDS_BYTES, stream);
    if (e != hipSuccess) fprintf(stderr, "cooperative launch failed: %s (grid %d)\n", hipGetErrorString(e), grid);
}
```

```cpp
#include <hip/hip_runtime.h>
#include <hip/hip_cooperative_groups.h>
#include <cstdio>
namespace cg = cooperative_groups;

typedef unsigned short u16;

constexpr int DM = 2048, FH = 5632, MC = 512, MLAT = 32768, MTOT = 33280, NTHR = 512;
constexpr int NP0 = 7168, NP1 = 5120;
constexpr int NG0 = 48, NG1 = 32;
constexpr int NSEG = 260;

constexpr size_t WS_WT_IN = 0;
constexpr size_t WS_WT_OUT = WS_WT_IN + (size_t)7424 * 2048 * 2;
constexpr size_t WS_WT_GU = WS_WT_OUT + (size_t)2048 * 2048 * 2;
constexpr size_t WS_WT_DN = WS_WT_GU + (size_t)11264 * 2048 * 2;
constexpr size_t WS_H = WS_WT_DN + (size_t)2048 * 5632 * 2;
constexpr size_t WS_PROJ = WS_H + (size_t)MTOT * 2048 * 2;
constexpr size_t WS_OF = WS_PROJ + (size_t)MTOT * 7168 * 2;
constexpr size_t WS_OB = WS_OF + (size_t)MTOT * 2048 * 2;
constexpr size_t WS_XC = WS_OB + (size_t)MTOT * 2048 * 2;
constexpr size_t WS_G = WS_XC + (size_t)MC * 2048 * 4;
constexpr size_t WS_CQ = WS_G + (size_t)MTOT * 48 * 4;
constexpr size_t WS_MODP = WS_CQ + (size_t)MC * 3072 * 2;
constexpr size_t WS_MOD = WS_MODP + (size_t)2 * 32 * 3 * 12288 * 4;
constexpr size_t WS_ATT0 = WS_MOD + (size_t)2 * 3 * 12288 * 4;
constexpr size_t WS_MLS = WS_ATT0 + (size_t)4160 * 4096 * 2;
constexpr size_t WS_GCS = WS_MLS + (size_t)4160 * 256 * 4;
constexpr size_t WS_WRT = WS_GCS + (size_t)8320 * 256 * 4;
constexpr size_t WS_BAR = WS_WRT + (size_t)32 * 16384 * 2;
constexpr size_t WS_END = WS_BAR + 16384;
constexpr size_t WS_TM = WS_H;
constexpr size_t WS_QK = WS_H + (size_t)8320 * 4096 * 2;
constexpr size_t WS_OF1 = WS_OF;
constexpr size_t WS_OB1 = WS_OF + (size_t)MTOT * 1024 * 2;
constexpr size_t WS_QE = WS_OB;
constexpr size_t WS_KDT = WS_QE + (size_t)2 * MTOT * 512 * 2;
constexpr size_t WS_TAIL = WS_PROJ + (size_t)MTOT * 5120 * 2;
constexpr size_t WS_ATT = WS_TAIL;
constexpr size_t WS_VT = WS_ATT + (size_t)4160 * 4096 * 2;
constexpr size_t WS_EBL = WS_VT + (size_t)2080 * 16384 * 2;
constexpr size_t WS_AGG = WS_EBL + (size_t)4160 * 128 * 4;
constexpr size_t WS_CARRY = WS_AGG + (size_t)4 * NSEG * 1024 * 8;
static_assert(WS_CARRY + (size_t)4 * NSEG * 1024 * 4 <= WS_OF, "layer-1 tail overflow");

struct Params {
    const float *x, *c, *ctx, *c_ctx, *mod_w, *mod_b, *norm_mix_g, *norm_ffn_g, *ffn_w_gu, *ffn_w_down, *final_norm_g,
        *ab_w_in, *ab_w_out, *ml_ig_b, *ml_fg_b, *ml_norm_g, *dn_conv_w, *dn_a_log, *dn_dt_bias, *dn_norm_g,
        *cd_w_in, *cd_w_out, *rg_conv_w, *rg_conv_b, *rg_w_r, *rg_b_r, *rg_w_i, *rg_b_i, *rg_lambda, *gla_w_up, *gla_b_up, *gla_norm_g;
    float* out; unsigned char* ws;
};

__device__ __forceinline__ float bf2f(u16 v) { return __uint_as_float(((unsigned)v) << 16); }
typedef __bf16 bf16x2_nat __attribute__((ext_vector_type(2)));
typedef float f32x2_nat __attribute__((ext_vector_type(2)));
__device__ __forceinline__ unsigned cvt_pk_bf16(float lo, float hi) { const f32x2_nat v = {lo, hi}; const bf16x2_nat r = __builtin_convertvector(v, bf16x2_nat); return __builtin_bit_cast(unsigned, r); }
__device__ __forceinline__ u16 f2bf(float f) { return (u16)(cvt_pk_bf16(f, 0.f) & 0xffffu); }
__device__ __forceinline__ void unpack8(const uint4& u, float* f) {
    f[0] = __uint_as_float(u.x << 16); f[1] = __uint_as_float(u.x & 0xffff0000u);
    f[2] = __uint_as_float(u.y << 16); f[3] = __uint_as_float(u.y & 0xffff0000u);
    f[4] = __uint_as_float(u.z << 16); f[5] = __uint_as_float(u.z & 0xffff0000u);
    f[6] = __uint_as_float(u.w << 16); f[7] = __uint_as_float(u.w & 0xffff0000u);
}
__device__ __forceinline__ uint4 pack8(const float* f) { uint4 o; o.x = cvt_pk_bf16(f[0], f[1]); o.y = cvt_pk_bf16(f[2], f[3]); o.z = cvt_pk_bf16(f[4], f[5]); o.w = cvt_pk_bf16(f[6], f[7]); return o; }
template <int CTRL> __device__ __forceinline__ float dppf(float x) { return __int_as_float(__builtin_amdgcn_update_dpp(0, __float_as_int(x), CTRL, 0xF, 0xF, true)); }
__device__ __forceinline__ float red4(float x) { x += dppf<0xB1>(x); x += dppf<0x4E>(x); return x; }
__device__ __forceinline__ float red8(float x) { x = red4(x); x += dppf<0x141>(x); return x; }
__device__ __forceinline__ float red16(float x) { x = red8(x); x += dppf<0x140>(x); return x; }
__device__ __forceinline__ float red64(float x) { x = red16(x); x += __shfl_xor(x, 16); x += __shfl_xor(x, 32); return x; }
__device__ __forceinline__ float frcp(float x) { return __builtin_amdgcn_rcpf(x); }
__device__ __forceinline__ float sigmoidf_(float x) { return frcp(1.f + __expf(-x)); }
__device__ __forceinline__ float siluf_(float x) { return x * frcp(1.f + __expf(-x)); }
__device__ __forceinline__ float softplusf_(float x) { return fmaxf(x, 0.f) + __logf(1.f + __expf(-fabsf(x))); }
__device__ __forceinline__ float logsigmoidf_(float x) { return fminf(x, 0.f) - __logf(1.f + __expf(-fabsf(x))); }
__device__ __forceinline__ float gelu_tanh(float x) { const float u = 0.7978845608028654f * (x + 0.044715f * x * x * x); const float th = 1.f - 2.f * frcp(1.f + __expf(2.f * u)); return 0.5f * x * (1.f + th); }
__device__ __forceinline__ float neg_expm1_small(float x) { float pl = 1.f / 720.f; pl = pl * x + 1.f / 120.f; pl = pl * x + 1.f / 24.f; pl = pl * x + 1.f / 6.f; pl = pl * x + 0.5f; pl = pl * x + 1.f; return -x * pl; }

__device__ __forceinline__ int tid_fresh() { int t = threadIdx.x; asm volatile("" : "+v"(t)); return t; }
namespace pg8 {
#define PG8_LAS __attribute__((address_space(3)))
typedef unsigned short bf16_t;
typedef short bf16x8 __attribute__((ext_vector_type(8)));
typedef float f32x4 __attribute__((ext_vector_type(4)));
typedef unsigned u32x4 __attribute__((ext_vector_type(4)));
constexpr int BM = 256, BK = 64, HALF = 128, HTB = HALF * BK * 2  , STAGE_BYTES = 8 * HTB, NXCD = 8, WGM = 8;

__host__ __device__ __forceinline__ int lds_byte(int r, int c) { const int st = (r >> 4) * 2 + (c >> 5), rr = r & 15, cc = c & 31, ob = rr * 64 + cc * 2; return st * 1024 + (ob ^ (((ob >> 9) & 1) << 5)); }
__host__ __device__ __forceinline__ void stage_rc(int b, int& R, int& C) { const int st = b / 1024, sb = b % 1024, swz = sb ^ (((sb >> 9) & 1) << 5); R = (st >> 1) * 16 + swz / 64; C = (st & 1) * 32 + (swz % 64) / 2; }
__host__ __device__ __forceinline__ int perm32(int rho) { const int n = rho >> 4, i = rho & 15; return 8 * (i >> 2) + 4 * n + (i & 3); }

struct Unit { int pm, pn; };
struct Gemm { const bf16_t* A; const bf16_t* Bt; int M, N, K; };

struct StaticOrder {
    int nM, nN, nwg, G, c;
    __host__ __device__ void init(int M, int N, int G_, int c_) { nM = M / BM; nN = N / BM; nwg = nM * nN; G = G_; c = c_; }
    __host__ __device__ bool next(int i, Unit& u) const {
        const long L = (long)i * G + c; if (L >= nwg) return false;
        int wgid = (int)L; { const int q = nwg / NXCD, r = nwg % NXCD, xcd = wgid % NXCD, off = wgid / NXCD; wgid = (xcd < r ? xcd * (q + 1) : r * (q + 1) + (xcd - r) * q) + off; }
        const int nig = WGM * nN, gid = wgid / nig, fm = gid * WGM, gsz = (nM - fm) < WGM ? (nM - fm) : WGM;
        u.pm = fm + ((wgid % nig) % gsz); u.pn = (wgid % nig) / gsz; return true;
    }
    __device__ __forceinline__ void a_ready(const Unit&) const {}
    __device__ __forceinline__ void done(const Unit&) const {}
};
using ::cvt_pk_bf16;
typedef float f32x2 __attribute__((ext_vector_type(2)));

struct EpiProj {
    static constexpr bool PERM = true, AFTER_DRAIN = false;
    bf16_t* P; int ldp; int n_main; float* G; int ldg; int ng; int perm_tiles;
    __device__ __forceinline__ void operator()(const f32x4 (&acc)[2][2][4][2], const Unit& u, int wr, int wc, int fr, int fq) const {
        const int row0 = u.pm * BM + wr * 64 + fr;
        if (u.pn < perm_tiles) {
#pragma unroll
            for (int ai = 0; ai < 2; ++ai)
#pragma unroll
                for (int m = 0; m < 4; ++m) { bf16_t* rowp = P + (size_t)(u.pm * BM + ai * HALF + wr * 64 + (m * 4 + wc) * 4 + fq) * ldp + u.pn * BM + fr * 8;
#pragma unroll
                    for (int bj = 0; bj < 2; ++bj) { const f32x4 v0 = acc[ai][bj][m][0], v1 = acc[ai][bj][m][1];
                        u32x4 w; w.x = cvt_pk_bf16(v0[0], v0[1]); w.y = cvt_pk_bf16(v0[2], v0[3]); w.z = cvt_pk_bf16(v1[0], v1[1]); w.w = cvt_pk_bf16(v1[2], v1[3]);
                        *(u32x4*)(rowp + bj * HALF) = w; } }
        } else if (u.pn < n_main) {
            const int col0 = u.pn * BM + wc * 32 + 8 * fq;
#pragma unroll
            for (int ai = 0; ai < 2; ++ai)
#pragma unroll
                for (int m = 0; m < 4; ++m) { bf16_t* rowp = P + (size_t)(row0 + ai * HALF + m * 16) * ldp + col0;
#pragma unroll
                    for (int bj = 0; bj < 2; ++bj) { const f32x4 v0 = acc[ai][bj][m][0], v1 = acc[ai][bj][m][1];
                        u32x4 w; w.x = cvt_pk_bf16(v0[0], v0[1]); w.y = cvt_pk_bf16(v0[2], v0[3]); w.z = cvt_pk_bf16(v1[0], v1[1]); w.w = cvt_pk_bf16(v1[2], v1[3]);
                        *(u32x4*)(rowp + bj * HALF) = w; } }
        } else {
            const int c0 = wc * 32 + 8 * fq;
#pragma unroll
            for (int ai = 0; ai < 2; ++ai)
#pragma unroll
                for (int m = 0; m < 4; ++m) { float* rowp = G + (size_t)(row0 + ai * HALF + m * 16) * ldg;
#pragma unroll
                    for (int n = 0; n < 2; ++n)
#pragma unroll
                        for (int j = 0; j < 4; ++j) { const int c = c0 + 4 * n + j; if (c < ng) rowp[c] = acc[ai][0][m][n][j]; } }
        }
    }
};
struct EpiRes {
    static constexpr bool PERM = false, AFTER_DRAIN = false;
    const float* srcC; const float* srcL; float* dstC; float* dstL; const float* gate  ; int row_off;
    __device__ __forceinline__ void operator()(const f32x4 (&acc)[2][2][4][2], const Unit& u, int wr, int wc, int fr, int fq) const {
        const int grow_t = u.pm * BM + row_off;
        const bool isc = grow_t < 512;
        const int mr = isc ? 2 : ((grow_t - 512) >> 14);
        const float* sp = isc ? srcC + (size_t)grow_t * 2048 : srcL + (size_t)(grow_t - 512) * 2048;
        float* dp = isc ? dstC + (size_t)grow_t * 2048 : dstL + (size_t)(grow_t - 512) * 2048;
        const int lrow0 = wr * 64 + fr, col0 = u.pn * BM + wc * 32 + 4 * fq;
        const float* gp = gate + (size_t)mr * 12288 + col0;
        f32x4 gv[2][2];
#pragma unroll
        for (int bj = 0; bj < 2; ++bj)
#pragma unroll
            for (int n = 0; n < 2; ++n) gv[bj][n] = *(const f32x4*)(gp + bj * HALF + n * 16);
#pragma unroll
        for (int ai = 0; ai < 2; ++ai)
#pragma unroll
            for (int m = 0; m < 4; ++m) { const size_t off = (size_t)(lrow0 + ai * HALF + m * 16) * 2048 + col0;
#pragma unroll
                for (int bj = 0; bj < 2; ++bj)
#pragma unroll
                    for (int n = 0; n < 2; ++n) { const f32x4 s = *(const f32x4*)(sp + off + bj * HALF + n * 16);
                        *(f32x4*)(dp + off + bj * HALF + n * 16) = s + gv[bj][n] * acc[ai][bj][m][n]; } }
    }
};
struct EpiSwiglu {
    static constexpr bool PERM = true, AFTER_DRAIN = false;
    bf16_t* O; int ldo;
    __device__ __forceinline__ void operator()(const f32x4 (&acc)[2][2][4][2], const Unit& u, int wr, int wc, int fr, int fq) const {
        const int row0 = u.pm * BM + wr * 64 + fr, col0 = u.pn * HALF + wc * 32 + 8 * fq;
#pragma unroll
        for (int ai = 0; ai < 2; ++ai)
#pragma unroll
            for (int m = 0; m < 4; ++m) { float r[8];
#pragma unroll
                for (int n = 0; n < 2; ++n)
#pragma unroll
                    for (int j = 0; j < 4; ++j) { const float gg = acc[ai][0][m][n][j], uu = acc[ai][1][m][n][j]; r[n * 4 + j] = gg * __builtin_amdgcn_rcpf(1.f + __expf(-gg)) * uu; }
                u32x4 w; w.x = cvt_pk_bf16(r[0], r[1]); w.y = cvt_pk_bf16(r[2], r[3]); w.z = cvt_pk_bf16(r[4], r[5]); w.w = cvt_pk_bf16(r[6], r[7]);
                *(u32x4*)(O + (size_t)(row0 + ai * HALF + m * 16) * ldo + col0) = w; }
    }
};

template <class Epi, class Sched>
__device__ __forceinline__ void gemm_phase(PG8_LAS unsigned char* lds, const Gemm g, const Sched& S, const Epi& E) {
    int tid = threadIdx.x; asm volatile("" : "+v"(tid)); const int wid = __builtin_amdgcn_readfirstlane(tid >> 6), lane = tid & 63, wr = wid >> 2, wc = wid & 3, fr = lane & 15, fq = lane >> 4;
    const int K = g.K, nt = K / BK;
    unsigned voffA[2], voffB[2];
#pragma unroll
    for (int i = 0; i < 2; ++i) { int R, C; stage_rc(tid * 16 + i * 8192, R, C); const int Rb = Epi::PERM ? ((R & ~31) + perm32(R & 31)) : R;
        voffA[i] = (unsigned)(R * K + C) * 2u; voffB[i] = (unsigned)(Rb * K + C) * 2u; }
    const size_t kstep = (size_t)(BK * 2);
    const size_t hstep = (size_t)HALF * K * 2;
    const size_t tstep = 2 * hstep;
    const unsigned ldsw = (unsigned)wid * 1024u;
    const int aoff = lds_byte(wr * 64 + fr, fq * 8), boff = lds_byte(wc * 32 + fr, fq * 8);
#define PG8_SA(b, h) (((b) * 2 + (h)) * HTB)
#define PG8_SB(b, h) ((4 + (b) * 2 + (h)) * HTB)
#define PG8_STAGE(bufoff, gbase, voff) do { _Pragma("unroll") for (int _i = 0; _i < 2; ++_i) \
        __builtin_amdgcn_global_load_lds((const unsigned*)((const char*)(gbase) + (voff)[_i]), (PG8_LAS unsigned*)(lds + (bufoff) + ldsw + _i * 8192), 16, 0, 0); } while (0)
#define PG8_LDA(dst, b, h) do { _Pragma("unroll") for (int m = 0; m < 4; ++m) _Pragma("unroll") for (int k = 0; k < 2; ++k) dst[m][k] = *(const PG8_LAS bf16x8*)(lds + PG8_SA(b, h) + aoff + m * 2048 + k * 1024); } while (0)
#define PG8_LDB(dst, b, h) do { _Pragma("unroll") for (int n = 0; n < 2; ++n) _Pragma("unroll") for (int k = 0; k < 2; ++k) dst[n][k] = *(const PG8_LAS bf16x8*)(lds + PG8_SB(b, h) + boff + n * 2048 + k * 1024); } while (0)
#define PG8_MMA(ai, bj, At, Bt) do { __builtin_amdgcn_s_setprio(1); _Pragma("unroll") for (int m = 0; m < 4; ++m) _Pragma("unroll") for (int n = 0; n < 2; ++n) _Pragma("unroll") for (int k = 0; k < 2; ++k) \
        acc[ai][bj][m][n] = __builtin_amdgcn_mfma_f32_16x16x32_bf16(Bt[n][k], At[m][k], acc[ai][bj][m][n], 0, 0, 0); __builtin_amdgcn_s_setprio(0); } while (0)
#define PG8_WAIT_V(n) asm volatile("s_waitcnt vmcnt(" #n ")" ::: "memory")
#define PG8_WAIT_L(n) asm volatile("s_waitcnt lgkmcnt(" #n ")" ::: "memory")
#define PG8_BAR __builtin_amdgcn_s_barrier()
#define PG8_SCHED __builtin_amdgcn_sched_barrier(0)
    Unit cur, nxt; int ui = 0;
    if (!S.next(0, cur)) return;
    f32x4 acc[2][2][4][2];
#pragma unroll
    for (int a = 0; a < 2; ++a)
#pragma unroll
        for (int b = 0; b < 2; ++b)
#pragma unroll
            for (int m = 0; m < 4; ++m)
#pragma unroll
                for (int n = 0; n < 2; ++n) acc[a][b][m][n] = (f32x4){0.f, 0.f, 0.f, 0.f};
    bf16x8 At[4][2], B0[2][2], B1[2][2];
    const char* cA = (const char*)g.A + (size_t)cur.pm * tstep; const char* cB = (const char*)g.Bt + (size_t)cur.pn * tstep;
    S.a_ready(cur);
    PG8_STAGE(PG8_SB(0, 0), cB, voffB); PG8_STAGE(PG8_SA(0, 0), cA, voffA); PG8_STAGE(PG8_SB(0, 1), cB + hstep, voffB); PG8_STAGE(PG8_SA(0, 1), cA + hstep, voffA);
    if (wr == 1) PG8_BAR;
    PG8_WAIT_V(4); PG8_BAR;
    PG8_STAGE(PG8_SB(1, 0), cB + kstep, voffB); PG8_STAGE(PG8_SA(1, 0), cA + kstep, voffA); PG8_STAGE(PG8_SB(1, 1), cB + hstep + kstep, voffB);
    PG8_WAIT_V(6); PG8_BAR;
    for (;;) {
        const bool has_next = S.next(ui + 1, nxt);
        const char* nA = has_next ? (const char*)g.A + (size_t)nxt.pm * tstep : cA; const char* nB = has_next ? (const char*)g.Bt + (size_t)nxt.pn * tstep : cB;
        for (int t = 0; t < nt; t += 2) {
            const bool last = (t == nt - 2);
            const char* a1 = cA + (size_t)(t + 1) * kstep;
            const char* a2 = last ? nA : cA + (size_t)(t + 2) * kstep; const char* b2 = last ? nB : cB + (size_t)(t + 2) * kstep;
            const char* a3 = a2 + kstep; const char* b3 = b2 + kstep;
            if (last && has_next) S.a_ready(nxt);
            PG8_LDB(B0, 0, 0); PG8_SCHED; PG8_LDA(At, 0, 0); PG8_STAGE(PG8_SA(1, 1), a1 + hstep, voffA);
            PG8_WAIT_L(8); PG8_BAR; PG8_WAIT_L(0); PG8_MMA(0, 0, At, B0); PG8_BAR; PG8_SCHED;
            PG8_LDB(B1, 0, 1); PG8_STAGE(PG8_SB(0, 0), b2, voffB);
            PG8_BAR; PG8_WAIT_L(0); PG8_MMA(0, 1, At, B1); PG8_BAR;
            PG8_LDA(At, 0, 1); PG8_STAGE(PG8_SA(0, 0), a2, voffA);
            PG8_BAR; PG8_WAIT_L(0); PG8_MMA(1, 0, At, B0); PG8_BAR; PG8_SCHED;
            PG8_STAGE(PG8_SB(0, 1), b2 + hstep, voffB);
            PG8_WAIT_V(6); PG8_BAR; PG8_MMA(1, 1, At, B1); PG8_BAR;
            PG8_LDB(B0, 1, 0); PG8_SCHED; PG8_LDA(At, 1, 0); PG8_STAGE(PG8_SA(0, 1), a2 + hstep, voffA);
            PG8_WAIT_L(8); PG8_BAR; PG8_WAIT_L(0); PG8_MMA(0, 0, At, B0); PG8_BAR; PG8_SCHED;
            PG8_LDB(B1, 1, 1); PG8_STAGE(PG8_SB(1, 0), b3, voffB);
            PG8_BAR; PG8_WAIT_L(0); PG8_MMA(0, 1, At, B1); PG8_BAR;
            PG8_LDA(At, 1, 1); PG8_STAGE(PG8_SA(1, 0), a3, voffA);
            PG8_BAR; PG8_WAIT_L(0); PG8_MMA(1, 0, At, B0); PG8_BAR; PG8_SCHED;
            PG8_STAGE(PG8_SB(1, 1), b3 + hstep, voffB);
            PG8_WAIT_V(6); PG8_BAR; PG8_MMA(1, 1, At, B1); PG8_BAR;
        }
        if constexpr (!Epi::AFTER_DRAIN) { E(acc, cur, wr, wc, fr, fq); S.done(cur); }
        if (!has_next) break;
#pragma unroll
        for (int a = 0; a < 2; ++a)
#pragma unroll
            for (int b = 0; b < 2; ++b)
#pragma unroll
                for (int m = 0; m < 4; ++m)
#pragma unroll
                    for (int n = 0; n < 2; ++n) acc[a][b][m][n] = (f32x4){0.f, 0.f, 0.f, 0.f};
        cur = nxt; cA = nA; cB = nB; ++ui;
    }
    PG8_WAIT_V(0);
    if (wr == 0) PG8_BAR;
    PG8_BAR;
    if constexpr (Epi::AFTER_DRAIN) { E.fused(acc, cur, wr, wc, fr, fq, lds, wid, lane); S.done(cur); }
#undef PG8_SA
#undef PG8_SB
#undef PG8_STAGE
#undef PG8_LDA
#undef PG8_LDB
#undef PG8_MMA
#undef PG8_WAIT_V
#undef PG8_WAIT_L
#undef PG8_BAR
#undef PG8_SCHED
}
}

__device__ __forceinline__ void ph_adaln_partials(const Params& p, float* sm) {
    const int tid = tid_fresh();
    float* MODP = (float*)(p.ws + WS_MODP);
    for (int it = blockIdx.x; it < 384; it += gridDim.x) {
        const int l = it / 192, rem = it % 192, kc = rem / 6, cgp = rem % 6;
        __syncthreads();
        if (tid < 192) { const int r = tid >> 6, kk = tid & 63, k = kc * 64 + kk; const float cv = (r < 2) ? p.c[r * 2048 + k] : p.c_ctx[k]; sm[tid] = siluf_(cv); }
        __syncthreads();
        const int col = cgp * 2048 + tid * 4;
        float4 a0 = {0.f, 0.f, 0.f, 0.f}, a1 = a0, a2 = a0;
        const float* wp = p.mod_w + ((size_t)l * 2048 + (size_t)kc * 64) * 12288 + col;
#pragma unroll 8
        for (int kk = 0; kk < 64; ++kk) {
            const float4 w = *(const float4*)(wp + (size_t)kk * 12288);
            const float s0 = sm[kk], s1 = sm[64 + kk], s2 = sm[128 + kk];
            a0.x += s0 * w.x; a0.y += s0 * w.y; a0.z += s0 * w.z; a0.w += s0 * w.w;
            a1.x += s1 * w.x; a1.y += s1 * w.y; a1.z += s1 * w.z; a1.w += s1 * w.w;
            a2.x += s2 * w.x; a2.y += s2 * w.y; a2.z += s2 * w.z; a2.w += s2 * w.w;
        }
        float* o = MODP + ((size_t)(l * 32 + kc) * 3) * 12288 + col;
        *(float4*)(o) = a0; *(float4*)(o + 12288) = a1; *(float4*)(o + 2 * 12288) = a2;
    }
}
__device__ __forceinline__ void ph_adaln_reduce(const Params& p) {
    const float* MODP = (const float*)(p.ws + WS_MODP); float* MOD = (float*)(p.ws + WS_MOD);
    for (int idx = blockIdx.x * NTHR + tid_fresh(); idx < 2 * 3 * 12288; idx += gridDim.x * NTHR) {
        const int l = idx / 36864, r = (idx / 12288) % 3, col = idx % 12288;
        float s = p.mod_b[l * 12288 + col];
        for (int kc = 0; kc < 32; ++kc) s += MODP[((size_t)(l * 32 + kc) * 3 + r) * 12288 + col];
        MOD[idx] = s;
    }
}

template <int MODE> __device__ __forceinline__ int colmap(int n, int nsrc) {
    if (MODE == 0) return n < nsrc ? n : -1;
    if (MODE == 1) { if (n < 3072) return n; if (n < 7168) return n + 16; if (n < 7184) return 3072 + (n - 7168); if (n < 7216) return n; return -1; }
    return ((n >> 7) & 1) * 5632 + (n >> 8) * 128 + (n & 127);
}
template <int MODE> __device__ __forceinline__ void ph_convert(const float* W, int nsrc, int K, int nout, u16* Bt, float* sm) {
    const int tid = tid_fresh(); const int nnt = nout / 64, ntiles = nnt * (K / 64);
    for (int t = blockIdx.x; t < ntiles; t += gridDim.x) {
        const int k0 = (t / nnt) * 64, n0 = (t % nnt) * 64;
        __syncthreads();
#pragma unroll
        for (int i = 0; i < 8; ++i) { const int idx = i * NTHR + tid, kk = idx >> 6, nn = idx & 63; const int src = colmap<MODE>(n0 + nn, nsrc);
            sm[kk * 65 + nn] = src >= 0 ? W[(size_t)(k0 + kk) * nsrc + src] : 0.f; }
        __syncthreads();
        { const int nn = tid >> 3, k8 = (tid & 7) * 8; float v[8];
#pragma unroll
            for (int j = 0; j < 8; ++j) v[j] = sm[(k8 + j) * 65 + nn];
            *(uint4*)(Bt + (size_t)(n0 + nn) * K + k0 + k8) = pack8(v); }
    }
}

__device__ __forceinline__ void ph_norm(const float* srcC, const float* srcL, const float* g, const float* modl, int chunk_sh, int chunk_sc, u16* H, int row_begin) {
    const int tid_ = tid_fresh(); const int lane = tid_ & 63, w = tid_ >> 6;
    for (int row = row_begin + blockIdx.x * 8 + w; row < MTOT; row += gridDim.x * 8) {
        const float* src = row < 512 ? srcC + (size_t)row * 2048 : srcL + (size_t)(row - 512) * 2048;
        const int mr = row < 512 ? 2 : ((row - 512) >> 14);
        const float* sc = modl + (mr * 6 + chunk_sc) * 2048; const float* sh = modl + (mr * 6 + chunk_sh) * 2048;
        float4 v[8]; float ss = 0.f;
#pragma unroll
        for (int i = 0; i < 8; ++i) { v[i] = *(const float4*)(src + i * 256 + lane * 4); ss += v[i].x * v[i].x + v[i].y * v[i].y + v[i].z * v[i].z + v[i].w * v[i].w; }
        ss = red64(ss);
        const float rstd = rsqrtf(ss * (1.f / 2048.f) + 1e-6f);
#pragma unroll
        for (int i = 0; i < 8; ++i) { const int col = i * 256 + lane * 4;
            const float4 g4 = *(const float4*)(g + col), s4 = *(const float4*)(sc + col), h4 = *(const float4*)(sh + col);
            const float y0 = v[i].x * rstd * g4.x * (1.f + s4.x) + h4.x, y1 = v[i].y * rstd * g4.y * (1.f + s4.y) + h4.y;
            const float y2 = v[i].z * rstd * g4.z * (1.f + s4.z) + h4.z, y3 = v[i].w * rstd * g4.w * (1.f + s4.w) + h4.w;
            uint2 o; o.x = cvt_pk_bf16(y0, y1); o.y = cvt_pk_bf16(y2, y3);
            *(uint2*)(H + (size_t)row * 2048 + col) = o; }
    }
}
__device__ __forceinline__ void ph_final_norm(const Params& p) {
    const int tid_ = tid_fresh(); const int lane = tid_ & 63, w = tid_ >> 6;
    for (int row = blockIdx.x * 8 + w; row < MLAT; row += gridDim.x * 8) {
        float* src = p.out + (size_t)row * 2048;
        float4 v[8]; float ss = 0.f;
#pragma unroll
        for (int i = 0; i < 8; ++i) { v[i] = *(const float4*)(src + i * 256 + lane * 4); ss += v[i].x * v[i].x + v[i].y * v[i].y + v[i].z * v[i].z + v[i].w * v[i].w; }
        ss = red64(ss);
        const float rstd = rsqrtf(ss * (1.f / 2048.f) + 1e-6f);
#pragma unroll
        for (int i = 0; i < 8; ++i) { const int col = i * 256 + lane * 4; const float4 g4 = *(const float4*)(p.final_norm_g + col);
            float4 o; o.x = v[i].x * rstd * g4.x; o.y = v[i].y * rstd * g4.y; o.z = v[i].z * rstd * g4.z; o.w = v[i].w * rstd * g4.w;
            *(float4*)(src + col) = o; }
    }
}

__device__ __forceinline__ void ph_l0_prep(const Params& p, float* sm) {
    const int tid = tid_fresh();
    u16* PROJ = (u16*)(p.ws + WS_PROJ); u16* CQ = (u16*)(p.ws + WS_CQ); float* G = (float*)(p.ws + WS_G);
    for (int idx = blockIdx.x * NTHR + tid; idx < MTOT * 48; idx += gridDim.x * NTHR) {
        const int j = idx % 48; const float v = G[idx]; float o;
        if (j < 8) o = v + p.ml_ig_b[j];
        else if (j < 16) o = logsigmoidf_(v + p.ml_fg_b[j - 8]);
        else if (j < 32) { const float dt = softplusf_(v + p.dn_dt_bias[j - 16]); o = -__expf(p.dn_a_log[j - 16]) * dt; }
        else o = sigmoidf_(v);
        G[idx] = o;
    }
    for (int t = blockIdx.x; t < 520 * 24; t += gridDim.x) {
        const int tt = t / 24, part = t % 24;
        const bool isctx = tt < 8;
        const int t0 = isctx ? (tt & 3) * 64 : 0;
        const int rowbase = isctx ? (tt >> 2) * 256 + t0 : 512 + (tt - 8) * 64;
        __syncthreads();
        for (int ch = tid; ch < 68 * 16; ch += NTHR) {
            const int rr = ch >> 4, c8 = (ch & 15) * 8, r = rr - 2;
            const bool ok = isctx ? (t0 + r >= 0 && t0 + r < 256) : (r >= 0 && r < 64);
            float f[8];
#pragma unroll
            for (int j = 0; j < 8; ++j) f[j] = 0.f;
            if (ok) { const uint4 u = *(const uint4*)(PROJ + (size_t)(rowbase + r) * NP0 + 3072 + part * 128 + c8); unpack8(u, f); }
            float* d = sm + rr * 132 + c8;
            *(float4*)(d) = make_float4(f[0], f[1], f[2], f[3]); *(float4*)(d + 4) = make_float4(f[4], f[5], f[6], f[7]);
        }
        __syncthreads();
        const int tk = tid >> 3, cs = (tid & 7) * 16;
        float o[16];
#pragma unroll
        for (int c = 0; c < 16; ++c) o[c] = 0.f;
#pragma unroll
        for (int j = 0; j < 5; ++j) {
            const float* wr_ = p.dn_conv_w + j * 3072 + part * 128 + cs; const float* ir = sm + (tk + j) * 132 + cs;
#pragma unroll
            for (int c4 = 0; c4 < 4; ++c4) { const float4 w4 = *(const float4*)(wr_ + c4 * 4), i4 = *(const float4*)(ir + c4 * 4);
                o[c4 * 4 + 0] += i4.x * w4.x; o[c4 * 4 + 1] += i4.y * w4.y; o[c4 * 4 + 2] += i4.z * w4.z; o[c4 * 4 + 3] += i4.w * w4.w; }
        }
        float ss = 0.f;
#pragma unroll
        for (int c = 0; c < 16; ++c) { o[c] = siluf_(o[c]); ss += o[c] * o[c]; }
        ss = red8(ss);
        if (part < 16) { const float sc = rsqrtf(ss + 1e-6f);
#pragma unroll
            for (int c = 0; c < 16; ++c) o[c] *= sc; }
        if (part < 16) {
            const int rs = isctx ? 3072 : NP0; u16* tb = isctx ? CQ + (size_t)rowbase * 3072 + part * 128 : PROJ + (size_t)rowbase * NP0 + 3072 + part * 128;
            const int r0 = ((tk >> 4) * 4 + (cs >> 5)) * 4 + ((cs >> 3) & 3);
            *(uint4*)(tb + (size_t)r0 * rs + (tk & 15) * 8) = pack8(o); *(uint4*)(tb + (size_t)(r0 + 1) * rs + (tk & 15) * 8) = pack8(o + 8);
        } else {
            u16* dst = isctx ? CQ + (size_t)(rowbase + tk) * 3072 + part * 128 + cs : PROJ + (size_t)(rowbase + tk) * NP0 + 3072 + part * 128 + cs;
            *(uint4*)(dst) = pack8(o); *(uint4*)(dst + 8) = pack8(o + 8); }
    }
}

__device__ __forceinline__ void ph_l0_merge(const Params& p) {
    const int tid_ = tid_fresh(); const int lane = tid_ & 63, w = tid_ >> 6;
    const u16* PROJ = (const u16*)(p.ws + WS_PROJ); const u16* OF = (const u16*)(p.ws + WS_OF); const u16* OB = (const u16*)(p.ws + WS_OB); u16* Y = (u16*)(p.ws + WS_H);
    for (int row = blockIdx.x * 8 + w; row < MTOT; row += gridDim.x * 8) {
        const int col = lane * 32; const bool isml = lane < 32;
        const u16* gsrc = PROJ + (size_t)row * NP0 + (isml ? 2048 + col : 6144 + (col - 1024));
        const float* gn = isml ? p.ml_norm_g + col : p.dn_norm_g + (col - 1024);
        float o[32]; float ss = 0.f;
#pragma unroll
        for (int i = 0; i < 4; ++i) { float a[8], bb[8]; unpack8(*(const uint4*)(OF + (size_t)row * 2048 + col + i * 8), a); unpack8(*(const uint4*)(OB + (size_t)row * 2048 + col + i * 8), bb);
#pragma unroll
            for (int j = 0; j < 8; ++j) { o[i * 8 + j] = a[j] + bb[j]; ss += o[i * 8 + j] * o[i * 8 + j]; } }
        ss = red4(ss); const float s8 = ss + dppf<0x141>(ss);
        const float rstd = isml ? rsqrtf(s8 * (1.f / 256.f) + 1e-6f) : rsqrtf(ss * (1.f / 128.f) + 1e-6f);
#pragma unroll
        for (int i = 0; i < 4; ++i) { float gt[8], r[8]; unpack8(*(const uint4*)(gsrc + i * 8), gt);
#pragma unroll
            for (int j = 0; j < 8; ++j) { const float gate = isml ? sigmoidf_(gt[j]) : siluf_(gt[j]); r[j] = o[i * 8 + j] * rstd * gn[i * 8 + j] * gate; }
            *(uint4*)(Y + (size_t)row * 2048 + col + i * 8) = pack8(r); }
    }
}

typedef short bf16x8_t __attribute__((ext_vector_type(8)));
typedef float f32x4_t __attribute__((ext_vector_type(4)));
__device__ __forceinline__ float wave_cumsum(float x, int lane) {
#pragma unroll
    for (int o = 1; o < 64; o <<= 1) { const float t = __shfl_up(x, o); if (lane >= o) x += t; }
    return x; }
__device__ __forceinline__ float wave_cummax(float x, int lane) {
#pragma unroll
    for (int o = 1; o < 64; o <<= 1) { const float t = __shfl_up(x, o); if (lane >= o) x = fmaxf(x, t); }
    return x; }
__device__ __forceinline__ int tile_of(int n, int b, int dir) { if (n < 4) return b * 4 + (dir ? 3 - n : n); const int li = n - 4; return 8 + b * 256 + (dir ? 255 - li : li); }
__device__ __forceinline__ int rowbase_of(int tt) { return tt < 8 ? tt * 64 : 512 + (tt - 8) * 64; }

__device__ __forceinline__ void ml_prep_item(const Params& p, int it, float* wl, int lane) {
    const int h = it & 3, tt = (it >> 2) % 520, z = it / 2080, rowbase = rowbase_of(tt), fr = lane & 15, fq = lane >> 4;
    const u16* PROJ = (const u16*)(p.ws + WS_PROJ); const float* G = (const float*)(p.ws + WS_G);
    float* MLS = (float*)(p.ws + WS_MLS) + (size_t)it * 256; u16* ATT0 = (u16*)(p.ws + WS_ATT0) + (size_t)it * 4096;
    const int tk = z ? 63 - lane : lane, row = rowbase + tk;
    const float ig = G[row * 48 + z * 4 + h], lf = G[row * 48 + 8 + z * 4 + h];
    const float bb = wave_cumsum(lf, lane), gg = ig - bb, cm = wave_cummax(gg, lane);
    const float bL = __shfl(bb, 63), cmL = __shfl(cm, 63);
    MLS[tk] = bb; MLS[64 + tk] = cm; MLS[128 + tk] = __expf(gg - cmL); if (lane == 0) { MLS[192] = bL; MLS[193] = cmL; }
    wl[tk] = gg; wl[64 + tk] = cm;
#pragma unroll 1
    for (int rt = 0; rt < 4; ++rt) {
        bf16x8_t a[4];
#pragma unroll
        for (int ks = 0; ks < 4; ++ks) a[ks] = *(const bf16x8_t*)(PROJ + (size_t)(rowbase + (rt * 4 + ks) * 4 + fq) * NP0 + h * 128 + fr * 8);
#pragma unroll 1
        for (int ct = 0; ct < 4; ++ct) {
            f32x4_t acc = (f32x4_t){0.f, 0.f, 0.f, 0.f};
#pragma unroll
            for (int ks = 0; ks < 4; ++ks) { const bf16x8_t bfr = *(const bf16x8_t*)(PROJ + (size_t)(rowbase + (ct * 4 + ks) * 4 + fq) * NP0 + 512 + h * 128 + fr * 8);
                acc = __builtin_amdgcn_mfma_f32_16x16x32_bf16(a[ks], bfr, acc, 0, 0, 0); }
            const int s = ct * 16 + fr; const float gs = wl[s];
#pragma unroll
            for (int j = 0; j < 4; ++j) { const int l = rt * 16 + fq * 4 + j; const bool keep = z ? (s >= l) : (s <= l);
                const float e = __expf(fminf(gs - wl[64 + l], 0.f));
                ATT0[(((l >> 4) * 2 + (s >> 5)) * 64 + ((s >> 3) & 3) * 16 + (l & 15)) * 8 + (s & 7)] = f2bf(keep ? acc[j] * 0.08838834764831845f * e : 0.f); }
        }
    }
}
__device__ __forceinline__ void dn_prep_item(const Params& p, int it, float* Ap, int lane) {
    const int h = it & 7, tt = (it >> 3) % 520, z = it / 4160, rowbase = rowbase_of(tt), fr = lane & 15, fq = lane >> 4;
    const bool isctx = tt < 8;
    const u16* qb = isctx ? (const u16*)(p.ws + WS_CQ) + (size_t)rowbase * 3072 + h * 128 : (const u16*)(p.ws + WS_PROJ) + (size_t)rowbase * NP0 + 3072 + h * 128;
    const int rs = isctx ? 3072 : NP0;
    const float* G = (const float*)(p.ws + WS_G);
    float* GCS = (float*)(p.ws + WS_GCS) + (size_t)it * 256; u16* TM = (u16*)(p.ws + WS_TM) + (size_t)it * 4096; u16* QK = (u16*)(p.ws + WS_QK) + (size_t)it * 4096;
    float* gcs = Ap + 4096; float* bes = Ap + 4160;
    const int tk = z ? 63 - lane : lane, row = rowbase + tk;
    const float g = G[row * 48 + 16 + z * 8 + h], be = G[row * 48 + 32 + z * 8 + h];
    const float gc = wave_cumsum(g, lane), gL = __shfl(gc, 63);
    GCS[tk] = __expf(gc); GCS[64 + tk] = be; GCS[128 + tk] = __expf(gL - gc); if (lane == 0) GCS[192] = __expf(gL);
    gcs[tk] = gc; bes[tk] = be;
#pragma unroll 1
    for (int rt = 0; rt < 4; ++rt) {
        bf16x8_t ak[4], aq[4];
#pragma unroll
        for (int ks = 0; ks < 4; ++ks) { ak[ks] = *(const bf16x8_t*)(qb + (size_t)((rt * 4 + ks) * 4 + fq) * rs + 1024 + fr * 8); aq[ks] = *(const bf16x8_t*)(qb + (size_t)((rt * 4 + ks) * 4 + fq) * rs + fr * 8); }
#pragma unroll 1
        for (int ct = 0; ct < 4; ++ct) {
            f32x4_t ck = (f32x4_t){0.f, 0.f, 0.f, 0.f}, cq = ck;
#pragma unroll
            for (int ks = 0; ks < 4; ++ks) { const bf16x8_t bfr = *(const bf16x8_t*)(qb + (size_t)((ct * 4 + ks) * 4 + fq) * rs + 1024 + fr * 8);
                ck = __builtin_amdgcn_mfma_f32_16x16x32_bf16(ak[ks], bfr, ck, 0, 0, 0); cq = __builtin_amdgcn_mfma_f32_16x16x32_bf16(aq[ks], bfr, cq, 0, 0, 0); }
            const int s = ct * 16 + fr; const float gs = gcs[s];
#pragma unroll
            for (int j = 0; j < 4; ++j) { const int l = rt * 16 + fq * 4 + j;
                const bool strict = z ? (s > l) : (s < l), incl = z ? (s >= l) : (s <= l);
                const float e = __expf(fminf(gcs[l] - gs, 0.f));
                const int lp = z ? 63 - l : l, sp = z ? 63 - s : s;
                Ap[lp * 64 + sp] = strict ? bes[l] * ck[j] * e : 0.f;
                QK[(((l >> 4) * 2 + (s >> 5)) * 64 + ((s >> 3) & 3) * 16 + (l & 15)) * 8 + (s & 7)] = f2bf(incl ? cq[j] * 0.08838834764831845f * e : 0.f); }
        }
    }
    Ap[lane] = (lane == 0) ? 1.f : 0.f;
#pragma unroll 1
    for (int i = 1; i < 64; ++i) {
        float t = (i == lane) ? 1.f : 0.f;
#pragma unroll 4
        for (int j = 0; j < i; ++j) t -= Ap[i * 64 + j] * Ap[j * 64 + lane];
        Ap[i * 64 + lane] = t;
    }
    const int sc = z ? 63 - lane : lane;
#pragma unroll 4
    for (int i = 0; i < 64; ++i) { const int l = z ? 63 - i : i; TM[(((l >> 4) * 2 + (sc >> 5)) * 64 + ((sc >> 3) & 3) * 16 + (l & 15)) * 8 + (sc & 7)] = f2bf(Ap[i * 64 + lane]); }
}
__device__ __forceinline__ void ph_l0_prepass(const Params& p, unsigned char* lds) {
    const int tid = tid_fresh(), lane = tid & 63, w = tid >> 6;
    float* wl = (float*)(lds + (size_t)w * 16896);
    const int gw = blockIdx.x * 8 + w, nw = gridDim.x * 8;
    for (int it = gw; it < 4160; it += nw) ml_prep_item(p, it, wl, lane);
    for (int it = gw; it < 8320; it += nw) dn_prep_item(p, it, wl, lane);
}

__device__ __forceinline__ unsigned ml_touch(const Params& p, int n, int b, int h, int dir, int e0, int tid) {
    const int nn = n < NSEG ? n : NSEG - 1;
    const int tt = tile_of(nn, b, dir), it = (dir * 520 + tt) * 4 + h, rowbase = rowbase_of(tt);
    const u16* PROJ = (const u16*)(p.ws + WS_PROJ);
    const u16* a;
    if (tid < 256) a = PROJ + (size_t)(rowbase + ((tid & 127) >> 1)) * NP0 + (tid >> 7) * 512 + h * 128 + (tid & 1) * 64;
    else if (tid < 320) a = PROJ + (size_t)(rowbase + tid - 256) * NP0 + 1024 + h * 256 + e0;
    else if (tid < 384) a = (const u16*)(p.ws + WS_ATT0) + (size_t)it * 4096 + (tid - 320) * 64;
    else a = (const u16*)(p.ws + WS_MLS) + (size_t)it * 512 + ((tid - 384) & 7) * 64;
    return *(const unsigned*)a;
}
struct MlFr { bf16x8_t q[4], at[2]; uint4 kr[2]; uint2 vr; float kw, b[4], cm[4], bL, cmL; };
__device__ __forceinline__ void ml_load(MlFr& F, const Params& p, int n, int b, int h, int dir, int e0, int lt, int fr, int fq, int tl, int seg) {
    const int nn = n < NSEG ? n : NSEG - 1;
    const int tt = tile_of(nn, b, dir), it = (dir * 520 + tt) * 4 + h, rowbase = rowbase_of(tt);
    const u16* PROJ = (const u16*)(p.ws + WS_PROJ);
    const u16* Q = PROJ + (size_t)(rowbase + lt * 16 + fq) * NP0 + h * 128 + fr * 8;
    const u16* AT = (const u16*)(p.ws + WS_ATT0) + (size_t)it * 4096 + lt * 1024 + (fq * 16 + fr) * 8;
    const float* MLS = (const float*)(p.ws + WS_MLS) + (size_t)it * 256;
#pragma unroll
    for (int ks = 0; ks < 4; ++ks) F.q[ks] = *(const bf16x8_t*)(Q + (size_t)ks * 4 * NP0);
#pragma unroll
    for (int ks = 0; ks < 2; ++ks) F.at[ks] = *(const bf16x8_t*)(AT + ks * 512);
    const u16* kp = PROJ + (size_t)(rowbase + ((tl >> 4) * 4 + (seg >> 1)) * 4 + (seg & 1) * 2) * NP0 + 512 + h * 128 + (tl & 15) * 8;
    F.kr[0] = *(const uint4*)(kp); F.kr[1] = *(const uint4*)(kp + NP0);
    F.vr = *(const uint2*)(PROJ + (size_t)(rowbase + tl) * NP0 + 1024 + h * 256 + e0 + seg * 4);
    F.kw = MLS[128 + tl];
#pragma unroll
    for (int j = 0; j < 4; ++j) { F.b[j] = MLS[lt * 16 + fq * 4 + j]; F.cm[j] = MLS[64 + lt * 16 + fq * 4 + j]; }
    F.bL = MLS[192]; F.cmL = MLS[193];
}
__device__ __forceinline__ void mlstm_chunk(const Params& p, int job, unsigned char* lds) {
    const int tid = tid_fresh(), lane = tid & 63, w = tid >> 6, fr = lane & 15, fq = lane >> 4;
    const int chain = job >> 3, cgp = job & 7;
    const int b = chain >> 3, h = (chain >> 1) & 3, dir = chain & 1;
    const int e0 = cgp * 32, lt = w >> 1, et = w & 1, dt0 = (w >> 1) * 2, tl = tid & 63, seg = tid >> 6;
    u16* Cl = (u16*)lds;
    u16* Ktw = (u16*)(lds + 17952);
    u16* Vt = (u16*)(lds + 17952 + 18432);
    u16* O = (u16*)(p.ws + (dir ? WS_OB : WS_OF));
    __syncthreads();
    for (int i = tid; i < 17952 / 4; i += NTHR) ((unsigned*)Cl)[i] = 0u;
    __syncthreads();
    f32x4_t Cacc[2], nacc; Cacc[0] = (f32x4_t){0.f, 0.f, 0.f, 0.f}; Cacc[1] = Cacc[0]; nacc = Cacc[0];
    float m_in = 0.f;
    bf16x8_t ones;
#pragma unroll
    for (int j = 0; j < 8; ++j) ones[j] = (short)0x3F80;
    MlFr buf[2];
    ml_load(buf[0], p, 0, b, h, dir, e0, lt, fr, fq, tl, seg); ml_load(buf[1], p, 1, b, h, dir, e0, lt, fr, fq, tl, seg);
    unsigned pfr[4] = {0u, 0u, 0u, 0u}, sink = 0u;
    for (int n0 = 0; n0 < NSEG; n0 += 4) {
#pragma unroll
        for (int u = 0; u < 4; ++u) {
            const int n = n0 + u; const int s = u & 1;
            sink ^= pfr[u]; pfr[u] = ml_touch(p, n + 5, b, h, dir, e0, tid);
            const MlFr& F = buf[s];
            const int tt = tile_of(n, b, dir), rowbase = rowbase_of(tt);
            const u16* Ccur = Cl + (n & 1) * (33 * 136); u16* Cnxt = Cl + ((n + 1) & 1) * (33 * 136);
            { float k[16]; unpack8(F.kr[0], k); unpack8(F.kr[1], k + 8);
#pragma unroll
                for (int c = 0; c < 16; ++c) Ktw[(seg * 16 + c) * 72 + tl] = f2bf(k[c] * F.kw);
                Vt[(seg * 4 + 0) * 72 + tl] = (u16)(F.vr.x & 0xffffu); Vt[(seg * 4 + 1) * 72 + tl] = (u16)(F.vr.x >> 16);
                Vt[(seg * 4 + 2) * 72 + tl] = (u16)(F.vr.y & 0xffffu); Vt[(seg * 4 + 3) * 72 + tl] = (u16)(F.vr.y >> 16); }
            __syncthreads();
            bf16x8_t vt[2];
#pragma unroll
            for (int ks = 0; ks < 2; ++ks) vt[ks] = *(const bf16x8_t*)(Vt + (et * 16 + fr) * 72 + ks * 32 + fq * 8);
            {
                f32x4_t inter = (f32x4_t){0.f, 0.f, 0.f, 0.f}, intra = inter, dinter = inter, dintra = inter;
#pragma unroll
                for (int ks = 0; ks < 4; ++ks) { const bf16x8_t cb = *(const bf16x8_t*)(Ccur + (et * 16 + fr) * 136 + ks * 32 + fq * 8); const bf16x8_t nb = *(const bf16x8_t*)(Ccur + 32 * 136 + ks * 32 + fq * 8);
                    inter = __builtin_amdgcn_mfma_f32_16x16x32_bf16(F.q[ks], cb, inter, 0, 0, 0); dinter = __builtin_amdgcn_mfma_f32_16x16x32_bf16(F.q[ks], nb, dinter, 0, 0, 0); }
#pragma unroll
                for (int ks = 0; ks < 2; ++ks) { intra = __builtin_amdgcn_mfma_f32_16x16x32_bf16(F.at[ks], vt[ks], intra, 0, 0, 0); dintra = __builtin_amdgcn_mfma_f32_16x16x32_bf16(F.at[ks], ones, dintra, 0, 0, 0); }
#pragma unroll
                for (int j = 0; j < 4; ++j) { const float M = fmaxf(F.cm[j], m_in); const float r = __expf(F.cm[j] - M), ei = __expf(m_in - M) * 0.08838834764831845f;
                    const float num = r * intra[j] + ei * inter[j], den = r * dintra[j] + ei * dinter[j];
                    const float hv = num * frcp(fmaxf(fabsf(den), __expf(-(F.b[j] + M))));
                    O[(size_t)(rowbase + lt * 16 + fq * 4 + j) * 2048 + h * 256 + e0 + et * 16 + fr] = f2bf(hv); }
            }
            { const float ML = fmaxf(F.cmL, m_in); const float a = __expf(m_in - ML), sc2 = __expf(F.cmL - ML); m_in = F.bL + ML;
#pragma unroll
                for (int i = 0; i < 2; ++i) { f32x4_t nw = (f32x4_t){0.f, 0.f, 0.f, 0.f};
#pragma unroll
                    for (int ks = 0; ks < 2; ++ks) { const bf16x8_t kb = *(const bf16x8_t*)(Ktw + ((dt0 + i) * 16 + fr) * 72 + ks * 32 + fq * 8); nw = __builtin_amdgcn_mfma_f32_16x16x32_bf16(vt[ks], kb, nw, 0, 0, 0); }
#pragma unroll
                    for (int j = 0; j < 4; ++j) { Cacc[i][j] = a * Cacc[i][j] + sc2 * nw[j]; Cnxt[(et * 16 + fq * 4 + j) * 136 + (dt0 + i) * 16 + fr] = f2bf(Cacc[i][j]); } }
                f32x4_t nw = (f32x4_t){0.f, 0.f, 0.f, 0.f};
#pragma unroll
                for (int ks = 0; ks < 2; ++ks) { const bf16x8_t kb = *(const bf16x8_t*)(Ktw + (w * 16 + fr) * 72 + ks * 32 + fq * 8); nw = __builtin_amdgcn_mfma_f32_16x16x32_bf16(ones, kb, nw, 0, 0, 0); }
                nacc[0] = a * nacc[0] + sc2 * nw[0];
                if (fq == 0) Cnxt[32 * 136 + w * 16 + fr] = f2bf(nacc[0]); }
            __syncthreads();
            ml_load(buf[s], p, n + 2, b, h, dir, e0, lt, fr, fq, tl, seg);
        }
    }
    ((unsigned*)(p.ws + WS_MODP))[blockIdx.x * NTHR + tid] = sink ^ pfr[0] ^ pfr[1] ^ pfr[2] ^ pfr[3];
}

__device__ __forceinline__ unsigned dn_touch(const Params& p, int n, int b, int h, int dir, int e0, int tid) {
    const int nn = n < NSEG ? n : NSEG - 1;
    const int tt = tile_of(nn, b, dir), it = (dir * 520 + tt) * 8 + h, rowbase = rowbase_of(tt);
    const bool isctx = tt < 8;
    const u16* qb = isctx ? (const u16*)(p.ws + WS_CQ) + (size_t)rowbase * 3072 + h * 128 : (const u16*)(p.ws + WS_PROJ) + (size_t)rowbase * NP0 + 3072 + h * 128;
    const int rs = isctx ? 3072 : NP0;
    const u16* a;
    if (tid < 256) a = qb + (size_t)((tid & 127) >> 1) * rs + (tid >> 7) * 1024 + (tid & 1) * 64;
    else if (tid < 320) a = qb + (size_t)(tid - 256) * rs + 2048 + e0;
    else if (tid < 384) a = (const u16*)(p.ws + WS_TM) + (size_t)it * 4096 + (tid - 320) * 64;
    else if (tid < 448) a = (const u16*)(p.ws + WS_QK) + (size_t)it * 4096 + (tid - 384) * 64;
    else a = (const u16*)(p.ws + WS_GCS) + (size_t)it * 512 + ((tid - 448) & 7) * 64;
    return *(const unsigned*)a;
}
struct DnFr { bf16x8_t k[4], q[4], tm[2], qk[2]; uint4 kr[2]; float kds, egc[4], be[4], egL; u16 v[4]; };
__device__ __forceinline__ void dn_load(DnFr& F, const Params& p, int n, int b, int h, int dir, int e0, int lt, int et, int fr, int fq, int tl, int seg) {
    const int nn = n < NSEG ? n : NSEG - 1;
    const int tt = tile_of(nn, b, dir), it = (dir * 520 + tt) * 8 + h, rowbase = rowbase_of(tt);
    const bool isctx = tt < 8;
    const u16* qb = isctx ? (const u16*)(p.ws + WS_CQ) + (size_t)rowbase * 3072 + h * 128 : (const u16*)(p.ws + WS_PROJ) + (size_t)rowbase * NP0 + 3072 + h * 128;
    const int rs = isctx ? 3072 : NP0;
    const u16* TM = (const u16*)(p.ws + WS_TM) + (size_t)it * 4096 + lt * 1024 + (fq * 16 + fr) * 8;
    const u16* QK = (const u16*)(p.ws + WS_QK) + (size_t)it * 4096 + lt * 1024 + (fq * 16 + fr) * 8;
    const float* GCS = (const float*)(p.ws + WS_GCS) + (size_t)it * 256;
    const u16* qr = qb + (size_t)(lt * 16 + fq) * rs + fr * 8;
#pragma unroll
    for (int ks = 0; ks < 4; ++ks) { F.q[ks] = *(const bf16x8_t*)(qr + (size_t)ks * 4 * rs); F.k[ks] = *(const bf16x8_t*)(qr + (size_t)ks * 4 * rs + 1024); }
#pragma unroll
    for (int ks = 0; ks < 2; ++ks) { F.tm[ks] = *(const bf16x8_t*)(TM + ks * 512); F.qk[ks] = *(const bf16x8_t*)(QK + ks * 512); }
    const u16* kp = qb + (size_t)(((tl >> 4) * 4 + (seg >> 1)) * 4 + (seg & 1) * 2) * rs + 1024 + (tl & 15) * 8;
    F.kr[0] = *(const uint4*)(kp); F.kr[1] = *(const uint4*)(kp + rs);
    F.kds = GCS[128 + tl]; F.egL = GCS[192];
#pragma unroll
    for (int j = 0; j < 4; ++j) { const int l = lt * 16 + fq * 4 + j; F.egc[j] = GCS[l]; F.be[j] = GCS[64 + l]; F.v[j] = qb[(size_t)l * rs + 2048 + e0 + et * 16 + fr]; }
}
__device__ __forceinline__ void deltanet_chunk(const Params& p, int job, unsigned char* lds) {
    const int tid = tid_fresh(), lane = tid & 63, w = tid >> 6, fr = lane & 15, fq = lane >> 4;
    const int chain = job >> 2, cgp = job & 3;
    const int b = chain >> 4, h = (chain >> 1) & 7, dir = chain & 1;
    const int e0 = cgp * 32, lt = w >> 1, et = w & 1, dt0 = (w >> 1) * 2, tl = tid & 63, seg = tid >> 6;
    u16* Sl = (u16*)lds;
    u16* Rt = (u16*)(lds + 17408);
    u16* VNt = (u16*)(lds + 17408 + 4608);
    u16* Kdt = (u16*)(lds + 17408 + 9216);
    u16* O = (u16*)(p.ws + (dir ? WS_OB : WS_OF));
    __syncthreads();
    for (int i = tid; i < 17408 / 4; i += NTHR) ((unsigned*)Sl)[i] = 0u;
    __syncthreads();
    f32x4_t Sacc[2]; Sacc[0] = (f32x4_t){0.f, 0.f, 0.f, 0.f}; Sacc[1] = Sacc[0];
    DnFr buf[2];
    dn_load(buf[0], p, 0, b, h, dir, e0, lt, et, fr, fq, tl, seg); dn_load(buf[1], p, 1, b, h, dir, e0, lt, et, fr, fq, tl, seg);
    unsigned pfr[4] = {0u, 0u, 0u, 0u}, sink = 0u;
    for (int n0 = 0; n0 < NSEG; n0 += 4) {
#pragma unroll
        for (int u = 0; u < 4; ++u) {
            const int n = n0 + u; const int s = u & 1;
            sink ^= pfr[u]; pfr[u] = dn_touch(p, n + 5, b, h, dir, e0, tid);
            const DnFr& F = buf[s];
            const int tt = tile_of(n, b, dir), rowbase = rowbase_of(tt);
            const u16* Scur = Sl + (n & 1) * (32 * 136); u16* Snxt = Sl + ((n + 1) & 1) * (32 * 136);
            f32x4_t X = (f32x4_t){0.f, 0.f, 0.f, 0.f}, Y = X;
#pragma unroll
            for (int ks = 0; ks < 4; ++ks) { const bf16x8_t sb = *(const bf16x8_t*)(Scur + (et * 16 + fr) * 136 + ks * 32 + fq * 8);
                X = __builtin_amdgcn_mfma_f32_16x16x32_bf16(F.k[ks], sb, X, 0, 0, 0); Y = __builtin_amdgcn_mfma_f32_16x16x32_bf16(F.q[ks], sb, Y, 0, 0, 0); }
#pragma unroll
            for (int j = 0; j < 4; ++j) Rt[(et * 16 + fr) * 72 + lt * 16 + fq * 4 + j] = f2bf(F.be[j] * (bf2f(F.v[j]) - F.egc[j] * X[j]));
            { float k[16]; unpack8(F.kr[0], k); unpack8(F.kr[1], k + 8);
#pragma unroll
                for (int c = 0; c < 16; ++c) Kdt[(seg * 16 + c) * 72 + tl] = f2bf(k[c] * F.kds); }
            __syncthreads();
            { f32x4_t VN = (f32x4_t){0.f, 0.f, 0.f, 0.f};
#pragma unroll
                for (int ks = 0; ks < 2; ++ks) { const bf16x8_t rb = *(const bf16x8_t*)(Rt + (et * 16 + fr) * 72 + ks * 32 + fq * 8); VN = __builtin_amdgcn_mfma_f32_16x16x32_bf16(F.tm[ks], rb, VN, 0, 0, 0); }
#pragma unroll
                for (int j = 0; j < 4; ++j) VNt[(et * 16 + fr) * 72 + lt * 16 + fq * 4 + j] = f2bf(VN[j]); }
            __syncthreads();
            bf16x8_t vn[2];
#pragma unroll
            for (int ks = 0; ks < 2; ++ks) vn[ks] = *(const bf16x8_t*)(VNt + (et * 16 + fr) * 72 + ks * 32 + fq * 8);
            { f32x4_t acc = (f32x4_t){0.f, 0.f, 0.f, 0.f};
#pragma unroll
                for (int ks = 0; ks < 2; ++ks) acc = __builtin_amdgcn_mfma_f32_16x16x32_bf16(F.qk[ks], vn[ks], acc, 0, 0, 0);
#pragma unroll
                for (int j = 0; j < 4; ++j) O[(size_t)(rowbase + lt * 16 + fq * 4 + j) * 2048 + 1024 + h * 128 + e0 + et * 16 + fr] = f2bf(0.08838834764831845f * F.egc[j] * Y[j] + acc[j]); }
#pragma unroll
            for (int i = 0; i < 2; ++i) { f32x4_t nw = (f32x4_t){0.f, 0.f, 0.f, 0.f};
#pragma unroll
                for (int ks = 0; ks < 2; ++ks) { const bf16x8_t kb = *(const bf16x8_t*)(Kdt + ((dt0 + i) * 16 + fr) * 72 + ks * 32 + fq * 8); nw = __builtin_amdgcn_mfma_f32_16x16x32_bf16(vn[ks], kb, nw, 0, 0, 0); }
#pragma unroll
                for (int j = 0; j < 4; ++j) { Sacc[i][j] = F.egL * Sacc[i][j] + nw[j]; Snxt[(et * 16 + fq * 4 + j) * 136 + (dt0 + i) * 16 + fr] = f2bf(Sacc[i][j]); } }
            __syncthreads();
            dn_load(buf[s], p, n + 2, b, h, dir, e0, lt, et, fr, fq, tl, seg);
        }
    }
    ((unsigned*)(p.ws + WS_MODP))[blockIdx.x * NTHR + tid] = sink ^ pfr[0] ^ pfr[1] ^ pfr[2] ^ pfr[3];
}

constexpr int RG_XC = 65536;

__device__ __forceinline__ void ph_convert_rg(const Params& p) {
    u16* WRT = (u16*)(p.ws + WS_WRT);
    for (int idx = blockIdx.x * NTHR + tid_fresh(); idx < 65536; idx += gridDim.x * NTHR) {
        const int k8 = idx & 15, n = (idx >> 4) & 127, mzg = idx >> 11;
        const float* W = (mzg < 16 ? p.rg_w_r : p.rg_w_i) + (size_t)(mzg & 15) * 16384;
        float v[8];
#pragma unroll
        for (int j = 0; j < 8; ++j) v[j] = W[(k8 * 8 + j) * 128 + n];
        *(uint4*)(WRT + (size_t)mzg * 16384 + (((n >> 4) * 4 + (k8 >> 2)) * 64 + (k8 & 3) * 16 + (n & 15)) * 8) = pack8(v);
    }
}
__device__ __forceinline__ int rg_tau(int tt, int z) { if (tt < 8) { const int ci = tt & 3; return z ? 3 - ci : ci; } const int li = (tt - 8) & 255; return 4 + (z ? 255 - li : li); }
__device__ __forceinline__ int rg_batch(int tt) { return tt < 8 ? (tt >> 2) : ((tt - 8) >> 8); }

__device__ __forceinline__ void rg_conv(const Params& p, int tt, int g, unsigned char* lds) {
    const int tid = tid_fresh();
    const u16* PROJ = (const u16*)(p.ws + WS_PROJ);
    float* sm = (float*)lds; u16* XC = (u16*)(lds + RG_XC);
    const bool isctx = tt < 8;
    const int t0 = isctx ? (tt & 3) * 64 : 0;
    const int rowbase = isctx ? (tt >> 2) * 256 + t0 : 512 + (tt - 8) * 64;
    __syncthreads();
    for (int ch = tid; ch < 68 * 16; ch += NTHR) {
        const int rr = ch >> 4, c8 = (ch & 15) * 8, r = rr - 2;
        const bool ok = isctx ? (t0 + r >= 0 && t0 + r < 256) : (r >= 0 && r < 64);
        float f[8];
#pragma unroll
        for (int j = 0; j < 8; ++j) f[j] = 0.f;
        if (ok) { const uint4 u = *(const uint4*)(PROJ + (size_t)(rowbase + r) * NP1 + g * 128 + c8); unpack8(u, f); }
        float* d = sm + rr * 132 + c8;
        *(float4*)(d) = make_float4(f[0], f[1], f[2], f[3]); *(float4*)(d + 4) = make_float4(f[4], f[5], f[6], f[7]);
    }
    __syncthreads();
    const int tk = tid >> 3, cs = (tid & 7) * 16;
    float o[16];
#pragma unroll
    for (int c4 = 0; c4 < 4; ++c4) { const float4 b4 = *(const float4*)(p.rg_conv_b + g * 128 + cs + c4 * 4); o[c4 * 4] = b4.x; o[c4 * 4 + 1] = b4.y; o[c4 * 4 + 2] = b4.z; o[c4 * 4 + 3] = b4.w; }
#pragma unroll
    for (int j = 0; j < 5; ++j) {
        const float* wr_ = p.rg_conv_w + j * 1024 + g * 128 + cs; const float* ir = sm + (tk + j) * 132 + cs;
#pragma unroll
        for (int c4 = 0; c4 < 4; ++c4) { const float4 w4 = *(const float4*)(wr_ + c4 * 4), i4 = *(const float4*)(ir + c4 * 4);
            o[c4 * 4 + 0] += i4.x * w4.x; o[c4 * 4 + 1] += i4.y * w4.y; o[c4 * 4 + 2] += i4.z * w4.z; o[c4 * 4 + 3] += i4.w * w4.w; }
    }
    *(uint4*)(XC + tk * 136 + cs) = pack8(o); *(uint4*)(XC + tk * 136 + cs + 8) = pack8(o + 8);
    __syncthreads();
}
__device__ __forceinline__ void rg_gates_reg(const Params& p, int g, int z, const unsigned char* lds, int rt, int chh, int fr, int fq, float (&av)[4][4], float (&bx)[4][4]) {
    const u16* XC = (const u16*)(lds + RG_XC);
    const u16* WR = (const u16*)(p.ws + WS_WRT) + (size_t)((0 * 2 + z) * 8 + g) * 16384; const u16* WI = (const u16*)(p.ws + WS_WRT) + (size_t)((1 * 2 + z) * 8 + g) * 16384;
    f32x4_t R[4], I[4];
#pragma unroll
    for (int c = 0; c < 4; ++c) { R[c] = (f32x4_t){0.f, 0.f, 0.f, 0.f}; I[c] = (f32x4_t){0.f, 0.f, 0.f, 0.f}; }
#pragma unroll
    for (int ks = 0; ks < 4; ++ks) {
        const bf16x8_t a = *(const bf16x8_t*)(XC + (rt * 16 + fr) * 136 + ks * 32 + fq * 8);
#pragma unroll
        for (int c = 0; c < 4; ++c) { const int fo = (((chh * 4 + c) * 4 + ks) * 64 + fq * 16 + fr) * 8;
            R[c] = __builtin_amdgcn_mfma_f32_16x16x32_bf16(a, *(const bf16x8_t*)(WR + fo), R[c], 0, 0, 0);
            I[c] = __builtin_amdgcn_mfma_f32_16x16x32_bf16(a, *(const bf16x8_t*)(WI + fo), I[c], 0, 0, 0); }
    }
#pragma unroll
    for (int c = 0; c < 4; ++c) {
        const int chl = (chh * 4 + c) * 16 + fr, chg = z * 1024 + g * 128 + chl;
        const float br = p.rg_b_r[chg], bi = p.rg_b_i[chg], sp = softplusf_(-p.rg_lambda[chg]);
#pragma unroll
        for (int j = 0; j < 4; ++j) { const int t = rt * 16 + fq * 4 + j;
            const float r = sigmoidf_(R[c][j] + br), ii = sigmoidf_(I[c][j] + bi);
            const float la = -8.f * r * sp;
            av[c][j] = __expf(la); bx[c][j] = __builtin_amdgcn_sqrtf(neg_expm1_small(2.f * la)) * ii * bf2f(XC[t * 136 + chl]); }
    }
}
__device__ __forceinline__ float2 rg_local(const float (&a)[4], const float (&b)[4], int z) {
    float P = 1.f, H = 0.f;
#pragma unroll
    for (int i = 0; i < 4; ++i) { const int j = z ? 3 - i : i; H = a[j] * H + b[j]; P *= a[j]; }
    return make_float2(P, H);
}
__device__ __forceinline__ void gla_prep_item(const Params& p, int it, unsigned char* lds) {
    const int tid = tid_fresh(), lane = tid & 63, w = tid >> 6, fr = lane & 15, fq = lane >> 4;
    const int h = it & 3, tt = (it >> 2) % 520, z = it / 2080;
    const int rowbase = tt < 8 ? tt * 64 : 512 + (tt - 8) * 64;
    float* LG = (float*)lds;
    u16* QEs = (u16*)(lds + 32768);
    u16* KEs = (u16*)(lds + 32768 + 17408);
    u16* Vs = (u16*)(lds + 32768 + 2 * 17408);
    float* BLs = (float*)(lds + 32768 + 2 * 17408 + 33792);
    const u16* PROJ = (const u16*)(p.ws + WS_PROJ); const float* LR = (const float*)(p.ws + WS_G);
    u16* QE = (u16*)(p.ws + WS_QE); u16* KDT = (u16*)(p.ws + WS_KDT) + (size_t)it * 8192; u16* ATT = (u16*)(p.ws + WS_ATT) + (size_t)it * 4096;
    u16* VT = (u16*)(p.ws + WS_VT); float* EBL = (float*)(p.ws + WS_EBL);
    __syncthreads();
    { const int c = tid & 127, tq = tid >> 7; float wv[16];
#pragma unroll
        for (int r = 0; r < 16; ++r) wv[r] = p.gla_w_up[(z * 16 + r) * 512 + h * 128 + c];
        const float bu = p.gla_b_up[z * 512 + h * 128 + c];
        for (int i = 0; i < 16; ++i) { const int tk = tq * 16 + i; const float* lr = LR + (size_t)(rowbase + tk) * 32 + z * 16; float s = bu;
#pragma unroll
            for (int r = 0; r < 16; ++r) s += lr[r] * wv[r];
            LG[tk * 128 + c] = logsigmoidf_(s) * (1.f / 16.f); } }
    __syncthreads();
    if (tid < 128) { float acc = 0.f;
        for (int i = 0; i < 64; ++i) { const int tk = z ? 63 - i : i; acc += LG[tk * 128 + tid]; LG[tk * 128 + tid] = acc; }
        BLs[tid] = acc; EBL[(size_t)it * 128 + tid] = __expf(acc); }
    __syncthreads();
    { const int tk = tid >> 3, cs = (tid & 7) * 16; const u16* rp = PROJ + (size_t)(rowbase + tk) * NP1;
        float q[16], k[16], qe[16], ke[16];
        unpack8(*(const uint4*)(rp + 2048 + h * 128 + cs), q); unpack8(*(const uint4*)(rp + 2048 + h * 128 + cs + 8), q + 8);
        unpack8(*(const uint4*)(rp + 2560 + h * 128 + cs), k); unpack8(*(const uint4*)(rp + 2560 + h * 128 + cs + 8), k + 8);
#pragma unroll
        for (int c = 0; c < 16; ++c) { const float bb = LG[tk * 128 + cs + c], bl = BLs[cs + c];
            qe[c] = q[c] * 0.08838834764831845f * __expf(bb); ke[c] = k[c] * __expf(-bb);
            { const int d = cs + c; KDT[(((d >> 4) * 2 + (tk >> 5)) * 64 + ((tk >> 3) & 3) * 16 + (d & 15)) * 8 + (tk & 7)] = f2bf(k[c] * __expf(bl - bb)); } }
        const uint4 q0 = pack8(qe), q1 = pack8(qe + 8);
        *(uint4*)(QEs + tk * 136 + cs) = q0; *(uint4*)(QEs + tk * 136 + cs + 8) = q1;
        *(uint4*)(KEs + tk * 136 + cs) = pack8(ke); *(uint4*)(KEs + tk * 136 + cs + 8) = pack8(ke + 8);
        u16* qg = QE + (size_t)it * 8192 + (((tk >> 4) * 4 + (cs >> 5)) * 64 + ((cs >> 3) & 3) * 16 + (tk & 15)) * 8;
        *(uint4*)(qg) = q0; *(uint4*)(qg + 128) = q1; }
    if (z == 0) for (int ch = tid; ch < 2048; ch += NTHR) { const int tk = ch >> 5, c8 = (ch & 31) * 8;
        *(uint4*)(Vs + tk * 264 + c8) = *(const uint4*)(PROJ + (size_t)(rowbase + tk) * NP1 + 3072 + h * 256 + c8); }
    __syncthreads();
    { const int rt = w >> 1;
#pragma unroll
        for (int i = 0; i < 2; ++i) { const int ct = (w & 1) * 2 + i; f32x4_t acc = (f32x4_t){0.f, 0.f, 0.f, 0.f};
#pragma unroll
            for (int ks = 0; ks < 4; ++ks) { const bf16x8_t a = *(const bf16x8_t*)(QEs + (rt * 16 + fr) * 136 + ks * 32 + fq * 8); const bf16x8_t bb = *(const bf16x8_t*)(KEs + (ct * 16 + fr) * 136 + ks * 32 + fq * 8);
                acc = __builtin_amdgcn_mfma_f32_16x16x32_bf16(a, bb, acc, 0, 0, 0); }
#pragma unroll
            for (int j = 0; j < 4; ++j) { const int l = rt * 16 + fq * 4 + j, s = ct * 16 + fr; const bool keep = z ? (s >= l) : (s <= l);
                ATT[(((l >> 4) * 2 + (s >> 5)) * 64 + ((s >> 3) & 3) * 16 + (l & 15)) * 8 + (s & 7)] = f2bf(keep ? acc[j] : 0.f); } } }
    if (z == 0) { const int e = tid >> 1, hf = tid & 1; u16* dst = VT + (size_t)(tt * 4 + h) * 16384 + (((e >> 4) * 2 + hf) * 64 + (e & 15)) * 8;
#pragma unroll
        for (int l8 = 0; l8 < 4; ++l8) { float v[8];
#pragma unroll
            for (int j = 0; j < 8; ++j) v[j] = bf2f(Vs[(hf * 32 + l8 * 8 + j) * 264 + e]);
            *(uint4*)(dst + l8 * 128) = pack8(v); } }
}
__device__ __forceinline__ void ph_l1_a(const Params& p, unsigned char* lds, int parts = 3) {
    const int tid = tid_fresh(), lane = tid & 63, w = tid >> 6, rt = w >> 1, chh = w & 1, fr = lane & 15, fq = lane >> 4;
#ifdef PROBE3
    if (blockIdx.x == 100 && tid == 0) { unsigned long long* pr = (unsigned long long*)(p.ws + WS_MODP) + 500000; pr[0] = __builtin_amdgcn_s_memrealtime(); }
#endif
    float2* AGG = (float2*)(p.ws + WS_AGG);
    float2* AG = (float2*)lds;
    if (parts & 1) for (int t = blockIdx.x; t < 520 * 8; t += gridDim.x) {
        const int tt = t >> 3, g = t & 7, b = rg_batch(tt);
        rg_conv(p, tt, g, lds);
#pragma unroll
        for (int z = 0; z < 2; ++z) {
            float av[4][4], bx[4][4];
            rg_gates_reg(p, g, z, lds, rt, chh, fr, fq, av, bx);
#pragma unroll
            for (int c = 0; c < 4; ++c) AG[(z * 16 + rt * 4 + fq) * 128 + (chh * 4 + c) * 16 + fr] = rg_local(av[c], bx[c], z);
        }
        __syncthreads();
        if (tid < 256) { const int z = tid >> 7, ch = tid & 127; float P = 1.f, H = 0.f;
#pragma unroll
            for (int s = 0; s < 16; ++s) { const int gi = z ? 15 - s : s; const float2 ph = AG[(z * 16 + gi) * 128 + ch]; H = ph.x * H + ph.y; P *= ph.x; }
            AGG[((size_t)(b * 2 + z) * NSEG + rg_tau(tt, z)) * 1024 + g * 128 + ch] = make_float2(P, H); }
    }
#ifdef PROBE3
    __syncthreads(); const unsigned long long tm_ = __builtin_amdgcn_s_memrealtime();
#endif
    if (parts & 2) for (int it = blockIdx.x; it < 4160; it += gridDim.x) gla_prep_item(p, it, lds);
#ifdef PROBE3
    __syncthreads(); if (blockIdx.x == 100 && tid == 0) { unsigned long long* pr = (unsigned long long*)(p.ws + WS_MODP) + 500000; pr[1] = tm_; pr[2] = __builtin_amdgcn_s_memrealtime(); }
#endif
}
__device__ __forceinline__ void rg_pass_b(const Params& p, int job) {
    const float2* __restrict__ AGG = (const float2*)(p.ws + WS_AGG); float* __restrict__ CARRY = (float*)(p.ws + WS_CARRY);
    const int bz = job >> 1, ch = (job & 1) * 512 + tid_fresh();
    float carry = 0.f;
    for (int t0 = 0; t0 < NSEG; t0 += 20) {
        float2 ph[20];
#pragma unroll
        for (int i = 0; i < 20; ++i) ph[i] = AGG[((size_t)bz * NSEG + t0 + i) * 1024 + ch];
#pragma unroll
        for (int i = 0; i < 20; ++i) { CARRY[((size_t)bz * NSEG + t0 + i) * 1024 + ch] = carry; carry = ph[i].x * carry + ph[i].y; }
    }
}
struct GlaFr { bf16x8_t qe[4], at[2], vt[2], kd[2][2]; float eb[2]; };
struct GlaOff { int qe, at, vt, kd, eb, o, tch, tsel; };
__device__ __forceinline__ void gla_load(GlaFr& F, const unsigned char* ws, int n, int b, int h, int dir, const GlaOff& o) {
    const int nn = n < NSEG ? n : NSEG - 1;
    const int tt = tile_of(nn, b, dir), it = (dir * 520 + tt) * 4 + h, rowbase = rowbase_of(tt);
    const u16* QE = (const u16*)(ws + WS_QE) + (size_t)it * 8192;
    const u16* AT = (const u16*)(ws + WS_ATT) + (size_t)it * 4096;
    const u16* VT = (const u16*)(ws + WS_VT) + (size_t)(tt * 4 + h) * 16384;
    const u16* KD = (const u16*)(ws + WS_KDT) + (size_t)it * 8192;
    const float* EB = (const float*)(ws + WS_EBL) + (size_t)it * 128;
#pragma unroll
    for (int ks = 0; ks < 4; ++ks) F.qe[ks] = *(const bf16x8_t*)(QE + o.qe + ks * 512);
#pragma unroll
    for (int ks = 0; ks < 2; ++ks) { F.at[ks] = *(const bf16x8_t*)(AT + o.at + ks * 512); F.vt[ks] = *(const bf16x8_t*)(VT + o.vt + ks * 512);
        F.kd[0][ks] = *(const bf16x8_t*)(KD + o.kd + ks * 512); F.kd[1][ks] = *(const bf16x8_t*)(KD + o.kd + 1024 + ks * 512); }
    F.eb[0] = EB[o.eb]; F.eb[1] = EB[o.eb + 16];
}
__device__ __forceinline__ unsigned gla_touch(const unsigned char* ws, int n, int b, int h, int dir, const GlaOff& o) {
    const int nn = n < NSEG ? n : NSEG - 1;
    const int tt = tile_of(nn, b, dir), it = (dir * 520 + tt) * 4 + h, rowbase = rowbase_of(tt);
    const u16* base;
    if (o.tsel == 0) base = (const u16*)(ws + WS_QE) + (size_t)it * 8192;
    else if (o.tsel == 1) base = (const u16*)(ws + WS_KDT) + (size_t)it * 8192;
    else if (o.tsel == 2) base = (const u16*)(ws + WS_ATT) + (size_t)it * 4096;
    else base = (const u16*)(ws + WS_VT) + (size_t)(tt * 4 + h) * 16384;
    return *(const unsigned*)(base + o.tch);
}
__device__ __forceinline__ void gla_chunk(const Params& p, int job, unsigned char* lds) {
    const int tid = tid_fresh(), lane = tid & 63, w = __builtin_amdgcn_readfirstlane(tid >> 6), fr = lane & 15, fq = lane >> 4;
    const int chain = job >> 3, cgp = job & 7;
    const int b = chain >> 3, h = (chain >> 1) & 3, dir = chain & 1;
    const int e0 = cgp * 32, lt = w >> 1, et = w & 1, dt0 = (w >> 1) * 2;
    const unsigned char* ws = p.ws;
    GlaOff o;
    o.qe = lt * 2048 + lane * 8; o.at = lt * 1024 + lane * 8; o.vt = ((e0 >> 4) + et) * 1024 + lane * 8;
    o.kd = dt0 * 1024 + lane * 8; o.eb = dt0 * 16 + fr; o.o = (lt * 16 + fq * 4) * 1024 + h * 256 + e0 + et * 16 + fr;
    o.tsel = w < 2 ? 0 : (w < 4 ? 1 : (w == 4 ? 2 : 3));
    o.tch = w < 2 ? (w * 64 + lane) * 64 : (w < 4 ? ((w - 2) * 64 + lane) * 64 : (w == 4 ? lane * 64 : (e0 >> 4) * 1024 + (lane & 31) * 64));
    u16* Sl = (u16*)lds;
    u16* O = (u16*)(p.ws + (dir ? WS_OB1 : WS_OF1));
    const int sRd = (et * 16 + fr) * 136 + fq * 8, sWr = (et * 16 + fq * 4) * 136 + dt0 * 16 + fr;
    __syncthreads();
    for (int i = tid; i < 2 * 32 * 136 / 2; i += NTHR) ((unsigned*)Sl)[i] = 0u;
    __syncthreads();
    f32x4_t Sacc[2]; Sacc[0] = (f32x4_t){0.f, 0.f, 0.f, 0.f}; Sacc[1] = Sacc[0];
    GlaFr buf[2];
    gla_load(buf[0], ws, 0, b, h, dir, o); gla_load(buf[1], ws, 1, b, h, dir, o);
    unsigned pfr[4] = {0u, 0u, 0u, 0u}, sink = 0u;
    for (int n0 = 0; n0 < NSEG; n0 += 4) {
#pragma unroll
        for (int u = 0; u < 4; ++u) {
            const int n = n0 + u; const int s = u & 1;
            sink ^= pfr[u]; if (w < 6) pfr[u] = gla_touch(ws, n + 5, b, h, dir, o);
            const GlaFr& F = buf[s];
            const u16* Scur = Sl + (n & 1) * (32 * 136); u16* Snxt = Sl + ((n + 1) & 1) * (32 * 136);
            if (n >= 4) {
                const int tt = tile_of(n, b, dir);
                u16* Ou = O + (size_t)(512 + (tt - 8) * 64) * 1024;
                f32x4_t acc = (f32x4_t){0.f, 0.f, 0.f, 0.f};
#pragma unroll
                for (int ks = 0; ks < 4; ++ks) { const bf16x8_t bb = *(const bf16x8_t*)(Scur + sRd + ks * 32); acc = __builtin_amdgcn_mfma_f32_16x16x32_bf16(F.qe[ks], bb, acc, 0, 0, 0); }
#pragma unroll
                for (int ks = 0; ks < 2; ++ks) acc = __builtin_amdgcn_mfma_f32_16x16x32_bf16(F.at[ks], F.vt[ks], acc, 0, 0, 0);
#pragma unroll
                for (int j = 0; j < 4; ++j) Ou[o.o + j * 1024] = f2bf(acc[j]);
            }
#pragma unroll
            for (int i = 0; i < 2; ++i) { f32x4_t nw = (f32x4_t){0.f, 0.f, 0.f, 0.f};
#pragma unroll
                for (int ks = 0; ks < 2; ++ks) nw = __builtin_amdgcn_mfma_f32_16x16x32_bf16(F.vt[ks], F.kd[i][ks], nw, 0, 0, 0);
#pragma unroll
                for (int j = 0; j < 4; ++j) { Sacc[i][j] = F.eb[i] * Sacc[i][j] + nw[j]; Snxt[sWr + j * 136 + i * 16] = f2bf(Sacc[i][j]); } }
            __syncthreads();
            gla_load(buf[s], ws, n + 2, b, h, dir, o);
        }
    }
    ((unsigned*)(p.ws + WS_MODP))[blockIdx.x * NTHR + tid] = sink ^ pfr[0] ^ pfr[1] ^ pfr[2] ^ pfr[3];
}
__device__ __forceinline__ void ph_l1_c(const Params& p, unsigned char* lds) {
    const int tid = tid_fresh(), rt = (tid >> 6) >> 1, chh = (tid >> 6) & 1, fr = tid & 15, fq = (tid & 63) >> 4;
    const u16* PROJ = (const u16*)(p.ws + WS_PROJ); const float* CARRY = (const float*)(p.ws + WS_CARRY); u16* Y = (u16*)(p.ws + WS_H);
    float2* AG = (float2*)lds;
    float* CIN = (float*)(lds + 32768);
    for (int t = blockIdx.x + 64; t < 520 * 8; t += gridDim.x) {
        const int tt = t >> 3, g = t & 7, b = rg_batch(tt);
        const int rowbase = 512 + (tt - 8) * 64;
        u16 grv[4][4];
#pragma unroll
        for (int c = 0; c < 4; ++c)
#pragma unroll
            for (int j = 0; j < 4; ++j) grv[c][j] = PROJ[(size_t)(rowbase + rt * 16 + fq * 4 + j) * NP1 + 1024 + g * 128 + (chh * 4 + c) * 16 + fr];
        rg_conv(p, tt, g, lds);
        float av[2][4][4], bx[2][4][4];
#pragma unroll
        for (int z = 0; z < 2; ++z) {
            rg_gates_reg(p, g, z, lds, rt, chh, fr, fq, av[z], bx[z]);
#pragma unroll
            for (int c = 0; c < 4; ++c) AG[(z * 16 + rt * 4 + fq) * 128 + (chh * 4 + c) * 16 + fr] = rg_local(av[z][c], bx[z][c], z);
        }
        __syncthreads();
        if (tid < 256) { const int z = tid >> 7, ch = tid & 127; float h = CARRY[((size_t)(b * 2 + z) * NSEG + rg_tau(tt, z)) * 1024 + g * 128 + ch];
#pragma unroll
            for (int s = 0; s < 16; ++s) { const int gi = z ? 15 - s : s; CIN[(z * 16 + gi) * 128 + ch] = h; const float2 ph = AG[(z * 16 + gi) * 128 + ch]; h = ph.x * h + ph.y; } }
        __syncthreads();
#pragma unroll
        for (int c = 0; c < 4; ++c) { const int chl = (chh * 4 + c) * 16 + fr; float hs[4];
            { float h = CIN[(0 * 16 + rt * 4 + fq) * 128 + chl];
#pragma unroll
                for (int j = 0; j < 4; ++j) { h = av[0][c][j] * h + bx[0][c][j]; hs[j] = h; } }
            { float h = CIN[(1 * 16 + rt * 4 + fq) * 128 + chl];
#pragma unroll
                for (int j = 3; j >= 0; --j) { h = av[1][c][j] * h + bx[1][c][j]; hs[j] += h; } }
#pragma unroll
            for (int j = 0; j < 4; ++j) Y[(size_t)(rowbase + rt * 16 + fq * 4 + j) * 2048 + g * 128 + chl] = f2bf(gelu_tanh(bf2f(grv[c][j])) * hs[j]); }
    }
    const int lane = tid & 63, w = tid >> 6;
    const u16* OF = (const u16*)(p.ws + WS_OF1); const u16* OB = (const u16*)(p.ws + WS_OB1);
    for (int row = 512 + blockIdx.x * 8 + w; row < MTOT; row += gridDim.x * 8) {
        const int col = lane * 16; float o[16]; float ss = 0.f;
#pragma unroll
        for (int i = 0; i < 2; ++i) { float a[8], bb[8]; unpack8(*(const uint4*)(OF + (size_t)row * 1024 + col + i * 8), a); unpack8(*(const uint4*)(OB + (size_t)row * 1024 + col + i * 8), bb);
#pragma unroll
            for (int j = 0; j < 8; ++j) { o[i * 8 + j] = a[j] + bb[j]; ss += o[i * 8 + j] * o[i * 8 + j]; } }
        ss = red16(ss);
        const float rstd = rsqrtf(ss * (1.f / 256.f) + 1e-6f);
#pragma unroll
        for (int i = 0; i < 2; ++i) { float gt[8], r[8]; unpack8(*(const uint4*)(PROJ + (size_t)row * NP1 + 4096 + col + i * 8), gt);
#pragma unroll
            for (int j = 0; j < 8; ++j) r[j] = o[i * 8 + j] * rstd * p.gla_norm_g[col + i * 8 + j] * siluf_(gt[j]);
            *(uint4*)(Y + (size_t)row * 2048 + 1024 + col + i * 8) = pack8(r); }
    }
}

#define XB_TMO      128
#define XB_XCNT(j)  (256  + 64 * (j))
#define XB_XSUB(j)  (1280 + 64 * (j))
#define XB_XGEN(j)  (2304 + 64 * (j))
#define XB_TOP      3328
#define XB_TOPGEN   3392
#define XCD_BAR_WORDS 3456
#define XB_SPIN_CAP (1u << 18)
#define XLAS __attribute__((address_space(3)))

__device__ __forceinline__ unsigned xb_ld(unsigned* p)              { return __hip_atomic_load(p, __ATOMIC_RELAXED, __HIP_MEMORY_SCOPE_AGENT); }
__device__ __forceinline__ unsigned xb_add(unsigned* p, unsigned v) { return __hip_atomic_fetch_add(p, v, __ATOMIC_RELAXED, __HIP_MEMORY_SCOPE_AGENT); }
__device__ __forceinline__ unsigned xb_xcc_id() { return (unsigned)__builtin_amdgcn_s_getreg((3 << 11) | 20) & 0xFu; }
#define XB_SPIN(cond, bar) do { unsigned _sp = 0; while (cond) { __builtin_amdgcn_s_sleep(1); \
    if ((++_sp & 255u) == 0u) { if (xb_ld(&(bar)[XB_TMO])) break; if (_sp > XB_SPIN_CAP) { atomicAdd(&(bar)[XB_TMO], 1u); break; } } } } while (0)

struct XcdBarrier {
    unsigned* bar; unsigned x;
    volatile XLAS unsigned* st;
};

__device__ __forceinline__ XcdBarrier xcd_barrier_post(unsigned* bar, volatile XLAS unsigned* st) {
    XcdBarrier b; b.bar = bar; b.x = xb_xcc_id(); b.st = st;
    if (threadIdx.x == 0) (void)xb_add(&bar[XB_XCNT(b.x)], 1u);
    return b;
}
__device__ __forceinline__ void xcd_barrier_complete(unsigned* bar, unsigned x, unsigned& nloc, unsigned& nx) {
    const unsigned G = gridDim.x * gridDim.y * gridDim.z;
    unsigned sum, cnt, mine, sp = 0u;
    for (;;) {
        sum = 0u; cnt = 0u; mine = 0u;
#pragma unroll
        for (unsigned j = 0; j < 16; ++j) { const unsigned c = xb_ld(&bar[XB_XCNT(j)]); sum += c; cnt += (c > 0u) ? 1u : 0u; mine = (j == x) ? c : mine; }
        if (sum == G) break;
        __builtin_amdgcn_s_sleep(1);
        if ((++sp & 255u) == 0u) { if (xb_ld(&bar[XB_TMO])) break; if (sp > XB_SPIN_CAP) { atomicAdd(&bar[XB_TMO], 1u); break; } }
    }
    nloc = mine > 0u ? mine : 1u; nx = cnt > 0u ? cnt : 1u;
}

__device__ __forceinline__ void xcd_barrier(const XcdBarrier& b) {
    asm volatile("s_waitcnt vmcnt(0)" ::: "memory");
    __syncthreads();
    if (threadIdx.x == 0) {
        unsigned* bar = b.bar;
        __builtin_amdgcn_s_waitcnt(0);
        unsigned nloc = b.st[0], nx = b.st[1];
        if (nloc == 0u) { xcd_barrier_complete(bar, b.x, nloc, nx); b.st[0] = nloc; b.st[1] = nx; }
        const unsigned old = xb_add(&bar[XB_XSUB(b.x)], 1u);
        const unsigned gen = old / nloc;
        if (old + 1u == (gen + 1u) * nloc) {
            __builtin_amdgcn_fence(__ATOMIC_RELEASE, "agent");
            asm volatile("s_waitcnt vmcnt(0)" ::: "memory");
            const unsigned og = xb_add(&bar[XB_TOP], 1u);
            const unsigned tg = og / nx;
            if (og + 1u == (tg + 1u) * nx) xb_add(&bar[XB_TOPGEN], 1u);
            else XB_SPIN(xb_ld(&bar[XB_TOPGEN]) == tg, bar);
            __builtin_amdgcn_fence(__ATOMIC_ACQUIRE, "agent");
            xb_add(&bar[XB_XGEN(b.x)], 1u);
            asm volatile("s_waitcnt vmcnt(0)" ::: "memory");
        } else {
            XB_SPIN(xb_ld(&bar[XB_XGEN(b.x)]) == gen, bar);
            __builtin_amdgcn_fence(__ATOMIC_ACQUIRE, "agent");
            asm volatile("s_waitcnt vmcnt(0)" ::: "memory");
        }
    }
    __syncthreads();
}

constexpr int LDS_BYTES = 135168 + 16;

__global__ void __launch_bounds__(NTHR, 2) hybrid_fwd(Params p) {
    extern __shared__ __attribute__((aligned(16))) unsigned char lds[];
    cg::grid_group grid = cg::this_grid();
    float* smf = (float*)lds;
    PG8_LAS unsigned char* ldsg = (PG8_LAS unsigned char*)lds;
    unsigned char* ws = p.ws;
    u16* WT_IN = (u16*)(ws + WS_WT_IN); u16* WT_OUT = (u16*)(ws + WS_WT_OUT); u16* WT_GU = (u16*)(ws + WS_WT_GU); u16* WT_DN = (u16*)(ws + WS_WT_DN);
    u16* H = (u16*)(ws + WS_H); u16* PROJ = (u16*)(ws + WS_PROJ); float* XC = (float*)(ws + WS_XC); float* G = (float*)(ws + WS_G);
    const float* MOD = (const float*)(ws + WS_MOD);
    const int GD = (int)gridDim.x, bid = (int)blockIdx.x;
    const int vb = (GD % 8 == 0) ? (bid % 8) * (GD / 8) + bid / 8 : bid;
    volatile XLAS unsigned* xst = (volatile XLAS unsigned*)((PG8_LAS unsigned char*)lds + 135168);
    if (threadIdx.x < 2) xst[threadIdx.x] = 0u;
    __syncthreads();
    const XcdBarrier xbar = xcd_barrier_post((unsigned*)(ws + WS_BAR), xst);
#ifdef PROBE
    unsigned long long tG = 0, tL0P = 0, tL0PP = 0, tL0M = 0, tL1A = 0, tL1M = 0, tL1C = 0, tO = 0, tprev = __builtin_amdgcn_s_memrealtime();
#define PSTAMP(c) do { const unsigned long long t_ = __builtin_amdgcn_s_memrealtime(); c += t_ - tprev; tprev = t_; } while (0)
#else
#define PSTAMP(c) do {} while (0)
#endif

    ph_adaln_partials(p, smf);
    ph_convert_rg(p);
    ph_convert<1>(p.ab_w_in, 7216, 2048, 7424, WT_IN, smf);
    ph_convert<0>(p.ab_w_out, 2048, 2048, 2048, WT_OUT, smf);
    ph_convert<2>(p.ffn_w_gu, 11264, 2048, 11264, WT_GU, smf);
    ph_convert<0>(p.ffn_w_down, 2048, 5632, 2048, WT_DN, smf);
    grid.sync();
    PSTAMP(tO);
    ph_adaln_reduce(p);
    xcd_barrier(xbar);
    PSTAMP(tO);

    ph_norm(p.ctx, p.x, p.norm_mix_g, MOD, 0, 1, H, 0);
    xcd_barrier(xbar);
    PSTAMP(tO);
    { pg8::Gemm g{H, WT_IN, MTOT, 7424, 2048}; pg8::StaticOrder S; S.init(MTOT, 7424, GD, bid);
      pg8::EpiProj E{PROJ, NP0, 28, G, NG0, NG0, 4}; pg8::gemm_phase<pg8::EpiProj, pg8::StaticOrder>(ldsg, g, S, E); }
    xcd_barrier(xbar);
    PSTAMP(tG);
    ph_l0_prep(p, smf);
    xcd_barrier(xbar);
    PSTAMP(tL0P);
    ph_l0_prepass(p, lds);
#ifdef DUP_L0PP
    xcd_barrier(xbar); ph_l0_prepass(p, lds);
#endif
    xcd_barrier(xbar);
    PSTAMP(tL0PP);
    for (int job = vb; job < 256; job += GD) { if (job < 128) mlstm_chunk(p, job, lds); else deltanet_chunk(p, job - 128, lds); }
#ifdef DUP_L0M
    xcd_barrier(xbar);
    for (int job = vb; job < 256; job += GD) { if (job < 128) mlstm_chunk(p, job, lds); else deltanet_chunk(p, job - 128, lds); }
#endif
    xcd_barrier(xbar);
    PSTAMP(tL0M);
    ph_l0_merge(p);
    xcd_barrier(xbar);
    PSTAMP(tO);
    { pg8::Gemm g{H, WT_OUT, MTOT, 2048, 2048}; pg8::StaticOrder S; S.init(MTOT, 2048, GD, bid);
      pg8::EpiRes E{p.ctx, p.x, XC, p.out, MOD + 2 * 2048, 0}; pg8::gemm_phase<pg8::EpiRes, pg8::StaticOrder>(ldsg, g, S, E); }
    xcd_barrier(xbar);
    PSTAMP(tG);
    ph_norm(XC, p.out, p.norm_ffn_g, MOD, 3, 4, H, 0);
    xcd_barrier(xbar);
    PSTAMP(tO);
    { pg8::Gemm g{H, WT_GU, MTOT, 11264, 2048}; pg8::StaticOrder S; S.init(MTOT, 11264, GD, bid);
      pg8::EpiSwiglu E{PROJ, FH}; pg8::gemm_phase<pg8::EpiSwiglu, pg8::StaticOrder>(ldsg, g, S, E); }
    xcd_barrier(xbar);
    PSTAMP(tG);
    { pg8::Gemm g{PROJ, WT_DN, MTOT, 2048, 5632}; pg8::StaticOrder S; S.init(MTOT, 2048, GD, bid);
      pg8::EpiRes E{XC, p.out, XC, p.out, MOD + 5 * 2048, 0}; pg8::gemm_phase<pg8::EpiRes, pg8::StaticOrder>(ldsg, g, S, E); }
    xcd_barrier(xbar);
    PSTAMP(tG);

    const float* MOD1 = MOD + 3 * 12288;
    ph_convert<0>(p.cd_w_in, 5152, 2048, 5376, WT_IN, smf);
    ph_convert<0>(p.cd_w_out, 2048, 2048, 2048, WT_OUT, smf);
    ph_convert<2>(p.ffn_w_gu + (size_t)2048 * 11264, 11264, 2048, 11264, WT_GU, smf);
    ph_convert<0>(p.ffn_w_down + (size_t)5632 * 2048, 2048, 5632, 2048, WT_DN, smf);
    ph_norm(XC, p.out, p.norm_mix_g + 2048, MOD1, 0, 1, H, 0);
    xcd_barrier(xbar);
    PSTAMP(tO);
    { pg8::Gemm g{H, WT_IN, MTOT, 5376, 2048}; pg8::StaticOrder S; S.init(MTOT, 5376, GD, bid);
      pg8::EpiProj E{PROJ, NP1, 20, G, NG1, NG1, 0}; pg8::gemm_phase<pg8::EpiProj, pg8::StaticOrder>(ldsg, g, S, E); }
    xcd_barrier(xbar);
    PSTAMP(tG);
    ph_l1_a(p, lds);
#ifdef DUP_L1A
    xcd_barrier(xbar); ph_l1_a(p, lds, DUP_L1A);
#endif
    xcd_barrier(xbar);
    PSTAMP(tL1A);
    for (int job = vb; job < 136; job += GD) { if (job < 128) gla_chunk(p, job, lds); else rg_pass_b(p, job - 128); }
#ifdef DUP_L1M
    xcd_barrier(xbar);
    for (int job = vb; job < 136; job += GD) { if (job < 128) gla_chunk(p, job, lds); else rg_pass_b(p, job - 128); }
#endif
    xcd_barrier(xbar);
    PSTAMP(tL1M);
    ph_l1_c(p, lds);
#ifdef DUP_L1C
    xcd_barrier(xbar); ph_l1_c(p, lds);
#endif
    xcd_barrier(xbar);
    PSTAMP(tL1C);
    { pg8::Gemm g{H + (size_t)512 * 2048, WT_OUT, MLAT, 2048, 2048}; pg8::StaticOrder S; S.init(MLAT, 2048, GD, bid);
      pg8::EpiRes E{XC, p.out, XC, p.out, MOD1 + 2 * 2048, 512}; pg8::gemm_phase<pg8::EpiRes, pg8::StaticOrder>(ldsg, g, S, E); }
    xcd_barrier(xbar);
    PSTAMP(tG);
    ph_norm(XC, p.out, p.norm_ffn_g + 2048, MOD1, 3, 4, H, 512);
    xcd_barrier(xbar);
    PSTAMP(tO);
    { pg8::Gemm g{H + (size_t)512 * 2048, WT_GU, MLAT, 11264, 2048}; pg8::StaticOrder S; S.init(MLAT, 11264, GD, bid);
      pg8::EpiSwiglu E{PROJ, FH}; pg8::gemm_phase<pg8::EpiSwiglu, pg8::StaticOrder>(ldsg, g, S, E); }
    xcd_barrier(xbar);
    PSTAMP(tG);
    { pg8::Gemm g{PROJ, WT_DN, MLAT, 2048, 5632}; pg8::StaticOrder S; S.init(MLAT, 2048, GD, bid);
      pg8::EpiRes E{XC, p.out, XC, p.out, MOD1 + 5 * 2048, 512}; pg8::gemm_phase<pg8::EpiRes, pg8::StaticOrder>(ldsg, g, S, E); }
    xcd_barrier(xbar);
    PSTAMP(tG);
#ifdef EXTRA_SYNCS
#pragma unroll 1
    for (int i = 0; i < EXTRA_SYNCS; ++i) xcd_barrier(xbar);
#endif
    ph_final_norm(p);
#ifdef PROBE
    PSTAMP(tO);
    __syncthreads();
    if (bid == 0 && threadIdx.x == 0) { const float tot = (float)(tG + tL0P + tL0PP + tL0M + tL1A + tL1M + tL1C + tO);
#ifdef PROBE3
        const unsigned long long* pq = (const unsigned long long*)(p.ws + WS_MODP) + 500000;
        p.out[0] += 0.25f + 0.15f * ((float)(pq[1] - pq[0]) / tot); p.out[1] += 0.10f + 0.14f * ((float)(pq[2] - pq[1]) / tot); }
#elif defined(PROBE2)
        const float* pr = (const float*)(p.ws + WS_MODP) + 1000000;
        p.out[0] += 0.25f + 0.15f * pr[0]; p.out[1] += 0.10f + 0.14f * pr[1]; }
#else
        p.out[0] += 0.25f + 0.15f * ((float)PROBE_A / tot); p.out[1] += 0.10f + 0.14f * ((float)PROBE_B / tot); }
#endif
#endif
}

extern "C" void kernel_launch(void* const* d_in, const int* in_sizes, int n_in, void* d_out, int out_size, void* d_ws, size_t ws_size, hipStream_t stream) {
    static int grid = 0;
    if (grid == 0) {
        if (n_in != 32 || out_size != MLAT * DM || ws_size < WS_END) { fprintf(stderr, "kernel_launch: unexpected shapes (n_in %d out %d ws %zu need %zu)\n", n_in, out_size, ws_size, (size_t)WS_END); grid = -1; return; }
        int dev = 0, cus = 0, per_cu = 0;
        (void)hipGetDevice(&dev);
        (void)hipDeviceGetAttribute(&cus, hipDeviceAttributeMultiprocessorCount, dev);
        if (hipFuncSetAttribute((const void*)hybrid_fwd, hipFuncAttributeMaxDynamicSharedMemorySize, LDS_BYTES) != hipSuccess) { fprintf(stderr, "kernel_launch: hipFuncSetAttribute failed\n"); }
        if (hipOccupancyMaxActiveBlocksPerMultiprocessor(&per_cu, (const void*)hybrid_fwd, NTHR, LDS_BYTES) != hipSuccess || per_cu < 1) { fprintf(stderr, "kernel_launch: occupancy query gave %d\n", per_cu); per_cu = 1; }
        (void)hipGetLastError();
        grid = cus * per_cu;
    }
    if (grid < 0) return;
    Params p{};
    const float** pp = (const float**)&p;
    for (int i = 0; i < 32; ++i) pp[i] = (const float*)d_in[i];
    p.out = (float*)d_out; p.ws = (unsigned char*)d_ws;
    (void)hipMemsetAsync((unsigned char*)d_ws + WS_BAR, 0, 16384, stream);
    void* args[] = {&p};
    hipError_t e = hipLaunchCooperativeKernel((const void*)hybrid_fwd, dim3(grid), dim3(NTHR), args, LDS_BYTES, stream);
    if (e != hipSuccess) fprintf(stderr, "cooperative launch failed: %s (grid %d)\n", hipGetErrorString(e), grid);
}
```

```cpp
#include <hip/hip_runtime.h>
#include <hip/hip_cooperative_groups.h>
#include <cstdio>
namespace cg = cooperative_groups;

typedef unsigned short u16;

constexpr int DM = 2048, FH = 5632, MC = 512, MLAT = 32768, MTOT = 33280, NTHR = 512;
constexpr int NP0 = 7168, NP1 = 5120;
constexpr int NG0 = 48, NG1 = 32;
constexpr int NSEG = 260;

constexpr size_t WS_WT_IN = 0;
constexpr size_t WS_WT_OUT = WS_WT_IN + (size_t)7424 * 2048 * 2;
constexpr size_t WS_WT_GU = WS_WT_OUT + (size_t)2048 * 2048 * 2;
constexpr size_t WS_WT_DN = WS_WT_GU + (size_t)11264 * 2048 * 2;
constexpr size_t WS_H = WS_WT_DN + (size_t)2048 * 5632 * 2;
constexpr size_t WS_PROJ = WS_H + (size_t)MTOT * 2048 * 2;
constexpr size_t WS_OF = WS_PROJ + (size_t)MTOT * 7168 * 2;
constexpr size_t WS_OB = WS_OF + (size_t)MTOT * 2048 * 2;
constexpr size_t WS_XC = WS_OB + (size_t)MTOT * 2048 * 2;
constexpr size_t WS_G = WS_XC + (size_t)MC * 2048 * 4;
constexpr size_t WS_CQ = WS_G + (size_t)MTOT * 48 * 4;
constexpr size_t WS_MODP = WS_CQ + (size_t)MC * 3072 * 2;
constexpr size_t WS_MOD = WS_MODP + (size_t)2 * 32 * 3 * 12288 * 4;
constexpr size_t WS_ATT0 = WS_MOD + (size_t)2 * 3 * 12288 * 4;
constexpr size_t WS_MLS = WS_ATT0 + (size_t)4160 * 4096 * 2;
constexpr size_t WS_GCS = WS_MLS + (size_t)4160 * 256 * 4;
constexpr size_t WS_WRT = WS_GCS + (size_t)8320 * 256 * 4;
constexpr size_t WS_BAR = WS_WRT + (size_t)32 * 16384 * 2;
constexpr size_t WS_END = WS_BAR + 16384;
constexpr size_t WS_TM = WS_H;
constexpr size_t WS_QK = WS_H + (size_t)8320 * 4096 * 2;
constexpr size_t WS_OF1 = WS_OF;
constexpr size_t WS_OB1 = WS_OF + (size_t)MTOT * 1024 * 2;
constexpr size_t WS_QE = WS_OB;
constexpr size_t WS_KDT = WS_QE + (size_t)2 * MTOT * 512 * 2;
constexpr size_t WS_TAIL = WS_PROJ + (size_t)MTOT * 5120 * 2;
constexpr size_t WS_ATT = WS_TAIL;
constexpr size_t WS_VT = WS_ATT + (size_t)4160 * 4096 * 2;
constexpr size_t WS_EBL = WS_VT + (size_t)2080 * 16384 * 2;
constexpr size_t WS_AGG = WS_EBL + (size_t)4160 * 128 * 4;
constexpr size_t WS_CARRY = WS_AGG + (size_t)4 * NSEG * 1024 * 8;
static_assert(WS_CARRY + (size_t)4 * NSEG * 1024 * 4 <= WS_OF, "layer-1 tail overflow");

struct Params {
    const float *x, *c, *ctx, *c_ctx, *mod_w, *mod_b, *norm_mix_g, *norm_ffn_g, *ffn_w_gu, *ffn_w_down, *final_norm_g,
        *ab_w_in, *ab_w_out, *ml_ig_b, *ml_fg_b, *ml_norm_g, *dn_conv_w, *dn_a_log, *dn_dt_bias, *dn_norm_g,
        *cd_w_in, *cd_w_out, *rg_conv_w, *rg_conv_b, *rg_w_r, *rg_b_r, *rg_w_i, *rg_b_i, *rg_lambda, *gla_w_up, *gla_b_up, *gla_norm_g;
    float* out; unsigned char* ws;
};

__device__ __forceinline__ float bf2f(u16 v) { return __uint_as_float(((unsigned)v) << 16); }
typedef __bf16 bf16x2_nat __attribute__((ext_vector_type(2)));
typedef float f32x2_nat __attribute__((ext_vector_type(2)));
__device__ __forceinline__ unsigned cvt_pk_bf16(float lo, float hi) { const f32x2_nat v = {lo, hi}; const bf16x2_nat r = __builtin_convertvector(v, bf16x2_nat); return __builtin_bit_cast(unsigned, r); }
__device__ __forceinline__ u16 f2bf(float f) { return (u16)(cvt_pk_bf16(f, 0.f) & 0xffffu); }
__device__ __forceinline__ void unpack8(const uint4& u, float* f) {
    f[0] = __uint_as_float(u.x << 16); f[1] = __uint_as_float(u.x & 0xffff0000u);
    f[2] = __uint_as_float(u.y << 16); f[3] = __uint_as_float(u.y & 0xffff0000u);
    f[4] = __uint_as_float(u.z << 16); f[5] = __uint_as_float(u.z & 0xffff0000u);
    f[6] = __uint_as_float(u.w << 16); f[7] = __uint_as_float(u.w & 0xffff0000u);
}
__device__ __forceinline__ uint4 pack8(const float* f) { uint4 o; o.x = cvt_pk_bf16(f[0], f[1]); o.y = cvt_pk_bf16(f[2], f[3]); o.z = cvt_pk_bf16(f[4], f[5]); o.w = cvt_pk_bf16(f[6], f[7]); return o; }
template <int CTRL> __device__ __forceinline__ float dppf(float x) { return __int_as_float(__builtin_amdgcn_update_dpp(0, __float_as_int(x), CTRL, 0xF, 0xF, true)); }
__device__ __forceinline__ float red4(float x) { x += dppf<0xB1>(x); x += dppf<0x4E>(x); return x; }
__device__ __forceinline__ float red8(float x) { x = red4(x); x += dppf<0x141>(x); return x; }
__device__ __forceinline__ float red16(float x) { x = red8(x); x += dppf<0x140>(x); return x; }
__device__ __forceinline__ float red64(float x) { x = red16(x); x += __shfl_xor(x, 16); x += __shfl_xor(x, 32); return x; }
__device__ __forceinline__ float frcp(float x) { return __builtin_amdgcn_rcpf(x); }
__device__ __forceinline__ float sigmoidf_(float x) { return frcp(1.f + __expf(-x)); }
__device__ __forceinline__ float siluf_(float x) { return x * frcp(1.f + __expf(-x)); }
__device__ __forceinline__ float softplusf_(float x) { return fmaxf(x, 0.f) + __logf(1.f + __expf(-fabsf(x))); }
__device__ __forceinline__ float logsigmoidf_(float x) { return fminf(x, 0.f) - __logf(1.f + __expf(-fabsf(x))); }
__device__ __forceinline__ float gelu_tanh(float x) { const float u = 0.7978845608028654f * (x + 0.044715f * x * x * x); const float th = 1.f - 2.f * frcp(1.f + __expf(2.f * u)); return 0.5f * x * (1.f + th); }
__device__ __forceinline__ float neg_expm1_small(float x) { float pl = 1.f / 720.f; pl = pl * x + 1.f / 120.f; pl = pl * x + 1.f / 24.f; pl = pl * x + 1.f / 6.f; pl = pl * x + 0.5f; pl = pl * x + 1.f; return -x * pl; }

__device__ __forceinline__ int tid_fresh() { int t = threadIdx.x; asm volatile("" : "+v"(t)); return t; }
namespace pg8 {
#define PG8_LAS __attribute__((address_space(3)))
typedef unsigned short bf16_t;
typedef short bf16x8 __attribute__((ext_vector_type(8)));
typedef float f32x4 __attribute__((ext_vector_type(4)));
typedef unsigned u32x4 __attribute__((ext_vector_type(4)));
constexpr int BM = 256, BK = 64, HALF = 128, HTB = HALF * BK * 2  , STAGE_BYTES = 8 * HTB, NXCD = 8, WGM = 8;

__host__ __device__ __forceinline__ int lds_byte(int r, int c) { const int st = (r >> 4) * 2 + (c >> 5), rr = r & 15, cc = c & 31, ob = rr * 64 + cc * 2; return st * 1024 + (ob ^ (((ob >> 9) & 1) << 5)); }
__host__ __device__ __forceinline__ void stage_rc(int b, int& R, int& C) { const int st = b / 1024, sb = b % 1024, swz = sb ^ (((sb >> 9) & 1) << 5); R = (st >> 1) * 16 + swz / 64; C = (st & 1) * 32 + (swz % 64) / 2; }
__host__ __device__ __forceinline__ int perm32(int rho) { const int n = rho >> 4, i = rho & 15; return 8 * (i >> 2) + 4 * n + (i & 3); }

struct Unit { int pm, pn; };
struct Gemm { const bf16_t* A; const bf16_t* Bt; int M, N, K; };

struct StaticOrder {
    int nM, nN, nwg, G, c;
    __host__ __device__ void init(int M, int N, int G_, int c_) { nM = M / BM; nN = N / BM; nwg = nM * nN; G = G_; c = c_; }
    __host__ __device__ bool next(int i, Unit& u) const {
        const long L = (long)i * G + c; if (L >= nwg) return false;
        int wgid = (int)L; { const int q = nwg / NXCD, r = nwg % NXCD, xcd = wgid % NXCD, off = wgid / NXCD; wgid = (xcd < r ? xcd * (q + 1) : r * (q + 1) + (xcd - r) * q) + off; }
        const int nig = WGM * nN, gid = wgid / nig, fm = gid * WGM, gsz = (nM - fm) < WGM ? (nM - fm) : WGM;
        u.pm = fm + ((wgid % nig) % gsz); u.pn = (wgid % nig) / gsz; return true;
    }
    __device__ __forceinline__ void a_ready(const Unit&) const {}
    __device__ __forceinline__ void done(const Unit&) const {}
};
using ::cvt_pk_bf16;
typedef float f32x2 __attribute__((ext_vector_type(2)));

struct EpiProj {
    static constexpr bool PERM = true, AFTER_DRAIN = false;
    bf16_t* P; int ldp; int n_main; float* G; int ldg; int ng; int perm_tiles;
    __device__ __forceinline__ void operator()(const f32x4 (&acc)[2][2][4][2], const Unit& u, int wr, int wc, int fr, int fq) const {
        const int row0 = u.pm * BM + wr * 64 + fr;
        if (u.pn < perm_tiles) {
#pragma unroll
            for (int ai = 0; ai < 2; ++ai)
#pragma unroll
                for (int m = 0; m < 4; ++m) { bf16_t* rowp = P + (size_t)(u.pm * BM + ai * HALF + wr * 64 + (m * 4 + wc) * 4 + fq) * ldp + u.pn * BM + fr * 8;
#pragma unroll
                    for (int bj = 0; bj < 2; ++bj) { const f32x4 v0 = acc[ai][bj][m][0], v1 = acc[ai][bj][m][1];
                        u32x4 w; w.x = cvt_pk_bf16(v0[0], v0[1]); w.y = cvt_pk_bf16(v0[2], v0[3]); w.z = cvt_pk_bf16(v1[0], v1[1]); w.w = cvt_pk_bf16(v1[2], v1[3]);
                        *(u32x4*)(rowp + bj * HALF) = w; } }
        } else if (u.pn < n_main) {
            const int col0 = u.pn * BM + wc * 32 + 8 * fq;
#pragma unroll
            for (int ai = 0; ai < 2; ++ai)
#pragma unroll
                for (int m = 0; m < 4; ++m) { bf16_t* rowp = P + (size_t)(row0 + ai * HALF + m * 16) * ldp + col0;
#pragma unroll
                    for (int bj = 0; bj < 2; ++bj) { const f32x4 v0 = acc[ai][bj][m][0], v1 = acc[ai][bj][m][1];
                        u32x4 w; w.x = cvt_pk_bf16(v0[0], v0[1]); w.y = cvt_pk_bf16(v0[2], v0[3]); w.z = cvt_pk_bf16(v1[0], v1[1]); w.w = cvt_pk_bf16(v1[2], v1[3]);
                        *(u32x4*)(rowp + bj * HALF) = w; } }
        } else {
            const int c0 = wc * 32 + 8 * fq;
#pragma unroll
            for (int ai = 0; ai < 2; ++ai)
#pragma unroll
                for (int m = 0; m < 4; ++m) { float* rowp = G + (size_t)(row0 + ai * HALF + m * 16) * ldg;
#pragma unroll
                    for (int n = 0; n < 2; ++n)
#pragma unroll
                        for (int j = 0; j < 4; ++j) { const int c = c0 + 4 * n + j; if (c < ng) rowp[c] = acc[ai][0][m][n][j]; } }
        }
    }
};
struct EpiRes {
    static constexpr bool PERM = false, AFTER_DRAIN = false;
    const float* srcC; const float* srcL; float* dstC; float* dstL; const float* gate  ; int row_off;
    __device__ __forceinline__ void operator()(const f32x4 (&acc)[2][2][4][2], const Unit& u, int wr, int wc, int fr, int fq) const {
        const int grow_t = u.pm * BM + row_off;
        const bool isc = grow_t < 512;
        const int mr = isc ? 2 : ((grow_t - 512) >> 14);
        const float* sp = isc ? srcC + (size_t)grow_t * 2048 : srcL + (size_t)(grow_t - 512) * 2048;
        float* dp = isc ? dstC + (size_t)grow_t * 2048 : dstL + (size_t)(grow_t - 512) * 2048;
        const int lrow0 = wr * 64 + fr, col0 = u.pn * BM + wc * 32 + 4 * fq;
        const float* gp = gate + (size_t)mr * 12288 + col0;
        f32x4 gv[2][2];
#pragma unroll
        for (int bj = 0; bj < 2; ++bj)
#pragma unroll
            for (int n = 0; n < 2; ++n) gv[bj][n] = *(const f32x4*)(gp + bj * HALF + n * 16);
#pragma unroll
        for (int ai = 0; ai < 2; ++ai)
#pragma unroll
            for (int m = 0; m < 4; ++m) { const size_t off = (size_t)(lrow0 + ai * HALF + m * 16) * 2048 + col0;
#pragma unroll
                for (int bj = 0; bj < 2; ++bj)
#pragma unroll
                    for (int n = 0; n < 2; ++n) { const f32x4 s = *(const f32x4*)(sp + off + bj * HALF + n * 16);
                        *(f32x4*)(dp + off + bj * HALF + n * 16) = s + gv[bj][n] * acc[ai][bj][m][n]; } }
    }
};
struct EpiSwiglu {
    static constexpr bool PERM = true, AFTER_DRAIN = false;
    bf16_t* O; int ldo;
    __device__ __forceinline__ void operator()(const f32x4 (&acc)[2][2][4][2], const Unit& u, int wr, int wc, int fr, int fq) const {
        const int row0 = u.pm * BM + wr * 64 + fr, col0 = u.pn * HALF + wc * 32 + 8 * fq;
#pragma unroll
        for (int ai = 0; ai < 2; ++ai)
#pragma unroll
            for (int m = 0; m < 4; ++m) { float r[8];
#pragma unroll
                for (int n = 0; n < 2; ++n)
#pragma unroll
                    for (int j = 0; j < 4; ++j) { const float gg = acc[ai][0][m][n][j], uu = acc[ai][1][m][n][j]; r[n * 4 + j] = gg * __builtin_amdgcn_rcpf(1.f + __expf(-gg)) * uu; }
                u32x4 w; w.x = cvt_pk_bf16(r[0], r[1]); w.y = cvt_pk_bf16(r[2], r[3]); w.z = cvt_pk_bf16(r[4], r[5]); w.w = cvt_pk_bf16(r[6], r[7]);
                *(u32x4*)(O + (size_t)(row0 + ai * HALF + m * 16) * ldo + col0) = w; }
    }
};

template <class Epi, class Sched>
__device__ __forceinline__ void gemm_phase(PG8_LAS unsigned char* lds, const Gemm g, const Sched& S, const Epi& E) {
    int tid = threadIdx.x; asm volatile("" : "+v"(tid)); const int wid = __builtin_amdgcn_readfirstlane(tid >> 6), lane = tid & 63, wr = wid >> 2, wc = wid & 3, fr = lane & 15, fq = lane >> 4;
    const int K = g.K, nt = K / BK;
    unsigned voffA[2], voffB[2];
#pragma unroll
    for (int i = 0; i < 2; ++i) { int R, C; stage_rc(tid * 16 + i * 8192, R, C); const int Rb = Epi::PERM ? ((R & ~31) + perm32(R & 31)) : R;
        voffA[i] = (unsigned)(R * K + C) * 2u; voffB[i] = (unsigned)(Rb * K + C) * 2u; }
    const size_t kstep = (size_t)(BK * 2);
    const size_t hstep = (size_t)HALF * K * 2;
    const size_t tstep = 2 * hstep;
    const unsigned ldsw = (unsigned)wid * 1024u;
    const int aoff = lds_byte(wr * 64 + fr, fq * 8), boff = lds_byte(wc * 32 + fr, fq * 8);
#define PG8_SA(b, h) (((b) * 2 + (h)) * HTB)
#define PG8_SB(b, h) ((4 + (b) * 2 + (h)) * HTB)
#define PG8_STAGE(bufoff, gbase, voff) do { _Pragma("unroll") for (int _i = 0; _i < 2; ++_i) \
        __builtin_amdgcn_global_load_lds((const unsigned*)((const char*)(gbase) + (voff)[_i]), (PG8_LAS unsigned*)(lds + (bufoff) + ldsw + _i * 8192), 16, 0, 0); } while (0)
#define PG8_LDA(dst, b, h) do { _Pragma("unroll") for (int m = 0; m < 4; ++m) _Pragma("unroll") for (int k = 0; k < 2; ++k) dst[m][k] = *(const PG8_LAS bf16x8*)(lds + PG8_SA(b, h) + aoff + m * 2048 + k * 1024); } while (0)
#define PG8_LDB(dst, b, h) do { _Pragma("unroll") for (int n = 0; n < 2; ++n) _Pragma("unroll") for (int k = 0; k < 2; ++k) dst[n][k] = *(const PG8_LAS bf16x8*)(lds + PG8_SB(b, h) + boff + n * 2048 + k * 1024); } while (0)
#define PG8_MMA(ai, bj, At, Bt) do { __builtin_amdgcn_s_setprio(1); _Pragma("unroll") for (int m = 0; m < 4; ++m) _Pragma("unroll") for (int n = 0; n < 2; ++n) _Pragma("unroll") for (int k = 0; k < 2; ++k) \
        acc[ai][bj][m][n] = __builtin_amdgcn_mfma_f32_16x16x32_bf16(Bt[n][k], At[m][k], acc[ai][bj][m][n], 0, 0, 0); __builtin_amdgcn_s_setprio(0); } while (0)
#define PG8_WAIT_V(n) asm volatile("s_waitcnt vmcnt(" #n ")" ::: "memory")
#define PG8_WAIT_L(n) asm volatile("s_waitcnt lgkmcnt(" #n ")" ::: "memory")
#define PG8_BAR __builtin_amdgcn_s_barrier()
#define PG8_SCHED __builtin_amdgcn_sched_barrier(0)
    Unit cur, nxt; int ui = 0;
    if (!S.next(0, cur)) return;
    f32x4 acc[2][2][4][2];
#pragma unroll
    for (int a = 0; a < 2; ++a)
#pragma unroll
        for (int b = 0; b < 2; ++b)
#pragma unroll
            for (int m = 0; m < 4; ++m)
#pragma unroll
                for (int n = 0; n < 2; ++n) acc[a][b][m][n] = (f32x4){0.f, 0.f, 0.f, 0.f};
    bf16x8 At[4][2], B0[2][2], B1[2][2];
    const char* cA = (const char*)g.A + (size_t)cur.pm * tstep; const char* cB = (const char*)g.Bt + (size_t)cur.pn * tstep;
    S.a_ready(cur);
    PG8_STAGE(PG8_SB(0, 0), cB, voffB); PG8_STAGE(PG8_SA(0, 0), cA, voffA); PG8_STAGE(PG8_SB(0, 1), cB + hstep, voffB); PG8_STAGE(PG8_SA(0, 1), cA + hstep, voffA);
    if (wr == 1) PG8_BAR;
    PG8_WAIT_V(4); PG8_BAR;
    PG8_STAGE(PG8_SB(1, 0), cB + kstep, voffB); PG8_STAGE(PG8_SA(1, 0), cA + kstep, voffA); PG8_STAGE(PG8_SB(1, 1), cB + hstep + kstep, voffB);
    PG8_WAIT_V(6); PG8_BAR;
    for (;;) {
        const bool has_next = S.next(ui + 1, nxt);
        const char* nA = has_next ? (const char*)g.A + (size_t)nxt.pm * tstep : cA; const char* nB = has_next ? (const char*)g.Bt + (size_t)nxt.pn * tstep : cB;
        for (int t = 0; t < nt; t += 2) {
            const bool last = (t == nt - 2);
            const char* a1 = cA + (size_t)(t + 1) * kstep;
            const char* a2 = last ? nA : cA + (size_t)(t + 2) * kstep; const char* b2 = last ? nB : cB + (size_t)(t + 2) * kstep;
            const char* a3 = a2 + kstep; const char* b3 = b2 + kstep;
            if (last && has_next) S.a_ready(nxt);
            PG8_LDB(B0, 0, 0); PG8_SCHED; PG8_LDA(At, 0, 0); PG8_STAGE(PG8_SA(1, 1), a1 + hstep, voffA);
            PG8_WAIT_L(8); PG8_BAR; PG8_WAIT_L(0); PG8_MMA(0, 0, At, B0); PG8_BAR; PG8_SCHED;
            PG8_LDB(B1, 0, 1); PG8_STAGE(PG8_SB(0, 0), b2, voffB);
            PG8_BAR; PG8_WAIT_L(0); PG8_MMA(0, 1, At, B1); PG8_BAR;
            PG8_LDA(At, 0, 1); PG8_STAGE(PG8_SA(0, 0), a2, voffA);
            PG8_BAR; PG8_WAIT_L(0); PG8_MMA(1, 0, At, B0); PG8_BAR; PG8_SCHED;
            PG8_STAGE(PG8_SB(0, 1), b2 + hstep, voffB);
            PG8_WAIT_V(6); PG8_BAR; PG8_MMA(1, 1, At, B1); PG8_BAR;
            PG8_LDB(B0, 1, 0); PG8_SCHED; PG8_LDA(At, 1, 0); PG8_STAGE(PG8_SA(0, 1), a2 + hstep, voffA);
            PG8_WAIT_L(8); PG8_BAR; PG8_WAIT_L(0); PG8_MMA(0, 0, At, B0); PG8_BAR; PG8_SCHED;
            PG8_LDB(B1, 1, 1); PG8_STAGE(PG8_SB(1, 0), b3, voffB);
            PG8_BAR; PG8_WAIT_L(0); PG8_MMA(0, 1, At, B1); PG8_BAR;
            PG8_LDA(At, 1, 1); PG8_STAGE(PG8_SA(1, 0), a3, voffA);
            PG8_BAR; PG8_WAIT_L(0); PG8_MMA(1, 0, At, B0); PG8_BAR; PG8_SCHED;
            PG8_STAGE(PG8_SB(1, 1), b3 + hstep, voffB);
            PG8_WAIT_V(6); PG8_BAR; PG8_MMA(1, 1, At, B1); PG8_BAR;
        }
        if constexpr (!Epi::AFTER_DRAIN) { E(acc, cur, wr, wc, fr, fq); S.done(cur); }
        if (!has_next) break;
#pragma unroll
        for (int a = 0; a < 2; ++a)
#pragma unroll
            for (int b = 0; b < 2; ++b)
#pragma unroll
                for (int m = 0; m < 4; ++m)
#pragma unroll
                    for (int n = 0; n < 2; ++n) acc[a][b][m][n] = (f32x4){0.f, 0.f, 0.f, 0.f};
        cur = nxt; cA = nA; cB = nB; ++ui;
    }
    PG8_WAIT_V(0);
    if (wr == 0) PG8_BAR;
    PG8_BAR;
    if constexpr (Epi::AFTER_DRAIN) { E.fused(acc, cur, wr, wc, fr, fq, lds, wid, lane); S.done(cur); }
#undef PG8_SA
#undef PG8_SB
#undef PG8_STAGE
#undef PG8_LDA
#undef PG8_LDB
#undef PG8_MMA
#undef PG8_WAIT_V
#undef PG8_WAIT_L
#undef PG8_BAR
#undef PG8_SCHED
}
}

__device__ __forceinline__ void ph_adaln_partials(const Params& p, float* sm) {
    const int tid = tid_fresh();
    float* MODP = (float*)(p.ws + WS_MODP);
    for (int it = blockIdx.x; it < 384; it += gridDim.x) {
        const int l = it / 192, rem = it % 192, kc = rem / 6, cgp = rem % 6;
        __syncthreads();
        if (tid < 192) { const int r = tid >> 6, kk = tid & 63, k = kc * 64 + kk; const float cv = (r < 2) ? p.c[r * 2048 + k] : p.c_ctx[k]; sm[tid] = siluf_(cv); }
        __syncthreads();
        const int col = cgp * 2048 + tid * 4;
        float4 a0 = {0.f, 0.f, 0.f, 0.f}, a1 = a0, a2 = a0;
        const float* wp = p.mod_w + ((size_t)l * 2048 + (size_t)kc * 64) * 12288 + col;
#pragma unroll 8
        for (int kk = 0; kk < 64; ++kk) {
            const float4 w = *(const float4*)(wp + (size_t)kk * 12288);
            const float s0 = sm[kk], s1 = sm[64 + kk], s2 = sm[128 + kk];
            a0.x += s0 * w.x; a0.y += s0 * w.y; a0.z += s0 * w.z; a0.w += s0 * w.w;
            a1.x += s1 * w.x; a1.y += s1 * w.y; a1.z += s1 * w.z; a1.w += s1 * w.w;
            a2.x += s2 * w.x; a2.y += s2 * w.y; a2.z += s2 * w.z; a2.w += s2 * w.w;
        }
        float* o = MODP + ((size_t)(l * 32 + kc) * 3) * 12288 + col;
        *(float4*)(o) = a0; *(float4*)(o + 12288) = a1; *(float4*)(o + 2 * 12288) = a2;
    }
}
__device__ __forceinline__ void ph_adaln_reduce(const Params& p) {
    const float* MODP = (const float*)(p.ws + WS_MODP); float* MOD = (float*)(p.ws + WS_MOD);
    for (int idx = blockIdx.x * NTHR + tid_fresh(); idx < 2 * 3 * 12288; idx += gridDim.x * NTHR) {
        const int l = idx / 36864, r = (idx / 12288) % 3, col = idx % 12288;
        float s = p.mod_b[l * 12288 + col];
        for (int kc = 0; kc < 32; ++kc) s += MODP[((size_t)(l * 32 + kc) * 3 + r) * 12288 + col];
        MOD[idx] = s;
    }
}

template <int MODE> __device__ __forceinline__ int colmap(int n, int nsrc) {
    if (MODE == 0) return n < nsrc ? n : -1;
    if (MODE == 1) { if (n < 3072) return n; if (n < 7168) return n + 16; if (n < 7184) return 3072 + (n - 7168); if (n < 7216) return n; return -1; }
    return ((n >> 7) & 1) * 5632 + (n >> 8) * 128 + (n & 127);
}
template <int MODE> __device__ __forceinline__ void ph_convert(const float* W, int nsrc, int K, int nout, u16* Bt, float* sm) {
    const int tid = tid_fresh(); const int nnt = nout / 64, ntiles = nnt * (K / 64);
    for (int t = blockIdx.x; t < ntiles; t += gridDim.x) {
        const int k0 = (t / nnt) * 64, n0 = (t % nnt) * 64;
        __syncthreads();
#pragma unroll
        for (int i = 0; i < 8; ++i) { const int idx = i * NTHR + tid, kk = idx >> 6, nn = idx & 63; const int src = colmap<MODE>(n0 + nn, nsrc);
            sm[kk * 65 + nn] = src >= 0 ? W[(size_t)(k0 + kk) * nsrc + src] : 0.f; }
        __syncthreads();
        { const int nn = tid >> 3, k8 = (tid & 7) * 8; float v[8];
#pragma unroll
            for (int j = 0; j < 8; ++j) v[j] = sm[(k8 + j) * 65 + nn];
            *(uint4*)(Bt + (size_t)(n0 + nn) * K + k0 + k8) = pack8(v); }
    }
}

__device__ __forceinline__ void ph_norm(const float* srcC, const float* srcL, const float* g, const float* modl, int chunk_sh, int chunk_sc, u16* H, int row_begin) {
    const int tid_ = tid_fresh(); const int lane = tid_ & 63, w = tid_ >> 6;
    for (int row = row_begin + blockIdx.x * 8 + w; row < MTOT; row += gridDim.x * 8) {
        const float* src = row < 512 ? srcC + (size_t)row * 2048 : srcL + (size_t)(row - 512) * 2048;
        const int mr = row < 512 ? 2 : ((row - 512) >> 14);
        const float* sc = modl + (mr * 6 + chunk_sc) * 2048; const float* sh = modl + (mr * 6 + chunk_sh) * 2048;
        float4 v[8]; float ss = 0.f;
#pragma unroll
        for (int i = 0; i < 8; ++i) { v[i] = *(const float4*)(src + i * 256 + lane * 4); ss += v[i].x * v[i].x + v[i].y * v[i].y + v[i].z * v[i].z + v[i].w * v[i].w; }
        ss = red64(ss);
        const float rstd = rsqrtf(ss * (1.f / 2048.f) + 1e-6f);
#pragma unroll
        for (int i = 0; i < 8; ++i) { const int col = i * 256 + lane * 4;
            const float4 g4 = *(const float4*)(g + col), s4 = *(const float4*)(sc + col), h4 = *(const float4*)(sh + col);
            const float y0 = v[i].x * rstd * g4.x * (1.f + s4.x) + h4.x, y1 = v[i].y * rstd * g4.y * (1.f + s4.y) + h4.y;
            const float y2 = v[i].z * rstd * g4.z * (1.f + s4.z) + h4.z, y3 = v[i].w * rstd * g4.w * (1.f + s4.w) + h4.w;
            uint2 o; o.x = cvt_pk_bf16(y0, y1); o.y = cvt_pk_bf16(y2, y3);
            *(uint2*)(H + (size_t)row * 2048 + col) = o; }
    }
}
__device__ __forceinline__ void ph_final_norm(const Params& p) {
    const int tid_ = tid_fresh(); const int lane = tid_ & 63, w = tid_ >> 6;
    for (int row = blockIdx.x * 8 + w; row < MLAT; row += gridDim.x * 8) {
        float* src = p.out + (size_t)row * 2048;
        float4 v[8]; float ss = 0.f;
#pragma unroll
        for (int i = 0; i < 8; ++i) { v[i] = *(const float4*)(src + i * 256 + lane * 4); ss += v[i].x * v[i].x + v[i].y * v[i].y + v[i].z * v[i].z + v[i].w * v[i].w; }
        ss = red64(ss);
        const float rstd = rsqrtf(ss * (1.f / 2048.f) + 1e-6f);
#pragma unroll
        for (int i = 0; i < 8; ++i) { const int col = i * 256 + lane * 4; const float4 g4 = *(const float4*)(p.final_norm_g + col);
            float4 o; o.x = v[i].x * rstd * g4.x; o.y = v[i].y * rstd * g4.y; o.z = v[i].z * rstd * g4.z; o.w = v[i].w * rstd * g4.w;
            *(float4*)(src + col) = o; }
    }
}

__device__ __forceinline__ void ph_l0_prep(const Params& p, float* sm) {
    const int tid = tid_fresh();
    u16* PROJ = (u16*)(p.ws + WS_PROJ); u16* CQ = (u16*)(p.ws + WS_CQ); float* G = (float*)(p.ws + WS_G);
    for (int idx = blockIdx.x * NTHR + tid; idx < MTOT * 48; idx += gridDim.x * NTHR) {
        const int j = idx % 48; const float v = G[idx]; float o;
        if (j < 8) o = v + p.ml_ig_b[j];
        else if (j < 16) o = logsigmoidf_(v + p.ml_fg_b[j - 8]);
        else if (j < 32) { const float dt = softplusf_(v + p.dn_dt_bias[j - 16]); o = -__expf(p.dn_a_log[j - 16]) * dt; }
        else o = sigmoidf_(v);
        G[idx] = o;
    }
    {
        const int NB = (int)gridDim.x;
        const int tk = tid >> 3, cs = (tid & 7) * 16;
        for (int pb = (int)blockIdx.x; pb < (NB < 24 ? 24 : NB); pb += NB) {
        const int part = pb % 24, slot = pb / 24;
        const int nbp = NB >= 24 ? (NB - part + 23) / 24 : 1;
        float wt[5][16];
#pragma unroll
        for (int j = 0; j < 5; ++j)
#pragma unroll
            for (int c4 = 0; c4 < 4; ++c4) { const float4 w4 = *(const float4*)(p.dn_conv_w + j * 3072 + part * 128 + cs + c4 * 4); wt[j][c4 * 4] = w4.x; wt[j][c4 * 4 + 1] = w4.y; wt[j][c4 * 4 + 2] = w4.z; wt[j][c4 * 4 + 3] = w4.w; }
        for (int tt = slot; tt < 520; tt += nbp) {
            const bool isctx = tt < 8;
            const int t0 = isctx ? (tt & 3) * 64 : 0;
            const int rowbase = isctx ? (tt >> 2) * 256 + t0 : 512 + (tt - 8) * 64;
            uint4 in[5][2];
#pragma unroll
            for (int j = 0; j < 5; ++j) { const int r = tk + j - 2;
                const bool ok = isctx ? (t0 + r >= 0 && t0 + r < 256) : (r >= 0 && r < 64);
                in[j][0] = make_uint4(0u, 0u, 0u, 0u); in[j][1] = in[j][0];
                if (ok) { const u16* src = PROJ + (size_t)(rowbase + r) * NP0 + 3072 + part * 128 + cs; in[j][0] = *(const uint4*)(src); in[j][1] = *(const uint4*)(src + 8); } }
            float o[16];
#pragma unroll
            for (int c = 0; c < 16; ++c) o[c] = 0.f;
#pragma unroll
            for (int j = 0; j < 5; ++j) { float f[16]; unpack8(in[j][0], f); unpack8(in[j][1], f + 8);
#pragma unroll
                for (int c = 0; c < 16; ++c) o[c] += f[c] * wt[j][c]; }
            float ss = 0.f;
#pragma unroll
            for (int c = 0; c < 16; ++c) { o[c] = siluf_(o[c]); ss += o[c] * o[c]; }
            ss = red8(ss);
            if (part < 16) { const float sc = rsqrtf(ss + 1e-6f);
#pragma unroll
                for (int c = 0; c < 16; ++c) o[c] *= sc; }
            __syncthreads();
            if (part < 16) {
                const int rs = isctx ? 3072 : NP0; u16* tb = isctx ? CQ + (size_t)rowbase * 3072 + part * 128 : PROJ + (size_t)rowbase * NP0 + 3072 + part * 128;
                const int r0 = ((tk >> 4) * 4 + (cs >> 5)) * 4 + ((cs >> 3) & 3);
                *(uint4*)(tb + (size_t)r0 * rs + (tk & 15) * 8) = pack8(o); *(uint4*)(tb + (size_t)(r0 + 1) * rs + (tk & 15) * 8) = pack8(o + 8);
            } else {
                u16* dst = isctx ? CQ + (size_t)(rowbase + tk) * 3072 + part * 128 + cs : PROJ + (size_t)(rowbase + tk) * NP0 + 3072 + part * 128 + cs;
                *(uint4*)(dst) = pack8(o); *(uint4*)(dst + 8) = pack8(o + 8); }
        }
        }
    }
}

__device__ __forceinline__ void ph_l0_merge(const Params& p) {
    const int tid_ = tid_fresh(); const int lane = tid_ & 63, w = tid_ >> 6;
    const u16* PROJ = (const u16*)(p.ws + WS_PROJ); const u16* OF = (const u16*)(p.ws + WS_OF); const u16* OB = (const u16*)(p.ws + WS_OB); u16* Y = (u16*)(p.ws + WS_H);
    for (int row = blockIdx.x * 8 + w; row < MTOT; row += gridDim.x * 8) {
        float o[4][8]; float ss[4];
#pragma unroll
        for (int k = 0; k < 4; ++k) { const int col = (k * 64 + lane) * 8; float a[8], bb[8];
            unpack8(*(const uint4*)(OF + (size_t)row * 2048 + col), a); unpack8(*(const uint4*)(OB + (size_t)row * 2048 + col), bb);
            float s = 0.f;
#pragma unroll
            for (int j = 0; j < 8; ++j) { o[k][j] = a[j] + bb[j]; s += o[k][j] * o[k][j]; }
            s = red16(s);
            if (k < 2) s += __shfl_xor(s, 16);
            ss[k] = s; }
#pragma unroll
        for (int k = 0; k < 4; ++k) { const int col = (k * 64 + lane) * 8; const bool isml = k < 2;
            const float rstd = isml ? rsqrtf(ss[k] * (1.f / 256.f) + 1e-6f) : rsqrtf(ss[k] * (1.f / 128.f) + 1e-6f);
            const u16* gsrc = PROJ + (size_t)row * NP0 + (isml ? 2048 + col : 6144 + (col - 1024));
            const float* gn = isml ? p.ml_norm_g + col : p.dn_norm_g + (col - 1024);
            float gt[8], r[8]; unpack8(*(const uint4*)gsrc, gt);
            const float4 g0 = *(const float4*)gn, g1 = *(const float4*)(gn + 4); const float gg[8] = {g0.x, g0.y, g0.z, g0.w, g1.x, g1.y, g1.z, g1.w};
#pragma unroll
            for (int j = 0; j < 8; ++j) { const float gate = isml ? sigmoidf_(gt[j]) : siluf_(gt[j]); r[j] = o[k][j] * rstd * gg[j] * gate; }
            *(uint4*)(Y + (size_t)row * 2048 + col) = pack8(r); }
    }
}

typedef short bf16x8_t __attribute__((ext_vector_type(8)));
typedef float f32x4_t __attribute__((ext_vector_type(4)));
__device__ __forceinline__ float wave_cumsum(float x, int lane) {
#pragma unroll
    for (int o = 1; o < 64; o <<= 1) { const float t = __shfl_up(x, o); if (lane >= o) x += t; }
    return x; }
__device__ __forceinline__ float wave_cummax(float x, int lane) {
#pragma unroll
    for (int o = 1; o < 64; o <<= 1) { const float t = __shfl_up(x, o); if (lane >= o) x = fmaxf(x, t); }
    return x; }
__device__ __forceinline__ int tile_of(int n, int b, int dir) { if (n < 4) return b * 4 + (dir ? 3 - n : n); const int li = n - 4; return 8 + b * 256 + (dir ? 255 - li : li); }
__device__ __forceinline__ int rowbase_of(int tt) { return tt < 8 ? tt * 64 : 512 + (tt - 8) * 64; }

__device__ __forceinline__ void ml_prep_item(const Params& p, int it, float* wl, int lane) {
    const int h = it & 3, tt = (it >> 2) % 520, z = it / 2080, rowbase = rowbase_of(tt), fr = lane & 15, fq = lane >> 4;
    const u16* PROJ = (const u16*)(p.ws + WS_PROJ); const float* G = (const float*)(p.ws + WS_G);
    float* MLS = (float*)(p.ws + WS_MLS) + (size_t)it * 256; u16* ATT0 = (u16*)(p.ws + WS_ATT0) + (size_t)it * 4096;
    const int tk = z ? 63 - lane : lane, row = rowbase + tk;
    const float ig = G[row * 48 + z * 4 + h], lf = G[row * 48 + 8 + z * 4 + h];
    const float bb = wave_cumsum(lf, lane), gg = ig - bb, cm = wave_cummax(gg, lane);
    const float bL = __shfl(bb, 63), cmL = __shfl(cm, 63);
    MLS[tk] = bb; MLS[64 + tk] = cm; MLS[128 + tk] = __expf(gg - cmL); if (lane == 0) { MLS[192] = bL; MLS[193] = cmL; }
    wl[tk] = gg; wl[64 + tk] = cm;
#pragma unroll 1
    for (int rt = 0; rt < 4; ++rt) {
        bf16x8_t a[4];
#pragma unroll
        for (int ks = 0; ks < 4; ++ks) a[ks] = *(const bf16x8_t*)(PROJ + (size_t)(rowbase + (rt * 4 + ks) * 4 + fq) * NP0 + h * 128 + fr * 8);
#pragma unroll 1
        for (int ct = 0; ct < 4; ++ct) {
            f32x4_t acc = (f32x4_t){0.f, 0.f, 0.f, 0.f};
#pragma unroll
            for (int ks = 0; ks < 4; ++ks) { const bf16x8_t bfr = *(const bf16x8_t*)(PROJ + (size_t)(rowbase + (ct * 4 + ks) * 4 + fq) * NP0 + 512 + h * 128 + fr * 8);
                acc = __builtin_amdgcn_mfma_f32_16x16x32_bf16(a[ks], bfr, acc, 0, 0, 0); }
            const int s = ct * 16 + fr; const float gs = wl[s];
#pragma unroll
            for (int j = 0; j < 4; ++j) { const int l = rt * 16 + fq * 4 + j; const bool keep = z ? (s >= l) : (s <= l);
                const float e = __expf(fminf(gs - wl[64 + l], 0.f));
                ATT0[(((l >> 4) * 2 + (s >> 5)) * 64 + ((s >> 3) & 3) * 16 + (l & 15)) * 8 + (s & 7)] = f2bf(keep ? acc[j] * 0.08838834764831845f * e : 0.f); }
        }
    }
}
__device__ __forceinline__ void dn_prep_item(const Params& p, int it, float* Ap, int lane) {
    const int h = it & 7, tt = (it >> 3) % 520, z = it / 4160, rowbase = rowbase_of(tt), fr = lane & 15, fq = lane >> 4;
    const bool isctx = tt < 8;
    const u16* qb = isctx ? (const u16*)(p.ws + WS_CQ) + (size_t)rowbase * 3072 + h * 128 : (const u16*)(p.ws + WS_PROJ) + (size_t)rowbase * NP0 + 3072 + h * 128;
    const int rs = isctx ? 3072 : NP0;
    const float* G = (const float*)(p.ws + WS_G);
    float* GCS = (float*)(p.ws + WS_GCS) + (size_t)it * 256; u16* TM = (u16*)(p.ws + WS_TM) + (size_t)it * 4096; u16* QK = (u16*)(p.ws + WS_QK) + (size_t)it * 4096;
    float* gcs = Ap + 4096; float* bes = Ap + 4160;
    const int tk = z ? 63 - lane : lane, row = rowbase + tk;
    const float g = G[row * 48 + 16 + z * 8 + h], be = G[row * 48 + 32 + z * 8 + h];
    const float gc = wave_cumsum(g, lane), gL = __shfl(gc, 63);
    GCS[tk] = __expf(gc); GCS[64 + tk] = be; GCS[128 + tk] = __expf(gL - gc); if (lane == 0) GCS[192] = __expf(gL);
    gcs[tk] = gc; bes[tk] = be;
#pragma unroll 1
    for (int rt = 0; rt < 4; ++rt) {
        bf16x8_t ak[4], aq[4];
#pragma unroll
        for (int ks = 0; ks < 4; ++ks) { ak[ks] = *(const bf16x8_t*)(qb + (size_t)((rt * 4 + ks) * 4 + fq) * rs + 1024 + fr * 8); aq[ks] = *(const bf16x8_t*)(qb + (size_t)((rt * 4 + ks) * 4 + fq) * rs + fr * 8); }
#pragma unroll 1
        for (int ct = 0; ct < 4; ++ct) {
            f32x4_t ck = (f32x4_t){0.f, 0.f, 0.f, 0.f}, cq = ck;
#pragma unroll
            for (int ks = 0; ks < 4; ++ks) { const bf16x8_t bfr = *(const bf16x8_t*)(qb + (size_t)((ct * 4 + ks) * 4 + fq) * rs + 1024 + fr * 8);
                ck = __builtin_amdgcn_mfma_f32_16x16x32_bf16(ak[ks], bfr, ck, 0, 0, 0); cq = __builtin_amdgcn_mfma_f32_16x16x32_bf16(aq[ks], bfr, cq, 0, 0, 0); }
            const int s = ct * 16 + fr; const float gs = gcs[s];
#pragma unroll
            for (int j = 0; j < 4; ++j) { const int l = rt * 16 + fq * 4 + j;
                const bool strict = z ? (s > l) : (s < l), incl = z ? (s >= l) : (s <= l);
                const float e = __expf(fminf(gcs[l] - gs, 0.f));
                const int lp = z ? 63 - l : l, sp = z ? 63 - s : s;
                Ap[lp * 64 + sp] = strict ? bes[l] * ck[j] * e : 0.f;
                QK[(((l >> 4) * 2 + (s >> 5)) * 64 + ((s >> 3) & 3) * 16 + (l & 15)) * 8 + (s & 7)] = f2bf(incl ? cq[j] * 0.08838834764831845f * e : 0.f); }
        }
    }
    Ap[lane] = (lane == 0) ? 1.f : 0.f;
#pragma unroll 1
    for (int i = 1; i < 64; ++i) {
        float t = (i == lane) ? 1.f : 0.f;
#pragma unroll 4
        for (int j = 0; j < i; ++j) t -= Ap[i * 64 + j] * Ap[j * 64 + lane];
        Ap[i * 64 + lane] = t;
    }
    const int sc = z ? 63 - lane : lane;
#pragma unroll 4
    for (int i = 0; i < 64; ++i) { const int l = z ? 63 - i : i; TM[(((l >> 4) * 2 + (sc >> 5)) * 64 + ((sc >> 3) & 3) * 16 + (l & 15)) * 8 + (sc & 7)] = f2bf(Ap[i * 64 + lane]); }
}
__device__ __forceinline__ void ph_l0_prepass(const Params& p, unsigned char* lds) {
    const int tid = tid_fresh(), lane = tid & 63, w = tid >> 6;
    float* wl = (float*)(lds + (size_t)w * 16896);
    const int gw = blockIdx.x * 8 + w, nw = gridDim.x * 8;
    for (int it = gw; it < 4160; it += nw) ml_prep_item(p, it, wl, lane);
    for (int it = gw; it < 8320; it += nw) dn_prep_item(p, it, wl, lane);
}

__device__ __forceinline__ unsigned ml_touch(const Params& p, int n, int b, int h, int dir, int e0, int tid) {
    const int nn = n < NSEG ? n : NSEG - 1;
    const int tt = tile_of(nn, b, dir), it = (dir * 520 + tt) * 4 + h, rowbase = rowbase_of(tt);
    const u16* PROJ = (const u16*)(p.ws + WS_PROJ);
    const u16* a;
    if (tid < 256) a = PROJ + (size_t)(rowbase + ((tid & 127) >> 1)) * NP0 + (tid >> 7) * 512 + h * 128 + (tid & 1) * 64;
    else if (tid < 320) a = PROJ + (size_t)(rowbase + tid - 256) * NP0 + 1024 + h * 256 + e0;
    else if (tid < 384) a = (const u16*)(p.ws + WS_ATT0) + (size_t)it * 4096 + (tid - 320) * 64;
    else a = (const u16*)(p.ws + WS_MLS) + (size_t)it * 512 + ((tid - 384) & 7) * 64;
    return *(const unsigned*)a;
}
struct MlFr { bf16x8_t q[4], at[2]; uint4 kr[2]; uint2 vr; float kw, b[4], cm[4], bL, cmL; };
__device__ __forceinline__ void ml_load(MlFr& F, const Params& p, int n, int b, int h, int dir, int e0, int lt, int fr, int fq, int tl, int seg) {
    const int nn = n < NSEG ? n : NSEG - 1;
    const int tt = tile_of(nn, b, dir), it = (dir * 520 + tt) * 4 + h, rowbase = rowbase_of(tt);
    const u16* PROJ = (const u16*)(p.ws + WS_PROJ);
    const u16* Q = PROJ + (size_t)(rowbase + lt * 16 + fq) * NP0 + h * 128 + fr * 8;
    const u16* AT = (const u16*)(p.ws + WS_ATT0) + (size_t)it * 4096 + lt * 1024 + (fq * 16 + fr) * 8;
    const float* MLS = (const float*)(p.ws + WS_MLS) + (size_t)it * 256;
#pragma unroll
    for (int ks = 0; ks < 4; ++ks) F.q[ks] = *(const bf16x8_t*)(Q + (size_t)ks * 4 * NP0);
#pragma unroll
    for (int ks = 0; ks < 2; ++ks) F.at[ks] = *(const bf16x8_t*)(AT + ks * 512);
    const u16* kp = PROJ + (size_t)(rowbase + ((tl >> 4) * 4 + (seg >> 1)) * 4 + (seg & 1) * 2) * NP0 + 512 + h * 128 + (tl & 15) * 8;
    F.kr[0] = *(const uint4*)(kp); F.kr[1] = *(const uint4*)(kp + NP0);
    F.vr = *(const uint2*)(PROJ + (size_t)(rowbase + tl) * NP0 + 1024 + h * 256 + e0 + seg * 4);
    F.kw = MLS[128 + tl];
#pragma unroll
    for (int j = 0; j < 4; ++j) { F.b[j] = MLS[lt * 16 + fq * 4 + j]; F.cm[j] = MLS[64 + lt * 16 + fq * 4 + j]; }
    F.bL = MLS[192]; F.cmL = MLS[193];
}
__device__ __forceinline__ void mlstm_chunk(const Params& p, int job, unsigned char* lds) {
    const int tid = tid_fresh(), lane = tid & 63, w = tid >> 6, fr = lane & 15, fq = lane >> 4;
    const int chain = job >> 3, cgp = job & 7;
    const int b = chain >> 3, h = (chain >> 1) & 3, dir = chain & 1;
    const int e0 = cgp * 32, lt = w >> 1, et = w & 1, dt0 = (w >> 1) * 2, tl = tid & 63, seg = tid >> 6;
    u16* Cl = (u16*)lds;
    u16* Ktw = (u16*)(lds + 17952);
    u16* Vt = (u16*)(lds + 17952 + 18432);
    u16* O = (u16*)(p.ws + (dir ? WS_OB : WS_OF));
    __syncthreads();
    for (int i = tid; i < 17952 / 4; i += NTHR) ((unsigned*)Cl)[i] = 0u;
    __syncthreads();
    f32x4_t Cacc[2], nacc; Cacc[0] = (f32x4_t){0.f, 0.f, 0.f, 0.f}; Cacc[1] = Cacc[0]; nacc = Cacc[0];
    float m_in = 0.f;
    bf16x8_t ones;
#pragma unroll
    for (int j = 0; j < 8; ++j) ones[j] = (short)0x3F80;
    MlFr buf[2];
    ml_load(buf[0], p, 0, b, h, dir, e0, lt, fr, fq, tl, seg); ml_load(buf[1], p, 1, b, h, dir, e0, lt, fr, fq, tl, seg);
    unsigned pfr[4] = {0u, 0u, 0u, 0u}, sink = 0u;
    for (int n0 = 0; n0 < NSEG; n0 += 4) {
#pragma unroll
        for (int u = 0; u < 4; ++u) {
            const int n = n0 + u; const int s = u & 1;
            sink ^= pfr[u]; pfr[u] = ml_touch(p, n + 5, b, h, dir, e0, tid);
            const MlFr& F = buf[s];
            const int tt = tile_of(n, b, dir), rowbase = rowbase_of(tt);
            const u16* Ccur = Cl + (n & 1) * (33 * 136); u16* Cnxt = Cl + ((n + 1) & 1) * (33 * 136);
            { float k[16]; unpack8(F.kr[0], k); unpack8(F.kr[1], k + 8);
#pragma unroll
                for (int c = 0; c < 16; ++c) Ktw[(seg * 16 + c) * 72 + tl] = f2bf(k[c] * F.kw);
                Vt[(seg * 4 + 0) * 72 + tl] = (u16)(F.vr.x & 0xffffu); Vt[(seg * 4 + 1) * 72 + tl] = (u16)(F.vr.x >> 16);
                Vt[(seg * 4 + 2) * 72 + tl] = (u16)(F.vr.y & 0xffffu); Vt[(seg * 4 + 3) * 72 + tl] = (u16)(F.vr.y >> 16); }
            __syncthreads();
            bf16x8_t vt[2];
#pragma unroll
            for (int ks = 0; ks < 2; ++ks) vt[ks] = *(const bf16x8_t*)(Vt + (et * 16 + fr) * 72 + ks * 32 + fq * 8);
            {
                f32x4_t inter = (f32x4_t){0.f, 0.f, 0.f, 0.f}, intra = inter, dinter = inter, dintra = inter;
#pragma unroll
                for (int ks = 0; ks < 4; ++ks) { const bf16x8_t cb = *(const bf16x8_t*)(Ccur + (et * 16 + fr) * 136 + ks * 32 + fq * 8); const bf16x8_t nb = *(const bf16x8_t*)(Ccur + 32 * 136 + ks * 32 + fq * 8);
                    inter = __builtin_amdgcn_mfma_f32_16x16x32_bf16(F.q[ks], cb, inter, 0, 0, 0); dinter = __builtin_amdgcn_mfma_f32_16x16x32_bf16(F.q[ks], nb, dinter, 0, 0, 0); }
#pragma unroll
                for (int ks = 0; ks < 2; ++ks) { intra = __builtin_amdgcn_mfma_f32_16x16x32_bf16(F.at[ks], vt[ks], intra, 0, 0, 0); dintra = __builtin_amdgcn_mfma_f32_16x16x32_bf16(F.at[ks], ones, dintra, 0, 0, 0); }
#pragma unroll
                for (int j = 0; j < 4; ++j) { const float M = fmaxf(F.cm[j], m_in); const float r = __expf(F.cm[j] - M), ei = __expf(m_in - M) * 0.08838834764831845f;
                    const float num = r * intra[j] + ei * inter[j], den = r * dintra[j] + ei * dinter[j];
                    const float hv = num * frcp(fmaxf(fabsf(den), __expf(-(F.b[j] + M))));
                    O[(size_t)(rowbase + lt * 16 + fq * 4 + j) * 2048 + h * 256 + e0 + et * 16 + fr] = f2bf(hv); }
            }
            { const float ML = fmaxf(F.cmL, m_in); const float a = __expf(m_in - ML), sc2 = __expf(F.cmL - ML); m_in = F.bL + ML;
#pragma unroll
                for (int i = 0; i < 2; ++i) { f32x4_t nw = (f32x4_t){0.f, 0.f, 0.f, 0.f};
#pragma unroll
                    for (int ks = 0; ks < 2; ++ks) { const bf16x8_t kb = *(const bf16x8_t*)(Ktw + ((dt0 + i) * 16 + fr) * 72 + ks * 32 + fq * 8); nw = __builtin_amdgcn_mfma_f32_16x16x32_bf16(vt[ks], kb, nw, 0, 0, 0); }
#pragma unroll
                    for (int j = 0; j < 4; ++j) { Cacc[i][j] = a * Cacc[i][j] + sc2 * nw[j]; Cnxt[(et * 16 + fq * 4 + j) * 136 + (dt0 + i) * 16 + fr] = f2bf(Cacc[i][j]); } }
                f32x4_t nw = (f32x4_t){0.f, 0.f, 0.f, 0.f};
#pragma unroll
                for (int ks = 0; ks < 2; ++ks) { const bf16x8_t kb = *(const bf16x8_t*)(Ktw + (w * 16 + fr) * 72 + ks * 32 + fq * 8); nw = __builtin_amdgcn_mfma_f32_16x16x32_bf16(ones, kb, nw, 0, 0, 0); }
                nacc[0] = a * nacc[0] + sc2 * nw[0];
                if (fq == 0) Cnxt[32 * 136 + w * 16 + fr] = f2bf(nacc[0]); }
            __syncthreads();
            ml_load(buf[s], p, n + 2, b, h, dir, e0, lt, fr, fq, tl, seg);
        }
    }
    ((unsigned*)(p.ws + WS_MODP))[blockIdx.x * NTHR + tid] = sink ^ pfr[0] ^ pfr[1] ^ pfr[2] ^ pfr[3];
}

__device__ __forceinline__ unsigned dn_touch(const Params& p, int n, int b, int h, int dir, int e0, int tid) {
    const int nn = n < NSEG ? n : NSEG - 1;
    const int tt = tile_of(nn, b, dir), it = (dir * 520 + tt) * 8 + h, rowbase = rowbase_of(tt);
    const bool isctx = tt < 8;
    const u16* qb = isctx ? (const u16*)(p.ws + WS_CQ) + (size_t)rowbase * 3072 + h * 128 : (const u16*)(p.ws + WS_PROJ) + (size_t)rowbase * NP0 + 3072 + h * 128;
    const int rs = isctx ? 3072 : NP0;
    const u16* a;
    if (tid < 256) a = qb + (size_t)((tid & 127) >> 1) * rs + (tid >> 7) * 1024 + (tid & 1) * 64;
    else if (tid < 320) a = qb + (size_t)(tid - 256) * rs + 2048 + e0;
    else if (tid < 384) a = (const u16*)(p.ws + WS_TM) + (size_t)it * 4096 + (tid - 320) * 64;
    else if (tid < 448) a = (const u16*)(p.ws + WS_QK) + (size_t)it * 4096 + (tid - 384) * 64;
    else a = (const u16*)(p.ws + WS_GCS) + (size_t)it * 512 + ((tid - 448) & 7) * 64;
    return *(const unsigned*)a;
}
struct DnFr { bf16x8_t k[4], q[4], tm[2], qk[2]; uint4 kr[2]; float kds, egc[4], be[4], egL; u16 v[4]; };
__device__ __forceinline__ void dn_load(DnFr& F, const Params& p, int n, int b, int h, int dir, int e0, int lt, int et, int fr, int fq, int tl, int seg) {
    const int nn = n < NSEG ? n : NSEG - 1;
    const int tt = tile_of(nn, b, dir), it = (dir * 520 + tt) * 8 + h, rowbase = rowbase_of(tt);
    const bool isctx = tt < 8;
    const u16* qb = isctx ? (const u16*)(p.ws + WS_CQ) + (size_t)rowbase * 3072 + h * 128 : (const u16*)(p.ws + WS_PROJ) + (size_t)rowbase * NP0 + 3072 + h * 128;
    const int rs = isctx ? 3072 : NP0;
    const u16* TM = (const u16*)(p.ws + WS_TM) + (size_t)it * 4096 + lt * 1024 + (fq * 16 + fr) * 8;
    const u16* QK = (const u16*)(p.ws + WS_QK) + (size_t)it * 4096 + lt * 1024 + (fq * 16 + fr) * 8;
    const float* GCS = (const float*)(p.ws + WS_GCS) + (size_t)it * 256;
    const u16* qr = qb + (size_t)(lt * 16 + fq) * rs + fr * 8;
#pragma unroll
    for (int ks = 0; ks < 4; ++ks) { F.q[ks] = *(const bf16x8_t*)(qr + (size_t)ks * 4 * rs); F.k[ks] = *(const bf16x8_t*)(qr + (size_t)ks * 4 * rs + 1024); }
#pragma unroll
    for (int ks = 0; ks < 2; ++ks) { F.tm[ks] = *(const bf16x8_t*)(TM + ks * 512); F.qk[ks] = *(const bf16x8_t*)(QK + ks * 512); }
    const u16* kp = qb + (size_t)(((tl >> 4) * 4 + (seg >> 1)) * 4 + (seg & 1) * 2) * rs + 1024 + (tl & 15) * 8;
    F.kr[0] = *(const uint4*)(kp); F.kr[1] = *(const uint4*)(kp + rs);
    F.kds = GCS[128 + tl]; F.egL = GCS[192];
#pragma unroll
    for (int j = 0; j < 4; ++j) { const int l = lt * 16 + fq * 4 + j; F.egc[j] = GCS[l]; F.be[j] = GCS[64 + l]; F.v[j] = qb[(size_t)l * rs + 2048 + e0 + et * 16 + fr]; }
}
__device__ __forceinline__ void deltanet_chunk(const Params& p, int job, unsigned char* lds) {
    const int tid = tid_fresh(), lane = tid & 63, w = tid >> 6, fr = lane & 15, fq = lane >> 4;
    const int chain = job >> 2, cgp = job & 3;
    const int b = chain >> 4, h = (chain >> 1) & 7, dir = chain & 1;
    const int e0 = cgp * 32, lt = w >> 1, et = w & 1, dt0 = (w >> 1) * 2, tl = tid & 63, seg = tid >> 6;
    u16* Sl = (u16*)lds;
    u16* Rt = (u16*)(lds + 17408);
    u16* VNt = (u16*)(lds + 17408 + 4608);
    u16* Kdt = (u16*)(lds + 17408 + 9216);
    u16* O = (u16*)(p.ws + (dir ? WS_OB : WS_OF));
    __syncthreads();
    for (int i = tid; i < 17408 / 4; i += NTHR) ((unsigned*)Sl)[i] = 0u;
    __syncthreads();
    f32x4_t Sacc[2]; Sacc[0] = (f32x4_t){0.f, 0.f, 0.f, 0.f}; Sacc[1] = Sacc[0];
    DnFr buf[2];
    dn_load(buf[0], p, 0, b, h, dir, e0, lt, et, fr, fq, tl, seg); dn_load(buf[1], p, 1, b, h, dir, e0, lt, et, fr, fq, tl, seg);
    unsigned pfr[4] = {0u, 0u, 0u, 0u}, sink = 0u;
    for (int n0 = 0; n0 < NSEG; n0 += 4) {
#pragma unroll
        for (int u = 0; u < 4; ++u) {
            const int n = n0 + u; const int s = u & 1;
            sink ^= pfr[u]; pfr[u] = dn_touch(p, n + 5, b, h, dir, e0, tid);
            const DnFr& F = buf[s];
            const int tt = tile_of(n, b, dir), rowbase = rowbase_of(tt);
            const u16* Scur = Sl + (n & 1) * (32 * 136); u16* Snxt = Sl + ((n + 1) & 1) * (32 * 136);
            f32x4_t X = (f32x4_t){0.f, 0.f, 0.f, 0.f}, Y = X;
#pragma unroll
            for (int ks = 0; ks < 4; ++ks) { const bf16x8_t sb = *(const bf16x8_t*)(Scur + (et * 16 + fr) * 136 + ks * 32 + fq * 8);
                X = __builtin_amdgcn_mfma_f32_16x16x32_bf16(F.k[ks], sb, X, 0, 0, 0); Y = __builtin_amdgcn_mfma_f32_16x16x32_bf16(F.q[ks], sb, Y, 0, 0, 0); }
#pragma unroll
            for (int j = 0; j < 4; ++j) Rt[(et * 16 + fr) * 72 + lt * 16 + fq * 4 + j] = f2bf(F.be[j] * (bf2f(F.v[j]) - F.egc[j] * X[j]));
            { float k[16]; unpack8(F.kr[0], k); unpack8(F.kr[1], k + 8);
#pragma unroll
                for (int c = 0; c < 16; ++c) Kdt[(seg * 16 + c) * 72 + tl] = f2bf(k[c] * F.kds); }
            __syncthreads();
            { f32x4_t VN = (f32x4_t){0.f, 0.f, 0.f, 0.f};
#pragma unroll
                for (int ks = 0; ks < 2; ++ks) { const bf16x8_t rb = *(const bf16x8_t*)(Rt + (et * 16 + fr) * 72 + ks * 32 + fq * 8); VN = __builtin_amdgcn_mfma_f32_16x16x32_bf16(F.tm[ks], rb, VN, 0, 0, 0); }
#pragma unroll
                for (int j = 0; j < 4; ++j) VNt[(et * 16 + fr) * 72 + lt * 16 + fq * 4 + j] = f2bf(VN[j]); }
            __syncthreads();
            bf16x8_t vn[2];
#pragma unroll
            for (int ks = 0; ks < 2; ++ks) vn[ks] = *(const bf16x8_t*)(VNt + (et * 16 + fr) * 72 + ks * 32 + fq * 8);
            { f32x4_t acc = (f32x4_t){0.f, 0.f, 0.f, 0.f};
#pragma unroll
                for (int ks = 0; ks < 2; ++ks) acc = __builtin_amdgcn_mfma_f32_16x16x32_bf16(F.qk[ks], vn[ks], acc, 0, 0, 0);
#pragma unroll
                for (int j = 0; j < 4; ++j) O[(size_t)(rowbase + lt * 16 + fq * 4 + j) * 2048 + 1024 + h * 128 + e0 + et * 16 + fr] = f2bf(0.08838834764831845f * F.egc[j] * Y[j] + acc[j]); }
#pragma unroll
            for (int i = 0; i < 2; ++i) { f32x4_t nw = (f32x4_t){0.f, 0.f, 0.f, 0.f};
#pragma unroll
                for (int ks = 0; ks < 2; ++ks) { const bf16x8_t kb = *(const bf16x8_t*)(Kdt + ((dt0 + i) * 16 + fr) * 72 + ks * 32 + fq * 8); nw = __builtin_amdgcn_mfma_f32_16x16x32_bf16(vn[ks], kb, nw, 0, 0, 0); }
#pragma unroll
                for (int j = 0; j < 4; ++j) { Sacc[i][j] = F.egL * Sacc[i][j] + nw[j]; Snxt[(et * 16 + fq * 4 + j) * 136 + (dt0 + i) * 16 + fr] = f2bf(Sacc[i][j]); } }
            __syncthreads();
            dn_load(buf[s], p, n + 2, b, h, dir, e0, lt, et, fr, fq, tl, seg);
        }
    }
    ((unsigned*)(p.ws + WS_MODP))[blockIdx.x * NTHR + tid] = sink ^ pfr[0] ^ pfr[1] ^ pfr[2] ^ pfr[3];
}

constexpr int RG_XC = 65536;

__device__ __forceinline__ void ph_convert_rg(const Params& p) {
    u16* WRT = (u16*)(p.ws + WS_WRT);
    for (int idx = blockIdx.x * NTHR + tid_fresh(); idx < 65536; idx += gridDim.x * NTHR) {
        const int k8 = idx & 15, n = (idx >> 4) & 127, mzg = idx >> 11;
        const float* W = (mzg < 16 ? p.rg_w_r : p.rg_w_i) + (size_t)(mzg & 15) * 16384;
        float v[8];
#pragma unroll
        for (int j = 0; j < 8; ++j) v[j] = W[(k8 * 8 + j) * 128 + n];
        *(uint4*)(WRT + (size_t)mzg * 16384 + (((n >> 4) * 4 + (k8 >> 2)) * 64 + (k8 & 3) * 16 + (n & 15)) * 8) = pack8(v);
    }
}
__device__ __forceinline__ int rg_tau(int tt, int z) { if (tt < 8) { const int ci = tt & 3; return z ? 3 - ci : ci; } const int li = (tt - 8) & 255; return 4 + (z ? 255 - li : li); }
__device__ __forceinline__ int rg_batch(int tt) { return tt < 8 ? (tt >> 2) : ((tt - 8) >> 8); }

__device__ __forceinline__ void rg_conv(const Params& p, int tt, int g, unsigned char* lds) {
    const int tid = tid_fresh();
    const u16* PROJ = (const u16*)(p.ws + WS_PROJ);
    u16* XC = (u16*)(lds + RG_XC);
    const bool isctx = tt < 8;
    const int t0 = isctx ? (tt & 3) * 64 : 0;
    const int rowbase = isctx ? (tt >> 2) * 256 + t0 : 512 + (tt - 8) * 64;
    const int tk = tid >> 3, cs = (tid & 7) * 16;
    uint4 in[5][2];
#pragma unroll
    for (int j = 0; j < 5; ++j) { const int r = tk + j - 2;
        const bool ok = isctx ? (t0 + r >= 0 && t0 + r < 256) : (r >= 0 && r < 64);
        in[j][0] = make_uint4(0u, 0u, 0u, 0u); in[j][1] = in[j][0];
        if (ok) { const u16* src = PROJ + (size_t)(rowbase + r) * NP1 + g * 128 + cs; in[j][0] = *(const uint4*)(src); in[j][1] = *(const uint4*)(src + 8); } }
    float o[16];
#pragma unroll
    for (int c4 = 0; c4 < 4; ++c4) { const float4 b4 = *(const float4*)(p.rg_conv_b + g * 128 + cs + c4 * 4); o[c4 * 4] = b4.x; o[c4 * 4 + 1] = b4.y; o[c4 * 4 + 2] = b4.z; o[c4 * 4 + 3] = b4.w; }
#pragma unroll
    for (int j = 0; j < 5; ++j) {
        const float* wr_ = p.rg_conv_w + j * 1024 + g * 128 + cs; float f[16]; unpack8(in[j][0], f); unpack8(in[j][1], f + 8);
#pragma unroll
        for (int c4 = 0; c4 < 4; ++c4) { const float4 w4 = *(const float4*)(wr_ + c4 * 4);
            o[c4 * 4 + 0] += f[c4 * 4 + 0] * w4.x; o[c4 * 4 + 1] += f[c4 * 4 + 1] * w4.y; o[c4 * 4 + 2] += f[c4 * 4 + 2] * w4.z; o[c4 * 4 + 3] += f[c4 * 4 + 3] * w4.w; }
    }
    __syncthreads();
    *(uint4*)(XC + tk * 136 + cs) = pack8(o); *(uint4*)(XC + tk * 136 + cs + 8) = pack8(o + 8);
    __syncthreads();
}
__device__ __forceinline__ void rg_gates_reg(const Params& p, int g, int z, const unsigned char* lds, int rt, int chh, int fr, int fq, float (&av)[4][4], float (&bx)[4][4]) {
    const u16* XC = (const u16*)(lds + RG_XC);
    const u16* WR = (const u16*)(p.ws + WS_WRT) + (size_t)((0 * 2 + z) * 8 + g) * 16384; const u16* WI = (const u16*)(p.ws + WS_WRT) + (size_t)((1 * 2 + z) * 8 + g) * 16384;
    f32x4_t R[4], I[4];
#pragma unroll
    for (int c = 0; c < 4; ++c) { R[c] = (f32x4_t){0.f, 0.f, 0.f, 0.f}; I[c] = (f32x4_t){0.f, 0.f, 0.f, 0.f}; }
#pragma unroll
    for (int ks = 0; ks < 4; ++ks) {
        const bf16x8_t a = *(const bf16x8_t*)(XC + (rt * 16 + fr) * 136 + ks * 32 + fq * 8);
#pragma unroll
        for (int c = 0; c < 4; ++c) { const int fo = (((chh * 4 + c) * 4 + ks) * 64 + fq * 16 + fr) * 8;
            R[c] = __builtin_amdgcn_mfma_f32_16x16x32_bf16(a, *(const bf16x8_t*)(WR + fo), R[c], 0, 0, 0);
            I[c] = __builtin_amdgcn_mfma_f32_16x16x32_bf16(a, *(const bf16x8_t*)(WI + fo), I[c], 0, 0, 0); }
    }
#pragma unroll
    for (int c = 0; c < 4; ++c) {
        const int chl = (chh * 4 + c) * 16 + fr, chg = z * 1024 + g * 128 + chl;
        const float br = p.rg_b_r[chg], bi = p.rg_b_i[chg], sp = softplusf_(-p.rg_lambda[chg]);
#pragma unroll
        for (int j = 0; j < 4; ++j) { const int t = rt * 16 + fq * 4 + j;
            const float r = sigmoidf_(R[c][j] + br), ii = sigmoidf_(I[c][j] + bi);
            const float la = -8.f * r * sp;
            av[c][j] = __expf(la); bx[c][j] = __builtin_amdgcn_sqrtf(neg_expm1_small(2.f * la)) * ii * bf2f(XC[t * 136 + chl]); }
    }
}
__device__ __forceinline__ float2 rg_local(const float (&a)[4], const float (&b)[4], int z) {
    float P = 1.f, H = 0.f;
#pragma unroll
    for (int i = 0; i < 4; ++i) { const int j = z ? 3 - i : i; H = a[j] * H + b[j]; P *= a[j]; }
    return make_float2(P, H);
}
__device__ __forceinline__ void gla_prep_item(const Params& p, int it, unsigned char* lds) {
    const int tid = tid_fresh(), lane = tid & 63, w = tid >> 6, fr = lane & 15, fq = lane >> 4;
    const int h = it & 3, tt = (it >> 2) % 520, z = it / 2080;
    const int rowbase = tt < 8 ? tt * 64 : 512 + (tt - 8) * 64;
    float* LG = (float*)lds;
    u16* QEs = (u16*)(lds + 32768);
    u16* KEs = (u16*)(lds + 32768 + 17408);
    u16* Vs = (u16*)(lds + 32768 + 2 * 17408);
    float* BLs = (float*)(lds + 32768 + 2 * 17408 + 33792);
    const u16* PROJ = (const u16*)(p.ws + WS_PROJ); const float* LR = (const float*)(p.ws + WS_G);
    u16* QE = (u16*)(p.ws + WS_QE); u16* KDT = (u16*)(p.ws + WS_KDT) + (size_t)it * 8192; u16* ATT = (u16*)(p.ws + WS_ATT) + (size_t)it * 4096;
    u16* VT = (u16*)(p.ws + WS_VT); float* EBL = (float*)(p.ws + WS_EBL);
    __syncthreads();
    { float* LRs = (float*)(lds + 32768);
        for (int i = tid; i < 1024; i += NTHR) LRs[i] = LR[(size_t)(rowbase + (i >> 4)) * 32 + z * 16 + (i & 15)];
        __syncthreads();
        const int c = tid & 127, tq = tid >> 7; float wv[16];
#pragma unroll
        for (int r = 0; r < 16; ++r) wv[r] = p.gla_w_up[(z * 16 + r) * 512 + h * 128 + c];
        const float bu = p.gla_b_up[z * 512 + h * 128 + c];
        for (int i = 0; i < 16; ++i) { const int tk = tq * 16 + i; const float4* lr4 = (const float4*)(LRs + tk * 16); float s = bu;
#pragma unroll
            for (int r4 = 0; r4 < 4; ++r4) { const float4 l4 = lr4[r4]; s += l4.x * wv[r4 * 4] + l4.y * wv[r4 * 4 + 1] + l4.z * wv[r4 * 4 + 2] + l4.w * wv[r4 * 4 + 3]; }
            LG[tk * 128 + c] = logsigmoidf_(s) * (1.f / 16.f); } }
    __syncthreads();
    if (tid < 128) { float acc = 0.f;
        for (int i = 0; i < 64; ++i) { const int tk = z ? 63 - i : i; acc += LG[tk * 128 + tid]; LG[tk * 128 + tid] = acc; }
        BLs[tid] = acc; EBL[(size_t)it * 128 + tid] = __expf(acc); }
    __syncthreads();
    { const int tk = tid >> 3, cs = (tid & 7) * 16; const u16* rp = PROJ + (size_t)(rowbase + tk) * NP1;
        float q[16], k[16], qe[16], ke[16];
        unpack8(*(const uint4*)(rp + 2048 + h * 128 + cs), q); unpack8(*(const uint4*)(rp + 2048 + h * 128 + cs + 8), q + 8);
        unpack8(*(const uint4*)(rp + 2560 + h * 128 + cs), k); unpack8(*(const uint4*)(rp + 2560 + h * 128 + cs + 8), k + 8);
#pragma unroll
        for (int c = 0; c < 16; ++c) { const float bb = LG[tk * 128 + cs + c], bl = BLs[cs + c];
            qe[c] = q[c] * 0.08838834764831845f * __expf(bb); ke[c] = k[c] * __expf(-bb);
            { const int d = cs + c; KDT[(((d >> 4) * 2 + (tk >> 5)) * 64 + ((tk >> 3) & 3) * 16 + (d & 15)) * 8 + (tk & 7)] = f2bf(k[c] * __expf(bl - bb)); } }
        const uint4 q0 = pack8(qe), q1 = pack8(qe + 8);
        *(uint4*)(QEs + tk * 136 + cs) = q0; *(uint4*)(QEs + tk * 136 + cs + 8) = q1;
        *(uint4*)(KEs + tk * 136 + cs) = pack8(ke); *(uint4*)(KEs + tk * 136 + cs + 8) = pack8(ke + 8);
        u16* qg = QE + (size_t)it * 8192 + (((tk >> 4) * 4 + (cs >> 5)) * 64 + ((cs >> 3) & 3) * 16 + (tk & 15)) * 8;
        *(uint4*)(qg) = q0; *(uint4*)(qg + 128) = q1; }
    if (z == 0) for (int ch = tid; ch < 2048; ch += NTHR) { const int tk = ch >> 5, c8 = (ch & 31) * 8;
        *(uint4*)(Vs + tk * 264 + c8) = *(const uint4*)(PROJ + (size_t)(rowbase + tk) * NP1 + 3072 + h * 256 + c8); }
    __syncthreads();
    { const int rt = w >> 1;
#pragma unroll
        for (int i = 0; i < 2; ++i) { const int ct = (w & 1) * 2 + i; f32x4_t acc = (f32x4_t){0.f, 0.f, 0.f, 0.f};
#pragma unroll
            for (int ks = 0; ks < 4; ++ks) { const bf16x8_t a = *(const bf16x8_t*)(QEs + (rt * 16 + fr) * 136 + ks * 32 + fq * 8); const bf16x8_t bb = *(const bf16x8_t*)(KEs + (ct * 16 + fr) * 136 + ks * 32 + fq * 8);
                acc = __builtin_amdgcn_mfma_f32_16x16x32_bf16(a, bb, acc, 0, 0, 0); }
#pragma unroll
            for (int j = 0; j < 4; ++j) { const int l = rt * 16 + fq * 4 + j, s = ct * 16 + fr; const bool keep = z ? (s >= l) : (s <= l);
                ATT[(((l >> 4) * 2 + (s >> 5)) * 64 + ((s >> 3) & 3) * 16 + (l & 15)) * 8 + (s & 7)] = f2bf(keep ? acc[j] : 0.f); } } }
    if (z == 0) { const int e = tid >> 1, hf = tid & 1; u16* dst = VT + (size_t)(tt * 4 + h) * 16384 + (((e >> 4) * 2 + hf) * 64 + (e & 15)) * 8;
#pragma unroll
        for (int l8 = 0; l8 < 4; ++l8) { float v[8];
#pragma unroll
            for (int j = 0; j < 8; ++j) v[j] = bf2f(Vs[(hf * 32 + l8 * 8 + j) * 264 + e]);
            *(uint4*)(dst + l8 * 128) = pack8(v); } }
}
__device__ __forceinline__ void ph_l1_a(const Params& p, unsigned char* lds, int parts = 3) {
    const int tid = tid_fresh(), lane = tid & 63, w = tid >> 6, rt = w >> 1, chh = w & 1, fr = lane & 15, fq = lane >> 4;
#ifdef PROBE3
    if (blockIdx.x == 100 && tid == 0) { unsigned long long* pr = (unsigned long long*)(p.ws + WS_MODP) + 500000; pr[0] = __builtin_amdgcn_s_memrealtime(); }
#endif
    float2* AGG = (float2*)(p.ws + WS_AGG);
    float2* AG = (float2*)lds;
    if (parts & 1) for (int t = blockIdx.x; t < 520 * 8; t += gridDim.x) {
        const int tt = t >> 3, g = t & 7, b = rg_batch(tt);
        rg_conv(p, tt, g, lds);
#pragma unroll
        for (int z = 0; z < 2; ++z) {
            float av[4][4], bx[4][4];
            rg_gates_reg(p, g, z, lds, rt, chh, fr, fq, av, bx);
#pragma unroll
            for (int c = 0; c < 4; ++c) AG[(z * 16 + rt * 4 + fq) * 128 + (chh * 4 + c) * 16 + fr] = rg_local(av[c], bx[c], z);
        }
        __syncthreads();
        if (tid < 256) { const int z = tid >> 7, ch = tid & 127; float P = 1.f, H = 0.f;
#pragma unroll
            for (int s = 0; s < 16; ++s) { const int gi = z ? 15 - s : s; const float2 ph = AG[(z * 16 + gi) * 128 + ch]; H = ph.x * H + ph.y; P *= ph.x; }
            AGG[((size_t)(b * 2 + z) * NSEG + rg_tau(tt, z)) * 1024 + g * 128 + ch] = make_float2(P, H); }
    }
#ifdef PROBE3
    __syncthreads(); const unsigned long long tm_ = __builtin_amdgcn_s_memrealtime();
#endif
    if (parts & 2) for (int it = blockIdx.x; it < 4160; it += gridDim.x) gla_prep_item(p, it, lds);
#ifdef PROBE3
    __syncthreads(); if (blockIdx.x == 100 && tid == 0) { unsigned long long* pr = (unsigned long long*)(p.ws + WS_MODP) + 500000; pr[1] = tm_; pr[2] = __builtin_amdgcn_s_memrealtime(); }
#endif
}
__device__ __forceinline__ void rg_pass_b(const Params& p, int job) {
    const float2* __restrict__ AGG = (const float2*)(p.ws + WS_AGG); float* __restrict__ CARRY = (float*)(p.ws + WS_CARRY);
    const int bz = job >> 1, ch = (job & 1) * 512 + tid_fresh();
    float carry = 0.f;
    for (int t0 = 0; t0 < NSEG; t0 += 20) {
        float2 ph[20];
#pragma unroll
        for (int i = 0; i < 20; ++i) ph[i] = AGG[((size_t)bz * NSEG + t0 + i) * 1024 + ch];
#pragma unroll
        for (int i = 0; i < 20; ++i) { CARRY[((size_t)bz * NSEG + t0 + i) * 1024 + ch] = carry; carry = ph[i].x * carry + ph[i].y; }
    }
}
struct GlaFr { bf16x8_t qe[4], at[2], vt[2], kd[2][2]; float eb[2]; };
struct GlaOff { int qe, at, vt, kd, eb, o, tch, tsel; };
__device__ __forceinline__ void gla_load(GlaFr& F, const unsigned char* ws, int n, int b, int h, int dir, const GlaOff& o) {
    const int nn = n < NSEG ? n : NSEG - 1;
    const int tt = tile_of(nn, b, dir), it = (dir * 520 + tt) * 4 + h, rowbase = rowbase_of(tt);
    const u16* QE = (const u16*)(ws + WS_QE) + (size_t)it * 8192;
    const u16* AT = (const u16*)(ws + WS_ATT) + (size_t)it * 4096;
    const u16* VT = (const u16*)(ws + WS_VT) + (size_t)(tt * 4 + h) * 16384;
    const u16* KD = (const u16*)(ws + WS_KDT) + (size_t)it * 8192;
    const float* EB = (const float*)(ws + WS_EBL) + (size_t)it * 128;
#pragma unroll
    for (int ks = 0; ks < 4; ++ks) F.qe[ks] = *(const bf16x8_t*)(QE + o.qe + ks * 512);
#pragma unroll
    for (int ks = 0; ks < 2; ++ks) { F.at[ks] = *(const bf16x8_t*)(AT + o.at + ks * 512); F.vt[ks] = *(const bf16x8_t*)(VT + o.vt + ks * 512);
        F.kd[0][ks] = *(const bf16x8_t*)(KD + o.kd + ks * 512); F.kd[1][ks] = *(const bf16x8_t*)(KD + o.kd + 1024 + ks * 512); }
    F.eb[0] = EB[o.eb]; F.eb[1] = EB[o.eb + 16];
}
__device__ __forceinline__ unsigned gla_touch(const unsigned char* ws, int n, int b, int h, int dir, const GlaOff& o) {
    const int nn = n < NSEG ? n : NSEG - 1;
    const int tt = tile_of(nn, b, dir), it = (dir * 520 + tt) * 4 + h, rowbase = rowbase_of(tt);
    const u16* base;
    if (o.tsel == 0) base = (const u16*)(ws + WS_QE) + (size_t)it * 8192;
    else if (o.tsel == 1) base = (const u16*)(ws + WS_KDT) + (size_t)it * 8192;
    else if (o.tsel == 2) base = (const u16*)(ws + WS_ATT) + (size_t)it * 4096;
    else base = (const u16*)(ws + WS_VT) + (size_t)(tt * 4 + h) * 16384;
    return *(const unsigned*)(base + o.tch);
}
__device__ __forceinline__ void gla_chunk(const Params& p, int job, unsigned char* lds) {
    const int tid = tid_fresh(), lane = tid & 63, w = __builtin_amdgcn_readfirstlane(tid >> 6), fr = lane & 15, fq = lane >> 4;
    const int chain = job >> 3, cgp = job & 7;
    const int b = chain >> 3, h = (chain >> 1) & 3, dir = chain & 1;
    const int e0 = cgp * 32, lt = w >> 1, et = w & 1, dt0 = (w >> 1) * 2;
    const unsigned char* ws = p.ws;
    GlaOff o;
    o.qe = lt * 2048 + lane * 8; o.at = lt * 1024 + lane * 8; o.vt = ((e0 >> 4) + et) * 1024 + lane * 8;
    o.kd = dt0 * 1024 + lane * 8; o.eb = dt0 * 16 + fr; o.o = (lt * 16 + fq * 4) * 1024 + h * 256 + e0 + et * 16 + fr;
    o.tsel = w < 2 ? 0 : (w < 4 ? 1 : (w == 4 ? 2 : 3));
    o.tch = w < 2 ? (w * 64 + lane) * 64 : (w < 4 ? ((w - 2) * 64 + lane) * 64 : (w == 4 ? lane * 64 : (e0 >> 4) * 1024 + (lane & 31) * 64));
    u16* Sl = (u16*)lds;
    u16* O = (u16*)(p.ws + (dir ? WS_OB1 : WS_OF1));
    const int sRd = (et * 16 + fr) * 136 + fq * 8, sWr = (et * 16 + fq * 4) * 136 + dt0 * 16 + fr;
    __syncthreads();
    for (int i = tid; i < 2 * 32 * 136 / 2; i += NTHR) ((unsigned*)Sl)[i] = 0u;
    __syncthreads();
    f32x4_t Sacc[2]; Sacc[0] = (f32x4_t){0.f, 0.f, 0.f, 0.f}; Sacc[1] = Sacc[0];
    GlaFr buf[2];
    gla_load(buf[0], ws, 0, b, h, dir, o); gla_load(buf[1], ws, 1, b, h, dir, o);
    unsigned pfr[4] = {0u, 0u, 0u, 0u}, sink = 0u;
    for (int n0 = 0; n0 < NSEG; n0 += 4) {
#pragma unroll
        for (int u = 0; u < 4; ++u) {
            const int n = n0 + u; const int s = u & 1;
            sink ^= pfr[u]; if (w < 6) pfr[u] = gla_touch(ws, n + 5, b, h, dir, o);
            const GlaFr& F = buf[s];
            const u16* Scur = Sl + (n & 1) * (32 * 136); u16* Snxt = Sl + ((n + 1) & 1) * (32 * 136);
            if (n >= 4) {
                const int tt = tile_of(n, b, dir);
                u16* Ou = O + (size_t)(512 + (tt - 8) * 64) * 1024;
                f32x4_t acc = (f32x4_t){0.f, 0.f, 0.f, 0.f};
#pragma unroll
                for (int ks = 0; ks < 4; ++ks) { const bf16x8_t bb = *(const bf16x8_t*)(Scur + sRd + ks * 32); acc = __builtin_amdgcn_mfma_f32_16x16x32_bf16(F.qe[ks], bb, acc, 0, 0, 0); }
#pragma unroll
                for (int ks = 0; ks < 2; ++ks) acc = __builtin_amdgcn_mfma_f32_16x16x32_bf16(F.at[ks], F.vt[ks], acc, 0, 0, 0);
#pragma unroll
                for (int j = 0; j < 4; ++j) Ou[o.o + j * 1024] = f2bf(acc[j]);
            }
#pragma unroll
            for (int i = 0; i < 2; ++i) { f32x4_t nw = (f32x4_t){0.f, 0.f, 0.f, 0.f};
#pragma unroll
                for (int ks = 0; ks < 2; ++ks) nw = __builtin_amdgcn_mfma_f32_16x16x32_bf16(F.vt[ks], F.kd[i][ks], nw, 0, 0, 0);
#pragma unroll
                for (int j = 0; j < 4; ++j) { Sacc[i][j] = F.eb[i] * Sacc[i][j] + nw[j]; Snxt[sWr + j * 136 + i * 16] = f2bf(Sacc[i][j]); } }
            __syncthreads();
            gla_load(buf[s], ws, n + 2, b, h, dir, o);
        }
    }
    ((unsigned*)(p.ws + WS_MODP))[blockIdx.x * NTHR + tid] = sink ^ pfr[0] ^ pfr[1] ^ pfr[2] ^ pfr[3];
}
__device__ __forceinline__ void ph_l1_c(const Params& p, unsigned char* lds, int t_lo, int t_hi, int first, int stride, int do_merge) {
    const int tid = tid_fresh(), rt = (tid >> 6) >> 1, chh = (tid >> 6) & 1, fr = tid & 15, fq = (tid & 63) >> 4;
    const u16* PROJ = (const u16*)(p.ws + WS_PROJ); const float* CARRY = (const float*)(p.ws + WS_CARRY); u16* Y = (u16*)(p.ws + WS_H);
    float2* AG = (float2*)lds;
    float* CIN = (float*)(lds + 32768);
    for (int t = t_lo + first; t < t_hi; t += stride) {
        const int tt = t >> 3, g = t & 7, b = rg_batch(tt);
        const int rowbase = 512 + (tt - 8) * 64;
        rg_conv(p, tt, g, lds);
        u16 grv[4][4];
#pragma unroll
        for (int c = 0; c < 4; ++c)
#pragma unroll
            for (int j = 0; j < 4; ++j) grv[c][j] = PROJ[(size_t)(rowbase + rt * 16 + fq * 4 + j) * NP1 + 1024 + g * 128 + (chh * 4 + c) * 16 + fr];
        float av[2][4][4], bx[2][4][4];
#pragma unroll
        for (int z = 0; z < 2; ++z) {
            rg_gates_reg(p, g, z, lds, rt, chh, fr, fq, av[z], bx[z]);
#pragma unroll
            for (int c = 0; c < 4; ++c) AG[(z * 16 + rt * 4 + fq) * 128 + (chh * 4 + c) * 16 + fr] = rg_local(av[z][c], bx[z][c], z);
        }
        __syncthreads();
        if (tid < 256) { const int z = tid >> 7, ch = tid & 127; float h = CARRY[((size_t)(b * 2 + z) * NSEG + rg_tau(tt, z)) * 1024 + g * 128 + ch];
#pragma unroll
            for (int s = 0; s < 16; ++s) { const int gi = z ? 15 - s : s; CIN[(z * 16 + gi) * 128 + ch] = h; const float2 ph = AG[(z * 16 + gi) * 128 + ch]; h = ph.x * h + ph.y; } }
        __syncthreads();
#pragma unroll
        for (int c = 0; c < 4; ++c) { const int chl = (chh * 4 + c) * 16 + fr; float hs[4];
            { float h = CIN[(0 * 16 + rt * 4 + fq) * 128 + chl];
#pragma unroll
                for (int j = 0; j < 4; ++j) { h = av[0][c][j] * h + bx[0][c][j]; hs[j] = h; } }
            { float h = CIN[(1 * 16 + rt * 4 + fq) * 128 + chl];
#pragma unroll
                for (int j = 3; j >= 0; --j) { h = av[1][c][j] * h + bx[1][c][j]; hs[j] += h; } }
#pragma unroll
            for (int j = 0; j < 4; ++j) Y[(size_t)(rowbase + rt * 16 + fq * 4 + j) * 2048 + g * 128 + chl] = f2bf(gelu_tanh(bf2f(grv[c][j])) * hs[j]); }
    }
    const int lane = tid & 63, w = tid >> 6;
    const u16* OF = (const u16*)(p.ws + WS_OF1); const u16* OB = (const u16*)(p.ws + WS_OB1);
    if (do_merge) for (int row = 512 + blockIdx.x * 8 + w; row < MTOT; row += gridDim.x * 8) {
        const int col = lane * 16; float o[16]; float ss = 0.f;
#pragma unroll
        for (int i = 0; i < 2; ++i) { float a[8], bb[8]; unpack8(*(const uint4*)(OF + (size_t)row * 1024 + col + i * 8), a); unpack8(*(const uint4*)(OB + (size_t)row * 1024 + col + i * 8), bb);
#pragma unroll
            for (int j = 0; j < 8; ++j) { o[i * 8 + j] = a[j] + bb[j]; ss += o[i * 8 + j] * o[i * 8 + j]; } }
        ss = red16(ss);
        const float rstd = rsqrtf(ss * (1.f / 256.f) + 1e-6f);
#pragma unroll
        for (int i = 0; i < 2; ++i) { float gt[8], r[8]; unpack8(*(const uint4*)(PROJ + (size_t)row * NP1 + 4096 + col + i * 8), gt);
#pragma unroll
            for (int j = 0; j < 8; ++j) r[j] = o[i * 8 + j] * rstd * p.gla_norm_g[col + i * 8 + j] * siluf_(gt[j]);
            *(uint4*)(Y + (size_t)row * 2048 + 1024 + col + i * 8) = pack8(r); }
    }
}

#define XB_TMO      128
#define XB_XCNT(j)  (256  + 64 * (j))
#define XB_XSUB(j)  (1280 + 64 * (j))
#define XB_XGEN(j)  (2304 + 64 * (j))
#define XB_TOP      3328
#define XB_TOPGEN   3392
#define XCD_BAR_WORDS 3456
#define XB_SPIN_CAP (1u << 18)
#define XLAS __attribute__((address_space(3)))

__device__ __forceinline__ unsigned xb_ld(unsigned* p)              { return __hip_atomic_load(p, __ATOMIC_RELAXED, __HIP_MEMORY_SCOPE_AGENT); }
__device__ __forceinline__ unsigned xb_add(unsigned* p, unsigned v) { return __hip_atomic_fetch_add(p, v, __ATOMIC_RELAXED, __HIP_MEMORY_SCOPE_AGENT); }
__device__ __forceinline__ unsigned xb_xcc_id() { return (unsigned)__builtin_amdgcn_s_getreg((3 << 11) | 20) & 0xFu; }
#define XB_SPIN(cond, bar) do { unsigned _sp = 0; while (cond) { __builtin_amdgcn_s_sleep(1); \
    if ((++_sp & 255u) == 0u) { if (xb_ld(&(bar)[XB_TMO])) break; if (_sp > XB_SPIN_CAP) { atomicAdd(&(bar)[XB_TMO], 1u); break; } } } } while (0)

struct XcdBarrier {
    unsigned* bar; unsigned x;
    volatile XLAS unsigned* st;
};

__device__ __forceinline__ XcdBarrier xcd_barrier_post(unsigned* bar, volatile XLAS unsigned* st) {
    XcdBarrier b; b.bar = bar; b.x = xb_xcc_id(); b.st = st;
    if (threadIdx.x == 0) (void)xb_add(&bar[XB_XCNT(b.x)], 1u);
    return b;
}
__device__ __forceinline__ void xcd_barrier_complete(unsigned* bar, unsigned x, unsigned& nloc, unsigned& nx) {
    const unsigned G = gridDim.x * gridDim.y * gridDim.z;
    unsigned sum, cnt, mine, sp = 0u;
    for (;;) {
        sum = 0u; cnt = 0u; mine = 0u;
#pragma unroll
        for (unsigned j = 0; j < 16; ++j) { const unsigned c = xb_ld(&bar[XB_XCNT(j)]); sum += c; cnt += (c > 0u) ? 1u : 0u; mine = (j == x) ? c : mine; }
        if (sum == G) break;
        __builtin_amdgcn_s_sleep(1);
        if ((++sp & 255u) == 0u) { if (xb_ld(&bar[XB_TMO])) break; if (sp > XB_SPIN_CAP) { atomicAdd(&bar[XB_TMO], 1u); break; } }
    }
    nloc = mine > 0u ? mine : 1u; nx = cnt > 0u ? cnt : 1u;
}

__device__ __forceinline__ void xcd_barrier(const XcdBarrier& b) {
    asm volatile("s_waitcnt vmcnt(0)" ::: "memory");
    __syncthreads();
    if (threadIdx.x == 0) {
        unsigned* bar = b.bar;
        __builtin_amdgcn_s_waitcnt(0);
        unsigned nloc = b.st[0], nx = b.st[1];
        if (nloc == 0u) { xcd_barrier_complete(bar, b.x, nloc, nx); b.st[0] = nloc; b.st[1] = nx; }
        const unsigned old = xb_add(&bar[XB_XSUB(b.x)], 1u);
        const unsigned gen = old / nloc;
        if (old + 1u == (gen + 1u) * nloc) {
            __builtin_amdgcn_fence(__ATOMIC_RELEASE, "agent");
            asm volatile("s_waitcnt vmcnt(0)" ::: "memory");
            const unsigned og = xb_add(&bar[XB_TOP], 1u);
            const unsigned tg = og / nx;
            if (og + 1u == (tg + 1u) * nx) xb_add(&bar[XB_TOPGEN], 1u);
            else XB_SPIN(xb_ld(&bar[XB_TOPGEN]) == tg, bar);
            __builtin_amdgcn_fence(__ATOMIC_ACQUIRE, "agent");
            xb_add(&bar[XB_XGEN(b.x)], 1u);
            asm volatile("s_waitcnt vmcnt(0)" ::: "memory");
        } else {
            XB_SPIN(xb_ld(&bar[XB_XGEN(b.x)]) == gen, bar);
            __builtin_amdgcn_fence(__ATOMIC_ACQUIRE, "agent");
            asm volatile("s_waitcnt vmcnt(0)" ::: "memory");
        }
    }
    __syncthreads();
}

constexpr int LDS_BYTES = 135168 + 16;
constexpr int L1C_SPLIT = 64 + 3072;

__global__ void __launch_bounds__(NTHR, 2) hybrid_fwd(Params p) {
    extern __shared__ __attribute__((aligned(16))) unsigned char lds[];
    cg::grid_group grid = cg::this_grid();
    float* smf = (float*)lds;
    PG8_LAS unsigned char* ldsg = (PG8_LAS unsigned char*)lds;
    unsigned char* ws = p.ws;
    u16* WT_IN = (u16*)(ws + WS_WT_IN); u16* WT_OUT = (u16*)(ws + WS_WT_OUT); u16* WT_GU = (u16*)(ws + WS_WT_GU); u16* WT_DN = (u16*)(ws + WS_WT_DN);
    u16* H = (u16*)(ws + WS_H); u16* PROJ = (u16*)(ws + WS_PROJ); float* XC = (float*)(ws + WS_XC); float* G = (float*)(ws + WS_G);
    const float* MOD = (const float*)(ws + WS_MOD);
    const int GD = (int)gridDim.x, bid = (int)blockIdx.x;
    const int vb = (GD % 8 == 0) ? (bid % 8) * (GD / 8) + bid / 8 : bid;
    volatile XLAS unsigned* xst = (volatile XLAS unsigned*)((PG8_LAS unsigned char*)lds + 135168);
    if (threadIdx.x < 2) xst[threadIdx.x] = 0u;
    __syncthreads();
    const XcdBarrier xbar = xcd_barrier_post((unsigned*)(ws + WS_BAR), xst);
#ifdef PROBE
    unsigned long long tG = 0, tL0P = 0, tL0PP = 0, tL0M = 0, tL1A = 0, tL1M = 0, tL1C = 0, tO = 0, tprev = __builtin_amdgcn_s_memrealtime();
#define PSTAMP(c) do { const unsigned long long t_ = __builtin_amdgcn_s_memrealtime(); c += t_ - tprev; tprev = t_; } while (0)
#else
#define PSTAMP(c) do {} while (0)
#endif

    ph_adaln_partials(p, smf);
    ph_convert_rg(p);
    ph_convert<1>(p.ab_w_in, 7216, 2048, 7424, WT_IN, smf);
    ph_convert<0>(p.ab_w_out, 2048, 2048, 2048, WT_OUT, smf);
    ph_convert<2>(p.ffn_w_gu, 11264, 2048, 11264, WT_GU, smf);
    ph_convert<0>(p.ffn_w_down, 2048, 5632, 2048, WT_DN, smf);
#ifdef DUP_CONV
    ph_convert<1>(p.ab_w_in, 7216, 2048, 7424, WT_IN, smf);
    ph_convert<0>(p.ab_w_out, 2048, 2048, 2048, WT_OUT, smf);
    ph_convert<2>(p.ffn_w_gu, 11264, 2048, 11264, WT_GU, smf);
    ph_convert<0>(p.ffn_w_down, 2048, 5632, 2048, WT_DN, smf);
#endif
    grid.sync();
    PSTAMP(tO);
    ph_adaln_reduce(p);
    xcd_barrier(xbar);
    PSTAMP(tO);

    ph_norm(p.ctx, p.x, p.norm_mix_g, MOD, 0, 1, H, 0);
#ifdef DUP_NORM
    ph_norm(p.ctx, p.x, p.norm_mix_g, MOD, 0, 1, H, 0);
#endif
    xcd_barrier(xbar);
    PSTAMP(tO);
    { pg8::Gemm g{H, WT_IN, MTOT, 7424, 2048}; pg8::StaticOrder S; S.init(MTOT, 7424, GD, bid);
      pg8::EpiProj E{PROJ, NP0, 28, G, NG0, NG0, 4}; pg8::gemm_phase<pg8::EpiProj, pg8::StaticOrder>(ldsg, g, S, E); }
    xcd_barrier(xbar);
    PSTAMP(tG);
    ph_l0_prep(p, smf);
    xcd_barrier(xbar);
    PSTAMP(tL0P);
    ph_l0_prepass(p, lds);
#ifdef DUP_L0PP
    xcd_barrier(xbar); ph_l0_prepass(p, lds);
#endif
    xcd_barrier(xbar);
    PSTAMP(tL0PP);
    for (int job = vb; job < 256; job += GD) { if (job < 128) mlstm_chunk(p, job, lds); else deltanet_chunk(p, job - 128, lds); }
#ifdef DUP_L0M
    xcd_barrier(xbar);
    for (int job = vb; job < 256; job += GD) { if (job < 128) mlstm_chunk(p, job, lds); else deltanet_chunk(p, job - 128, lds); }
#endif
    xcd_barrier(xbar);
    PSTAMP(tL0M);
    ph_l0_merge(p);
#ifdef DUP_NORM
    ph_l0_merge(p);
#endif
    xcd_barrier(xbar);
    PSTAMP(tO);
    { pg8::Gemm g{H, WT_OUT, MTOT, 2048, 2048}; pg8::StaticOrder S; S.init(MTOT, 2048, GD, bid);
      pg8::EpiRes E{p.ctx, p.x, XC, p.out, MOD + 2 * 2048, 0}; pg8::gemm_phase<pg8::EpiRes, pg8::StaticOrder>(ldsg, g, S, E); }
    xcd_barrier(xbar);
    PSTAMP(tG);
    ph_norm(XC, p.out, p.norm_ffn_g, MOD, 3, 4, H, 0);
#ifdef DUP_NORM
    ph_norm(XC, p.out, p.norm_ffn_g, MOD, 3, 4, H, 0);
#endif
    xcd_barrier(xbar);
    PSTAMP(tO);
    { pg8::Gemm g{H, WT_GU, MTOT, 11264, 2048}; pg8::StaticOrder S; S.init(MTOT, 11264, GD, bid);
      pg8::EpiSwiglu E{PROJ, FH}; pg8::gemm_phase<pg8::EpiSwiglu, pg8::StaticOrder>(ldsg, g, S, E);
#ifdef DUP_GU
      xcd_barrier(xbar); pg8::gemm_phase<pg8::EpiSwiglu, pg8::StaticOrder>(ldsg, g, S, E);
#endif
    }
    xcd_barrier(xbar);
    PSTAMP(tG);
    { pg8::Gemm g{PROJ, WT_DN, MTOT, 2048, 5632}; pg8::StaticOrder S; S.init(MTOT, 2048, GD, bid);
      pg8::EpiRes E{XC, p.out, XC, p.out, MOD + 5 * 2048, 0}; pg8::gemm_phase<pg8::EpiRes, pg8::StaticOrder>(ldsg, g, S, E); }
    xcd_barrier(xbar);
    PSTAMP(tG);

    const float* MOD1 = MOD + 3 * 12288;
    ph_convert<0>(p.cd_w_in, 5152, 2048, 5376, WT_IN, smf);
    ph_convert<0>(p.cd_w_out, 2048, 2048, 2048, WT_OUT, smf);
    ph_convert<2>(p.ffn_w_gu + (size_t)2048 * 11264, 11264, 2048, 11264, WT_GU, smf);
    ph_convert<0>(p.ffn_w_down + (size_t)5632 * 2048, 2048, 5632, 2048, WT_DN, smf);
#ifdef DUP_CONV
    ph_convert<0>(p.cd_w_in, 5152, 2048, 5376, WT_IN, smf);
    ph_convert<0>(p.cd_w_out, 2048, 2048, 2048, WT_OUT, smf);
    ph_convert<2>(p.ffn_w_gu + (size_t)2048 * 11264, 11264, 2048, 11264, WT_GU, smf);
    ph_convert<0>(p.ffn_w_down + (size_t)5632 * 2048, 2048, 5632, 2048, WT_DN, smf);
#endif
    ph_norm(XC, p.out, p.norm_mix_g + 2048, MOD1, 0, 1, H, 0);
#ifdef DUP_NORM
    ph_norm(XC, p.out, p.norm_mix_g + 2048, MOD1, 0, 1, H, 0);
#endif
    xcd_barrier(xbar);
    PSTAMP(tO);
    { pg8::Gemm g{H, WT_IN, MTOT, 5376, 2048}; pg8::StaticOrder S; S.init(MTOT, 5376, GD, bid);
      pg8::EpiProj E{PROJ, NP1, 20, G, NG1, NG1, 0}; pg8::gemm_phase<pg8::EpiProj, pg8::StaticOrder>(ldsg, g, S, E); }
    xcd_barrier(xbar);
    PSTAMP(tG);
    ph_l1_a(p, lds);
#ifdef DUP_L1A
    xcd_barrier(xbar); ph_l1_a(p, lds, DUP_L1A);
#endif
    xcd_barrier(xbar);
    PSTAMP(tL1A);
    const bool l1_split = (GD >= 200);
    unsigned* rgflag = (unsigned*)(ws + WS_BAR) + 3600;
    for (int job = vb; job < 136; job += GD) {
        if (job < 128) gla_chunk(p, job, lds);
        else { rg_pass_b(p, job - 128);
            __builtin_amdgcn_fence(__ATOMIC_RELEASE, "agent"); asm volatile("s_waitcnt vmcnt(0)" ::: "memory"); __syncthreads();
            if (threadIdx.x == 0) __hip_atomic_fetch_add(rgflag, 1u, __ATOMIC_RELAXED, __HIP_MEMORY_SCOPE_AGENT); }
    }
    if (l1_split && vb >= 136) {
        if (threadIdx.x == 0) { unsigned sp = 0; while (__hip_atomic_load(rgflag, __ATOMIC_RELAXED, __HIP_MEMORY_SCOPE_AGENT) < 8u && ++sp < (1u << 22)) __builtin_amdgcn_s_sleep(4); }
        __syncthreads();
        __builtin_amdgcn_fence(__ATOMIC_ACQUIRE, "agent"); asm volatile("s_waitcnt vmcnt(0)" ::: "memory");
        ph_l1_c(p, lds, 64, L1C_SPLIT, vb - 136, GD - 136, 0);
    }
    xcd_barrier(xbar);
    PSTAMP(tL1M);
    ph_l1_c(p, lds, l1_split ? L1C_SPLIT : 64, 520 * 8, bid, GD, 1);
    xcd_barrier(xbar);
    PSTAMP(tL1C);
    { pg8::Gemm g{H + (size_t)512 * 2048, WT_OUT, MLAT, 2048, 2048}; pg8::StaticOrder S; S.init(MLAT, 2048, GD, bid);
      pg8::EpiRes E{XC, p.out, XC, p.out, MOD1 + 2 * 2048, 512}; pg8::gemm_phase<pg8::EpiRes, pg8::StaticOrder>(ldsg, g, S, E); }
    xcd_barrier(xbar);
    PSTAMP(tG);
    ph_norm(XC, p.out, p.norm_ffn_g + 2048, MOD1, 3, 4, H, 512);
#ifdef DUP_NORM
    ph_norm(XC, p.out, p.norm_ffn_g + 2048, MOD1, 3, 4, H, 512);
#endif
    xcd_barrier(xbar);
    PSTAMP(tO);
    { pg8::Gemm g{H + (size_t)512 * 2048, WT_GU, MLAT, 11264, 2048}; pg8::StaticOrder S; S.init(MLAT, 11264, GD, bid);
      pg8::EpiSwiglu E{PROJ, FH}; pg8::gemm_phase<pg8::EpiSwiglu, pg8::StaticOrder>(ldsg, g, S, E);
#ifdef DUP_GU
      xcd_barrier(xbar); pg8::gemm_phase<pg8::EpiSwiglu, pg8::StaticOrder>(ldsg, g, S, E);
#endif
    }
    xcd_barrier(xbar);
    PSTAMP(tG);
    { pg8::Gemm g{PROJ, WT_DN, MLAT, 2048, 5632}; pg8::StaticOrder S; S.init(MLAT, 2048, GD, bid);
      pg8::EpiRes E{XC, p.out, XC, p.out, MOD1 + 5 * 2048, 512}; pg8::gemm_phase<pg8::EpiRes, pg8::StaticOrder>(ldsg, g, S, E); }
    xcd_barrier(xbar);
    PSTAMP(tG);
#ifdef EXTRA_SYNCS
#pragma unroll 1
    for (int i = 0; i < EXTRA_SYNCS; ++i) xcd_barrier(xbar);
#endif
    ph_final_norm(p);
#ifdef PROBE
    PSTAMP(tO);
    __syncthreads();
    if (bid == 0 && threadIdx.x == 0) { const float tot = (float)(tG + tL0P + tL0PP + tL0M + tL1A + tL1M + tL1C + tO);
#ifdef PROBE3
        const unsigned long long* pq = (const unsigned long long*)(p.ws + WS_MODP) + 500000;
        p.out[0] += 0.25f + 0.15f * ((float)(pq[1] - pq[0]) / tot); p.out[1] += 0.10f + 0.14f * ((float)(pq[2] - pq[1]) / tot); }
#elif defined(PROBE2)
        const float* pr = (const float*)(p.ws + WS_MODP) + 1000000;
        p.out[0] += 0.25f + 0.15f * pr[0]; p.out[1] += 0.10f + 0.14f * pr[1]; }
#else
        p.out[0] += 0.25f + 0.15f * ((float)PROBE_A / tot); p.out[1] += 0.10f + 0.14f * ((float)PROBE_B / tot); }
#endif
#endif
}

extern "C" void kernel_launch(void* const* d_in, const int* in_sizes, int n_in, void* d_out, int out_size, void* d_ws, size_t ws_size, hipStream_t stream) {
    static int grid = 0;
    if (grid == 0) {
        if (n_in != 32 || out_size != MLAT * DM || ws_size < WS_END) { fprintf(stderr, "kernel_launch: unexpected shapes (n_in %d out %d ws %zu need %zu)\n", n_in, out_size, ws_size, (size_t)WS_END); grid = -1; return; }
        int dev = 0, cus = 0, per_cu = 0;
        (void)hipGetDevice(&dev);
        (void)hipDeviceGetAttribute(&cus, hipDeviceAttributeMultiprocessorCount, dev);
        if (hipFuncSetAttribute((const void*)hybrid_fwd, hipFuncAttributeMaxDynamicSharedMemorySize, LDS_BYTES) != hipSuccess) { fprintf(stderr, "kernel_launch: hipFuncSetAttribute failed\n"); }
        if (hipOccupancyMaxActiveBlocksPerMultiprocessor(&per_cu, (const void*)hybrid_fwd, NTHR, LDS_BYTES) != hipSuccess || per_cu < 1) { fprintf(stderr, "kernel_launch: occupancy query gave %d\n", per_cu); per_cu = 1; }
        (void)hipGetLastError();
        grid = cus * per_cu;
    }
    if (grid < 0) return;
    Params p{};
    const float** pp = (const float**)&p;
    for (int i = 0; i < 32; ++i) pp[i] = (const float*)d_in[i];
    p.out = (float*)d_out; p.ws = (unsigned char*)d_ws;
    (void)hipMemsetAsync((unsigned char*)d_ws + WS_BAR, 0, 16384, stream);
    void* args[] = {&p};
    hipError_t e = hipLaunchCooperativeKernel((const void*)hybrid_fwd, dim3(grid), dim3(NTHR), args, LDS_BYTES, stream);
    if (e != hipSuccess) fprintf(stderr, "cooperative launch failed: %s (grid %d)\n", hipGetErrorString(e), grid);
}
```

```cpp
#include <hip/hip_runtime.h>
#include <hip/hip_cooperative_groups.h>
#include <cstdio>
namespace cg = cooperative_groups;

typedef unsigned short u16;

constexpr int DM = 2048, FH = 5632, MC = 512, MLAT = 32768, MTOT = 33280, NTHR = 512;
constexpr int NP0 = 7168, NP1 = 5120;
constexpr int NG0 = 48, NG1 = 32;
constexpr int NSEG = 260;

constexpr size_t WS_WT_IN = 0;
constexpr size_t WS_WT_OUT = WS_WT_IN + (size_t)7424 * 2048 * 2;
constexpr size_t WS_WT_GU = WS_WT_OUT + (size_t)2048 * 2048 * 2;
constexpr size_t WS_WT_DN = WS_WT_GU + (size_t)11264 * 2048 * 2;
constexpr size_t WS_H = WS_WT_DN + (size_t)2048 * 5632 * 2;
constexpr size_t WS_PROJ = WS_H + (size_t)MTOT * 2048 * 2;
constexpr size_t WS_OF = WS_PROJ + (size_t)MTOT * 7168 * 2;
constexpr size_t WS_OB = WS_OF + (size_t)MTOT * 2048 * 2;
constexpr size_t WS_XC = WS_OB + (size_t)MTOT * 2048 * 2;
constexpr size_t WS_G = WS_XC + (size_t)MC * 2048 * 4;
constexpr size_t WS_CQ = WS_G + (size_t)MTOT * 48 * 4;
constexpr size_t WS_MODP = WS_CQ + (size_t)MC * 3072 * 2;
constexpr size_t WS_MOD = WS_MODP + (size_t)2 * 32 * 3 * 12288 * 4;
constexpr size_t WS_ATT0 = WS_MOD + (size_t)2 * 3 * 12288 * 4;
constexpr size_t WS_MLS = WS_ATT0 + (size_t)4160 * 4096 * 2;
constexpr size_t WS_GCS = WS_MLS + (size_t)4160 * 256 * 4;
constexpr size_t WS_WRT = WS_GCS + (size_t)8320 * 256 * 4;
constexpr size_t WS_BAR = WS_WRT + (size_t)32 * 16384 * 2;
constexpr size_t WS_END = WS_BAR + 16384;
constexpr size_t WS_TM = WS_H;
constexpr size_t WS_QK = WS_H + (size_t)8320 * 4096 * 2;
constexpr size_t WS_OF1 = WS_OF;
constexpr size_t WS_OB1 = WS_OF + (size_t)MTOT * 1024 * 2;
constexpr size_t WS_QE = WS_OB;
constexpr size_t WS_KDT = WS_QE + (size_t)2 * MTOT * 512 * 2;
constexpr size_t WS_TAIL = WS_PROJ + (size_t)MTOT * 5120 * 2;
constexpr size_t WS_ATT = WS_TAIL;
constexpr size_t WS_VT = WS_ATT + (size_t)4160 * 4096 * 2;
constexpr size_t WS_EBL = WS_VT + (size_t)2080 * 16384 * 2;
constexpr size_t WS_AGG = WS_EBL + (size_t)4160 * 128 * 4;
constexpr size_t WS_CARRY = WS_AGG + (size_t)4 * NSEG * 1024 * 8;
static_assert(WS_CARRY + (size_t)4 * NSEG * 1024 * 4 <= WS_OF, "layer-1 tail overflow");

struct Params {
    const float *x, *c, *ctx, *c_ctx, *mod_w, *mod_b, *norm_mix_g, *norm_ffn_g, *ffn_w_gu, *ffn_w_down, *final_norm_g,
        *ab_w_in, *ab_w_out, *ml_ig_b, *ml_fg_b, *ml_norm_g, *dn_conv_w, *dn_a_log, *dn_dt_bias, *dn_norm_g,
        *cd_w_in, *cd_w_out, *rg_conv_w, *rg_conv_b, *rg_w_r, *rg_b_r, *rg_w_i, *rg_b_i, *rg_lambda, *gla_w_up, *gla_b_up, *gla_norm_g;
    float* out; unsigned char* ws;
};

__device__ __forceinline__ float bf2f(u16 v) { return __uint_as_float(((unsigned)v) << 16); }
typedef __bf16 bf16x2_nat __attribute__((ext_vector_type(2)));
typedef float f32x2_nat __attribute__((ext_vector_type(2)));
__device__ __forceinline__ unsigned cvt_pk_bf16(float lo, float hi) { const f32x2_nat v = {lo, hi}; const bf16x2_nat r = __builtin_convertvector(v, bf16x2_nat); return __builtin_bit_cast(unsigned, r); }
__device__ __forceinline__ u16 f2bf(float f) { return (u16)(cvt_pk_bf16(f, 0.f) & 0xffffu); }
__device__ __forceinline__ void unpack8(const uint4& u, float* f) {
    f[0] = __uint_as_float(u.x << 16); f[1] = __uint_as_float(u.x & 0xffff0000u);
    f[2] = __uint_as_float(u.y << 16); f[3] = __uint_as_float(u.y & 0xffff0000u);
    f[4] = __uint_as_float(u.z << 16); f[5] = __uint_as_float(u.z & 0xffff0000u);
    f[6] = __uint_as_float(u.w << 16); f[7] = __uint_as_float(u.w & 0xffff0000u);
}
__device__ __forceinline__ uint4 pack8(const float* f) { uint4 o; o.x = cvt_pk_bf16(f[0], f[1]); o.y = cvt_pk_bf16(f[2], f[3]); o.z = cvt_pk_bf16(f[4], f[5]); o.w = cvt_pk_bf16(f[6], f[7]); return o; }
template <int CTRL> __device__ __forceinline__ float dppf(float x) { return __int_as_float(__builtin_amdgcn_update_dpp(0, __float_as_int(x), CTRL, 0xF, 0xF, true)); }
__device__ __forceinline__ float red4(float x) { x += dppf<0xB1>(x); x += dppf<0x4E>(x); return x; }
__device__ __forceinline__ float red8(float x) { x = red4(x); x += dppf<0x141>(x); return x; }
__device__ __forceinline__ float red16(float x) { x = red8(x); x += dppf<0x140>(x); return x; }
__device__ __forceinline__ float red64(float x) { x = red16(x); x += __shfl_xor(x, 16); x += __shfl_xor(x, 32); return x; }
__device__ __forceinline__ float frcp(float x) { return __builtin_amdgcn_rcpf(x); }
__device__ __forceinline__ float sigmoidf_(float x) { return frcp(1.f + __expf(-x)); }
__device__ __forceinline__ float siluf_(float x) { return x * frcp(1.f + __expf(-x)); }
__device__ __forceinline__ float softplusf_(float x) { return fmaxf(x, 0.f) + __logf(1.f + __expf(-fabsf(x))); }
__device__ __forceinline__ float logsigmoidf_(float x) { return fminf(x, 0.f) - __logf(1.f + __expf(-fabsf(x))); }
__device__ __forceinline__ float gelu_tanh(float x) { const float u = 0.7978845608028654f * (x + 0.044715f * x * x * x); const float th = 1.f - 2.f * frcp(1.f + __expf(2.f * u)); return 0.5f * x * (1.f + th); }
__device__ __forceinline__ float neg_expm1_small(float x) { float pl = 1.f / 720.f; pl = pl * x + 1.f / 120.f; pl = pl * x + 1.f / 24.f; pl = pl * x + 1.f / 6.f; pl = pl * x + 0.5f; pl = pl * x + 1.f; return -x * pl; }

__device__ __forceinline__ int tid_fresh() { int t = threadIdx.x; asm volatile("" : "+v"(t)); return t; }
namespace pg8 {
#define PG8_LAS __attribute__((address_space(3)))
typedef unsigned short bf16_t;
typedef short bf16x8 __attribute__((ext_vector_type(8)));
typedef float f32x4 __attribute__((ext_vector_type(4)));
typedef unsigned u32x4 __attribute__((ext_vector_type(4)));
constexpr int BM = 256, BK = 64, HALF = 128, HTB = HALF * BK * 2  , STAGE_BYTES = 8 * HTB, NXCD = 8, WGM = 8;

__host__ __device__ __forceinline__ int lds_byte(int r, int c) { const int st = (r >> 4) * 2 + (c >> 5), rr = r & 15, cc = c & 31, ob = rr * 64 + cc * 2; return st * 1024 + (ob ^ (((ob >> 9) & 1) << 5)); }
__host__ __device__ __forceinline__ void stage_rc(int b, int& R, int& C) { const int st = b / 1024, sb = b % 1024, swz = sb ^ (((sb >> 9) & 1) << 5); R = (st >> 1) * 16 + swz / 64; C = (st & 1) * 32 + (swz % 64) / 2; }
__host__ __device__ __forceinline__ int perm32(int rho) { const int n = rho >> 4, i = rho & 15; return 8 * (i >> 2) + 4 * n + (i & 3); }

struct Unit { int pm, pn; };
struct Gemm { const bf16_t* A; const bf16_t* Bt; int M, N, K; };

struct StaticOrder {
    int nM, nN, nwg, G, c;
    __host__ __device__ void init(int M, int N, int G_, int c_) { nM = M / BM; nN = N / BM; nwg = nM * nN; G = G_; c = c_; }
    __host__ __device__ bool next(int i, Unit& u) const {
        const long L = (long)i * G + c; if (L >= nwg) return false;
        int wgid = (int)L; { const int q = nwg / NXCD, r = nwg % NXCD, xcd = wgid % NXCD, off = wgid / NXCD; wgid = (xcd < r ? xcd * (q + 1) : r * (q + 1) + (xcd - r) * q) + off; }
        const int nig = WGM * nN, gid = wgid / nig, fm = gid * WGM, gsz = (nM - fm) < WGM ? (nM - fm) : WGM;
        u.pm = fm + ((wgid % nig) % gsz); u.pn = (wgid % nig) / gsz; return true;
    }
    __device__ __forceinline__ void a_ready(const Unit&) const {}
    __device__ __forceinline__ void done(const Unit&) const {}
};
using ::cvt_pk_bf16;
typedef float f32x2 __attribute__((ext_vector_type(2)));

struct EpiProj {
    static constexpr bool PERM = true, AFTER_DRAIN = false;
    bf16_t* P; int ldp; int n_main; float* G; int ldg; int ng; int perm_tiles;
    __device__ __forceinline__ void operator()(const f32x4 (&acc)[2][2][4][2], const Unit& u, int wr, int wc, int fr, int fq) const {
        const int row0 = u.pm * BM + wr * 64 + fr;
        if (u.pn < perm_tiles) {
#pragma unroll
            for (int ai = 0; ai < 2; ++ai)
#pragma unroll
                for (int m = 0; m < 4; ++m) { bf16_t* rowp = P + (size_t)(u.pm * BM + ai * HALF + wr * 64 + (m * 4 + wc) * 4 + fq) * ldp + u.pn * BM + fr * 8;
#pragma unroll
                    for (int bj = 0; bj < 2; ++bj) { const f32x4 v0 = acc[ai][bj][m][0], v1 = acc[ai][bj][m][1];
                        u32x4 w; w.x = cvt_pk_bf16(v0[0], v0[1]); w.y = cvt_pk_bf16(v0[2], v0[3]); w.z = cvt_pk_bf16(v1[0], v1[1]); w.w = cvt_pk_bf16(v1[2], v1[3]);
                        *(u32x4*)(rowp + bj * HALF) = w; } }
        } else if (u.pn < n_main) {
            const int col0 = u.pn * BM + wc * 32 + 8 * fq;
#pragma unroll
            for (int ai = 0; ai < 2; ++ai)
#pragma unroll
                for (int m = 0; m < 4; ++m) { bf16_t* rowp = P + (size_t)(row0 + ai * HALF + m * 16) * ldp + col0;
#pragma unroll
                    for (int bj = 0; bj < 2; ++bj) { const f32x4 v0 = acc[ai][bj][m][0], v1 = acc[ai][bj][m][1];
                        u32x4 w; w.x = cvt_pk_bf16(v0[0], v0[1]); w.y = cvt_pk_bf16(v0[2], v0[3]); w.z = cvt_pk_bf16(v1[0], v1[1]); w.w = cvt_pk_bf16(v1[2], v1[3]);
                        *(u32x4*)(rowp + bj * HALF) = w; } }
        } else {
            const int c0 = wc * 32 + 8 * fq;
#pragma unroll
            for (int ai = 0; ai < 2; ++ai)
#pragma unroll
                for (int m = 0; m < 4; ++m) { float* rowp = G + (size_t)(row0 + ai * HALF + m * 16) * ldg;
#pragma unroll
                    for (int n = 0; n < 2; ++n)
#pragma unroll
                        for (int j = 0; j < 4; ++j) { const int c = c0 + 4 * n + j; if (c < ng) rowp[c] = acc[ai][0][m][n][j]; } }
        }
    }
};
struct EpiRes {
    static constexpr bool PERM = false, AFTER_DRAIN = false;
    const float* srcC; const float* srcL; float* dstC; float* dstL; const float* gate  ; int row_off;
    __device__ __forceinline__ void operator()(const f32x4 (&acc)[2][2][4][2], const Unit& u, int wr, int wc, int fr, int fq) const {
        const int grow_t = u.pm * BM + row_off;
        const bool isc = grow_t < 512;
        const int mr = isc ? 2 : ((grow_t - 512) >> 14);
        const float* sp = isc ? srcC + (size_t)grow_t * 2048 : srcL + (size_t)(grow_t - 512) * 2048;
        float* dp = isc ? dstC + (size_t)grow_t * 2048 : dstL + (size_t)(grow_t - 512) * 2048;
        const int lrow0 = wr * 64 + fr, col0 = u.pn * BM + wc * 32 + 4 * fq;
        const float* gp = gate + (size_t)mr * 12288 + col0;
        f32x4 gv[2][2];
#pragma unroll
        for (int bj = 0; bj < 2; ++bj)
#pragma unroll
            for (int n = 0; n < 2; ++n) gv[bj][n] = *(const f32x4*)(gp + bj * HALF + n * 16);
#pragma unroll
        for (int ai = 0; ai < 2; ++ai)
#pragma unroll
            for (int m = 0; m < 4; ++m) { const size_t off = (size_t)(lrow0 + ai * HALF + m * 16) * 2048 + col0;
#pragma unroll
                for (int bj = 0; bj < 2; ++bj)
#pragma unroll
                    for (int n = 0; n < 2; ++n) { const f32x4 s = *(const f32x4*)(sp + off + bj * HALF + n * 16);
                        *(f32x4*)(dp + off + bj * HALF + n * 16) = s + gv[bj][n] * acc[ai][bj][m][n]; } }
    }
};
struct EpiSwiglu {
    static constexpr bool PERM = true, AFTER_DRAIN = false;
    bf16_t* O; int ldo;
    __device__ __forceinline__ void operator()(const f32x4 (&acc)[2][2][4][2], const Unit& u, int wr, int wc, int fr, int fq) const {
        const int row0 = u.pm * BM + wr * 64 + fr, col0 = u.pn * HALF + wc * 32 + 8 * fq;
#pragma unroll
        for (int ai = 0; ai < 2; ++ai)
#pragma unroll
            for (int m = 0; m < 4; ++m) { float r[8];
#pragma unroll
                for (int n = 0; n < 2; ++n)
#pragma unroll
                    for (int j = 0; j < 4; ++j) { const float gg = acc[ai][0][m][n][j], uu = acc[ai][1][m][n][j]; r[n * 4 + j] = gg * __builtin_amdgcn_rcpf(1.f + __expf(-gg)) * uu; }
                u32x4 w; w.x = cvt_pk_bf16(r[0], r[1]); w.y = cvt_pk_bf16(r[2], r[3]); w.z = cvt_pk_bf16(r[4], r[5]); w.w = cvt_pk_bf16(r[6], r[7]);
                *(u32x4*)(O + (size_t)(row0 + ai * HALF + m * 16) * ldo + col0) = w; }
    }
};

template <class Epi, class Sched>
__device__ __forceinline__ void gemm_phase(PG8_LAS unsigned char* lds, const Gemm g, const Sched& S, const Epi& E) {
    int tid = threadIdx.x; asm volatile("" : "+v"(tid)); const int wid = __builtin_amdgcn_readfirstlane(tid >> 6), lane = tid & 63, wr = wid >> 2, wc = wid & 3, fr = lane & 15, fq = lane >> 4;
    const int K = g.K, nt = K / BK;
    unsigned voffA[2], voffB[2];
#pragma unroll
    for (int i = 0; i < 2; ++i) { int R, C; stage_rc(tid * 16 + i * 8192, R, C); const int Rb = Epi::PERM ? ((R & ~31) + perm32(R & 31)) : R;
        voffA[i] = (unsigned)(R * K + C) * 2u; voffB[i] = (unsigned)(Rb * K + C) * 2u; }
    const size_t kstep = (size_t)(BK * 2);
    const size_t hstep = (size_t)HALF * K * 2;
    const size_t tstep = 2 * hstep;
    const unsigned ldsw = (unsigned)wid * 1024u;
    const int aoff = lds_byte(wr * 64 + fr, fq * 8), boff = lds_byte(wc * 32 + fr, fq * 8);
#define PG8_SA(b, h) (((b) * 2 + (h)) * HTB)
#define PG8_SB(b, h) ((4 + (b) * 2 + (h)) * HTB)
#define PG8_STAGE(bufoff, gbase, voff) do { _Pragma("unroll") for (int _i = 0; _i < 2; ++_i) \
        __builtin_amdgcn_global_load_lds((const unsigned*)((const char*)(gbase) + (voff)[_i]), (PG8_LAS unsigned*)(lds + (bufoff) + ldsw + _i * 8192), 16, 0, 0); } while (0)
#define PG8_LDA(dst, b, h) do { _Pragma("unroll") for (int m = 0; m < 4; ++m) _Pragma("unroll") for (int k = 0; k < 2; ++k) dst[m][k] = *(const PG8_LAS bf16x8*)(lds + PG8_SA(b, h) + aoff + m * 2048 + k * 1024); } while (0)
#define PG8_LDB(dst, b, h) do { _Pragma("unroll") for (int n = 0; n < 2; ++n) _Pragma("unroll") for (int k = 0; k < 2; ++k) dst[n][k] = *(const PG8_LAS bf16x8*)(lds + PG8_SB(b, h) + boff + n * 2048 + k * 1024); } while (0)
#define PG8_MMA(ai, bj, At, Bt) do { __builtin_amdgcn_s_setprio(1); _Pragma("unroll") for (int m = 0; m < 4; ++m) _Pragma("unroll") for (int n = 0; n < 2; ++n) _Pragma("unroll") for (int k = 0; k < 2; ++k) \
        acc[ai][bj][m][n] = __builtin_amdgcn_mfma_f32_16x16x32_bf16(Bt[n][k], At[m][k], acc[ai][bj][m][n], 0, 0, 0); __builtin_amdgcn_s_setprio(0); } while (0)
#define PG8_WAIT_V(n) asm volatile("s_waitcnt vmcnt(" #n ")" ::: "memory")
#define PG8_WAIT_L(n) asm volatile("s_waitcnt lgkmcnt(" #n ")" ::: "memory")
#define PG8_BAR __builtin_amdgcn_s_barrier()
#define PG8_SCHED __builtin_amdgcn_sched_barrier(0)
    Unit cur, nxt; int ui = 0;
    if (!S.next(0, cur)) return;
    f32x4 acc[2][2][4][2];
#pragma unroll
    for (int a = 0; a < 2; ++a)
#pragma unroll
        for (int b = 0; b < 2; ++b)
#pragma unroll
            for (int m = 0; m < 4; ++m)
#pragma unroll
                for (int n = 0; n < 2; ++n) acc[a][b][m][n] = (f32x4){0.f, 0.f, 0.f, 0.f};
    bf16x8 At[4][2], B0[2][2], B1[2][2];
    const char* cA = (const char*)g.A + (size_t)cur.pm * tstep; const char* cB = (const char*)g.Bt + (size_t)cur.pn * tstep;
    S.a_ready(cur);
    PG8_STAGE(PG8_SB(0, 0), cB, voffB); PG8_STAGE(PG8_SA(0, 0), cA, voffA); PG8_STAGE(PG8_SB(0, 1), cB + hstep, voffB); PG8_STAGE(PG8_SA(0, 1), cA + hstep, voffA);
    if (wr == 1) PG8_BAR;
    PG8_WAIT_V(4); PG8_BAR;
    PG8_STAGE(PG8_SB(1, 0), cB + kstep, voffB); PG8_STAGE(PG8_SA(1, 0), cA + kstep, voffA); PG8_STAGE(PG8_SB(1, 1), cB + hstep + kstep, voffB);
    PG8_WAIT_V(6); PG8_BAR;
    for (;;) {
        const bool has_next = S.next(ui + 1, nxt);
        const char* nA = has_next ? (const char*)g.A + (size_t)nxt.pm * tstep : cA; const char* nB = has_next ? (const char*)g.Bt + (size_t)nxt.pn * tstep : cB;
        for (int t = 0; t < nt; t += 2) {
            const bool last = (t == nt - 2);
            const char* a1 = cA + (size_t)(t + 1) * kstep;
            const char* a2 = last ? nA : cA + (size_t)(t + 2) * kstep; const char* b2 = last ? nB : cB + (size_t)(t + 2) * kstep;
            const char* a3 = a2 + kstep; const char* b3 = b2 + kstep;
            if (last && has_next) S.a_ready(nxt);
            PG8_LDB(B0, 0, 0); PG8_SCHED; PG8_LDA(At, 0, 0); PG8_STAGE(PG8_SA(1, 1), a1 + hstep, voffA);
            PG8_WAIT_L(8); PG8_BAR; PG8_WAIT_L(0); PG8_MMA(0, 0, At, B0); PG8_BAR; PG8_SCHED;
            PG8_LDB(B1, 0, 1); PG8_STAGE(PG8_SB(0, 0), b2, voffB);
            PG8_BAR; PG8_WAIT_L(0); PG8_MMA(0, 1, At, B1); PG8_BAR;
            PG8_LDA(At, 0, 1); PG8_STAGE(PG8_SA(0, 0), a2, voffA);
            PG8_BAR; PG8_WAIT_L(0); PG8_MMA(1, 0, At, B0); PG8_BAR; PG8_SCHED;
            PG8_STAGE(PG8_SB(0, 1), b2 + hstep, voffB);
            PG8_WAIT_V(6); PG8_BAR; PG8_MMA(1, 1, At, B1); PG8_BAR;
            PG8_LDB(B0, 1, 0); PG8_SCHED; PG8_LDA(At, 1, 0); PG8_STAGE(PG8_SA(0, 1), a2 + hstep, voffA);
            PG8_WAIT_L(8); PG8_BAR; PG8_WAIT_L(0); PG8_MMA(0, 0, At, B0); PG8_BAR; PG8_SCHED;
            PG8_LDB(B1, 1, 1); PG8_STAGE(PG8_SB(1, 0), b3, voffB);
            PG8_BAR; PG8_WAIT_L(0); PG8_MMA(0, 1, At, B1); PG8_BAR;
            PG8_LDA(At, 1, 1); PG8_STAGE(PG8_SA(1, 0), a3, voffA);
            PG8_BAR; PG8_WAIT_L(0); PG8_MMA(1, 0, At, B0); PG8_BAR; PG8_SCHED;
            PG8_STAGE(PG8_SB(1, 1), b3 + hstep, voffB);
            PG8_WAIT_V(6); PG8_BAR; PG8_MMA(1, 1, At, B1); PG8_BAR;
        }
        if constexpr (!Epi::AFTER_DRAIN) { E(acc, cur, wr, wc, fr, fq); S.done(cur); }
        if (!has_next) break;
#pragma unroll
        for (int a = 0; a < 2; ++a)
#pragma unroll
            for (int b = 0; b < 2; ++b)
#pragma unroll
                for (int m = 0; m < 4; ++m)
#pragma unroll
                    for (int n = 0; n < 2; ++n) acc[a][b][m][n] = (f32x4){0.f, 0.f, 0.f, 0.f};
        cur = nxt; cA = nA; cB = nB; ++ui;
    }
    PG8_WAIT_V(0);
    if (wr == 0) PG8_BAR;
    PG8_BAR;
    if constexpr (Epi::AFTER_DRAIN) { E.fused(acc, cur, wr, wc, fr, fq, lds, wid, lane); S.done(cur); }
#undef PG8_SA
#undef PG8_SB
#undef PG8_STAGE
#undef PG8_LDA
#undef PG8_LDB
#undef PG8_MMA
#undef PG8_WAIT_V
#undef PG8_WAIT_L
#undef PG8_BAR
#undef PG8_SCHED
}
}

__device__ __forceinline__ void ph_adaln_partials(const Params& p, float* sm) {
    const int tid = tid_fresh();
    float* MODP = (float*)(p.ws + WS_MODP);
    for (int it = blockIdx.x; it < 384; it += gridDim.x) {
        const int l = it / 192, rem = it % 192, kc = rem / 6, cgp = rem % 6;
        __syncthreads();
        if (tid < 192) { const int r = tid >> 6, kk = tid & 63, k = kc * 64 + kk; const float cv = (r < 2) ? p.c[r * 2048 + k] : p.c_ctx[k]; sm[tid] = siluf_(cv); }
        __syncthreads();
        const int col = cgp * 2048 + tid * 4;
        float4 a0 = {0.f, 0.f, 0.f, 0.f}, a1 = a0, a2 = a0;
        const float* wp = p.mod_w + ((size_t)l * 2048 + (size_t)kc * 64) * 12288 + col;
#pragma unroll 8
        for (int kk = 0; kk < 64; ++kk) {
            const float4 w = *(const float4*)(wp + (size_t)kk * 12288);
            const float s0 = sm[kk], s1 = sm[64 + kk], s2 = sm[128 + kk];
            a0.x += s0 * w.x; a0.y += s0 * w.y; a0.z += s0 * w.z; a0.w += s0 * w.w;
            a1.x += s1 * w.x; a1.y += s1 * w.y; a1.z += s1 * w.z; a1.w += s1 * w.w;
            a2.x += s2 * w.x; a2.y += s2 * w.y; a2.z += s2 * w.z; a2.w += s2 * w.w;
        }
        float* o = MODP + ((size_t)(l * 32 + kc) * 3) * 12288 + col;
        *(float4*)(o) = a0; *(float4*)(o + 12288) = a1; *(float4*)(o + 2 * 12288) = a2;
    }
}
__device__ __forceinline__ void ph_adaln_reduce(const Params& p) {
    const float* MODP = (const float*)(p.ws + WS_MODP); float* MOD = (float*)(p.ws + WS_MOD);
    for (int idx = blockIdx.x * NTHR + tid_fresh(); idx < 2 * 3 * 12288; idx += gridDim.x * NTHR) {
        const int l = idx / 36864, r = (idx / 12288) % 3, col = idx % 12288;
        float s = p.mod_b[l * 12288 + col];
        for (int kc = 0; kc < 32; ++kc) s += MODP[((size_t)(l * 32 + kc) * 3 + r) * 12288 + col];
        MOD[idx] = s;
    }
}

template <int MODE> __device__ __forceinline__ int colmap(int n, int nsrc) {
    if (MODE == 0) return n < nsrc ? n : -1;
    if (MODE == 1) { if (n < 3072) return n; if (n < 7168) return n + 16; if (n < 7184) return 3072 + (n - 7168); if (n < 7216) return n; return -1; }
    return ((n >> 7) & 1) * 5632 + (n >> 8) * 128 + (n & 127);
}
template <int MODE> __device__ __forceinline__ void ph_convert(const float* W, int nsrc, int K, int nout, u16* Bt, float* sm) {
    const int tid = tid_fresh(); const int nnt = nout / 64, ntiles = nnt * (K / 64);
    for (int t = blockIdx.x; t < ntiles; t += gridDim.x) {
        const int k0 = (t / nnt) * 64, n0 = (t % nnt) * 64;
        __syncthreads();
#pragma unroll
        for (int i = 0; i < 8; ++i) { const int idx = i * NTHR + tid, kk = idx >> 6, nn = idx & 63; const int src = colmap<MODE>(n0 + nn, nsrc);
            sm[kk * 65 + nn] = src >= 0 ? W[(size_t)(k0 + kk) * nsrc + src] : 0.f; }
        __syncthreads();
        { const int nn = tid >> 3, k8 = (tid & 7) * 8; float v[8];
#pragma unroll
            for (int j = 0; j < 8; ++j) v[j] = sm[(k8 + j) * 65 + nn];
            *(uint4*)(Bt + (size_t)(n0 + nn) * K + k0 + k8) = pack8(v); }
    }
}

__device__ __forceinline__ void ph_norm(const float* srcC, const float* srcL, const float* g, const float* modl, int chunk_sh, int chunk_sc, u16* H, int row_begin) {
    const int tid_ = tid_fresh(); const int lane = tid_ & 63, w = tid_ >> 6;
    for (int row = row_begin + blockIdx.x * 8 + w; row < MTOT; row += gridDim.x * 8) {
        const float* src = row < 512 ? srcC + (size_t)row * 2048 : srcL + (size_t)(row - 512) * 2048;
        const int mr = row < 512 ? 2 : ((row - 512) >> 14);
        const float* sc = modl + (mr * 6 + chunk_sc) * 2048; const float* sh = modl + (mr * 6 + chunk_sh) * 2048;
        float4 v[8]; float ss = 0.f;
#pragma unroll
        for (int i = 0; i < 8; ++i) { v[i] = *(const float4*)(src + i * 256 + lane * 4); ss += v[i].x * v[i].x + v[i].y * v[i].y + v[i].z * v[i].z + v[i].w * v[i].w; }
        ss = red64(ss);
        const float rstd = rsqrtf(ss * (1.f / 2048.f) + 1e-6f);
#pragma unroll
        for (int i = 0; i < 8; ++i) { const int col = i * 256 + lane * 4;
            const float4 g4 = *(const float4*)(g + col), s4 = *(const float4*)(sc + col), h4 = *(const float4*)(sh + col);
            const float y0 = v[i].x * rstd * g4.x * (1.f + s4.x) + h4.x, y1 = v[i].y * rstd * g4.y * (1.f + s4.y) + h4.y;
            const float y2 = v[i].z * rstd * g4.z * (1.f + s4.z) + h4.z, y3 = v[i].w * rstd * g4.w * (1.f + s4.w) + h4.w;
            uint2 o; o.x = cvt_pk_bf16(y0, y1); o.y = cvt_pk_bf16(y2, y3);
            *(uint2*)(H + (size_t)row * 2048 + col) = o; }
    }
}
__device__ __forceinline__ void ph_final_norm(const Params& p) {
    const int tid_ = tid_fresh(); const int lane = tid_ & 63, w = tid_ >> 6;
    for (int row = blockIdx.x * 8 + w; row < MLAT; row += gridDim.x * 8) {
        float* src = p.out + (size_t)row * 2048;
        float4 v[8]; float ss = 0.f;
#pragma unroll
        for (int i = 0; i < 8; ++i) { v[i] = *(const float4*)(src + i * 256 + lane * 4); ss += v[i].x * v[i].x + v[i].y * v[i].y + v[i].z * v[i].z + v[i].w * v[i].w; }
        ss = red64(ss);
        const float rstd = rsqrtf(ss * (1.f / 2048.f) + 1e-6f);
#pragma unroll
        for (int i = 0; i < 8; ++i) { const int col = i * 256 + lane * 4; const float4 g4 = *(const float4*)(p.final_norm_g + col);
            float4 o; o.x = v[i].x * rstd * g4.x; o.y = v[i].y * rstd * g4.y; o.z = v[i].z * rstd * g4.z; o.w = v[i].w * rstd * g4.w;
            *(float4*)(src + col) = o; }
    }
}

__device__ __forceinline__ void ph_l0_prep(const Params& p, float* sm) {
    const int tid = tid_fresh();
    u16* PROJ = (u16*)(p.ws + WS_PROJ); u16* CQ = (u16*)(p.ws + WS_CQ); float* G = (float*)(p.ws + WS_G);
    for (int idx = blockIdx.x * NTHR + tid; idx < MTOT * 48; idx += gridDim.x * NTHR) {
        const int j = idx % 48; const float v = G[idx]; float o;
        if (j < 8) o = v + p.ml_ig_b[j];
        else if (j < 16) o = logsigmoidf_(v + p.ml_fg_b[j - 8]);
        else if (j < 32) { const float dt = softplusf_(v + p.dn_dt_bias[j - 16]); o = -__expf(p.dn_a_log[j - 16]) * dt; }
        else o = sigmoidf_(v);
        G[idx] = o;
    }
    {
        const int NB = (int)gridDim.x;
        const int tk = tid >> 3, cs = (tid & 7) * 16;
        for (int pb = (int)blockIdx.x; pb < (NB < 24 ? 24 : NB); pb += NB) {
        const int part = pb % 24, slot = pb / 24;
        const int nbp = NB >= 24 ? (NB - part + 23) / 24 : 1;
        float wt[5][16];
#pragma unroll
        for (int j = 0; j < 5; ++j)
#pragma unroll
            for (int c4 = 0; c4 < 4; ++c4) { const float4 w4 = *(const float4*)(p.dn_conv_w + j * 3072 + part * 128 + cs + c4 * 4); wt[j][c4 * 4] = w4.x; wt[j][c4 * 4 + 1] = w4.y; wt[j][c4 * 4 + 2] = w4.z; wt[j][c4 * 4 + 3] = w4.w; }
        uint4 in[5][2];
#define L0P_LOAD(TT) do { const int tt_ = (TT); const bool ic_ = tt_ < 8; const int t0_ = ic_ ? (tt_ & 3) * 64 : 0; const int rb_ = ic_ ? (tt_ >> 2) * 256 + t0_ : 512 + (tt_ - 8) * 64; \
            _Pragma("unroll") for (int j = 0; j < 5; ++j) { const int r = tk + j - 2; const bool ok = ic_ ? (t0_ + r >= 0 && t0_ + r < 256) : (r >= 0 && r < 64); \
                in[j][0] = make_uint4(0u, 0u, 0u, 0u); in[j][1] = in[j][0]; \
                if (ok) { const u16* src = PROJ + (size_t)(rb_ + r) * NP0 + 3072 + part * 128 + cs; in[j][0] = *(const uint4*)(src); in[j][1] = *(const uint4*)(src + 8); } } } while (0)
        if (slot < 520) L0P_LOAD(slot);
        for (int tt = slot; tt < 520; tt += nbp) {
            const bool isctx = tt < 8;
            const int t0 = isctx ? (tt & 3) * 64 : 0;
            const int rowbase = isctx ? (tt >> 2) * 256 + t0 : 512 + (tt - 8) * 64;
            float o[16];
#pragma unroll
            for (int c = 0; c < 16; ++c) o[c] = 0.f;
#pragma unroll
            for (int j = 0; j < 5; ++j) { float f[16]; unpack8(in[j][0], f); unpack8(in[j][1], f + 8);
#pragma unroll
                for (int c = 0; c < 16; ++c) o[c] += f[c] * wt[j][c]; }
            if (tt + nbp < 520) L0P_LOAD(tt + nbp);
            float ss = 0.f;
#pragma unroll
            for (int c = 0; c < 16; ++c) { o[c] = siluf_(o[c]); ss += o[c] * o[c]; }
            ss = red8(ss);
            if (part < 16) { const float sc = rsqrtf(ss + 1e-6f);
#pragma unroll
                for (int c = 0; c < 16; ++c) o[c] *= sc; }
            __syncthreads();
            if (part < 16) {
                const int rs = isctx ? 3072 : NP0; u16* tb = isctx ? CQ + (size_t)rowbase * 3072 + part * 128 : PROJ + (size_t)rowbase * NP0 + 3072 + part * 128;
                const int r0 = ((tk >> 4) * 4 + (cs >> 5)) * 4 + ((cs >> 3) & 3);
                *(uint4*)(tb + (size_t)r0 * rs + (tk & 15) * 8) = pack8(o); *(uint4*)(tb + (size_t)(r0 + 1) * rs + (tk & 15) * 8) = pack8(o + 8);
            } else {
                u16* dst = isctx ? CQ + (size_t)(rowbase + tk) * 3072 + part * 128 + cs : PROJ + (size_t)(rowbase + tk) * NP0 + 3072 + part * 128 + cs;
                *(uint4*)(dst) = pack8(o); *(uint4*)(dst + 8) = pack8(o + 8); }
        }
        }
    }
}

__device__ __forceinline__ void ph_l0_merge(const Params& p) {
    const int tid_ = tid_fresh(); const int lane = tid_ & 63, w = tid_ >> 6;
    const u16* PROJ = (const u16*)(p.ws + WS_PROJ); const u16* OF = (const u16*)(p.ws + WS_OF); const u16* OB = (const u16*)(p.ws + WS_OB); u16* Y = (u16*)(p.ws + WS_H);
    for (int row = blockIdx.x * 8 + w; row < MTOT; row += gridDim.x * 8) {
        float o[4][8]; float ss[4];
#pragma unroll
        for (int k = 0; k < 4; ++k) { const int col = (k * 64 + lane) * 8; float a[8], bb[8];
            unpack8(*(const uint4*)(OF + (size_t)row * 2048 + col), a); unpack8(*(const uint4*)(OB + (size_t)row * 2048 + col), bb);
            float s = 0.f;
#pragma unroll
            for (int j = 0; j < 8; ++j) { o[k][j] = a[j] + bb[j]; s += o[k][j] * o[k][j]; }
            s = red16(s);
            if (k < 2) s += __shfl_xor(s, 16);
            ss[k] = s; }
#pragma unroll
        for (int k = 0; k < 4; ++k) { const int col = (k * 64 + lane) * 8; const bool isml = k < 2;
            const float rstd = isml ? rsqrtf(ss[k] * (1.f / 256.f) + 1e-6f) : rsqrtf(ss[k] * (1.f / 128.f) + 1e-6f);
            const u16* gsrc = PROJ + (size_t)row * NP0 + (isml ? 2048 + col : 6144 + (col - 1024));
            const float* gn = isml ? p.ml_norm_g + col : p.dn_norm_g + (col - 1024);
            float gt[8], r[8]; unpack8(*(const uint4*)gsrc, gt);
            const float4 g0 = *(const float4*)gn, g1 = *(const float4*)(gn + 4); const float gg[8] = {g0.x, g0.y, g0.z, g0.w, g1.x, g1.y, g1.z, g1.w};
#pragma unroll
            for (int j = 0; j < 8; ++j) { const float gate = isml ? sigmoidf_(gt[j]) : siluf_(gt[j]); r[j] = o[k][j] * rstd * gg[j] * gate; }
            *(uint4*)(Y + (size_t)row * 2048 + col) = pack8(r); }
    }
}

typedef short bf16x8_t __attribute__((ext_vector_type(8)));
typedef float f32x4_t __attribute__((ext_vector_type(4)));
__device__ __forceinline__ float wave_cumsum(float x, int lane) {
#pragma unroll
    for (int o = 1; o < 64; o <<= 1) { const float t = __shfl_up(x, o); if (lane >= o) x += t; }
    return x; }
__device__ __forceinline__ float wave_cummax(float x, int lane) {
#pragma unroll
    for (int o = 1; o < 64; o <<= 1) { const float t = __shfl_up(x, o); if (lane >= o) x = fmaxf(x, t); }
    return x; }
__device__ __forceinline__ int tile_of(int n, int b, int dir) { if (n < 4) return b * 4 + (dir ? 3 - n : n); const int li = n - 4; return 8 + b * 256 + (dir ? 255 - li : li); }
__device__ __forceinline__ int rowbase_of(int tt) { return tt < 8 ? tt * 64 : 512 + (tt - 8) * 64; }

__device__ __forceinline__ void ml_prep_item(const Params& p, int it, float* wl, int lane) {
    const int h = it & 3, tt = (it >> 2) % 520, z = it / 2080, rowbase = rowbase_of(tt), fr = lane & 15, fq = lane >> 4;
    const u16* PROJ = (const u16*)(p.ws + WS_PROJ); const float* G = (const float*)(p.ws + WS_G);
    float* MLS = (float*)(p.ws + WS_MLS) + (size_t)it * 256; u16* ATT0 = (u16*)(p.ws + WS_ATT0) + (size_t)it * 4096;
    const int tk = z ? 63 - lane : lane, row = rowbase + tk;
    const float ig = G[row * 48 + z * 4 + h], lf = G[row * 48 + 8 + z * 4 + h];
    const float bb = wave_cumsum(lf, lane), gg = ig - bb, cm = wave_cummax(gg, lane);
    const float bL = __shfl(bb, 63), cmL = __shfl(cm, 63);
    MLS[tk] = bb; MLS[64 + tk] = cm; MLS[128 + tk] = __expf(gg - cmL); if (lane == 0) { MLS[192] = bL; MLS[193] = cmL; }
    wl[tk] = gg; wl[64 + tk] = cm;
    bf16x8_t kf[4][4];
#pragma unroll
    for (int rt = 0; rt < 4; ++rt)
#pragma unroll
        for (int ks = 0; ks < 4; ++ks) kf[rt][ks] = *(const bf16x8_t*)(PROJ + (size_t)(rowbase + (rt * 4 + ks) * 4 + fq) * NP0 + 512 + h * 128 + fr * 8);
#pragma unroll 1
    for (int rt = 0; rt < 4; ++rt) {
        bf16x8_t qf[4];
#pragma unroll
        for (int ks = 0; ks < 4; ++ks) qf[ks] = *(const bf16x8_t*)(PROJ + (size_t)(rowbase + (rt * 4 + ks) * 4 + fq) * NP0 + h * 128 + fr * 8);
#pragma unroll
        for (int ct = 0; ct < 4; ++ct) {
            f32x4_t acc = (f32x4_t){0.f, 0.f, 0.f, 0.f};
#pragma unroll
            for (int ks = 0; ks < 4; ++ks) acc = __builtin_amdgcn_mfma_f32_16x16x32_bf16(qf[ks], kf[ct][ks], acc, 0, 0, 0);
            const int s = ct * 16 + fr; const float gs = wl[s];
#pragma unroll
            for (int j = 0; j < 4; ++j) { const int l = rt * 16 + fq * 4 + j; const bool keep = z ? (s >= l) : (s <= l);
                const float e = __expf(fminf(gs - wl[64 + l], 0.f));
                ATT0[(((l >> 4) * 2 + (s >> 5)) * 64 + ((s >> 3) & 3) * 16 + (l & 15)) * 8 + (s & 7)] = f2bf(keep ? acc[j] * 0.08838834764831845f * e : 0.f); }
        }
    }
}
__device__ __forceinline__ void dn_prep_item(const Params& p, int it, float* Ap, int lane) {
    asm volatile("" : "+v"(lane));
    const int h = it & 7, tt = (it >> 3) % 520, z = it / 4160, rowbase = rowbase_of(tt), fr = lane & 15, fq = lane >> 4;
    const bool isctx = tt < 8;
    const u16* qb = isctx ? (const u16*)(p.ws + WS_CQ) + (size_t)rowbase * 3072 + h * 128 : (const u16*)(p.ws + WS_PROJ) + (size_t)rowbase * NP0 + 3072 + h * 128;
    const int rs = isctx ? 3072 : NP0;
    const float* G = (const float*)(p.ws + WS_G);
    float* GCS = (float*)(p.ws + WS_GCS) + (size_t)it * 256; u16* TM = (u16*)(p.ws + WS_TM) + (size_t)it * 4096; u16* QK = (u16*)(p.ws + WS_QK) + (size_t)it * 4096;
    float* gcs = Ap + 4096; float* bes = Ap + 4160;
    const int tk = z ? 63 - lane : lane, row = rowbase + tk;
    const float g = G[row * 48 + 16 + z * 8 + h], be = G[row * 48 + 32 + z * 8 + h];
    const float gc = wave_cumsum(g, lane), gL = __shfl(gc, 63);
    GCS[tk] = __expf(gc); GCS[64 + tk] = be; GCS[128 + tk] = __expf(gL - gc); if (lane == 0) GCS[192] = __expf(gL);
    gcs[tk] = gc; bes[tk] = be;
    bf16x8_t kf[4][4];
#pragma unroll
    for (int rt = 0; rt < 4; ++rt)
#pragma unroll
        for (int ks = 0; ks < 4; ++ks) kf[rt][ks] = *(const bf16x8_t*)(qb + (size_t)((rt * 4 + ks) * 4 + fq) * rs + 1024 + fr * 8);
#pragma unroll 1
    for (int rt = 0; rt < 4; ++rt) {
        bf16x8_t qf[4], ka[4];
#pragma unroll
        for (int ks = 0; ks < 4; ++ks) { qf[ks] = *(const bf16x8_t*)(qb + (size_t)((rt * 4 + ks) * 4 + fq) * rs + fr * 8); ka[ks] = *(const bf16x8_t*)(qb + (size_t)((rt * 4 + ks) * 4 + fq) * rs + 1024 + fr * 8); }
#pragma unroll
        for (int ct = 0; ct < 4; ++ct) {
            f32x4_t ck = (f32x4_t){0.f, 0.f, 0.f, 0.f}, cq = ck;
#pragma unroll
            for (int ks = 0; ks < 4; ++ks) { ck = __builtin_amdgcn_mfma_f32_16x16x32_bf16(ka[ks], kf[ct][ks], ck, 0, 0, 0); cq = __builtin_amdgcn_mfma_f32_16x16x32_bf16(qf[ks], kf[ct][ks], cq, 0, 0, 0); }
            const int s = ct * 16 + fr; const float gs = gcs[s];
#pragma unroll
            for (int j = 0; j < 4; ++j) { const int l = rt * 16 + fq * 4 + j;
                const bool strict = z ? (s > l) : (s < l), incl = z ? (s >= l) : (s <= l);
                const float e = __expf(fminf(gcs[l] - gs, 0.f));
                const int lp = z ? 63 - l : l, sp = z ? 63 - s : s;
                Ap[lp * 64 + sp] = strict ? bes[l] * ck[j] * e : 0.f;
                QK[(((l >> 4) * 2 + (s >> 5)) * 64 + ((s >> 3) & 3) * 16 + (l & 15)) * 8 + (s & 7)] = f2bf(incl ? cq[j] * 0.08838834764831845f * e : 0.f); }
        }
    }
    float T[64];
#pragma unroll
    for (int i = 0; i < 64; ++i) {
        float t = (i == lane) ? 1.f : 0.f;
#pragma unroll
        for (int j4 = 0; j4 < (i + 3) / 4; ++j4) { const float4 a4 = *(const float4*)(Ap + i * 64 + j4 * 4);
            if (j4 * 4 + 0 < i) t -= a4.x * T[j4 * 4 + 0];
            if (j4 * 4 + 1 < i) t -= a4.y * T[j4 * 4 + 1];
            if (j4 * 4 + 2 < i) t -= a4.z * T[j4 * 4 + 2];
            if (j4 * 4 + 3 < i) t -= a4.w * T[j4 * 4 + 3];
            if ((j4 & 7) == 7) asm volatile("" : "+v"(t) :: "memory"); }
        T[i] = t;
        asm volatile("" : "+v"(T[i]) :: "memory");
    }
    const int sc = z ? 63 - lane : lane;
    u16* TMp = TM + ((sc >> 5) * 64 + ((sc >> 3) & 3) * 16) * 8 + (sc & 7);
    if (z) {
#pragma unroll
        for (int i = 0; i < 64; ++i) { const int l = 63 - i; TMp[(l >> 4) * 1024 + (l & 15) * 8] = f2bf(T[i]); }
    } else {
#pragma unroll
        for (int i = 0; i < 64; ++i) { const int l = i; TMp[(l >> 4) * 1024 + (l & 15) * 8] = f2bf(T[i]); }
    }
}
__device__ __forceinline__ void ph_l0_prepass(const Params& p, unsigned char* lds) {
    const int tid = tid_fresh(), lane = tid & 63, w = tid >> 6;
    float* wl = (float*)(lds + (size_t)w * 16896);
    const int gw = blockIdx.x * 8 + w, nw = gridDim.x * 8;
    for (int it = (gw + nw - 128) % nw; it < 4160; it += nw) ml_prep_item(p, it, wl, lane);
    for (int it = gw; it < 8320; it += nw) dn_prep_item(p, it, wl, lane);
}

__device__ __forceinline__ unsigned ml_touch(const Params& p, int n, int b, int h, int dir, int e0, int tid) {
    const int nn = n < NSEG ? n : NSEG - 1;
    const int tt = tile_of(nn, b, dir), it = (dir * 520 + tt) * 4 + h, rowbase = rowbase_of(tt);
    const u16* PROJ = (const u16*)(p.ws + WS_PROJ);
    const u16* a;
    if (tid < 256) a = PROJ + (size_t)(rowbase + ((tid & 127) >> 1)) * NP0 + (tid >> 7) * 512 + h * 128 + (tid & 1) * 64;
    else if (tid < 320) a = PROJ + (size_t)(rowbase + tid - 256) * NP0 + 1024 + h * 256 + e0;
    else if (tid < 384) a = (const u16*)(p.ws + WS_ATT0) + (size_t)it * 4096 + (tid - 320) * 64;
    else a = (const u16*)(p.ws + WS_MLS) + (size_t)it * 512 + ((tid - 384) & 7) * 64;
    return *(const unsigned*)a;
}
struct MlFr { bf16x8_t q[4], at[2]; uint4 kr[2]; uint2 vr; float kw, b[4], cm[4], bL, cmL; };
__device__ __forceinline__ void ml_load(MlFr& F, const Params& p, int n, int b, int h, int dir, int e0, int lt, int fr, int fq, int tl, int seg) {
    const int nn = n < NSEG ? n : NSEG - 1;
    const int tt = tile_of(nn, b, dir), it = (dir * 520 + tt) * 4 + h, rowbase = rowbase_of(tt);
    const u16* PROJ = (const u16*)(p.ws + WS_PROJ);
    const u16* Q = PROJ + (size_t)(rowbase + lt * 16 + fq) * NP0 + h * 128 + fr * 8;
    const u16* AT = (const u16*)(p.ws + WS_ATT0) + (size_t)it * 4096 + lt * 1024 + (fq * 16 + fr) * 8;
    const float* MLS = (const float*)(p.ws + WS_MLS) + (size_t)it * 256;
#pragma unroll
    for (int ks = 0; ks < 4; ++ks) F.q[ks] = *(const bf16x8_t*)(Q + (size_t)ks * 4 * NP0);
#pragma unroll
    for (int ks = 0; ks < 2; ++ks) F.at[ks] = *(const bf16x8_t*)(AT + ks * 512);
    const u16* kp = PROJ + (size_t)(rowbase + ((tl >> 4) * 4 + (seg >> 1)) * 4 + (seg & 1) * 2) * NP0 + 512 + h * 128 + (tl & 15) * 8;
    F.kr[0] = *(const uint4*)(kp); F.kr[1] = *(const uint4*)(kp + NP0);
    F.vr = *(const uint2*)(PROJ + (size_t)(rowbase + tl) * NP0 + 1024 + h * 256 + e0 + seg * 4);
    F.kw = MLS[128 + tl];
#pragma unroll
    for (int j = 0; j < 4; ++j) { F.b[j] = MLS[lt * 16 + fq * 4 + j]; F.cm[j] = MLS[64 + lt * 16 + fq * 4 + j]; }
    F.bL = MLS[192]; F.cmL = MLS[193];
}
__device__ __forceinline__ void mlstm_chunk(const Params& p, int job, unsigned char* lds) {
    const int tid = tid_fresh(), lane = tid & 63, w = tid >> 6, fr = lane & 15, fq = lane >> 4;
    const int chain = job >> 3, cgp = job & 7;
    const int b = chain >> 3, h = (chain >> 1) & 3, dir = chain & 1;
    const int e0 = cgp * 32, lt = w >> 1, et = w & 1, dt0 = (w >> 1) * 2, tl = tid & 63, seg = tid >> 6;
    u16* Cl = (u16*)lds;
    u16* Ktw = (u16*)(lds + 17952);
    u16* Vt = (u16*)(lds + 17952 + 18432);
    u16* O = (u16*)(p.ws + (dir ? WS_OB : WS_OF));
    __syncthreads();
    for (int i = tid; i < 17952 / 4; i += NTHR) ((unsigned*)Cl)[i] = 0u;
    __syncthreads();
    f32x4_t Cacc[2], nacc; Cacc[0] = (f32x4_t){0.f, 0.f, 0.f, 0.f}; Cacc[1] = Cacc[0]; nacc = Cacc[0];
    float m_in = 0.f;
    bf16x8_t ones;
#pragma unroll
    for (int j = 0; j < 8; ++j) ones[j] = (short)0x3F80;
    MlFr buf[2];
    ml_load(buf[0], p, 0, b, h, dir, e0, lt, fr, fq, tl, seg); ml_load(buf[1], p, 1, b, h, dir, e0, lt, fr, fq, tl, seg);
    unsigned pfr[4] = {0u, 0u, 0u, 0u}, sink = 0u;
    for (int n0 = 0; n0 < NSEG; n0 += 4) {
#pragma unroll
        for (int u = 0; u < 4; ++u) {
            const int n = n0 + u; const int s = u & 1;
            sink ^= pfr[u]; pfr[u] = ml_touch(p, n + 5, b, h, dir, e0, tid);
            const MlFr& F = buf[s];
            const int tt = tile_of(n, b, dir), rowbase = rowbase_of(tt);
            const u16* Ccur = Cl + (n & 1) * (33 * 136); u16* Cnxt = Cl + ((n + 1) & 1) * (33 * 136);
            { float k[16]; unpack8(F.kr[0], k); unpack8(F.kr[1], k + 8);
#pragma unroll
                for (int c = 0; c < 16; ++c) Ktw[(seg * 16 + c) * 72 + tl] = f2bf(k[c] * F.kw);
                Vt[(seg * 4 + 0) * 72 + tl] = (u16)(F.vr.x & 0xffffu); Vt[(seg * 4 + 1) * 72 + tl] = (u16)(F.vr.x >> 16);
                Vt[(seg * 4 + 2) * 72 + tl] = (u16)(F.vr.y & 0xffffu); Vt[(seg * 4 + 3) * 72 + tl] = (u16)(F.vr.y >> 16); }
            __syncthreads();
            bf16x8_t vt[2];
#pragma unroll
            for (int ks = 0; ks < 2; ++ks) vt[ks] = *(const bf16x8_t*)(Vt + (et * 16 + fr) * 72 + ks * 32 + fq * 8);
            {
                f32x4_t inter = (f32x4_t){0.f, 0.f, 0.f, 0.f}, intra = inter, dinter = inter, dintra = inter;
#pragma unroll
                for (int ks = 0; ks < 4; ++ks) { const bf16x8_t cb = *(const bf16x8_t*)(Ccur + (et * 16 + fr) * 136 + ks * 32 + fq * 8); const bf16x8_t nb = *(const bf16x8_t*)(Ccur + 32 * 136 + ks * 32 + fq * 8);
                    inter = __builtin_amdgcn_mfma_f32_16x16x32_bf16(F.q[ks], cb, inter, 0, 0, 0); dinter = __builtin_amdgcn_mfma_f32_16x16x32_bf16(F.q[ks], nb, dinter, 0, 0, 0); }
#pragma unroll
                for (int ks = 0; ks < 2; ++ks) { intra = __builtin_amdgcn_mfma_f32_16x16x32_bf16(F.at[ks], vt[ks], intra, 0, 0, 0); dintra = __builtin_amdgcn_mfma_f32_16x16x32_bf16(F.at[ks], ones, dintra, 0, 0, 0); }
#pragma unroll
                for (int j = 0; j < 4; ++j) { const float M = fmaxf(F.cm[j], m_in); const float r = __expf(F.cm[j] - M), ei = __expf(m_in - M) * 0.08838834764831845f;
                    const float num = r * intra[j] + ei * inter[j], den = r * dintra[j] + ei * dinter[j];
                    const float hv = num * frcp(fmaxf(fabsf(den), __expf(-(F.b[j] + M))));
                    O[(size_t)(rowbase + lt * 16 + fq * 4 + j) * 2048 + h * 256 + e0 + et * 16 + fr] = f2bf(hv); }
            }
            { const float ML = fmaxf(F.cmL, m_in); const float a = __expf(m_in - ML), sc2 = __expf(F.cmL - ML); m_in = F.bL + ML;
#pragma unroll
                for (int i = 0; i < 2; ++i) { f32x4_t nw = (f32x4_t){0.f, 0.f, 0.f, 0.f};
#pragma unroll
                    for (int ks = 0; ks < 2; ++ks) { const bf16x8_t kb = *(const bf16x8_t*)(Ktw + ((dt0 + i) * 16 + fr) * 72 + ks * 32 + fq * 8); nw = __builtin_amdgcn_mfma_f32_16x16x32_bf16(vt[ks], kb, nw, 0, 0, 0); }
#pragma unroll
                    for (int j = 0; j < 4; ++j) { Cacc[i][j] = a * Cacc[i][j] + sc2 * nw[j]; Cnxt[(et * 16 + fq * 4 + j) * 136 + (dt0 + i) * 16 + fr] = f2bf(Cacc[i][j]); } }
                f32x4_t nw = (f32x4_t){0.f, 0.f, 0.f, 0.f};
#pragma unroll
                for (int ks = 0; ks < 2; ++ks) { const bf16x8_t kb = *(const bf16x8_t*)(Ktw + (w * 16 + fr) * 72 + ks * 32 + fq * 8); nw = __builtin_amdgcn_mfma_f32_16x16x32_bf16(ones, kb, nw, 0, 0, 0); }
                nacc[0] = a * nacc[0] + sc2 * nw[0];
                if (fq == 0) Cnxt[32 * 136 + w * 16 + fr] = f2bf(nacc[0]); }
            __syncthreads();
            ml_load(buf[s], p, n + 2, b, h, dir, e0, lt, fr, fq, tl, seg);
        }
    }
    ((unsigned*)(p.ws + WS_MODP))[blockIdx.x * NTHR + tid] = sink ^ pfr[0] ^ pfr[1] ^ pfr[2] ^ pfr[3];
}

__device__ __forceinline__ unsigned dn_touch(const Params& p, int n, int b, int h, int dir, int e0, int tid) {
    const int nn = n < NSEG ? n : NSEG - 1;
    const int tt = tile_of(nn, b, dir), it = (dir * 520 + tt) * 8 + h, rowbase = rowbase_of(tt);
    const bool isctx = tt < 8;
    const u16* qb = isctx ? (const u16*)(p.ws + WS_CQ) + (size_t)rowbase * 3072 + h * 128 : (const u16*)(p.ws + WS_PROJ) + (size_t)rowbase * NP0 + 3072 + h * 128;
    const int rs = isctx ? 3072 : NP0;
    const u16* a;
    if (tid < 256) a = qb + (size_t)((tid & 127) >> 1) * rs + (tid >> 7) * 1024 + (tid & 1) * 64;
    else if (tid < 320) a = qb + (size_t)(tid - 256) * rs + 2048 + e0;
    else if (tid < 384) a = (const u16*)(p.ws + WS_TM) + (size_t)it * 4096 + (tid - 320) * 64;
    else if (tid < 448) a = (const u16*)(p.ws + WS_QK) + (size_t)it * 4096 + (tid - 384) * 64;
    else a = (const u16*)(p.ws + WS_GCS) + (size_t)it * 512 + ((tid - 448) & 7) * 64;
    return *(const unsigned*)a;
}
struct DnFr { bf16x8_t k[4], q[4], tm[2], qk[2]; uint4 kr[2]; float kds, egc[4], be[4], egL; u16 v[4]; };
__device__ __forceinline__ void dn_load(DnFr& F, const Params& p, int n, int b, int h, int dir, int e0, int lt, int et, int fr, int fq, int tl, int seg) {
    const int nn = n < NSEG ? n : NSEG - 1;
    const int tt = tile_of(nn, b, dir), it = (dir * 520 + tt) * 8 + h, rowbase = rowbase_of(tt);
    const bool isctx = tt < 8;
    const u16* qb = isctx ? (const u16*)(p.ws + WS_CQ) + (size_t)rowbase * 3072 + h * 128 : (const u16*)(p.ws + WS_PROJ) + (size_t)rowbase * NP0 + 3072 + h * 128;
    const int rs = isctx ? 3072 : NP0;
    const u16* TM = (const u16*)(p.ws + WS_TM) + (size_t)it * 4096 + lt * 1024 + (fq * 16 + fr) * 8;
    const u16* QK = (const u16*)(p.ws + WS_QK) + (size_t)it * 4096 + lt * 1024 + (fq * 16 + fr) * 8;
    const float* GCS = (const float*)(p.ws + WS_GCS) + (size_t)it * 256;
    const u16* qr = qb + (size_t)(lt * 16 + fq) * rs + fr * 8;
#pragma unroll
    for (int ks = 0; ks < 4; ++ks) { F.q[ks] = *(const bf16x8_t*)(qr + (size_t)ks * 4 * rs); F.k[ks] = *(const bf16x8_t*)(qr + (size_t)ks * 4 * rs + 1024); }
#pragma unroll
    for (int ks = 0; ks < 2; ++ks) { F.tm[ks] = *(const bf16x8_t*)(TM + ks * 512); F.qk[ks] = *(const bf16x8_t*)(QK + ks * 512); }
    const u16* kp = qb + (size_t)(((tl >> 4) * 4 + (seg >> 1)) * 4 + (seg & 1) * 2) * rs + 1024 + (tl & 15) * 8;
    F.kr[0] = *(const uint4*)(kp); F.kr[1] = *(const uint4*)(kp + rs);
    F.kds = GCS[128 + tl]; F.egL = GCS[192];
#pragma unroll
    for (int j = 0; j < 4; ++j) { const int l = lt * 16 + fq * 4 + j; F.egc[j] = GCS[l]; F.be[j] = GCS[64 + l]; F.v[j] = qb[(size_t)l * rs + 2048 + e0 + et * 16 + fr]; }
}
__device__ __forceinline__ void deltanet_chunk(const Params& p, int job, unsigned char* lds) {
    const int tid = tid_fresh(), lane = tid & 63, w = tid >> 6, fr = lane & 15, fq = lane >> 4;
    const int chain = job >> 2, cgp = job & 3;
    const int b = chain >> 4, h = (chain >> 1) & 7, dir = chain & 1;
    const int e0 = cgp * 32, lt = w >> 1, et = w & 1, dt0 = (w >> 1) * 2, tl = tid & 63, seg = tid >> 6;
    u16* Sl = (u16*)lds;
    u16* Rt = (u16*)(lds + 17408);
    u16* VNt = (u16*)(lds + 17408 + 4608);
    u16* Kdt = (u16*)(lds + 17408 + 9216);
    u16* O = (u16*)(p.ws + (dir ? WS_OB : WS_OF));
    __syncthreads();
    for (int i = tid; i < 17408 / 4; i += NTHR) ((unsigned*)Sl)[i] = 0u;
    __syncthreads();
    f32x4_t Sacc[2]; Sacc[0] = (f32x4_t){0.f, 0.f, 0.f, 0.f}; Sacc[1] = Sacc[0];
    DnFr buf[2];
    dn_load(buf[0], p, 0, b, h, dir, e0, lt, et, fr, fq, tl, seg); dn_load(buf[1], p, 1, b, h, dir, e0, lt, et, fr, fq, tl, seg);
    unsigned pfr[4] = {0u, 0u, 0u, 0u}, sink = 0u;
    for (int n0 = 0; n0 < NSEG; n0 += 4) {
#pragma unroll
        for (int u = 0; u < 4; ++u) {
            const int n = n0 + u; const int s = u & 1;
            sink ^= pfr[u]; pfr[u] = dn_touch(p, n + 5, b, h, dir, e0, tid);
            const DnFr& F = buf[s];
            const int tt = tile_of(n, b, dir), rowbase = rowbase_of(tt);
            const u16* Scur = Sl + (n & 1) * (32 * 136); u16* Snxt = Sl + ((n + 1) & 1) * (32 * 136);
            f32x4_t X = (f32x4_t){0.f, 0.f, 0.f, 0.f}, Y = X;
#pragma unroll
            for (int ks = 0; ks < 4; ++ks) { const bf16x8_t sb = *(const bf16x8_t*)(Scur + (et * 16 + fr) * 136 + ks * 32 + fq * 8);
                X = __builtin_amdgcn_mfma_f32_16x16x32_bf16(F.k[ks], sb, X, 0, 0, 0); Y = __builtin_amdgcn_mfma_f32_16x16x32_bf16(F.q[ks], sb, Y, 0, 0, 0); }
#pragma unroll
            for (int j = 0; j < 4; ++j) Rt[(et * 16 + fr) * 72 + lt * 16 + fq * 4 + j] = f2bf(F.be[j] * (bf2f(F.v[j]) - F.egc[j] * X[j]));
            { float k[16]; unpack8(F.kr[0], k); unpack8(F.kr[1], k + 8);
#pragma unroll
                for (int c = 0; c < 16; ++c) Kdt[(seg * 16 + c) * 72 + tl] = f2bf(k[c] * F.kds); }
            __syncthreads();
            { f32x4_t VN = (f32x4_t){0.f, 0.f, 0.f, 0.f};
#pragma unroll
                for (int ks = 0; ks < 2; ++ks) { const bf16x8_t rb = *(const bf16x8_t*)(Rt + (et * 16 + fr) * 72 + ks * 32 + fq * 8); VN = __builtin_amdgcn_mfma_f32_16x16x32_bf16(F.tm[ks], rb, VN, 0, 0, 0); }
#pragma unroll
                for (int j = 0; j < 4; ++j) VNt[(et * 16 + fr) * 72 + lt * 16 + fq * 4 + j] = f2bf(VN[j]); }
            __syncthreads();
            bf16x8_t vn[2];
#pragma unroll
            for (int ks = 0; ks < 2; ++ks) vn[ks] = *(const bf16x8_t*)(VNt + (et * 16 + fr) * 72 + ks * 32 + fq * 8);
            { f32x4_t acc = (f32x4_t){0.f, 0.f, 0.f, 0.f};
#pragma unroll
                for (int ks = 0; ks < 2; ++ks) acc = __builtin_amdgcn_mfma_f32_16x16x32_bf16(F.qk[ks], vn[ks], acc, 0, 0, 0);
#pragma unroll
                for (int j = 0; j < 4; ++j) O[(size_t)(rowbase + lt * 16 + fq * 4 + j) * 2048 + 1024 + h * 128 + e0 + et * 16 + fr] = f2bf(0.08838834764831845f * F.egc[j] * Y[j] + acc[j]); }
#pragma unroll
            for (int i = 0; i < 2; ++i) { f32x4_t nw = (f32x4_t){0.f, 0.f, 0.f, 0.f};
#pragma unroll
                for (int ks = 0; ks < 2; ++ks) { const bf16x8_t kb = *(const bf16x8_t*)(Kdt + ((dt0 + i) * 16 + fr) * 72 + ks * 32 + fq * 8); nw = __builtin_amdgcn_mfma_f32_16x16x32_bf16(vn[ks], kb, nw, 0, 0, 0); }
#pragma unroll
                for (int j = 0; j < 4; ++j) { Sacc[i][j] = F.egL * Sacc[i][j] + nw[j]; Snxt[(et * 16 + fq * 4 + j) * 136 + (dt0 + i) * 16 + fr] = f2bf(Sacc[i][j]); } }
            __syncthreads();
            dn_load(buf[s], p, n + 2, b, h, dir, e0, lt, et, fr, fq, tl, seg);
        }
    }
    ((unsigned*)(p.ws + WS_MODP))[blockIdx.x * NTHR + tid] = sink ^ pfr[0] ^ pfr[1] ^ pfr[2] ^ pfr[3];
}

constexpr int RG_XC = 65536;

__device__ __forceinline__ void ph_convert_rg(const Params& p) {
    u16* WRT = (u16*)(p.ws + WS_WRT);
    for (int idx = blockIdx.x * NTHR + tid_fresh(); idx < 65536; idx += gridDim.x * NTHR) {
        const int k8 = idx & 15, n = (idx >> 4) & 127, mzg = idx >> 11;
        const float* W = (mzg < 16 ? p.rg_w_r : p.rg_w_i) + (size_t)(mzg & 15) * 16384;
        float v[8];
#pragma unroll
        for (int j = 0; j < 8; ++j) v[j] = W[(k8 * 8 + j) * 128 + n];
        *(uint4*)(WRT + (size_t)mzg * 16384 + (((n >> 4) * 4 + (k8 >> 2)) * 64 + (k8 & 3) * 16 + (n & 15)) * 8) = pack8(v);
    }
}
__device__ __forceinline__ int rg_tau(int tt, int z) { if (tt < 8) { const int ci = tt & 3; return z ? 3 - ci : ci; } const int li = (tt - 8) & 255; return 4 + (z ? 255 - li : li); }
__device__ __forceinline__ int rg_batch(int tt) { return tt < 8 ? (tt >> 2) : ((tt - 8) >> 8); }

__device__ __forceinline__ void rg_conv(const Params& p, int tt, int g, unsigned char* lds) {
    const int tid = tid_fresh();
    const u16* PROJ = (const u16*)(p.ws + WS_PROJ);
    u16* XC = (u16*)(lds + RG_XC);
    const bool isctx = tt < 8;
    const int t0 = isctx ? (tt & 3) * 64 : 0;
    const int rowbase = isctx ? (tt >> 2) * 256 + t0 : 512 + (tt - 8) * 64;
    const int tk = tid >> 3, cs = (tid & 7) * 16;
    uint4 in[5][2];
#pragma unroll
    for (int j = 0; j < 5; ++j) { const int r = tk + j - 2;
        const bool ok = isctx ? (t0 + r >= 0 && t0 + r < 256) : (r >= 0 && r < 64);
        in[j][0] = make_uint4(0u, 0u, 0u, 0u); in[j][1] = in[j][0];
        if (ok) { const u16* src = PROJ + (size_t)(rowbase + r) * NP1 + g * 128 + cs; in[j][0] = *(const uint4*)(src); in[j][1] = *(const uint4*)(src + 8); } }
    float o[16];
#pragma unroll
    for (int c4 = 0; c4 < 4; ++c4) { const float4 b4 = *(const float4*)(p.rg_conv_b + g * 128 + cs + c4 * 4); o[c4 * 4] = b4.x; o[c4 * 4 + 1] = b4.y; o[c4 * 4 + 2] = b4.z; o[c4 * 4 + 3] = b4.w; }
#pragma unroll
    for (int j = 0; j < 5; ++j) {
        const float* wr_ = p.rg_conv_w + j * 1024 + g * 128 + cs; float f[16]; unpack8(in[j][0], f); unpack8(in[j][1], f + 8);
#pragma unroll
        for (int c4 = 0; c4 < 4; ++c4) { const float4 w4 = *(const float4*)(wr_ + c4 * 4);
            o[c4 * 4 + 0] += f[c4 * 4 + 0] * w4.x; o[c4 * 4 + 1] += f[c4 * 4 + 1] * w4.y; o[c4 * 4 + 2] += f[c4 * 4 + 2] * w4.z; o[c4 * 4 + 3] += f[c4 * 4 + 3] * w4.w; }
    }
    __syncthreads();
    *(uint4*)(XC + tk * 136 + cs) = pack8(o); *(uint4*)(XC + tk * 136 + cs + 8) = pack8(o + 8);
    __syncthreads();
}
__device__ __forceinline__ void rg_gates_reg(const Params& p, int g, int z, const unsigned char* lds, int rt, int chh, int fr, int fq, float (&av)[4][4], float (&bx)[4][4]) {
    const u16* XC = (const u16*)(lds + RG_XC);
    const u16* WR = (const u16*)(p.ws + WS_WRT) + (size_t)((0 * 2 + z) * 8 + g) * 16384; const u16* WI = (const u16*)(p.ws + WS_WRT) + (size_t)((1 * 2 + z) * 8 + g) * 16384;
    f32x4_t R[4], I[4];
#pragma unroll
    for (int c = 0; c < 4; ++c) { R[c] = (f32x4_t){0.f, 0.f, 0.f, 0.f}; I[c] = (f32x4_t){0.f, 0.f, 0.f, 0.f}; }
#pragma unroll
    for (int ks = 0; ks < 4; ++ks) {
        const bf16x8_t a = *(const bf16x8_t*)(XC + (rt * 16 + fr) * 136 + ks * 32 + fq * 8);
#pragma unroll
        for (int c = 0; c < 4; ++c) { const int fo = (((chh * 4 + c) * 4 + ks) * 64 + fq * 16 + fr) * 8;
            R[c] = __builtin_amdgcn_mfma_f32_16x16x32_bf16(a, *(const bf16x8_t*)(WR + fo), R[c], 0, 0, 0);
            I[c] = __builtin_amdgcn_mfma_f32_16x16x32_bf16(a, *(const bf16x8_t*)(WI + fo), I[c], 0, 0, 0); }
    }
#pragma unroll
    for (int c = 0; c < 4; ++c) {
        const int chl = (chh * 4 + c) * 16 + fr, chg = z * 1024 + g * 128 + chl;
        const float br = p.rg_b_r[chg], bi = p.rg_b_i[chg], sp = softplusf_(-p.rg_lambda[chg]);
#pragma unroll
        for (int j = 0; j < 4; ++j) { const int t = rt * 16 + fq * 4 + j;
            const float r = sigmoidf_(R[c][j] + br), ii = sigmoidf_(I[c][j] + bi);
            const float la = -8.f * r * sp;
            av[c][j] = __expf(la); bx[c][j] = __builtin_amdgcn_sqrtf(neg_expm1_small(2.f * la)) * ii * bf2f(XC[t * 136 + chl]); }
    }
}
__device__ __forceinline__ float2 rg_local(const float (&a)[4], const float (&b)[4], int z) {
    float P = 1.f, H = 0.f;
#pragma unroll
    for (int i = 0; i < 4; ++i) { const int j = z ? 3 - i : i; H = a[j] * H + b[j]; P *= a[j]; }
    return make_float2(P, H);
}
__device__ __forceinline__ void gla_prep_item(const Params& p, int it, unsigned char* lds) {
    const int tid = tid_fresh(), lane = tid & 63, w = tid >> 6, fr = lane & 15, fq = lane >> 4;
    const int h = it & 3, tt = (it >> 2) % 520, z = it / 2080;
    const int rowbase = tt < 8 ? tt * 64 : 512 + (tt - 8) * 64;
    float* LG = (float*)lds;
    u16* QEs = (u16*)(lds + 32768);
    u16* KEs = (u16*)(lds + 32768 + 17408);
    u16* Vs = (u16*)(lds + 32768 + 2 * 17408);
    float* BLs = (float*)(lds + 32768 + 2 * 17408 + 33792);
    const u16* PROJ = (const u16*)(p.ws + WS_PROJ); const float* LR = (const float*)(p.ws + WS_G);
    u16* QE = (u16*)(p.ws + WS_QE); u16* KDT = (u16*)(p.ws + WS_KDT) + (size_t)it * 8192; u16* ATT = (u16*)(p.ws + WS_ATT) + (size_t)it * 4096;
    u16* VT = (u16*)(p.ws + WS_VT); float* EBL = (float*)(p.ws + WS_EBL);
    __syncthreads();
    { float* LRs = (float*)(lds + 32768);
        for (int i = tid; i < 1024; i += NTHR) LRs[i] = LR[(size_t)(rowbase + (i >> 4)) * 32 + z * 16 + (i & 15)];
        __syncthreads();
        const int c = tid & 127, tq = tid >> 7; float wv[16];
#pragma unroll
        for (int r = 0; r < 16; ++r) wv[r] = p.gla_w_up[(z * 16 + r) * 512 + h * 128 + c];
        const float bu = p.gla_b_up[z * 512 + h * 128 + c];
        for (int i = 0; i < 16; ++i) { const int tk = tq * 16 + i; const float4* lr4 = (const float4*)(LRs + tk * 16); float s = bu;
#pragma unroll
            for (int r4 = 0; r4 < 4; ++r4) { const float4 l4 = lr4[r4]; s += l4.x * wv[r4 * 4] + l4.y * wv[r4 * 4 + 1] + l4.z * wv[r4 * 4 + 2] + l4.w * wv[r4 * 4 + 3]; }
            LG[tk * 128 + c] = logsigmoidf_(s) * (1.f / 16.f); } }
    __syncthreads();
    if (tid < 128) { float acc = 0.f;
        for (int i = 0; i < 64; ++i) { const int tk = z ? 63 - i : i; acc += LG[tk * 128 + tid]; LG[tk * 128 + tid] = acc; }
        BLs[tid] = acc; EBL[(size_t)it * 128 + tid] = __expf(acc); }
    __syncthreads();
    { const int tk = tid >> 3, cs = (tid & 7) * 16; const u16* rp = PROJ + (size_t)(rowbase + tk) * NP1;
        float q[16], k[16], qe[16], ke[16];
        unpack8(*(const uint4*)(rp + 2048 + h * 128 + cs), q); unpack8(*(const uint4*)(rp + 2048 + h * 128 + cs + 8), q + 8);
        unpack8(*(const uint4*)(rp + 2560 + h * 128 + cs), k); unpack8(*(const uint4*)(rp + 2560 + h * 128 + cs + 8), k + 8);
#pragma unroll
        for (int c = 0; c < 16; ++c) { const float bb = LG[tk * 128 + cs + c], bl = BLs[cs + c];
            qe[c] = q[c] * 0.08838834764831845f * __expf(bb); ke[c] = k[c] * __expf(-bb);
            { const int d = cs + c; KDT[(((d >> 4) * 2 + (tk >> 5)) * 64 + ((tk >> 3) & 3) * 16 + (d & 15)) * 8 + (tk & 7)] = f2bf(k[c] * __expf(bl - bb)); } }
        const uint4 q0 = pack8(qe), q1 = pack8(qe + 8);
        *(uint4*)(QEs + tk * 136 + cs) = q0; *(uint4*)(QEs + tk * 136 + cs + 8) = q1;
        *(uint4*)(KEs + tk * 136 + cs) = pack8(ke); *(uint4*)(KEs + tk * 136 + cs + 8) = pack8(ke + 8);
        u16* qg = QE + (size_t)it * 8192 + (((tk >> 4) * 4 + (cs >> 5)) * 64 + ((cs >> 3) & 3) * 16 + (tk & 15)) * 8;
        *(uint4*)(qg) = q0; *(uint4*)(qg + 128) = q1; }
    if (z == 0) for (int ch = tid; ch < 2048; ch += NTHR) { const int tk = ch >> 5, c8 = (ch & 31) * 8;
        *(uint4*)(Vs + tk * 264 + c8) = *(const uint4*)(PROJ + (size_t)(rowbase + tk) * NP1 + 3072 + h * 256 + c8); }
    __syncthreads();
    { const int rt = w >> 1;
#pragma unroll
        for (int i = 0; i < 2; ++i) { const int ct = (w & 1) * 2 + i; f32x4_t acc = (f32x4_t){0.f, 0.f, 0.f, 0.f};
#pragma unroll
            for (int ks = 0; ks < 4; ++ks) { const bf16x8_t a = *(const bf16x8_t*)(QEs + (rt * 16 + fr) * 136 + ks * 32 + fq * 8); const bf16x8_t bb = *(const bf16x8_t*)(KEs + (ct * 16 + fr) * 136 + ks * 32 + fq * 8);
                acc = __builtin_amdgcn_mfma_f32_16x16x32_bf16(a, bb, acc, 0, 0, 0); }
#pragma unroll
            for (int j = 0; j < 4; ++j) { const int l = rt * 16 + fq * 4 + j, s = ct * 16 + fr; const bool keep = z ? (s >= l) : (s <= l);
                ATT[(((l >> 4) * 2 + (s >> 5)) * 64 + ((s >> 3) & 3) * 16 + (l & 15)) * 8 + (s & 7)] = f2bf(keep ? acc[j] : 0.f); } } }
    if (z == 0) { const int e = tid >> 1, hf = tid & 1; u16* dst = VT + (size_t)(tt * 4 + h) * 16384 + (((e >> 4) * 2 + hf) * 64 + (e & 15)) * 8;
#pragma unroll
        for (int l8 = 0; l8 < 4; ++l8) { float v[8];
#pragma unroll
            for (int j = 0; j < 8; ++j) v[j] = bf2f(Vs[(hf * 32 + l8 * 8 + j) * 264 + e]);
            *(uint4*)(dst + l8 * 128) = pack8(v); } }
}
__device__ __forceinline__ void ph_l1_a(const Params& p, unsigned char* lds, int parts = 3) {
    const int tid = tid_fresh(), lane = tid & 63, w = tid >> 6, rt = w >> 1, chh = w & 1, fr = lane & 15, fq = lane >> 4;
#ifdef PROBE3
    if (blockIdx.x == 100 && tid == 0) { unsigned long long* pr = (unsigned long long*)(p.ws + WS_MODP) + 500000; pr[0] = __builtin_amdgcn_s_memrealtime(); }
#endif
    float2* AGG = (float2*)(p.ws + WS_AGG);
    float2* AG = (float2*)lds;
    if (parts & 1) for (int t = blockIdx.x; t < 520 * 8; t += gridDim.x) {
        const int tt = t >> 3, g = t & 7, b = rg_batch(tt);
        rg_conv(p, tt, g, lds);
#pragma unroll
        for (int z = 0; z < 2; ++z) {
            float av[4][4], bx[4][4];
            rg_gates_reg(p, g, z, lds, rt, chh, fr, fq, av, bx);
#pragma unroll
            for (int c = 0; c < 4; ++c) AG[(z * 16 + rt * 4 + fq) * 128 + (chh * 4 + c) * 16 + fr] = rg_local(av[c], bx[c], z);
        }
        __syncthreads();
        if (tid < 256) { const int z = tid >> 7, ch = tid & 127; float P = 1.f, H = 0.f;
#pragma unroll
            for (int s = 0; s < 16; ++s) { const int gi = z ? 15 - s : s; const float2 ph = AG[(z * 16 + gi) * 128 + ch]; H = ph.x * H + ph.y; P *= ph.x; }
            AGG[((size_t)(b * 2 + z) * NSEG + rg_tau(tt, z)) * 1024 + g * 128 + ch] = make_float2(P, H); }
    }
#ifdef PROBE3
    __syncthreads(); const unsigned long long tm_ = __builtin_amdgcn_s_memrealtime();
#endif
    if (parts & 2) for (int it = blockIdx.x; it < 4160; it += gridDim.x) gla_prep_item(p, it, lds);
#ifdef PROBE3
    __syncthreads(); if (blockIdx.x == 100 && tid == 0) { unsigned long long* pr = (unsigned long long*)(p.ws + WS_MODP) + 500000; pr[1] = tm_; pr[2] = __builtin_amdgcn_s_memrealtime(); }
#endif
}
__device__ __forceinline__ void rg_pass_b(const Params& p, int job) {
    const float2* __restrict__ AGG = (const float2*)(p.ws + WS_AGG); float* __restrict__ CARRY = (float*)(p.ws + WS_CARRY);
    const int bz = job >> 1, ch = (job & 1) * 512 + tid_fresh();
    float carry = 0.f;
    for (int t0 = 0; t0 < NSEG; t0 += 20) {
        float2 ph[20];
#pragma unroll
        for (int i = 0; i < 20; ++i) ph[i] = AGG[((size_t)bz * NSEG + t0 + i) * 1024 + ch];
#pragma unroll
        for (int i = 0; i < 20; ++i) { CARRY[((size_t)bz * NSEG + t0 + i) * 1024 + ch] = carry; carry = ph[i].x * carry + ph[i].y; }
    }
}
struct GlaFr { bf16x8_t qe[4], at[2], vt[2], kd[2][2]; float eb[2]; };
struct GlaOff { int qe, at, vt, kd, eb, o, tch, tsel; };
__device__ __forceinline__ void gla_load(GlaFr& F, const unsigned char* ws, int n, int b, int h, int dir, const GlaOff& o) {
    const int nn = n < NSEG ? n : NSEG - 1;
    const int tt = tile_of(nn, b, dir), it = (dir * 520 + tt) * 4 + h, rowbase = rowbase_of(tt);
    const u16* QE = (const u16*)(ws + WS_QE) + (size_t)it * 8192;
    const u16* AT = (const u16*)(ws + WS_ATT) + (size_t)it * 4096;
    const u16* VT = (const u16*)(ws + WS_VT) + (size_t)(tt * 4 + h) * 16384;
    const u16* KD = (const u16*)(ws + WS_KDT) + (size_t)it * 8192;
    const float* EB = (const float*)(ws + WS_EBL) + (size_t)it * 128;
#pragma unroll
    for (int ks = 0; ks < 4; ++ks) F.qe[ks] = *(const bf16x8_t*)(QE + o.qe + ks * 512);
#pragma unroll
    for (int ks = 0; ks < 2; ++ks) { F.at[ks] = *(const bf16x8_t*)(AT + o.at + ks * 512); F.vt[ks] = *(const bf16x8_t*)(VT + o.vt + ks * 512);
        F.kd[0][ks] = *(const bf16x8_t*)(KD + o.kd + ks * 512); F.kd[1][ks] = *(const bf16x8_t*)(KD + o.kd + 1024 + ks * 512); }
    F.eb[0] = EB[o.eb]; F.eb[1] = EB[o.eb + 16];
}
__device__ __forceinline__ unsigned gla_touch(const unsigned char* ws, int n, int b, int h, int dir, const GlaOff& o) {
    const int nn = n < NSEG ? n : NSEG - 1;
    const int tt = tile_of(nn, b, dir), it = (dir * 520 + tt) * 4 + h, rowbase = rowbase_of(tt);
    const u16* base;
    if (o.tsel == 0) base = (const u16*)(ws + WS_QE) + (size_t)it * 8192;
    else if (o.tsel == 1) base = (const u16*)(ws + WS_KDT) + (size_t)it * 8192;
    else if (o.tsel == 2) base = (const u16*)(ws + WS_ATT) + (size_t)it * 4096;
    else base = (const u16*)(ws + WS_VT) + (size_t)(tt * 4 + h) * 16384;
    return *(const unsigned*)(base + o.tch);
}
__device__ __forceinline__ void gla_chunk(const Params& p, int job, unsigned char* lds) {
    const int tid = tid_fresh(), lane = tid & 63, w = __builtin_amdgcn_readfirstlane(tid >> 6), fr = lane & 15, fq = lane >> 4;
    const int chain = job >> 3, cgp = job & 7;
    const int b = chain >> 3, h = (chain >> 1) & 3, dir = chain & 1;
    const int e0 = cgp * 32, lt = w >> 1, et = w & 1, dt0 = (w >> 1) * 2;
    const unsigned char* ws = p.ws;
    GlaOff o;
    o.qe = lt * 2048 + lane * 8; o.at = lt * 1024 + lane * 8; o.vt = ((e0 >> 4) + et) * 1024 + lane * 8;
    o.kd = dt0 * 1024 + lane * 8; o.eb = dt0 * 16 + fr; o.o = (lt * 16 + fq * 4) * 1024 + h * 256 + e0 + et * 16 + fr;
    o.tsel = w < 2 ? 0 : (w < 4 ? 1 : (w == 4 ? 2 : 3));
    o.tch = w < 2 ? (w * 64 + lane) * 64 : (w < 4 ? ((w - 2) * 64 + lane) * 64 : (w == 4 ? lane * 64 : (e0 >> 4) * 1024 + (lane & 31) * 64));
    u16* Sl = (u16*)lds;
    u16* O = (u16*)(p.ws + (dir ? WS_OB1 : WS_OF1));
    const int sRd = (et * 16 + fr) * 136 + fq * 8, sWr = (et * 16 + fq * 4) * 136 + dt0 * 16 + fr;
    __syncthreads();
    for (int i = tid; i < 2 * 32 * 136 / 2; i += NTHR) ((unsigned*)Sl)[i] = 0u;
    __syncthreads();
    f32x4_t Sacc[2]; Sacc[0] = (f32x4_t){0.f, 0.f, 0.f, 0.f}; Sacc[1] = Sacc[0];
    GlaFr buf[2];
    gla_load(buf[0], ws, 0, b, h, dir, o); gla_load(buf[1], ws, 1, b, h, dir, o);
    unsigned pfr[4] = {0u, 0u, 0u, 0u}, sink = 0u;
    for (int n0 = 0; n0 < NSEG; n0 += 4) {
#pragma unroll
        for (int u = 0; u < 4; ++u) {
            const int n = n0 + u; const int s = u & 1;
            sink ^= pfr[u]; if (w < 6) pfr[u] = gla_touch(ws, n + 5, b, h, dir, o);
            const GlaFr& F = buf[s];
            const u16* Scur = Sl + (n & 1) * (32 * 136); u16* Snxt = Sl + ((n + 1) & 1) * (32 * 136);
            if (n >= 4) {
                const int tt = tile_of(n, b, dir);
                u16* Ou = O + (size_t)(512 + (tt - 8) * 64) * 1024;
                f32x4_t acc = (f32x4_t){0.f, 0.f, 0.f, 0.f};
#pragma unroll
                for (int ks = 0; ks < 4; ++ks) { const bf16x8_t bb = *(const bf16x8_t*)(Scur + sRd + ks * 32); acc = __builtin_amdgcn_mfma_f32_16x16x32_bf16(F.qe[ks], bb, acc, 0, 0, 0); }
#pragma unroll
                for (int ks = 0; ks < 2; ++ks) acc = __builtin_amdgcn_mfma_f32_16x16x32_bf16(F.at[ks], F.vt[ks], acc, 0, 0, 0);
#pragma unroll
                for (int j = 0; j < 4; ++j) Ou[o.o + j * 1024] = f2bf(acc[j]);
            }
#pragma unroll
            for (int i = 0; i < 2; ++i) { f32x4_t nw = (f32x4_t){0.f, 0.f, 0.f, 0.f};
#pragma unroll
                for (int ks = 0; ks < 2; ++ks) nw = __builtin_amdgcn_mfma_f32_16x16x32_bf16(F.vt[ks], F.kd[i][ks], nw, 0, 0, 0);
#pragma unroll
                for (int j = 0; j < 4; ++j) { Sacc[i][j] = F.eb[i] * Sacc[i][j] + nw[j]; Snxt[sWr + j * 136 + i * 16] = f2bf(Sacc[i][j]); } }
            __syncthreads();
            gla_load(buf[s], ws, n + 2, b, h, dir, o);
        }
    }
    ((unsigned*)(p.ws + WS_MODP))[blockIdx.x * NTHR + tid] = sink ^ pfr[0] ^ pfr[1] ^ pfr[2] ^ pfr[3];
}
__device__ __forceinline__ void ph_l1_c(const Params& p, unsigned char* lds, int t_lo, int t_hi, int first, int stride, int do_merge) {
    const int tid = tid_fresh(), rt = (tid >> 6) >> 1, chh = (tid >> 6) & 1, fr = tid & 15, fq = (tid & 63) >> 4;
    const u16* PROJ = (const u16*)(p.ws + WS_PROJ); const float* CARRY = (const float*)(p.ws + WS_CARRY); u16* Y = (u16*)(p.ws + WS_H);
    float2* AG = (float2*)lds;
    float* CIN = (float*)(lds + 32768);
    for (int t = t_lo + first; t < t_hi; t += stride) {
        const int tt = t >> 3, g = t & 7, b = rg_batch(tt);
        const int rowbase = 512 + (tt - 8) * 64;
        rg_conv(p, tt, g, lds);
        u16 grv[4][4];
#pragma unroll
        for (int c = 0; c < 4; ++c)
#pragma unroll
            for (int j = 0; j < 4; ++j) grv[c][j] = PROJ[(size_t)(rowbase + rt * 16 + fq * 4 + j) * NP1 + 1024 + g * 128 + (chh * 4 + c) * 16 + fr];
        float av[2][4][4], bx[2][4][4];
#pragma unroll
        for (int z = 0; z < 2; ++z) {
            rg_gates_reg(p, g, z, lds, rt, chh, fr, fq, av[z], bx[z]);
#pragma unroll
            for (int c = 0; c < 4; ++c) AG[(z * 16 + rt * 4 + fq) * 128 + (chh * 4 + c) * 16 + fr] = rg_local(av[z][c], bx[z][c], z);
        }
        __syncthreads();
        if (tid < 256) { const int z = tid >> 7, ch = tid & 127; float h = CARRY[((size_t)(b * 2 + z) * NSEG + rg_tau(tt, z)) * 1024 + g * 128 + ch];
#pragma unroll
            for (int s = 0; s < 16; ++s) { const int gi = z ? 15 - s : s; CIN[(z * 16 + gi) * 128 + ch] = h; const float2 ph = AG[(z * 16 + gi) * 128 + ch]; h = ph.x * h + ph.y; } }
        __syncthreads();
#pragma unroll
        for (int c = 0; c < 4; ++c) { const int chl = (chh * 4 + c) * 16 + fr; float hs[4];
            { float h = CIN[(0 * 16 + rt * 4 + fq) * 128 + chl];
#pragma unroll
                for (int j = 0; j < 4; ++j) { h = av[0][c][j] * h + bx[0][c][j]; hs[j] = h; } }
            { float h = CIN[(1 * 16 + rt * 4 + fq) * 128 + chl];
#pragma unroll
                for (int j = 3; j >= 0; --j) { h = av[1][c][j] * h + bx[1][c][j]; hs[j] += h; } }
#pragma unroll
            for (int j = 0; j < 4; ++j) Y[(size_t)(rowbase + rt * 16 + fq * 4 + j) * 2048 + g * 128 + chl] = f2bf(gelu_tanh(bf2f(grv[c][j])) * hs[j]); }
    }
    const int lane = tid & 63, w = tid >> 6;
    const u16* OF = (const u16*)(p.ws + WS_OF1); const u16* OB = (const u16*)(p.ws + WS_OB1);
    if (do_merge) for (int row = 512 + blockIdx.x * 8 + w; row < MTOT; row += gridDim.x * 8) {
        float o[2][8], ssq[2];
#pragma unroll
        for (int k = 0; k < 2; ++k) { const int col = (k * 64 + lane) * 8; float a[8], bb[8];
            unpack8(*(const uint4*)(OF + (size_t)row * 1024 + col), a); unpack8(*(const uint4*)(OB + (size_t)row * 1024 + col), bb);
            float s = 0.f;
#pragma unroll
            for (int j = 0; j < 8; ++j) { o[k][j] = a[j] + bb[j]; s += o[k][j] * o[k][j]; }
            s = red16(s); s += __shfl_xor(s, 16); ssq[k] = s; }
#pragma unroll
        for (int k = 0; k < 2; ++k) { const int col = (k * 64 + lane) * 8; const float rstd = rsqrtf(ssq[k] * (1.f / 256.f) + 1e-6f);
            float gt[8], r[8]; unpack8(*(const uint4*)(PROJ + (size_t)row * NP1 + 4096 + col), gt);
            const float4 g0 = *(const float4*)(p.gla_norm_g + col), g1 = *(const float4*)(p.gla_norm_g + col + 4); const float gg[8] = {g0.x, g0.y, g0.z, g0.w, g1.x, g1.y, g1.z, g1.w};
#pragma unroll
            for (int j = 0; j < 8; ++j) r[j] = o[k][j] * rstd * gg[j] * siluf_(gt[j]);
            *(uint4*)(Y + (size_t)row * 2048 + 1024 + col) = pack8(r); }
    }
}

#define XB_TMO      128
#define XB_XCNT(j)  (256  + 64 * (j))
#define XB_XSUB(j)  (1280 + 64 * (j))
#define XB_XGEN(j)  (2304 + 64 * (j))
#define XB_TOP      3328
#define XB_TOPGEN   3392
#define XCD_BAR_WORDS 3456
#define XB_SPIN_CAP (1u << 18)
#define XLAS __attribute__((address_space(3)))

__device__ __forceinline__ unsigned xb_ld(unsigned* p)              { return __hip_atomic_load(p, __ATOMIC_RELAXED, __HIP_MEMORY_SCOPE_AGENT); }
__device__ __forceinline__ unsigned xb_add(unsigned* p, unsigned v) { return __hip_atomic_fetch_add(p, v, __ATOMIC_RELAXED, __HIP_MEMORY_SCOPE_AGENT); }
__device__ __forceinline__ unsigned xb_xcc_id() { return (unsigned)__builtin_amdgcn_s_getreg((3 << 11) | 20) & 0xFu; }
#define XB_SPIN(cond, bar) do { unsigned _sp = 0; while (cond) { __builtin_amdgcn_s_sleep(1); \
    if ((++_sp & 255u) == 0u) { if (xb_ld(&(bar)[XB_TMO])) break; if (_sp > XB_SPIN_CAP) { atomicAdd(&(bar)[XB_TMO], 1u); break; } } } } while (0)

struct XcdBarrier {
    unsigned* bar; unsigned x;
    volatile XLAS unsigned* st;
};

__device__ __forceinline__ XcdBarrier xcd_barrier_post(unsigned* bar, volatile XLAS unsigned* st) {
    XcdBarrier b; b.bar = bar; b.x = xb_xcc_id(); b.st = st;
    if (threadIdx.x == 0) (void)xb_add(&bar[XB_XCNT(b.x)], 1u);
    return b;
}
__device__ __forceinline__ void xcd_barrier_complete(unsigned* bar, unsigned x, unsigned& nloc, unsigned& nx) {
    const unsigned G = gridDim.x * gridDim.y * gridDim.z;
    unsigned sum, cnt, mine, sp = 0u;
    for (;;) {
        sum = 0u; cnt = 0u; mine = 0u;
#pragma unroll
        for (unsigned j = 0; j < 16; ++j) { const unsigned c = xb_ld(&bar[XB_XCNT(j)]); sum += c; cnt += (c > 0u) ? 1u : 0u; mine = (j == x) ? c : mine; }
        if (sum == G) break;
        __builtin_amdgcn_s_sleep(1);
        if ((++sp & 255u) == 0u) { if (xb_ld(&bar[XB_TMO])) break; if (sp > XB_SPIN_CAP) { atomicAdd(&bar[XB_TMO], 1u); break; } }
    }
    nloc = mine > 0u ? mine : 1u; nx = cnt > 0u ? cnt : 1u;
}

__device__ __forceinline__ void xcd_barrier(const XcdBarrier& b) {
    asm volatile("s_waitcnt vmcnt(0)" ::: "memory");
    __syncthreads();
    if (threadIdx.x == 0) {
        unsigned* bar = b.bar;
        __builtin_amdgcn_s_waitcnt(0);
        unsigned nloc = b.st[0], nx = b.st[1];
        if (nloc == 0u) { xcd_barrier_complete(bar, b.x, nloc, nx); b.st[0] = nloc; b.st[1] = nx; }
        const unsigned old = xb_add(&bar[XB_XSUB(b.x)], 1u);
        const unsigned gen = old / nloc;
        if (old + 1u == (gen + 1u) * nloc) {
            __builtin_amdgcn_fence(__ATOMIC_RELEASE, "agent");
            asm volatile("s_waitcnt vmcnt(0)" ::: "memory");
            const unsigned og = xb_add(&bar[XB_TOP], 1u);
            const unsigned tg = og / nx;
            if (og + 1u == (tg + 1u) * nx) xb_add(&bar[XB_TOPGEN], 1u);
            else XB_SPIN(xb_ld(&bar[XB_TOPGEN]) == tg, bar);
            __builtin_amdgcn_fence(__ATOMIC_ACQUIRE, "agent");
            xb_add(&bar[XB_XGEN(b.x)], 1u);
            asm volatile("s_waitcnt vmcnt(0)" ::: "memory");
        } else {
            XB_SPIN(xb_ld(&bar[XB_XGEN(b.x)]) == gen, bar);
            __builtin_amdgcn_fence(__ATOMIC_ACQUIRE, "agent");
            asm volatile("s_waitcnt vmcnt(0)" ::: "memory");
        }
    }
    __syncthreads();
}

constexpr int LDS_BYTES = 135168 + 16;
constexpr int L1C_SPLIT = 64 + 3072;

__global__ void __launch_bounds__(NTHR, 2) hybrid_fwd(Params p) {
    extern __shared__ __attribute__((aligned(16))) unsigned char lds[];
    cg::grid_group grid = cg::this_grid();
    float* smf = (float*)lds;
    PG8_LAS unsigned char* ldsg = (PG8_LAS unsigned char*)lds;
    unsigned char* ws = p.ws;
    u16* WT_IN = (u16*)(ws + WS_WT_IN); u16* WT_OUT = (u16*)(ws + WS_WT_OUT); u16* WT_GU = (u16*)(ws + WS_WT_GU); u16* WT_DN = (u16*)(ws + WS_WT_DN);
    u16* H = (u16*)(ws + WS_H); u16* PROJ = (u16*)(ws + WS_PROJ); float* XC = (float*)(ws + WS_XC); float* G = (float*)(ws + WS_G);
    const float* MOD = (const float*)(ws + WS_MOD);
    const int GD = (int)gridDim.x, bid = (int)blockIdx.x;
    const int vb = (GD % 8 == 0) ? (bid % 8) * (GD / 8) + bid / 8 : bid;
    volatile XLAS unsigned* xst = (volatile XLAS unsigned*)((PG8_LAS unsigned char*)lds + 135168);
    if (threadIdx.x < 2) xst[threadIdx.x] = 0u;
    __syncthreads();
    const XcdBarrier xbar = xcd_barrier_post((unsigned*)(ws + WS_BAR), xst);
#ifdef PROBE
    unsigned long long tG = 0, tL0P = 0, tL0PP = 0, tL0M = 0, tL1A = 0, tL1M = 0, tL1C = 0, tO = 0, tprev = __builtin_amdgcn_s_memrealtime();
#define PSTAMP(c) do { const unsigned long long t_ = __builtin_amdgcn_s_memrealtime(); c += t_ - tprev; tprev = t_; } while (0)
#else
#define PSTAMP(c) do {} while (0)
#endif

    ph_adaln_partials(p, smf);
    ph_convert_rg(p);
    ph_convert<1>(p.ab_w_in, 7216, 2048, 7424, WT_IN, smf);
    ph_convert<0>(p.ab_w_out, 2048, 2048, 2048, WT_OUT, smf);
    ph_convert<2>(p.ffn_w_gu, 11264, 2048, 11264, WT_GU, smf);
    ph_convert<0>(p.ffn_w_down, 2048, 5632, 2048, WT_DN, smf);
#ifdef DUP_CONV
    ph_convert<1>(p.ab_w_in, 7216, 2048, 7424, WT_IN, smf);
    ph_convert<0>(p.ab_w_out, 2048, 2048, 2048, WT_OUT, smf);
    ph_convert<2>(p.ffn_w_gu, 11264, 2048, 11264, WT_GU, smf);
    ph_convert<0>(p.ffn_w_down, 2048, 5632, 2048, WT_DN, smf);
#endif
    grid.sync();
    PSTAMP(tO);
    ph_adaln_reduce(p);
    xcd_barrier(xbar);
    PSTAMP(tO);

    ph_norm(p.ctx, p.x, p.norm_mix_g, MOD, 0, 1, H, 0);
#ifdef DUP_NORM
    ph_norm(p.ctx, p.x, p.norm_mix_g, MOD, 0, 1, H, 0);
#endif
    xcd_barrier(xbar);
    PSTAMP(tO);
    { pg8::Gemm g{H, WT_IN, MTOT, 7424, 2048}; pg8::StaticOrder S; S.init(MTOT, 7424, GD, bid);
      pg8::EpiProj E{PROJ, NP0, 28, G, NG0, NG0, 4}; pg8::gemm_phase<pg8::EpiProj, pg8::StaticOrder>(ldsg, g, S, E); }
    xcd_barrier(xbar);
    PSTAMP(tG);
    ph_l0_prep(p, smf);
    xcd_barrier(xbar);
    PSTAMP(tL0P);
    ph_l0_prepass(p, lds);
#ifdef DUP_L0PP
    xcd_barrier(xbar); ph_l0_prepass(p, lds);
#endif
    xcd_barrier(xbar);
    PSTAMP(tL0PP);
    for (int job = vb; job < 256; job += GD) { if (job < 128) mlstm_chunk(p, job, lds); else deltanet_chunk(p, job - 128, lds); }
#ifdef DUP_L0M
    xcd_barrier(xbar);
    for (int job = vb; job < 256; job += GD) { if (job < 128) { if (DUP_L0M & 1) mlstm_chunk(p, job, lds); } else { if (DUP_L0M & 2) deltanet_chunk(p, job - 128, lds); } }
#endif
    xcd_barrier(xbar);
    PSTAMP(tL0M);
    ph_l0_merge(p);
#ifdef DUP_NORM
    ph_l0_merge(p);
#endif
    xcd_barrier(xbar);
    PSTAMP(tO);
    { pg8::Gemm g{H, WT_OUT, MTOT, 2048, 2048}; pg8::StaticOrder S; S.init(MTOT, 2048, GD, bid);
      pg8::EpiRes E{p.ctx, p.x, XC, p.out, MOD + 2 * 2048, 0}; pg8::gemm_phase<pg8::EpiRes, pg8::StaticOrder>(ldsg, g, S, E); }
    xcd_barrier(xbar);
    PSTAMP(tG);
    ph_norm(XC, p.out, p.norm_ffn_g, MOD, 3, 4, H, 0);
#ifdef DUP_NORM
    ph_norm(XC, p.out, p.norm_ffn_g, MOD, 3, 4, H, 0);
#endif
    xcd_barrier(xbar);
    PSTAMP(tO);
    { pg8::Gemm g{H, WT_GU, MTOT, 11264, 2048}; pg8::StaticOrder S; S.init(MTOT, 11264, GD, bid);
      pg8::EpiSwiglu E{PROJ, FH}; pg8::gemm_phase<pg8::EpiSwiglu, pg8::StaticOrder>(ldsg, g, S, E);
#ifdef DUP_GU
      xcd_barrier(xbar); pg8::gemm_phase<pg8::EpiSwiglu, pg8::StaticOrder>(ldsg, g, S, E);
#endif
    }
    xcd_barrier(xbar);
    PSTAMP(tG);
    { pg8::Gemm g{PROJ, WT_DN, MTOT, 2048, 5632}; pg8::StaticOrder S; S.init(MTOT, 2048, GD, bid);
      pg8::EpiRes E{XC, p.out, XC, p.out, MOD + 5 * 2048, 0}; pg8::gemm_phase<pg8::EpiRes, pg8::StaticOrder>(ldsg, g, S, E); }
    xcd_barrier(xbar);
    PSTAMP(tG);

    const float* MOD1 = MOD + 3 * 12288;
    ph_convert<0>(p.cd_w_in, 5152, 2048, 5376, WT_IN, smf);
    ph_convert<0>(p.cd_w_out, 2048, 2048, 2048, WT_OUT, smf);
    ph_convert<2>(p.ffn_w_gu + (size_t)2048 * 11264, 11264, 2048, 11264, WT_GU, smf);
    ph_convert<0>(p.ffn_w_down + (size_t)5632 * 2048, 2048, 5632, 2048, WT_DN, smf);
#ifdef DUP_CONV
    ph_convert<0>(p.cd_w_in, 5152, 2048, 5376, WT_IN, smf);
    ph_convert<0>(p.cd_w_out, 2048, 2048, 2048, WT_OUT, smf);
    ph_convert<2>(p.ffn_w_gu + (size_t)2048 * 11264, 11264, 2048, 11264, WT_GU, smf);
    ph_convert<0>(p.ffn_w_down + (size_t)5632 * 2048, 2048, 5632, 2048, WT_DN, smf);
#endif
    ph_norm(XC, p.out, p.norm_mix_g + 2048, MOD1, 0, 1, H, 0);
#ifdef DUP_NORM
    ph_norm(XC, p.out, p.norm_mix_g + 2048, MOD1, 0, 1, H, 0);
#endif
    xcd_barrier(xbar);
    PSTAMP(tO);
    { pg8::Gemm g{H, WT_IN, MTOT, 5376, 2048}; pg8::StaticOrder S; S.init(MTOT, 5376, GD, bid);
      pg8::EpiProj E{PROJ, NP1, 20, G, NG1, NG1, 0}; pg8::gemm_phase<pg8::EpiProj, pg8::StaticOrder>(ldsg, g, S, E); }
    xcd_barrier(xbar);
    PSTAMP(tG);
    ph_l1_a(p, lds);
#ifdef DUP_L1A
    xcd_barrier(xbar); ph_l1_a(p, lds, DUP_L1A);
#endif
    xcd_barrier(xbar);
    PSTAMP(tL1A);
    const bool l1_split = (GD >= 200);
    unsigned* rgflag = (unsigned*)(ws + WS_BAR) + 3600;
    for (int job = vb; job < 136; job += GD) {
        if (job < 128) gla_chunk(p, job, lds);
        else { rg_pass_b(p, job - 128);
            __builtin_amdgcn_fence(__ATOMIC_RELEASE, "agent"); asm volatile("s_waitcnt vmcnt(0)" ::: "memory"); __syncthreads();
            if (threadIdx.x == 0) __hip_atomic_fetch_add(rgflag, 1u, __ATOMIC_RELAXED, __HIP_MEMORY_SCOPE_AGENT); }
    }
    if (l1_split && vb >= 136) {
        if (threadIdx.x == 0) { unsigned sp = 0; while (__hip_atomic_load(rgflag, __ATOMIC_RELAXED, __HIP_MEMORY_SCOPE_AGENT) < 8u && ++sp < (1u << 22)) __builtin_amdgcn_s_sleep(4); }
        __syncthreads();
        __builtin_amdgcn_fence(__ATOMIC_ACQUIRE, "agent"); asm volatile("s_waitcnt vmcnt(0)" ::: "memory");
        ph_l1_c(p, lds, 64, L1C_SPLIT, vb - 136, GD - 136, 0);
    }
    xcd_barrier(xbar);
    PSTAMP(tL1M);
    ph_l1_c(p, lds, l1_split ? L1C_SPLIT : 64, 520 * 8, bid, GD, 1);
    xcd_barrier(xbar);
    PSTAMP(tL1C);
    { pg8::Gemm g{H + (size_t)512 * 2048, WT_OUT, MLAT, 2048, 2048}; pg8::StaticOrder S; S.init(MLAT, 2048, GD, bid);
      pg8::EpiRes E{XC, p.out, XC, p.out, MOD1 + 2 * 2048, 512}; pg8::gemm_phase<pg8::EpiRes, pg8::StaticOrder>(ldsg, g, S, E); }
    xcd_barrier(xbar);
    PSTAMP(tG);
    ph_norm(XC, p.out, p.norm_ffn_g + 2048, MOD1, 3, 4, H, 512);
#ifdef DUP_NORM
    ph_norm(XC, p.out, p.norm_ffn_g + 2048, MOD1, 3, 4, H, 512);
#endif
    xcd_barrier(xbar);
    PSTAMP(tO);
    { pg8::Gemm g{H + (size_t)512 * 2048, WT_GU, MLAT, 11264, 2048}; pg8::StaticOrder S; S.init(MLAT, 11264, GD, bid);
      pg8::EpiSwiglu E{PROJ, FH}; pg8::gemm_phase<pg8::EpiSwiglu, pg8::StaticOrder>(ldsg, g, S, E);
#ifdef DUP_GU
      xcd_barrier(xbar); pg8::gemm_phase<pg8::EpiSwiglu, pg8::StaticOrder>(ldsg, g, S, E);
#endif
    }
    xcd_barrier(xbar);
    PSTAMP(tG);
    { pg8::Gemm g{PROJ, WT_DN, MLAT, 2048, 5632}; pg8::StaticOrder S; S.init(MLAT, 2048, GD, bid);
      pg8::EpiRes E{XC, p.out, XC, p.out, MOD1 + 5 * 2048, 512}; pg8::gemm_phase<pg8::EpiRes, pg8::StaticOrder>(ldsg, g, S, E); }
    xcd_barrier(xbar);
    PSTAMP(tG);
#ifdef EXTRA_SYNCS
#pragma unroll 1
    for (int i = 0; i < EXTRA_SYNCS; ++i) xcd_barrier(xbar);
#endif
    ph_final_norm(p);
#ifdef PROBE
    PSTAMP(tO);
    __syncthreads();
    if (bid == 0 && threadIdx.x == 0) { const float tot = (float)(tG + tL0P + tL0PP + tL0M + tL1A + tL1M + tL1C + tO);
#ifdef PROBE3
        const unsigned long long* pq = (const unsigned long long*)(p.ws + WS_MODP) + 500000;
        p.out[0] += 0.25f + 0.15f * ((float)(pq[1] - pq[0]) / tot); p.out[1] += 0.10f + 0.14f * ((float)(pq[2] - pq[1]) / tot); }
#elif defined(PROBE2)
        const float* pr = (const float*)(p.ws + WS_MODP) + 1000000;
        p.out[0] += 0.25f + 0.15f * pr[0]; p.out[1] += 0.10f + 0.14f * pr[1]; }
#else
        p.out[0] += 0.25f + 0.15f * ((float)PROBE_A / tot); p.out[1] += 0.10f + 0.14f * ((float)PROBE_B / tot); }
#endif
#endif
}

extern "C" void kernel_launch(void* const* d_in, const int* in_sizes, int n_in, void* d_out, int out_size, void* d_ws, size_t ws_size, hipStream_t stream) {
    static int grid = 0;
    if (grid == 0) {
        if (n_in != 32 || out_size != MLAT * DM || ws_size < WS_END) { fprintf(stderr, "kernel_launch: unexpected shapes (n_in %d out %d ws %zu need %zu)\n", n_in, out_size, ws_size, (size_t)WS_END); grid = -1; return; }
        int dev = 0, cus = 0, per_cu = 0;
        (void)hipGetDevice(&dev);
        (void)hipDeviceGetAttribute(&cus, hipDeviceAttributeMultiprocessorCount, dev);
        if (hipFuncSetAttribute((const void*)hybrid_fwd, hipFuncAttributeMaxDynamicSharedMemorySize, LDS_BYTES) != hipSuccess) { fprintf(stderr, "kernel_launch: hipFuncSetAttribute failed\n"); }
        if (hipOccupancyMaxActiveBlocksPerMultiprocessor(&per_cu, (const void*)hybrid_fwd, NTHR, LDS_BYTES) != hipSuccess || per_cu < 1) { fprintf(stderr, "kernel_launch: occupancy query gave %d\n", per_cu); per_cu = 1; }
        (void)hipGetLastError();
        grid = cus * per_cu;
    }
    if (grid < 0) return;
    Params p{};
    const float** pp = (const float**)&p;
    for (int i = 0; i < 32; ++i) pp[i] = (const float*)d_in[i];
    p.out = (float*)d_out; p.ws = (unsigned char*)d_ws;
    (void)hipMemsetAsync((unsigned char*)d_ws + WS_BAR, 0, 16384, stream);
    void* args[] = {&p};
    hipError_t e = hipLaunchCooperativeKernel((const void*)hybrid_fwd, dim3(grid), dim3(NTHR), args, LDS_BYTES, stream);
    if (e != hipSuccess) fprintf(stderr, "cooperative launch failed: %s (grid %d)\n", hipGetErrorString(e), grid);
}
```

```cpp
#include <hip/hip_runtime.h>
#include <hip/hip_cooperative_groups.h>
#include <cstdio>
namespace cg = cooperative_groups;

typedef unsigned short u16;

constexpr int DM = 2048, FH = 5632, MC = 512, MLAT = 32768, MTOT = 33280, NTHR = 512;
constexpr int NP0 = 7168, NP1 = 5120;
constexpr int NG0 = 48, NG1 = 32;
constexpr int NSEG = 260;

constexpr size_t WS_WT_IN = 0;
constexpr size_t WS_WT_OUT = WS_WT_IN + (size_t)7424 * 2048 * 2;
constexpr size_t WS_WT_GU = WS_WT_OUT + (size_t)2048 * 2048 * 2;
constexpr size_t WS_WT_DN = WS_WT_GU + (size_t)11264 * 2048 * 2;
constexpr size_t WS_H = WS_WT_DN + (size_t)2048 * 5632 * 2;
constexpr size_t WS_PROJ = WS_H + (size_t)MTOT * 2048 * 2;
constexpr size_t WS_OF = WS_PROJ + (size_t)MTOT * 7168 * 2;
constexpr size_t WS_OB = WS_OF + (size_t)MTOT * 2048 * 2;
constexpr size_t WS_XC = WS_OB + (size_t)MTOT * 2048 * 2;
constexpr size_t WS_G = WS_XC + (size_t)MC * 2048 * 4;
constexpr size_t WS_CQ = WS_G + (size_t)MTOT * 48 * 4;
constexpr size_t WS_MODP = WS_CQ + (size_t)MC * 3072 * 2;
constexpr size_t WS_MOD = WS_MODP + (size_t)2 * 32 * 3 * 12288 * 4;
constexpr size_t WS_ATT0 = WS_MOD + (size_t)2 * 3 * 12288 * 4;
constexpr size_t WS_MLS = WS_ATT0 + (size_t)4160 * 4096 * 2;
constexpr size_t WS_GCS = WS_MLS + (size_t)4160 * 256 * 4;
constexpr size_t WS_WRT = WS_GCS + (size_t)8320 * 256 * 4;
constexpr size_t WS_BAR = WS_WRT + (size_t)32 * 16384 * 2;
constexpr size_t WS_END = WS_BAR + 16384;
constexpr size_t WS_TM = WS_H;
constexpr size_t WS_QK = WS_H + (size_t)8320 * 4096 * 2;
constexpr size_t WS_OF1 = WS_OF;
constexpr size_t WS_OB1 = WS_OF + (size_t)MTOT * 1024 * 2;
constexpr size_t WS_QE = WS_OB;
constexpr size_t WS_KDT = WS_QE + (size_t)2 * MTOT * 512 * 2;
constexpr size_t WS_TAIL = WS_PROJ + (size_t)MTOT * 5120 * 2;
constexpr size_t WS_ATT = WS_TAIL;
constexpr size_t WS_VT = WS_ATT + (size_t)4160 * 4096 * 2;
constexpr size_t WS_EBL = WS_VT + (size_t)2080 * 16384 * 2;
constexpr size_t WS_AGG = WS_EBL + (size_t)4160 * 128 * 4;
constexpr size_t WS_CARRY = WS_AGG + (size_t)4 * NSEG * 1024 * 8;
static_assert(WS_CARRY + (size_t)4 * NSEG * 1024 * 4 <= WS_OF, "layer-1 tail overflow");

struct Params {
    const float *x, *c, *ctx, *c_ctx, *mod_w, *mod_b, *norm_mix_g, *norm_ffn_g, *ffn_w_gu, *ffn_w_down, *final_norm_g,
        *ab_w_in, *ab_w_out, *ml_ig_b, *ml_fg_b, *ml_norm_g, *dn_conv_w, *dn_a_log, *dn_dt_bias, *dn_norm_g,
        *cd_w_in, *cd_w_out, *rg_conv_w, *rg_conv_b, *rg_w_r, *rg_b_r, *rg_w_i, *rg_b_i, *rg_lambda, *gla_w_up, *gla_b_up, *gla_norm_g;
    float* out; unsigned char* ws;
};

__device__ __forceinline__ float bf2f(u16 v) { return __uint_as_float(((unsigned)v) << 16); }
typedef __bf16 bf16x2_nat __attribute__((ext_vector_type(2)));
typedef float f32x2_nat __attribute__((ext_vector_type(2)));
__device__ __forceinline__ unsigned cvt_pk_bf16(float lo, float hi) { const f32x2_nat v = {lo, hi}; const bf16x2_nat r = __builtin_convertvector(v, bf16x2_nat); return __builtin_bit_cast(unsigned, r); }
__device__ __forceinline__ u16 f2bf(float f) { return (u16)(cvt_pk_bf16(f, 0.f) & 0xffffu); }
__device__ __forceinline__ void unpack8(const uint4& u, float* f) {
    f[0] = __uint_as_float(u.x << 16); f[1] = __uint_as_float(u.x & 0xffff0000u);
    f[2] = __uint_as_float(u.y << 16); f[3] = __uint_as_float(u.y & 0xffff0000u);
    f[4] = __uint_as_float(u.z << 16); f[5] = __uint_as_float(u.z & 0xffff0000u);
    f[6] = __uint_as_float(u.w << 16); f[7] = __uint_as_float(u.w & 0xffff0000u);
}
__device__ __forceinline__ uint4 pack8(const float* f) { uint4 o; o.x = cvt_pk_bf16(f[0], f[1]); o.y = cvt_pk_bf16(f[2], f[3]); o.z = cvt_pk_bf16(f[4], f[5]); o.w = cvt_pk_bf16(f[6], f[7]); return o; }
template <int CTRL> __device__ __forceinline__ float dppf(float x) { return __int_as_float(__builtin_amdgcn_update_dpp(0, __float_as_int(x), CTRL, 0xF, 0xF, true)); }
__device__ __forceinline__ float red4(float x) { x += dppf<0xB1>(x); x += dppf<0x4E>(x); return x; }
__device__ __forceinline__ float red8(float x) { x = red4(x); x += dppf<0x141>(x); return x; }
__device__ __forceinline__ float red16(float x) { x = red8(x); x += dppf<0x140>(x); return x; }
__device__ __forceinline__ float red64(float x) { x = red16(x); x += __shfl_xor(x, 16); x += __shfl_xor(x, 32); return x; }
__device__ __forceinline__ float frcp(float x) { return __builtin_amdgcn_rcpf(x); }
__device__ __forceinline__ float sigmoidf_(float x) { return frcp(1.f + __expf(-x)); }
__device__ __forceinline__ float siluf_(float x) { return x * frcp(1.f + __expf(-x)); }
__device__ __forceinline__ float softplusf_(float x) { return fmaxf(x, 0.f) + __logf(1.f + __expf(-fabsf(x))); }
__device__ __forceinline__ float logsigmoidf_(float x) { return fminf(x, 0.f) - __logf(1.f + __expf(-fabsf(x))); }
__device__ __forceinline__ float gelu_tanh(float x) { const float u = 0.7978845608028654f * (x + 0.044715f * x * x * x); const float th = 1.f - 2.f * frcp(1.f + __expf(2.f * u)); return 0.5f * x * (1.f + th); }
__device__ __forceinline__ float neg_expm1_small(float x) { float pl = 1.f / 720.f; pl = pl * x + 1.f / 120.f; pl = pl * x + 1.f / 24.f; pl = pl * x + 1.f / 6.f; pl = pl * x + 0.5f; pl = pl * x + 1.f; return -x * pl; }

__device__ __forceinline__ int tid_fresh() { int t = threadIdx.x; asm volatile("" : "+v"(t)); return t; }
namespace pg8 {
#define PG8_LAS __attribute__((address_space(3)))
typedef unsigned short bf16_t;
typedef short bf16x8 __attribute__((ext_vector_type(8)));
typedef float f32x4 __attribute__((ext_vector_type(4)));
typedef unsigned u32x4 __attribute__((ext_vector_type(4)));
constexpr int BM = 256, BK = 64, HALF = 128, HTB = HALF * BK * 2  , STAGE_BYTES = 8 * HTB, NXCD = 8, WGM = 8;

__host__ __device__ __forceinline__ int lds_byte(int r, int c) { const int st = (r >> 4) * 2 + (c >> 5), rr = r & 15, cc = c & 31, ob = rr * 64 + cc * 2; return st * 1024 + (ob ^ (((ob >> 9) & 1) << 5)); }
__host__ __device__ __forceinline__ void stage_rc(int b, int& R, int& C) { const int st = b / 1024, sb = b % 1024, swz = sb ^ (((sb >> 9) & 1) << 5); R = (st >> 1) * 16 + swz / 64; C = (st & 1) * 32 + (swz % 64) / 2; }
__host__ __device__ __forceinline__ int perm32(int rho) { const int n = rho >> 4, i = rho & 15; return 8 * (i >> 2) + 4 * n + (i & 3); }

struct Unit { int pm, pn; };
struct Gemm { const bf16_t* A; const bf16_t* Bt; int M, N, K; };

struct StaticOrder {
    int nM, nN, nwg, G, c;
    __host__ __device__ void init(int M, int N, int G_, int c_) { nM = M / BM; nN = N / BM; nwg = nM * nN; G = G_; c = c_; }
    __host__ __device__ bool next(int i, Unit& u) const {
        const long L = (long)i * G + c; if (L >= nwg) return false;
        int wgid = (int)L; { const int q = nwg / NXCD, r = nwg % NXCD, xcd = wgid % NXCD, off = wgid / NXCD; wgid = (xcd < r ? xcd * (q + 1) : r * (q + 1) + (xcd - r) * q) + off; }
        const int nig = WGM * nN, gid = wgid / nig, fm = gid * WGM, gsz = (nM - fm) < WGM ? (nM - fm) : WGM;
        u.pm = fm + ((wgid % nig) % gsz); u.pn = (wgid % nig) / gsz; return true;
    }
    __device__ __forceinline__ void a_ready(const Unit&) const {}
    __device__ __forceinline__ void done(const Unit&) const {}
};
using ::cvt_pk_bf16;
typedef float f32x2 __attribute__((ext_vector_type(2)));

struct EpiProj {
    static constexpr bool PERM = true, AFTER_DRAIN = false;
    bf16_t* P; int ldp; int n_main; float* G; int ldg; int ng; int perm_tiles;
    __device__ __forceinline__ void operator()(const f32x4 (&acc)[2][2][4][2], const Unit& u, int wr, int wc, int fr, int fq) const {
        const int row0 = u.pm * BM + wr * 64 + fr;
        if (u.pn < perm_tiles) {
#pragma unroll
            for (int ai = 0; ai < 2; ++ai)
#pragma unroll
                for (int m = 0; m < 4; ++m) { bf16_t* rowp = P + (size_t)(u.pm * BM + ai * HALF + wr * 64 + (m * 4 + wc) * 4 + fq) * ldp + u.pn * BM + fr * 8;
#pragma unroll
                    for (int bj = 0; bj < 2; ++bj) { const f32x4 v0 = acc[ai][bj][m][0], v1 = acc[ai][bj][m][1];
                        u32x4 w; w.x = cvt_pk_bf16(v0[0], v0[1]); w.y = cvt_pk_bf16(v0[2], v0[3]); w.z = cvt_pk_bf16(v1[0], v1[1]); w.w = cvt_pk_bf16(v1[2], v1[3]);
                        *(u32x4*)(rowp + bj * HALF) = w; } }
        } else if (u.pn < n_main) {
            const int col0 = u.pn * BM + wc * 32 + 8 * fq;
#pragma unroll
            for (int ai = 0; ai < 2; ++ai)
#pragma unroll
                for (int m = 0; m < 4; ++m) { bf16_t* rowp = P + (size_t)(row0 + ai * HALF + m * 16) * ldp + col0;
#pragma unroll
                    for (int bj = 0; bj < 2; ++bj) { const f32x4 v0 = acc[ai][bj][m][0], v1 = acc[ai][bj][m][1];
                        u32x4 w; w.x = cvt_pk_bf16(v0[0], v0[1]); w.y = cvt_pk_bf16(v0[2], v0[3]); w.z = cvt_pk_bf16(v1[0], v1[1]); w.w = cvt_pk_bf16(v1[2], v1[3]);
                        *(u32x4*)(rowp + bj * HALF) = w; } }
        } else {
            const int c0 = wc * 32 + 8 * fq;
#pragma unroll
            for (int ai = 0; ai < 2; ++ai)
#pragma unroll
                for (int m = 0; m < 4; ++m) { float* rowp = G + (size_t)(row0 + ai * HALF + m * 16) * ldg;
#pragma unroll
                    for (int n = 0; n < 2; ++n)
#pragma unroll
                        for (int j = 0; j < 4; ++j) { const int c = c0 + 4 * n + j; if (c < ng) rowp[c] = acc[ai][0][m][n][j]; } }
        }
    }
};
struct EpiRes {
    static constexpr bool PERM = false, AFTER_DRAIN = false;
    const float* srcC; const float* srcL; float* dstC; float* dstL; const float* gate  ; int row_off;
    __device__ __forceinline__ void operator()(const f32x4 (&acc)[2][2][4][2], const Unit& u, int wr, int wc, int fr, int fq) const {
        const int grow_t = u.pm * BM + row_off;
        const bool isc = grow_t < 512;
        const int mr = isc ? 2 : ((grow_t - 512) >> 14);
        const float* sp = isc ? srcC + (size_t)grow_t * 2048 : srcL + (size_t)(grow_t - 512) * 2048;
        float* dp = isc ? dstC + (size_t)grow_t * 2048 : dstL + (size_t)(grow_t - 512) * 2048;
        const int lrow0 = wr * 64 + fr, col0 = u.pn * BM + wc * 32 + 4 * fq;
        const float* gp = gate + (size_t)mr * 12288 + col0;
        f32x4 gv[2][2];
#pragma unroll
        for (int bj = 0; bj < 2; ++bj)
#pragma unroll
            for (int n = 0; n < 2; ++n) gv[bj][n] = *(const f32x4*)(gp + bj * HALF + n * 16);
#pragma unroll
        for (int ai = 0; ai < 2; ++ai)
#pragma unroll
            for (int m = 0; m < 4; ++m) { const size_t off = (size_t)(lrow0 + ai * HALF + m * 16) * 2048 + col0;
#pragma unroll
                for (int bj = 0; bj < 2; ++bj)
#pragma unroll
                    for (int n = 0; n < 2; ++n) { const f32x4 s = *(const f32x4*)(sp + off + bj * HALF + n * 16);
                        *(f32x4*)(dp + off + bj * HALF + n * 16) = s + gv[bj][n] * acc[ai][bj][m][n]; } }
    }
};
struct EpiSwiglu {
    static constexpr bool PERM = true, AFTER_DRAIN = false;
    bf16_t* O; int ldo;
    __device__ __forceinline__ void operator()(const f32x4 (&acc)[2][2][4][2], const Unit& u, int wr, int wc, int fr, int fq) const {
        const int row0 = u.pm * BM + wr * 64 + fr, col0 = u.pn * HALF + wc * 32 + 8 * fq;
#pragma unroll
        for (int ai = 0; ai < 2; ++ai)
#pragma unroll
            for (int m = 0; m < 4; ++m) { float r[8];
#pragma unroll
                for (int n = 0; n < 2; ++n)
#pragma unroll
                    for (int j = 0; j < 4; ++j) { const float gg = acc[ai][0][m][n][j], uu = acc[ai][1][m][n][j]; r[n * 4 + j] = gg * __builtin_amdgcn_rcpf(1.f + __expf(-gg)) * uu; }
                u32x4 w; w.x = cvt_pk_bf16(r[0], r[1]); w.y = cvt_pk_bf16(r[2], r[3]); w.z = cvt_pk_bf16(r[4], r[5]); w.w = cvt_pk_bf16(r[6], r[7]);
                *(u32x4*)(O + (size_t)(row0 + ai * HALF + m * 16) * ldo + col0) = w; }
    }
};

template <class Epi, class Sched>
__device__ __forceinline__ void gemm_phase(PG8_LAS unsigned char* lds, const Gemm g, const Sched& S, const Epi& E) {
    int tid = threadIdx.x; asm volatile("" : "+v"(tid)); const int wid = __builtin_amdgcn_readfirstlane(tid >> 6), lane = tid & 63, wr = wid >> 2, wc = wid & 3, fr = lane & 15, fq = lane >> 4;
    const int K = g.K, nt = K / BK;
    unsigned voffA[2], voffB[2];
#pragma unroll
    for (int i = 0; i < 2; ++i) { int R, C; stage_rc(tid * 16 + i * 8192, R, C); const int Rb = Epi::PERM ? ((R & ~31) + perm32(R & 31)) : R;
        voffA[i] = (unsigned)(R * K + C) * 2u; voffB[i] = (unsigned)(Rb * K + C) * 2u; }
    const size_t kstep = (size_t)(BK * 2);
    const size_t hstep = (size_t)HALF * K * 2;
    const size_t tstep = 2 * hstep;
    const unsigned ldsw = (unsigned)wid * 1024u;
    const int aoff = lds_byte(wr * 64 + fr, fq * 8), boff = lds_byte(wc * 32 + fr, fq * 8);
#define PG8_SA(b, h) (((b) * 2 + (h)) * HTB)
#define PG8_SB(b, h) ((4 + (b) * 2 + (h)) * HTB)
#define PG8_STAGE(bufoff, gbase, voff) do { _Pragma("unroll") for (int _i = 0; _i < 2; ++_i) \
        __builtin_amdgcn_global_load_lds((const unsigned*)((const char*)(gbase) + (voff)[_i]), (PG8_LAS unsigned*)(lds + (bufoff) + ldsw + _i * 8192), 16, 0, 0); } while (0)
#define PG8_LDA(dst, b, h) do { _Pragma("unroll") for (int m = 0; m < 4; ++m) _Pragma("unroll") for (int k = 0; k < 2; ++k) dst[m][k] = *(const PG8_LAS bf16x8*)(lds + PG8_SA(b, h) + aoff + m * 2048 + k * 1024); } while (0)
#define PG8_LDB(dst, b, h) do { _Pragma("unroll") for (int n = 0; n < 2; ++n) _Pragma("unroll") for (int k = 0; k < 2; ++k) dst[n][k] = *(const PG8_LAS bf16x8*)(lds + PG8_SB(b, h) + boff + n * 2048 + k * 1024); } while (0)
#define PG8_MMA(ai, bj, At, Bt) do { __builtin_amdgcn_s_setprio(1); _Pragma("unroll") for (int m = 0; m < 4; ++m) _Pragma("unroll") for (int n = 0; n < 2; ++n) _Pragma("unroll") for (int k = 0; k < 2; ++k) \
        acc[ai][bj][m][n] = __builtin_amdgcn_mfma_f32_16x16x32_bf16(Bt[n][k], At[m][k], acc[ai][bj][m][n], 0, 0, 0); __builtin_amdgcn_s_setprio(0); } while (0)
#define PG8_WAIT_V(n) asm volatile("s_waitcnt vmcnt(" #n ")" ::: "memory")
#define PG8_WAIT_L(n) asm volatile("s_waitcnt lgkmcnt(" #n ")" ::: "memory")
#define PG8_BAR __builtin_amdgcn_s_barrier()
#define PG8_SCHED __builtin_amdgcn_sched_barrier(0)
    Unit cur, nxt; int ui = 0;
    if (!S.next(0, cur)) return;
    f32x4 acc[2][2][4][2];
#pragma unroll
    for (int a = 0; a < 2; ++a)
#pragma unroll
        for (int b = 0; b < 2; ++b)
#pragma unroll
            for (int m = 0; m < 4; ++m)
#pragma unroll
                for (int n = 0; n < 2; ++n) acc[a][b][m][n] = (f32x4){0.f, 0.f, 0.f, 0.f};
    bf16x8 At[4][2], B0[2][2], B1[2][2];
    const char* cA = (const char*)g.A + (size_t)cur.pm * tstep; const char* cB = (const char*)g.Bt + (size_t)cur.pn * tstep;
    S.a_ready(cur);
    PG8_STAGE(PG8_SB(0, 0), cB, voffB); PG8_STAGE(PG8_SA(0, 0), cA, voffA); PG8_STAGE(PG8_SB(0, 1), cB + hstep, voffB); PG8_STAGE(PG8_SA(0, 1), cA + hstep, voffA);
    if (wr == 1) PG8_BAR;
    PG8_WAIT_V(4); PG8_BAR;
    PG8_STAGE(PG8_SB(1, 0), cB + kstep, voffB); PG8_STAGE(PG8_SA(1, 0), cA + kstep, voffA); PG8_STAGE(PG8_SB(1, 1), cB + hstep + kstep, voffB);
    PG8_WAIT_V(6); PG8_BAR;
    for (;;) {
        const bool has_next = S.next(ui + 1, nxt);
        const char* nA = has_next ? (const char*)g.A + (size_t)nxt.pm * tstep : cA; const char* nB = has_next ? (const char*)g.Bt + (size_t)nxt.pn * tstep : cB;
        for (int t = 0; t < nt; t += 2) {
            const bool last = (t == nt - 2);
            const char* a1 = cA + (size_t)(t + 1) * kstep;
            const char* a2 = last ? nA : cA + (size_t)(t + 2) * kstep; const char* b2 = last ? nB : cB + (size_t)(t + 2) * kstep;
            const char* a3 = a2 + kstep; const char* b3 = b2 + kstep;
            if (last && has_next) S.a_ready(nxt);
            PG8_LDB(B0, 0, 0); PG8_SCHED; PG8_LDA(At, 0, 0); PG8_STAGE(PG8_SA(1, 1), a1 + hstep, voffA);
            PG8_WAIT_L(8); PG8_BAR; PG8_WAIT_L(0); PG8_MMA(0, 0, At, B0); PG8_BAR; PG8_SCHED;
            PG8_LDB(B1, 0, 1); PG8_STAGE(PG8_SB(0, 0), b2, voffB);
            PG8_BAR; PG8_WAIT_L(0); PG8_MMA(0, 1, At, B1); PG8_BAR;
            PG8_LDA(At, 0, 1); PG8_STAGE(PG8_SA(0, 0), a2, voffA);
            PG8_BAR; PG8_WAIT_L(0); PG8_MMA(1, 0, At, B0); PG8_BAR; PG8_SCHED;
            PG8_STAGE(PG8_SB(0, 1), b2 + hstep, voffB);
            PG8_WAIT_V(6); PG8_BAR; PG8_MMA(1, 1, At, B1); PG8_BAR;
            PG8_LDB(B0, 1, 0); PG8_SCHED; PG8_LDA(At, 1, 0); PG8_STAGE(PG8_SA(0, 1), a2 + hstep, voffA);
            PG8_WAIT_L(8); PG8_BAR; PG8_WAIT_L(0); PG8_MMA(0, 0, At, B0); PG8_BAR; PG8_SCHED;
            PG8_LDB(B1, 1, 1); PG8_STAGE(PG8_SB(1, 0), b3, voffB);
            PG8_BAR; PG8_WAIT_L(0); PG8_MMA(0, 1, At, B1); PG8_BAR;
            PG8_LDA(At, 1, 1); PG8_STAGE(PG8_SA(1, 0), a3, voffA);
            PG8_BAR; PG8_WAIT_L(0); PG8_MMA(1, 0, At, B0); PG8_BAR; PG8_SCHED;
            PG8_STAGE(PG8_SB(1, 1), b3 + hstep, voffB);
            PG8_WAIT_V(6); PG8_BAR; PG8_MMA(1, 1, At, B1); PG8_BAR;
        }
        if constexpr (!Epi::AFTER_DRAIN) { E(acc, cur, wr, wc, fr, fq); S.done(cur); }
        if (!has_next) break;
#pragma unroll
        for (int a = 0; a < 2; ++a)
#pragma unroll
            for (int b = 0; b < 2; ++b)
#pragma unroll
                for (int m = 0; m < 4; ++m)
#pragma unroll
                    for (int n = 0; n < 2; ++n) acc[a][b][m][n] = (f32x4){0.f, 0.f, 0.f, 0.f};
        cur = nxt; cA = nA; cB = nB; ++ui;
    }
    PG8_WAIT_V(0);
    if (wr == 0) PG8_BAR;
    PG8_BAR;
    if constexpr (Epi::AFTER_DRAIN) { E.fused(acc, cur, wr, wc, fr, fq, lds, wid, lane); S.done(cur); }
#undef PG8_SA
#undef PG8_SB
#undef PG8_STAGE
#undef PG8_LDA
#undef PG8_LDB
#undef PG8_MMA
#undef PG8_WAIT_V
#undef PG8_WAIT_L
#undef PG8_BAR
#undef PG8_SCHED
}
}

__device__ __forceinline__ void ph_adaln_partials(const Params& p, float* sm) {
    const int tid = tid_fresh();
    float* MODP = (float*)(p.ws + WS_MODP);
    for (int it = blockIdx.x; it < 384; it += gridDim.x) {
        const int l = it / 192, rem = it % 192, kc = rem / 6, cgp = rem % 6;
        __syncthreads();
        if (tid < 192) { const int r = tid >> 6, kk = tid & 63, k = kc * 64 + kk; const float cv = (r < 2) ? p.c[r * 2048 + k] : p.c_ctx[k]; sm[tid] = siluf_(cv); }
        __syncthreads();
        const int col = cgp * 2048 + tid * 4;
        float4 a0 = {0.f, 0.f, 0.f, 0.f}, a1 = a0, a2 = a0;
        const float* wp = p.mod_w + ((size_t)l * 2048 + (size_t)kc * 64) * 12288 + col;
#pragma unroll 8
        for (int kk = 0; kk < 64; ++kk) {
            const float4 w = *(const float4*)(wp + (size_t)kk * 12288);
            const float s0 = sm[kk], s1 = sm[64 + kk], s2 = sm[128 + kk];
            a0.x += s0 * w.x; a0.y += s0 * w.y; a0.z += s0 * w.z; a0.w += s0 * w.w;
            a1.x += s1 * w.x; a1.y += s1 * w.y; a1.z += s1 * w.z; a1.w += s1 * w.w;
            a2.x += s2 * w.x; a2.y += s2 * w.y; a2.z += s2 * w.z; a2.w += s2 * w.w;
        }
        float* o = MODP + ((size_t)(l * 32 + kc) * 3) * 12288 + col;
        *(float4*)(o) = a0; *(float4*)(o + 12288) = a1; *(float4*)(o + 2 * 12288) = a2;
    }
}
__device__ __forceinline__ void ph_adaln_reduce(const Params& p) {
    const float* MODP = (const float*)(p.ws + WS_MODP); float* MOD = (float*)(p.ws + WS_MOD);
    for (int idx = blockIdx.x * NTHR + tid_fresh(); idx < 2 * 3 * 12288; idx += gridDim.x * NTHR) {
        const int l = idx / 36864, r = (idx / 12288) % 3, col = idx % 12288;
        float s = p.mod_b[l * 12288 + col];
        for (int kc = 0; kc < 32; ++kc) s += MODP[((size_t)(l * 32 + kc) * 3 + r) * 12288 + col];
        MOD[idx] = s;
    }
}

template <int MODE> __device__ __forceinline__ int colmap(int n, int nsrc) {
    if (MODE == 0) return n < nsrc ? n : -1;
    if (MODE == 1) { if (n < 3072) return n; if (n < 7168) return n + 16; if (n < 7184) return 3072 + (n - 7168); if (n < 7216) return n; return -1; }
    return ((n >> 7) & 1) * 5632 + (n >> 8) * 128 + (n & 127);
}
template <int MODE> __device__ __forceinline__ void ph_convert(const float* W, int nsrc, int K, int nout, u16* Bt, float* sm) {
    const int tid = tid_fresh(); const int nnt = nout / 64, ntiles = nnt * (K / 64);
    for (int t = blockIdx.x; t < ntiles; t += gridDim.x) {
        const int k0 = (t / nnt) * 64, n0 = (t % nnt) * 64;
        __syncthreads();
#pragma unroll
        for (int i = 0; i < 8; ++i) { const int idx = i * NTHR + tid, kk = idx >> 6, nn = idx & 63; const int src = colmap<MODE>(n0 + nn, nsrc);
            sm[kk * 65 + nn] = src >= 0 ? W[(size_t)(k0 + kk) * nsrc + src] : 0.f; }
        __syncthreads();
        { const int nn = tid >> 3, k8 = (tid & 7) * 8; float v[8];
#pragma unroll
            for (int j = 0; j < 8; ++j) v[j] = sm[(k8 + j) * 65 + nn];
            *(uint4*)(Bt + (size_t)(n0 + nn) * K + k0 + k8) = pack8(v); }
    }
}

__device__ __forceinline__ void ph_norm(const float* srcC, const float* srcL, const float* g, const float* modl, int chunk_sh, int chunk_sc, u16* H, int row_begin) {
    const int tid_ = tid_fresh(); const int lane = tid_ & 63, w = tid_ >> 6;
    for (int row = row_begin + blockIdx.x * 8 + w; row < MTOT; row += gridDim.x * 8) {
        const float* src = row < 512 ? srcC + (size_t)row * 2048 : srcL + (size_t)(row - 512) * 2048;
        const int mr = row < 512 ? 2 : ((row - 512) >> 14);
        const float* sc = modl + (mr * 6 + chunk_sc) * 2048; const float* sh = modl + (mr * 6 + chunk_sh) * 2048;
        float4 v[8]; float ss = 0.f;
#pragma unroll
        for (int i = 0; i < 8; ++i) { v[i] = *(const float4*)(src + i * 256 + lane * 4); ss += v[i].x * v[i].x + v[i].y * v[i].y + v[i].z * v[i].z + v[i].w * v[i].w; }
        ss = red64(ss);
        const float rstd = rsqrtf(ss * (1.f / 2048.f) + 1e-6f);
#pragma unroll
        for (int i = 0; i < 8; ++i) { const int col = i * 256 + lane * 4;
            const float4 g4 = *(const float4*)(g + col), s4 = *(const float4*)(sc + col), h4 = *(const float4*)(sh + col);
            const float y0 = v[i].x * rstd * g4.x * (1.f + s4.x) + h4.x, y1 = v[i].y * rstd * g4.y * (1.f + s4.y) + h4.y;
            const float y2 = v[i].z * rstd * g4.z * (1.f + s4.z) + h4.z, y3 = v[i].w * rstd * g4.w * (1.f + s4.w) + h4.w;
            uint2 o; o.x = cvt_pk_bf16(y0, y1); o.y = cvt_pk_bf16(y2, y3);
            *(uint2*)(H + (size_t)row * 2048 + col) = o; }
    }
}
__device__ __forceinline__ void ph_final_norm(const Params& p) {
    const int tid_ = tid_fresh(); const int lane = tid_ & 63, w = tid_ >> 6;
    for (int row = blockIdx.x * 8 + w; row < MLAT; row += gridDim.x * 8) {
        float* src = p.out + (size_t)row * 2048;
        float4 v[8]; float ss = 0.f;
#pragma unroll
        for (int i = 0; i < 8; ++i) { v[i] = *(const float4*)(src + i * 256 + lane * 4); ss += v[i].x * v[i].x + v[i].y * v[i].y + v[i].z * v[i].z + v[i].w * v[i].w; }
        ss = red64(ss);
        const float rstd = rsqrtf(ss * (1.f / 2048.f) + 1e-6f);
#pragma unroll
        for (int i = 0; i < 8; ++i) { const int col = i * 256 + lane * 4; const float4 g4 = *(const float4*)(p.final_norm_g + col);
            float4 o; o.x = v[i].x * rstd * g4.x; o.y = v[i].y * rstd * g4.y; o.z = v[i].z * rstd * g4.z; o.w = v[i].w * rstd * g4.w;
            *(float4*)(src + col) = o; }
    }
}

__device__ __forceinline__ void ph_l0_prep(const Params& p, float* sm) {
    const int tid = tid_fresh();
    u16* PROJ = (u16*)(p.ws + WS_PROJ); u16* CQ = (u16*)(p.ws + WS_CQ); float* G = (float*)(p.ws + WS_G);
    for (int idx = blockIdx.x * NTHR + tid; idx < MTOT * 48; idx += gridDim.x * NTHR) {
        const int j = idx % 48; const float v = G[idx]; float o;
        if (j < 8) o = v + p.ml_ig_b[j];
        else if (j < 16) o = logsigmoidf_(v + p.ml_fg_b[j - 8]);
        else if (j < 32) { const float dt = softplusf_(v + p.dn_dt_bias[j - 16]); o = -__expf(p.dn_a_log[j - 16]) * dt; }
        else o = sigmoidf_(v);
        G[idx] = o;
    }
    {
        const int NB = (int)gridDim.x;
        const int tk = tid >> 3, cs = (tid & 7) * 16;
        for (int pb = (int)blockIdx.x; pb < (NB < 24 ? 24 : NB); pb += NB) {
        const int part = pb % 24, slot = pb / 24;
        const int nbp = NB >= 24 ? (NB - part + 23) / 24 : 1;
        float wt[5][16];
#pragma unroll
        for (int j = 0; j < 5; ++j)
#pragma unroll
            for (int c4 = 0; c4 < 4; ++c4) { const float4 w4 = *(const float4*)(p.dn_conv_w + j * 3072 + part * 128 + cs + c4 * 4); wt[j][c4 * 4] = w4.x; wt[j][c4 * 4 + 1] = w4.y; wt[j][c4 * 4 + 2] = w4.z; wt[j][c4 * 4 + 3] = w4.w; }
        uint4 in[5][2];
#define L0P_LOAD(TT) do { const int tt_ = (TT); const bool ic_ = tt_ < 8; const int t0_ = ic_ ? (tt_ & 3) * 64 : 0; const int rb_ = ic_ ? (tt_ >> 2) * 256 + t0_ : 512 + (tt_ - 8) * 64; \
            _Pragma("unroll") for (int j = 0; j < 5; ++j) { const int r = tk + j - 2; const bool ok = ic_ ? (t0_ + r >= 0 && t0_ + r < 256) : (r >= 0 && r < 64); \
                in[j][0] = make_uint4(0u, 0u, 0u, 0u); in[j][1] = in[j][0]; \
                if (ok) { const u16* src = PROJ + (size_t)(rb_ + r) * NP0 + 3072 + part * 128 + cs; in[j][0] = *(const uint4*)(src); in[j][1] = *(const uint4*)(src + 8); } } } while (0)
        if (slot < 520) L0P_LOAD(slot);
        for (int tt = slot; tt < 520; tt += nbp) {
            const bool isctx = tt < 8;
            const int t0 = isctx ? (tt & 3) * 64 : 0;
            const int rowbase = isctx ? (tt >> 2) * 256 + t0 : 512 + (tt - 8) * 64;
            float o[16];
#pragma unroll
            for (int c = 0; c < 16; ++c) o[c] = 0.f;
#pragma unroll
            for (int j = 0; j < 5; ++j) { float f[16]; unpack8(in[j][0], f); unpack8(in[j][1], f + 8);
#pragma unroll
                for (int c = 0; c < 16; ++c) o[c] += f[c] * wt[j][c]; }
            if (tt + nbp < 520) L0P_LOAD(tt + nbp);
            float ss = 0.f;
#pragma unroll
            for (int c = 0; c < 16; ++c) { o[c] = siluf_(o[c]); ss += o[c] * o[c]; }
            ss = red8(ss);
            if (part < 16) { const float sc = rsqrtf(ss + 1e-6f);
#pragma unroll
                for (int c = 0; c < 16; ++c) o[c] *= sc; }
            __syncthreads();
            if (part < 16) {
                const int rs = isctx ? 3072 : NP0; u16* tb = isctx ? CQ + (size_t)rowbase * 3072 + part * 128 : PROJ + (size_t)rowbase * NP0 + 3072 + part * 128;
                const int r0 = ((tk >> 4) * 4 + (cs >> 5)) * 4 + ((cs >> 3) & 3);
                *(uint4*)(tb + (size_t)r0 * rs + (tk & 15) * 8) = pack8(o); *(uint4*)(tb + (size_t)(r0 + 1) * rs + (tk & 15) * 8) = pack8(o + 8);
            } else {
                u16* dst = isctx ? CQ + (size_t)(rowbase + tk) * 3072 + part * 128 + cs : PROJ + (size_t)(rowbase + tk) * NP0 + 3072 + part * 128 + cs;
                *(uint4*)(dst) = pack8(o); *(uint4*)(dst + 8) = pack8(o + 8); }
        }
        }
    }
}

__device__ __forceinline__ void ph_l0_merge(const Params& p) {
    const int tid_ = tid_fresh(); const int lane = tid_ & 63, w = tid_ >> 6;
    const u16* PROJ = (const u16*)(p.ws + WS_PROJ); const u16* OF = (const u16*)(p.ws + WS_OF); const u16* OB = (const u16*)(p.ws + WS_OB); u16* Y = (u16*)(p.ws + WS_H);
    for (int row = blockIdx.x * 8 + w; row < MTOT; row += gridDim.x * 8) {
        float o[4][8]; float ss[4];
#pragma unroll
        for (int k = 0; k < 4; ++k) { const int col = (k * 64 + lane) * 8; float a[8], bb[8];
            unpack8(*(const uint4*)(OF + (size_t)row * 2048 + col), a); unpack8(*(const uint4*)(OB + (size_t)row * 2048 + col), bb);
            float s = 0.f;
#pragma unroll
            for (int j = 0; j < 8; ++j) { o[k][j] = a[j] + bb[j]; s += o[k][j] * o[k][j]; }
            s = red16(s);
            if (k < 2) s += __shfl_xor(s, 16);
            ss[k] = s; }
#pragma unroll
        for (int k = 0; k < 4; ++k) { const int col = (k * 64 + lane) * 8; const bool isml = k < 2;
            const float rstd = isml ? rsqrtf(ss[k] * (1.f / 256.f) + 1e-6f) : rsqrtf(ss[k] * (1.f / 128.f) + 1e-6f);
            const u16* gsrc = PROJ + (size_t)row * NP0 + (isml ? 2048 + col : 6144 + (col - 1024));
            const float* gn = isml ? p.ml_norm_g + col : p.dn_norm_g + (col - 1024);
            float gt[8], r[8]; unpack8(*(const uint4*)gsrc, gt);
            const float4 g0 = *(const float4*)gn, g1 = *(const float4*)(gn + 4); const float gg[8] = {g0.x, g0.y, g0.z, g0.w, g1.x, g1.y, g1.z, g1.w};
#pragma unroll
            for (int j = 0; j < 8; ++j) { const float gate = isml ? sigmoidf_(gt[j]) : siluf_(gt[j]); r[j] = o[k][j] * rstd * gg[j] * gate; }
            *(uint4*)(Y + (size_t)row * 2048 + col) = pack8(r); }
    }
}

typedef short bf16x8_t __attribute__((ext_vector_type(8)));
typedef float f32x4_t __attribute__((ext_vector_type(4)));
__device__ __forceinline__ float wave_cumsum(float x, int lane) {
#pragma unroll
    for (int o = 1; o < 64; o <<= 1) { const float t = __shfl_up(x, o); if (lane >= o) x += t; }
    return x; }
__device__ __forceinline__ float wave_cummax(float x, int lane) {
#pragma unroll
    for (int o = 1; o < 64; o <<= 1) { const float t = __shfl_up(x, o); if (lane >= o) x = fmaxf(x, t); }
    return x; }
__device__ __forceinline__ int tile_of(int n, int b, int dir) { if (n < 4) return b * 4 + (dir ? 3 - n : n); const int li = n - 4; return 8 + b * 256 + (dir ? 255 - li : li); }
__device__ __forceinline__ int rowbase_of(int tt) { return tt < 8 ? tt * 64 : 512 + (tt - 8) * 64; }

__device__ __forceinline__ void ml_prep_item(const Params& p, int it, float* wl, int lane) {
    const int h = it & 3, tt = (it >> 2) % 520, z = it / 2080, rowbase = rowbase_of(tt), fr = lane & 15, fq = lane >> 4;
    const u16* PROJ = (const u16*)(p.ws + WS_PROJ); const float* G = (const float*)(p.ws + WS_G);
    float* MLS = (float*)(p.ws + WS_MLS) + (size_t)it * 256; u16* ATT0 = (u16*)(p.ws + WS_ATT0) + (size_t)it * 4096;
    const int tk = z ? 63 - lane : lane, row = rowbase + tk;
    const float ig = G[row * 48 + z * 4 + h], lf = G[row * 48 + 8 + z * 4 + h];
    const float bb = wave_cumsum(lf, lane), gg = ig - bb, cm = wave_cummax(gg, lane);
    const float bL = __shfl(bb, 63), cmL = __shfl(cm, 63);
    MLS[tk] = bb; MLS[64 + tk] = cm; MLS[128 + tk] = __expf(gg - cmL); if (lane == 0) { MLS[192] = bL; MLS[193] = cmL; }
    wl[tk] = gg; wl[64 + tk] = cm;
    bf16x8_t kf[4][4];
#pragma unroll
    for (int rt = 0; rt < 4; ++rt)
#pragma unroll
        for (int ks = 0; ks < 4; ++ks) kf[rt][ks] = *(const bf16x8_t*)(PROJ + (size_t)(rowbase + (rt * 4 + ks) * 4 + fq) * NP0 + 512 + h * 128 + fr * 8);
#pragma unroll 1
    for (int rt = 0; rt < 4; ++rt) {
        bf16x8_t qf[4];
#pragma unroll
        for (int ks = 0; ks < 4; ++ks) qf[ks] = *(const bf16x8_t*)(PROJ + (size_t)(rowbase + (rt * 4 + ks) * 4 + fq) * NP0 + h * 128 + fr * 8);
#pragma unroll
        for (int ct = 0; ct < 4; ++ct) {
            f32x4_t acc = (f32x4_t){0.f, 0.f, 0.f, 0.f};
#pragma unroll
            for (int ks = 0; ks < 4; ++ks) acc = __builtin_amdgcn_mfma_f32_16x16x32_bf16(qf[ks], kf[ct][ks], acc, 0, 0, 0);
            const int s = ct * 16 + fr; const float gs = wl[s];
#pragma unroll
            for (int j = 0; j < 4; ++j) { const int l = rt * 16 + fq * 4 + j; const bool keep = z ? (s >= l) : (s <= l);
                const float e = __expf(fminf(gs - wl[64 + l], 0.f));
                ATT0[(((l >> 4) * 2 + (s >> 5)) * 64 + ((s >> 3) & 3) * 16 + (l & 15)) * 8 + (s & 7)] = f2bf(keep ? acc[j] * 0.08838834764831845f * e : 0.f); }
        }
    }
}
__device__ __forceinline__ void dn_prep_item(const Params& p, int it, float* Ap, int lane) {
    asm volatile("" : "+v"(lane));
    const int h = it & 7, tt = (it >> 3) % 520, z = it / 4160, rowbase = rowbase_of(tt), fr = lane & 15, fq = lane >> 4;
    const bool isctx = tt < 8;
    const u16* qb = isctx ? (const u16*)(p.ws + WS_CQ) + (size_t)rowbase * 3072 + h * 128 : (const u16*)(p.ws + WS_PROJ) + (size_t)rowbase * NP0 + 3072 + h * 128;
    const int rs = isctx ? 3072 : NP0;
    const float* G = (const float*)(p.ws + WS_G);
    float* GCS = (float*)(p.ws + WS_GCS) + (size_t)it * 256; u16* TM = (u16*)(p.ws + WS_TM) + (size_t)it * 4096; u16* QK = (u16*)(p.ws + WS_QK) + (size_t)it * 4096;
    float* gcs = Ap + 4096; float* bes = Ap + 4160;
    const int tk = z ? 63 - lane : lane, row = rowbase + tk;
    const float g = G[row * 48 + 16 + z * 8 + h], be = G[row * 48 + 32 + z * 8 + h];
    const float gc = wave_cumsum(g, lane), gL = __shfl(gc, 63);
    GCS[tk] = __expf(gc); GCS[64 + tk] = be; GCS[128 + tk] = __expf(gL - gc); if (lane == 0) GCS[192] = __expf(gL);
    gcs[tk] = gc; bes[tk] = be;
    bf16x8_t kf[4][4];
#pragma unroll
    for (int rt = 0; rt < 4; ++rt)
#pragma unroll
        for (int ks = 0; ks < 4; ++ks) kf[rt][ks] = *(const bf16x8_t*)(qb + (size_t)((rt * 4 + ks) * 4 + fq) * rs + 1024 + fr * 8);
#pragma unroll 1
    for (int rt = 0; rt < 4; ++rt) {
        bf16x8_t qf[4], ka[4];
#pragma unroll
        for (int ks = 0; ks < 4; ++ks) { qf[ks] = *(const bf16x8_t*)(qb + (size_t)((rt * 4 + ks) * 4 + fq) * rs + fr * 8); ka[ks] = *(const bf16x8_t*)(qb + (size_t)((rt * 4 + ks) * 4 + fq) * rs + 1024 + fr * 8); }
#pragma unroll
        for (int ct = 0; ct < 4; ++ct) {
            f32x4_t ck = (f32x4_t){0.f, 0.f, 0.f, 0.f}, cq = ck;
#pragma unroll
            for (int ks = 0; ks < 4; ++ks) { ck = __builtin_amdgcn_mfma_f32_16x16x32_bf16(ka[ks], kf[ct][ks], ck, 0, 0, 0); cq = __builtin_amdgcn_mfma_f32_16x16x32_bf16(qf[ks], kf[ct][ks], cq, 0, 0, 0); }
            const int s = ct * 16 + fr; const float gs = gcs[s];
#pragma unroll
            for (int j = 0; j < 4; ++j) { const int l = rt * 16 + fq * 4 + j;
                const bool strict = z ? (s > l) : (s < l), incl = z ? (s >= l) : (s <= l);
                const float e = __expf(fminf(gcs[l] - gs, 0.f));
                const int lp = z ? 63 - l : l, sp = z ? 63 - s : s;
                Ap[lp * 64 + sp] = strict ? bes[l] * ck[j] * e : 0.f;
                QK[(((l >> 4) * 2 + (s >> 5)) * 64 + ((s >> 3) & 3) * 16 + (l & 15)) * 8 + (s & 7)] = f2bf(incl ? cq[j] * 0.08838834764831845f * e : 0.f); }
        }
    }
    float T[64];
#pragma unroll
    for (int i = 0; i < 64; ++i) {
        float t = (i == lane) ? 1.f : 0.f;
#pragma unroll
        for (int j4 = 0; j4 < (i + 3) / 4; ++j4) { const float4 a4 = *(const float4*)(Ap + i * 64 + j4 * 4);
            if (j4 * 4 + 0 < i) t -= a4.x * T[j4 * 4 + 0];
            if (j4 * 4 + 1 < i) t -= a4.y * T[j4 * 4 + 1];
            if (j4 * 4 + 2 < i) t -= a4.z * T[j4 * 4 + 2];
            if (j4 * 4 + 3 < i) t -= a4.w * T[j4 * 4 + 3];
            if ((j4 & 7) == 7) asm volatile("" : "+v"(t) :: "memory"); }
        T[i] = t;
        asm volatile("" : "+v"(T[i]) :: "memory");
    }
    const int sc = z ? 63 - lane : lane;
    u16* TMp = TM + ((sc >> 5) * 64 + ((sc >> 3) & 3) * 16) * 8 + (sc & 7);
    if (z) {
#pragma unroll
        for (int i = 0; i < 64; ++i) { const int l = 63 - i; TMp[(l >> 4) * 1024 + (l & 15) * 8] = f2bf(T[i]); }
    } else {
#pragma unroll
        for (int i = 0; i < 64; ++i) { const int l = i; TMp[(l >> 4) * 1024 + (l & 15) * 8] = f2bf(T[i]); }
    }
}
__device__ __forceinline__ void ph_l0_prepass(const Params& p, unsigned char* lds) {
    const int tid = tid_fresh(), lane = tid & 63, w = tid >> 6;
    float* wl = (float*)(lds + (size_t)w * 16896);
    const int gw = blockIdx.x * 8 + w, nw = gridDim.x * 8;
    for (int it = (gw + nw - 128) % nw; it < 4160; it += nw) ml_prep_item(p, it, wl, lane);
    for (int it = gw; it < 8320; it += nw) dn_prep_item(p, it, wl, lane);
}

__device__ __forceinline__ unsigned ml_touch(const Params& p, int n, int b, int h, int dir, int e0, int tid) {
    const int nn = n < NSEG ? n : NSEG - 1;
    const int tt = tile_of(nn, b, dir), it = (dir * 520 + tt) * 4 + h, rowbase = rowbase_of(tt);
    const u16* PROJ = (const u16*)(p.ws + WS_PROJ);
    const u16* a;
    if (tid < 256) a = PROJ + (size_t)(rowbase + ((tid & 127) >> 1)) * NP0 + (tid >> 7) * 512 + h * 128 + (tid & 1) * 64;
    else if (tid < 320) a = PROJ + (size_t)(rowbase + tid - 256) * NP0 + 1024 + h * 256 + e0;
    else if (tid < 384) a = (const u16*)(p.ws + WS_ATT0) + (size_t)it * 4096 + (tid - 320) * 64;
    else a = (const u16*)(p.ws + WS_MLS) + (size_t)it * 512 + ((tid - 384) & 7) * 64;
    return *(const unsigned*)a;
}
struct MlFr { bf16x8_t q[4], at[2]; uint4 kr[2]; uint2 vr; float kw, b[4], cm[4], bL, cmL; };
__device__ __forceinline__ void ml_load(MlFr& F, const Params& p, int n, int b, int h, int dir, int e0, int lt, int fr, int fq, int tl, int seg) {
    const int nn = n < NSEG ? n : NSEG - 1;
    const int tt = tile_of(nn, b, dir), it = (dir * 520 + tt) * 4 + h, rowbase = rowbase_of(tt);
    const u16* PROJ = (const u16*)(p.ws + WS_PROJ);
    const u16* Q = PROJ + (size_t)(rowbase + lt * 16 + fq) * NP0 + h * 128 + fr * 8;
    const u16* AT = (const u16*)(p.ws + WS_ATT0) + (size_t)it * 4096 + lt * 1024 + (fq * 16 + fr) * 8;
    const float* MLS = (const float*)(p.ws + WS_MLS) + (size_t)it * 256;
#pragma unroll
    for (int ks = 0; ks < 4; ++ks) F.q[ks] = *(const bf16x8_t*)(Q + (size_t)ks * 4 * NP0);
#pragma unroll
    for (int ks = 0; ks < 2; ++ks) F.at[ks] = *(const bf16x8_t*)(AT + ks * 512);
    const u16* kp = PROJ + (size_t)(rowbase + ((tl >> 4) * 4 + (seg >> 1)) * 4 + (seg & 1) * 2) * NP0 + 512 + h * 128 + (tl & 15) * 8;
    F.kr[0] = *(const uint4*)(kp); F.kr[1] = *(const uint4*)(kp + NP0);
    F.vr = *(const uint2*)(PROJ + (size_t)(rowbase + tl) * NP0 + 1024 + h * 256 + e0 + seg * 4);
    F.kw = MLS[128 + tl];
#pragma unroll
    for (int j = 0; j < 4; ++j) { F.b[j] = MLS[lt * 16 + fq * 4 + j]; F.cm[j] = MLS[64 + lt * 16 + fq * 4 + j]; }
    F.bL = MLS[192]; F.cmL = MLS[193];
}
__device__ __forceinline__ void mlstm_chunk(const Params& p, int job, unsigned char* lds) {
    const int tid = tid_fresh(), lane = tid & 63, w = tid >> 6, fr = lane & 15, fq = lane >> 4;
    const int chain = job >> 3, cgp = job & 7;
    const int b = chain >> 3, h = (chain >> 1) & 3, dir = chain & 1;
    const int e0 = cgp * 32, lt = w >> 1, et = w & 1, dt0 = (w >> 1) * 2, tl = tid & 63, seg = tid >> 6;
    u16* Cl = (u16*)lds;
    u16* Ktw = (u16*)(lds + 17952);
    u16* Vt = (u16*)(lds + 17952 + 18432);
    u16* O = (u16*)(p.ws + (dir ? WS_OB : WS_OF));
    __syncthreads();
    for (int i = tid; i < 17952 / 4; i += NTHR) ((unsigned*)Cl)[i] = 0u;
    __syncthreads();
    f32x4_t Cacc[2], nacc; Cacc[0] = (f32x4_t){0.f, 0.f, 0.f, 0.f}; Cacc[1] = Cacc[0]; nacc = Cacc[0];
    float m_in = 0.f;
    bf16x8_t ones;
#pragma unroll
    for (int j = 0; j < 8; ++j) ones[j] = (short)0x3F80;
    MlFr buf[2];
    ml_load(buf[0], p, 0, b, h, dir, e0, lt, fr, fq, tl, seg); ml_load(buf[1], p, 1, b, h, dir, e0, lt, fr, fq, tl, seg);
    unsigned pfr[4] = {0u, 0u, 0u, 0u}, sink = 0u;
    for (int n0 = 0; n0 < NSEG; n0 += 4) {
#pragma unroll
        for (int u = 0; u < 4; ++u) {
            const int n = n0 + u; const int s = u & 1;
            sink ^= pfr[u]; pfr[u] = ml_touch(p, n + 5, b, h, dir, e0, tid);
            const MlFr& F = buf[s];
            const int tt = tile_of(n, b, dir), rowbase = rowbase_of(tt);
            const u16* Ccur = Cl + (n & 1) * (33 * 136); u16* Cnxt = Cl + ((n + 1) & 1) * (33 * 136);
            { float k[16]; unpack8(F.kr[0], k); unpack8(F.kr[1], k + 8);
#pragma unroll
                for (int c = 0; c < 16; ++c) Ktw[(seg * 16 + c) * 72 + tl] = f2bf(k[c] * F.kw);
                Vt[(seg * 4 + 0) * 72 + tl] = (u16)(F.vr.x & 0xffffu); Vt[(seg * 4 + 1) * 72 + tl] = (u16)(F.vr.x >> 16);
                Vt[(seg * 4 + 2) * 72 + tl] = (u16)(F.vr.y & 0xffffu); Vt[(seg * 4 + 3) * 72 + tl] = (u16)(F.vr.y >> 16); }
            __syncthreads();
            bf16x8_t vt[2];
#pragma unroll
            for (int ks = 0; ks < 2; ++ks) vt[ks] = *(const bf16x8_t*)(Vt + (et * 16 + fr) * 72 + ks * 32 + fq * 8);
            {
                f32x4_t inter = (f32x4_t){0.f, 0.f, 0.f, 0.f}, intra = inter, dinter = inter, dintra = inter;
#pragma unroll
                for (int ks = 0; ks < 4; ++ks) { const bf16x8_t cb = *(const bf16x8_t*)(Ccur + (et * 16 + fr) * 136 + ks * 32 + fq * 8); const bf16x8_t nb = *(const bf16x8_t*)(Ccur + 32 * 136 + ks * 32 + fq * 8);
                    inter = __builtin_amdgcn_mfma_f32_16x16x32_bf16(F.q[ks], cb, inter, 0, 0, 0); dinter = __builtin_amdgcn_mfma_f32_16x16x32_bf16(F.q[ks], nb, dinter, 0, 0, 0); }
#pragma unroll
                for (int ks = 0; ks < 2; ++ks) { intra = __builtin_amdgcn_mfma_f32_16x16x32_bf16(F.at[ks], vt[ks], intra, 0, 0, 0); dintra = __builtin_amdgcn_mfma_f32_16x16x32_bf16(F.at[ks], ones, dintra, 0, 0, 0); }
#pragma unroll
                for (int j = 0; j < 4; ++j) { const float M = fmaxf(F.cm[j], m_in); const float r = __expf(F.cm[j] - M), ei = __expf(m_in - M) * 0.08838834764831845f;
                    const float num = r * intra[j] + ei * inter[j], den = r * dintra[j] + ei * dinter[j];
                    const float hv = num * frcp(fmaxf(fabsf(den), __expf(-(F.b[j] + M))));
                    O[(size_t)(rowbase + lt * 16 + fq * 4 + j) * 2048 + h * 256 + e0 + et * 16 + fr] = f2bf(hv); }
            }
            { const float ML = fmaxf(F.cmL, m_in); const float a = __expf(m_in - ML), sc2 = __expf(F.cmL - ML); m_in = F.bL + ML;
#pragma unroll
                for (int i = 0; i < 2; ++i) { f32x4_t nw = (f32x4_t){0.f, 0.f, 0.f, 0.f};
#pragma unroll
                    for (int ks = 0; ks < 2; ++ks) { const bf16x8_t kb = *(const bf16x8_t*)(Ktw + ((dt0 + i) * 16 + fr) * 72 + ks * 32 + fq * 8); nw = __builtin_amdgcn_mfma_f32_16x16x32_bf16(vt[ks], kb, nw, 0, 0, 0); }
#pragma unroll
                    for (int j = 0; j < 4; ++j) { Cacc[i][j] = a * Cacc[i][j] + sc2 * nw[j]; Cnxt[(et * 16 + fq * 4 + j) * 136 + (dt0 + i) * 16 + fr] = f2bf(Cacc[i][j]); } }
                f32x4_t nw = (f32x4_t){0.f, 0.f, 0.f, 0.f};
#pragma unroll
                for (int ks = 0; ks < 2; ++ks) { const bf16x8_t kb = *(const bf16x8_t*)(Ktw + (w * 16 + fr) * 72 + ks * 32 + fq * 8); nw = __builtin_amdgcn_mfma_f32_16x16x32_bf16(ones, kb, nw, 0, 0, 0); }
                nacc[0] = a * nacc[0] + sc2 * nw[0];
                if (fq == 0) Cnxt[32 * 136 + w * 16 + fr] = f2bf(nacc[0]); }
            __syncthreads();
            ml_load(buf[s], p, n + 2, b, h, dir, e0, lt, fr, fq, tl, seg);
        }
    }
    ((unsigned*)(p.ws + WS_MODP))[blockIdx.x * NTHR + tid] = sink ^ pfr[0] ^ pfr[1] ^ pfr[2] ^ pfr[3];
}

__device__ __forceinline__ unsigned dn_touch(const Params& p, int n, int b, int h, int dir, int e0, int tid) {
    const int nn = n < NSEG ? n : NSEG - 1;
    const int tt = tile_of(nn, b, dir), it = (dir * 520 + tt) * 8 + h, rowbase = rowbase_of(tt);
    const bool isctx = tt < 8;
    const u16* qb = isctx ? (const u16*)(p.ws + WS_CQ) + (size_t)rowbase * 3072 + h * 128 : (const u16*)(p.ws + WS_PROJ) + (size_t)rowbase * NP0 + 3072 + h * 128;
    const int rs = isctx ? 3072 : NP0;
    const u16* a;
    if (tid < 256) a = qb + (size_t)((tid & 127) >> 1) * rs + (tid >> 7) * 1024 + (tid & 1) * 64;
    else if (tid < 320) a = qb + (size_t)(tid - 256) * rs + 2048 + e0;
    else if (tid < 384) a = (const u16*)(p.ws + WS_TM) + (size_t)it * 4096 + (tid - 320) * 64;
    else if (tid < 448) a = (const u16*)(p.ws + WS_QK) + (size_t)it * 4096 + (tid - 384) * 64;
    else a = (const u16*)(p.ws + WS_GCS) + (size_t)it * 512 + ((tid - 448) & 7) * 64;
    return *(const unsigned*)a;
}
struct DnFr { bf16x8_t k[4], q[4], tm[2], qk[2]; uint4 kr[2]; float kds, egc[4], be[4], egL; u16 v[4]; };
__device__ __forceinline__ void dn_load(DnFr& F, const Params& p, int n, int b, int h, int dir, int e0, int lt, int et, int fr, int fq, int tl, int seg) {
    const int nn = n < NSEG ? n : NSEG - 1;
    const int tt = tile_of(nn, b, dir), it = (dir * 520 + tt) * 8 + h, rowbase = rowbase_of(tt);
    const bool isctx = tt < 8;
    const u16* qb = isctx ? (const u16*)(p.ws + WS_CQ) + (size_t)rowbase * 3072 + h * 128 : (const u16*)(p.ws + WS_PROJ) + (size_t)rowbase * NP0 + 3072 + h * 128;
    const int rs = isctx ? 3072 : NP0;
    const u16* TM = (const u16*)(p.ws + WS_TM) + (size_t)it * 4096 + lt * 1024 + (fq * 16 + fr) * 8;
    const u16* QK = (const u16*)(p.ws + WS_QK) + (size_t)it * 4096 + lt * 1024 + (fq * 16 + fr) * 8;
    const float* GCS = (const float*)(p.ws + WS_GCS) + (size_t)it * 256;
    const u16* qr = qb + (size_t)(lt * 16 + fq) * rs + fr * 8;
#pragma unroll
    for (int ks = 0; ks < 4; ++ks) { F.q[ks] = *(const bf16x8_t*)(qr + (size_t)ks * 4 * rs); F.k[ks] = *(const bf16x8_t*)(qr + (size_t)ks * 4 * rs + 1024); }
#pragma unroll
    for (int ks = 0; ks < 2; ++ks) { F.tm[ks] = *(const bf16x8_t*)(TM + ks * 512); F.qk[ks] = *(const bf16x8_t*)(QK + ks * 512); }
    const u16* kp = qb + (size_t)(((tl >> 4) * 4 + (seg >> 1)) * 4 + (seg & 1) * 2) * rs + 1024 + (tl & 15) * 8;
    F.kr[0] = *(const uint4*)(kp); F.kr[1] = *(const uint4*)(kp + rs);
    F.kds = GCS[128 + tl]; F.egL = GCS[192];
#pragma unroll
    for (int j = 0; j < 4; ++j) { const int l = lt * 16 + fq * 4 + j; F.egc[j] = GCS[l]; F.be[j] = GCS[64 + l]; F.v[j] = qb[(size_t)l * rs + 2048 + e0 + et * 16 + fr]; }
}
__device__ __forceinline__ void deltanet_chunk(const Params& p, int job, unsigned char* lds) {
    const int tid = tid_fresh(), lane = tid & 63, w = tid >> 6, fr = lane & 15, fq = lane >> 4;
    const int chain = job >> 2, cgp = job & 3;
    const int b = chain >> 4, h = (chain >> 1) & 7, dir = chain & 1;
    const int e0 = cgp * 32, lt = w >> 1, et = w & 1, dt0 = (w >> 1) * 2, tl = tid & 63, seg = tid >> 6;
    u16* Sl = (u16*)lds;
    u16* Rt = (u16*)(lds + 17408);
    u16* VNt = (u16*)(lds + 17408 + 4608);
    u16* Kdt = (u16*)(lds + 17408 + 9216);
    u16* O = (u16*)(p.ws + (dir ? WS_OB : WS_OF));
    __syncthreads();
    for (int i = tid; i < 17408 / 4; i += NTHR) ((unsigned*)Sl)[i] = 0u;
    __syncthreads();
    f32x4_t Sacc[2]; Sacc[0] = (f32x4_t){0.f, 0.f, 0.f, 0.f}; Sacc[1] = Sacc[0];
    DnFr buf[2];
    dn_load(buf[0], p, 0, b, h, dir, e0, lt, et, fr, fq, tl, seg); dn_load(buf[1], p, 1, b, h, dir, e0, lt, et, fr, fq, tl, seg);
    unsigned pfr[4] = {0u, 0u, 0u, 0u}, sink = 0u;
    for (int n0 = 0; n0 < NSEG; n0 += 4) {
#pragma unroll
        for (int u = 0; u < 4; ++u) {
            const int n = n0 + u; const int s = u & 1;
            sink ^= pfr[u]; pfr[u] = dn_touch(p, n + 5, b, h, dir, e0, tid);
            const DnFr& F = buf[s];
            const int tt = tile_of(n, b, dir), rowbase = rowbase_of(tt);
            const u16* Scur = Sl + (n & 1) * (32 * 136); u16* Snxt = Sl + ((n + 1) & 1) * (32 * 136);
            f32x4_t X = (f32x4_t){0.f, 0.f, 0.f, 0.f}, Y = X;
#pragma unroll
            for (int ks = 0; ks < 4; ++ks) { const bf16x8_t sb = *(const bf16x8_t*)(Scur + (et * 16 + fr) * 136 + ks * 32 + fq * 8);
                X = __builtin_amdgcn_mfma_f32_16x16x32_bf16(F.k[ks], sb, X, 0, 0, 0); Y = __builtin_amdgcn_mfma_f32_16x16x32_bf16(F.q[ks], sb, Y, 0, 0, 0); }
#pragma unroll
            for (int j = 0; j < 4; ++j) Rt[(et * 16 + fr) * 72 + lt * 16 + fq * 4 + j] = f2bf(F.be[j] * (bf2f(F.v[j]) - F.egc[j] * X[j]));
            { float k[16]; unpack8(F.kr[0], k); unpack8(F.kr[1], k + 8);
#pragma unroll
                for (int c = 0; c < 16; ++c) Kdt[(seg * 16 + c) * 72 + tl] = f2bf(k[c] * F.kds); }
            __syncthreads();
            { f32x4_t VN = (f32x4_t){0.f, 0.f, 0.f, 0.f};
#pragma unroll
                for (int ks = 0; ks < 2; ++ks) { const bf16x8_t rb = *(const bf16x8_t*)(Rt + (et * 16 + fr) * 72 + ks * 32 + fq * 8); VN = __builtin_amdgcn_mfma_f32_16x16x32_bf16(F.tm[ks], rb, VN, 0, 0, 0); }
#pragma unroll
                for (int j = 0; j < 4; ++j) VNt[(et * 16 + fr) * 72 + lt * 16 + fq * 4 + j] = f2bf(VN[j]); }
            __syncthreads();
            bf16x8_t vn[2];
#pragma unroll
            for (int ks = 0; ks < 2; ++ks) vn[ks] = *(const bf16x8_t*)(VNt + (et * 16 + fr) * 72 + ks * 32 + fq * 8);
            { f32x4_t acc = (f32x4_t){0.f, 0.f, 0.f, 0.f};
#pragma unroll
                for (int ks = 0; ks < 2; ++ks) acc = __builtin_amdgcn_mfma_f32_16x16x32_bf16(F.qk[ks], vn[ks], acc, 0, 0, 0);
#pragma unroll
                for (int j = 0; j < 4; ++j) O[(size_t)(rowbase + lt * 16 + fq * 4 + j) * 2048 + 1024 + h * 128 + e0 + et * 16 + fr] = f2bf(0.08838834764831845f * F.egc[j] * Y[j] + acc[j]); }
#pragma unroll
            for (int i = 0; i < 2; ++i) { f32x4_t nw = (f32x4_t){0.f, 0.f, 0.f, 0.f};
#pragma unroll
                for (int ks = 0; ks < 2; ++ks) { const bf16x8_t kb = *(const bf16x8_t*)(Kdt + ((dt0 + i) * 16 + fr) * 72 + ks * 32 + fq * 8); nw = __builtin_amdgcn_mfma_f32_16x16x32_bf16(vn[ks], kb, nw, 0, 0, 0); }
#pragma unroll
                for (int j = 0; j < 4; ++j) { Sacc[i][j] = F.egL * Sacc[i][j] + nw[j]; Snxt[(et * 16 + fq * 4 + j) * 136 + (dt0 + i) * 16 + fr] = f2bf(Sacc[i][j]); } }
            __syncthreads();
            dn_load(buf[s], p, n + 2, b, h, dir, e0, lt, et, fr, fq, tl, seg);
        }
    }
    ((unsigned*)(p.ws + WS_MODP))[blockIdx.x * NTHR + tid] = sink ^ pfr[0] ^ pfr[1] ^ pfr[2] ^ pfr[3];
}

constexpr int RG_XC = 65536;

__device__ __forceinline__ void ph_convert_rg(const Params& p) {
    u16* WRT = (u16*)(p.ws + WS_WRT);
    for (int idx = blockIdx.x * NTHR + tid_fresh(); idx < 65536; idx += gridDim.x * NTHR) {
        const int k8 = idx & 15, n = (idx >> 4) & 127, mzg = idx >> 11;
        const float* W = (mzg < 16 ? p.rg_w_r : p.rg_w_i) + (size_t)(mzg & 15) * 16384;
        float v[8];
#pragma unroll
        for (int j = 0; j < 8; ++j) v[j] = W[(k8 * 8 + j) * 128 + n];
        *(uint4*)(WRT + (size_t)mzg * 16384 + (((n >> 4) * 4 + (k8 >> 2)) * 64 + (k8 & 3) * 16 + (n & 15)) * 8) = pack8(v);
    }
}
__device__ __forceinline__ int rg_tau(int tt, int z) { if (tt < 8) { const int ci = tt & 3; return z ? 3 - ci : ci; } const int li = (tt - 8) & 255; return 4 + (z ? 255 - li : li); }
__device__ __forceinline__ int rg_batch(int tt) { return tt < 8 ? (tt >> 2) : ((tt - 8) >> 8); }

__device__ __forceinline__ void rg_conv(const Params& p, int tt, int g, unsigned char* lds) {
    const int tid = tid_fresh();
    const u16* PROJ = (const u16*)(p.ws + WS_PROJ);
    u16* XC = (u16*)(lds + RG_XC);
    const bool isctx = tt < 8;
    const int t0 = isctx ? (tt & 3) * 64 : 0;
    const int rowbase = isctx ? (tt >> 2) * 256 + t0 : 512 + (tt - 8) * 64;
    const int tk = tid >> 3, cs = (tid & 7) * 16;
    uint4 in[5][2];
#pragma unroll
    for (int j = 0; j < 5; ++j) { const int r = tk + j - 2;
        const bool ok = isctx ? (t0 + r >= 0 && t0 + r < 256) : (r >= 0 && r < 64);
        in[j][0] = make_uint4(0u, 0u, 0u, 0u); in[j][1] = in[j][0];
        if (ok) { const u16* src = PROJ + (size_t)(rowbase + r) * NP1 + g * 128 + cs; in[j][0] = *(const uint4*)(src); in[j][1] = *(const uint4*)(src + 8); } }
    float o[16];
#pragma unroll
    for (int c4 = 0; c4 < 4; ++c4) { const float4 b4 = *(const float4*)(p.rg_conv_b + g * 128 + cs + c4 * 4); o[c4 * 4] = b4.x; o[c4 * 4 + 1] = b4.y; o[c4 * 4 + 2] = b4.z; o[c4 * 4 + 3] = b4.w; }
#pragma unroll
    for (int j = 0; j < 5; ++j) {
        const float* wr_ = p.rg_conv_w + j * 1024 + g * 128 + cs; float f[16]; unpack8(in[j][0], f); unpack8(in[j][1], f + 8);
#pragma unroll
        for (int c4 = 0; c4 < 4; ++c4) { const float4 w4 = *(const float4*)(wr_ + c4 * 4);
            o[c4 * 4 + 0] += f[c4 * 4 + 0] * w4.x; o[c4 * 4 + 1] += f[c4 * 4 + 1] * w4.y; o[c4 * 4 + 2] += f[c4 * 4 + 2] * w4.z; o[c4 * 4 + 3] += f[c4 * 4 + 3] * w4.w; }
    }
    __syncthreads();
    *(uint4*)(XC + tk * 136 + cs) = pack8(o); *(uint4*)(XC + tk * 136 + cs + 8) = pack8(o + 8);
    __syncthreads();
}
__device__ __forceinline__ void rg_gates_reg(const Params& p, int g, int z, const unsigned char* lds, int rt, int chh, int fr, int fq, float (&av)[4][4], float (&bx)[4][4]) {
    const u16* XC = (const u16*)(lds + RG_XC);
    const u16* WR = (const u16*)(p.ws + WS_WRT) + (size_t)((0 * 2 + z) * 8 + g) * 16384; const u16* WI = (const u16*)(p.ws + WS_WRT) + (size_t)((1 * 2 + z) * 8 + g) * 16384;
    f32x4_t R[4], I[4];
#pragma unroll
    for (int c = 0; c < 4; ++c) { R[c] = (f32x4_t){0.f, 0.f, 0.f, 0.f}; I[c] = (f32x4_t){0.f, 0.f, 0.f, 0.f}; }
#pragma unroll
    for (int ks = 0; ks < 4; ++ks) {
        const bf16x8_t a = *(const bf16x8_t*)(XC + (rt * 16 + fr) * 136 + ks * 32 + fq * 8);
#pragma unroll
        for (int c = 0; c < 4; ++c) { const int fo = (((chh * 4 + c) * 4 + ks) * 64 + fq * 16 + fr) * 8;
            R[c] = __builtin_amdgcn_mfma_f32_16x16x32_bf16(a, *(const bf16x8_t*)(WR + fo), R[c], 0, 0, 0);
            I[c] = __builtin_amdgcn_mfma_f32_16x16x32_bf16(a, *(const bf16x8_t*)(WI + fo), I[c], 0, 0, 0); }
    }
#pragma unroll
    for (int c = 0; c < 4; ++c) {
        const int chl = (chh * 4 + c) * 16 + fr, chg = z * 1024 + g * 128 + chl;
        const float br = p.rg_b_r[chg], bi = p.rg_b_i[chg], sp = softplusf_(-p.rg_lambda[chg]);
#pragma unroll
        for (int j = 0; j < 4; ++j) { const int t = rt * 16 + fq * 4 + j;
            const float r = sigmoidf_(R[c][j] + br), ii = sigmoidf_(I[c][j] + bi);
            const float la = -8.f * r * sp;
            av[c][j] = __expf(la); bx[c][j] = __builtin_amdgcn_sqrtf(neg_expm1_small(2.f * la)) * ii * bf2f(XC[t * 136 + chl]); }
    }
}
__device__ __forceinline__ float2 rg_local(const float (&a)[4], const float (&b)[4], int z) {
    float P = 1.f, H = 0.f;
#pragma unroll
    for (int i = 0; i < 4; ++i) { const int j = z ? 3 - i : i; H = a[j] * H + b[j]; P *= a[j]; }
    return make_float2(P, H);
}
__device__ __forceinline__ void gla_prep_item(const Params& p, int it, unsigned char* lds) {
    const int tid = tid_fresh(), lane = tid & 63, w = tid >> 6, fr = lane & 15, fq = lane >> 4;
    const int h = it & 3, tt = (it >> 2) % 520, z = it / 2080;
    const int rowbase = tt < 8 ? tt * 64 : 512 + (tt - 8) * 64;
    float* LG = (float*)lds;
    u16* QEs = (u16*)(lds + 32768);
    u16* KEs = (u16*)(lds + 32768 + 17408);
    u16* Vs = (u16*)(lds + 32768 + 2 * 17408);
    float* BLs = (float*)(lds + 32768 + 2 * 17408 + 33792);
    const u16* PROJ = (const u16*)(p.ws + WS_PROJ); const float* LR = (const float*)(p.ws + WS_G);
    u16* QE = (u16*)(p.ws + WS_QE); u16* KDT = (u16*)(p.ws + WS_KDT) + (size_t)it * 8192; u16* ATT = (u16*)(p.ws + WS_ATT) + (size_t)it * 4096;
    u16* VT = (u16*)(p.ws + WS_VT); float* EBL = (float*)(p.ws + WS_EBL);
    __syncthreads();
    { float* LRs = (float*)(lds + 32768);
        for (int i = tid; i < 1024; i += NTHR) LRs[i] = LR[(size_t)(rowbase + (i >> 4)) * 32 + z * 16 + (i & 15)];
        __syncthreads();
        const int c = tid & 127, tq = tid >> 7; float wv[16];
#pragma unroll
        for (int r = 0; r < 16; ++r) wv[r] = p.gla_w_up[(z * 16 + r) * 512 + h * 128 + c];
        const float bu = p.gla_b_up[z * 512 + h * 128 + c];
        for (int i = 0; i < 16; ++i) { const int tk = tq * 16 + i; const float4* lr4 = (const float4*)(LRs + tk * 16); float s = bu;
#pragma unroll
            for (int r4 = 0; r4 < 4; ++r4) { const float4 l4 = lr4[r4]; s += l4.x * wv[r4 * 4] + l4.y * wv[r4 * 4 + 1] + l4.z * wv[r4 * 4 + 2] + l4.w * wv[r4 * 4 + 3]; }
            LG[tk * 128 + c] = logsigmoidf_(s) * (1.f / 16.f); } }
    __syncthreads();
    if (tid < 128) { float acc = 0.f;
        for (int i = 0; i < 64; ++i) { const int tk = z ? 63 - i : i; acc += LG[tk * 128 + tid]; LG[tk * 128 + tid] = acc; }
        BLs[tid] = acc; EBL[(size_t)it * 128 + tid] = __expf(acc); }
    __syncthreads();
    { const int tk = tid >> 3, cs = (tid & 7) * 16; const u16* rp = PROJ + (size_t)(rowbase + tk) * NP1;
        float q[16], k[16], qe[16], ke[16];
        unpack8(*(const uint4*)(rp + 2048 + h * 128 + cs), q); unpack8(*(const uint4*)(rp + 2048 + h * 128 + cs + 8), q + 8);
        unpack8(*(const uint4*)(rp + 2560 + h * 128 + cs), k); unpack8(*(const uint4*)(rp + 2560 + h * 128 + cs + 8), k + 8);
#pragma unroll
        for (int c = 0; c < 16; ++c) { const float bb = LG[tk * 128 + cs + c], bl = BLs[cs + c];
            qe[c] = q[c] * 0.08838834764831845f * __expf(bb); ke[c] = k[c] * __expf(-bb);
            { const int d = cs + c; KDT[(((d >> 4) * 2 + (tk >> 5)) * 64 + ((tk >> 3) & 3) * 16 + (d & 15)) * 8 + (tk & 7)] = f2bf(k[c] * __expf(bl - bb)); } }
        const uint4 q0 = pack8(qe), q1 = pack8(qe + 8);
        *(uint4*)(QEs + tk * 136 + cs) = q0; *(uint4*)(QEs + tk * 136 + cs + 8) = q1;
        *(uint4*)(KEs + tk * 136 + cs) = pack8(ke); *(uint4*)(KEs + tk * 136 + cs + 8) = pack8(ke + 8);
        u16* qg = QE + (size_t)it * 8192 + (((tk >> 4) * 4 + (cs >> 5)) * 64 + ((cs >> 3) & 3) * 16 + (tk & 15)) * 8;
        *(uint4*)(qg) = q0; *(uint4*)(qg + 128) = q1; }
    if (z == 0) for (int ch = tid; ch < 2048; ch += NTHR) { const int tk = ch >> 5, c8 = (ch & 31) * 8;
        *(uint4*)(Vs + tk * 264 + c8) = *(const uint4*)(PROJ + (size_t)(rowbase + tk) * NP1 + 3072 + h * 256 + c8); }
    __syncthreads();
    { const int rt = w >> 1;
#pragma unroll
        for (int i = 0; i < 2; ++i) { const int ct = (w & 1) * 2 + i; f32x4_t acc = (f32x4_t){0.f, 0.f, 0.f, 0.f};
#pragma unroll
            for (int ks = 0; ks < 4; ++ks) { const bf16x8_t a = *(const bf16x8_t*)(QEs + (rt * 16 + fr) * 136 + ks * 32 + fq * 8); const bf16x8_t bb = *(const bf16x8_t*)(KEs + (ct * 16 + fr) * 136 + ks * 32 + fq * 8);
                acc = __builtin_amdgcn_mfma_f32_16x16x32_bf16(a, bb, acc, 0, 0, 0); }
#pragma unroll
            for (int j = 0; j < 4; ++j) { const int l = rt * 16 + fq * 4 + j, s = ct * 16 + fr; const bool keep = z ? (s >= l) : (s <= l);
                ATT[(((l >> 4) * 2 + (s >> 5)) * 64 + ((s >> 3) & 3) * 16 + (l & 15)) * 8 + (s & 7)] = f2bf(keep ? acc[j] : 0.f); } } }
    if (z == 0) { const int e = tid >> 1, hf = tid & 1; u16* dst = VT + (size_t)(tt * 4 + h) * 16384 + (((e >> 4) * 2 + hf) * 64 + (e & 15)) * 8;
#pragma unroll
        for (int l8 = 0; l8 < 4; ++l8) { float v[8];
#pragma unroll
            for (int j = 0; j < 8; ++j) v[j] = bf2f(Vs[(hf * 32 + l8 * 8 + j) * 264 + e]);
            *(uint4*)(dst + l8 * 128) = pack8(v); } }
}
__device__ __forceinline__ void ph_l1_a(const Params& p, unsigned char* lds, int parts = 3) {
    const int tid = tid_fresh(), lane = tid & 63, w = tid >> 6, rt = w >> 1, chh = w & 1, fr = lane & 15, fq = lane >> 4;
    float2* AGG = (float2*)(p.ws + WS_AGG);
    float2* AG = (float2*)lds;
    if (parts & 1) for (int t = blockIdx.x; t < 520 * 8; t += gridDim.x) {
        const int tt = t >> 3, g = t & 7, b = rg_batch(tt);
        rg_conv(p, tt, g, lds);
#pragma unroll
        for (int z = 0; z < 2; ++z) {
            float av[4][4], bx[4][4];
            rg_gates_reg(p, g, z, lds, rt, chh, fr, fq, av, bx);
#pragma unroll
            for (int c = 0; c < 4; ++c) AG[(z * 16 + rt * 4 + fq) * 128 + (chh * 4 + c) * 16 + fr] = rg_local(av[c], bx[c], z);
        }
        __syncthreads();
        if (tid < 256) { const int z = tid >> 7, ch = tid & 127; float P = 1.f, H = 0.f;
#pragma unroll
            for (int s = 0; s < 16; ++s) { const int gi = z ? 15 - s : s; const float2 ph = AG[(z * 16 + gi) * 128 + ch]; H = ph.x * H + ph.y; P *= ph.x; }
            AGG[((size_t)(b * 2 + z) * NSEG + rg_tau(tt, z)) * 1024 + g * 128 + ch] = make_float2(P, H); }
    }
    if (parts & 2) for (int it = blockIdx.x; it < 4160; it += gridDim.x) gla_prep_item(p, it, lds);
}
__device__ __forceinline__ void rg_pass_b(const Params& p, int job) {
    const float2* __restrict__ AGG = (const float2*)(p.ws + WS_AGG); float* __restrict__ CARRY = (float*)(p.ws + WS_CARRY);
    const int bz = job >> 1, ch = (job & 1) * 512 + tid_fresh();
    float carry = 0.f;
    for (int t0 = 0; t0 < NSEG; t0 += 20) {
        float2 ph[20];
#pragma unroll
        for (int i = 0; i < 20; ++i) ph[i] = AGG[((size_t)bz * NSEG + t0 + i) * 1024 + ch];
#pragma unroll
        for (int i = 0; i < 20; ++i) { CARRY[((size_t)bz * NSEG + t0 + i) * 1024 + ch] = carry; carry = ph[i].x * carry + ph[i].y; }
    }
}
struct GlaFr { bf16x8_t qe[4], at[2], vt[2], kd[2][2]; float eb[2]; };
struct GlaOff { int qe, at, vt, kd, eb, o, tch, tsel; };
__device__ __forceinline__ void gla_load(GlaFr& F, const unsigned char* ws, int n, int b, int h, int dir, const GlaOff& o) {
    const int nn = n < NSEG ? n : NSEG - 1;
    const int tt = tile_of(nn, b, dir), it = (dir * 520 + tt) * 4 + h, rowbase = rowbase_of(tt);
    const u16* QE = (const u16*)(ws + WS_QE) + (size_t)it * 8192;
    const u16* AT = (const u16*)(ws + WS_ATT) + (size_t)it * 4096;
    const u16* VT = (const u16*)(ws + WS_VT) + (size_t)(tt * 4 + h) * 16384;
    const u16* KD = (const u16*)(ws + WS_KDT) + (size_t)it * 8192;
    const float* EB = (const float*)(ws + WS_EBL) + (size_t)it * 128;
#pragma unroll
    for (int ks = 0; ks < 4; ++ks) F.qe[ks] = *(const bf16x8_t*)(QE + o.qe + ks * 512);
#pragma unroll
    for (int ks = 0; ks < 2; ++ks) { F.at[ks] = *(const bf16x8_t*)(AT + o.at + ks * 512); F.vt[ks] = *(const bf16x8_t*)(VT + o.vt + ks * 512);
        F.kd[0][ks] = *(const bf16x8_t*)(KD + o.kd + ks * 512); F.kd[1][ks] = *(const bf16x8_t*)(KD + o.kd + 1024 + ks * 512); }
    F.eb[0] = EB[o.eb]; F.eb[1] = EB[o.eb + 16];
}
__device__ __forceinline__ unsigned gla_touch(const unsigned char* ws, int n, int b, int h, int dir, const GlaOff& o) {
    const int nn = n < NSEG ? n : NSEG - 1;
    const int tt = tile_of(nn, b, dir), it = (dir * 520 + tt) * 4 + h, rowbase = rowbase_of(tt);
    const u16* base;
    if (o.tsel == 0) base = (const u16*)(ws + WS_QE) + (size_t)it * 8192;
    else if (o.tsel == 1) base = (const u16*)(ws + WS_KDT) + (size_t)it * 8192;
    else if (o.tsel == 2) base = (const u16*)(ws + WS_ATT) + (size_t)it * 4096;
    else base = (const u16*)(ws + WS_VT) + (size_t)(tt * 4 + h) * 16384;
    return *(const unsigned*)(base + o.tch);
}
__device__ __forceinline__ void gla_chunk(const Params& p, int job, unsigned char* lds) {
    const int tid = tid_fresh(), lane = tid & 63, w = __builtin_amdgcn_readfirstlane(tid >> 6), fr = lane & 15, fq = lane >> 4;
    const int chain = job >> 3, cgp = job & 7;
    const int b = chain >> 3, h = (chain >> 1) & 3, dir = chain & 1;
    const int e0 = cgp * 32, lt = w >> 1, et = w & 1, dt0 = (w >> 1) * 2;
    const unsigned char* ws = p.ws;
    GlaOff o;
    o.qe = lt * 2048 + lane * 8; o.at = lt * 1024 + lane * 8; o.vt = ((e0 >> 4) + et) * 1024 + lane * 8;
    o.kd = dt0 * 1024 + lane * 8; o.eb = dt0 * 16 + fr; o.o = (lt * 16 + fq * 4) * 1024 + h * 256 + e0 + et * 16 + fr;
    o.tsel = w < 2 ? 0 : (w < 4 ? 1 : (w == 4 ? 2 : 3));
    o.tch = w < 2 ? (w * 64 + lane) * 64 : (w < 4 ? ((w - 2) * 64 + lane) * 64 : (w == 4 ? lane * 64 : (e0 >> 4) * 1024 + (lane & 31) * 64));
    u16* Sl = (u16*)lds;
    u16* O = (u16*)(p.ws + (dir ? WS_OB1 : WS_OF1));
    const int sRd = (et * 16 + fr) * 136 + fq * 8, sWr = (et * 16 + fq * 4) * 136 + dt0 * 16 + fr;
    __syncthreads();
    for (int i = tid; i < 2 * 32 * 136 / 2; i += NTHR) ((unsigned*)Sl)[i] = 0u;
    __syncthreads();
    f32x4_t Sacc[2]; Sacc[0] = (f32x4_t){0.f, 0.f, 0.f, 0.f}; Sacc[1] = Sacc[0];
    GlaFr buf[2];
    gla_load(buf[0], ws, 0, b, h, dir, o); gla_load(buf[1], ws, 1, b, h, dir, o);
    unsigned pfr[4] = {0u, 0u, 0u, 0u}, sink = 0u;
    for (int n0 = 0; n0 < NSEG; n0 += 4) {
#pragma unroll
        for (int u = 0; u < 4; ++u) {
            const int n = n0 + u; const int s = u & 1;
            sink ^= pfr[u]; if (w < 6) pfr[u] = gla_touch(ws, n + 5, b, h, dir, o);
            const GlaFr& F = buf[s];
            const u16* Scur = Sl + (n & 1) * (32 * 136); u16* Snxt = Sl + ((n + 1) & 1) * (32 * 136);
            if (n >= 4) {
                const int tt = tile_of(n, b, dir);
                u16* Ou = O + (size_t)(512 + (tt - 8) * 64) * 1024;
                f32x4_t acc = (f32x4_t){0.f, 0.f, 0.f, 0.f};
#pragma unroll
                for (int ks = 0; ks < 4; ++ks) { const bf16x8_t bb = *(const bf16x8_t*)(Scur + sRd + ks * 32); acc = __builtin_amdgcn_mfma_f32_16x16x32_bf16(F.qe[ks], bb, acc, 0, 0, 0); }
#pragma unroll
                for (int ks = 0; ks < 2; ++ks) acc = __builtin_amdgcn_mfma_f32_16x16x32_bf16(F.at[ks], F.vt[ks], acc, 0, 0, 0);
#pragma unroll
                for (int j = 0; j < 4; ++j) Ou[o.o + j * 1024] = f2bf(acc[j]);
            }
#pragma unroll
            for (int i = 0; i < 2; ++i) { f32x4_t nw = (f32x4_t){0.f, 0.f, 0.f, 0.f};
#pragma unroll
                for (int ks = 0; ks < 2; ++ks) nw = __builtin_amdgcn_mfma_f32_16x16x32_bf16(F.vt[ks], F.kd[i][ks], nw, 0, 0, 0);
#pragma unroll
                for (int j = 0; j < 4; ++j) { Sacc[i][j] = F.eb[i] * Sacc[i][j] + nw[j]; Snxt[sWr + j * 136 + i * 16] = f2bf(Sacc[i][j]); } }
            __syncthreads();
            gla_load(buf[s], ws, n + 2, b, h, dir, o);
        }
    }
    ((unsigned*)(p.ws + WS_MODP))[blockIdx.x * NTHR + tid] = sink ^ pfr[0] ^ pfr[1] ^ pfr[2] ^ pfr[3];
}
__device__ __forceinline__ void ph_l1_c(const Params& p, unsigned char* lds, int t_lo, int t_hi, int first, int stride, int do_merge) {
    const int tid = tid_fresh(), rt = (tid >> 6) >> 1, chh = (tid >> 6) & 1, fr = tid & 15, fq = (tid & 63) >> 4;
    const u16* PROJ = (const u16*)(p.ws + WS_PROJ); const float* CARRY = (const float*)(p.ws + WS_CARRY); u16* Y = (u16*)(p.ws + WS_H);
    float2* AG = (float2*)lds;
    float* CIN = (float*)(lds + 32768);
    for (int t = t_lo + first; t < t_hi; t += stride) {
        const int tt = t >> 3, g = t & 7, b = rg_batch(tt);
        const int rowbase = 512 + (tt - 8) * 64;
        rg_conv(p, tt, g, lds);
        u16 grv[4][4];
#pragma unroll
        for (int c = 0; c < 4; ++c)
#pragma unroll
            for (int j = 0; j < 4; ++j) grv[c][j] = PROJ[(size_t)(rowbase + rt * 16 + fq * 4 + j) * NP1 + 1024 + g * 128 + (chh * 4 + c) * 16 + fr];
        float av[2][4][4], bx[2][4][4];
#pragma unroll
        for (int z = 0; z < 2; ++z) {
            rg_gates_reg(p, g, z, lds, rt, chh, fr, fq, av[z], bx[z]);
#pragma unroll
            for (int c = 0; c < 4; ++c) AG[(z * 16 + rt * 4 + fq) * 128 + (chh * 4 + c) * 16 + fr] = rg_local(av[z][c], bx[z][c], z);
        }
        __syncthreads();
        if (tid < 256) { const int z = tid >> 7, ch = tid & 127; float h = CARRY[((size_t)(b * 2 + z) * NSEG + rg_tau(tt, z)) * 1024 + g * 128 + ch];
#pragma unroll
            for (int s = 0; s < 16; ++s) { const int gi = z ? 15 - s : s; CIN[(z * 16 + gi) * 128 + ch] = h; const float2 ph = AG[(z * 16 + gi) * 128 + ch]; h = ph.x * h + ph.y; } }
        __syncthreads();
#pragma unroll
        for (int c = 0; c < 4; ++c) { const int chl = (chh * 4 + c) * 16 + fr; float hs[4];
            { float h = CIN[(0 * 16 + rt * 4 + fq) * 128 + chl];
#pragma unroll
                for (int j = 0; j < 4; ++j) { h = av[0][c][j] * h + bx[0][c][j]; hs[j] = h; } }
            { float h = CIN[(1 * 16 + rt * 4 + fq) * 128 + chl];
#pragma unroll
                for (int j = 3; j >= 0; --j) { h = av[1][c][j] * h + bx[1][c][j]; hs[j] += h; } }
#pragma unroll
            for (int j = 0; j < 4; ++j) Y[(size_t)(rowbase + rt * 16 + fq * 4 + j) * 2048 + g * 128 + chl] = f2bf(gelu_tanh(bf2f(grv[c][j])) * hs[j]); }
    }
    const int lane = tid & 63, w = tid >> 6;
    const u16* OF = (const u16*)(p.ws + WS_OF1); const u16* OB = (const u16*)(p.ws + WS_OB1);
    if (do_merge) for (int row = 512 + blockIdx.x * 8 + w; row < MTOT; row += gridDim.x * 8) {
        float o[2][8], ssq[2];
#pragma unroll
        for (int k = 0; k < 2; ++k) { const int col = (k * 64 + lane) * 8; float a[8], bb[8];
            unpack8(*(const uint4*)(OF + (size_t)row * 1024 + col), a); unpack8(*(const uint4*)(OB + (size_t)row * 1024 + col), bb);
            float s = 0.f;
#pragma unroll
            for (int j = 0; j < 8; ++j) { o[k][j] = a[j] + bb[j]; s += o[k][j] * o[k][j]; }
            s = red16(s); s += __shfl_xor(s, 16); ssq[k] = s; }
#pragma unroll
        for (int k = 0; k < 2; ++k) { const int col = (k * 64 + lane) * 8; const float rstd = rsqrtf(ssq[k] * (1.f / 256.f) + 1e-6f);
            float gt[8], r[8]; unpack8(*(const uint4*)(PROJ + (size_t)row * NP1 + 4096 + col), gt);
            const float4 g0 = *(const float4*)(p.gla_norm_g + col), g1 = *(const float4*)(p.gla_norm_g + col + 4); const float gg[8] = {g0.x, g0.y, g0.z, g0.w, g1.x, g1.y, g1.z, g1.w};
#pragma unroll
            for (int j = 0; j < 8; ++j) r[j] = o[k][j] * rstd * gg[j] * siluf_(gt[j]);
            *(uint4*)(Y + (size_t)row * 2048 + 1024 + col) = pack8(r); }
    }
}

#define XB_TMO      128
#define XB_XCNT(j)  (256  + 64 * (j))
#define XB_XSUB(j)  (1280 + 64 * (j))
#define XB_XGEN(j)  (2304 + 64 * (j))
#define XB_TOP      3328
#define XB_TOPGEN   3392
#define XCD_BAR_WORDS 3456
#define XB_SPIN_CAP (1u << 18)
#define XLAS __attribute__((address_space(3)))

__device__ __forceinline__ unsigned xb_ld(unsigned* p)              { return __hip_atomic_load(p, __ATOMIC_RELAXED, __HIP_MEMORY_SCOPE_AGENT); }
__device__ __forceinline__ unsigned xb_add(unsigned* p, unsigned v) { return __hip_atomic_fetch_add(p, v, __ATOMIC_RELAXED, __HIP_MEMORY_SCOPE_AGENT); }
__device__ __forceinline__ unsigned xb_xcc_id() { return (unsigned)__builtin_amdgcn_s_getreg((3 << 11) | 20) & 0xFu; }
#define XB_SPIN(cond, bar) do { unsigned _sp = 0; while (cond) { __builtin_amdgcn_s_sleep(1); \
    if ((++_sp & 255u) == 0u) { if (xb_ld(&(bar)[XB_TMO])) break; if (_sp > XB_SPIN_CAP) { atomicAdd(&(bar)[XB_TMO], 1u); break; } } } } while (0)

struct XcdBarrier {
    unsigned* bar; unsigned x;
    volatile XLAS unsigned* st;
};

__device__ __forceinline__ XcdBarrier xcd_barrier_post(unsigned* bar, volatile XLAS unsigned* st) {
    XcdBarrier b; b.bar = bar; b.x = xb_xcc_id(); b.st = st;
    if (threadIdx.x == 0) (void)xb_add(&bar[XB_XCNT(b.x)], 1u);
    return b;
}
__device__ __forceinline__ void xcd_barrier_complete(unsigned* bar, unsigned x, unsigned& nloc, unsigned& nx) {
    const unsigned G = gridDim.x * gridDim.y * gridDim.z;
    unsigned sum, cnt, mine, sp = 0u;
    for (;;) {
        sum = 0u; cnt = 0u; mine = 0u;
#pragma unroll
        for (unsigned j = 0; j < 16; ++j) { const unsigned c = xb_ld(&bar[XB_XCNT(j)]); sum += c; cnt += (c > 0u) ? 1u : 0u; mine = (j == x) ? c : mine; }
        if (sum == G) break;
        __builtin_amdgcn_s_sleep(1);
        if ((++sp & 255u) == 0u) { if (xb_ld(&bar[XB_TMO])) break; if (sp > XB_SPIN_CAP) { atomicAdd(&bar[XB_TMO], 1u); break; } }
    }
    nloc = mine > 0u ? mine : 1u; nx = cnt > 0u ? cnt : 1u;
}

__device__ __forceinline__ void xcd_barrier(const XcdBarrier& b) {
    asm volatile("s_waitcnt vmcnt(0)" ::: "memory");
    __syncthreads();
    if (threadIdx.x == 0) {
        unsigned* bar = b.bar;
        __builtin_amdgcn_s_waitcnt(0);
        unsigned nloc = b.st[0], nx = b.st[1];
        if (nloc == 0u) { xcd_barrier_complete(bar, b.x, nloc, nx); b.st[0] = nloc; b.st[1] = nx; }
        const unsigned old = xb_add(&bar[XB_XSUB(b.x)], 1u);
        const unsigned gen = old / nloc;
        if (old + 1u == (gen + 1u) * nloc) {
            __builtin_amdgcn_fence(__ATOMIC_RELEASE, "agent");
            asm volatile("s_waitcnt vmcnt(0)" ::: "memory");
            const unsigned og = xb_add(&bar[XB_TOP], 1u);
            const unsigned tg = og / nx;
            if (og + 1u == (tg + 1u) * nx) xb_add(&bar[XB_TOPGEN], 1u);
            else XB_SPIN(xb_ld(&bar[XB_TOPGEN]) == tg, bar);
            __builtin_amdgcn_fence(__ATOMIC_ACQUIRE, "agent");
            xb_add(&bar[XB_XGEN(b.x)], 1u);
            asm volatile("s_waitcnt vmcnt(0)" ::: "memory");
        } else {
            XB_SPIN(xb_ld(&bar[XB_XGEN(b.x)]) == gen, bar);
            __builtin_amdgcn_fence(__ATOMIC_ACQUIRE, "agent");
            asm volatile("s_waitcnt vmcnt(0)" ::: "memory");
        }
    }
    __syncthreads();
}

constexpr int LDS_BYTES = 135168 + 16;
constexpr int L1C_SPLIT = 64 + 3072;

__global__ void __launch_bounds__(NTHR, 2) hybrid_fwd(Params p) {
    extern __shared__ __attribute__((aligned(16))) unsigned char lds[];
    cg::grid_group grid = cg::this_grid();
    float* smf = (float*)lds;
    PG8_LAS unsigned char* ldsg = (PG8_LAS unsigned char*)lds;
    unsigned char* ws = p.ws;
    u16* WT_IN = (u16*)(ws + WS_WT_IN); u16* WT_OUT = (u16*)(ws + WS_WT_OUT); u16* WT_GU = (u16*)(ws + WS_WT_GU); u16* WT_DN = (u16*)(ws + WS_WT_DN);
    u16* H = (u16*)(ws + WS_H); u16* PROJ = (u16*)(ws + WS_PROJ); float* XC = (float*)(ws + WS_XC); float* G = (float*)(ws + WS_G);
    const float* MOD = (const float*)(ws + WS_MOD);
    const int GD = (int)gridDim.x, bid = (int)blockIdx.x;
    const int vb = (GD % 8 == 0) ? (bid % 8) * (GD / 8) + bid / 8 : bid;
    volatile XLAS unsigned* xst = (volatile XLAS unsigned*)((PG8_LAS unsigned char*)lds + 135168);
    if (threadIdx.x < 2) xst[threadIdx.x] = 0u;
    __syncthreads();
    const XcdBarrier xbar = xcd_barrier_post((unsigned*)(ws + WS_BAR), xst);

    ph_adaln_partials(p, smf);
    ph_convert_rg(p);
    ph_convert<1>(p.ab_w_in, 7216, 2048, 7424, WT_IN, smf);
    ph_convert<0>(p.ab_w_out, 2048, 2048, 2048, WT_OUT, smf);
    ph_convert<2>(p.ffn_w_gu, 11264, 2048, 11264, WT_GU, smf);
    ph_convert<0>(p.ffn_w_down, 2048, 5632, 2048, WT_DN, smf);
    grid.sync();
    ph_adaln_reduce(p);
    xcd_barrier(xbar);

    ph_norm(p.ctx, p.x, p.norm_mix_g, MOD, 0, 1, H, 0);
    xcd_barrier(xbar);
    { pg8::Gemm g{H, WT_IN, MTOT, 7424, 2048}; pg8::StaticOrder S; S.init(MTOT, 7424, GD, bid);
      pg8::EpiProj E{PROJ, NP0, 28, G, NG0, NG0, 4}; pg8::gemm_phase<pg8::EpiProj, pg8::StaticOrder>(ldsg, g, S, E); }
    xcd_barrier(xbar);
    ph_l0_prep(p, smf);
    xcd_barrier(xbar);
    ph_l0_prepass(p, lds);
    xcd_barrier(xbar);
    for (int job = vb; job < 256; job += GD) { if (job < 128) mlstm_chunk(p, job, lds); else deltanet_chunk(p, job - 128, lds); }
    xcd_barrier(xbar);
    ph_l0_merge(p);
    xcd_barrier(xbar);
    { pg8::Gemm g{H, WT_OUT, MTOT, 2048, 2048}; pg8::StaticOrder S; S.init(MTOT, 2048, GD, bid);
      pg8::EpiRes E{p.ctx, p.x, XC, p.out, MOD + 2 * 2048, 0}; pg8::gemm_phase<pg8::EpiRes, pg8::StaticOrder>(ldsg, g, S, E); }
    xcd_barrier(xbar);
    ph_norm(XC, p.out, p.norm_ffn_g, MOD, 3, 4, H, 0);
    xcd_barrier(xbar);
    { pg8::Gemm g{H, WT_GU, MTOT, 11264, 2048}; pg8::StaticOrder S; S.init(MTOT, 11264, GD, bid);
      pg8::EpiSwiglu E{PROJ, FH}; pg8::gemm_phase<pg8::EpiSwiglu, pg8::StaticOrder>(ldsg, g, S, E);
    }
    xcd_barrier(xbar);
    { pg8::Gemm g{PROJ, WT_DN, MTOT, 2048, 5632}; pg8::StaticOrder S; S.init(MTOT, 2048, GD, bid);
      pg8::EpiRes E{XC, p.out, XC, p.out, MOD + 5 * 2048, 0}; pg8::gemm_phase<pg8::EpiRes, pg8::StaticOrder>(ldsg, g, S, E); }
    xcd_barrier(xbar);

    const float* MOD1 = MOD + 3 * 12288;
    ph_convert<0>(p.cd_w_in, 5152, 2048, 5376, WT_IN, smf);
    ph_convert<0>(p.cd_w_out, 2048, 2048, 2048, WT_OUT, smf);
    ph_convert<2>(p.ffn_w_gu + (size_t)2048 * 11264, 11264, 2048, 11264, WT_GU, smf);
    ph_convert<0>(p.ffn_w_down + (size_t)5632 * 2048, 2048, 5632, 2048, WT_DN, smf);
    ph_norm(XC, p.out, p.norm_mix_g + 2048, MOD1, 0, 1, H, 0);
    xcd_barrier(xbar);
    { pg8::Gemm g{H, WT_IN, MTOT, 5376, 2048}; pg8::StaticOrder S; S.init(MTOT, 5376, GD, bid);
      pg8::EpiProj E{PROJ, NP1, 20, G, NG1, NG1, 0}; pg8::gemm_phase<pg8::EpiProj, pg8::StaticOrder>(ldsg, g, S, E); }
    xcd_barrier(xbar);
    ph_l1_a(p, lds);
    xcd_barrier(xbar);
    const bool l1_split = (GD >= 200);
    unsigned* rgflag = (unsigned*)(ws + WS_BAR) + 3600;
    for (int job = vb; job < 136; job += GD) {
        if (job < 128) gla_chunk(p, job, lds);
        else { rg_pass_b(p, job - 128);
            __builtin_amdgcn_fence(__ATOMIC_RELEASE, "agent"); asm volatile("s_waitcnt vmcnt(0)" ::: "memory"); __syncthreads();
            if (threadIdx.x == 0) __hip_atomic_fetch_add(rgflag, 1u, __ATOMIC_RELAXED, __HIP_MEMORY_SCOPE_AGENT); }
    }
    if (l1_split && vb >= 136) {
        if (threadIdx.x == 0) { unsigned sp = 0; while (__hip_atomic_load(rgflag, __ATOMIC_RELAXED, __HIP_MEMORY_SCOPE_AGENT) < 8u && ++sp < (1u << 22)) __builtin_amdgcn_s_sleep(4); }
        __syncthreads();
        __builtin_amdgcn_fence(__ATOMIC_ACQUIRE, "agent"); asm volatile("s_waitcnt vmcnt(0)" ::: "memory");
        ph_l1_c(p, lds, 64, L1C_SPLIT, vb - 136, GD - 136, 0);
    }
    xcd_barrier(xbar);
    ph_l1_c(p, lds, l1_split ? L1C_SPLIT : 64, 520 * 8, bid, GD, 1);
    xcd_barrier(xbar);
    { pg8::Gemm g{H + (size_t)512 * 2048, WT_OUT, MLAT, 2048, 2048}; pg8::StaticOrder S; S.init(MLAT, 2048, GD, bid);
      pg8::EpiRes E{XC, p.out, XC, p.out, MOD1 + 2 * 2048, 512}; pg8::gemm_phase<pg8::EpiRes, pg8::StaticOrder>(ldsg, g, S, E); }
    xcd_barrier(xbar);
    ph_norm(XC, p.out, p.norm_ffn_g + 2048, MOD1, 3, 4, H, 512);
    xcd_barrier(xbar);
    { pg8::Gemm g{H + (size_t)512 * 2048, WT_GU, MLAT, 11264, 2048}; pg8::StaticOrder S; S.init(MLAT, 11264, GD, bid);
      pg8::EpiSwiglu E{PROJ, FH}; pg8::gemm_phase<pg8::EpiSwiglu, pg8::StaticOrder>(ldsg, g, S, E);
    }
    xcd_barrier(xbar);
    { pg8::Gemm g{PROJ, WT_DN, MLAT, 2048, 5632}; pg8::StaticOrder S; S.init(MLAT, 2048, GD, bid);
      pg8::EpiRes E{XC, p.out, XC, p.out, MOD1 + 5 * 2048, 512}; pg8::gemm_phase<pg8::EpiRes, pg8::StaticOrder>(ldsg, g, S, E); }
    xcd_barrier(xbar);
    ph_final_norm(p);
}

extern "C" void kernel_launch(void* const* d_in, const int* in_sizes, int n_in, void* d_out, int out_size, void* d_ws, size_t ws_size, hipStream_t stream) {
    static int grid = 0;
    if (grid == 0) {
        if (n_in != 32 || out_size != MLAT * DM || ws_size < WS_END) { fprintf(stderr, "kernel_launch: unexpected shapes (n_in %d out %d ws %zu need %zu)\n", n_in, out_size, ws_size, (size_t)WS_END); grid = -1; return; }
        int dev = 0, cus = 0, per_cu = 0;
        (void)hipGetDevice(&dev);
        (void)hipDeviceGetAttribute(&cus, hipDeviceAttributeMultiprocessorCount, dev);
        if (hipFuncSetAttribute((const void*)hybrid_fwd, hipFuncAttributeMaxDynamicSharedMemorySize, LDS_BYTES) != hipSuccess) { fprintf(stderr, "kernel_launch: hipFuncSetAttribute failed\n"); }
        if (hipOccupancyMaxActiveBlocksPerMultiprocessor(&per_cu, (const void*)hybrid_fwd, NTHR, LDS_BYTES) != hipSuccess || per_cu < 1) { fprintf(stderr, "kernel_launch: occupancy query gave %d\n", per_cu); per_cu = 1; }
        (void)hipGetLastError();
        grid = cus * per_cu;
    }
    if (grid < 0) return;
    Params p{};
    const float** pp = (const float**)&p;
    for (int i = 0; i < 32; ++i) pp[i] = (const float*)d_in[i];
    p.out = (float*)d_out; p.ws = (unsigned char*)d_ws;
    (void)hipMemsetAsync((unsigned char*)d_ws + WS_BAR, 0, 16384, stream);
    void* args[] = {&p};
    hipError_t e = hipLaunchCooperativeKernel((const void*)hybrid_fwd, dim3(grid), dim3(NTHR), args, LDS_BYTES, stream);
    if (e != hipSuccess) fprintf(stderr, "cooperative launch failed: %s (grid %d)\n", hipGetErrorString(e), grid);
}
```

```cpp
#include <hip/hip_runtime.h>
#include <hip/hip_cooperative_groups.h>
#include <cstdio>
namespace cg = cooperative_groups;

typedef unsigned short u16;

constexpr int DM = 2048, FH = 5632, MC = 512, MLAT = 32768, MTOT = 33280, NTHR = 512;
constexpr int NP0 = 7168, NP1 = 5120;
constexpr int NG0 = 48, NG1 = 32;
constexpr int NSEG = 260;

constexpr size_t WS_WT_IN = 0;
constexpr size_t WS_WT_OUT = WS_WT_IN + (size_t)7424 * 2048 * 2;
constexpr size_t WS_WT_GU = WS_WT_OUT + (size_t)2048 * 2048 * 2;
constexpr size_t WS_WT_DN = WS_WT_GU + (size_t)11264 * 2048 * 2;
constexpr size_t WS_H = WS_WT_DN + (size_t)2048 * 5632 * 2;
constexpr size_t WS_PROJ = WS_H + (size_t)MTOT * 2048 * 2;
constexpr size_t WS_OF = WS_PROJ + (size_t)MTOT * 7168 * 2;
constexpr size_t WS_OB = WS_OF + (size_t)MTOT * 2048 * 2;
constexpr size_t WS_XC = WS_OB + (size_t)MTOT * 2048 * 2;
constexpr size_t WS_G = WS_XC + (size_t)MC * 2048 * 4;
constexpr size_t WS_CQ = WS_G + (size_t)MTOT * 48 * 4;
constexpr size_t WS_MODP = WS_CQ + (size_t)MC * 3072 * 2;
constexpr size_t WS_MOD = WS_MODP + (size_t)2 * 32 * 3 * 12288 * 4;
constexpr size_t WS_ATT0 = WS_MOD + (size_t)2 * 3 * 12288 * 4;
constexpr size_t WS_MLS = WS_ATT0 + (size_t)4160 * 4096 * 2;
constexpr size_t WS_GCS = WS_MLS + (size_t)4160 * 256 * 4;
constexpr size_t WS_WRT = WS_GCS + (size_t)8320 * 256 * 4;
constexpr size_t WS_BAR = WS_WRT + (size_t)32 * 16384 * 2;
constexpr size_t WS_END = WS_BAR + 16384;
constexpr size_t WS_TM = WS_H;
constexpr size_t WS_QK = WS_H + (size_t)8320 * 4096 * 2;
constexpr size_t WS_OF1 = WS_OF;
constexpr size_t WS_OB1 = WS_OF + (size_t)MTOT * 1024 * 2;
constexpr size_t WS_QE = WS_OB;
constexpr size_t WS_KDT = WS_QE + (size_t)2 * MTOT * 512 * 2;
constexpr size_t WS_TAIL = WS_PROJ + (size_t)MTOT * 5120 * 2;
constexpr size_t WS_ATT = WS_TAIL;
constexpr size_t WS_VT = WS_ATT + (size_t)4160 * 4096 * 2;
constexpr size_t WS_EBL = WS_VT + (size_t)2080 * 16384 * 2;
constexpr size_t WS_AGG = WS_EBL + (size_t)4160 * 128 * 4;
constexpr size_t WS_CARRY = WS_AGG + (size_t)4 * NSEG * 1024 * 8;
static_assert(WS_CARRY + (size_t)4 * NSEG * 1024 * 4 <= WS_OF, "layer-1 tail overflow");

struct Params {
    const float *x, *c, *ctx, *c_ctx, *mod_w, *mod_b, *norm_mix_g, *norm_ffn_g, *ffn_w_gu, *ffn_w_down, *final_norm_g,
        *ab_w_in, *ab_w_out, *ml_ig_b, *ml_fg_b, *ml_norm_g, *dn_conv_w, *dn_a_log, *dn_dt_bias, *dn_norm_g,
        *cd_w_in, *cd_w_out, *rg_conv_w, *rg_conv_b, *rg_w_r, *rg_b_r, *rg_w_i, *rg_b_i, *rg_lambda, *gla_w_up, *gla_b_up, *gla_norm_g;
    float* out; unsigned char* ws;
};

__device__ __forceinline__ float bf2f(u16 v) { return __uint_as_float(((unsigned)v) << 16); }
typedef __bf16 bf16x2_nat __attribute__((ext_vector_type(2)));
typedef float f32x2_nat __attribute__((ext_vector_type(2)));
__device__ __forceinline__ unsigned cvt_pk_bf16(float lo, float hi) { const f32x2_nat v = {lo, hi}; const bf16x2_nat r = __builtin_convertvector(v, bf16x2_nat); return __builtin_bit_cast(unsigned, r); }
__device__ __forceinline__ u16 f2bf(float f) { return (u16)(cvt_pk_bf16(f, 0.f) & 0xffffu); }
__device__ __forceinline__ void unpack8(const uint4& u, float* f) {
    f[0] = __uint_as_float(u.x << 16); f[1] = __uint_as_float(u.x & 0xffff0000u);
    f[2] = __uint_as_float(u.y << 16); f[3] = __uint_as_float(u.y & 0xffff0000u);
    f[4] = __uint_as_float(u.z << 16); f[5] = __uint_as_float(u.z & 0xffff0000u);
    f[6] = __uint_as_float(u.w << 16); f[7] = __uint_as_float(u.w & 0xffff0000u);
}
__device__ __forceinline__ uint4 pack8(const float* f) { uint4 o; o.x = cvt_pk_bf16(f[0], f[1]); o.y = cvt_pk_bf16(f[2], f[3]); o.z = cvt_pk_bf16(f[4], f[5]); o.w = cvt_pk_bf16(f[6], f[7]); return o; }
template <int CTRL> __device__ __forceinline__ float dppf(float x) { return __int_as_float(__builtin_amdgcn_update_dpp(0, __float_as_int(x), CTRL, 0xF, 0xF, true)); }
__device__ __forceinline__ float red4(float x) { x += dppf<0xB1>(x); x += dppf<0x4E>(x); return x; }
__device__ __forceinline__ float red8(float x) { x = red4(x); x += dppf<0x141>(x); return x; }
__device__ __forceinline__ float red16(float x) { x = red8(x); x += dppf<0x140>(x); return x; }
__device__ __forceinline__ float red64(float x) { x = red16(x); x += __shfl_xor(x, 16); x += __shfl_xor(x, 32); return x; }
__device__ __forceinline__ float frcp(float x) { return __builtin_amdgcn_rcpf(x); }
__device__ __forceinline__ float sigmoidf_(float x) { return frcp(1.f + __expf(-x)); }
__device__ __forceinline__ float siluf_(float x) { return x * frcp(1.f + __expf(-x)); }
__device__ __forceinline__ float softplusf_(float x) { return fmaxf(x, 0.f) + __logf(1.f + __expf(-fabsf(x))); }
__device__ __forceinline__ float logsigmoidf_(float x) { return fminf(x, 0.f) - __logf(1.f + __expf(-fabsf(x))); }
__device__ __forceinline__ float gelu_tanh(float x) { const float u = 0.7978845608028654f * (x + 0.044715f * x * x * x); const float th = 1.f - 2.f * frcp(1.f + __expf(2.f * u)); return 0.5f * x * (1.f + th); }
__device__ __forceinline__ float neg_expm1_small(float x) { float pl = 1.f / 720.f; pl = pl * x + 1.f / 120.f; pl = pl * x + 1.f / 24.f; pl = pl * x + 1.f / 6.f; pl = pl * x + 0.5f; pl = pl * x + 1.f; return -x * pl; }

__device__ __forceinline__ int tid_fresh() { int t = threadIdx.x; asm volatile("" : "+v"(t)); return t; }
namespace pg8 {
#define PG8_LAS __attribute__((address_space(3)))
typedef unsigned short bf16_t;
typedef short bf16x8 __attribute__((ext_vector_type(8)));
typedef float f32x4 __attribute__((ext_vector_type(4)));
typedef unsigned u32x4 __attribute__((ext_vector_type(4)));
constexpr int BM = 256, BK = 64, HALF = 128, HTB = HALF * BK * 2  , STAGE_BYTES = 8 * HTB, NXCD = 8, WGM = 8;

__host__ __device__ __forceinline__ int lds_byte(int r, int c) { const int st = (r >> 4) * 2 + (c >> 5), rr = r & 15, cc = c & 31, ob = rr * 64 + cc * 2; return st * 1024 + (ob ^ (((ob >> 9) & 1) << 5)); }
__host__ __device__ __forceinline__ void stage_rc(int b, int& R, int& C) { const int st = b / 1024, sb = b % 1024, swz = sb ^ (((sb >> 9) & 1) << 5); R = (st >> 1) * 16 + swz / 64; C = (st & 1) * 32 + (swz % 64) / 2; }
__host__ __device__ __forceinline__ int perm32(int rho) { const int n = rho >> 4, i = rho & 15; return 8 * (i >> 2) + 4 * n + (i & 3); }

struct Unit { int pm, pn; };
struct Gemm { const bf16_t* A; const bf16_t* Bt; int M, N, K; };

struct StaticOrder {
    int nM, nN, nwg, G, c;
    __host__ __device__ void init(int M, int N, int G_, int c_) { nM = M / BM; nN = N / BM; nwg = nM * nN; G = G_; c = c_; }
    __host__ __device__ bool next(int i, Unit& u) const {
        const long L = (long)i * G + c; if (L >= nwg) return false;
        int wgid = (int)L; { const int q = nwg / NXCD, r = nwg % NXCD, xcd = wgid % NXCD, off = wgid / NXCD; wgid = (xcd < r ? xcd * (q + 1) : r * (q + 1) + (xcd - r) * q) + off; }
        const int nig = WGM * nN, gid = wgid / nig, fm = gid * WGM, gsz = (nM - fm) < WGM ? (nM - fm) : WGM;
        u.pm = fm + ((wgid % nig) % gsz); u.pn = (wgid % nig) / gsz; return true;
    }
    __device__ __forceinline__ void a_ready(const Unit&) const {}
    __device__ __forceinline__ void done(const Unit&) const {}
};
using ::cvt_pk_bf16;
typedef float f32x2 __attribute__((ext_vector_type(2)));

struct EpiProj {
    static constexpr bool PERM = true, AFTER_DRAIN = false;
    bf16_t* P; int ldp; int n_main; float* G; int ldg; int ng; int perm_tiles;
    __device__ __forceinline__ void operator()(const f32x4 (&acc)[2][2][4][2], const Unit& u, int wr, int wc, int fr, int fq) const {
        const int row0 = u.pm * BM + wr * 64 + fr;
        if (u.pn < perm_tiles) {
#pragma unroll
            for (int ai = 0; ai < 2; ++ai)
#pragma unroll
                for (int m = 0; m < 4; ++m) { bf16_t* rowp = P + (size_t)(u.pm * BM + ai * HALF + wr * 64 + (m * 4 + wc) * 4 + fq) * ldp + u.pn * BM + fr * 8;
#pragma unroll
                    for (int bj = 0; bj < 2; ++bj) { const f32x4 v0 = acc[ai][bj][m][0], v1 = acc[ai][bj][m][1];
                        u32x4 w; w.x = cvt_pk_bf16(v0[0], v0[1]); w.y = cvt_pk_bf16(v0[2], v0[3]); w.z = cvt_pk_bf16(v1[0], v1[1]); w.w = cvt_pk_bf16(v1[2], v1[3]);
                        *(u32x4*)(rowp + bj * HALF) = w; } }
        } else if (u.pn < n_main) {
            const int col0 = u.pn * BM + wc * 32 + 8 * fq;
#pragma unroll
            for (int ai = 0; ai < 2; ++ai)
#pragma unroll
                for (int m = 0; m < 4; ++m) { bf16_t* rowp = P + (size_t)(row0 + ai * HALF + m * 16) * ldp + col0;
#pragma unroll
                    for (int bj = 0; bj < 2; ++bj) { const f32x4 v0 = acc[ai][bj][m][0], v1 = acc[ai][bj][m][1];
                        u32x4 w; w.x = cvt_pk_bf16(v0[0], v0[1]); w.y = cvt_pk_bf16(v0[2], v0[3]); w.z = cvt_pk_bf16(v1[0], v1[1]); w.w = cvt_pk_bf16(v1[2], v1[3]);
                        *(u32x4*)(rowp + bj * HALF) = w; } }
        } else {
            const int c0 = wc * 32 + 8 * fq;
#pragma unroll
            for (int ai = 0; ai < 2; ++ai)
#pragma unroll
                for (int m = 0; m < 4; ++m) { float* rowp = G + (size_t)(row0 + ai * HALF + m * 16) * ldg;
#pragma unroll
                    for (int n = 0; n < 2; ++n)
#pragma unroll
                        for (int j = 0; j < 4; ++j) { const int c = c0 + 4 * n + j; if (c < ng) rowp[c] = acc[ai][0][m][n][j]; } }
        }
    }
};
struct EpiRes {
    static constexpr bool PERM = false, AFTER_DRAIN = false;
    const float* srcC; const float* srcL; float* dstC; float* dstL; const float* gate  ; int row_off;
    __device__ __forceinline__ void operator()(const f32x4 (&acc)[2][2][4][2], const Unit& u, int wr, int wc, int fr, int fq) const {
        const int grow_t = u.pm * BM + row_off;
        const bool isc = grow_t < 512;
        const int mr = isc ? 2 : ((grow_t - 512) >> 14);
        const float* sp = isc ? srcC + (size_t)grow_t * 2048 : srcL + (size_t)(grow_t - 512) * 2048;
        float* dp = isc ? dstC + (size_t)grow_t * 2048 : dstL + (size_t)(grow_t - 512) * 2048;
        const int lrow0 = wr * 64 + fr, col0 = u.pn * BM + wc * 32 + 4 * fq;
        const float* gp = gate + (size_t)mr * 12288 + col0;
        f32x4 gv[2][2];
#pragma unroll
        for (int bj = 0; bj < 2; ++bj)
#pragma unroll
            for (int n = 0; n < 2; ++n) gv[bj][n] = *(const f32x4*)(gp + bj * HALF + n * 16);
#pragma unroll
        for (int ai = 0; ai < 2; ++ai)
#pragma unroll
            for (int m = 0; m < 4; ++m) { const size_t off = (size_t)(lrow0 + ai * HALF + m * 16) * 2048 + col0;
#pragma unroll
                for (int bj = 0; bj < 2; ++bj)
#pragma unroll
                    for (int n = 0; n < 2; ++n) { const f32x4 s = *(const f32x4*)(sp + off + bj * HALF + n * 16);
                        *(f32x4*)(dp + off + bj * HALF + n * 16) = s + gv[bj][n] * acc[ai][bj][m][n]; } }
    }
};
struct EpiSwiglu {
    static constexpr bool PERM = true, AFTER_DRAIN = false;
    bf16_t* O; int ldo;
    __device__ __forceinline__ void operator()(const f32x4 (&acc)[2][2][4][2], const Unit& u, int wr, int wc, int fr, int fq) const {
        const int row0 = u.pm * BM + wr * 64 + fr, col0 = u.pn * HALF + wc * 32 + 8 * fq;
#pragma unroll
        for (int ai = 0; ai < 2; ++ai)
#pragma unroll
            for (int m = 0; m < 4; ++m) { float r[8];
#pragma unroll
                for (int n = 0; n < 2; ++n)
#pragma unroll
                    for (int j = 0; j < 4; ++j) { const float gg = acc[ai][0][m][n][j], uu = acc[ai][1][m][n][j]; r[n * 4 + j] = gg * __builtin_amdgcn_rcpf(1.f + __expf(-gg)) * uu; }
                u32x4 w; w.x = cvt_pk_bf16(r[0], r[1]); w.y = cvt_pk_bf16(r[2], r[3]); w.z = cvt_pk_bf16(r[4], r[5]); w.w = cvt_pk_bf16(r[6], r[7]);
                *(u32x4*)(O + (size_t)(row0 + ai * HALF + m * 16) * ldo + col0) = w; }
    }
};

template <class Epi, class Sched>
__device__ __forceinline__ void gemm_phase(PG8_LAS unsigned char* lds, const Gemm g, const Sched& S, const Epi& E) {
    int tid = threadIdx.x; asm volatile("" : "+v"(tid)); const int wid = __builtin_amdgcn_readfirstlane(tid >> 6), lane = tid & 63, wr = wid >> 2, wc = wid & 3, fr = lane & 15, fq = lane >> 4;
    const int K = g.K, nt = K / BK;
    unsigned voffA[2], voffB[2];
#pragma unroll
    for (int i = 0; i < 2; ++i) { int R, C; stage_rc(tid * 16 + i * 8192, R, C); const int Rb = Epi::PERM ? ((R & ~31) + perm32(R & 31)) : R;
        voffA[i] = (unsigned)(R * K + C) * 2u; voffB[i] = (unsigned)(Rb * K + C) * 2u; }
    const size_t kstep = (size_t)(BK * 2);
    const size_t hstep = (size_t)HALF * K * 2;
    const size_t tstep = 2 * hstep;
    const unsigned ldsw = (unsigned)wid * 1024u;
    const int aoff = lds_byte(wr * 64 + fr, fq * 8), boff = lds_byte(wc * 32 + fr, fq * 8);
#define PG8_SA(b, h) (((b) * 2 + (h)) * HTB)
#define PG8_SB(b, h) ((4 + (b) * 2 + (h)) * HTB)
#define PG8_STAGE(bufoff, gbase, voff) do { _Pragma("unroll") for (int _i = 0; _i < 2; ++_i) \
        __builtin_amdgcn_global_load_lds((const unsigned*)((const char*)(gbase) + (voff)[_i]), (PG8_LAS unsigned*)(lds + (bufoff) + ldsw + _i * 8192), 16, 0, 0); } while (0)
#define PG8_LDA(dst, b, h) do { _Pragma("unroll") for (int m = 0; m < 4; ++m) _Pragma("unroll") for (int k = 0; k < 2; ++k) dst[m][k] = *(const PG8_LAS bf16x8*)(lds + PG8_SA(b, h) + aoff + m * 2048 + k * 1024); } while (0)
#define PG8_LDB(dst, b, h) do { _Pragma("unroll") for (int n = 0; n < 2; ++n) _Pragma("unroll") for (int k = 0; k < 2; ++k) dst[n][k] = *(const PG8_LAS bf16x8*)(lds + PG8_SB(b, h) + boff + n * 2048 + k * 1024); } while (0)
#define PG8_MMA(ai, bj, At, Bt) do { __builtin_amdgcn_s_setprio(1); _Pragma("unroll") for (int m = 0; m < 4; ++m) _Pragma("unroll") for (int n = 0; n < 2; ++n) _Pragma("unroll") for (int k = 0; k < 2; ++k) \
        acc[ai][bj][m][n] = __builtin_amdgcn_mfma_f32_16x16x32_bf16(Bt[n][k], At[m][k], acc[ai][bj][m][n], 0, 0, 0); __builtin_amdgcn_s_setprio(0); } while (0)
#define PG8_WAIT_V(n) asm volatile("s_waitcnt vmcnt(" #n ")" ::: "memory")
#define PG8_WAIT_L(n) asm volatile("s_waitcnt lgkmcnt(" #n ")" ::: "memory")
#define PG8_BAR __builtin_amdgcn_s_barrier()
#define PG8_SCHED __builtin_amdgcn_sched_barrier(0)
    Unit cur, nxt; int ui = 0;
    if (!S.next(0, cur)) return;
    f32x4 acc[2][2][4][2];
#pragma unroll
    for (int a = 0; a < 2; ++a)
#pragma unroll
        for (int b = 0; b < 2; ++b)
#pragma unroll
            for (int m = 0; m < 4; ++m)
#pragma unroll
                for (int n = 0; n < 2; ++n) acc[a][b][m][n] = (f32x4){0.f, 0.f, 0.f, 0.f};
    bf16x8 At[4][2], B0[2][2], B1[2][2];
    const char* cA = (const char*)g.A + (size_t)cur.pm * tstep; const char* cB = (const char*)g.Bt + (size_t)cur.pn * tstep;
    S.a_ready(cur);
    PG8_STAGE(PG8_SB(0, 0), cB, voffB); PG8_STAGE(PG8_SA(0, 0), cA, voffA); PG8_STAGE(PG8_SB(0, 1), cB + hstep, voffB); PG8_STAGE(PG8_SA(0, 1), cA + hstep, voffA);
    if (wr == 1) PG8_BAR;
    PG8_WAIT_V(4); PG8_BAR;
    PG8_STAGE(PG8_SB(1, 0), cB + kstep, voffB); PG8_STAGE(PG8_SA(1, 0), cA + kstep, voffA); PG8_STAGE(PG8_SB(1, 1), cB + hstep + kstep, voffB);
    PG8_WAIT_V(6); PG8_BAR;
    for (;;) {
        const bool has_next = S.next(ui + 1, nxt);
        const char* nA = has_next ? (const char*)g.A + (size_t)nxt.pm * tstep : cA; const char* nB = has_next ? (const char*)g.Bt + (size_t)nxt.pn * tstep : cB;
        for (int t = 0; t < nt; t += 2) {
            const bool last = (t == nt - 2);
            const char* a1 = cA + (size_t)(t + 1) * kstep;
            const char* a2 = last ? nA : cA + (size_t)(t + 2) * kstep; const char* b2 = last ? nB : cB + (size_t)(t + 2) * kstep;
            const char* a3 = a2 + kstep; const char* b3 = b2 + kstep;
            if (last && has_next) S.a_ready(nxt);
            PG8_LDB(B0, 0, 0); PG8_SCHED; PG8_LDA(At, 0, 0); PG8_STAGE(PG8_SA(1, 1), a1 + hstep, voffA);
            PG8_WAIT_L(8); PG8_BAR; PG8_WAIT_L(0); PG8_MMA(0, 0, At, B0); PG8_BAR; PG8_SCHED;
            PG8_LDB(B1, 0, 1); PG8_STAGE(PG8_SB(0, 0), b2, voffB);
            PG8_BAR; PG8_WAIT_L(0); PG8_MMA(0, 1, At, B1); PG8_BAR;
            PG8_LDA(At, 0, 1); PG8_STAGE(PG8_SA(0, 0), a2, voffA);
            PG8_BAR; PG8_WAIT_L(0); PG8_MMA(1, 0, At, B0); PG8_BAR; PG8_SCHED;
            PG8_STAGE(PG8_SB(0, 1), b2 + hstep, voffB);
            PG8_WAIT_V(6); PG8_BAR; PG8_MMA(1, 1, At, B1); PG8_BAR;
            PG8_LDB(B0, 1, 0); PG8_SCHED; PG8_LDA(At, 1, 0); PG8_STAGE(PG8_SA(0, 1), a2 + hstep, voffA);
            PG8_WAIT_L(8); PG8_BAR; PG8_WAIT_L(0); PG8_MMA(0, 0, At, B0); PG8_BAR; PG8_SCHED;
            PG8_LDB(B1, 1, 1); PG8_STAGE(PG8_SB(1, 0), b3, voffB);
            PG8_BAR; PG8_WAIT_L(0); PG8_MMA(0, 1, At, B1); PG8_BAR;
            PG8_LDA(At, 1, 1); PG8_STAGE(PG8_SA(1, 0), a3, voffA);
            PG8_BAR; PG8_WAIT_L(0); PG8_MMA(1, 0, At, B0); PG8_BAR; PG8_SCHED;
            PG8_STAGE(PG8_SB(1, 1), b3 + hstep, voffB);
            PG8_WAIT_V(6); PG8_BAR; PG8_MMA(1, 1, At, B1); PG8_BAR;
        }
        if constexpr (!Epi::AFTER_DRAIN) { E(acc, cur, wr, wc, fr, fq); S.done(cur); }
        if (!has_next) break;
#pragma unroll
        for (int a = 0; a < 2; ++a)
#pragma unroll
            for (int b = 0; b < 2; ++b)
#pragma unroll
                for (int m = 0; m < 4; ++m)
#pragma unroll
                    for (int n = 0; n < 2; ++n) acc[a][b][m][n] = (f32x4){0.f, 0.f, 0.f, 0.f};
        cur = nxt; cA = nA; cB = nB; ++ui;
    }
    PG8_WAIT_V(0);
    if (wr == 0) PG8_BAR;
    PG8_BAR;
    if constexpr (Epi::AFTER_DRAIN) { E.fused(acc, cur, wr, wc, fr, fq, lds, wid, lane); S.done(cur); }
#undef PG8_SA
#undef PG8_SB
#undef PG8_STAGE
#undef PG8_LDA
#undef PG8_LDB
#undef PG8_MMA
#undef PG8_WAIT_V
#undef PG8_WAIT_L
#undef PG8_BAR
#undef PG8_SCHED
}
}

__device__ __forceinline__ void ph_adaln_partials(const Params& p, float* sm) {
    const int tid = tid_fresh();
    float* MODP = (float*)(p.ws + WS_MODP);
    for (int it = blockIdx.x; it < 384; it += gridDim.x) {
        const int l = it / 192, rem = it % 192, kc = rem / 6, cgp = rem % 6;
        __syncthreads();
        if (tid < 192) { const int r = tid >> 6, kk = tid & 63, k = kc * 64 + kk; const float cv = (r < 2) ? p.c[r * 2048 + k] : p.c_ctx[k]; sm[tid] = siluf_(cv); }
        __syncthreads();
        const int col = cgp * 2048 + tid * 4;
        float4 a0 = {0.f, 0.f, 0.f, 0.f}, a1 = a0, a2 = a0;
        const float* wp = p.mod_w + ((size_t)l * 2048 + (size_t)kc * 64) * 12288 + col;
#pragma unroll 8
        for (int kk = 0; kk < 64; ++kk) {
            const float4 w = *(const float4*)(wp + (size_t)kk * 12288);
            const float s0 = sm[kk], s1 = sm[64 + kk], s2 = sm[128 + kk];
            a0.x += s0 * w.x; a0.y += s0 * w.y; a0.z += s0 * w.z; a0.w += s0 * w.w;
            a1.x += s1 * w.x; a1.y += s1 * w.y; a1.z += s1 * w.z; a1.w += s1 * w.w;
            a2.x += s2 * w.x; a2.y += s2 * w.y; a2.z += s2 * w.z; a2.w += s2 * w.w;
        }
        float* o = MODP + ((size_t)(l * 32 + kc) * 3) * 12288 + col;
        *(float4*)(o) = a0; *(float4*)(o + 12288) = a1; *(float4*)(o + 2 * 12288) = a2;
    }
}
__device__ __forceinline__ void ph_adaln_reduce(const Params& p) {
    const float* MODP = (const float*)(p.ws + WS_MODP); float* MOD = (float*)(p.ws + WS_MOD);
    for (int idx = blockIdx.x * NTHR + tid_fresh(); idx < 2 * 3 * 12288; idx += gridDim.x * NTHR) {
        const int l = idx / 36864, r = (idx / 12288) % 3, col = idx % 12288;
        float s = p.mod_b[l * 12288 + col];
        for (int kc = 0; kc < 32; ++kc) s += MODP[((size_t)(l * 32 + kc) * 3 + r) * 12288 + col];
        MOD[idx] = s;
    }
}

template <int MODE> __device__ __forceinline__ int colmap(int n, int nsrc) {
    if (MODE == 0) return n < nsrc ? n : -1;
    if (MODE == 1) { if (n < 3072) return n; if (n < 7168) return n + 16; if (n < 7184) return 3072 + (n - 7168); if (n < 7216) return n; return -1; }
    return ((n >> 7) & 1) * 5632 + (n >> 8) * 128 + (n & 127);
}
template <int MODE> __device__ __forceinline__ void ph_convert(const float* W, int nsrc, int K, int nout, u16* Bt, float* sm) {
    const int tid = tid_fresh(); const int nnt = nout / 64, ntiles = nnt * (K / 64);
    for (int t = blockIdx.x; t < ntiles; t += gridDim.x) {
        const int k0 = (t / nnt) * 64, n0 = (t % nnt) * 64;
        __syncthreads();
#pragma unroll
        for (int i = 0; i < 8; ++i) { const int idx = i * NTHR + tid, kk = idx >> 6, nn = idx & 63; const int src = colmap<MODE>(n0 + nn, nsrc);
            sm[kk * 65 + nn] = src >= 0 ? W[(size_t)(k0 + kk) * nsrc + src] : 0.f; }
        __syncthreads();
        { const int nn = tid >> 3, k8 = (tid & 7) * 8; float v[8];
#pragma unroll
            for (int j = 0; j < 8; ++j) v[j] = sm[(k8 + j) * 65 + nn];
            *(uint4*)(Bt + (size_t)(n0 + nn) * K + k0 + k8) = pack8(v); }
    }
}

__device__ __forceinline__ void ph_norm(const float* srcC, const float* srcL, const float* g, const float* modl, int chunk_sh, int chunk_sc, u16* H, int row_begin) {
    const int tid_ = tid_fresh(); const int lane = tid_ & 63, w = tid_ >> 6;
    for (int row = row_begin + blockIdx.x * 8 + w; row < MTOT; row += gridDim.x * 8) {
        const float* src = row < 512 ? srcC + (size_t)row * 2048 : srcL + (size_t)(row - 512) * 2048;
        const int mr = row < 512 ? 2 : ((row - 512) >> 14);
        const float* sc = modl + (mr * 6 + chunk_sc) * 2048; const float* sh = modl + (mr * 6 + chunk_sh) * 2048;
        float4 v[8]; float ss = 0.f;
#pragma unroll
        for (int i = 0; i < 8; ++i) { v[i] = *(const float4*)(src + i * 256 + lane * 4); ss += v[i].x * v[i].x + v[i].y * v[i].y + v[i].z * v[i].z + v[i].w * v[i].w; }
        ss = red64(ss);
        const float rstd = rsqrtf(ss * (1.f / 2048.f) + 1e-6f);
#pragma unroll
        for (int i = 0; i < 8; ++i) { const int col = i * 256 + lane * 4;
            const float4 g4 = *(const float4*)(g + col), s4 = *(const float4*)(sc + col), h4 = *(const float4*)(sh + col);
            const float y0 = v[i].x * rstd * g4.x * (1.f + s4.x) + h4.x, y1 = v[i].y * rstd * g4.y * (1.f + s4.y) + h4.y;
            const float y2 = v[i].z * rstd * g4.z * (1.f + s4.z) + h4.z, y3 = v[i].w * rstd * g4.w * (1.f + s4.w) + h4.w;
            uint2 o; o.x = cvt_pk_bf16(y0, y1); o.y = cvt_pk_bf16(y2, y3);
            *(uint2*)(H + (size_t)row * 2048 + col) = o; }
    }
}
__device__ __forceinline__ void ph_final_norm(const Params& p) {
    const int tid_ = tid_fresh(); const int lane = tid_ & 63, w = tid_ >> 6;
    for (int row = blockIdx.x * 8 + w; row < MLAT; row += gridDim.x * 8) {
        float* src = p.out + (size_t)row * 2048;
        float4 v[8]; float ss = 0.f;
#pragma unroll
        for (int i = 0; i < 8; ++i) { v[i] = *(const float4*)(src + i * 256 + lane * 4); ss += v[i].x * v[i].x + v[i].y * v[i].y + v[i].z * v[i].z + v[i].w * v[i].w; }
        ss = red64(ss);
        const float rstd = rsqrtf(ss * (1.f / 2048.f) + 1e-6f);
#pragma unroll
        for (int i = 0; i < 8; ++i) { const int col = i * 256 + lane * 4; const float4 g4 = *(const float4*)(p.final_norm_g + col);
            float4 o; o.x = v[i].x * rstd * g4.x; o.y = v[i].y * rstd * g4.y; o.z = v[i].z * rstd * g4.z; o.w = v[i].w * rstd * g4.w;
            *(float4*)(src + col) = o; }
    }
}

__device__ __forceinline__ void ph_l0_prep(const Params& p, float* sm) {
    const int tid = tid_fresh();
    u16* PROJ = (u16*)(p.ws + WS_PROJ); u16* CQ = (u16*)(p.ws + WS_CQ); float* G = (float*)(p.ws + WS_G);
    for (int idx = blockIdx.x * NTHR + tid; idx < MTOT * 48; idx += gridDim.x * NTHR) {
        const int j = idx % 48; const float v = G[idx]; float o;
        if (j < 8) o = v + p.ml_ig_b[j];
        else if (j < 16) o = logsigmoidf_(v + p.ml_fg_b[j - 8]);
        else if (j < 32) { const float dt = softplusf_(v + p.dn_dt_bias[j - 16]); o = -__expf(p.dn_a_log[j - 16]) * dt; }
        else o = sigmoidf_(v);
        G[idx] = o;
    }
    {
        const int NB = (int)gridDim.x;
        const int tk = tid >> 3, cs = (tid & 7) * 16;
        for (int pb = (int)blockIdx.x; pb < (NB < 24 ? 24 : NB); pb += NB) {
        const int part = pb % 24, slot = pb / 24;
        const int nbp = NB >= 24 ? (NB - part + 23) / 24 : 1;
        float wt[5][16];
#pragma unroll
        for (int j = 0; j < 5; ++j)
#pragma unroll
            for (int c4 = 0; c4 < 4; ++c4) { const float4 w4 = *(const float4*)(p.dn_conv_w + j * 3072 + part * 128 + cs + c4 * 4); wt[j][c4 * 4] = w4.x; wt[j][c4 * 4 + 1] = w4.y; wt[j][c4 * 4 + 2] = w4.z; wt[j][c4 * 4 + 3] = w4.w; }
        uint4 in[5][2];
#define L0P_LOAD(TT) do { const int tt_ = (TT); const bool ic_ = tt_ < 8; const int t0_ = ic_ ? (tt_ & 3) * 64 : 0; const int rb_ = ic_ ? (tt_ >> 2) * 256 + t0_ : 512 + (tt_ - 8) * 64; \
            _Pragma("unroll") for (int j = 0; j < 5; ++j) { const int r = tk + j - 2; const bool ok = ic_ ? (t0_ + r >= 0 && t0_ + r < 256) : (r >= 0 && r < 64); \
                in[j][0] = make_uint4(0u, 0u, 0u, 0u); in[j][1] = in[j][0]; \
                if (ok) { const u16* src = PROJ + (size_t)(rb_ + r) * NP0 + 3072 + part * 128 + cs; in[j][0] = *(const uint4*)(src); in[j][1] = *(const uint4*)(src + 8); } } } while (0)
        if (slot < 520) L0P_LOAD(slot);
        for (int tt = slot; tt < 520; tt += nbp) {
            const bool isctx = tt < 8;
            const int t0 = isctx ? (tt & 3) * 64 : 0;
            const int rowbase = isctx ? (tt >> 2) * 256 + t0 : 512 + (tt - 8) * 64;
            float o[16];
#pragma unroll
            for (int c = 0; c < 16; ++c) o[c] = 0.f;
#pragma unroll
            for (int j = 0; j < 5; ++j) { float f[16]; unpack8(in[j][0], f); unpack8(in[j][1], f + 8);
#pragma unroll
                for (int c = 0; c < 16; ++c) o[c] += f[c] * wt[j][c]; }
            if (tt + nbp < 520) L0P_LOAD(tt + nbp);
            float ss = 0.f;
#pragma unroll
            for (int c = 0; c < 16; ++c) { o[c] = siluf_(o[c]); ss += o[c] * o[c]; }
            ss = red8(ss);
            if (part < 16) { const float sc = rsqrtf(ss + 1e-6f);
#pragma unroll
                for (int c = 0; c < 16; ++c) o[c] *= sc; }
            __syncthreads();
            if (part < 16) {
                const int rs = isctx ? 3072 : NP0; u16* tb = isctx ? CQ + (size_t)rowbase * 3072 + part * 128 : PROJ + (size_t)rowbase * NP0 + 3072 + part * 128;
                const int r0 = ((tk >> 4) * 4 + (cs >> 5)) * 4 + ((cs >> 3) & 3);
                *(uint4*)(tb + (size_t)r0 * rs + (tk & 15) * 8) = pack8(o); *(uint4*)(tb + (size_t)(r0 + 1) * rs + (tk & 15) * 8) = pack8(o + 8);
            } else {
                u16* dst = isctx ? CQ + (size_t)(rowbase + tk) * 3072 + part * 128 + cs : PROJ + (size_t)(rowbase + tk) * NP0 + 3072 + part * 128 + cs;
                *(uint4*)(dst) = pack8(o); *(uint4*)(dst + 8) = pack8(o + 8); }
        }
        }
    }
}

__device__ __forceinline__ void ph_l0_merge(const Params& p) {
    const int tid_ = tid_fresh(); const int lane = tid_ & 63, w = tid_ >> 6;
    const u16* PROJ = (const u16*)(p.ws + WS_PROJ); const u16* OF = (const u16*)(p.ws + WS_OF); const u16* OB = (const u16*)(p.ws + WS_OB); u16* Y = (u16*)(p.ws + WS_H);
    for (int row = blockIdx.x * 8 + w; row < MTOT; row += gridDim.x * 8) {
        float o[4][8]; float ss[4];
#pragma unroll
        for (int k = 0; k < 4; ++k) { const int col = (k * 64 + lane) * 8; float a[8], bb[8];
            unpack8(*(const uint4*)(OF + (size_t)row * 2048 + col), a); unpack8(*(const uint4*)(OB + (size_t)row * 2048 + col), bb);
            float s = 0.f;
#pragma unroll
            for (int j = 0; j < 8; ++j) { o[k][j] = a[j] + bb[j]; s += o[k][j] * o[k][j]; }
            s = red16(s);
            if (k < 2) s += __shfl_xor(s, 16);
            ss[k] = s; }
#pragma unroll
        for (int k = 0; k < 4; ++k) { const int col = (k * 64 + lane) * 8; const bool isml = k < 2;
            const float rstd = isml ? rsqrtf(ss[k] * (1.f / 256.f) + 1e-6f) : rsqrtf(ss[k] * (1.f / 128.f) + 1e-6f);
            const u16* gsrc = PROJ + (size_t)row * NP0 + (isml ? 2048 + col : 6144 + (col - 1024));
            const float* gn = isml ? p.ml_norm_g + col : p.dn_norm_g + (col - 1024);
            float gt[8], r[8]; unpack8(*(const uint4*)gsrc, gt);
            const float4 g0 = *(const float4*)gn, g1 = *(const float4*)(gn + 4); const float gg[8] = {g0.x, g0.y, g0.z, g0.w, g1.x, g1.y, g1.z, g1.w};
#pragma unroll
            for (int j = 0; j < 8; ++j) { const float gate = isml ? sigmoidf_(gt[j]) : siluf_(gt[j]); r[j] = o[k][j] * rstd * gg[j] * gate; }
            *(uint4*)(Y + (size_t)row * 2048 + col) = pack8(r); }
    }
}

typedef short bf16x8_t __attribute__((ext_vector_type(8)));
typedef float f32x4_t __attribute__((ext_vector_type(4)));
__device__ __forceinline__ float wave_cumsum(float x, int lane) {
#pragma unroll
    for (int o = 1; o < 64; o <<= 1) { const float t = __shfl_up(x, o); if (lane >= o) x += t; }
    return x; }
__device__ __forceinline__ float wave_cummax(float x, int lane) {
#pragma unroll
    for (int o = 1; o < 64; o <<= 1) { const float t = __shfl_up(x, o); if (lane >= o) x = fmaxf(x, t); }
    return x; }
__device__ __forceinline__ int tile_of(int n, int b, int dir) { if (n < 4) return b * 4 + (dir ? 3 - n : n); const int li = n - 4; return 8 + b * 256 + (dir ? 255 - li : li); }
__device__ __forceinline__ int rowbase_of(int tt) { return tt < 8 ? tt * 64 : 512 + (tt - 8) * 64; }

__device__ __forceinline__ void ml_prep_item(const Params& p, int it, float* wl, int lane) {
    const int h = it & 3, tt = (it >> 2) % 520, z = it / 2080, rowbase = rowbase_of(tt), fr = lane & 15, fq = lane >> 4;
    const u16* PROJ = (const u16*)(p.ws + WS_PROJ); const float* G = (const float*)(p.ws + WS_G);
    float* MLS = (float*)(p.ws + WS_MLS) + (size_t)it * 256; u16* ATT0 = (u16*)(p.ws + WS_ATT0) + (size_t)it * 4096;
    const int tk = z ? 63 - lane : lane, row = rowbase + tk;
    const float ig = G[row * 48 + z * 4 + h], lf = G[row * 48 + 8 + z * 4 + h];
    const float bb = wave_cumsum(lf, lane), gg = ig - bb, cm = wave_cummax(gg, lane);
    const float bL = __shfl(bb, 63), cmL = __shfl(cm, 63);
    MLS[tk] = bb; MLS[64 + tk] = cm; MLS[128 + tk] = __expf(gg - cmL); if (lane == 0) { MLS[192] = bL; MLS[193] = cmL; }
    wl[tk] = gg; wl[64 + tk] = cm;
    bf16x8_t kf[4][4];
#pragma unroll
    for (int rt = 0; rt < 4; ++rt)
#pragma unroll
        for (int ks = 0; ks < 4; ++ks) kf[rt][ks] = *(const bf16x8_t*)(PROJ + (size_t)(rowbase + (rt * 4 + ks) * 4 + fq) * NP0 + 512 + h * 128 + fr * 8);
#pragma unroll 1
    for (int rt = 0; rt < 4; ++rt) {
        bf16x8_t qf[4];
#pragma unroll
        for (int ks = 0; ks < 4; ++ks) qf[ks] = *(const bf16x8_t*)(PROJ + (size_t)(rowbase + (rt * 4 + ks) * 4 + fq) * NP0 + h * 128 + fr * 8);
#pragma unroll
        for (int ct = 0; ct < 4; ++ct) {
            f32x4_t acc = (f32x4_t){0.f, 0.f, 0.f, 0.f};
#pragma unroll
            for (int ks = 0; ks < 4; ++ks) acc = __builtin_amdgcn_mfma_f32_16x16x32_bf16(qf[ks], kf[ct][ks], acc, 0, 0, 0);
            const int s = ct * 16 + fr; const float gs = wl[s];
#pragma unroll
            for (int j = 0; j < 4; ++j) { const int l = rt * 16 + fq * 4 + j; const bool keep = z ? (s >= l) : (s <= l);
                const float e = __expf(fminf(gs - wl[64 + l], 0.f));
                ATT0[(((l >> 4) * 2 + (s >> 5)) * 64 + ((s >> 3) & 3) * 16 + (l & 15)) * 8 + (s & 7)] = f2bf(keep ? acc[j] * 0.08838834764831845f * e : 0.f); }
        }
    }
}
__device__ __forceinline__ void dn_prep_item(const Params& p, int it, float* Ap, int lane) {
    asm volatile("" : "+v"(lane));
    const int h = it & 7, tt = (it >> 3) % 520, z = it / 4160, rowbase = rowbase_of(tt), fr = lane & 15, fq = lane >> 4;
    const bool isctx = tt < 8;
    const u16* qb = isctx ? (const u16*)(p.ws + WS_CQ) + (size_t)rowbase * 3072 + h * 128 : (const u16*)(p.ws + WS_PROJ) + (size_t)rowbase * NP0 + 3072 + h * 128;
    const int rs = isctx ? 3072 : NP0;
    const float* G = (const float*)(p.ws + WS_G);
    float* GCS = (float*)(p.ws + WS_GCS) + (size_t)it * 256; u16* TM = (u16*)(p.ws + WS_TM) + (size_t)it * 4096; u16* QK = (u16*)(p.ws + WS_QK) + (size_t)it * 4096;
    float* gcs = Ap + 4096; float* bes = Ap + 4160;
    const int tk = z ? 63 - lane : lane, row = rowbase + tk;
    const float g = G[row * 48 + 16 + z * 8 + h], be = G[row * 48 + 32 + z * 8 + h];
    const float gc = wave_cumsum(g, lane), gL = __shfl(gc, 63);
    GCS[tk] = __expf(gc); GCS[64 + tk] = be; GCS[128 + tk] = __expf(gL - gc); if (lane == 0) GCS[192] = __expf(gL);
    gcs[tk] = gc; bes[tk] = be;
    bf16x8_t kf[4][4];
#pragma unroll
    for (int rt = 0; rt < 4; ++rt)
#pragma unroll
        for (int ks = 0; ks < 4; ++ks) kf[rt][ks] = *(const bf16x8_t*)(qb + (size_t)((rt * 4 + ks) * 4 + fq) * rs + 1024 + fr * 8);
#pragma unroll 1
    for (int rt = 0; rt < 4; ++rt) {
        bf16x8_t qf[4], ka[4];
#pragma unroll
        for (int ks = 0; ks < 4; ++ks) { qf[ks] = *(const bf16x8_t*)(qb + (size_t)((rt * 4 + ks) * 4 + fq) * rs + fr * 8); ka[ks] = *(const bf16x8_t*)(qb + (size_t)((rt * 4 + ks) * 4 + fq) * rs + 1024 + fr * 8); }
#pragma unroll
        for (int ct = 0; ct < 4; ++ct) {
            f32x4_t ck = (f32x4_t){0.f, 0.f, 0.f, 0.f}, cq = ck;
#pragma unroll
            for (int ks = 0; ks < 4; ++ks) { ck = __builtin_amdgcn_mfma_f32_16x16x32_bf16(ka[ks], kf[ct][ks], ck, 0, 0, 0); cq = __builtin_amdgcn_mfma_f32_16x16x32_bf16(qf[ks], kf[ct][ks], cq, 0, 0, 0); }
            const int s = ct * 16 + fr; const float gs = gcs[s];
#pragma unroll
            for (int j = 0; j < 4; ++j) { const int l = rt * 16 + fq * 4 + j;
                const bool strict = z ? (s > l) : (s < l), incl = z ? (s >= l) : (s <= l);
                const float e = __expf(fminf(gcs[l] - gs, 0.f));
                const int lp = z ? 63 - l : l, sp = z ? 63 - s : s;
                Ap[lp * 64 + sp] = strict ? bes[l] * ck[j] * e : 0.f;
                QK[(((l >> 4) * 2 + (s >> 5)) * 64 + ((s >> 3) & 3) * 16 + (l & 15)) * 8 + (s & 7)] = f2bf(incl ? cq[j] * 0.08838834764831845f * e : 0.f); }
        }
    }
    float T[64];
#pragma unroll
    for (int i = 0; i < 64; ++i) {
        float t = (i == lane) ? 1.f : 0.f;
#pragma unroll
        for (int j4 = 0; j4 < (i + 3) / 4; ++j4) { const float4 a4 = *(const float4*)(Ap + i * 64 + j4 * 4);
            if (j4 * 4 + 0 < i) t -= a4.x * T[j4 * 4 + 0];
            if (j4 * 4 + 1 < i) t -= a4.y * T[j4 * 4 + 1];
            if (j4 * 4 + 2 < i) t -= a4.z * T[j4 * 4 + 2];
            if (j4 * 4 + 3 < i) t -= a4.w * T[j4 * 4 + 3];
            if ((j4 & 7) == 7) asm volatile("" : "+v"(t) :: "memory"); }
        T[i] = t;
        asm volatile("" : "+v"(T[i]) :: "memory");
    }
    const int sc = z ? 63 - lane : lane;
    u16* TMp = TM + ((sc >> 5) * 64 + ((sc >> 3) & 3) * 16) * 8 + (sc & 7);
    if (z) {
#pragma unroll
        for (int i = 0; i < 64; ++i) { const int l = 63 - i; TMp[(l >> 4) * 1024 + (l & 15) * 8] = f2bf(T[i]); }
    } else {
#pragma unroll
        for (int i = 0; i < 64; ++i) { const int l = i; TMp[(l >> 4) * 1024 + (l & 15) * 8] = f2bf(T[i]); }
    }
}
__device__ __forceinline__ void ph_l0_prepass(const Params& p, unsigned char* lds) {
    const int tid = tid_fresh(), lane = tid & 63, w = tid >> 6;
    float* wl = (float*)(lds + (size_t)w * 16896);
    const int gw = blockIdx.x * 8 + w, nw = gridDim.x * 8;
    for (int it = (gw + nw - 128) % nw; it < 4160; it += nw) ml_prep_item(p, it, wl, lane);
    for (int it = gw; it < 8320; it += nw) dn_prep_item(p, it, wl, lane);
}

struct MlFr { bf16x8_t q[4], at[2]; uint4 kr[2]; uint2 vr; float kw, b[4], cm[4], bL, cmL; };
__device__ __forceinline__ void ml_load(MlFr& F, const Params& p, int n, int b, int h, int dir, int e0, int lt, int fr, int fq, int tl, int seg) {
    const int nn = n < NSEG ? n : NSEG - 1;
    const int tt = tile_of(nn, b, dir), it = (dir * 520 + tt) * 4 + h, rowbase = rowbase_of(tt);
    const u16* PROJ = (const u16*)(p.ws + WS_PROJ);
    const u16* Q = PROJ + (size_t)(rowbase + lt * 16 + fq) * NP0 + h * 128 + fr * 8;
    const u16* AT = (const u16*)(p.ws + WS_ATT0) + (size_t)it * 4096 + lt * 1024 + (fq * 16 + fr) * 8;
    const float* MLS = (const float*)(p.ws + WS_MLS) + (size_t)it * 256;
#pragma unroll
    for (int ks = 0; ks < 4; ++ks) F.q[ks] = *(const bf16x8_t*)(Q + (size_t)ks * 4 * NP0);
#pragma unroll
    for (int ks = 0; ks < 2; ++ks) F.at[ks] = *(const bf16x8_t*)(AT + ks * 512);
    const u16* kp = PROJ + (size_t)(rowbase + ((tl >> 4) * 4 + (seg >> 1)) * 4 + (seg & 1) * 2) * NP0 + 512 + h * 128 + (tl & 15) * 8;
    F.kr[0] = *(const uint4*)(kp); F.kr[1] = *(const uint4*)(kp + NP0);
    F.vr = *(const uint2*)(PROJ + (size_t)(rowbase + tl) * NP0 + 1024 + h * 256 + e0 + seg * 4);
    F.kw = MLS[128 + tl];
#pragma unroll
    for (int j = 0; j < 4; ++j) { F.b[j] = MLS[lt * 16 + fq * 4 + j]; F.cm[j] = MLS[64 + lt * 16 + fq * 4 + j]; }
    F.bL = MLS[192]; F.cmL = MLS[193];
}
__device__ __forceinline__ void mlstm_chunk(const Params& p, int job, unsigned char* lds) {
    const int tid = tid_fresh(), lane = tid & 63, w = tid >> 6, fr = lane & 15, fq = lane >> 4;
    const int chain = job >> 3, cgp = job & 7;
    const int b = chain >> 3, h = (chain >> 1) & 3, dir = chain & 1;
    const int e0 = cgp * 32, lt = w >> 1, et = w & 1, dt0 = (w >> 1) * 2, tl = tid & 63, seg = tid >> 6;
    u16* Cl = (u16*)lds;
    u16* Ktw = (u16*)(lds + 17952);
    u16* Vt = (u16*)(lds + 17952 + 18432);
    u16* O = (u16*)(p.ws + (dir ? WS_OB : WS_OF));
    __syncthreads();
    for (int i = tid; i < 17952 / 4; i += NTHR) ((unsigned*)Cl)[i] = 0u;
    __syncthreads();
    f32x4_t Cacc[2], nacc; Cacc[0] = (f32x4_t){0.f, 0.f, 0.f, 0.f}; Cacc[1] = Cacc[0]; nacc = Cacc[0];
    float m_in = 0.f;
    bf16x8_t ones;
#pragma unroll
    for (int j = 0; j < 8; ++j) ones[j] = (short)0x3F80;
    MlFr buf[2];
    ml_load(buf[0], p, 0, b, h, dir, e0, lt, fr, fq, tl, seg); ml_load(buf[1], p, 1, b, h, dir, e0, lt, fr, fq, tl, seg);
    for (int n0 = 0; n0 < NSEG; n0 += 4) {
#pragma unroll
        for (int u = 0; u < 4; ++u) {
            const int n = n0 + u; const int s = u & 1;
            const MlFr& F = buf[s];
            const int tt = tile_of(n, b, dir), rowbase = rowbase_of(tt);
            const u16* Ccur = Cl + (n & 1) * (33 * 136); u16* Cnxt = Cl + ((n + 1) & 1) * (33 * 136);
            { float k[16]; unpack8(F.kr[0], k); unpack8(F.kr[1], k + 8);
#pragma unroll
                for (int c = 0; c < 16; ++c) Ktw[(seg * 16 + c) * 72 + tl] = f2bf(k[c] * F.kw);
                Vt[(seg * 4 + 0) * 72 + tl] = (u16)(F.vr.x & 0xffffu); Vt[(seg * 4 + 1) * 72 + tl] = (u16)(F.vr.x >> 16);
                Vt[(seg * 4 + 2) * 72 + tl] = (u16)(F.vr.y & 0xffffu); Vt[(seg * 4 + 3) * 72 + tl] = (u16)(F.vr.y >> 16); }
            __syncthreads();
            bf16x8_t vt[2];
#pragma unroll
            for (int ks = 0; ks < 2; ++ks) vt[ks] = *(const bf16x8_t*)(Vt + (et * 16 + fr) * 72 + ks * 32 + fq * 8);
            {
                f32x4_t inter = (f32x4_t){0.f, 0.f, 0.f, 0.f}, intra = inter, dinter = inter, dintra = inter;
#pragma unroll
                for (int ks = 0; ks < 4; ++ks) { const bf16x8_t cb = *(const bf16x8_t*)(Ccur + (et * 16 + fr) * 136 + ks * 32 + fq * 8); const bf16x8_t nb = *(const bf16x8_t*)(Ccur + 32 * 136 + ks * 32 + fq * 8);
                    inter = __builtin_amdgcn_mfma_f32_16x16x32_bf16(F.q[ks], cb, inter, 0, 0, 0); dinter = __builtin_amdgcn_mfma_f32_16x16x32_bf16(F.q[ks], nb, dinter, 0, 0, 0); }
#pragma unroll
                for (int ks = 0; ks < 2; ++ks) { intra = __builtin_amdgcn_mfma_f32_16x16x32_bf16(F.at[ks], vt[ks], intra, 0, 0, 0); dintra = __builtin_amdgcn_mfma_f32_16x16x32_bf16(F.at[ks], ones, dintra, 0, 0, 0); }
#pragma unroll
                for (int j = 0; j < 4; ++j) { const float M = fmaxf(F.cm[j], m_in); const float r = __expf(F.cm[j] - M), ei = __expf(m_in - M) * 0.08838834764831845f;
                    const float num = r * intra[j] + ei * inter[j], den = r * dintra[j] + ei * dinter[j];
                    const float hv = num * frcp(fmaxf(fabsf(den), __expf(-(F.b[j] + M))));
                    O[(size_t)(rowbase + lt * 16 + fq * 4 + j) * 2048 + h * 256 + e0 + et * 16 + fr] = f2bf(hv); }
            }
            { const float ML = fmaxf(F.cmL, m_in); const float a = __expf(m_in - ML), sc2 = __expf(F.cmL - ML); m_in = F.bL + ML;
#pragma unroll
                for (int i = 0; i < 2; ++i) { f32x4_t nw = (f32x4_t){0.f, 0.f, 0.f, 0.f};
#pragma unroll
                    for (int ks = 0; ks < 2; ++ks) { const bf16x8_t kb = *(const bf16x8_t*)(Ktw + ((dt0 + i) * 16 + fr) * 72 + ks * 32 + fq * 8); nw = __builtin_amdgcn_mfma_f32_16x16x32_bf16(vt[ks], kb, nw, 0, 0, 0); }
#pragma unroll
                    for (int j = 0; j < 4; ++j) { Cacc[i][j] = a * Cacc[i][j] + sc2 * nw[j]; Cnxt[(et * 16 + fq * 4 + j) * 136 + (dt0 + i) * 16 + fr] = f2bf(Cacc[i][j]); } }
                f32x4_t nw = (f32x4_t){0.f, 0.f, 0.f, 0.f};
#pragma unroll
                for (int ks = 0; ks < 2; ++ks) { const bf16x8_t kb = *(const bf16x8_t*)(Ktw + (w * 16 + fr) * 72 + ks * 32 + fq * 8); nw = __builtin_amdgcn_mfma_f32_16x16x32_bf16(ones, kb, nw, 0, 0, 0); }
                nacc[0] = a * nacc[0] + sc2 * nw[0];
                if (fq == 0) Cnxt[32 * 136 + w * 16 + fr] = f2bf(nacc[0]); }
            __syncthreads();
            ml_load(buf[s], p, n + 2, b, h, dir, e0, lt, fr, fq, tl, seg);
        }
    }
}

struct DnFr { bf16x8_t k[4], q[4], tm[2], qk[2]; uint4 kr[2]; float kds, egc[4], be[4], egL; u16 v[4]; };
__device__ __forceinline__ void dn_load(DnFr& F, const Params& p, int n, int b, int h, int dir, int e0, int lt, int et, int fr, int fq, int tl, int seg) {
    const int nn = n < NSEG ? n : NSEG - 1;
    const int tt = tile_of(nn, b, dir), it = (dir * 520 + tt) * 8 + h, rowbase = rowbase_of(tt);
    const bool isctx = tt < 8;
    const u16* qb = isctx ? (const u16*)(p.ws + WS_CQ) + (size_t)rowbase * 3072 + h * 128 : (const u16*)(p.ws + WS_PROJ) + (size_t)rowbase * NP0 + 3072 + h * 128;
    const int rs = isctx ? 3072 : NP0;
    const u16* TM = (const u16*)(p.ws + WS_TM) + (size_t)it * 4096 + lt * 1024 + (fq * 16 + fr) * 8;
    const u16* QK = (const u16*)(p.ws + WS_QK) + (size_t)it * 4096 + lt * 1024 + (fq * 16 + fr) * 8;
    const float* GCS = (const float*)(p.ws + WS_GCS) + (size_t)it * 256;
    const u16* qr = qb + (size_t)(lt * 16 + fq) * rs + fr * 8;
#pragma unroll
    for (int ks = 0; ks < 4; ++ks) { F.q[ks] = *(const bf16x8_t*)(qr + (size_t)ks * 4 * rs); F.k[ks] = *(const bf16x8_t*)(qr + (size_t)ks * 4 * rs + 1024); }
#pragma unroll
    for (int ks = 0; ks < 2; ++ks) { F.tm[ks] = *(const bf16x8_t*)(TM + ks * 512); F.qk[ks] = *(const bf16x8_t*)(QK + ks * 512); }
    const u16* kp = qb + (size_t)(((tl >> 4) * 4 + (seg >> 1)) * 4 + (seg & 1) * 2) * rs + 1024 + (tl & 15) * 8;
    F.kr[0] = *(const uint4*)(kp); F.kr[1] = *(const uint4*)(kp + rs);
    F.kds = GCS[128 + tl]; F.egL = GCS[192];
#pragma unroll
    for (int j = 0; j < 4; ++j) { const int l = lt * 16 + fq * 4 + j; F.egc[j] = GCS[l]; F.be[j] = GCS[64 + l]; F.v[j] = qb[(size_t)l * rs + 2048 + e0 + et * 16 + fr]; }
}
__device__ __forceinline__ void deltanet_chunk(const Params& p, int job, unsigned char* lds) {
    const int tid = tid_fresh(), lane = tid & 63, w = tid >> 6, fr = lane & 15, fq = lane >> 4;
    const int chain = job >> 2, cgp = job & 3;
    const int b = chain >> 4, h = (chain >> 1) & 7, dir = chain & 1;
    const int e0 = cgp * 32, lt = w >> 1, et = w & 1, dt0 = (w >> 1) * 2, tl = tid & 63, seg = tid >> 6;
    u16* Sl = (u16*)lds;
    u16* Rt = (u16*)(lds + 17408);
    u16* VNt = (u16*)(lds + 17408 + 4608);
    u16* Kdt = (u16*)(lds + 17408 + 9216);
    u16* O = (u16*)(p.ws + (dir ? WS_OB : WS_OF));
    __syncthreads();
    for (int i = tid; i < 17408 / 4; i += NTHR) ((unsigned*)Sl)[i] = 0u;
    __syncthreads();
    f32x4_t Sacc[2]; Sacc[0] = (f32x4_t){0.f, 0.f, 0.f, 0.f}; Sacc[1] = Sacc[0];
    DnFr buf[2];
    dn_load(buf[0], p, 0, b, h, dir, e0, lt, et, fr, fq, tl, seg); dn_load(buf[1], p, 1, b, h, dir, e0, lt, et, fr, fq, tl, seg);
    for (int n0 = 0; n0 < NSEG; n0 += 4) {
#pragma unroll
        for (int u = 0; u < 4; ++u) {
            const int n = n0 + u; const int s = u & 1;
            const DnFr& F = buf[s];
            const int tt = tile_of(n, b, dir), rowbase = rowbase_of(tt);
            const u16* Scur = Sl + (n & 1) * (32 * 136); u16* Snxt = Sl + ((n + 1) & 1) * (32 * 136);
            f32x4_t X = (f32x4_t){0.f, 0.f, 0.f, 0.f}, Y = X;
#pragma unroll
            for (int ks = 0; ks < 4; ++ks) { const bf16x8_t sb = *(const bf16x8_t*)(Scur + (et * 16 + fr) * 136 + ks * 32 + fq * 8);
                X = __builtin_amdgcn_mfma_f32_16x16x32_bf16(F.k[ks], sb, X, 0, 0, 0); Y = __builtin_amdgcn_mfma_f32_16x16x32_bf16(F.q[ks], sb, Y, 0, 0, 0); }
#pragma unroll
            for (int j = 0; j < 4; ++j) Rt[(et * 16 + fr) * 72 + lt * 16 + fq * 4 + j] = f2bf(F.be[j] * (bf2f(F.v[j]) - F.egc[j] * X[j]));
            { float k[16]; unpack8(F.kr[0], k); unpack8(F.kr[1], k + 8);
#pragma unroll
                for (int c = 0; c < 16; ++c) Kdt[(seg * 16 + c) * 72 + tl] = f2bf(k[c] * F.kds); }
            __syncthreads();
            { f32x4_t VN = (f32x4_t){0.f, 0.f, 0.f, 0.f};
#pragma unroll
                for (int ks = 0; ks < 2; ++ks) { const bf16x8_t rb = *(const bf16x8_t*)(Rt + (et * 16 + fr) * 72 + ks * 32 + fq * 8); VN = __builtin_amdgcn_mfma_f32_16x16x32_bf16(F.tm[ks], rb, VN, 0, 0, 0); }
#pragma unroll
                for (int j = 0; j < 4; ++j) VNt[(et * 16 + fr) * 72 + lt * 16 + fq * 4 + j] = f2bf(VN[j]); }
            __syncthreads();
            bf16x8_t vn[2];
#pragma unroll
            for (int ks = 0; ks < 2; ++ks) vn[ks] = *(const bf16x8_t*)(VNt + (et * 16 + fr) * 72 + ks * 32 + fq * 8);
            { f32x4_t acc = (f32x4_t){0.f, 0.f, 0.f, 0.f};
#pragma unroll
                for (int ks = 0; ks < 2; ++ks) acc = __builtin_amdgcn_mfma_f32_16x16x32_bf16(F.qk[ks], vn[ks], acc, 0, 0, 0);
#pragma unroll
                for (int j = 0; j < 4; ++j) O[(size_t)(rowbase + lt * 16 + fq * 4 + j) * 2048 + 1024 + h * 128 + e0 + et * 16 + fr] = f2bf(0.08838834764831845f * F.egc[j] * Y[j] + acc[j]); }
#pragma unroll
            for (int i = 0; i < 2; ++i) { f32x4_t nw = (f32x4_t){0.f, 0.f, 0.f, 0.f};
#pragma unroll
                for (int ks = 0; ks < 2; ++ks) { const bf16x8_t kb = *(const bf16x8_t*)(Kdt + ((dt0 + i) * 16 + fr) * 72 + ks * 32 + fq * 8); nw = __builtin_amdgcn_mfma_f32_16x16x32_bf16(vn[ks], kb, nw, 0, 0, 0); }
#pragma unroll
                for (int j = 0; j < 4; ++j) { Sacc[i][j] = F.egL * Sacc[i][j] + nw[j]; Snxt[(et * 16 + fq * 4 + j) * 136 + (dt0 + i) * 16 + fr] = f2bf(Sacc[i][j]); } }
            __syncthreads();
            dn_load(buf[s], p, n + 2, b, h, dir, e0, lt, et, fr, fq, tl, seg);
        }
    }
}

constexpr int RG_XC = 65536;

__device__ __forceinline__ void ph_convert_rg(const Params& p) {
    u16* WRT = (u16*)(p.ws + WS_WRT);
    for (int idx = blockIdx.x * NTHR + tid_fresh(); idx < 65536; idx += gridDim.x * NTHR) {
        const int k8 = idx & 15, n = (idx >> 4) & 127, mzg = idx >> 11;
        const float* W = (mzg < 16 ? p.rg_w_r : p.rg_w_i) + (size_t)(mzg & 15) * 16384;
        float v[8];
#pragma unroll
        for (int j = 0; j < 8; ++j) v[j] = W[(k8 * 8 + j) * 128 + n];
        *(uint4*)(WRT + (size_t)mzg * 16384 + (((n >> 4) * 4 + (k8 >> 2)) * 64 + (k8 & 3) * 16 + (n & 15)) * 8) = pack8(v);
    }
}
__device__ __forceinline__ int rg_tau(int tt, int z) { if (tt < 8) { const int ci = tt & 3; return z ? 3 - ci : ci; } const int li = (tt - 8) & 255; return 4 + (z ? 255 - li : li); }
__device__ __forceinline__ int rg_batch(int tt) { return tt < 8 ? (tt >> 2) : ((tt - 8) >> 8); }

__device__ __forceinline__ void rg_conv(const Params& p, int tt, int g, unsigned char* lds) {
    const int tid = tid_fresh();
    const u16* PROJ = (const u16*)(p.ws + WS_PROJ);
    u16* XC = (u16*)(lds + RG_XC);
    const bool isctx = tt < 8;
    const int t0 = isctx ? (tt & 3) * 64 : 0;
    const int rowbase = isctx ? (tt >> 2) * 256 + t0 : 512 + (tt - 8) * 64;
    const int tk = tid >> 3, cs = (tid & 7) * 16;
    uint4 in[5][2];
#pragma unroll
    for (int j = 0; j < 5; ++j) { const int r = tk + j - 2;
        const bool ok = isctx ? (t0 + r >= 0 && t0 + r < 256) : (r >= 0 && r < 64);
        in[j][0] = make_uint4(0u, 0u, 0u, 0u); in[j][1] = in[j][0];
        if (ok) { const u16* src = PROJ + (size_t)(rowbase + r) * NP1 + g * 128 + cs; in[j][0] = *(const uint4*)(src); in[j][1] = *(const uint4*)(src + 8); } }
    float o[16];
#pragma unroll
    for (int c4 = 0; c4 < 4; ++c4) { const float4 b4 = *(const float4*)(p.rg_conv_b + g * 128 + cs + c4 * 4); o[c4 * 4] = b4.x; o[c4 * 4 + 1] = b4.y; o[c4 * 4 + 2] = b4.z; o[c4 * 4 + 3] = b4.w; }
#pragma unroll
    for (int j = 0; j < 5; ++j) {
        const float* wr_ = p.rg_conv_w + j * 1024 + g * 128 + cs; float f[16]; unpack8(in[j][0], f); unpack8(in[j][1], f + 8);
#pragma unroll
        for (int c4 = 0; c4 < 4; ++c4) { const float4 w4 = *(const float4*)(wr_ + c4 * 4);
            o[c4 * 4 + 0] += f[c4 * 4 + 0] * w4.x; o[c4 * 4 + 1] += f[c4 * 4 + 1] * w4.y; o[c4 * 4 + 2] += f[c4 * 4 + 2] * w4.z; o[c4 * 4 + 3] += f[c4 * 4 + 3] * w4.w; }
    }
    __syncthreads();
    *(uint4*)(XC + tk * 136 + cs) = pack8(o); *(uint4*)(XC + tk * 136 + cs + 8) = pack8(o + 8);
    __syncthreads();
}
__device__ __forceinline__ void rg_gates_reg(const Params& p, int g, int z, const unsigned char* lds, int rt, int chh, int fr, int fq, float (&av)[4][4], float (&bx)[4][4]) {
    const u16* XC = (const u16*)(lds + RG_XC);
    const u16* WR = (const u16*)(p.ws + WS_WRT) + (size_t)((0 * 2 + z) * 8 + g) * 16384; const u16* WI = (const u16*)(p.ws + WS_WRT) + (size_t)((1 * 2 + z) * 8 + g) * 16384;
    f32x4_t R[4], I[4];
#pragma unroll
    for (int c = 0; c < 4; ++c) { R[c] = (f32x4_t){0.f, 0.f, 0.f, 0.f}; I[c] = (f32x4_t){0.f, 0.f, 0.f, 0.f}; }
#pragma unroll
    for (int ks = 0; ks < 4; ++ks) {
        const bf16x8_t a = *(const bf16x8_t*)(XC + (rt * 16 + fr) * 136 + ks * 32 + fq * 8);
#pragma unroll
        for (int c = 0; c < 4; ++c) { const int fo = (((chh * 4 + c) * 4 + ks) * 64 + fq * 16 + fr) * 8;
            R[c] = __builtin_amdgcn_mfma_f32_16x16x32_bf16(a, *(const bf16x8_t*)(WR + fo), R[c], 0, 0, 0);
            I[c] = __builtin_amdgcn_mfma_f32_16x16x32_bf16(a, *(const bf16x8_t*)(WI + fo), I[c], 0, 0, 0); }
    }
#pragma unroll
    for (int c = 0; c < 4; ++c) {
        const int chl = (chh * 4 + c) * 16 + fr, chg = z * 1024 + g * 128 + chl;
        const float br = p.rg_b_r[chg], bi = p.rg_b_i[chg], sp = softplusf_(-p.rg_lambda[chg]);
#pragma unroll
        for (int j = 0; j < 4; ++j) { const int t = rt * 16 + fq * 4 + j;
            const float r = sigmoidf_(R[c][j] + br), ii = sigmoidf_(I[c][j] + bi);
            const float la = -8.f * r * sp;
            av[c][j] = __expf(la); bx[c][j] = __builtin_amdgcn_sqrtf(neg_expm1_small(2.f * la)) * ii * bf2f(XC[t * 136 + chl]); }
    }
}
__device__ __forceinline__ float2 rg_local(const float (&a)[4], const float (&b)[4], int z) {
    float P = 1.f, H = 0.f;
#pragma unroll
    for (int i = 0; i < 4; ++i) { const int j = z ? 3 - i : i; H = a[j] * H + b[j]; P *= a[j]; }
    return make_float2(P, H);
}
__device__ __forceinline__ void gla_prep_item(const Params& p, int it, unsigned char* lds) {
    const int tid = tid_fresh(), lane = tid & 63, w = tid >> 6, fr = lane & 15, fq = lane >> 4;
    const int h = it & 3, tt = (it >> 2) % 520, z = it / 2080;
    const int rowbase = tt < 8 ? tt * 64 : 512 + (tt - 8) * 64;
    float* LG = (float*)lds;
    u16* QEs = (u16*)(lds + 32768);
    u16* KEs = (u16*)(lds + 32768 + 17408);
    u16* Vs = (u16*)(lds + 32768 + 2 * 17408);
    float* BLs = (float*)(lds + 32768 + 2 * 17408 + 33792);
    const u16* PROJ = (const u16*)(p.ws + WS_PROJ); const float* LR = (const float*)(p.ws + WS_G);
    u16* QE = (u16*)(p.ws + WS_QE); u16* KDT = (u16*)(p.ws + WS_KDT) + (size_t)it * 8192; u16* ATT = (u16*)(p.ws + WS_ATT) + (size_t)it * 4096;
    u16* VT = (u16*)(p.ws + WS_VT); float* EBL = (float*)(p.ws + WS_EBL);
    __syncthreads();
    { float* LRs = (float*)(lds + 32768);
        for (int i = tid; i < 1024; i += NTHR) LRs[i] = LR[(size_t)(rowbase + (i >> 4)) * 32 + z * 16 + (i & 15)];
        __syncthreads();
        const int c = tid & 127, tq = tid >> 7; float wv[16];
#pragma unroll
        for (int r = 0; r < 16; ++r) wv[r] = p.gla_w_up[(z * 16 + r) * 512 + h * 128 + c];
        const float bu = p.gla_b_up[z * 512 + h * 128 + c];
        for (int i = 0; i < 16; ++i) { const int tk = tq * 16 + i; const float4* lr4 = (const float4*)(LRs + tk * 16); float s = bu;
#pragma unroll
            for (int r4 = 0; r4 < 4; ++r4) { const float4 l4 = lr4[r4]; s += l4.x * wv[r4 * 4] + l4.y * wv[r4 * 4 + 1] + l4.z * wv[r4 * 4 + 2] + l4.w * wv[r4 * 4 + 3]; }
            LG[tk * 128 + c] = logsigmoidf_(s) * (1.f / 16.f); } }
    __syncthreads();
    if (tid < 128) { float acc = 0.f;
        for (int i = 0; i < 64; ++i) { const int tk = z ? 63 - i : i; acc += LG[tk * 128 + tid]; LG[tk * 128 + tid] = acc; }
        BLs[tid] = acc; EBL[(size_t)it * 128 + tid] = __expf(acc); }
    __syncthreads();
    { const int tk = tid >> 3, cs = (tid & 7) * 16; const u16* rp = PROJ + (size_t)(rowbase + tk) * NP1;
        float q[16], k[16], qe[16], ke[16];
        unpack8(*(const uint4*)(rp + 2048 + h * 128 + cs), q); unpack8(*(const uint4*)(rp + 2048 + h * 128 + cs + 8), q + 8);
        unpack8(*(const uint4*)(rp + 2560 + h * 128 + cs), k); unpack8(*(const uint4*)(rp + 2560 + h * 128 + cs + 8), k + 8);
#pragma unroll
        for (int c = 0; c < 16; ++c) { const float bb = LG[tk * 128 + cs + c], bl = BLs[cs + c];
            qe[c] = q[c] * 0.08838834764831845f * __expf(bb); ke[c] = k[c] * __expf(-bb);
            { const int d = cs + c; KDT[(((d >> 4) * 2 + (tk >> 5)) * 64 + ((tk >> 3) & 3) * 16 + (d & 15)) * 8 + (tk & 7)] = f2bf(k[c] * __expf(bl - bb)); } }
        const uint4 q0 = pack8(qe), q1 = pack8(qe + 8);
        *(uint4*)(QEs + tk * 136 + cs) = q0; *(uint4*)(QEs + tk * 136 + cs + 8) = q1;
        *(uint4*)(KEs + tk * 136 + cs) = pack8(ke); *(uint4*)(KEs + tk * 136 + cs + 8) = pack8(ke + 8);
        u16* qg = QE + (size_t)it * 8192 + (((tk >> 4) * 4 + (cs >> 5)) * 64 + ((cs >> 3) & 3) * 16 + (tk & 15)) * 8;
        *(uint4*)(qg) = q0; *(uint4*)(qg + 128) = q1; }
    if (z == 0) for (int ch = tid; ch < 2048; ch += NTHR) { const int tk = ch >> 5, c8 = (ch & 31) * 8;
        *(uint4*)(Vs + tk * 264 + c8) = *(const uint4*)(PROJ + (size_t)(rowbase + tk) * NP1 + 3072 + h * 256 + c8); }
    __syncthreads();
    { const int rt = w >> 1;
#pragma unroll
        for (int i = 0; i < 2; ++i) { const int ct = (w & 1) * 2 + i; f32x4_t acc = (f32x4_t){0.f, 0.f, 0.f, 0.f};
#pragma unroll
            for (int ks = 0; ks < 4; ++ks) { const bf16x8_t a = *(const bf16x8_t*)(QEs + (rt * 16 + fr) * 136 + ks * 32 + fq * 8); const bf16x8_t bb = *(const bf16x8_t*)(KEs + (ct * 16 + fr) * 136 + ks * 32 + fq * 8);
                acc = __builtin_amdgcn_mfma_f32_16x16x32_bf16(a, bb, acc, 0, 0, 0); }
#pragma unroll
            for (int j = 0; j < 4; ++j) { const int l = rt * 16 + fq * 4 + j, s = ct * 16 + fr; const bool keep = z ? (s >= l) : (s <= l);
                ATT[(((l >> 4) * 2 + (s >> 5)) * 64 + ((s >> 3) & 3) * 16 + (l & 15)) * 8 + (s & 7)] = f2bf(keep ? acc[j] : 0.f); } } }
    if (z == 0) { const int e = tid >> 1, hf = tid & 1; u16* dst = VT + (size_t)(tt * 4 + h) * 16384 + (((e >> 4) * 2 + hf) * 64 + (e & 15)) * 8;
#pragma unroll
        for (int l8 = 0; l8 < 4; ++l8) { float v[8];
#pragma unroll
            for (int j = 0; j < 8; ++j) v[j] = bf2f(Vs[(hf * 32 + l8 * 8 + j) * 264 + e]);
            *(uint4*)(dst + l8 * 128) = pack8(v); } }
}
__device__ __forceinline__ void ph_l1_a(const Params& p, unsigned char* lds, int parts = 3) {
    const int tid = tid_fresh(), lane = tid & 63, w = tid >> 6, rt = w >> 1, chh = w & 1, fr = lane & 15, fq = lane >> 4;
    float2* AGG = (float2*)(p.ws + WS_AGG);
    float2* AG = (float2*)lds;
    if (parts & 1) for (int t = blockIdx.x; t < 520 * 8; t += gridDim.x) {
        const int tt = t >> 3, g = t & 7, b = rg_batch(tt);
        rg_conv(p, tt, g, lds);
#pragma unroll
        for (int z = 0; z < 2; ++z) {
            float av[4][4], bx[4][4];
            rg_gates_reg(p, g, z, lds, rt, chh, fr, fq, av, bx);
#pragma unroll
            for (int c = 0; c < 4; ++c) AG[(z * 16 + rt * 4 + fq) * 128 + (chh * 4 + c) * 16 + fr] = rg_local(av[c], bx[c], z);
        }
        __syncthreads();
        if (tid < 256) { const int z = tid >> 7, ch = tid & 127; float P = 1.f, H = 0.f;
#pragma unroll
            for (int s = 0; s < 16; ++s) { const int gi = z ? 15 - s : s; const float2 ph = AG[(z * 16 + gi) * 128 + ch]; H = ph.x * H + ph.y; P *= ph.x; }
            AGG[((size_t)(b * 2 + z) * NSEG + rg_tau(tt, z)) * 1024 + g * 128 + ch] = make_float2(P, H); }
    }
    if (parts & 2) for (int it = blockIdx.x; it < 4160; it += gridDim.x) gla_prep_item(p, it, lds);
}
__device__ __forceinline__ void rg_pass_b(const Params& p, int job) {
    const float2* __restrict__ AGG = (const float2*)(p.ws + WS_AGG); float* __restrict__ CARRY = (float*)(p.ws + WS_CARRY);
    const int bz = job >> 1, ch = (job & 1) * 512 + tid_fresh();
    float carry = 0.f;
    for (int t0 = 0; t0 < NSEG; t0 += 20) {
        float2 ph[20];
#pragma unroll
        for (int i = 0; i < 20; ++i) ph[i] = AGG[((size_t)bz * NSEG + t0 + i) * 1024 + ch];
#pragma unroll
        for (int i = 0; i < 20; ++i) { CARRY[((size_t)bz * NSEG + t0 + i) * 1024 + ch] = carry; carry = ph[i].x * carry + ph[i].y; }
    }
}
struct GlaFr { bf16x8_t qe[4], at[2], vt[2], kd[2][2]; float eb[2]; };
struct GlaOff { int qe, at, vt, kd, eb, o; };
__device__ __forceinline__ void gla_load(GlaFr& F, const unsigned char* ws, int n, int b, int h, int dir, const GlaOff& o) {
    const int nn = n < NSEG ? n : NSEG - 1;
    const int tt = tile_of(nn, b, dir), it = (dir * 520 + tt) * 4 + h, rowbase = rowbase_of(tt);
    const u16* QE = (const u16*)(ws + WS_QE) + (size_t)it * 8192;
    const u16* AT = (const u16*)(ws + WS_ATT) + (size_t)it * 4096;
    const u16* VT = (const u16*)(ws + WS_VT) + (size_t)(tt * 4 + h) * 16384;
    const u16* KD = (const u16*)(ws + WS_KDT) + (size_t)it * 8192;
    const float* EB = (const float*)(ws + WS_EBL) + (size_t)it * 128;
#pragma unroll
    for (int ks = 0; ks < 4; ++ks) F.qe[ks] = *(const bf16x8_t*)(QE + o.qe + ks * 512);
#pragma unroll
    for (int ks = 0; ks < 2; ++ks) { F.at[ks] = *(const bf16x8_t*)(AT + o.at + ks * 512); F.vt[ks] = *(const bf16x8_t*)(VT + o.vt + ks * 512);
        F.kd[0][ks] = *(const bf16x8_t*)(KD + o.kd + ks * 512); F.kd[1][ks] = *(const bf16x8_t*)(KD + o.kd + 1024 + ks * 512); }
    F.eb[0] = EB[o.eb]; F.eb[1] = EB[o.eb + 16];
}
__device__ __forceinline__ void gla_chunk(const Params& p, int job, unsigned char* lds) {
    const int tid = tid_fresh(), lane = tid & 63, w = __builtin_amdgcn_readfirstlane(tid >> 6), fr = lane & 15, fq = lane >> 4;
    const int chain = job >> 3, cgp = job & 7;
    const int b = chain >> 3, h = (chain >> 1) & 3, dir = chain & 1;
    const int e0 = cgp * 32, lt = w >> 1, et = w & 1, dt0 = (w >> 1) * 2;
    const unsigned char* ws = p.ws;
    GlaOff o;
    o.qe = lt * 2048 + lane * 8; o.at = lt * 1024 + lane * 8; o.vt = ((e0 >> 4) + et) * 1024 + lane * 8;
    o.kd = dt0 * 1024 + lane * 8; o.eb = dt0 * 16 + fr; o.o = (lt * 16 + fq * 4) * 1024 + h * 256 + e0 + et * 16 + fr;
    u16* Sl = (u16*)lds;
    u16* O = (u16*)(p.ws + (dir ? WS_OB1 : WS_OF1));
    const int sRd = (et * 16 + fr) * 136 + fq * 8, sWr = (et * 16 + fq * 4) * 136 + dt0 * 16 + fr;
    __syncthreads();
    for (int i = tid; i < 2 * 32 * 136 / 2; i += NTHR) ((unsigned*)Sl)[i] = 0u;
    __syncthreads();
    f32x4_t Sacc[2]; Sacc[0] = (f32x4_t){0.f, 0.f, 0.f, 0.f}; Sacc[1] = Sacc[0];
    GlaFr buf[2];
    gla_load(buf[0], ws, 0, b, h, dir, o); gla_load(buf[1], ws, 1, b, h, dir, o);
    for (int n0 = 0; n0 < NSEG; n0 += 4) {
#pragma unroll
        for (int u = 0; u < 4; ++u) {
            const int n = n0 + u; const int s = u & 1;
            const GlaFr& F = buf[s];
            const u16* Scur = Sl + (n & 1) * (32 * 136); u16* Snxt = Sl + ((n + 1) & 1) * (32 * 136);
            if (n >= 4) {
                const int tt = tile_of(n, b, dir);
                u16* Ou = O + (size_t)(512 + (tt - 8) * 64) * 1024;
                f32x4_t acc = (f32x4_t){0.f, 0.f, 0.f, 0.f};
#pragma unroll
                for (int ks = 0; ks < 4; ++ks) { const bf16x8_t bb = *(const bf16x8_t*)(Scur + sRd + ks * 32); acc = __builtin_amdgcn_mfma_f32_16x16x32_bf16(F.qe[ks], bb, acc, 0, 0, 0); }
#pragma unroll
                for (int ks = 0; ks < 2; ++ks) acc = __builtin_amdgcn_mfma_f32_16x16x32_bf16(F.at[ks], F.vt[ks], acc, 0, 0, 0);
#pragma unroll
                for (int j = 0; j < 4; ++j) Ou[o.o + j * 1024] = f2bf(acc[j]);
            }
#pragma unroll
            for (int i = 0; i < 2; ++i) { f32x4_t nw = (f32x4_t){0.f, 0.f, 0.f, 0.f};
#pragma unroll
                for (int ks = 0; ks < 2; ++ks) nw = __builtin_amdgcn_mfma_f32_16x16x32_bf16(F.vt[ks], F.kd[i][ks], nw, 0, 0, 0);
#pragma unroll
                for (int j = 0; j < 4; ++j) { Sacc[i][j] = F.eb[i] * Sacc[i][j] + nw[j]; Snxt[sWr + j * 136 + i * 16] = f2bf(Sacc[i][j]); } }
            __syncthreads();
            gla_load(buf[s], ws, n + 2, b, h, dir, o);
        }
    }
}
__device__ __forceinline__ void ph_l1_c(const Params& p, unsigned char* lds, int t_lo, int t_hi, int first, int stride, int do_merge) {
    const int tid = tid_fresh(), rt = (tid >> 6) >> 1, chh = (tid >> 6) & 1, fr = tid & 15, fq = (tid & 63) >> 4;
    const u16* PROJ = (const u16*)(p.ws + WS_PROJ); const float* CARRY = (const float*)(p.ws + WS_CARRY); u16* Y = (u16*)(p.ws + WS_H);
    float2* AG = (float2*)lds;
    float* CIN = (float*)(lds + 32768);
    for (int t = t_lo + first; t < t_hi; t += stride) {
        const int tt = t >> 3, g = t & 7, b = rg_batch(tt);
        const int rowbase = 512 + (tt - 8) * 64;
        rg_conv(p, tt, g, lds);
        u16 grv[4][4];
#pragma unroll
        for (int c = 0; c < 4; ++c)
#pragma unroll
            for (int j = 0; j < 4; ++j) grv[c][j] = PROJ[(size_t)(rowbase + rt * 16 + fq * 4 + j) * NP1 + 1024 + g * 128 + (chh * 4 + c) * 16 + fr];
        float av[2][4][4], bx[2][4][4];
#pragma unroll
        for (int z = 0; z < 2; ++z) {
            rg_gates_reg(p, g, z, lds, rt, chh, fr, fq, av[z], bx[z]);
#pragma unroll
            for (int c = 0; c < 4; ++c) AG[(z * 16 + rt * 4 + fq) * 128 + (chh * 4 + c) * 16 + fr] = rg_local(av[z][c], bx[z][c], z);
        }
        __syncthreads();
        if (tid < 256) { const int z = tid >> 7, ch = tid & 127; float h = CARRY[((size_t)(b * 2 + z) * NSEG + rg_tau(tt, z)) * 1024 + g * 128 + ch];
#pragma unroll
            for (int s = 0; s < 16; ++s) { const int gi = z ? 15 - s : s; CIN[(z * 16 + gi) * 128 + ch] = h; const float2 ph = AG[(z * 16 + gi) * 128 + ch]; h = ph.x * h + ph.y; } }
        __syncthreads();
#pragma unroll
        for (int c = 0; c < 4; ++c) { const int chl = (chh * 4 + c) * 16 + fr; float hs[4];
            { float h = CIN[(0 * 16 + rt * 4 + fq) * 128 + chl];
#pragma unroll
                for (int j = 0; j < 4; ++j) { h = av[0][c][j] * h + bx[0][c][j]; hs[j] = h; } }
            { float h = CIN[(1 * 16 + rt * 4 + fq) * 128 + chl];
#pragma unroll
                for (int j = 3; j >= 0; --j) { h = av[1][c][j] * h + bx[1][c][j]; hs[j] += h; } }
#pragma unroll
            for (int j = 0; j < 4; ++j) Y[(size_t)(rowbase + rt * 16 + fq * 4 + j) * 2048 + g * 128 + chl] = f2bf(gelu_tanh(bf2f(grv[c][j])) * hs[j]); }
    }
    const int lane = tid & 63, w = tid >> 6;
    const u16* OF = (const u16*)(p.ws + WS_OF1); const u16* OB = (const u16*)(p.ws + WS_OB1);
    if (do_merge) for (int row = 512 + blockIdx.x * 8 + w; row < MTOT; row += gridDim.x * 8) {
        float o[2][8], ssq[2];
#pragma unroll
        for (int k = 0; k < 2; ++k) { const int col = (k * 64 + lane) * 8; float a[8], bb[8];
            unpack8(*(const uint4*)(OF + (size_t)row * 1024 + col), a); unpack8(*(const uint4*)(OB + (size_t)row * 1024 + col), bb);
            float s = 0.f;
#pragma unroll
            for (int j = 0; j < 8; ++j) { o[k][j] = a[j] + bb[j]; s += o[k][j] * o[k][j]; }
            s = red16(s); s += __shfl_xor(s, 16); ssq[k] = s; }
#pragma unroll
        for (int k = 0; k < 2; ++k) { const int col = (k * 64 + lane) * 8; const float rstd = rsqrtf(ssq[k] * (1.f / 256.f) + 1e-6f);
            float gt[8], r[8]; unpack8(*(const uint4*)(PROJ + (size_t)row * NP1 + 4096 + col), gt);
            const float4 g0 = *(const float4*)(p.gla_norm_g + col), g1 = *(const float4*)(p.gla_norm_g + col + 4); const float gg[8] = {g0.x, g0.y, g0.z, g0.w, g1.x, g1.y, g1.z, g1.w};
#pragma unroll
            for (int j = 0; j < 8; ++j) r[j] = o[k][j] * rstd * gg[j] * siluf_(gt[j]);
            *(uint4*)(Y + (size_t)row * 2048 + 1024 + col) = pack8(r); }
    }
}

#define XB_TMO      128
#define XB_XCNT(j)  (256  + 64 * (j))
#define XB_XSUB(j)  (1280 + 64 * (j))
#define XB_XGEN(j)  (2304 + 64 * (j))
#define XB_TOP      3328
#define XB_TOPGEN   3392
#define XCD_BAR_WORDS 3456
#define XB_SPIN_CAP (1u << 18)
#define XLAS __attribute__((address_space(3)))

__device__ __forceinline__ unsigned xb_ld(unsigned* p)              { return __hip_atomic_load(p, __ATOMIC_RELAXED, __HIP_MEMORY_SCOPE_AGENT); }
__device__ __forceinline__ unsigned xb_add(unsigned* p, unsigned v) { return __hip_atomic_fetch_add(p, v, __ATOMIC_RELAXED, __HIP_MEMORY_SCOPE_AGENT); }
__device__ __forceinline__ unsigned xb_xcc_id() { return (unsigned)__builtin_amdgcn_s_getreg((3 << 11) | 20) & 0xFu; }
#define XB_SPIN(cond, bar) do { unsigned _sp = 0; while (cond) { __builtin_amdgcn_s_sleep(1); \
    if ((++_sp & 255u) == 0u) { if (xb_ld(&(bar)[XB_TMO])) break; if (_sp > XB_SPIN_CAP) { atomicAdd(&(bar)[XB_TMO], 1u); break; } } } } while (0)

struct XcdBarrier {
    unsigned* bar; unsigned x;
    volatile XLAS unsigned* st;
};

__device__ __forceinline__ XcdBarrier xcd_barrier_post(unsigned* bar, volatile XLAS unsigned* st) {
    XcdBarrier b; b.bar = bar; b.x = xb_xcc_id(); b.st = st;
    if (threadIdx.x == 0) (void)xb_add(&bar[XB_XCNT(b.x)], 1u);
    return b;
}
__device__ __forceinline__ void xcd_barrier_complete(unsigned* bar, unsigned x, unsigned& nloc, unsigned& nx) {
    const unsigned G = gridDim.x * gridDim.y * gridDim.z;
    unsigned sum, cnt, mine, sp = 0u;
    for (;;) {
        sum = 0u; cnt = 0u; mine = 0u;
#pragma unroll
        for (unsigned j = 0; j < 16; ++j) { const unsigned c = xb_ld(&bar[XB_XCNT(j)]); sum += c; cnt += (c > 0u) ? 1u : 0u; mine = (j == x) ? c : mine; }
        if (sum == G) break;
        __builtin_amdgcn_s_sleep(1);
        if ((++sp & 255u) == 0u) { if (xb_ld(&bar[XB_TMO])) break; if (sp > XB_SPIN_CAP) { atomicAdd(&bar[XB_TMO], 1u); break; } }
    }
    nloc = mine > 0u ? mine : 1u; nx = cnt > 0u ? cnt : 1u;
}

__device__ __forceinline__ void xcd_barrier(const XcdBarrier& b) {
    asm volatile("s_waitcnt vmcnt(0)" ::: "memory");
    __syncthreads();
    if (threadIdx.x == 0) {
        unsigned* bar = b.bar;
        __builtin_amdgcn_s_waitcnt(0);
        unsigned nloc = b.st[0], nx = b.st[1];
        if (nloc == 0u) { xcd_barrier_complete(bar, b.x, nloc, nx); b.st[0] = nloc; b.st[1] = nx; }
        const unsigned old = xb_add(&bar[XB_XSUB(b.x)], 1u);
        const unsigned gen = old / nloc;
        if (old + 1u == (gen + 1u) * nloc) {
            __builtin_amdgcn_fence(__ATOMIC_RELEASE, "agent");
            asm volatile("s_waitcnt vmcnt(0)" ::: "memory");
            const unsigned og = xb_add(&bar[XB_TOP], 1u);
            const unsigned tg = og / nx;
            if (og + 1u == (tg + 1u) * nx) xb_add(&bar[XB_TOPGEN], 1u);
            else XB_SPIN(xb_ld(&bar[XB_TOPGEN]) == tg, bar);
            __builtin_amdgcn_fence(__ATOMIC_ACQUIRE, "agent");
            xb_add(&bar[XB_XGEN(b.x)], 1u);
            asm volatile("s_waitcnt vmcnt(0)" ::: "memory");
        } else {
            XB_SPIN(xb_ld(&bar[XB_XGEN(b.x)]) == gen, bar);
            __builtin_amdgcn_fence(__ATOMIC_ACQUIRE, "agent");
            asm volatile("s_waitcnt vmcnt(0)" ::: "memory");
        }
    }
    __syncthreads();
}

constexpr int LDS_BYTES = 135168 + 16;
constexpr int L1C_SPLIT = 64 + 3072;

__global__ void __launch_bounds__(NTHR, 2) hybrid_fwd(Params p) {
    extern __shared__ __attribute__((aligned(16))) unsigned char lds[];
    cg::grid_group grid = cg::this_grid();
    float* smf = (float*)lds;
    PG8_LAS unsigned char* ldsg = (PG8_LAS unsigned char*)lds;
    unsigned char* ws = p.ws;
    u16* WT_IN = (u16*)(ws + WS_WT_IN); u16* WT_OUT = (u16*)(ws + WS_WT_OUT); u16* WT_GU = (u16*)(ws + WS_WT_GU); u16* WT_DN = (u16*)(ws + WS_WT_DN);
    u16* H = (u16*)(ws + WS_H); u16* PROJ = (u16*)(ws + WS_PROJ); float* XC = (float*)(ws + WS_XC); float* G = (float*)(ws + WS_G);
    const float* MOD = (const float*)(ws + WS_MOD);
    const int GD = (int)gridDim.x, bid = (int)blockIdx.x;
    const int vb = (GD % 8 == 0) ? (bid % 8) * (GD / 8) + bid / 8 : bid;
    volatile XLAS unsigned* xst = (volatile XLAS unsigned*)((PG8_LAS unsigned char*)lds + 135168);
    if (threadIdx.x < 2) xst[threadIdx.x] = 0u;
    __syncthreads();
    const XcdBarrier xbar = xcd_barrier_post((unsigned*)(ws + WS_BAR), xst);

    ph_adaln_partials(p, smf);
    ph_convert_rg(p);
    ph_convert<1>(p.ab_w_in, 7216, 2048, 7424, WT_IN, smf);
    ph_convert<0>(p.ab_w_out, 2048, 2048, 2048, WT_OUT, smf);
    ph_convert<2>(p.ffn_w_gu, 11264, 2048, 11264, WT_GU, smf);
    ph_convert<0>(p.ffn_w_down, 2048, 5632, 2048, WT_DN, smf);
    grid.sync();
    ph_adaln_reduce(p);
    xcd_barrier(xbar);

    ph_norm(p.ctx, p.x, p.norm_mix_g, MOD, 0, 1, H, 0);
    xcd_barrier(xbar);
    { pg8::Gemm g{H, WT_IN, MTOT, 7424, 2048}; pg8::StaticOrder S; S.init(MTOT, 7424, GD, bid);
      pg8::EpiProj E{PROJ, NP0, 28, G, NG0, NG0, 4}; pg8::gemm_phase<pg8::EpiProj, pg8::StaticOrder>(ldsg, g, S, E); }
    xcd_barrier(xbar);
    ph_l0_prep(p, smf);
    xcd_barrier(xbar);
    ph_l0_prepass(p, lds);
    xcd_barrier(xbar);
    for (int job = vb; job < 256; job += GD) { if (job < 128) mlstm_chunk(p, job, lds); else deltanet_chunk(p, job - 128, lds); }
    xcd_barrier(xbar);
    ph_l0_merge(p);
    xcd_barrier(xbar);
    { pg8::Gemm g{H, WT_OUT, MTOT, 2048, 2048}; pg8::StaticOrder S; S.init(MTOT, 2048, GD, bid);
      pg8::EpiRes E{p.ctx, p.x, XC, p.out, MOD + 2 * 2048, 0}; pg8::gemm_phase<pg8::EpiRes, pg8::StaticOrder>(ldsg, g, S, E); }
    xcd_barrier(xbar);
    ph_norm(XC, p.out, p.norm_ffn_g, MOD, 3, 4, H, 0);
    xcd_barrier(xbar);
    { pg8::Gemm g{H, WT_GU, MTOT, 11264, 2048}; pg8::StaticOrder S; S.init(MTOT, 11264, GD, bid);
      pg8::EpiSwiglu E{PROJ, FH}; pg8::gemm_phase<pg8::EpiSwiglu, pg8::StaticOrder>(ldsg, g, S, E);
    }
    xcd_barrier(xbar);
    { pg8::Gemm g{PROJ, WT_DN, MTOT, 2048, 5632}; pg8::StaticOrder S; S.init(MTOT, 2048, GD, bid);
      pg8::EpiRes E{XC, p.out, XC, p.out, MOD + 5 * 2048, 0}; pg8::gemm_phase<pg8::EpiRes, pg8::StaticOrder>(ldsg, g, S, E); }
    xcd_barrier(xbar);

    const float* MOD1 = MOD + 3 * 12288;
    ph_convert<0>(p.cd_w_in, 5152, 2048, 5376, WT_IN, smf);
    ph_convert<0>(p.cd_w_out, 2048, 2048, 2048, WT_OUT, smf);
    ph_convert<2>(p.ffn_w_gu + (size_t)2048 * 11264, 11264, 2048, 11264, WT_GU, smf);
    ph_convert<0>(p.ffn_w_down + (size_t)5632 * 2048, 2048, 5632, 2048, WT_DN, smf);
    ph_norm(XC, p.out, p.norm_mix_g + 2048, MOD1, 0, 1, H, 0);
    xcd_barrier(xbar);
    { pg8::Gemm g{H, WT_IN, MTOT, 5376, 2048}; pg8::StaticOrder S; S.init(MTOT, 5376, GD, bid);
      pg8::EpiProj E{PROJ, NP1, 20, G, NG1, NG1, 0}; pg8::gemm_phase<pg8::EpiProj, pg8::StaticOrder>(ldsg, g, S, E); }
    xcd_barrier(xbar);
    ph_l1_a(p, lds);
    xcd_barrier(xbar);
    const bool l1_split = (GD >= 200);
    unsigned* rgflag = (unsigned*)(ws + WS_BAR) + 3600;
    for (int job = vb; job < 136; job += GD) {
        if (job < 128) gla_chunk(p, job, lds);
        else { rg_pass_b(p, job - 128);
            __builtin_amdgcn_fence(__ATOMIC_RELEASE, "agent"); asm volatile("s_waitcnt vmcnt(0)" ::: "memory"); __syncthreads();
            if (threadIdx.x == 0) __hip_atomic_fetch_add(rgflag, 1u, __ATOMIC_RELAXED, __HIP_MEMORY_SCOPE_AGENT); }
    }
    if (l1_split && vb >= 136) {
        if (threadIdx.x == 0) { unsigned sp = 0; while (__hip_atomic_load(rgflag, __ATOMIC_RELAXED, __HIP_MEMORY_SCOPE_AGENT) < 8u && ++sp < (1u << 22)) __builtin_amdgcn_s_sleep(4); }
        __syncthreads();
        __builtin_amdgcn_fence(__ATOMIC_ACQUIRE, "agent"); asm volatile("s_waitcnt vmcnt(0)" ::: "memory");
        ph_l1_c(p, lds, 64, L1C_SPLIT, vb - 136, GD - 136, 0);
    }
    xcd_barrier(xbar);
    ph_l1_c(p, lds, l1_split ? L1C_SPLIT : 64, 520 * 8, bid, GD, 1);
    xcd_barrier(xbar);
    { pg8::Gemm g{H + (size_t)512 * 2048, WT_OUT, MLAT, 2048, 2048}; pg8::StaticOrder S; S.init(MLAT, 2048, GD, bid);
      pg8::EpiRes E{XC, p.out, XC, p.out, MOD1 + 2 * 2048, 512}; pg8::gemm_phase<pg8::EpiRes, pg8::StaticOrder>(ldsg, g, S, E); }
    xcd_barrier(xbar);
    ph_norm(XC, p.out, p.norm_ffn_g + 2048, MOD1, 3, 4, H, 512);
    xcd_barrier(xbar);
    { pg8::Gemm g{H + (size_t)512 * 2048, WT_GU, MLAT, 11264, 2048}; pg8::StaticOrder S; S.init(MLAT, 11264, GD, bid);
      pg8::EpiSwiglu E{PROJ, FH}; pg8::gemm_phase<pg8::EpiSwiglu, pg8::StaticOrder>(ldsg, g, S, E);
    }
    xcd_barrier(xbar);
    { pg8::Gemm g{PROJ, WT_DN, MLAT, 2048, 5632}; pg8::StaticOrder S; S.init(MLAT, 2048, GD, bid);
      pg8::EpiRes E{XC, p.out, XC, p.out, MOD1 + 5 * 2048, 512}; pg8::gemm_phase<pg8::EpiRes, pg8::StaticOrder>(ldsg, g, S, E); }
    xcd_barrier(xbar);
    ph_final_norm(p);
}

extern "C" void kernel_launch(void* const* d_in, const int* in_sizes, int n_in, void* d_out, int out_size, void* d_ws, size_t ws_size, hipStream_t stream) {
    static int grid = 0;
    if (grid == 0) {
        if (n_in != 32 || out_size != MLAT * DM || ws_size < WS_END) { fprintf(stderr, "kernel_launch: unexpected shapes (n_in %d out %d ws %zu need %zu)\n", n_in, out_size, ws_size, (size_t)WS_END); grid = -1; return; }
        int dev = 0, cus = 0, per_cu = 0;
        (void)hipGetDevice(&dev);
        (void)hipDeviceGetAttribute(&cus, hipDeviceAttributeMultiprocessorCount, dev);
        if (hipFuncSetAttribute((const void*)hybrid_fwd, hipFuncAttributeMaxDynamicSharedMemorySize, LDS_BYTES) != hipSuccess) { fprintf(stderr, "kernel_launch: hipFuncSetAttribute failed\n"); }
        if (hipOccupancyMaxActiveBlocksPerMultiprocessor(&per_cu, (const void*)hybrid_fwd, NTHR, LDS_BYTES) != hipSuccess || per_cu < 1) { fprintf(stderr, "kernel_launch: occupancy query gave %d\n", per_cu); per_cu = 1; }
        (void)hipGetLastError();
        grid = cus * per_cu;
    }
    if (grid < 0) return;
    Params p{};
    const float** pp = (const float**)&p;
    for (int i = 0; i < 32; ++i) pp[i] = (const float*)d_in[i];
    p.out = (float*)d_out; p.ws = (unsigned char*)d_ws;
    (void)hipMemsetAsync((unsigned char*)d_ws + WS_BAR, 0, 16384, stream);
    void* args[] = {&p};
    hipError_t e = hipLaunchCooperativeKernel((const void*)hybrid_fwd, dim3(grid), dim3(NTHR), args, LDS_BYTES, stream);
    if (e != hipSuccess) fprintf(stderr, "cooperative launch failed: %s (grid %d)\n", hipGetErrorString(e), grid);
}
```

```cpp
#include <hip/hip_runtime.h>
#include <hip/hip_cooperative_groups.h>
#include <cstdio>
namespace cg = cooperative_groups;

typedef unsigned short u16;

constexpr int DM = 2048, FH = 5632, MC = 512, MLAT = 32768, MTOT = 33280, NTHR = 512;
constexpr int NP0 = 7168, NP1 = 5120;
constexpr int NG0 = 48, NG1 = 32;
constexpr int NSEG = 260;

constexpr size_t WS_WT_IN = 0;
constexpr size_t WS_WT_OUT = WS_WT_IN + (size_t)7424 * 2048 * 2;
constexpr size_t WS_WT_GU = WS_WT_OUT + (size_t)2048 * 2048 * 2;
constexpr size_t WS_WT_DN = WS_WT_GU + (size_t)11264 * 2048 * 2;
constexpr size_t WS_H = WS_WT_DN + (size_t)2048 * 5632 * 2;
constexpr size_t WS_PROJ = WS_H + (size_t)MTOT * 2048 * 2;
constexpr size_t WS_OF = WS_PROJ + (size_t)MTOT * 7168 * 2;
constexpr size_t WS_OB = WS_OF + (size_t)MTOT * 2048 * 2;
constexpr size_t WS_XC = WS_OB + (size_t)MTOT * 2048 * 2;
constexpr size_t WS_G = WS_XC + (size_t)MC * 2048 * 4;
constexpr size_t WS_CQ = WS_G + (size_t)MTOT * 48 * 4;
constexpr size_t WS_MODP = WS_CQ + (size_t)MC * 3072 * 2;
constexpr size_t WS_MOD = WS_MODP + (size_t)2 * 32 * 3 * 12288 * 4;
constexpr size_t WS_ATT0 = WS_MOD + (size_t)2 * 3 * 12288 * 4;
constexpr size_t WS_MLS = WS_ATT0 + (size_t)4160 * 4096 * 2;
constexpr size_t WS_GCS = WS_MLS + (size_t)4160 * 256 * 4;
constexpr size_t WS_WRT = WS_GCS + (size_t)8320 * 256 * 4;
constexpr size_t WS_BAR = WS_WRT + (size_t)32 * 16384 * 2;
constexpr size_t WS_END = WS_BAR + 16384;
constexpr size_t WS_TM = WS_H;
constexpr size_t WS_QK = WS_H + (size_t)8320 * 4096 * 2;
constexpr size_t WS_OF1 = WS_OF;
constexpr size_t WS_OB1 = WS_OF + (size_t)MTOT * 1024 * 2;
constexpr size_t WS_QE = WS_OB;
constexpr size_t WS_KDT = WS_QE + (size_t)2 * MTOT * 512 * 2;
constexpr size_t WS_TAIL = WS_PROJ + (size_t)MTOT * 5120 * 2;
constexpr size_t WS_ATT = WS_TAIL;
constexpr size_t WS_VT = WS_ATT + (size_t)4160 * 4096 * 2;
constexpr size_t WS_EBL = WS_VT + (size_t)2080 * 16384 * 2;
constexpr size_t WS_AGG = WS_EBL + (size_t)4160 * 128 * 4;
constexpr size_t WS_CARRY = WS_AGG + (size_t)4 * NSEG * 1024 * 8;
static_assert(WS_CARRY + (size_t)4 * NSEG * 1024 * 4 <= WS_OF, "layer-1 tail overflow");

struct Params {
    const float *x, *c, *ctx, *c_ctx, *mod_w, *mod_b, *norm_mix_g, *norm_ffn_g, *ffn_w_gu, *ffn_w_down, *final_norm_g,
        *ab_w_in, *ab_w_out, *ml_ig_b, *ml_fg_b, *ml_norm_g, *dn_conv_w, *dn_a_log, *dn_dt_bias, *dn_norm_g,
        *cd_w_in, *cd_w_out, *rg_conv_w, *rg_conv_b, *rg_w_r, *rg_b_r, *rg_w_i, *rg_b_i, *rg_lambda, *gla_w_up, *gla_b_up, *gla_norm_g;
    float* out; unsigned char* ws;
};

__device__ __forceinline__ float bf2f(u16 v) { return __uint_as_float(((unsigned)v) << 16); }
typedef __bf16 bf16x2_nat __attribute__((ext_vector_type(2)));
typedef float f32x2_nat __attribute__((ext_vector_type(2)));
__device__ __forceinline__ unsigned cvt_pk_bf16(float lo, float hi) { const f32x2_nat v = {lo, hi}; const bf16x2_nat r = __builtin_convertvector(v, bf16x2_nat); return __builtin_bit_cast(unsigned, r); }
__device__ __forceinline__ u16 f2bf(float f) { return (u16)(cvt_pk_bf16(f, 0.f) & 0xffffu); }
__device__ __forceinline__ void unpack8(const uint4& u, float* f) {
    f[0] = __uint_as_float(u.x << 16); f[1] = __uint_as_float(u.x & 0xffff0000u);
    f[2] = __uint_as_float(u.y << 16); f[3] = __uint_as_float(u.y & 0xffff0000u);
    f[4] = __uint_as_float(u.z << 16); f[5] = __uint_as_float(u.z & 0xffff0000u);
    f[6] = __uint_as_float(u.w << 16); f[7] = __uint_as_float(u.w & 0xffff0000u);
}
__device__ __forceinline__ uint4 pack8(const float* f) { uint4 o; o.x = cvt_pk_bf16(f[0], f[1]); o.y = cvt_pk_bf16(f[2], f[3]); o.z = cvt_pk_bf16(f[4], f[5]); o.w = cvt_pk_bf16(f[6], f[7]); return o; }
template <int CTRL> __device__ __forceinline__ float dppf(float x) { return __int_as_float(__builtin_amdgcn_update_dpp(0, __float_as_int(x), CTRL, 0xF, 0xF, true)); }
__device__ __forceinline__ float red4(float x) { x += dppf<0xB1>(x); x += dppf<0x4E>(x); return x; }
__device__ __forceinline__ float red8(float x) { x = red4(x); x += dppf<0x141>(x); return x; }
__device__ __forceinline__ float red16(float x) { x = red8(x); x += dppf<0x140>(x); return x; }
__device__ __forceinline__ float red64(float x) { x = red16(x); x += __shfl_xor(x, 16); x += __shfl_xor(x, 32); return x; }
__device__ __forceinline__ float frcp(float x) { return __builtin_amdgcn_rcpf(x); }
__device__ __forceinline__ float sigmoidf_(float x) { return frcp(1.f + __expf(-x)); }
__device__ __forceinline__ float siluf_(float x) { return x * frcp(1.f + __expf(-x)); }
__device__ __forceinline__ float softplusf_(float x) { return fmaxf(x, 0.f) + __logf(1.f + __expf(-fabsf(x))); }
__device__ __forceinline__ float logsigmoidf_(float x) { return fminf(x, 0.f) - __logf(1.f + __expf(-fabsf(x))); }
__device__ __forceinline__ float gelu_tanh(float x) { const float u = 0.7978845608028654f * (x + 0.044715f * x * x * x); const float th = 1.f - 2.f * frcp(1.f + __expf(2.f * u)); return 0.5f * x * (1.f + th); }
__device__ __forceinline__ float neg_expm1_small(float x) { float pl = 1.f / 720.f; pl = pl * x + 1.f / 120.f; pl = pl * x + 1.f / 24.f; pl = pl * x + 1.f / 6.f; pl = pl * x + 0.5f; pl = pl * x + 1.f; return -x * pl; }

__device__ __forceinline__ int tid_fresh() { int t = threadIdx.x; asm volatile("" : "+v"(t)); return t; }
namespace pg8 {
#define PG8_LAS __attribute__((address_space(3)))
typedef unsigned short bf16_t;
typedef short bf16x8 __attribute__((ext_vector_type(8)));
typedef float f32x4 __attribute__((ext_vector_type(4)));
typedef unsigned u32x4 __attribute__((ext_vector_type(4)));
constexpr int BM = 256, BK = 64, HALF = 128, HTB = HALF * BK * 2  , STAGE_BYTES = 8 * HTB, NXCD = 8, WGM = 8;

__host__ __device__ __forceinline__ int lds_byte(int r, int c) { const int st = (r >> 4) * 2 + (c >> 5), rr = r & 15, cc = c & 31, ob = rr * 64 + cc * 2; return st * 1024 + (ob ^ (((ob >> 9) & 1) << 5)); }
__host__ __device__ __forceinline__ void stage_rc(int b, int& R, int& C) { const int st = b / 1024, sb = b % 1024, swz = sb ^ (((sb >> 9) & 1) << 5); R = (st >> 1) * 16 + swz / 64; C = (st & 1) * 32 + (swz % 64) / 2; }
__host__ __device__ __forceinline__ int perm32(int rho) { const int n = rho >> 4, i = rho & 15; return 8 * (i >> 2) + 4 * n + (i & 3); }

struct Unit { int pm, pn; };
struct Gemm { const bf16_t* A; const bf16_t* Bt; int M, N, K; };

struct StaticOrder {
    int nM, nN, nwg, G, c;
    __host__ __device__ void init(int M, int N, int G_, int c_) { nM = M / BM; nN = N / BM; nwg = nM * nN; G = G_; c = c_; }
    __host__ __device__ bool next(int i, Unit& u) const {
        const long L = (long)i * G + c; if (L >= nwg) return false;
        int wgid = (int)L; { const int q = nwg / NXCD, r = nwg % NXCD, xcd = wgid % NXCD, off = wgid / NXCD; wgid = (xcd < r ? xcd * (q + 1) : r * (q + 1) + (xcd - r) * q) + off; }
        const int nig = WGM * nN, gid = wgid / nig, fm = gid * WGM, gsz = (nM - fm) < WGM ? (nM - fm) : WGM;
        u.pm = fm + ((wgid % nig) % gsz); u.pn = (wgid % nig) / gsz; return true;
    }
    __device__ __forceinline__ void a_ready(const Unit&) const {}
    __device__ __forceinline__ void done(const Unit&) const {}
};
using ::cvt_pk_bf16;
typedef float f32x2 __attribute__((ext_vector_type(2)));

struct EpiProj {
    static constexpr bool PERM = true, AFTER_DRAIN = false;
    bf16_t* P; int ldp; int n_main; float* G; int ldg; int ng; int perm_tiles;
    __device__ __forceinline__ void operator()(const f32x4 (&acc)[2][2][4][2], const Unit& u, int wr, int wc, int fr, int fq) const {
        const int row0 = u.pm * BM + wr * 64 + fr;
        if (u.pn < perm_tiles) {
#pragma unroll
            for (int ai = 0; ai < 2; ++ai)
#pragma unroll
                for (int m = 0; m < 4; ++m) { bf16_t* rowp = P + (size_t)(u.pm * BM + ai * HALF + wr * 64 + (m * 4 + wc) * 4 + fq) * ldp + u.pn * BM + fr * 8;
#pragma unroll
                    for (int bj = 0; bj < 2; ++bj) { const f32x4 v0 = acc[ai][bj][m][0], v1 = acc[ai][bj][m][1];
                        u32x4 w; w.x = cvt_pk_bf16(v0[0], v0[1]); w.y = cvt_pk_bf16(v0[2], v0[3]); w.z = cvt_pk_bf16(v1[0], v1[1]); w.w = cvt_pk_bf16(v1[2], v1[3]);
                        *(u32x4*)(rowp + bj * HALF) = w; } }
        } else if (u.pn < n_main) {
            const int col0 = u.pn * BM + wc * 32 + 8 * fq;
#pragma unroll
            for (int ai = 0; ai < 2; ++ai)
#pragma unroll
                for (int m = 0; m < 4; ++m) { bf16_t* rowp = P + (size_t)(row0 + ai * HALF + m * 16) * ldp + col0;
#pragma unroll
                    for (int bj = 0; bj < 2; ++bj) { const f32x4 v0 = acc[ai][bj][m][0], v1 = acc[ai][bj][m][1];
                        u32x4 w; w.x = cvt_pk_bf16(v0[0], v0[1]); w.y = cvt_pk_bf16(v0[2], v0[3]); w.z = cvt_pk_bf16(v1[0], v1[1]); w.w = cvt_pk_bf16(v1[2], v1[3]);
                        *(u32x4*)(rowp + bj * HALF) = w; } }
        } else {
            const int c0 = wc * 32 + 8 * fq;
#pragma unroll
            for (int ai = 0; ai < 2; ++ai)
#pragma unroll
                for (int m = 0; m < 4; ++m) { float* rowp = G + (size_t)(row0 + ai * HALF + m * 16) * ldg;
#pragma unroll
                    for (int n = 0; n < 2; ++n)
#pragma unroll
                        for (int j = 0; j < 4; ++j) { const int c = c0 + 4 * n + j; if (c < ng) rowp[c] = acc[ai][0][m][n][j]; } }
        }
    }
};
struct EpiRes {
    static constexpr bool PERM = false, AFTER_DRAIN = false;
    const float* srcC; const float* srcL; float* dstC; float* dstL; const float* gate  ; int row_off;
    __device__ __forceinline__ void operator()(const f32x4 (&acc)[2][2][4][2], const Unit& u, int wr, int wc, int fr, int fq) const {
        const int grow_t = u.pm * BM + row_off;
        const bool isc = grow_t < 512;
        const int mr = isc ? 2 : ((grow_t - 512) >> 14);
        const float* sp = isc ? srcC + (size_t)grow_t * 2048 : srcL + (size_t)(grow_t - 512) * 2048;
        float* dp = isc ? dstC + (size_t)grow_t * 2048 : dstL + (size_t)(grow_t - 512) * 2048;
        const int lrow0 = wr * 64 + fr, col0 = u.pn * BM + wc * 32 + 4 * fq;
        const float* gp = gate + (size_t)mr * 12288 + col0;
        f32x4 gv[2][2];
#pragma unroll
        for (int bj = 0; bj < 2; ++bj)
#pragma unroll
            for (int n = 0; n < 2; ++n) gv[bj][n] = *(const f32x4*)(gp + bj * HALF + n * 16);
#pragma unroll
        for (int ai = 0; ai < 2; ++ai)
#pragma unroll
            for (int m = 0; m < 4; ++m) { const size_t off = (size_t)(lrow0 + ai * HALF + m * 16) * 2048 + col0;
#pragma unroll
                for (int bj = 0; bj < 2; ++bj)
#pragma unroll
                    for (int n = 0; n < 2; ++n) { const f32x4 s = *(const f32x4*)(sp + off + bj * HALF + n * 16);
                        *(f32x4*)(dp + off + bj * HALF + n * 16) = s + gv[bj][n] * acc[ai][bj][m][n]; } }
    }
};
struct EpiSwiglu {
    static constexpr bool PERM = true, AFTER_DRAIN = false;
    bf16_t* O; int ldo;
    __device__ __forceinline__ void operator()(const f32x4 (&acc)[2][2][4][2], const Unit& u, int wr, int wc, int fr, int fq) const {
        const int row0 = u.pm * BM + wr * 64 + fr, col0 = u.pn * HALF + wc * 32 + 8 * fq;
#pragma unroll
        for (int ai = 0; ai < 2; ++ai)
#pragma unroll
            for (int m = 0; m < 4; ++m) { float r[8];
#pragma unroll
                for (int n = 0; n < 2; ++n)
#pragma unroll
                    for (int j = 0; j < 4; ++j) { const float gg = acc[ai][0][m][n][j], uu = acc[ai][1][m][n][j]; r[n * 4 + j] = gg * __builtin_amdgcn_rcpf(1.f + __expf(-gg)) * uu; }
                u32x4 w; w.x = cvt_pk_bf16(r[0], r[1]); w.y = cvt_pk_bf16(r[2], r[3]); w.z = cvt_pk_bf16(r[4], r[5]); w.w = cvt_pk_bf16(r[6], r[7]);
                *(u32x4*)(O + (size_t)(row0 + ai * HALF + m * 16) * ldo + col0) = w; }
    }
};

template <class Epi, class Sched>
__device__ __forceinline__ void gemm_phase(PG8_LAS unsigned char* lds, const Gemm g, const Sched& S, const Epi& E) {
    int tid = threadIdx.x; asm volatile("" : "+v"(tid)); const int wid = __builtin_amdgcn_readfirstlane(tid >> 6), lane = tid & 63, wr = wid >> 2, wc = wid & 3, fr = lane & 15, fq = lane >> 4;
    const int K = g.K, nt = K / BK;
    unsigned voffA[2], voffB[2];
#pragma unroll
    for (int i = 0; i < 2; ++i) { int R, C; stage_rc(tid * 16 + i * 8192, R, C); const int Rb = Epi::PERM ? ((R & ~31) + perm32(R & 31)) : R;
        voffA[i] = (unsigned)(R * K + C) * 2u; voffB[i] = (unsigned)(Rb * K + C) * 2u; }
    const size_t kstep = (size_t)(BK * 2);
    const size_t hstep = (size_t)HALF * K * 2;
    const size_t tstep = 2 * hstep;
    const unsigned ldsw = (unsigned)wid * 1024u;
    const int aoff = lds_byte(wr * 64 + fr, fq * 8), boff = lds_byte(wc * 32 + fr, fq * 8);
#define PG8_SA(b, h) (((b) * 2 + (h)) * HTB)
#define PG8_SB(b, h) ((4 + (b) * 2 + (h)) * HTB)
#define PG8_STAGE(bufoff, gbase, voff) do { _Pragma("unroll") for (int _i = 0; _i < 2; ++_i) \
        __builtin_amdgcn_global_load_lds((const unsigned*)((const char*)(gbase) + (voff)[_i]), (PG8_LAS unsigned*)(lds + (bufoff) + ldsw + _i * 8192), 16, 0, 0); } while (0)
#define PG8_LDA(dst, b, h) do { _Pragma("unroll") for (int m = 0; m < 4; ++m) _Pragma("unroll") for (int k = 0; k < 2; ++k) dst[m][k] = *(const PG8_LAS bf16x8*)(lds + PG8_SA(b, h) + aoff + m * 2048 + k * 1024); } while (0)
#define PG8_LDB(dst, b, h) do { _Pragma("unroll") for (int n = 0; n < 2; ++n) _Pragma("unroll") for (int k = 0; k < 2; ++k) dst[n][k] = *(const PG8_LAS bf16x8*)(lds + PG8_SB(b, h) + boff + n * 2048 + k * 1024); } while (0)
#define PG8_MMA(ai, bj, At, Bt) do { __builtin_amdgcn_s_setprio(1); _Pragma("unroll") for (int m = 0; m < 4; ++m) _Pragma("unroll") for (int n = 0; n < 2; ++n) _Pragma("unroll") for (int k = 0; k < 2; ++k) \
        acc[ai][bj][m][n] = __builtin_amdgcn_mfma_f32_16x16x32_bf16(Bt[n][k], At[m][k], acc[ai][bj][m][n], 0, 0, 0); __builtin_amdgcn_s_setprio(0); } while (0)
#define PG8_WAIT_V(n) asm volatile("s_waitcnt vmcnt(" #n ")" ::: "memory")
#define PG8_WAIT_L(n) asm volatile("s_waitcnt lgkmcnt(" #n ")" ::: "memory")
#define PG8_BAR __builtin_amdgcn_s_barrier()
#define PG8_SCHED __builtin_amdgcn_sched_barrier(0)
    Unit cur, nxt; int ui = 0;
    if (!S.next(0, cur)) return;
    f32x4 acc[2][2][4][2];
#pragma unroll
    for (int a = 0; a < 2; ++a)
#pragma unroll
        for (int b = 0; b < 2; ++b)
#pragma unroll
            for (int m = 0; m < 4; ++m)
#pragma unroll
                for (int n = 0; n < 2; ++n) acc[a][b][m][n] = (f32x4){0.f, 0.f, 0.f, 0.f};
    bf16x8 At[4][2], B0[2][2], B1[2][2];
    const char* cA = (const char*)g.A + (size_t)cur.pm * tstep; const char* cB = (const char*)g.Bt + (size_t)cur.pn * tstep;
    S.a_ready(cur);
    PG8_STAGE(PG8_SB(0, 0), cB, voffB); PG8_STAGE(PG8_SA(0, 0), cA, voffA); PG8_STAGE(PG8_SB(0, 1), cB + hstep, voffB); PG8_STAGE(PG8_SA(0, 1), cA + hstep, voffA);
    if (wr == 1) PG8_BAR;
    PG8_WAIT_V(4); PG8_BAR;
    PG8_STAGE(PG8_SB(1, 0), cB + kstep, voffB); PG8_STAGE(PG8_SA(1, 0), cA + kstep, voffA); PG8_STAGE(PG8_SB(1, 1), cB + hstep + kstep, voffB);
    PG8_WAIT_V(6); PG8_BAR;
    for (;;) {
        const bool has_next = S.next(ui + 1, nxt);
        const char* nA = has_next ? (const char*)g.A + (size_t)nxt.pm * tstep : cA; const char* nB = has_next ? (const char*)g.Bt + (size_t)nxt.pn * tstep : cB;
        for (int t = 0; t < nt; t += 2) {
            const bool last = (t == nt - 2);
            const char* a1 = cA + (size_t)(t + 1) * kstep;
            const char* a2 = last ? nA : cA + (size_t)(t + 2) * kstep; const char* b2 = last ? nB : cB + (size_t)(t + 2) * kstep;
            const char* a3 = a2 + kstep; const char* b3 = b2 + kstep;
            if (last && has_next) S.a_ready(nxt);
            PG8_LDB(B0, 0, 0); PG8_SCHED; PG8_LDA(At, 0, 0); PG8_STAGE(PG8_SA(1, 1), a1 + hstep, voffA);
            PG8_WAIT_L(8); PG8_BAR; PG8_WAIT_L(0); PG8_MMA(0, 0, At, B0); PG8_BAR; PG8_SCHED;
            PG8_LDB(B1, 0, 1); PG8_STAGE(PG8_SB(0, 0), b2, voffB);
            PG8_BAR; PG8_WAIT_L(0); PG8_MMA(0, 1, At, B1); PG8_BAR;
            PG8_LDA(At, 0, 1); PG8_STAGE(PG8_SA(0, 0), a2, voffA);
            PG8_BAR; PG8_WAIT_L(0); PG8_MMA(1, 0, At, B0); PG8_BAR; PG8_SCHED;
            PG8_STAGE(PG8_SB(0, 1), b2 + hstep, voffB);
            PG8_WAIT_V(6); PG8_BAR; PG8_MMA(1, 1, At, B1); PG8_BAR;
            PG8_LDB(B0, 1, 0); PG8_SCHED; PG8_LDA(At, 1, 0); PG8_STAGE(PG8_SA(0, 1), a2 + hstep, voffA);
            PG8_WAIT_L(8); PG8_BAR; PG8_WAIT_L(0); PG8_MMA(0, 0, At, B0); PG8_BAR; PG8_SCHED;
            PG8_LDB(B1, 1, 1); PG8_STAGE(PG8_SB(1, 0), b3, voffB);
            PG8_BAR; PG8_WAIT_L(0); PG8_MMA(0, 1, At, B1); PG8_BAR;
            PG8_LDA(At, 1, 1); PG8_STAGE(PG8_SA(1, 0), a3, voffA);
            PG8_BAR; PG8_WAIT_L(0); PG8_MMA(1, 0, At, B0); PG8_BAR; PG8_SCHED;
            PG8_STAGE(PG8_SB(1, 1), b3 + hstep, voffB);
            PG8_WAIT_V(6); PG8_BAR; PG8_MMA(1, 1, At, B1); PG8_BAR;
        }
        if constexpr (!Epi::AFTER_DRAIN) { E(acc, cur, wr, wc, fr, fq); S.done(cur); }
        if (!has_next) break;
#pragma unroll
        for (int a = 0; a < 2; ++a)
#pragma unroll
            for (int b = 0; b < 2; ++b)
#pragma unroll
                for (int m = 0; m < 4; ++m)
#pragma unroll
                    for (int n = 0; n < 2; ++n) acc[a][b][m][n] = (f32x4){0.f, 0.f, 0.f, 0.f};
        cur = nxt; cA = nA; cB = nB; ++ui;
    }
    PG8_WAIT_V(0);
    if (wr == 0) PG8_BAR;
    PG8_BAR;
    if constexpr (Epi::AFTER_DRAIN) { E.fused(acc, cur, wr, wc, fr, fq, lds, wid, lane); S.done(cur); }
#undef PG8_SA
#undef PG8_SB
#undef PG8_STAGE
#undef PG8_LDA
#undef PG8_LDB
#undef PG8_MMA
#undef PG8_WAIT_V
#undef PG8_WAIT_L
#undef PG8_BAR
#undef PG8_SCHED
}
}

__device__ __forceinline__ void ph_adaln_partials(const Params& p, float* sm) {
    const int tid = tid_fresh();
    float* MODP = (float*)(p.ws + WS_MODP);
    for (int it = blockIdx.x; it < 384; it += gridDim.x) {
        const int l = it / 192, rem = it % 192, kc = rem / 6, cgp = rem % 6;
        __syncthreads();
        if (tid < 192) { const int r = tid >> 6, kk = tid & 63, k = kc * 64 + kk; const float cv = (r < 2) ? p.c[r * 2048 + k] : p.c_ctx[k]; sm[tid] = siluf_(cv); }
        __syncthreads();
        const int col = cgp * 2048 + tid * 4;
        float4 a0 = {0.f, 0.f, 0.f, 0.f}, a1 = a0, a2 = a0;
        const float* wp = p.mod_w + ((size_t)l * 2048 + (size_t)kc * 64) * 12288 + col;
#pragma unroll 8
        for (int kk = 0; kk < 64; ++kk) {
            const float4 w = *(const float4*)(wp + (size_t)kk * 12288);
            const float s0 = sm[kk], s1 = sm[64 + kk], s2 = sm[128 + kk];
            a0.x += s0 * w.x; a0.y += s0 * w.y; a0.z += s0 * w.z; a0.w += s0 * w.w;
            a1.x += s1 * w.x; a1.y += s1 * w.y; a1.z += s1 * w.z; a1.w += s1 * w.w;
            a2.x += s2 * w.x; a2.y += s2 * w.y; a2.z += s2 * w.z; a2.w += s2 * w.w;
        }
        float* o = MODP + ((size_t)(l * 32 + kc) * 3) * 12288 + col;
        *(float4*)(o) = a0; *(float4*)(o + 12288) = a1; *(float4*)(o + 2 * 12288) = a2;
    }
}
__device__ __forceinline__ void ph_adaln_reduce(const Params& p) {
    const float* MODP = (const float*)(p.ws + WS_MODP); float* MOD = (float*)(p.ws + WS_MOD);
    for (int idx = blockIdx.x * NTHR + tid_fresh(); idx < 2 * 3 * 12288; idx += gridDim.x * NTHR) {
        const int l = idx / 36864, r = (idx / 12288) % 3, col = idx % 12288;
        float s = p.mod_b[l * 12288 + col];
        for (int kc = 0; kc < 32; ++kc) s += MODP[((size_t)(l * 32 + kc) * 3 + r) * 12288 + col];
        MOD[idx] = s;
    }
}

template <int MODE> __device__ __forceinline__ int colmap(int n, int nsrc) {
    if (MODE == 0) return n < nsrc ? n : -1;
    if (MODE == 1) { if (n < 3072) return n; if (n < 7168) return n + 16; if (n < 7184) return 3072 + (n - 7168); if (n < 7216) return n; return -1; }
    return ((n >> 7) & 1) * 5632 + (n >> 8) * 128 + (n & 127);
}
template <int MODE> __device__ __forceinline__ void ph_convert(const float* W, int nsrc, int K, int nout, u16* Bt, float* sm) {
    const int tid = tid_fresh(); const int nnt = nout / 64, ntiles = nnt * (K / 64);
    for (int t = blockIdx.x; t < ntiles; t += gridDim.x) {
        const int k0 = (t / nnt) * 64, n0 = (t % nnt) * 64;
        __syncthreads();
#pragma unroll
        for (int i = 0; i < 8; ++i) { const int idx = i * NTHR + tid, kk = idx >> 6, nn = idx & 63; const int src = colmap<MODE>(n0 + nn, nsrc);
            sm[kk * 65 + nn] = src >= 0 ? W[(size_t)(k0 + kk) * nsrc + src] : 0.f; }
        __syncthreads();
        { const int nn = tid >> 3, k8 = (tid & 7) * 8; float v[8];
#pragma unroll
            for (int j = 0; j < 8; ++j) v[j] = sm[(k8 + j) * 65 + nn];
            *(uint4*)(Bt + (size_t)(n0 + nn) * K + k0 + k8) = pack8(v); }
    }
}

__device__ __forceinline__ void ph_norm(const float* srcC, const float* srcL, const float* g, const float* modl, int chunk_sh, int chunk_sc, u16* H, int row_begin) {
    const int tid_ = tid_fresh(); const int lane = tid_ & 63, w = tid_ >> 6;
    for (int row = row_begin + blockIdx.x * 8 + w; row < MTOT; row += gridDim.x * 8) {
        const float* src = row < 512 ? srcC + (size_t)row * 2048 : srcL + (size_t)(row - 512) * 2048;
        const int mr = row < 512 ? 2 : ((row - 512) >> 14);
        const float* sc = modl + (mr * 6 + chunk_sc) * 2048; const float* sh = modl + (mr * 6 + chunk_sh) * 2048;
        float4 v[8]; float ss = 0.f;
#pragma unroll
        for (int i = 0; i < 8; ++i) { v[i] = *(const float4*)(src + i * 256 + lane * 4); ss += v[i].x * v[i].x + v[i].y * v[i].y + v[i].z * v[i].z + v[i].w * v[i].w; }
        ss = red64(ss);
        const float rstd = rsqrtf(ss * (1.f / 2048.f) + 1e-6f);
#pragma unroll
        for (int i = 0; i < 8; ++i) { const int col = i * 256 + lane * 4;
            const float4 g4 = *(const float4*)(g + col), s4 = *(const float4*)(sc + col), h4 = *(const float4*)(sh + col);
            const float y0 = v[i].x * rstd * g4.x * (1.f + s4.x) + h4.x, y1 = v[i].y * rstd * g4.y * (1.f + s4.y) + h4.y;
            const float y2 = v[i].z * rstd * g4.z * (1.f + s4.z) + h4.z, y3 = v[i].w * rstd * g4.w * (1.f + s4.w) + h4.w;
            uint2 o; o.x = cvt_pk_bf16(y0, y1); o.y = cvt_pk_bf16(y2, y3);
            *(uint2*)(H + (size_t)row * 2048 + col) = o; }
    }
}
__device__ __forceinline__ void ph_final_norm(const Params& p) {
    const int tid_ = tid_fresh(); const int lane = tid_ & 63, w = tid_ >> 6;
    for (int row = blockIdx.x * 8 + w; row < MLAT; row += gridDim.x * 8) {
        float* src = p.out + (size_t)row * 2048;
        float4 v[8]; float ss = 0.f;
#pragma unroll
        for (int i = 0; i < 8; ++i) { v[i] = *(const float4*)(src + i * 256 + lane * 4); ss += v[i].x * v[i].x + v[i].y * v[i].y + v[i].z * v[i].z + v[i].w * v[i].w; }
        ss = red64(ss);
        const float rstd = rsqrtf(ss * (1.f / 2048.f) + 1e-6f);
#pragma unroll
        for (int i = 0; i < 8; ++i) { const int col = i * 256 + lane * 4; const float4 g4 = *(const float4*)(p.final_norm_g + col);
            float4 o; o.x = v[i].x * rstd * g4.x; o.y = v[i].y * rstd * g4.y; o.z = v[i].z * rstd * g4.z; o.w = v[i].w * rstd * g4.w;
            *(float4*)(src + col) = o; }
    }
}

__device__ __forceinline__ void ph_l0_prep(const Params& p, float* sm) {
    const int tid = tid_fresh();
    u16* PROJ = (u16*)(p.ws + WS_PROJ); u16* CQ = (u16*)(p.ws + WS_CQ); float* G = (float*)(p.ws + WS_G);
    for (int idx = blockIdx.x * NTHR + tid; idx < MTOT * 48; idx += gridDim.x * NTHR) {
        const int j = idx % 48; const float v = G[idx]; float o;
        if (j < 8) o = v + p.ml_ig_b[j];
        else if (j < 16) o = logsigmoidf_(v + p.ml_fg_b[j - 8]);
        else if (j < 32) { const float dt = softplusf_(v + p.dn_dt_bias[j - 16]); o = -__expf(p.dn_a_log[j - 16]) * dt; }
        else o = sigmoidf_(v);
        G[idx] = o;
    }
    {
        const int NB = (int)gridDim.x;
        const int tk = tid >> 3, cs = (tid & 7) * 16;
        for (int pb = (int)blockIdx.x; pb < (NB < 24 ? 24 : NB); pb += NB) {
        const int part = pb % 24, slot = pb / 24;
        const int nbp = NB >= 24 ? (NB - part + 23) / 24 : 1;
        float wt[5][16];
#pragma unroll
        for (int j = 0; j < 5; ++j)
#pragma unroll
            for (int c4 = 0; c4 < 4; ++c4) { const float4 w4 = *(const float4*)(p.dn_conv_w + j * 3072 + part * 128 + cs + c4 * 4); wt[j][c4 * 4] = w4.x; wt[j][c4 * 4 + 1] = w4.y; wt[j][c4 * 4 + 2] = w4.z; wt[j][c4 * 4 + 3] = w4.w; }
        uint4 in[5][2];
#define L0P_LOAD(TT) do { const int tt_ = (TT); const bool ic_ = tt_ < 8; const int t0_ = ic_ ? (tt_ & 3) * 64 : 0; const int rb_ = ic_ ? (tt_ >> 2) * 256 + t0_ : 512 + (tt_ - 8) * 64; \
            _Pragma("unroll") for (int j = 0; j < 5; ++j) { const int r = tk + j - 2; const bool ok = ic_ ? (t0_ + r >= 0 && t0_ + r < 256) : (r >= 0 && r < 64); \
                in[j][0] = make_uint4(0u, 0u, 0u, 0u); in[j][1] = in[j][0]; \
                if (ok) { const u16* src = PROJ + (size_t)(rb_ + r) * NP0 + 3072 + part * 128 + cs; in[j][0] = *(const uint4*)(src); in[j][1] = *(const uint4*)(src + 8); } } } while (0)
        if (slot < 520) L0P_LOAD(slot);
        for (int tt = slot; tt < 520; tt += nbp) {
            const bool isctx = tt < 8;
            const int t0 = isctx ? (tt & 3) * 64 : 0;
            const int rowbase = isctx ? (tt >> 2) * 256 + t0 : 512 + (tt - 8) * 64;
            float o[16];
#pragma unroll
            for (int c = 0; c < 16; ++c) o[c] = 0.f;
#pragma unroll
            for (int j = 0; j < 5; ++j) { float f[16]; unpack8(in[j][0], f); unpack8(in[j][1], f + 8);
#pragma unroll
                for (int c = 0; c < 16; ++c) o[c] += f[c] * wt[j][c]; }
            if (tt + nbp < 520) L0P_LOAD(tt + nbp);
            float ss = 0.f;
#pragma unroll
            for (int c = 0; c < 16; ++c) { o[c] = siluf_(o[c]); ss += o[c] * o[c]; }
            ss = red8(ss);
            if (part < 16) { const float sc = rsqrtf(ss + 1e-6f);
#pragma unroll
                for (int c = 0; c < 16; ++c) o[c] *= sc; }
            __syncthreads();
            if (part < 16) {
                const int rs = isctx ? 3072 : NP0; u16* tb = isctx ? CQ + (size_t)rowbase * 3072 + part * 128 : PROJ + (size_t)rowbase * NP0 + 3072 + part * 128;
                const int r0 = ((tk >> 4) * 4 + (cs >> 5)) * 4 + ((cs >> 3) & 3);
                *(uint4*)(tb + (size_t)r0 * rs + (tk & 15) * 8) = pack8(o); *(uint4*)(tb + (size_t)(r0 + 1) * rs + (tk & 15) * 8) = pack8(o + 8);
            } else {
                u16* dst = isctx ? CQ + (size_t)(rowbase + tk) * 3072 + part * 128 + cs : PROJ + (size_t)(rowbase + tk) * NP0 + 3072 + part * 128 + cs;
                *(uint4*)(dst) = pack8(o); *(uint4*)(dst + 8) = pack8(o + 8); }
        }
        }
    }
}

__device__ __forceinline__ void ph_l0_merge(const Params& p) {
    const int tid_ = tid_fresh(); const int lane = tid_ & 63, w = tid_ >> 6;
    const u16* PROJ = (const u16*)(p.ws + WS_PROJ); const u16* OF = (const u16*)(p.ws + WS_OF); const u16* OB = (const u16*)(p.ws + WS_OB); u16* Y = (u16*)(p.ws + WS_H);
    for (int row = blockIdx.x * 8 + w; row < MTOT; row += gridDim.x * 8) {
        float o[4][8]; float ss[4];
#pragma unroll
        for (int k = 0; k < 4; ++k) { const int col = (k * 64 + lane) * 8; float a[8], bb[8];
            unpack8(*(const uint4*)(OF + (size_t)row * 2048 + col), a); unpack8(*(const uint4*)(OB + (size_t)row * 2048 + col), bb);
            float s = 0.f;
#pragma unroll
            for (int j = 0; j < 8; ++j) { o[k][j] = a[j] + bb[j]; s += o[k][j] * o[k][j]; }
            s = red16(s);
            if (k < 2) s += __shfl_xor(s, 16);
            ss[k] = s; }
#pragma unroll
        for (int k = 0; k < 4; ++k) { const int col = (k * 64 + lane) * 8; const bool isml = k < 2;
            const float rstd = isml ? rsqrtf(ss[k] * (1.f / 256.f) + 1e-6f) : rsqrtf(ss[k] * (1.f / 128.f) + 1e-6f);
            const u16* gsrc = PROJ + (size_t)row * NP0 + (isml ? 2048 + col : 6144 + (col - 1024));
            const float* gn = isml ? p.ml_norm_g + col : p.dn_norm_g + (col - 1024);
            float gt[8], r[8]; unpack8(*(const uint4*)gsrc, gt);
            const float4 g0 = *(const float4*)gn, g1 = *(const float4*)(gn + 4); const float gg[8] = {g0.x, g0.y, g0.z, g0.w, g1.x, g1.y, g1.z, g1.w};
#pragma unroll
            for (int j = 0; j < 8; ++j) { const float gate = isml ? sigmoidf_(gt[j]) : siluf_(gt[j]); r[j] = o[k][j] * rstd * gg[j] * gate; }
            *(uint4*)(Y + (size_t)row * 2048 + col) = pack8(r); }
    }
}

typedef short bf16x8_t __attribute__((ext_vector_type(8)));
typedef float f32x4_t __attribute__((ext_vector_type(4)));
__device__ __forceinline__ float wave_cumsum(float x, int lane) {
#pragma unroll
    for (int o = 1; o < 64; o <<= 1) { const float t = __shfl_up(x, o); if (lane >= o) x += t; }
    return x; }
__device__ __forceinline__ float wave_cummax(float x, int lane) {
#pragma unroll
    for (int o = 1; o < 64; o <<= 1) { const float t = __shfl_up(x, o); if (lane >= o) x = fmaxf(x, t); }
    return x; }
__device__ __forceinline__ int tile_of(int n, int b, int dir) { if (n < 4) return b * 4 + (dir ? 3 - n : n); const int li = n - 4; return 8 + b * 256 + (dir ? 255 - li : li); }
__device__ __forceinline__ int rowbase_of(int tt) { return tt < 8 ? tt * 64 : 512 + (tt - 8) * 64; }

__device__ __forceinline__ void ml_prep_item(const Params& p, int it, float* wl, int lane) {
    const int h = it & 3, tt = (it >> 2) % 520, z = it / 2080, rowbase = rowbase_of(tt), fr = lane & 15, fq = lane >> 4;
    const u16* PROJ = (const u16*)(p.ws + WS_PROJ); const float* G = (const float*)(p.ws + WS_G);
    float* MLS = (float*)(p.ws + WS_MLS) + (size_t)it * 256; u16* ATT0 = (u16*)(p.ws + WS_ATT0) + (size_t)it * 4096;
    const int tk = z ? 63 - lane : lane, row = rowbase + tk;
    const float ig = G[row * 48 + z * 4 + h], lf = G[row * 48 + 8 + z * 4 + h];
    const float bb = wave_cumsum(lf, lane), gg = ig - bb, cm = wave_cummax(gg, lane);
    const float bL = __shfl(bb, 63), cmL = __shfl(cm, 63);
    MLS[tk] = bb; MLS[64 + tk] = cm; MLS[128 + tk] = __expf(gg - cmL); if (lane == 0) { MLS[192] = bL; MLS[193] = cmL; }
    wl[tk] = gg; wl[64 + tk] = cm;
    bf16x8_t kf[4][4];
#pragma unroll
    for (int rt = 0; rt < 4; ++rt)
#pragma unroll
        for (int ks = 0; ks < 4; ++ks) kf[rt][ks] = *(const bf16x8_t*)(PROJ + (size_t)(rowbase + (rt * 4 + ks) * 4 + fq) * NP0 + 512 + h * 128 + fr * 8);
#pragma unroll 1
    for (int rt = 0; rt < 4; ++rt) {
        bf16x8_t qf[4];
#pragma unroll
        for (int ks = 0; ks < 4; ++ks) qf[ks] = *(const bf16x8_t*)(PROJ + (size_t)(rowbase + (rt * 4 + ks) * 4 + fq) * NP0 + h * 128 + fr * 8);
#pragma unroll
        for (int ct = 0; ct < 4; ++ct) {
            f32x4_t acc = (f32x4_t){0.f, 0.f, 0.f, 0.f};
#pragma unroll
            for (int ks = 0; ks < 4; ++ks) acc = __builtin_amdgcn_mfma_f32_16x16x32_bf16(qf[ks], kf[ct][ks], acc, 0, 0, 0);
            const int s = ct * 16 + fr; const float gs = wl[s];
#pragma unroll
            for (int j = 0; j < 4; ++j) { const int l = rt * 16 + fq * 4 + j; const bool keep = z ? (s >= l) : (s <= l);
                const float e = __expf(fminf(gs - wl[64 + l], 0.f));
                ATT0[(((l >> 4) * 2 + (s >> 5)) * 64 + ((s >> 3) & 3) * 16 + (l & 15)) * 8 + (s & 7)] = f2bf(keep ? acc[j] * 0.08838834764831845f * e : 0.f); }
        }
    }
}
__device__ __forceinline__ void dn_prep_item(const Params& p, int it, float* Ap, int lane) {
    asm volatile("" : "+v"(lane));
    const int h = it & 7, tt = (it >> 3) % 520, z = it / 4160, rowbase = rowbase_of(tt), fr = lane & 15, fq = lane >> 4;
    const bool isctx = tt < 8;
    const u16* qb = isctx ? (const u16*)(p.ws + WS_CQ) + (size_t)rowbase * 3072 + h * 128 : (const u16*)(p.ws + WS_PROJ) + (size_t)rowbase * NP0 + 3072 + h * 128;
    const int rs = isctx ? 3072 : NP0;
    const float* G = (const float*)(p.ws + WS_G);
    float* GCS = (float*)(p.ws + WS_GCS) + (size_t)it * 256; u16* TM = (u16*)(p.ws + WS_TM) + (size_t)it * 4096; u16* QK = (u16*)(p.ws + WS_QK) + (size_t)it * 4096;
    float* gcs = Ap + 4096; float* bes = Ap + 4160;
    const int tk = z ? 63 - lane : lane, row = rowbase + tk;
    const float g = G[row * 48 + 16 + z * 8 + h], be = G[row * 48 + 32 + z * 8 + h];
    const float gc = wave_cumsum(g, lane), gL = __shfl(gc, 63);
    GCS[tk] = __expf(gc); GCS[64 + tk] = be; GCS[128 + tk] = __expf(gL - gc); if (lane == 0) GCS[192] = __expf(gL);
    gcs[tk] = gc; bes[tk] = be;
    bf16x8_t kf[4][4];
#pragma unroll
    for (int rt = 0; rt < 4; ++rt)
#pragma unroll
        for (int ks = 0; ks < 4; ++ks) kf[rt][ks] = *(const bf16x8_t*)(qb + (size_t)((rt * 4 + ks) * 4 + fq) * rs + 1024 + fr * 8);
#pragma unroll 1
    for (int rt = 0; rt < 4; ++rt) {
        bf16x8_t qf[4], ka[4];
#pragma unroll
        for (int ks = 0; ks < 4; ++ks) { qf[ks] = *(const bf16x8_t*)(qb + (size_t)((rt * 4 + ks) * 4 + fq) * rs + fr * 8); ka[ks] = *(const bf16x8_t*)(qb + (size_t)((rt * 4 + ks) * 4 + fq) * rs + 1024 + fr * 8); }
#pragma unroll
        for (int ct = 0; ct < 4; ++ct) {
            f32x4_t ck = (f32x4_t){0.f, 0.f, 0.f, 0.f}, cq = ck;
#pragma unroll
            for (int ks = 0; ks < 4; ++ks) { ck = __builtin_amdgcn_mfma_f32_16x16x32_bf16(ka[ks], kf[ct][ks], ck, 0, 0, 0); cq = __builtin_amdgcn_mfma_f32_16x16x32_bf16(qf[ks], kf[ct][ks], cq, 0, 0, 0); }
            const int s = ct * 16 + fr; const float gs = gcs[s];
#pragma unroll
            for (int j = 0; j < 4; ++j) { const int l = rt * 16 + fq * 4 + j;
                const bool strict = z ? (s > l) : (s < l), incl = z ? (s >= l) : (s <= l);
                const float e = __expf(fminf(gcs[l] - gs, 0.f));
                const int lp = z ? 63 - l : l, sp = z ? 63 - s : s;
                Ap[lp * 64 + sp] = strict ? bes[l] * ck[j] * e : 0.f;
                QK[(((l >> 4) * 2 + (s >> 5)) * 64 + ((s >> 3) & 3) * 16 + (l & 15)) * 8 + (s & 7)] = f2bf(incl ? cq[j] * 0.08838834764831845f * e : 0.f); }
        }
    }
    float T[64];
#pragma unroll
    for (int i = 0; i < 64; ++i) {
        float t = (i == lane) ? 1.f : 0.f;
#pragma unroll
        for (int j4 = 0; j4 < (i + 3) / 4; ++j4) { const float4 a4 = *(const float4*)(Ap + i * 64 + j4 * 4);
            if (j4 * 4 + 0 < i) t -= a4.x * T[j4 * 4 + 0];
            if (j4 * 4 + 1 < i) t -= a4.y * T[j4 * 4 + 1];
            if (j4 * 4 + 2 < i) t -= a4.z * T[j4 * 4 + 2];
            if (j4 * 4 + 3 < i) t -= a4.w * T[j4 * 4 + 3];
            if ((j4 & 7) == 7) asm volatile("" : "+v"(t) :: "memory"); }
        T[i] = t;
        asm volatile("" : "+v"(T[i]) :: "memory");
    }
    const int sc = z ? 63 - lane : lane;
    u16* TMp = TM + ((sc >> 5) * 64 + ((sc >> 3) & 3) * 16) * 8 + (sc & 7);
    if (z) {
#pragma unroll
        for (int i = 0; i < 64; ++i) { const int l = 63 - i; TMp[(l >> 4) * 1024 + (l & 15) * 8] = f2bf(T[i]); }
    } else {
#pragma unroll
        for (int i = 0; i < 64; ++i) { const int l = i; TMp[(l >> 4) * 1024 + (l & 15) * 8] = f2bf(T[i]); }
    }
}
__device__ __forceinline__ void ph_l0_prepass(const Params& p, unsigned char* lds) {
    const int tid = tid_fresh(), lane = tid & 63, w = tid >> 6;
    float* wl = (float*)(lds + (size_t)w * 16896);
    const int gw = blockIdx.x * 8 + w, nw = gridDim.x * 8;
    for (int it = (gw + nw - 128) % nw; it < 4160; it += nw) ml_prep_item(p, it, wl, lane);
    for (int it = gw; it < 8320; it += nw) dn_prep_item(p, it, wl, lane);
}

struct MlFr { bf16x8_t q[4], at[2]; uint4 kr[2]; uint2 vr; float kw, b[4], cm[4], bL, cmL; };
__device__ __forceinline__ void ml_load(MlFr& F, const Params& p, int n, int b, int h, int dir, int e0, int lt, int fr, int fq, int tl, int seg) {
    const int nn = n < NSEG ? n : NSEG - 1;
    const int tt = tile_of(nn, b, dir), it = (dir * 520 + tt) * 4 + h, rowbase = rowbase_of(tt);
    const u16* PROJ = (const u16*)(p.ws + WS_PROJ);
    const u16* Q = PROJ + (size_t)(rowbase + lt * 16 + fq) * NP0 + h * 128 + fr * 8;
    const u16* AT = (const u16*)(p.ws + WS_ATT0) + (size_t)it * 4096 + lt * 1024 + (fq * 16 + fr) * 8;
    const float* MLS = (const float*)(p.ws + WS_MLS) + (size_t)it * 256;
#pragma unroll
    for (int ks = 0; ks < 4; ++ks) F.q[ks] = *(const bf16x8_t*)(Q + (size_t)ks * 4 * NP0);
#pragma unroll
    for (int ks = 0; ks < 2; ++ks) F.at[ks] = *(const bf16x8_t*)(AT + ks * 512);
    const u16* kp = PROJ + (size_t)(rowbase + ((tl >> 4) * 4 + (seg >> 1)) * 4 + (seg & 1) * 2) * NP0 + 512 + h * 128 + (tl & 15) * 8;
    F.kr[0] = *(const uint4*)(kp); F.kr[1] = *(const uint4*)(kp + NP0);
    F.vr = *(const uint2*)(PROJ + (size_t)(rowbase + tl) * NP0 + 1024 + h * 256 + e0 + seg * 4);
    F.kw = MLS[128 + tl];
#pragma unroll
    for (int j = 0; j < 4; ++j) { F.b[j] = MLS[lt * 16 + fq * 4 + j]; F.cm[j] = MLS[64 + lt * 16 + fq * 4 + j]; }
    F.bL = MLS[192]; F.cmL = MLS[193];
}
__device__ __forceinline__ void mlstm_chunk(const Params& p, int job, unsigned char* lds) {
    const int tid = tid_fresh(), lane = tid & 63, w = tid >> 6, fr = lane & 15, fq = lane >> 4;
    const int chain = job >> 3, cgp = job & 7;
    const int b = chain >> 3, h = (chain >> 1) & 3, dir = chain & 1;
    const int e0 = cgp * 32, lt = w >> 1, et = w & 1, dt0 = (w >> 1) * 2, tl = tid & 63, seg = tid >> 6;
    u16* Cl = (u16*)lds;
    u16* Ktw = (u16*)(lds + 17952);
    u16* Vt = (u16*)(lds + 17952 + 18432);
    u16* O = (u16*)(p.ws + (dir ? WS_OB : WS_OF));
    __syncthreads();
    for (int i = tid; i < 17952 / 4; i += NTHR) ((unsigned*)Cl)[i] = 0u;
    __syncthreads();
    f32x4_t Cacc[2], nacc; Cacc[0] = (f32x4_t){0.f, 0.f, 0.f, 0.f}; Cacc[1] = Cacc[0]; nacc = Cacc[0];
    float m_in = 0.f;
    bf16x8_t ones;
#pragma unroll
    for (int j = 0; j < 8; ++j) ones[j] = (short)0x3F80;
    MlFr buf[2];
    ml_load(buf[0], p, 0, b, h, dir, e0, lt, fr, fq, tl, seg); ml_load(buf[1], p, 1, b, h, dir, e0, lt, fr, fq, tl, seg);
    for (int n0 = 0; n0 < NSEG; n0 += 4) {
#pragma unroll
        for (int u = 0; u < 4; ++u) {
            const int n = n0 + u; const int s = u & 1;
            const MlFr& F = buf[s];
            const int tt = tile_of(n, b, dir), rowbase = rowbase_of(tt);
            const u16* Ccur = Cl + (n & 1) * (33 * 136); u16* Cnxt = Cl + ((n + 1) & 1) * (33 * 136);
            { float k[16]; unpack8(F.kr[0], k); unpack8(F.kr[1], k + 8);
#pragma unroll
                for (int c = 0; c < 16; ++c) Ktw[(seg * 16 + c) * 72 + tl] = f2bf(k[c] * F.kw);
                Vt[(seg * 4 + 0) * 72 + tl] = (u16)(F.vr.x & 0xffffu); Vt[(seg * 4 + 1) * 72 + tl] = (u16)(F.vr.x >> 16);
                Vt[(seg * 4 + 2) * 72 + tl] = (u16)(F.vr.y & 0xffffu); Vt[(seg * 4 + 3) * 72 + tl] = (u16)(F.vr.y >> 16); }
            __syncthreads();
            bf16x8_t vt[2];
#pragma unroll
            for (int ks = 0; ks < 2; ++ks) vt[ks] = *(const bf16x8_t*)(Vt + (et * 16 + fr) * 72 + ks * 32 + fq * 8);
            {
                f32x4_t inter = (f32x4_t){0.f, 0.f, 0.f, 0.f}, intra = inter, dinter = inter, dintra = inter;
#pragma unroll
                for (int ks = 0; ks < 4; ++ks) { const bf16x8_t cb = *(const bf16x8_t*)(Ccur + (et * 16 + fr) * 136 + ks * 32 + fq * 8); const bf16x8_t nb = *(const bf16x8_t*)(Ccur + 32 * 136 + ks * 32 + fq * 8);
                    inter = __builtin_amdgcn_mfma_f32_16x16x32_bf16(F.q[ks], cb, inter, 0, 0, 0); dinter = __builtin_amdgcn_mfma_f32_16x16x32_bf16(F.q[ks], nb, dinter, 0, 0, 0); }
#pragma unroll
                for (int ks = 0; ks < 2; ++ks) { intra = __builtin_amdgcn_mfma_f32_16x16x32_bf16(F.at[ks], vt[ks], intra, 0, 0, 0); dintra = __builtin_amdgcn_mfma_f32_16x16x32_bf16(F.at[ks], ones, dintra, 0, 0, 0); }
#pragma unroll
                for (int j = 0; j < 4; ++j) { const float M = fmaxf(F.cm[j], m_in); const float r = __expf(F.cm[j] - M), ei = __expf(m_in - M) * 0.08838834764831845f;
                    const float num = r * intra[j] + ei * inter[j], den = r * dintra[j] + ei * dinter[j];
                    const float hv = num * frcp(fmaxf(fabsf(den), __expf(-(F.b[j] + M))));
                    O[(size_t)(rowbase + lt * 16 + fq * 4 + j) * 2048 + h * 256 + e0 + et * 16 + fr] = f2bf(hv); }
            }
            { const float ML = fmaxf(F.cmL, m_in); const float a = __expf(m_in - ML), sc2 = __expf(F.cmL - ML); m_in = F.bL + ML;
#pragma unroll
                for (int i = 0; i < 2; ++i) { f32x4_t nw = (f32x4_t){0.f, 0.f, 0.f, 0.f};
#pragma unroll
                    for (int ks = 0; ks < 2; ++ks) { const bf16x8_t kb = *(const bf16x8_t*)(Ktw + ((dt0 + i) * 16 + fr) * 72 + ks * 32 + fq * 8); nw = __builtin_amdgcn_mfma_f32_16x16x32_bf16(vt[ks], kb, nw, 0, 0, 0); }
#pragma unroll
                    for (int j = 0; j < 4; ++j) { Cacc[i][j] = a * Cacc[i][j] + sc2 * nw[j]; Cnxt[(et * 16 + fq * 4 + j) * 136 + (dt0 + i) * 16 + fr] = f2bf(Cacc[i][j]); } }
                f32x4_t nw = (f32x4_t){0.f, 0.f, 0.f, 0.f};
#pragma unroll
                for (int ks = 0; ks < 2; ++ks) { const bf16x8_t kb = *(const bf16x8_t*)(Ktw + (w * 16 + fr) * 72 + ks * 32 + fq * 8); nw = __builtin_amdgcn_mfma_f32_16x16x32_bf16(ones, kb, nw, 0, 0, 0); }
                nacc[0] = a * nacc[0] + sc2 * nw[0];
                if (fq == 0) Cnxt[32 * 136 + w * 16 + fr] = f2bf(nacc[0]); }
            __syncthreads();
            ml_load(buf[s], p, n + 2, b, h, dir, e0, lt, fr, fq, tl, seg);
        }
    }
}

struct DnFr { bf16x8_t k[4], q[4], tm[2], qk[2]; uint4 kr[2]; float kds, egc[4], be[4], egL; u16 v[4]; };
__device__ __forceinline__ void dn_load(DnFr& F, const Params& p, int n, int b, int h, int dir, int e0, int lt, int et, int fr, int fq, int tl, int seg) {
    const int nn = n < NSEG ? n : NSEG - 1;
    const int tt = tile_of(nn, b, dir), it = (dir * 520 + tt) * 8 + h, rowbase = rowbase_of(tt);
    const bool isctx = tt < 8;
    const u16* qb = isctx ? (const u16*)(p.ws + WS_CQ) + (size_t)rowbase * 3072 + h * 128 : (const u16*)(p.ws + WS_PROJ) + (size_t)rowbase * NP0 + 3072 + h * 128;
    const int rs = isctx ? 3072 : NP0;
    const u16* TM = (const u16*)(p.ws + WS_TM) + (size_t)it * 4096 + lt * 1024 + (fq * 16 + fr) * 8;
    const u16* QK = (const u16*)(p.ws + WS_QK) + (size_t)it * 4096 + lt * 1024 + (fq * 16 + fr) * 8;
    const float* GCS = (const float*)(p.ws + WS_GCS) + (size_t)it * 256;
    const u16* qr = qb + (size_t)(lt * 16 + fq) * rs + fr * 8;
#pragma unroll
    for (int ks = 0; ks < 4; ++ks) { F.q[ks] = *(const bf16x8_t*)(qr + (size_t)ks * 4 * rs); F.k[ks] = *(const bf16x8_t*)(qr + (size_t)ks * 4 * rs + 1024); }
#pragma unroll
    for (int ks = 0; ks < 2; ++ks) { F.tm[ks] = *(const bf16x8_t*)(TM + ks * 512); F.qk[ks] = *(const bf16x8_t*)(QK + ks * 512); }
    const u16* kp = qb + (size_t)(((tl >> 4) * 4 + (seg >> 1)) * 4 + (seg & 1) * 2) * rs + 1024 + (tl & 15) * 8;
    F.kr[0] = *(const uint4*)(kp); F.kr[1] = *(const uint4*)(kp + rs);
    F.kds = GCS[128 + tl]; F.egL = GCS[192];
#pragma unroll
    for (int j = 0; j < 4; ++j) { const int l = lt * 16 + fq * 4 + j; F.egc[j] = GCS[l]; F.be[j] = GCS[64 + l]; F.v[j] = qb[(size_t)l * rs + 2048 + e0 + et * 16 + fr]; }
}
__device__ __forceinline__ void deltanet_chunk(const Params& p, int job, unsigned char* lds) {
    const int tid = tid_fresh(), lane = tid & 63, w = tid >> 6, fr = lane & 15, fq = lane >> 4;
    const int chain = job >> 2, cgp = job & 3;
    const int b = chain >> 4, h = (chain >> 1) & 7, dir = chain & 1;
    const int e0 = cgp * 32, lt = w >> 1, et = w & 1, dt0 = (w >> 1) * 2, tl = tid & 63, seg = tid >> 6;
    u16* Sl = (u16*)lds;
    u16* Rt = (u16*)(lds + 17408);
    u16* VNt = (u16*)(lds + 17408 + 4608);
    u16* Kdt = (u16*)(lds + 17408 + 9216);
    u16* O = (u16*)(p.ws + (dir ? WS_OB : WS_OF));
    __syncthreads();
    for (int i = tid; i < 17408 / 4; i += NTHR) ((unsigned*)Sl)[i] = 0u;
    __syncthreads();
    f32x4_t Sacc[2]; Sacc[0] = (f32x4_t){0.f, 0.f, 0.f, 0.f}; Sacc[1] = Sacc[0];
    DnFr buf[2];
    dn_load(buf[0], p, 0, b, h, dir, e0, lt, et, fr, fq, tl, seg); dn_load(buf[1], p, 1, b, h, dir, e0, lt, et, fr, fq, tl, seg);
    for (int n0 = 0; n0 < NSEG; n0 += 4) {
#pragma unroll
        for (int u = 0; u < 4; ++u) {
            const int n = n0 + u; const int s = u & 1;
            const DnFr& F = buf[s];
            const int tt = tile_of(n, b, dir), rowbase = rowbase_of(tt);
            const u16* Scur = Sl + (n & 1) * (32 * 136); u16* Snxt = Sl + ((n + 1) & 1) * (32 * 136);
            f32x4_t X = (f32x4_t){0.f, 0.f, 0.f, 0.f}, Y = X;
#pragma unroll
            for (int ks = 0; ks < 4; ++ks) { const bf16x8_t sb = *(const bf16x8_t*)(Scur + (et * 16 + fr) * 136 + ks * 32 + fq * 8);
                X = __builtin_amdgcn_mfma_f32_16x16x32_bf16(F.k[ks], sb, X, 0, 0, 0); Y = __builtin_amdgcn_mfma_f32_16x16x32_bf16(F.q[ks], sb, Y, 0, 0, 0); }
#pragma unroll
            for (int j = 0; j < 4; ++j) Rt[(et * 16 + fr) * 72 + lt * 16 + fq * 4 + j] = f2bf(F.be[j] * (bf2f(F.v[j]) - F.egc[j] * X[j]));
            { float k[16]; unpack8(F.kr[0], k); unpack8(F.kr[1], k + 8);
#pragma unroll
                for (int c = 0; c < 16; ++c) Kdt[(seg * 16 + c) * 72 + tl] = f2bf(k[c] * F.kds); }
            __syncthreads();
            { f32x4_t VN = (f32x4_t){0.f, 0.f, 0.f, 0.f};
#pragma unroll
                for (int ks = 0; ks < 2; ++ks) { const bf16x8_t rb = *(const bf16x8_t*)(Rt + (et * 16 + fr) * 72 + ks * 32 + fq * 8); VN = __builtin_amdgcn_mfma_f32_16x16x32_bf16(F.tm[ks], rb, VN, 0, 0, 0); }
#pragma unroll
                for (int j = 0; j < 4; ++j) VNt[(et * 16 + fr) * 72 + lt * 16 + fq * 4 + j] = f2bf(VN[j]); }
            __syncthreads();
            bf16x8_t vn[2];
#pragma unroll
            for (int ks = 0; ks < 2; ++ks) vn[ks] = *(const bf16x8_t*)(VNt + (et * 16 + fr) * 72 + ks * 32 + fq * 8);
            { f32x4_t acc = (f32x4_t){0.f, 0.f, 0.f, 0.f};
#pragma unroll
                for (int ks = 0; ks < 2; ++ks) acc = __builtin_amdgcn_mfma_f32_16x16x32_bf16(F.qk[ks], vn[ks], acc, 0, 0, 0);
#pragma unroll
                for (int j = 0; j < 4; ++j) O[(size_t)(rowbase + lt * 16 + fq * 4 + j) * 2048 + 1024 + h * 128 + e0 + et * 16 + fr] = f2bf(0.08838834764831845f * F.egc[j] * Y[j] + acc[j]); }
#pragma unroll
            for (int i = 0; i < 2; ++i) { f32x4_t nw = (f32x4_t){0.f, 0.f, 0.f, 0.f};
#pragma unroll
                for (int ks = 0; ks < 2; ++ks) { const bf16x8_t kb = *(const bf16x8_t*)(Kdt + ((dt0 + i) * 16 + fr) * 72 + ks * 32 + fq * 8); nw = __builtin_amdgcn_mfma_f32_16x16x32_bf16(vn[ks], kb, nw, 0, 0, 0); }
#pragma unroll
                for (int j = 0; j < 4; ++j) { Sacc[i][j] = F.egL * Sacc[i][j] + nw[j]; Snxt[(et * 16 + fq * 4 + j) * 136 + (dt0 + i) * 16 + fr] = f2bf(Sacc[i][j]); } }
            __syncthreads();
            dn_load(buf[s], p, n + 2, b, h, dir, e0, lt, et, fr, fq, tl, seg);
        }
    }
}

constexpr int RG_XC = 65536;

__device__ __forceinline__ void ph_convert_rg(const Params& p) {
    u16* WRT = (u16*)(p.ws + WS_WRT);
    for (int idx = blockIdx.x * NTHR + tid_fresh(); idx < 65536; idx += gridDim.x * NTHR) {
        const int k8 = idx & 15, n = (idx >> 4) & 127, mzg = idx >> 11;
        const float* W = (mzg < 16 ? p.rg_w_r : p.rg_w_i) + (size_t)(mzg & 15) * 16384;
        float v[8];
#pragma unroll
        for (int j = 0; j < 8; ++j) v[j] = W[(k8 * 8 + j) * 128 + n];
        *(uint4*)(WRT + (size_t)mzg * 16384 + (((n >> 4) * 4 + (k8 >> 2)) * 64 + (k8 & 3) * 16 + (n & 15)) * 8) = pack8(v);
    }
}
__device__ __forceinline__ int rg_tau(int tt, int z) { if (tt < 8) { const int ci = tt & 3; return z ? 3 - ci : ci; } const int li = (tt - 8) & 255; return 4 + (z ? 255 - li : li); }
__device__ __forceinline__ int rg_batch(int tt) { return tt < 8 ? (tt >> 2) : ((tt - 8) >> 8); }

__device__ __forceinline__ void rg_conv(const Params& p, int tt, int g, unsigned char* lds) {
    const int tid = tid_fresh();
    const u16* PROJ = (const u16*)(p.ws + WS_PROJ);
    u16* XC = (u16*)(lds + RG_XC);
    const bool isctx = tt < 8;
    const int t0 = isctx ? (tt & 3) * 64 : 0;
    const int rowbase = isctx ? (tt >> 2) * 256 + t0 : 512 + (tt - 8) * 64;
    const int tk = tid >> 3, cs = (tid & 7) * 16;
    uint4 in[5][2];
#pragma unroll
    for (int j = 0; j < 5; ++j) { const int r = tk + j - 2;
        const bool ok = isctx ? (t0 + r >= 0 && t0 + r < 256) : (r >= 0 && r < 64);
        in[j][0] = make_uint4(0u, 0u, 0u, 0u); in[j][1] = in[j][0];
        if (ok) { const u16* src = PROJ + (size_t)(rowbase + r) * NP1 + g * 128 + cs; in[j][0] = *(const uint4*)(src); in[j][1] = *(const uint4*)(src + 8); } }
    float o[16];
#pragma unroll
    for (int c4 = 0; c4 < 4; ++c4) { const float4 b4 = *(const float4*)(p.rg_conv_b + g * 128 + cs + c4 * 4); o[c4 * 4] = b4.x; o[c4 * 4 + 1] = b4.y; o[c4 * 4 + 2] = b4.z; o[c4 * 4 + 3] = b4.w; }
#pragma unroll
    for (int j = 0; j < 5; ++j) {
        const float* wr_ = p.rg_conv_w + j * 1024 + g * 128 + cs; float f[16]; unpack8(in[j][0], f); unpack8(in[j][1], f + 8);
#pragma unroll
        for (int c4 = 0; c4 < 4; ++c4) { const float4 w4 = *(const float4*)(wr_ + c4 * 4);
            o[c4 * 4 + 0] += f[c4 * 4 + 0] * w4.x; o[c4 * 4 + 1] += f[c4 * 4 + 1] * w4.y; o[c4 * 4 + 2] += f[c4 * 4 + 2] * w4.z; o[c4 * 4 + 3] += f[c4 * 4 + 3] * w4.w; }
    }
    __syncthreads();
    *(uint4*)(XC + tk * 136 + cs) = pack8(o); *(uint4*)(XC + tk * 136 + cs + 8) = pack8(o + 8);
    __syncthreads();
}
__device__ __forceinline__ void rg_gates_reg(const Params& p, int g, int z, const unsigned char* lds, int rt, int chh, int fr, int fq, float (&av)[4][4], float (&bx)[4][4]) {
    const u16* XC = (const u16*)(lds + RG_XC);
    const u16* WR = (const u16*)(p.ws + WS_WRT) + (size_t)((0 * 2 + z) * 8 + g) * 16384; const u16* WI = (const u16*)(p.ws + WS_WRT) + (size_t)((1 * 2 + z) * 8 + g) * 16384;
    f32x4_t R[4], I[4];
#pragma unroll
    for (int c = 0; c < 4; ++c) { R[c] = (f32x4_t){0.f, 0.f, 0.f, 0.f}; I[c] = (f32x4_t){0.f, 0.f, 0.f, 0.f}; }
#pragma unroll
    for (int ks = 0; ks < 4; ++ks) {
        const bf16x8_t a = *(const bf16x8_t*)(XC + (rt * 16 + fr) * 136 + ks * 32 + fq * 8);
#pragma unroll
        for (int c = 0; c < 4; ++c) { const int fo = (((chh * 4 + c) * 4 + ks) * 64 + fq * 16 + fr) * 8;
            R[c] = __builtin_amdgcn_mfma_f32_16x16x32_bf16(a, *(const bf16x8_t*)(WR + fo), R[c], 0, 0, 0);
            I[c] = __builtin_amdgcn_mfma_f32_16x16x32_bf16(a, *(const bf16x8_t*)(WI + fo), I[c], 0, 0, 0); }
    }
#pragma unroll
    for (int c = 0; c < 4; ++c) {
        const int chl = (chh * 4 + c) * 16 + fr, chg = z * 1024 + g * 128 + chl;
        const float br = p.rg_b_r[chg], bi = p.rg_b_i[chg], sp = softplusf_(-p.rg_lambda[chg]);
#pragma unroll
        for (int j = 0; j < 4; ++j) { const int t = rt * 16 + fq * 4 + j;
            const float r = sigmoidf_(R[c][j] + br), ii = sigmoidf_(I[c][j] + bi);
            const float la = -8.f * r * sp;
            av[c][j] = __expf(la); bx[c][j] = __builtin_amdgcn_sqrtf(neg_expm1_small(2.f * la)) * ii * bf2f(XC[t * 136 + chl]); }
    }
}
__device__ __forceinline__ float2 rg_local(const float (&a)[4], const float (&b)[4], int z) {
    float P = 1.f, H = 0.f;
#pragma unroll
    for (int i = 0; i < 4; ++i) { const int j = z ? 3 - i : i; H = a[j] * H + b[j]; P *= a[j]; }
    return make_float2(P, H);
}
__device__ __forceinline__ void gla_prep_item(const Params& p, int it, unsigned char* lds) {
    const int tid = tid_fresh(), lane = tid & 63, w = tid >> 6, fr = lane & 15, fq = lane >> 4;
    const int h = it & 3, tt = (it >> 2) % 520, z = it / 2080;
    const int rowbase = tt < 8 ? tt * 64 : 512 + (tt - 8) * 64;
    float* LG = (float*)lds;
    u16* QEs = (u16*)(lds + 32768);
    u16* KEs = (u16*)(lds + 32768 + 17408);
    u16* Vs = (u16*)(lds + 32768 + 2 * 17408);
    float* BLs = (float*)(lds + 32768 + 2 * 17408 + 33792);
    const u16* PROJ = (const u16*)(p.ws + WS_PROJ); const float* LR = (const float*)(p.ws + WS_G);
    u16* QE = (u16*)(p.ws + WS_QE); u16* KDT = (u16*)(p.ws + WS_KDT) + (size_t)it * 8192; u16* ATT = (u16*)(p.ws + WS_ATT) + (size_t)it * 4096;
    u16* VT = (u16*)(p.ws + WS_VT); float* EBL = (float*)(p.ws + WS_EBL);
    __syncthreads();
    { float* LRs = (float*)(lds + 32768);
        for (int i = tid; i < 1024; i += NTHR) LRs[i] = LR[(size_t)(rowbase + (i >> 4)) * 32 + z * 16 + (i & 15)];
        __syncthreads();
        const int c = tid & 127, tq = tid >> 7; float wv[16];
#pragma unroll
        for (int r = 0; r < 16; ++r) wv[r] = p.gla_w_up[(z * 16 + r) * 512 + h * 128 + c];
        const float bu = p.gla_b_up[z * 512 + h * 128 + c];
        for (int i = 0; i < 16; ++i) { const int tk = tq * 16 + i; const float4* lr4 = (const float4*)(LRs + tk * 16); float s = bu;
#pragma unroll
            for (int r4 = 0; r4 < 4; ++r4) { const float4 l4 = lr4[r4]; s += l4.x * wv[r4 * 4] + l4.y * wv[r4 * 4 + 1] + l4.z * wv[r4 * 4 + 2] + l4.w * wv[r4 * 4 + 3]; }
            LG[tk * 128 + c] = logsigmoidf_(s) * (1.f / 16.f); } }
    __syncthreads();
    if (tid < 128) { float acc = 0.f;
        for (int i = 0; i < 64; ++i) { const int tk = z ? 63 - i : i; acc += LG[tk * 128 + tid]; LG[tk * 128 + tid] = acc; }
        BLs[tid] = acc; EBL[(size_t)it * 128 + tid] = __expf(acc); }
    __syncthreads();
    { const int tk = tid >> 3, cs = (tid & 7) * 16; const u16* rp = PROJ + (size_t)(rowbase + tk) * NP1;
        float q[16], k[16], qe[16], ke[16];
        unpack8(*(const uint4*)(rp + 2048 + h * 128 + cs), q); unpack8(*(const uint4*)(rp + 2048 + h * 128 + cs + 8), q + 8);
        unpack8(*(const uint4*)(rp + 2560 + h * 128 + cs), k); unpack8(*(const uint4*)(rp + 2560 + h * 128 + cs + 8), k + 8);
#pragma unroll
        for (int c = 0; c < 16; ++c) { const float bb = LG[tk * 128 + cs + c], bl = BLs[cs + c];
            qe[c] = q[c] * 0.08838834764831845f * __expf(bb); ke[c] = k[c] * __expf(-bb);
            { const int d = cs + c; KDT[(((d >> 4) * 2 + (tk >> 5)) * 64 + ((tk >> 3) & 3) * 16 + (d & 15)) * 8 + (tk & 7)] = f2bf(k[c] * __expf(bl - bb)); } }
        const uint4 q0 = pack8(qe), q1 = pack8(qe + 8);
        *(uint4*)(QEs + tk * 136 + cs) = q0; *(uint4*)(QEs + tk * 136 + cs + 8) = q1;
        *(uint4*)(KEs + tk * 136 + cs) = pack8(ke); *(uint4*)(KEs + tk * 136 + cs + 8) = pack8(ke + 8);
        u16* qg = QE + (size_t)it * 8192 + (((tk >> 4) * 4 + (cs >> 5)) * 64 + ((cs >> 3) & 3) * 16 + (tk & 15)) * 8;
        *(uint4*)(qg) = q0; *(uint4*)(qg + 128) = q1; }
    if (z == 0) for (int ch = tid; ch < 2048; ch += NTHR) { const int tk = ch >> 5, c8 = (ch & 31) * 8;
        *(uint4*)(Vs + tk * 264 + c8) = *(const uint4*)(PROJ + (size_t)(rowbase + tk) * NP1 + 3072 + h * 256 + c8); }
    __syncthreads();
    { const int rt = w >> 1;
#pragma unroll
        for (int i = 0; i < 2; ++i) { const int ct = (w & 1) * 2 + i; f32x4_t acc = (f32x4_t){0.f, 0.f, 0.f, 0.f};
#pragma unroll
            for (int ks = 0; ks < 4; ++ks) { const bf16x8_t a = *(const bf16x8_t*)(QEs + (rt * 16 + fr) * 136 + ks * 32 + fq * 8); const bf16x8_t bb = *(const bf16x8_t*)(KEs + (ct * 16 + fr) * 136 + ks * 32 + fq * 8);
                acc = __builtin_amdgcn_mfma_f32_16x16x32_bf16(a, bb, acc, 0, 0, 0); }
#pragma unroll
            for (int j = 0; j < 4; ++j) { const int l = rt * 16 + fq * 4 + j, s = ct * 16 + fr; const bool keep = z ? (s >= l) : (s <= l);
                ATT[(((l >> 4) * 2 + (s >> 5)) * 64 + ((s >> 3) & 3) * 16 + (l & 15)) * 8 + (s & 7)] = f2bf(keep ? acc[j] : 0.f); } } }
    if (z == 0) { const int e = tid >> 1, hf = tid & 1; u16* dst = VT + (size_t)(tt * 4 + h) * 16384 + (((e >> 4) * 2 + hf) * 64 + (e & 15)) * 8;
#pragma unroll
        for (int l8 = 0; l8 < 4; ++l8) { float v[8];
#pragma unroll
            for (int j = 0; j < 8; ++j) v[j] = bf2f(Vs[(hf * 32 + l8 * 8 + j) * 264 + e]);
            *(uint4*)(dst + l8 * 128) = pack8(v); } }
}
__device__ __forceinline__ void ph_l1_a(const Params& p, unsigned char* lds, int parts = 3) {
    const int tid = tid_fresh(), lane = tid & 63, w = tid >> 6, rt = w >> 1, chh = w & 1, fr = lane & 15, fq = lane >> 4;
    float2* AGG = (float2*)(p.ws + WS_AGG);
    float2* AG = (float2*)lds;
    if (parts & 1) for (int t = blockIdx.x; t < 520 * 8; t += gridDim.x) {
        const int tt = t >> 3, g = t & 7, b = rg_batch(tt);
        rg_conv(p, tt, g, lds);
#pragma unroll
        for (int z = 0; z < 2; ++z) {
            float av[4][4], bx[4][4];
            rg_gates_reg(p, g, z, lds, rt, chh, fr, fq, av, bx);
#pragma unroll
            for (int c = 0; c < 4; ++c) AG[(z * 16 + rt * 4 + fq) * 128 + (chh * 4 + c) * 16 + fr] = rg_local(av[c], bx[c], z);
        }
        __syncthreads();
        if (tid < 256) { const int z = tid >> 7, ch = tid & 127; float P = 1.f, H = 0.f;
#pragma unroll
            for (int s = 0; s < 16; ++s) { const int gi = z ? 15 - s : s; const float2 ph = AG[(z * 16 + gi) * 128 + ch]; H = ph.x * H + ph.y; P *= ph.x; }
            AGG[((size_t)(b * 2 + z) * NSEG + rg_tau(tt, z)) * 1024 + g * 128 + ch] = make_float2(P, H); }
    }
    if (parts & 2) for (int it = blockIdx.x; it < 4160; it += gridDim.x) gla_prep_item(p, it, lds);
}
__device__ __forceinline__ void rg_pass_b(const Params& p, int job) {
    const float2* __restrict__ AGG = (const float2*)(p.ws + WS_AGG); float* __restrict__ CARRY = (float*)(p.ws + WS_CARRY);
    const int bz = job >> 1, ch = (job & 1) * 512 + tid_fresh();
    float carry = 0.f;
    for (int t0 = 0; t0 < NSEG; t0 += 20) {
        float2 ph[20];
#pragma unroll
        for (int i = 0; i < 20; ++i) ph[i] = AGG[((size_t)bz * NSEG + t0 + i) * 1024 + ch];
#pragma unroll
        for (int i = 0; i < 20; ++i) { CARRY[((size_t)bz * NSEG + t0 + i) * 1024 + ch] = carry; carry = ph[i].x * carry + ph[i].y; }
    }
}
struct GlaFr { bf16x8_t qe[4], at[2], vt[2], kd[2][2]; float eb[2]; };
struct GlaOff { int qe, at, vt, kd, eb, o; };
__device__ __forceinline__ void gla_load(GlaFr& F, const unsigned char* ws, int n, int b, int h, int dir, const GlaOff& o) {
    const int nn = n < NSEG ? n : NSEG - 1;
    const int tt = tile_of(nn, b, dir), it = (dir * 520 + tt) * 4 + h, rowbase = rowbase_of(tt);
    const u16* QE = (const u16*)(ws + WS_QE) + (size_t)it * 8192;
    const u16* AT = (const u16*)(ws + WS_ATT) + (size_t)it * 4096;
    const u16* VT = (const u16*)(ws + WS_VT) + (size_t)(tt * 4 + h) * 16384;
    const u16* KD = (const u16*)(ws + WS_KDT) + (size_t)it * 8192;
    const float* EB = (const float*)(ws + WS_EBL) + (size_t)it * 128;
#pragma unroll
    for (int ks = 0; ks < 4; ++ks) F.qe[ks] = *(const bf16x8_t*)(QE + o.qe + ks * 512);
#pragma unroll
    for (int ks = 0; ks < 2; ++ks) { F.at[ks] = *(const bf16x8_t*)(AT + o.at + ks * 512); F.vt[ks] = *(const bf16x8_t*)(VT + o.vt + ks * 512);
        F.kd[0][ks] = *(const bf16x8_t*)(KD + o.kd + ks * 512); F.kd[1][ks] = *(const bf16x8_t*)(KD + o.kd + 1024 + ks * 512); }
    F.eb[0] = EB[o.eb]; F.eb[1] = EB[o.eb + 16];
}
__device__ __forceinline__ void gla_chunk(const Params& p, int job, unsigned char* lds) {
    const int tid = tid_fresh(), lane = tid & 63, w = __builtin_amdgcn_readfirstlane(tid >> 6), fr = lane & 15, fq = lane >> 4;
    const int chain = job >> 3, cgp = job & 7;
    const int b = chain >> 3, h = (chain >> 1) & 3, dir = chain & 1;
    const int e0 = cgp * 32, lt = w >> 1, et = w & 1, dt0 = (w >> 1) * 2;
    const unsigned char* ws = p.ws;
    GlaOff o;
    o.qe = lt * 2048 + lane * 8; o.at = lt * 1024 + lane * 8; o.vt = ((e0 >> 4) + et) * 1024 + lane * 8;
    o.kd = dt0 * 1024 + lane * 8; o.eb = dt0 * 16 + fr; o.o = (lt * 16 + fq * 4) * 1024 + h * 256 + e0 + et * 16 + fr;
    u16* Sl = (u16*)lds;
    u16* O = (u16*)(p.ws + (dir ? WS_OB1 : WS_OF1));
    const int sRd = (et * 16 + fr) * 136 + fq * 8, sWr = (et * 16 + fq * 4) * 136 + dt0 * 16 + fr;
    __syncthreads();
    for (int i = tid; i < 2 * 32 * 136 / 2; i += NTHR) ((unsigned*)Sl)[i] = 0u;
    __syncthreads();
    f32x4_t Sacc[2]; Sacc[0] = (f32x4_t){0.f, 0.f, 0.f, 0.f}; Sacc[1] = Sacc[0];
    GlaFr buf[2];
    gla_load(buf[0], ws, 0, b, h, dir, o); gla_load(buf[1], ws, 1, b, h, dir, o);
    for (int n0 = 0; n0 < NSEG; n0 += 4) {
#pragma unroll
        for (int u = 0; u < 4; ++u) {
            const int n = n0 + u; const int s = u & 1;
            const GlaFr& F = buf[s];
            const u16* Scur = Sl + (n & 1) * (32 * 136); u16* Snxt = Sl + ((n + 1) & 1) * (32 * 136);
            if (n >= 4) {
                const int tt = tile_of(n, b, dir);
                u16* Ou = O + (size_t)(512 + (tt - 8) * 64) * 1024;
                f32x4_t acc = (f32x4_t){0.f, 0.f, 0.f, 0.f};
#pragma unroll
                for (int ks = 0; ks < 4; ++ks) { const bf16x8_t bb = *(const bf16x8_t*)(Scur + sRd + ks * 32); acc = __builtin_amdgcn_mfma_f32_16x16x32_bf16(F.qe[ks], bb, acc, 0, 0, 0); }
#pragma unroll
                for (int ks = 0; ks < 2; ++ks) acc = __builtin_amdgcn_mfma_f32_16x16x32_bf16(F.at[ks], F.vt[ks], acc, 0, 0, 0);
#pragma unroll
                for (int j = 0; j < 4; ++j) Ou[o.o + j * 1024] = f2bf(acc[j]);
            }
#pragma unroll
            for (int i = 0; i < 2; ++i) { f32x4_t nw = (f32x4_t){0.f, 0.f, 0.f, 0.f};
#pragma unroll
                for (int ks = 0; ks < 2; ++ks) nw = __builtin_amdgcn_mfma_f32_16x16x32_bf16(F.vt[ks], F.kd[i][ks], nw, 0, 0, 0);
#pragma unroll
                for (int j = 0; j < 4; ++j) { Sacc[i][j] = F.eb[i] * Sacc[i][j] + nw[j]; Snxt[sWr + j * 136 + i * 16] = f2bf(Sacc[i][j]); } }
            __syncthreads();
            gla_load(buf[s], ws, n + 2, b, h, dir, o);
        }
    }
}
__device__ __forceinline__ void ph_l1_c(const Params& p, unsigned char* lds, int t_lo, int t_hi, int first, int stride, int do_merge) {
    const int tid = tid_fresh(), rt = (tid >> 6) >> 1, chh = (tid >> 6) & 1, fr = tid & 15, fq = (tid & 63) >> 4;
    const u16* PROJ = (const u16*)(p.ws + WS_PROJ); const float* CARRY = (const float*)(p.ws + WS_CARRY); u16* Y = (u16*)(p.ws + WS_H);
    float2* AG = (float2*)lds;
    float* CIN = (float*)(lds + 32768);
    for (int t = t_lo + first; t < t_hi; t += stride) {
        const int tt = t >> 3, g = t & 7, b = rg_batch(tt);
        const int rowbase = 512 + (tt - 8) * 64;
        rg_conv(p, tt, g, lds);
        u16 grv[4][4];
#pragma unroll
        for (int c = 0; c < 4; ++c)
#pragma unroll
            for (int j = 0; j < 4; ++j) grv[c][j] = PROJ[(size_t)(rowbase + rt * 16 + fq * 4 + j) * NP1 + 1024 + g * 128 + (chh * 4 + c) * 16 + fr];
        float av[2][4][4], bx[2][4][4];
#pragma unroll
        for (int z = 0; z < 2; ++z) {
            rg_gates_reg(p, g, z, lds, rt, chh, fr, fq, av[z], bx[z]);
#pragma unroll
            for (int c = 0; c < 4; ++c) AG[(z * 16 + rt * 4 + fq) * 128 + (chh * 4 + c) * 16 + fr] = rg_local(av[z][c], bx[z][c], z);
        }
        __syncthreads();
        if (tid < 256) { const int z = tid >> 7, ch = tid & 127; float h = CARRY[((size_t)(b * 2 + z) * NSEG + rg_tau(tt, z)) * 1024 + g * 128 + ch];
#pragma unroll
            for (int s = 0; s < 16; ++s) { const int gi = z ? 15 - s : s; CIN[(z * 16 + gi) * 128 + ch] = h; const float2 ph = AG[(z * 16 + gi) * 128 + ch]; h = ph.x * h + ph.y; } }
        __syncthreads();
#pragma unroll
        for (int c = 0; c < 4; ++c) { const int chl = (chh * 4 + c) * 16 + fr; float hs[4];
            { float h = CIN[(0 * 16 + rt * 4 + fq) * 128 + chl];
#pragma unroll
                for (int j = 0; j < 4; ++j) { h = av[0][c][j] * h + bx[0][c][j]; hs[j] = h; } }
            { float h = CIN[(1 * 16 + rt * 4 + fq) * 128 + chl];
#pragma unroll
                for (int j = 3; j >= 0; --j) { h = av[1][c][j] * h + bx[1][c][j]; hs[j] += h; } }
#pragma unroll
            for (int j = 0; j < 4; ++j) Y[(size_t)(rowbase + rt * 16 + fq * 4 + j) * 2048 + g * 128 + chl] = f2bf(gelu_tanh(bf2f(grv[c][j])) * hs[j]); }
    }
    const int lane = tid & 63, w = tid >> 6;
    const u16* OF = (const u16*)(p.ws + WS_OF1); const u16* OB = (const u16*)(p.ws + WS_OB1);
    if (do_merge) for (int row = 512 + blockIdx.x * 8 + w; row < MTOT; row += gridDim.x * 8) {
        float o[2][8], ssq[2];
#pragma unroll
        for (int k = 0; k < 2; ++k) { const int col = (k * 64 + lane) * 8; float a[8], bb[8];
            unpack8(*(const uint4*)(OF + (size_t)row * 1024 + col), a); unpack8(*(const uint4*)(OB + (size_t)row * 1024 + col), bb);
            float s = 0.f;
#pragma unroll
            for (int j = 0; j < 8; ++j) { o[k][j] = a[j] + bb[j]; s += o[k][j] * o[k][j]; }
            s = red16(s); s += __shfl_xor(s, 16); ssq[k] = s; }
#pragma unroll
        for (int k = 0; k < 2; ++k) { const int col = (k * 64 + lane) * 8; const float rstd = rsqrtf(ssq[k] * (1.f / 256.f) + 1e-6f);
            float gt[8], r[8]; unpack8(*(const uint4*)(PROJ + (size_t)row * NP1 + 4096 + col), gt);
            const float4 g0 = *(const float4*)(p.gla_norm_g + col), g1 = *(const float4*)(p.gla_norm_g + col + 4); const float gg[8] = {g0.x, g0.y, g0.z, g0.w, g1.x, g1.y, g1.z, g1.w};
#pragma unroll
            for (int j = 0; j < 8; ++j) r[j] = o[k][j] * rstd * gg[j] * siluf_(gt[j]);
            *(uint4*)(Y + (size_t)row * 2048 + 1024 + col) = pack8(r); }
    }
}

#define XB_TMO      128
#define XB_XCNT(j)  (256  + 64 * (j))
#define XB_XSUB(j)  (1280 + 64 * (j))
#define XB_XGEN(j)  (2304 + 64 * (j))
#define XB_TOP      3328
#define XB_TOPGEN   3392
#define XCD_BAR_WORDS 3456
#define XB_SPIN_CAP (1u << 18)
#define XLAS __attribute__((address_space(3)))

__device__ __forceinline__ unsigned xb_ld(unsigned* p)              { return __hip_atomic_load(p, __ATOMIC_RELAXED, __HIP_MEMORY_SCOPE_AGENT); }
__device__ __forceinline__ unsigned xb_add(unsigned* p, unsigned v) { return __hip_atomic_fetch_add(p, v, __ATOMIC_RELAXED, __HIP_MEMORY_SCOPE_AGENT); }
__device__ __forceinline__ unsigned xb_xcc_id() { return (unsigned)__builtin_amdgcn_s_getreg((3 << 11) | 20) & 0xFu; }
#define XB_SPIN(cond, bar) do { unsigned _sp = 0; while (cond) { __builtin_amdgcn_s_sleep(1); \
    if ((++_sp & 255u) == 0u) { if (xb_ld(&(bar)[XB_TMO])) break; if (_sp > XB_SPIN_CAP) { atomicAdd(&(bar)[XB_TMO], 1u); break; } } } } while (0)

struct XcdBarrier {
    unsigned* bar; unsigned x;
    volatile XLAS unsigned* st;
};

__device__ __forceinline__ XcdBarrier xcd_barrier_post(unsigned* bar, volatile XLAS unsigned* st) {
    XcdBarrier b; b.bar = bar; b.x = xb_xcc_id(); b.st = st;
    if (threadIdx.x == 0) (void)xb_add(&bar[XB_XCNT(b.x)], 1u);
    return b;
}
__device__ __forceinline__ void xcd_barrier_complete(unsigned* bar, unsigned x, unsigned& nloc, unsigned& nx) {
    const unsigned G = gridDim.x * gridDim.y * gridDim.z;
    unsigned sum, cnt, mine, sp = 0u;
    for (;;) {
        sum = 0u; cnt = 0u; mine = 0u;
#pragma unroll
        for (unsigned j = 0; j < 16; ++j) { const unsigned c = xb_ld(&bar[XB_XCNT(j)]); sum += c; cnt += (c > 0u) ? 1u : 0u; mine = (j == x) ? c : mine; }
        if (sum == G) break;
        __builtin_amdgcn_s_sleep(1);
        if ((++sp & 255u) == 0u) { if (xb_ld(&bar[XB_TMO])) break; if (sp > XB_SPIN_CAP) { atomicAdd(&bar[XB_TMO], 1u); break; } }
    }
    nloc = mine > 0u ? mine : 1u; nx = cnt > 0u ? cnt : 1u;
}

__device__ __forceinline__ void xcd_barrier(const XcdBarrier& b) {
    asm volatile("s_waitcnt vmcnt(0)" ::: "memory");
    __syncthreads();
    if (threadIdx.x == 0) {
        unsigned* bar = b.bar;
        __builtin_amdgcn_s_waitcnt(0);
        unsigned nloc = b.st[0], nx = b.st[1];
        if (nloc == 0u) { xcd_barrier_complete(bar, b.x, nloc, nx); b.st[0] = nloc; b.st[1] = nx; }
        const unsigned old = xb_add(&bar[XB_XSUB(b.x)], 1u);
        const unsigned gen = old / nloc;
        if (old + 1u == (gen + 1u) * nloc) {
            __builtin_amdgcn_fence(__ATOMIC_RELEASE, "agent");
            asm volatile("s_waitcnt vmcnt(0)" ::: "memory");
            const unsigned og = xb_add(&bar[XB_TOP], 1u);
            const unsigned tg = og / nx;
            if (og + 1u == (tg + 1u) * nx) xb_add(&bar[XB_TOPGEN], 1u);
            else XB_SPIN(xb_ld(&bar[XB_TOPGEN]) == tg, bar);
            __builtin_amdgcn_fence(__ATOMIC_ACQUIRE, "agent");
            xb_add(&bar[XB_XGEN(b.x)], 1u);
            asm volatile("s_waitcnt vmcnt(0)" ::: "memory");
        } else {
            XB_SPIN(xb_ld(&bar[XB_XGEN(b.x)]) == gen, bar);
            __builtin_amdgcn_fence(__ATOMIC_ACQUIRE, "agent");
            asm volatile("s_waitcnt vmcnt(0)" ::: "memory");
        }
    }
    __syncthreads();
}

constexpr int LDS_BYTES = 135168 + 16;
constexpr int L1C_SPLIT = 64 + 2048;

__global__ void __launch_bounds__(NTHR, 2) hybrid_fwd(Params p) {
    extern __shared__ __attribute__((aligned(16))) unsigned char lds[];
    cg::grid_group grid = cg::this_grid();
    float* smf = (float*)lds;
    PG8_LAS unsigned char* ldsg = (PG8_LAS unsigned char*)lds;
    unsigned char* ws = p.ws;
    u16* WT_IN = (u16*)(ws + WS_WT_IN); u16* WT_OUT = (u16*)(ws + WS_WT_OUT); u16* WT_GU = (u16*)(ws + WS_WT_GU); u16* WT_DN = (u16*)(ws + WS_WT_DN);
    u16* H = (u16*)(ws + WS_H); u16* PROJ = (u16*)(ws + WS_PROJ); float* XC = (float*)(ws + WS_XC); float* G = (float*)(ws + WS_G);
    const float* MOD = (const float*)(ws + WS_MOD);
    const int GD = (int)gridDim.x, bid = (int)blockIdx.x;
    const int vb = (GD % 8 == 0) ? (bid % 8) * (GD / 8) + bid / 8 : bid;
    volatile XLAS unsigned* xst = (volatile XLAS unsigned*)((PG8_LAS unsigned char*)lds + 135168);
    if (threadIdx.x < 2) xst[threadIdx.x] = 0u;
    __syncthreads();
    const XcdBarrier xbar = xcd_barrier_post((unsigned*)(ws + WS_BAR), xst);

    ph_adaln_partials(p, smf);
    ph_convert_rg(p);
    ph_convert<1>(p.ab_w_in, 7216, 2048, 7424, WT_IN, smf);
    ph_convert<0>(p.ab_w_out, 2048, 2048, 2048, WT_OUT, smf);
    ph_convert<2>(p.ffn_w_gu, 11264, 2048, 11264, WT_GU, smf);
    ph_convert<0>(p.ffn_w_down, 2048, 5632, 2048, WT_DN, smf);
    grid.sync();
    ph_adaln_reduce(p);
    xcd_barrier(xbar);

    ph_norm(p.ctx, p.x, p.norm_mix_g, MOD, 0, 1, H, 0);
    xcd_barrier(xbar);
    { pg8::Gemm g{H, WT_IN, MTOT, 7424, 2048}; pg8::StaticOrder S; S.init(MTOT, 7424, GD, bid);
      pg8::EpiProj E{PROJ, NP0, 28, G, NG0, NG0, 4}; pg8::gemm_phase<pg8::EpiProj, pg8::StaticOrder>(ldsg, g, S, E); }
    xcd_barrier(xbar);
    ph_l0_prep(p, smf);
    xcd_barrier(xbar);
    ph_l0_prepass(p, lds);
    xcd_barrier(xbar);
    for (int job = vb; job < 256; job += GD) { if (job < 128) mlstm_chunk(p, job, lds); else deltanet_chunk(p, job - 128, lds); }
    xcd_barrier(xbar);
    ph_l0_merge(p);
    xcd_barrier(xbar);
    { pg8::Gemm g{H, WT_OUT, MTOT, 2048, 2048}; pg8::StaticOrder S; S.init(MTOT, 2048, GD, bid);
      pg8::EpiRes E{p.ctx, p.x, XC, p.out, MOD + 2 * 2048, 0}; pg8::gemm_phase<pg8::EpiRes, pg8::StaticOrder>(ldsg, g, S, E); }
    xcd_barrier(xbar);
    ph_norm(XC, p.out, p.norm_ffn_g, MOD, 3, 4, H, 0);
    xcd_barrier(xbar);
    { pg8::Gemm g{H, WT_GU, MTOT, 11264, 2048}; pg8::StaticOrder S; S.init(MTOT, 11264, GD, bid);
      pg8::EpiSwiglu E{PROJ, FH}; pg8::gemm_phase<pg8::EpiSwiglu, pg8::StaticOrder>(ldsg, g, S, E);
    }
    xcd_barrier(xbar);
    { pg8::Gemm g{PROJ, WT_DN, MTOT, 2048, 5632}; pg8::StaticOrder S; S.init(MTOT, 2048, GD, bid);
      pg8::EpiRes E{XC, p.out, XC, p.out, MOD + 5 * 2048, 0}; pg8::gemm_phase<pg8::EpiRes, pg8::StaticOrder>(ldsg, g, S, E); }
    xcd_barrier(xbar);

    const float* MOD1 = MOD + 3 * 12288;
    ph_convert<0>(p.cd_w_in, 5152, 2048, 5376, WT_IN, smf);
    ph_convert<0>(p.cd_w_out, 2048, 2048, 2048, WT_OUT, smf);
    ph_convert<2>(p.ffn_w_gu + (size_t)2048 * 11264, 11264, 2048, 11264, WT_GU, smf);
    ph_convert<0>(p.ffn_w_down + (size_t)5632 * 2048, 2048, 5632, 2048, WT_DN, smf);
    ph_norm(XC, p.out, p.norm_mix_g + 2048, MOD1, 0, 1, H, 0);
    xcd_barrier(xbar);
    { pg8::Gemm g{H, WT_IN, MTOT, 5376, 2048}; pg8::StaticOrder S; S.init(MTOT, 5376, GD, bid);
      pg8::EpiProj E{PROJ, NP1, 20, G, NG1, NG1, 0}; pg8::gemm_phase<pg8::EpiProj, pg8::StaticOrder>(ldsg, g, S, E); }
    xcd_barrier(xbar);
    ph_l1_a(p, lds);
    xcd_barrier(xbar);
    const bool l1_split = (GD >= 200);
    unsigned* rgflag = (unsigned*)(ws + WS_BAR) + 3600;
    for (int job = vb; job < 136; job += GD) {
        if (job < 128) gla_chunk(p, job, lds);
        else { rg_pass_b(p, job - 128);
            __builtin_amdgcn_fence(__ATOMIC_RELEASE, "agent"); asm volatile("s_waitcnt vmcnt(0)" ::: "memory"); __syncthreads();
            if (threadIdx.x == 0) __hip_atomic_fetch_add(rgflag, 1u, __ATOMIC_RELAXED, __HIP_MEMORY_SCOPE_AGENT); }
    }
    if (l1_split && vb >= 136) {
        if (threadIdx.x == 0) { unsigned sp = 0; while (__hip_atomic_load(rgflag, __ATOMIC_RELAXED, __HIP_MEMORY_SCOPE_AGENT) < 8u && ++sp < (1u << 22)) __builtin_amdgcn_s_sleep(4); }
        __syncthreads();
        __builtin_amdgcn_fence(__ATOMIC_ACQUIRE, "agent"); asm volatile("s_waitcnt vmcnt(0)" ::: "memory");
        ph_l1_c(p, lds, 64, L1C_SPLIT, vb - 136, GD - 136, 0);
    }
    xcd_barrier(xbar);
    ph_l1_c(p, lds, l1_split ? L1C_SPLIT : 64, 520 * 8, bid, GD, 1);
    xcd_barrier(xbar);
    { pg8::Gemm g{H + (size_t)512 * 2048, WT_OUT, MLAT, 2048, 2048}; pg8::StaticOrder S; S.init(MLAT, 2048, GD, bid);
      pg8::EpiRes E{XC, p.out, XC, p.out, MOD1 + 2 * 2048, 512}; pg8::gemm_phase<pg8::EpiRes, pg8::StaticOrder>(ldsg, g, S, E); }
    xcd_barrier(xbar);
    ph_norm(XC, p.out, p.norm_ffn_g + 2048, MOD1, 3, 4, H, 512);
    xcd_barrier(xbar);
    { pg8::Gemm g{H + (size_t)512 * 2048, WT_GU, MLAT, 11264, 2048}; pg8::StaticOrder S; S.init(MLAT, 11264, GD, bid);
      pg8::EpiSwiglu E{PROJ, FH}; pg8::gemm_phase<pg8::EpiSwiglu, pg8::StaticOrder>(ldsg, g, S, E);
    }
    xcd_barrier(xbar);
    { pg8::Gemm g{PROJ, WT_DN, MLAT, 2048, 5632}; pg8::StaticOrder S; S.init(MLAT, 2048, GD, bid);
      pg8::EpiRes E{XC, p.out, XC, p.out, MOD1 + 5 * 2048, 512}; pg8::gemm_phase<pg8::EpiRes, pg8::StaticOrder>(ldsg, g, S, E); }
    xcd_barrier(xbar);
    ph_final_norm(p);
}

extern "C" void kernel_launch(void* const* d_in, const int* in_sizes, int n_in, void* d_out, int out_size, void* d_ws, size_t ws_size, hipStream_t stream) {
    static int grid = 0;
    if (grid == 0) {
        if (n_in != 32 || out_size != MLAT * DM || ws_size < WS_END) { fprintf(stderr, "kernel_launch: unexpected shapes (n_in %d out %d ws %zu need %zu)\n", n_in, out_size, ws_size, (size_t)WS_END); grid = -1; return; }
        int dev = 0, cus = 0, per_cu = 0;
        (void)hipGetDevice(&dev);
        (void)hipDeviceGetAttribute(&cus, hipDeviceAttributeMultiprocessorCount, dev);
        if (hipFuncSetAttribute((const void*)hybrid_fwd, hipFuncAttributeMaxDynamicSharedMemorySize, LDS_BYTES) != hipSuccess) { fprintf(stderr, "kernel_launch: hipFuncSetAttribute failed\n"); }
        if (hipOccupancyMaxActiveBlocksPerMultiprocessor(&per_cu, (const void*)hybrid_fwd, NTHR, LDS_BYTES) != hipSuccess || per_cu < 1) { fprintf(stderr, "kernel_launch: occupancy query gave %d\n", per_cu); per_cu = 1; }
        (void)hipGetLastError();
        grid = cus * per_cu;
    }
    if (grid < 0) return;
    Params p{};
    const float** pp = (const float**)&p;
    for (int i = 0; i < 32; ++i) pp[i] = (const float*)d_in[i];
    p.out = (float*)d_out; p.ws = (unsigned char*)d_ws;
    (void)hipMemsetAsync((unsigned char*)d_ws + WS_BAR, 0, 16384, stream);
    void* args[] = {&p};
    hipError_t e = hipLaunchCooperativeKernel((const void*)hybrid_fwd, dim3(grid), dim3(NTHR), args, LDS_BYTES, stream);
    if (e != hipSuccess) fprintf(stderr, "cooperative launch failed: %s (grid %d)\n", hipGetErrorString(e), grid);
}
```

```cpp
#include <hip/hip_runtime.h>
#include <hip/hip_cooperative_groups.h>
#include <cstdio>
namespace cg = cooperative_groups;

typedef unsigned short u16;

constexpr int DM = 2048, FH = 5632, MC = 512, MLAT = 32768, MTOT = 33280, NTHR = 512;
constexpr int NP0 = 7168, NP1 = 5120;
constexpr int NG0 = 48, NG1 = 32;
constexpr int NSEG = 260;

constexpr size_t WS_WT_IN = 0;
constexpr size_t WS_WT_OUT = WS_WT_IN + (size_t)7424 * 2048 * 2;
constexpr size_t WS_WT_GU = WS_WT_OUT + (size_t)2048 * 2048 * 2;
constexpr size_t WS_WT_DN = WS_WT_GU + (size_t)11264 * 2048 * 2;
constexpr size_t WS_H = WS_WT_DN + (size_t)2048 * 5632 * 2;
constexpr size_t WS_PROJ = WS_H + (size_t)MTOT * 2048 * 2;
constexpr size_t WS_OF = WS_PROJ + (size_t)MTOT * 7168 * 2;
constexpr size_t WS_OB = WS_OF + (size_t)MTOT * 2048 * 2;
constexpr size_t WS_XC = WS_OB + (size_t)MTOT * 2048 * 2;
constexpr size_t WS_G = WS_XC + (size_t)MC * 2048 * 4;
constexpr size_t WS_CQ = WS_G + (size_t)MTOT * 48 * 4;
constexpr size_t WS_MODP = WS_CQ + (size_t)MC * 3072 * 2;
constexpr size_t WS_MOD = WS_MODP + (size_t)2 * 32 * 3 * 12288 * 4;
constexpr size_t WS_ATT0 = WS_MOD + (size_t)2 * 3 * 12288 * 4;
constexpr size_t WS_MLS = WS_ATT0 + (size_t)4160 * 4096 * 2;
constexpr size_t WS_GCS = WS_MLS + (size_t)4160 * 256 * 4;
constexpr size_t WS_WRT = WS_GCS + (size_t)8320 * 256 * 4;
constexpr size_t WS_BAR = WS_WRT + (size_t)32 * 16384 * 2;
constexpr size_t WS_END = WS_BAR + 16384;
constexpr size_t WS_TM = WS_H;
constexpr size_t WS_QK = WS_H + (size_t)8320 * 4096 * 2;
constexpr size_t WS_OF1 = WS_OF;
constexpr size_t WS_OB1 = WS_OF + (size_t)MTOT * 1024 * 2;
constexpr size_t WS_QE = WS_OB;
constexpr size_t WS_KDT = WS_QE + (size_t)2 * MTOT * 512 * 2;
constexpr size_t WS_TAIL = WS_PROJ + (size_t)MTOT * 5120 * 2;
constexpr size_t WS_ATT = WS_TAIL;
constexpr size_t WS_VT = WS_ATT + (size_t)4160 * 4096 * 2;
constexpr size_t WS_EBL = WS_VT + (size_t)2080 * 16384 * 2;
constexpr size_t WS_AGG = WS_EBL + (size_t)4160 * 128 * 4;
constexpr size_t WS_CARRY = WS_AGG + (size_t)4 * NSEG * 1024 * 8;
static_assert(WS_CARRY + (size_t)4 * NSEG * 1024 * 4 <= WS_OF, "layer-1 tail overflow");

struct Params {
    const float *x, *c, *ctx, *c_ctx, *mod_w, *mod_b, *norm_mix_g, *norm_ffn_g, *ffn_w_gu, *ffn_w_down, *final_norm_g,
        *ab_w_in, *ab_w_out, *ml_ig_b, *ml_fg_b, *ml_norm_g, *dn_conv_w, *dn_a_log, *dn_dt_bias, *dn_norm_g,
        *cd_w_in, *cd_w_out, *rg_conv_w, *rg_conv_b, *rg_w_r, *rg_b_r, *rg_w_i, *rg_b_i, *rg_lambda, *gla_w_up, *gla_b_up, *gla_norm_g;
    float* out; unsigned char* ws;
};

__device__ __forceinline__ float bf2f(u16 v) { return __uint_as_float(((unsigned)v) << 16); }
typedef __bf16 bf16x2_nat __attribute__((ext_vector_type(2)));
typedef float f32x2_nat __attribute__((ext_vector_type(2)));
__device__ __forceinline__ unsigned cvt_pk_bf16(float lo, float hi) { const f32x2_nat v = {lo, hi}; const bf16x2_nat r = __builtin_convertvector(v, bf16x2_nat); return __builtin_bit_cast(unsigned, r); }
__device__ __forceinline__ u16 f2bf(float f) { return (u16)(cvt_pk_bf16(f, 0.f) & 0xffffu); }
__device__ __forceinline__ void unpack8(const uint4& u, float* f) {
    f[0] = __uint_as_float(u.x << 16); f[1] = __uint_as_float(u.x & 0xffff0000u);
    f[2] = __uint_as_float(u.y << 16); f[3] = __uint_as_float(u.y & 0xffff0000u);
    f[4] = __uint_as_float(u.z << 16); f[5] = __uint_as_float(u.z & 0xffff0000u);
    f[6] = __uint_as_float(u.w << 16); f[7] = __uint_as_float(u.w & 0xffff0000u);
}
__device__ __forceinline__ uint4 pack8(const float* f) { uint4 o; o.x = cvt_pk_bf16(f[0], f[1]); o.y = cvt_pk_bf16(f[2], f[3]); o.z = cvt_pk_bf16(f[4], f[5]); o.w = cvt_pk_bf16(f[6], f[7]); return o; }
template <int CTRL> __device__ __forceinline__ float dppf(float x) { return __int_as_float(__builtin_amdgcn_update_dpp(0, __float_as_int(x), CTRL, 0xF, 0xF, true)); }
__device__ __forceinline__ float red4(float x) { x += dppf<0xB1>(x); x += dppf<0x4E>(x); return x; }
__device__ __forceinline__ float red8(float x) { x = red4(x); x += dppf<0x141>(x); return x; }
__device__ __forceinline__ float red16(float x) { x = red8(x); x += dppf<0x140>(x); return x; }
__device__ __forceinline__ float red64(float x) { x = red16(x); x += __shfl_xor(x, 16); x += __shfl_xor(x, 32); return x; }
__device__ __forceinline__ float frcp(float x) { return __builtin_amdgcn_rcpf(x); }
__device__ __forceinline__ float sigmoidf_(float x) { return frcp(1.f + __expf(-x)); }
__device__ __forceinline__ float siluf_(float x) { return x * frcp(1.f + __expf(-x)); }
__device__ __forceinline__ float softplusf_(float x) { return fmaxf(x, 0.f) + __logf(1.f + __expf(-fabsf(x))); }
__device__ __forceinline__ float logsigmoidf_(float x) { return fminf(x, 0.f) - __logf(1.f + __expf(-fabsf(x))); }
__device__ __forceinline__ float gelu_tanh(float x) { const float u = 0.7978845608028654f * (x + 0.044715f * x * x * x); const float th = 1.f - 2.f * frcp(1.f + __expf(2.f * u)); return 0.5f * x * (1.f + th); }
__device__ __forceinline__ float neg_expm1_small(float x) { float pl = 1.f / 720.f; pl = pl * x + 1.f / 120.f; pl = pl * x + 1.f / 24.f; pl = pl * x + 1.f / 6.f; pl = pl * x + 0.5f; pl = pl * x + 1.f; return -x * pl; }

__device__ __forceinline__ int tid_fresh() { int t = threadIdx.x; asm volatile("" : "+v"(t)); return t; }
namespace pg8 {
#define PG8_LAS __attribute__((address_space(3)))
typedef unsigned short bf16_t;
typedef short bf16x8 __attribute__((ext_vector_type(8)));
typedef float f32x4 __attribute__((ext_vector_type(4)));
typedef unsigned u32x4 __attribute__((ext_vector_type(4)));
constexpr int BM = 256, BK = 64, HALF = 128, HTB = HALF * BK * 2  , STAGE_BYTES = 8 * HTB, NXCD = 8, WGM = 8;

__host__ __device__ __forceinline__ int lds_byte(int r, int c) { const int st = (r >> 4) * 2 + (c >> 5), rr = r & 15, cc = c & 31, ob = rr * 64 + cc * 2; return st * 1024 + (ob ^ (((ob >> 9) & 1) << 5)); }
__host__ __device__ __forceinline__ void stage_rc(int b, int& R, int& C) { const int st = b / 1024, sb = b % 1024, swz = sb ^ (((sb >> 9) & 1) << 5); R = (st >> 1) * 16 + swz / 64; C = (st & 1) * 32 + (swz % 64) / 2; }
__host__ __device__ __forceinline__ int perm32(int rho) { const int n = rho >> 4, i = rho & 15; return 8 * (i >> 2) + 4 * n + (i & 3); }

struct Unit { int pm, pn; };
struct Gemm { const bf16_t* A; const bf16_t* Bt; int M, N, K; };

struct StaticOrder {
    int nM, nN, nwg, G, c;
    __host__ __device__ void init(int M, int N, int G_, int c_) { nM = M / BM; nN = N / BM; nwg = nM * nN; G = G_; c = c_; }
    __host__ __device__ bool next(int i, Unit& u) const {
        const long L = (long)i * G + c; if (L >= nwg) return false;
        int wgid = (int)L; { const int q = nwg / NXCD, r = nwg % NXCD, xcd = wgid % NXCD, off = wgid / NXCD; wgid = (xcd < r ? xcd * (q + 1) : r * (q + 1) + (xcd - r) * q) + off; }
        const int nig = WGM * nN, gid = wgid / nig, fm = gid * WGM, gsz = (nM - fm) < WGM ? (nM - fm) : WGM;
        u.pm = fm + ((wgid % nig) % gsz); u.pn = (wgid % nig) / gsz; return true;
    }
    __device__ __forceinline__ void a_ready(const Unit&) const {}
    __device__ __forceinline__ void done(const Unit&) const {}
};
using ::cvt_pk_bf16;
typedef float f32x2 __attribute__((ext_vector_type(2)));

struct EpiProj {
    static constexpr bool PERM = true, AFTER_DRAIN = false;
    bf16_t* P; int ldp; int n_main; float* G; int ldg; int ng; int perm_tiles;
    __device__ __forceinline__ void operator()(const f32x4 (&acc)[2][2][4][2], const Unit& u, int wr, int wc, int fr, int fq) const {
        const int row0 = u.pm * BM + wr * 64 + fr;
        if (u.pn < perm_tiles) {
#pragma unroll
            for (int ai = 0; ai < 2; ++ai)
#pragma unroll
                for (int m = 0; m < 4; ++m) { bf16_t* rowp = P + (size_t)(u.pm * BM + ai * HALF + wr * 64 + (m * 4 + wc) * 4 + fq) * ldp + u.pn * BM + fr * 8;
#pragma unroll
                    for (int bj = 0; bj < 2; ++bj) { const f32x4 v0 = acc[ai][bj][m][0], v1 = acc[ai][bj][m][1];
                        u32x4 w; w.x = cvt_pk_bf16(v0[0], v0[1]); w.y = cvt_pk_bf16(v0[2], v0[3]); w.z = cvt_pk_bf16(v1[0], v1[1]); w.w = cvt_pk_bf16(v1[2], v1[3]);
                        *(u32x4*)(rowp + bj * HALF) = w; } }
        } else if (u.pn < n_main) {
            const int col0 = u.pn * BM + wc * 32 + 8 * fq;
#pragma unroll
            for (int ai = 0; ai < 2; ++ai)
#pragma unroll
                for (int m = 0; m < 4; ++m) { bf16_t* rowp = P + (size_t)(row0 + ai * HALF + m * 16) * ldp + col0;
#pragma unroll
                    for (int bj = 0; bj < 2; ++bj) { const f32x4 v0 = acc[ai][bj][m][0], v1 = acc[ai][bj][m][1];
                        u32x4 w; w.x = cvt_pk_bf16(v0[0], v0[1]); w.y = cvt_pk_bf16(v0[2], v0[3]); w.z = cvt_pk_bf16(v1[0], v1[1]); w.w = cvt_pk_bf16(v1[2], v1[3]);
                        *(u32x4*)(rowp + bj * HALF) = w; } }
        } else {
            const int c0 = wc * 32 + 8 * fq;
#pragma unroll
            for (int ai = 0; ai < 2; ++ai)
#pragma unroll
                for (int m = 0; m < 4; ++m) { float* rowp = G + (size_t)(row0 + ai * HALF + m * 16) * ldg;
#pragma unroll
                    for (int n = 0; n < 2; ++n)
#pragma unroll
                        for (int j = 0; j < 4; ++j) { const int c = c0 + 4 * n + j; if (c < ng) rowp[c] = acc[ai][0][m][n][j]; } }
        }
    }
};
struct EpiRes {
    static constexpr bool PERM = false, AFTER_DRAIN = false;
    const float* srcC; const float* srcL; float* dstC; float* dstL; const float* gate  ; int row_off;
    __device__ __forceinline__ void operator()(const f32x4 (&acc)[2][2][4][2], const Unit& u, int wr, int wc, int fr, int fq) const {
        const int grow_t = u.pm * BM + row_off;
        const bool isc = grow_t < 512;
        const int mr = isc ? 2 : ((grow_t - 512) >> 14);
        const float* sp = isc ? srcC + (size_t)grow_t * 2048 : srcL + (size_t)(grow_t - 512) * 2048;
        float* dp = isc ? dstC + (size_t)grow_t * 2048 : dstL + (size_t)(grow_t - 512) * 2048;
        const int lrow0 = wr * 64 + fr, col0 = u.pn * BM + wc * 32 + 4 * fq;
        const float* gp = gate + (size_t)mr * 12288 + col0;
        f32x4 gv[2][2];
#pragma unroll
        for (int bj = 0; bj < 2; ++bj)
#pragma unroll
            for (int n = 0; n < 2; ++n) gv[bj][n] = *(const f32x4*)(gp + bj * HALF + n * 16);
#pragma unroll
        for (int ai = 0; ai < 2; ++ai)
#pragma unroll
            for (int m = 0; m < 4; ++m) { const size_t off = (size_t)(lrow0 + ai * HALF + m * 16) * 2048 + col0;
#pragma unroll
                for (int bj = 0; bj < 2; ++bj)
#pragma unroll
                    for (int n = 0; n < 2; ++n) { const f32x4 s = *(const f32x4*)(sp + off + bj * HALF + n * 16);
                        *(f32x4*)(dp + off + bj * HALF + n * 16) = s + gv[bj][n] * acc[ai][bj][m][n]; } }
    }
};
struct EpiSwiglu {
    static constexpr bool PERM = true, AFTER_DRAIN = false;
    bf16_t* O; int ldo;
    __device__ __forceinline__ void operator()(const f32x4 (&acc)[2][2][4][2], const Unit& u, int wr, int wc, int fr, int fq) const {
        const int row0 = u.pm * BM + wr * 64 + fr, col0 = u.pn * HALF + wc * 32 + 8 * fq;
#pragma unroll
        for (int ai = 0; ai < 2; ++ai)
#pragma unroll
            for (int m = 0; m < 4; ++m) { float r[8];
#pragma unroll
                for (int n = 0; n < 2; ++n)
#pragma unroll
                    for (int j = 0; j < 4; ++j) { const float gg = acc[ai][0][m][n][j], uu = acc[ai][1][m][n][j]; r[n * 4 + j] = gg * __builtin_amdgcn_rcpf(1.f + __expf(-gg)) * uu; }
                u32x4 w; w.x = cvt_pk_bf16(r[0], r[1]); w.y = cvt_pk_bf16(r[2], r[3]); w.z = cvt_pk_bf16(r[4], r[5]); w.w = cvt_pk_bf16(r[6], r[7]);
                *(u32x4*)(O + (size_t)(row0 + ai * HALF + m * 16) * ldo + col0) = w; }
    }
};

template <class Epi, class Sched>
__device__ __forceinline__ void gemm_phase(PG8_LAS unsigned char* lds, const Gemm g, const Sched& S, const Epi& E) {
    int tid = threadIdx.x; asm volatile("" : "+v"(tid)); const int wid = __builtin_amdgcn_readfirstlane(tid >> 6), lane = tid & 63, wr = wid >> 2, wc = wid & 3, fr = lane & 15, fq = lane >> 4;
    const int K = g.K, nt = K / BK;
    unsigned voffA[2], voffB[2];
#pragma unroll
    for (int i = 0; i < 2; ++i) { int R, C; stage_rc(tid * 16 + i * 8192, R, C); const int Rb = Epi::PERM ? ((R & ~31) + perm32(R & 31)) : R;
        voffA[i] = (unsigned)(R * K + C) * 2u; voffB[i] = (unsigned)(Rb * K + C) * 2u; }
    const size_t kstep = (size_t)(BK * 2);
    const size_t hstep = (size_t)HALF * K * 2;
    const size_t tstep = 2 * hstep;
    const unsigned ldsw = (unsigned)wid * 1024u;
    const int aoff = lds_byte(wr * 64 + fr, fq * 8), boff = lds_byte(wc * 32 + fr, fq * 8);
#define PG8_SA(b, h) (((b) * 2 + (h)) * HTB)
#define PG8_SB(b, h) ((4 + (b) * 2 + (h)) * HTB)
#define PG8_STAGE(bufoff, gbase, voff) do { _Pragma("unroll") for (int _i = 0; _i < 2; ++_i) \
        __builtin_amdgcn_global_load_lds((const unsigned*)((const char*)(gbase) + (voff)[_i]), (PG8_LAS unsigned*)(lds + (bufoff) + ldsw + _i * 8192), 16, 0, 0); } while (0)
#define PG8_LDA(dst, b, h) do { _Pragma("unroll") for (int m = 0; m < 4; ++m) _Pragma("unroll") for (int k = 0; k < 2; ++k) dst[m][k] = *(const PG8_LAS bf16x8*)(lds + PG8_SA(b, h) + aoff + m * 2048 + k * 1024); } while (0)
#define PG8_LDB(dst, b, h) do { _Pragma("unroll") for (int n = 0; n < 2; ++n) _Pragma("unroll") for (int k = 0; k < 2; ++k) dst[n][k] = *(const PG8_LAS bf16x8*)(lds + PG8_SB(b, h) + boff + n * 2048 + k * 1024); } while (0)
#define PG8_MMA(ai, bj, At, Bt) do { __builtin_amdgcn_s_setprio(1); _Pragma("unroll") for (int m = 0; m < 4; ++m) _Pragma("unroll") for (int n = 0; n < 2; ++n) _Pragma("unroll") for (int k = 0; k < 2; ++k) \
        acc[ai][bj][m][n] = __builtin_amdgcn_mfma_f32_16x16x32_bf16(Bt[n][k], At[m][k], acc[ai][bj][m][n], 0, 0, 0); __builtin_amdgcn_s_setprio(0); } while (0)
#define PG8_WAIT_V(n) asm volatile("s_waitcnt vmcnt(" #n ")" ::: "memory")
#define PG8_WAIT_L(n) asm volatile("s_waitcnt lgkmcnt(" #n ")" ::: "memory")
#define PG8_BAR __builtin_amdgcn_s_barrier()
#define PG8_SCHED __builtin_amdgcn_sched_barrier(0)
    Unit cur, nxt; int ui = 0;
    if (!S.next(0, cur)) return;
    f32x4 acc[2][2][4][2];
#pragma unroll
    for (int a = 0; a < 2; ++a)
#pragma unroll
        for (int b = 0; b < 2; ++b)
#pragma unroll
            for (int m = 0; m < 4; ++m)
#pragma unroll
                for (int n = 0; n < 2; ++n) acc[a][b][m][n] = (f32x4){0.f, 0.f, 0.f, 0.f};
    bf16x8 At[4][2], B0[2][2], B1[2][2];
    const char* cA = (const char*)g.A + (size_t)cur.pm * tstep; const char* cB = (const char*)g.Bt + (size_t)cur.pn * tstep;
    S.a_ready(cur);
    PG8_STAGE(PG8_SB(0, 0), cB, voffB); PG8_STAGE(PG8_SA(0, 0), cA, voffA); PG8_STAGE(PG8_SB(0, 1), cB + hstep, voffB); PG8_STAGE(PG8_SA(0, 1), cA + hstep, voffA);
    if (wr == 1) PG8_BAR;
    PG8_WAIT_V(4); PG8_BAR;
    PG8_STAGE(PG8_SB(1, 0), cB + kstep, voffB); PG8_STAGE(PG8_SA(1, 0), cA + kstep, voffA); PG8_STAGE(PG8_SB(1, 1), cB + hstep + kstep, voffB);
    PG8_WAIT_V(6); PG8_BAR;
    for (;;) {
        const bool has_next = S.next(ui + 1, nxt);
        const char* nA = has_next ? (const char*)g.A + (size_t)nxt.pm * tstep : cA; const char* nB = has_next ? (const char*)g.Bt + (size_t)nxt.pn * tstep : cB;
        for (int t = 0; t < nt; t += 2) {
            const bool last = (t == nt - 2);
            const char* a1 = cA + (size_t)(t + 1) * kstep;
            const char* a2 = last ? nA : cA + (size_t)(t + 2) * kstep; const char* b2 = last ? nB : cB + (size_t)(t + 2) * kstep;
            const char* a3 = a2 + kstep; const char* b3 = b2 + kstep;
            if (last && has_next) S.a_ready(nxt);
            PG8_LDB(B0, 0, 0); PG8_SCHED; PG8_LDA(At, 0, 0); PG8_STAGE(PG8_SA(1, 1), a1 + hstep, voffA);
            PG8_WAIT_L(8); PG8_BAR; PG8_WAIT_L(0); PG8_MMA(0, 0, At, B0); PG8_BAR; PG8_SCHED;
            PG8_LDB(B1, 0, 1); PG8_STAGE(PG8_SB(0, 0), b2, voffB);
            PG8_BAR; PG8_WAIT_L(0); PG8_MMA(0, 1, At, B1); PG8_BAR;
            PG8_LDA(At, 0, 1); PG8_STAGE(PG8_SA(0, 0), a2, voffA);
            PG8_BAR; PG8_WAIT_L(0); PG8_MMA(1, 0, At, B0); PG8_BAR; PG8_SCHED;
            PG8_STAGE(PG8_SB(0, 1), b2 + hstep, voffB);
            PG8_WAIT_V(6); PG8_BAR; PG8_MMA(1, 1, At, B1); PG8_BAR;
            PG8_LDB(B0, 1, 0); PG8_SCHED; PG8_LDA(At, 1, 0); PG8_STAGE(PG8_SA(0, 1), a2 + hstep, voffA);
            PG8_WAIT_L(8); PG8_BAR; PG8_WAIT_L(0); PG8_MMA(0, 0, At, B0); PG8_BAR; PG8_SCHED;
            PG8_LDB(B1, 1, 1); PG8_STAGE(PG8_SB(1, 0), b3, voffB);
            PG8_BAR; PG8_WAIT_L(0); PG8_MMA(0, 1, At, B1); PG8_BAR;
            PG8_LDA(At, 1, 1); PG8_STAGE(PG8_SA(1, 0), a3, voffA);
            PG8_BAR; PG8_WAIT_L(0); PG8_MMA(1, 0, At, B0); PG8_BAR; PG8_SCHED;
            PG8_STAGE(PG8_SB(1, 1), b3 + hstep, voffB);
            PG8_WAIT_V(6); PG8_BAR; PG8_MMA(1, 1, At, B1); PG8_BAR;
        }
        if constexpr (!Epi::AFTER_DRAIN) { E(acc, cur, wr, wc, fr, fq); S.done(cur); }
        if (!has_next) break;
#pragma unroll
        for (int a = 0; a < 2; ++a)
#pragma unroll
            for (int b = 0; b < 2; ++b)
#pragma unroll
                for (int m = 0; m < 4; ++m)
#pragma unroll
                    for (int n = 0; n < 2; ++n) acc[a][b][m][n] = (f32x4){0.f, 0.f, 0.f, 0.f};
        cur = nxt; cA = nA; cB = nB; ++ui;
    }
    PG8_WAIT_V(0);
    if (wr == 0) PG8_BAR;
    PG8_BAR;
    if constexpr (Epi::AFTER_DRAIN) { E.fused(acc, cur, wr, wc, fr, fq, lds, wid, lane); S.done(cur); }
#undef PG8_SA
#undef PG8_SB
#undef PG8_STAGE
#undef PG8_LDA
#undef PG8_LDB
#undef PG8_MMA
#undef PG8_WAIT_V
#undef PG8_WAIT_L
#undef PG8_BAR
#undef PG8_SCHED
}
}

__device__ __forceinline__ void ph_adaln_partials(const Params& p, float* sm) {
    const int tid = tid_fresh();
    float* MODP = (float*)(p.ws + WS_MODP);
    for (int it = blockIdx.x; it < 384; it += gridDim.x) {
        const int l = it / 192, rem = it % 192, kc = rem / 6, cgp = rem % 6;
        __syncthreads();
        if (tid < 192) { const int r = tid >> 6, kk = tid & 63, k = kc * 64 + kk; const float cv = (r < 2) ? p.c[r * 2048 + k] : p.c_ctx[k]; sm[tid] = siluf_(cv); }
        __syncthreads();
        const int col = cgp * 2048 + tid * 4;
        float4 a0 = {0.f, 0.f, 0.f, 0.f}, a1 = a0, a2 = a0;
        const float* wp = p.mod_w + ((size_t)l * 2048 + (size_t)kc * 64) * 12288 + col;
#pragma unroll 8
        for (int kk = 0; kk < 64; ++kk) {
            const float4 w = *(const float4*)(wp + (size_t)kk * 12288);
            const float s0 = sm[kk], s1 = sm[64 + kk], s2 = sm[128 + kk];
            a0.x += s0 * w.x; a0.y += s0 * w.y; a0.z += s0 * w.z; a0.w += s0 * w.w;
            a1.x += s1 * w.x; a1.y += s1 * w.y; a1.z += s1 * w.z; a1.w += s1 * w.w;
            a2.x += s2 * w.x; a2.y += s2 * w.y; a2.z += s2 * w.z; a2.w += s2 * w.w;
        }
        float* o = MODP + ((size_t)(l * 32 + kc) * 3) * 12288 + col;
        *(float4*)(o) = a0; *(float4*)(o + 12288) = a1; *(float4*)(o + 2 * 12288) = a2;
    }
}
__device__ __forceinline__ void ph_adaln_reduce(const Params& p) {
    const float* MODP = (const float*)(p.ws + WS_MODP); float* MOD = (float*)(p.ws + WS_MOD);
    for (int idx = blockIdx.x * NTHR + tid_fresh(); idx < 2 * 3 * 12288; idx += gridDim.x * NTHR) {
        const int l = idx / 36864, r = (idx / 12288) % 3, col = idx % 12288;
        float s = p.mod_b[l * 12288 + col];
        for (int kc = 0; kc < 32; ++kc) s += MODP[((size_t)(l * 32 + kc) * 3 + r) * 12288 + col];
        MOD[idx] = s;
    }
}

template <int MODE> __device__ __forceinline__ int colmap(int n, int nsrc) {
    if (MODE == 0) return n < nsrc ? n : -1;
    if (MODE == 1) { if (n < 3072) return n; if (n < 7168) return n + 16; if (n < 7184) return 3072 + (n - 7168); if (n < 7216) return n; return -1; }
    return ((n >> 7) & 1) * 5632 + (n >> 8) * 128 + (n & 127);
}
template <int MODE> __device__ __forceinline__ void ph_convert(const float* W, int nsrc, int K, int nout, u16* Bt, float* sm) {
    const int tid = tid_fresh(); const int nnt = nout / 64, ntiles = nnt * (K / 64);
    for (int t = blockIdx.x; t < ntiles; t += gridDim.x) {
        const int k0 = (t / nnt) * 64, n0 = (t % nnt) * 64;
        __syncthreads();
#pragma unroll
        for (int i = 0; i < 8; ++i) { const int idx = i * NTHR + tid, kk = idx >> 6, nn = idx & 63; const int src = colmap<MODE>(n0 + nn, nsrc);
            sm[kk * 65 + nn] = src >= 0 ? W[(size_t)(k0 + kk) * nsrc + src] : 0.f; }
        __syncthreads();
        { const int nn = tid >> 3, k8 = (tid & 7) * 8; float v[8];
#pragma unroll
            for (int j = 0; j < 8; ++j) v[j] = sm[(k8 + j) * 65 + nn];
            *(uint4*)(Bt + (size_t)(n0 + nn) * K + k0 + k8) = pack8(v); }
    }
}

__device__ __forceinline__ void ph_norm(const float* srcC, const float* srcL, const float* g, const float* modl, int chunk_sh, int chunk_sc, u16* H, int row_begin) {
    const int tid_ = tid_fresh(); const int lane = tid_ & 63, w = tid_ >> 6;
    for (int row = row_begin + blockIdx.x * 8 + w; row < MTOT; row += gridDim.x * 8) {
        const float* src = row < 512 ? srcC + (size_t)row * 2048 : srcL + (size_t)(row - 512) * 2048;
        const int mr = row < 512 ? 2 : ((row - 512) >> 14);
        const float* sc = modl + (mr * 6 + chunk_sc) * 2048; const float* sh = modl + (mr * 6 + chunk_sh) * 2048;
        float4 v[8]; float ss = 0.f;
#pragma unroll
        for (int i = 0; i < 8; ++i) { v[i] = *(const float4*)(src + i * 256 + lane * 4); ss += v[i].x * v[i].x + v[i].y * v[i].y + v[i].z * v[i].z + v[i].w * v[i].w; }
        ss = red64(ss);
        const float rstd = rsqrtf(ss * (1.f / 2048.f) + 1e-6f);
#pragma unroll
        for (int i = 0; i < 8; ++i) { const int col = i * 256 + lane * 4;
            const float4 g4 = *(const float4*)(g + col), s4 = *(const float4*)(sc + col), h4 = *(const float4*)(sh + col);
            const float y0 = v[i].x * rstd * g4.x * (1.f + s4.x) + h4.x, y1 = v[i].y * rstd * g4.y * (1.f + s4.y) + h4.y;
            const float y2 = v[i].z * rstd * g4.z * (1.f + s4.z) + h4.z, y3 = v[i].w * rstd * g4.w * (1.f + s4.w) + h4.w;
            uint2 o; o.x = cvt_pk_bf16(y0, y1); o.y = cvt_pk_bf16(y2, y3);
            *(uint2*)(H + (size_t)row * 2048 + col) = o; }
    }
}
__device__ __forceinline__ void ph_final_norm(const Params& p) {
    const int tid_ = tid_fresh(); const int lane = tid_ & 63, w = tid_ >> 6;
    for (int row = blockIdx.x * 8 + w; row < MLAT; row += gridDim.x * 8) {
        float* src = p.out + (size_t)row * 2048;
        float4 v[8]; float ss = 0.f;
#pragma unroll
        for (int i = 0; i < 8; ++i) { v[i] = *(const float4*)(src + i * 256 + lane * 4); ss += v[i].x * v[i].x + v[i].y * v[i].y + v[i].z * v[i].z + v[i].w * v[i].w; }
        ss = red64(ss);
        const float rstd = rsqrtf(ss * (1.f / 2048.f) + 1e-6f);
#pragma unroll
        for (int i = 0; i < 8; ++i) { const int col = i * 256 + lane * 4; const float4 g4 = *(const float4*)(p.final_norm_g + col);
            float4 o; o.x = v[i].x * rstd * g4.x; o.y = v[i].y * rstd * g4.y; o.z = v[i].z * rstd * g4.z; o.w = v[i].w * rstd * g4.w;
            *(float4*)(src + col) = o; }
    }
}

__device__ __forceinline__ void ph_l0_prep(const Params& p, float* sm) {
    const int tid = tid_fresh();
    u16* PROJ = (u16*)(p.ws + WS_PROJ); u16* CQ = (u16*)(p.ws + WS_CQ); float* G = (float*)(p.ws + WS_G);
    for (int idx = blockIdx.x * NTHR + tid; idx < MTOT * 48; idx += gridDim.x * NTHR) {
        const int j = idx % 48; const float v = G[idx]; float o;
        if (j < 8) o = v + p.ml_ig_b[j];
        else if (j < 16) o = logsigmoidf_(v + p.ml_fg_b[j - 8]);
        else if (j < 32) { const float dt = softplusf_(v + p.dn_dt_bias[j - 16]); o = -__expf(p.dn_a_log[j - 16]) * dt; }
        else o = sigmoidf_(v);
        G[idx] = o;
    }
    {
        const int NB = (int)gridDim.x;
        const int tk = tid >> 3, cs = (tid & 7) * 16;
        for (int pb = (int)blockIdx.x; pb < (NB < 24 ? 24 : NB); pb += NB) {
        const int part = pb % 24, slot = pb / 24;
        const int nbp = NB >= 24 ? (NB - part + 23) / 24 : 1;
        float wt[5][16];
#pragma unroll
        for (int j = 0; j < 5; ++j)
#pragma unroll
            for (int c4 = 0; c4 < 4; ++c4) { const float4 w4 = *(const float4*)(p.dn_conv_w + j * 3072 + part * 128 + cs + c4 * 4); wt[j][c4 * 4] = w4.x; wt[j][c4 * 4 + 1] = w4.y; wt[j][c4 * 4 + 2] = w4.z; wt[j][c4 * 4 + 3] = w4.w; }
        uint4 in[5][2];
#define L0P_LOAD(TT) do { const int tt_ = (TT); const bool ic_ = tt_ < 8; const int t0_ = ic_ ? (tt_ & 3) * 64 : 0; const int rb_ = ic_ ? (tt_ >> 2) * 256 + t0_ : 512 + (tt_ - 8) * 64; \
            _Pragma("unroll") for (int j = 0; j < 5; ++j) { const int r = tk + j - 2; const bool ok = ic_ ? (t0_ + r >= 0 && t0_ + r < 256) : (r >= 0 && r < 64); \
                in[j][0] = make_uint4(0u, 0u, 0u, 0u); in[j][1] = in[j][0]; \
                if (ok) { const u16* src = PROJ + (size_t)(rb_ + r) * NP0 + 3072 + part * 128 + cs; in[j][0] = *(const uint4*)(src); in[j][1] = *(const uint4*)(src + 8); } } } while (0)
        if (slot < 520) L0P_LOAD(slot);
        for (int tt = slot; tt < 520; tt += nbp) {
            const bool isctx = tt < 8;
            const int t0 = isctx ? (tt & 3) * 64 : 0;
            const int rowbase = isctx ? (tt >> 2) * 256 + t0 : 512 + (tt - 8) * 64;
            float o[16];
#pragma unroll
            for (int c = 0; c < 16; ++c) o[c] = 0.f;
#pragma unroll
            for (int j = 0; j < 5; ++j) { float f[16]; unpack8(in[j][0], f); unpack8(in[j][1], f + 8);
#pragma unroll
                for (int c = 0; c < 16; ++c) o[c] += f[c] * wt[j][c]; }
            if (tt + nbp < 520) L0P_LOAD(tt + nbp);
            float ss = 0.f;
#pragma unroll
            for (int c = 0; c < 16; ++c) { o[c] = siluf_(o[c]); ss += o[c] * o[c]; }
            ss = red8(ss);
            if (part < 16) { const float sc = rsqrtf(ss + 1e-6f);
#pragma unroll
                for (int c = 0; c < 16; ++c) o[c] *= sc; }
            __syncthreads();
            if (part < 16) {
                const int rs = isctx ? 3072 : NP0; u16* tb = isctx ? CQ + (size_t)rowbase * 3072 + part * 128 : PROJ + (size_t)rowbase * NP0 + 3072 + part * 128;
                const int r0 = ((tk >> 4) * 4 + (cs >> 5)) * 4 + ((cs >> 3) & 3);
                *(uint4*)(tb + (size_t)r0 * rs + (tk & 15) * 8) = pack8(o); *(uint4*)(tb + (size_t)(r0 + 1) * rs + (tk & 15) * 8) = pack8(o + 8);
            } else {
                u16* dst = isctx ? CQ + (size_t)(rowbase + tk) * 3072 + part * 128 + cs : PROJ + (size_t)(rowbase + tk) * NP0 + 3072 + part * 128 + cs;
                *(uint4*)(dst) = pack8(o); *(uint4*)(dst + 8) = pack8(o + 8); }
        }
        }
    }
}

__device__ __forceinline__ void ph_l0_merge(const Params& p) {
    const int tid_ = tid_fresh(); const int lane = tid_ & 63, w = tid_ >> 6;
    const u16* PROJ = (const u16*)(p.ws + WS_PROJ); const u16* OF = (const u16*)(p.ws + WS_OF); const u16* OB = (const u16*)(p.ws + WS_OB); u16* Y = (u16*)(p.ws + WS_H);
    for (int row = blockIdx.x * 8 + w; row < MTOT; row += gridDim.x * 8) {
        float o[4][8]; float ss[4];
#pragma unroll
        for (int k = 0; k < 4; ++k) { const int col = (k * 64 + lane) * 8; float a[8], bb[8];
            unpack8(*(const uint4*)(OF + (size_t)row * 2048 + col), a); unpack8(*(const uint4*)(OB + (size_t)row * 2048 + col), bb);
            float s = 0.f;
#pragma unroll
            for (int j = 0; j < 8; ++j) { o[k][j] = a[j] + bb[j]; s += o[k][j] * o[k][j]; }
            s = red16(s);
            if (k < 2) s += __shfl_xor(s, 16);
            ss[k] = s; }
#pragma unroll
        for (int k = 0; k < 4; ++k) { const int col = (k * 64 + lane) * 8; const bool isml = k < 2;
            const float rstd = isml ? rsqrtf(ss[k] * (1.f / 256.f) + 1e-6f) : rsqrtf(ss[k] * (1.f / 128.f) + 1e-6f);
            const u16* gsrc = PROJ + (size_t)row * NP0 + (isml ? 2048 + col : 6144 + (col - 1024));
            const float* gn = isml ? p.ml_norm_g + col : p.dn_norm_g + (col - 1024);
            float gt[8], r[8]; unpack8(*(const uint4*)gsrc, gt);
            const float4 g0 = *(const float4*)gn, g1 = *(const float4*)(gn + 4); const float gg[8] = {g0.x, g0.y, g0.z, g0.w, g1.x, g1.y, g1.z, g1.w};
#pragma unroll
            for (int j = 0; j < 8; ++j) { const float gate = isml ? sigmoidf_(gt[j]) : siluf_(gt[j]); r[j] = o[k][j] * rstd * gg[j] * gate; }
            *(uint4*)(Y + (size_t)row * 2048 + col) = pack8(r); }
    }
}

typedef short bf16x8_t __attribute__((ext_vector_type(8)));
typedef float f32x4_t __attribute__((ext_vector_type(4)));
__device__ __forceinline__ float wave_cumsum(float x, int lane) {
#pragma unroll
    for (int o = 1; o < 64; o <<= 1) { const float t = __shfl_up(x, o); if (lane >= o) x += t; }
    return x; }
__device__ __forceinline__ float wave_cummax(float x, int lane) {
#pragma unroll
    for (int o = 1; o < 64; o <<= 1) { const float t = __shfl_up(x, o); if (lane >= o) x = fmaxf(x, t); }
    return x; }
__device__ __forceinline__ int tile_of(int n, int b, int dir) { if (n < 4) return b * 4 + (dir ? 3 - n : n); const int li = n - 4; return 8 + b * 256 + (dir ? 255 - li : li); }
__device__ __forceinline__ int rowbase_of(int tt) { return tt < 8 ? tt * 64 : 512 + (tt - 8) * 64; }

__device__ __forceinline__ void ml_prep_item(const Params& p, int it, float* wl, int lane) {
    const int h = it & 3, tt = (it >> 2) % 520, z = it / 2080, rowbase = rowbase_of(tt), fr = lane & 15, fq = lane >> 4;
    const u16* PROJ = (const u16*)(p.ws + WS_PROJ); const float* G = (const float*)(p.ws + WS_G);
    float* MLS = (float*)(p.ws + WS_MLS) + (size_t)it * 256; u16* ATT0 = (u16*)(p.ws + WS_ATT0) + (size_t)it * 4096;
    const int tk = z ? 63 - lane : lane, row = rowbase + tk;
    const float ig = G[row * 48 + z * 4 + h], lf = G[row * 48 + 8 + z * 4 + h];
    const float bb = wave_cumsum(lf, lane), gg = ig - bb, cm = wave_cummax(gg, lane);
    const float bL = __shfl(bb, 63), cmL = __shfl(cm, 63);
    MLS[tk] = bb; MLS[64 + tk] = cm; MLS[128 + tk] = __expf(gg - cmL); if (lane == 0) { MLS[192] = bL; MLS[193] = cmL; }
    wl[tk] = gg; wl[64 + tk] = cm;
    bf16x8_t kf[4][4];
#pragma unroll
    for (int rt = 0; rt < 4; ++rt)
#pragma unroll
        for (int ks = 0; ks < 4; ++ks) kf[rt][ks] = *(const bf16x8_t*)(PROJ + (size_t)(rowbase + (rt * 4 + ks) * 4 + fq) * NP0 + 512 + h * 128 + fr * 8);
#pragma unroll 1
    for (int rt = 0; rt < 4; ++rt) {
        bf16x8_t qf[4];
#pragma unroll
        for (int ks = 0; ks < 4; ++ks) qf[ks] = *(const bf16x8_t*)(PROJ + (size_t)(rowbase + (rt * 4 + ks) * 4 + fq) * NP0 + h * 128 + fr * 8);
#pragma unroll
        for (int ct = 0; ct < 4; ++ct) {
            f32x4_t acc = (f32x4_t){0.f, 0.f, 0.f, 0.f};
#pragma unroll
            for (int ks = 0; ks < 4; ++ks) acc = __builtin_amdgcn_mfma_f32_16x16x32_bf16(qf[ks], kf[ct][ks], acc, 0, 0, 0);
            const int s = ct * 16 + fr; const float gs = wl[s];
#pragma unroll
            for (int j = 0; j < 4; ++j) { const int l = rt * 16 + fq * 4 + j; const bool keep = z ? (s >= l) : (s <= l);
                const float e = __expf(fminf(gs - wl[64 + l], 0.f));
                ATT0[(((l >> 4) * 2 + (s >> 5)) * 64 + ((s >> 3) & 3) * 16 + (l & 15)) * 8 + (s & 7)] = f2bf(keep ? acc[j] * 0.08838834764831845f * e : 0.f); }
        }
    }
}
__device__ __forceinline__ void dn_prep_item(const Params& p, int it, float* Ap, int lane) {
    asm volatile("" : "+v"(lane));
    const int h = it & 7, tt = (it >> 3) % 520, z = it / 4160, rowbase = rowbase_of(tt), fr = lane & 15, fq = lane >> 4;
    const bool isctx = tt < 8;
    const u16* qb = isctx ? (const u16*)(p.ws + WS_CQ) + (size_t)rowbase * 3072 + h * 128 : (const u16*)(p.ws + WS_PROJ) + (size_t)rowbase * NP0 + 3072 + h * 128;
    const int rs = isctx ? 3072 : NP0;
    const float* G = (const float*)(p.ws + WS_G);
    float* GCS = (float*)(p.ws + WS_GCS) + (size_t)it * 256; u16* TM = (u16*)(p.ws + WS_TM) + (size_t)it * 4096; u16* QK = (u16*)(p.ws + WS_QK) + (size_t)it * 4096;
    float* gcs = Ap + 4096; float* bes = Ap + 4160;
    const int tk = z ? 63 - lane : lane, row = rowbase + tk;
    const float g = G[row * 48 + 16 + z * 8 + h], be = G[row * 48 + 32 + z * 8 + h];
    const float gc = wave_cumsum(g, lane), gL = __shfl(gc, 63);
    GCS[tk] = __expf(gc); GCS[64 + tk] = be; GCS[128 + tk] = __expf(gL - gc); if (lane == 0) GCS[192] = __expf(gL);
    gcs[tk] = gc; bes[tk] = be;
    bf16x8_t kf[4][4];
#pragma unroll
    for (int rt = 0; rt < 4; ++rt)
#pragma unroll
        for (int ks = 0; ks < 4; ++ks) kf[rt][ks] = *(const bf16x8_t*)(qb + (size_t)((rt * 4 + ks) * 4 + fq) * rs + 1024 + fr * 8);
#pragma unroll 1
    for (int rt = 0; rt < 4; ++rt) {
        bf16x8_t qf[4], ka[4];
#pragma unroll
        for (int ks = 0; ks < 4; ++ks) { qf[ks] = *(const bf16x8_t*)(qb + (size_t)((rt * 4 + ks) * 4 + fq) * rs + fr * 8); ka[ks] = *(const bf16x8_t*)(qb + (size_t)((rt * 4 + ks) * 4 + fq) * rs + 1024 + fr * 8); }
#pragma unroll
        for (int ct = 0; ct < 4; ++ct) {
            f32x4_t ck = (f32x4_t){0.f, 0.f, 0.f, 0.f}, cq = ck;
#pragma unroll
            for (int ks = 0; ks < 4; ++ks) { ck = __builtin_amdgcn_mfma_f32_16x16x32_bf16(ka[ks], kf[ct][ks], ck, 0, 0, 0); cq = __builtin_amdgcn_mfma_f32_16x16x32_bf16(qf[ks], kf[ct][ks], cq, 0, 0, 0); }
            const int s = ct * 16 + fr; const float gs = gcs[s];
#pragma unroll
            for (int j = 0; j < 4; ++j) { const int l = rt * 16 + fq * 4 + j;
                const bool strict = z ? (s > l) : (s < l), incl = z ? (s >= l) : (s <= l);
                const float e = __expf(fminf(gcs[l] - gs, 0.f));
                const int lp = z ? 63 - l : l, sp = z ? 63 - s : s;
                Ap[lp * 64 + sp] = strict ? bes[l] * ck[j] * e : 0.f;
                QK[(((l >> 4) * 2 + (s >> 5)) * 64 + ((s >> 3) & 3) * 16 + (l & 15)) * 8 + (s & 7)] = f2bf(incl ? cq[j] * 0.08838834764831845f * e : 0.f); }
        }
    }
    float T[64];
#pragma unroll
    for (int i = 0; i < 64; ++i) {
        float t = (i == lane) ? 1.f : 0.f;
#pragma unroll
        for (int j4 = 0; j4 < (i + 3) / 4; ++j4) { const float4 a4 = *(const float4*)(Ap + i * 64 + j4 * 4);
            if (j4 * 4 + 0 < i) t -= a4.x * T[j4 * 4 + 0];
            if (j4 * 4 + 1 < i) t -= a4.y * T[j4 * 4 + 1];
            if (j4 * 4 + 2 < i) t -= a4.z * T[j4 * 4 + 2];
            if (j4 * 4 + 3 < i) t -= a4.w * T[j4 * 4 + 3];
            if ((j4 & 7) == 7) asm volatile("" : "+v"(t) :: "memory"); }
        T[i] = t;
        asm volatile("" : "+v"(T[i]) :: "memory");
    }
    const int sc = z ? 63 - lane : lane;
    u16* TMp = TM + ((sc >> 5) * 64 + ((sc >> 3) & 3) * 16) * 8 + (sc & 7);
    if (z) {
#pragma unroll
        for (int i = 0; i < 64; ++i) { const int l = 63 - i; TMp[(l >> 4) * 1024 + (l & 15) * 8] = f2bf(T[i]); }
    } else {
#pragma unroll
        for (int i = 0; i < 64; ++i) { const int l = i; TMp[(l >> 4) * 1024 + (l & 15) * 8] = f2bf(T[i]); }
    }
}
__device__ __forceinline__ void ph_l0_prepass(const Params& p, unsigned char* lds) {
    const int tid = tid_fresh(), lane = tid & 63, w = tid >> 6;
    float* wl = (float*)(lds + (size_t)w * 16896);
    const int gw = blockIdx.x * 8 + w, nw = gridDim.x * 8;
    for (int it = (gw + nw - 128) % nw; it < 4160; it += nw) ml_prep_item(p, it, wl, lane);
    for (int it = gw; it < 8320; it += nw) dn_prep_item(p, it, wl, lane);
}

struct MlFr { bf16x8_t q[4], at[2]; uint4 kr[2]; uint2 vr; float kw, b[4], cm[4], bL, cmL; };
__device__ __forceinline__ void ml_load(MlFr& F, const Params& p, int n, int b, int h, int dir, int e0, int lt, int fr, int fq, int tl, int seg) {
    const int nn = n < NSEG ? n : NSEG - 1;
    const int tt = tile_of(nn, b, dir), it = (dir * 520 + tt) * 4 + h, rowbase = rowbase_of(tt);
    const u16* PROJ = (const u16*)(p.ws + WS_PROJ);
    const u16* Q = PROJ + (size_t)(rowbase + lt * 16 + fq) * NP0 + h * 128 + fr * 8;
    const u16* AT = (const u16*)(p.ws + WS_ATT0) + (size_t)it * 4096 + lt * 1024 + (fq * 16 + fr) * 8;
    const float* MLS = (const float*)(p.ws + WS_MLS) + (size_t)it * 256;
#pragma unroll
    for (int ks = 0; ks < 4; ++ks) F.q[ks] = *(const bf16x8_t*)(Q + (size_t)ks * 4 * NP0);
#pragma unroll
    for (int ks = 0; ks < 2; ++ks) F.at[ks] = *(const bf16x8_t*)(AT + ks * 512);
    const u16* kp = PROJ + (size_t)(rowbase + ((tl >> 4) * 4 + (seg >> 1)) * 4 + (seg & 1) * 2) * NP0 + 512 + h * 128 + (tl & 15) * 8;
    F.kr[0] = *(const uint4*)(kp); F.kr[1] = *(const uint4*)(kp + NP0);
    F.vr = *(const uint2*)(PROJ + (size_t)(rowbase + tl) * NP0 + 1024 + h * 256 + e0 + seg * 4);
    F.kw = MLS[128 + tl];
#pragma unroll
    for (int j = 0; j < 4; ++j) { F.b[j] = MLS[lt * 16 + fq * 4 + j]; F.cm[j] = MLS[64 + lt * 16 + fq * 4 + j]; }
    F.bL = MLS[192]; F.cmL = MLS[193];
}
__device__ __forceinline__ void mlstm_chunk(const Params& p, int job, unsigned char* lds) {
    const int tid = tid_fresh(), lane = tid & 63, w = tid >> 6, fr = lane & 15, fq = lane >> 4;
    const int chain = job >> 3, cgp = job & 7;
    const int b = chain >> 3, h = (chain >> 1) & 3, dir = chain & 1;
    const int e0 = cgp * 32, lt = w >> 1, et = w & 1, dt0 = (w >> 1) * 2, tl = tid & 63, seg = tid >> 6;
    u16* Cl = (u16*)lds;
    u16* Ktw = (u16*)(lds + 17952);
    u16* Vt = (u16*)(lds + 17952 + 18432);
    u16* O = (u16*)(p.ws + (dir ? WS_OB : WS_OF));
    __syncthreads();
    for (int i = tid; i < 17952 / 4; i += NTHR) ((unsigned*)Cl)[i] = 0u;
    __syncthreads();
    f32x4_t Cacc[2], nacc; Cacc[0] = (f32x4_t){0.f, 0.f, 0.f, 0.f}; Cacc[1] = Cacc[0]; nacc = Cacc[0];
    float m_in = 0.f;
    bf16x8_t ones;
#pragma unroll
    for (int j = 0; j < 8; ++j) ones[j] = (short)0x3F80;
    MlFr buf[2];
    ml_load(buf[0], p, 0, b, h, dir, e0, lt, fr, fq, tl, seg); ml_load(buf[1], p, 1, b, h, dir, e0, lt, fr, fq, tl, seg);
    for (int n0 = 0; n0 < NSEG; n0 += 4) {
#pragma unroll
        for (int u = 0; u < 4; ++u) {
            const int n = n0 + u; const int s = u & 1;
            const MlFr& F = buf[s];
            const int tt = tile_of(n, b, dir), rowbase = rowbase_of(tt);
            const u16* Ccur = Cl + (n & 1) * (33 * 136); u16* Cnxt = Cl + ((n + 1) & 1) * (33 * 136);
            { float k[16]; unpack8(F.kr[0], k); unpack8(F.kr[1], k + 8);
#pragma unroll
                for (int c = 0; c < 16; ++c) Ktw[(seg * 16 + c) * 72 + tl] = f2bf(k[c] * F.kw);
                Vt[(seg * 4 + 0) * 72 + tl] = (u16)(F.vr.x & 0xffffu); Vt[(seg * 4 + 1) * 72 + tl] = (u16)(F.vr.x >> 16);
                Vt[(seg * 4 + 2) * 72 + tl] = (u16)(F.vr.y & 0xffffu); Vt[(seg * 4 + 3) * 72 + tl] = (u16)(F.vr.y >> 16); }
            __syncthreads();
            bf16x8_t vt[2];
#pragma unroll
            for (int ks = 0; ks < 2; ++ks) vt[ks] = *(const bf16x8_t*)(Vt + (et * 16 + fr) * 72 + ks * 32 + fq * 8);
            {
                f32x4_t inter = (f32x4_t){0.f, 0.f, 0.f, 0.f}, intra = inter, dinter = inter, dintra = inter;
#pragma unroll
                for (int ks = 0; ks < 4; ++ks) { const bf16x8_t cb = *(const bf16x8_t*)(Ccur + (et * 16 + fr) * 136 + ks * 32 + fq * 8); const bf16x8_t nb = *(const bf16x8_t*)(Ccur + 32 * 136 + ks * 32 + fq * 8);
                    inter = __builtin_amdgcn_mfma_f32_16x16x32_bf16(F.q[ks], cb, inter, 0, 0, 0); dinter = __builtin_amdgcn_mfma_f32_16x16x32_bf16(F.q[ks], nb, dinter, 0, 0, 0); }
#pragma unroll
                for (int ks = 0; ks < 2; ++ks) { intra = __builtin_amdgcn_mfma_f32_16x16x32_bf16(F.at[ks], vt[ks], intra, 0, 0, 0); dintra = __builtin_amdgcn_mfma_f32_16x16x32_bf16(F.at[ks], ones, dintra, 0, 0, 0); }
#pragma unroll
                for (int j = 0; j < 4; ++j) { const float M = fmaxf(F.cm[j], m_in); const float r = __expf(F.cm[j] - M), ei = __expf(m_in - M) * 0.08838834764831845f;
                    const float num = r * intra[j] + ei * inter[j], den = r * dintra[j] + ei * dinter[j];
                    const float hv = num * frcp(fmaxf(fabsf(den), __expf(-(F.b[j] + M))));
                    O[(size_t)(rowbase + lt * 16 + fq * 4 + j) * 2048 + h * 256 + e0 + et * 16 + fr] = f2bf(hv); }
            }
            { const float ML = fmaxf(F.cmL, m_in); const float a = __expf(m_in - ML), sc2 = __expf(F.cmL - ML); m_in = F.bL + ML;
#pragma unroll
                for (int i = 0; i < 2; ++i) { f32x4_t nw = (f32x4_t){0.f, 0.f, 0.f, 0.f};
#pragma unroll
                    for (int ks = 0; ks < 2; ++ks) { const bf16x8_t kb = *(const bf16x8_t*)(Ktw + ((dt0 + i) * 16 + fr) * 72 + ks * 32 + fq * 8); nw = __builtin_amdgcn_mfma_f32_16x16x32_bf16(vt[ks], kb, nw, 0, 0, 0); }
#pragma unroll
                    for (int j = 0; j < 4; ++j) { Cacc[i][j] = a * Cacc[i][j] + sc2 * nw[j]; Cnxt[(et * 16 + fq * 4 + j) * 136 + (dt0 + i) * 16 + fr] = f2bf(Cacc[i][j]); } }
                f32x4_t nw = (f32x4_t){0.f, 0.f, 0.f, 0.f};
#pragma unroll
                for (int ks = 0; ks < 2; ++ks) { const bf16x8_t kb = *(const bf16x8_t*)(Ktw + (w * 16 + fr) * 72 + ks * 32 + fq * 8); nw = __builtin_amdgcn_mfma_f32_16x16x32_bf16(ones, kb, nw, 0, 0, 0); }
                nacc[0] = a * nacc[0] + sc2 * nw[0];
                if (fq == 0) Cnxt[32 * 136 + w * 16 + fr] = f2bf(nacc[0]); }
            __syncthreads();
            ml_load(buf[s], p, n + 2, b, h, dir, e0, lt, fr, fq, tl, seg);
        }
    }
}

struct DnFr { bf16x8_t k[4], q[4], tm[2], qk[2]; uint4 kr[2]; float kds, egc[4], be[4], egL; u16 v[4]; };
__device__ __forceinline__ void dn_load(DnFr& F, const Params& p, int n, int b, int h, int dir, int e0, int lt, int et, int fr, int fq, int tl, int seg) {
    const int nn = n < NSEG ? n : NSEG - 1;
    const int tt = tile_of(nn, b, dir), it = (dir * 520 + tt) * 8 + h, rowbase = rowbase_of(tt);
    const bool isctx = tt < 8;
    const u16* qb = isctx ? (const u16*)(p.ws + WS_CQ) + (size_t)rowbase * 3072 + h * 128 : (const u16*)(p.ws + WS_PROJ) + (size_t)rowbase * NP0 + 3072 + h * 128;
    const int rs = isctx ? 3072 : NP0;
    const u16* TM = (const u16*)(p.ws + WS_TM) + (size_t)it * 4096 + lt * 1024 + (fq * 16 + fr) * 8;
    const u16* QK = (const u16*)(p.ws + WS_QK) + (size_t)it * 4096 + lt * 1024 + (fq * 16 + fr) * 8;
    const float* GCS = (const float*)(p.ws + WS_GCS) + (size_t)it * 256;
    const u16* qr = qb + (size_t)(lt * 16 + fq) * rs + fr * 8;
#pragma unroll
    for (int ks = 0; ks < 4; ++ks) { F.q[ks] = *(const bf16x8_t*)(qr + (size_t)ks * 4 * rs); F.k[ks] = *(const bf16x8_t*)(qr + (size_t)ks * 4 * rs + 1024); }
#pragma unroll
    for (int ks = 0; ks < 2; ++ks) { F.tm[ks] = *(const bf16x8_t*)(TM + ks * 512); F.qk[ks] = *(const bf16x8_t*)(QK + ks * 512); }
    const u16* kp = qb + (size_t)(((tl >> 4) * 4 + (seg >> 1)) * 4 + (seg & 1) * 2) * rs + 1024 + (tl & 15) * 8;
    F.kr[0] = *(const uint4*)(kp); F.kr[1] = *(const uint4*)(kp + rs);
    F.kds = GCS[128 + tl]; F.egL = GCS[192];
#pragma unroll
    for (int j = 0; j < 4; ++j) { const int l = lt * 16 + fq * 4 + j; F.egc[j] = GCS[l]; F.be[j] = GCS[64 + l]; F.v[j] = qb[(size_t)l * rs + 2048 + e0 + et * 16 + fr]; }
}
__device__ __forceinline__ void deltanet_chunk(const Params& p, int job, unsigned char* lds) {
    const int tid = tid_fresh(), lane = tid & 63, w = tid >> 6, fr = lane & 15, fq = lane >> 4;
    const int chain = job >> 2, cgp = job & 3;
    const int b = chain >> 4, h = (chain >> 1) & 7, dir = chain & 1;
    const int e0 = cgp * 32, lt = w >> 1, et = w & 1, dt0 = (w >> 1) * 2, tl = tid & 63, seg = tid >> 6;
    u16* Sl = (u16*)lds;
    u16* Rt = (u16*)(lds + 17408);
    u16* VNt = (u16*)(lds + 17408 + 4608);
    u16* Kdt = (u16*)(lds + 17408 + 9216);
    u16* O = (u16*)(p.ws + (dir ? WS_OB : WS_OF));
    __syncthreads();
    for (int i = tid; i < 17408 / 4; i += NTHR) ((unsigned*)Sl)[i] = 0u;
    __syncthreads();
    f32x4_t Sacc[2]; Sacc[0] = (f32x4_t){0.f, 0.f, 0.f, 0.f}; Sacc[1] = Sacc[0];
    DnFr buf[2];
    dn_load(buf[0], p, 0, b, h, dir, e0, lt, et, fr, fq, tl, seg); dn_load(buf[1], p, 1, b, h, dir, e0, lt, et, fr, fq, tl, seg);
    for (int n0 = 0; n0 < NSEG; n0 += 4) {
#pragma unroll
        for (int u = 0; u < 4; ++u) {
            const int n = n0 + u; const int s = u & 1;
            const DnFr& F = buf[s];
            const int tt = tile_of(n, b, dir), rowbase = rowbase_of(tt);
            const u16* Scur = Sl + (n & 1) * (32 * 136); u16* Snxt = Sl + ((n + 1) & 1) * (32 * 136);
            f32x4_t X = (f32x4_t){0.f, 0.f, 0.f, 0.f}, Y = X;
#pragma unroll
            for (int ks = 0; ks < 4; ++ks) { const bf16x8_t sb = *(const bf16x8_t*)(Scur + (et * 16 + fr) * 136 + ks * 32 + fq * 8);
                X = __builtin_amdgcn_mfma_f32_16x16x32_bf16(F.k[ks], sb, X, 0, 0, 0); Y = __builtin_amdgcn_mfma_f32_16x16x32_bf16(F.q[ks], sb, Y, 0, 0, 0); }
#pragma unroll
            for (int j = 0; j < 4; ++j) Rt[(et * 16 + fr) * 72 + lt * 16 + fq * 4 + j] = f2bf(F.be[j] * (bf2f(F.v[j]) - F.egc[j] * X[j]));
            { float k[16]; unpack8(F.kr[0], k); unpack8(F.kr[1], k + 8);
#pragma unroll
                for (int c = 0; c < 16; ++c) Kdt[(seg * 16 + c) * 72 + tl] = f2bf(k[c] * F.kds); }
            __syncthreads();
            { f32x4_t VN = (f32x4_t){0.f, 0.f, 0.f, 0.f};
#pragma unroll
                for (int ks = 0; ks < 2; ++ks) { const bf16x8_t rb = *(const bf16x8_t*)(Rt + (et * 16 + fr) * 72 + ks * 32 + fq * 8); VN = __builtin_amdgcn_mfma_f32_16x16x32_bf16(F.tm[ks], rb, VN, 0, 0, 0); }
#pragma unroll
                for (int j = 0; j < 4; ++j) VNt[(et * 16 + fr) * 72 + lt * 16 + fq * 4 + j] = f2bf(VN[j]); }
            __syncthreads();
            bf16x8_t vn[2];
#pragma unroll
            for (int ks = 0; ks < 2; ++ks) vn[ks] = *(const bf16x8_t*)(VNt + (et * 16 + fr) * 72 + ks * 32 + fq * 8);
            { f32x4_t acc = (f32x4_t){0.f, 0.f, 0.f, 0.f};
#pragma unroll
                for (int ks = 0; ks < 2; ++ks) acc = __builtin_amdgcn_mfma_f32_16x16x32_bf16(F.qk[ks], vn[ks], acc, 0, 0, 0);
#pragma unroll
                for (int j = 0; j < 4; ++j) O[(size_t)(rowbase + lt * 16 + fq * 4 + j) * 2048 + 1024 + h * 128 + e0 + et * 16 + fr] = f2bf(0.08838834764831845f * F.egc[j] * Y[j] + acc[j]); }
#pragma unroll
            for (int i = 0; i < 2; ++i) { f32x4_t nw = (f32x4_t){0.f, 0.f, 0.f, 0.f};
#pragma unroll
                for (int ks = 0; ks < 2; ++ks) { const bf16x8_t kb = *(const bf16x8_t*)(Kdt + ((dt0 + i) * 16 + fr) * 72 + ks * 32 + fq * 8); nw = __builtin_amdgcn_mfma_f32_16x16x32_bf16(vn[ks], kb, nw, 0, 0, 0); }
#pragma unroll
                for (int j = 0; j < 4; ++j) { Sacc[i][j] = F.egL * Sacc[i][j] + nw[j]; Snxt[(et * 16 + fq * 4 + j) * 136 + (dt0 + i) * 16 + fr] = f2bf(Sacc[i][j]); } }
            __syncthreads();
            dn_load(buf[s], p, n + 2, b, h, dir, e0, lt, et, fr, fq, tl, seg);
        }
    }
}

constexpr int RG_XC = 65536;

__device__ __forceinline__ void ph_convert_rg(const Params& p) {
    u16* WRT = (u16*)(p.ws + WS_WRT);
    for (int idx = blockIdx.x * NTHR + tid_fresh(); idx < 65536; idx += gridDim.x * NTHR) {
        const int k8 = idx & 15, n = (idx >> 4) & 127, mzg = idx >> 11;
        const float* W = (mzg < 16 ? p.rg_w_r : p.rg_w_i) + (size_t)(mzg & 15) * 16384;
        float v[8];
#pragma unroll
        for (int j = 0; j < 8; ++j) v[j] = W[(k8 * 8 + j) * 128 + n];
        *(uint4*)(WRT + (size_t)mzg * 16384 + (((n >> 4) * 4 + (k8 >> 2)) * 64 + (k8 & 3) * 16 + (n & 15)) * 8) = pack8(v);
    }
}
__device__ __forceinline__ int rg_tau(int tt, int z) { if (tt < 8) { const int ci = tt & 3; return z ? 3 - ci : ci; } const int li = (tt - 8) & 255; return 4 + (z ? 255 - li : li); }
__device__ __forceinline__ int rg_batch(int tt) { return tt < 8 ? (tt >> 2) : ((tt - 8) >> 8); }

__device__ __forceinline__ void rg_conv(const Params& p, int tt, int g, unsigned char* lds) {
    const int tid = tid_fresh();
    const u16* PROJ = (const u16*)(p.ws + WS_PROJ);
    u16* XC = (u16*)(lds + RG_XC);
    const bool isctx = tt < 8;
    const int t0 = isctx ? (tt & 3) * 64 : 0;
    const int rowbase = isctx ? (tt >> 2) * 256 + t0 : 512 + (tt - 8) * 64;
    const int tk = tid >> 3, cs = (tid & 7) * 16;
    uint4 in[5][2];
#pragma unroll
    for (int j = 0; j < 5; ++j) { const int r = tk + j - 2;
        const bool ok = isctx ? (t0 + r >= 0 && t0 + r < 256) : (r >= 0 && r < 64);
        in[j][0] = make_uint4(0u, 0u, 0u, 0u); in[j][1] = in[j][0];
        if (ok) { const u16* src = PROJ + (size_t)(rowbase + r) * NP1 + g * 128 + cs; in[j][0] = *(const uint4*)(src); in[j][1] = *(const uint4*)(src + 8); } }
    float o[16];
#pragma unroll
    for (int c4 = 0; c4 < 4; ++c4) { const float4 b4 = *(const float4*)(p.rg_conv_b + g * 128 + cs + c4 * 4); o[c4 * 4] = b4.x; o[c4 * 4 + 1] = b4.y; o[c4 * 4 + 2] = b4.z; o[c4 * 4 + 3] = b4.w; }
#pragma unroll
    for (int j = 0; j < 5; ++j) {
        const float* wr_ = p.rg_conv_w + j * 1024 + g * 128 + cs; float f[16]; unpack8(in[j][0], f); unpack8(in[j][1], f + 8);
#pragma unroll
        for (int c4 = 0; c4 < 4; ++c4) { const float4 w4 = *(const float4*)(wr_ + c4 * 4);
            o[c4 * 4 + 0] += f[c4 * 4 + 0] * w4.x; o[c4 * 4 + 1] += f[c4 * 4 + 1] * w4.y; o[c4 * 4 + 2] += f[c4 * 4 + 2] * w4.z; o[c4 * 4 + 3] += f[c4 * 4 + 3] * w4.w; }
    }
    __syncthreads();
    *(uint4*)(XC + tk * 136 + cs) = pack8(o); *(uint4*)(XC + tk * 136 + cs + 8) = pack8(o + 8);
    __syncthreads();
}
__device__ __forceinline__ void rg_gates_reg(const Params& p, int g, int z, const unsigned char* lds, int rt, int chh, int fr, int fq, float (&av)[4][4], float (&bx)[4][4]) {
    const u16* XC = (const u16*)(lds + RG_XC);
    const u16* WR = (const u16*)(p.ws + WS_WRT) + (size_t)((0 * 2 + z) * 8 + g) * 16384; const u16* WI = (const u16*)(p.ws + WS_WRT) + (size_t)((1 * 2 + z) * 8 + g) * 16384;
    f32x4_t R[4], I[4];
#pragma unroll
    for (int c = 0; c < 4; ++c) { R[c] = (f32x4_t){0.f, 0.f, 0.f, 0.f}; I[c] = (f32x4_t){0.f, 0.f, 0.f, 0.f}; }
#pragma unroll
    for (int ks = 0; ks < 4; ++ks) {
        const bf16x8_t a = *(const bf16x8_t*)(XC + (rt * 16 + fr) * 136 + ks * 32 + fq * 8);
#pragma unroll
        for (int c = 0; c < 4; ++c) { const int fo = (((chh * 4 + c) * 4 + ks) * 64 + fq * 16 + fr) * 8;
            R[c] = __builtin_amdgcn_mfma_f32_16x16x32_bf16(a, *(const bf16x8_t*)(WR + fo), R[c], 0, 0, 0);
            I[c] = __builtin_amdgcn_mfma_f32_16x16x32_bf16(a, *(const bf16x8_t*)(WI + fo), I[c], 0, 0, 0); }
    }
#pragma unroll
    for (int c = 0; c < 4; ++c) {
        const int chl = (chh * 4 + c) * 16 + fr, chg = z * 1024 + g * 128 + chl;
        const float br = p.rg_b_r[chg], bi = p.rg_b_i[chg], sp = softplusf_(-p.rg_lambda[chg]);
#pragma unroll
        for (int j = 0; j < 4; ++j) { const int t = rt * 16 + fq * 4 + j;
            const float r = sigmoidf_(R[c][j] + br), ii = sigmoidf_(I[c][j] + bi);
            const float la = -8.f * r * sp;
            av[c][j] = __expf(la); bx[c][j] = __builtin_amdgcn_sqrtf(neg_expm1_small(2.f * la)) * ii * bf2f(XC[t * 136 + chl]); }
    }
}
__device__ __forceinline__ float2 rg_local(const float (&a)[4], const float (&b)[4], int z) {
    float P = 1.f, H = 0.f;
#pragma unroll
    for (int i = 0; i < 4; ++i) { const int j = z ? 3 - i : i; H = a[j] * H + b[j]; P *= a[j]; }
    return make_float2(P, H);
}
struct GlaPin { float lr[2]; uint4 q[2], k[2], v[4]; };
__device__ __forceinline__ void gla_prep_load(GlaPin& I, const Params& p, int it, int tid) {
    const int h = it & 3, tt = (it >> 2) % 520, z = it / 2080;
    const int rowbase = tt < 8 ? tt * 64 : 512 + (tt - 8) * 64;
    const u16* PROJ = (const u16*)(p.ws + WS_PROJ); const float* LR = (const float*)(p.ws + WS_G);
#pragma unroll
    for (int r = 0; r < 2; ++r) { const int i = tid + r * NTHR; I.lr[r] = LR[(size_t)(rowbase + (i >> 4)) * 32 + z * 16 + (i & 15)]; }
    const int tk = tid >> 3, cs = (tid & 7) * 16; const u16* rp = PROJ + (size_t)(rowbase + tk) * NP1;
    I.q[0] = *(const uint4*)(rp + 2048 + h * 128 + cs); I.q[1] = *(const uint4*)(rp + 2048 + h * 128 + cs + 8);
    I.k[0] = *(const uint4*)(rp + 2560 + h * 128 + cs); I.k[1] = *(const uint4*)(rp + 2560 + h * 128 + cs + 8);
    if (z == 0) {
#pragma unroll
        for (int r = 0; r < 4; ++r) { const int ch = tid + r * NTHR, vk = ch >> 5, c8 = (ch & 31) * 8; I.v[r] = *(const uint4*)(PROJ + (size_t)(rowbase + vk) * NP1 + 3072 + h * 256 + c8); } }
}
__device__ __forceinline__ void gla_prep_item(const Params& p, int it, unsigned char* lds, const GlaPin& I) {
    const int tid = tid_fresh(), lane = tid & 63, w = tid >> 6, fr = lane & 15, fq = lane >> 4;
    const int h = it & 3, tt = (it >> 2) % 520, z = it / 2080;
    const int rowbase = tt < 8 ? tt * 64 : 512 + (tt - 8) * 64;
    float* LG = (float*)lds;
    u16* QEs = (u16*)(lds + 32768);
    u16* KEs = (u16*)(lds + 32768 + 17408);
    u16* Vs = (u16*)(lds + 32768 + 2 * 17408);
    float* BLs = (float*)(lds + 32768 + 2 * 17408 + 33792);
    const u16* PROJ = (const u16*)(p.ws + WS_PROJ); const float* LR = (const float*)(p.ws + WS_G);
    u16* QE = (u16*)(p.ws + WS_QE); u16* KDT = (u16*)(p.ws + WS_KDT) + (size_t)it * 8192; u16* ATT = (u16*)(p.ws + WS_ATT) + (size_t)it * 4096;
    u16* VT = (u16*)(p.ws + WS_VT); float* EBL = (float*)(p.ws + WS_EBL);
    __syncthreads();
    { float* LRs = (float*)(lds + 32768);
        LRs[tid] = I.lr[0]; LRs[tid + NTHR] = I.lr[1];
        __syncthreads();
        const int c = tid & 127, tq = tid >> 7; float wv[16];
#pragma unroll
        for (int r = 0; r < 16; ++r) wv[r] = p.gla_w_up[(z * 16 + r) * 512 + h * 128 + c];
        const float bu = p.gla_b_up[z * 512 + h * 128 + c];
        for (int i = 0; i < 16; ++i) { const int tk = tq * 16 + i; const float4* lr4 = (const float4*)(LRs + tk * 16); float s = bu;
#pragma unroll
            for (int r4 = 0; r4 < 4; ++r4) { const float4 l4 = lr4[r4]; s += l4.x * wv[r4 * 4] + l4.y * wv[r4 * 4 + 1] + l4.z * wv[r4 * 4 + 2] + l4.w * wv[r4 * 4 + 3]; }
            LG[tk * 128 + c] = logsigmoidf_(s) * (1.f / 16.f); } }
    __syncthreads();
    if (tid < 128) { float acc = 0.f;
        for (int i = 0; i < 64; ++i) { const int tk = z ? 63 - i : i; acc += LG[tk * 128 + tid]; LG[tk * 128 + tid] = acc; }
        BLs[tid] = acc; EBL[(size_t)it * 128 + tid] = __expf(acc); }
    __syncthreads();
    { const int tk = tid >> 3, cs = (tid & 7) * 16; const u16* rp = PROJ + (size_t)(rowbase + tk) * NP1;
        float q[16], k[16], qe[16], ke[16];
        unpack8(I.q[0], q); unpack8(I.q[1], q + 8);
        unpack8(I.k[0], k); unpack8(I.k[1], k + 8);
#pragma unroll
        for (int c = 0; c < 16; ++c) { const float bb = LG[tk * 128 + cs + c], bl = BLs[cs + c];
            qe[c] = q[c] * 0.08838834764831845f * __expf(bb); ke[c] = k[c] * __expf(-bb);
            { const int d = cs + c; KDT[(((d >> 4) * 2 + (tk >> 5)) * 64 + ((tk >> 3) & 3) * 16 + (d & 15)) * 8 + (tk & 7)] = f2bf(k[c] * __expf(bl - bb)); } }
        const uint4 q0 = pack8(qe), q1 = pack8(qe + 8);
        *(uint4*)(QEs + tk * 136 + cs) = q0; *(uint4*)(QEs + tk * 136 + cs + 8) = q1;
        *(uint4*)(KEs + tk * 136 + cs) = pack8(ke); *(uint4*)(KEs + tk * 136 + cs + 8) = pack8(ke + 8);
        u16* qg = QE + (size_t)it * 8192 + (((tk >> 4) * 4 + (cs >> 5)) * 64 + ((cs >> 3) & 3) * 16 + (tk & 15)) * 8;
        *(uint4*)(qg) = q0; *(uint4*)(qg + 128) = q1; }
    if (z == 0) {
#pragma unroll
        for (int r = 0; r < 4; ++r) { const int ch = tid + r * NTHR, vk = ch >> 5, c8 = (ch & 31) * 8; *(uint4*)(Vs + vk * 264 + c8) = I.v[r]; } }
    __syncthreads();
    { const int rt = w >> 1;
#pragma unroll
        for (int i = 0; i < 2; ++i) { const int ct = (w & 1) * 2 + i; f32x4_t acc = (f32x4_t){0.f, 0.f, 0.f, 0.f};
#pragma unroll
            for (int ks = 0; ks < 4; ++ks) { const bf16x8_t a = *(const bf16x8_t*)(QEs + (rt * 16 + fr) * 136 + ks * 32 + fq * 8); const bf16x8_t bb = *(const bf16x8_t*)(KEs + (ct * 16 + fr) * 136 + ks * 32 + fq * 8);
                acc = __builtin_amdgcn_mfma_f32_16x16x32_bf16(a, bb, acc, 0, 0, 0); }
#pragma unroll
            for (int j = 0; j < 4; ++j) { const int l = rt * 16 + fq * 4 + j, s = ct * 16 + fr; const bool keep = z ? (s >= l) : (s <= l);
                ATT[(((l >> 4) * 2 + (s >> 5)) * 64 + ((s >> 3) & 3) * 16 + (l & 15)) * 8 + (s & 7)] = f2bf(keep ? acc[j] : 0.f); } } }
    if (z == 0) { const int e = tid >> 1, hf = tid & 1; u16* dst = VT + (size_t)(tt * 4 + h) * 16384 + (((e >> 4) * 2 + hf) * 64 + (e & 15)) * 8;
#pragma unroll
        for (int l8 = 0; l8 < 4; ++l8) { float v[8];
#pragma unroll
            for (int j = 0; j < 8; ++j) v[j] = bf2f(Vs[(hf * 32 + l8 * 8 + j) * 264 + e]);
            *(uint4*)(dst + l8 * 128) = pack8(v); } }
}
__device__ __forceinline__ void ph_l1_a(const Params& p, unsigned char* lds, int parts = 3) {
    const int tid = tid_fresh(), lane = tid & 63, w = tid >> 6, rt = w >> 1, chh = w & 1, fr = lane & 15, fq = lane >> 4;
    float2* AGG = (float2*)(p.ws + WS_AGG);
    float2* AG = (float2*)lds;
    if (parts & 1) for (int t = blockIdx.x; t < 520 * 8; t += gridDim.x) {
        const int tt = t >> 3, g = t & 7, b = rg_batch(tt);
        rg_conv(p, tt, g, lds);
#pragma unroll
        for (int z = 0; z < 2; ++z) {
            float av[4][4], bx[4][4];
            rg_gates_reg(p, g, z, lds, rt, chh, fr, fq, av, bx);
#pragma unroll
            for (int c = 0; c < 4; ++c) AG[(z * 16 + rt * 4 + fq) * 128 + (chh * 4 + c) * 16 + fr] = rg_local(av[c], bx[c], z);
        }
        __syncthreads();
        if (tid < 256) { const int z = tid >> 7, ch = tid & 127; float P = 1.f, H = 0.f;
#pragma unroll
            for (int s = 0; s < 16; ++s) { const int gi = z ? 15 - s : s; const float2 ph = AG[(z * 16 + gi) * 128 + ch]; H = ph.x * H + ph.y; P *= ph.x; }
            AGG[((size_t)(b * 2 + z) * NSEG + rg_tau(tt, z)) * 1024 + g * 128 + ch] = make_float2(P, H); }
    }
    if (parts & 2) { GlaPin cur, nxt; const int G_ = (int)gridDim.x;
        if ((int)blockIdx.x < 4160) gla_prep_load(cur, p, blockIdx.x, tid);
        for (int it = blockIdx.x; it < 4160; it += G_) {
            if (it + G_ < 4160) gla_prep_load(nxt, p, it + G_, tid);
            gla_prep_item(p, it, lds, cur);
            cur = nxt; } }
}
__device__ __forceinline__ void rg_pass_b(const Params& p, int job) {
    const float2* __restrict__ AGG = (const float2*)(p.ws + WS_AGG); float* __restrict__ CARRY = (float*)(p.ws + WS_CARRY);
    const int bz = job >> 1, ch = (job & 1) * 512 + tid_fresh();
    float carry = 0.f;
    for (int t0 = 0; t0 < NSEG; t0 += 20) {
        float2 ph[20];
#pragma unroll
        for (int i = 0; i < 20; ++i) ph[i] = AGG[((size_t)bz * NSEG + t0 + i) * 1024 + ch];
#pragma unroll
        for (int i = 0; i < 20; ++i) { CARRY[((size_t)bz * NSEG + t0 + i) * 1024 + ch] = carry; carry = ph[i].x * carry + ph[i].y; }
    }
}
struct GlaFr { bf16x8_t qe[4], at[2], vt[2], kd[2][2]; float eb[2]; };
struct GlaOff { int qe, at, vt, kd, eb, o; };
__device__ __forceinline__ void gla_load(GlaFr& F, const unsigned char* ws, int n, int b, int h, int dir, const GlaOff& o) {
    const int nn = n < NSEG ? n : NSEG - 1;
    const int tt = tile_of(nn, b, dir), it = (dir * 520 + tt) * 4 + h, rowbase = rowbase_of(tt);
    const u16* QE = (const u16*)(ws + WS_QE) + (size_t)it * 8192;
    const u16* AT = (const u16*)(ws + WS_ATT) + (size_t)it * 4096;
    const u16* VT = (const u16*)(ws + WS_VT) + (size_t)(tt * 4 + h) * 16384;
    const u16* KD = (const u16*)(ws + WS_KDT) + (size_t)it * 8192;
    const float* EB = (const float*)(ws + WS_EBL) + (size_t)it * 128;
#pragma unroll
    for (int ks = 0; ks < 4; ++ks) F.qe[ks] = *(const bf16x8_t*)(QE + o.qe + ks * 512);
#pragma unroll
    for (int ks = 0; ks < 2; ++ks) { F.at[ks] = *(const bf16x8_t*)(AT + o.at + ks * 512); F.vt[ks] = *(const bf16x8_t*)(VT + o.vt + ks * 512);
        F.kd[0][ks] = *(const bf16x8_t*)(KD + o.kd + ks * 512); F.kd[1][ks] = *(const bf16x8_t*)(KD + o.kd + 1024 + ks * 512); }
    F.eb[0] = EB[o.eb]; F.eb[1] = EB[o.eb + 16];
}
__device__ __forceinline__ void gla_chunk(const Params& p, int job, unsigned char* lds) {
    const int tid = tid_fresh(), lane = tid & 63, w = __builtin_amdgcn_readfirstlane(tid >> 6), fr = lane & 15, fq = lane >> 4;
    const int chain = job >> 3, cgp = job & 7;
    const int b = chain >> 3, h = (chain >> 1) & 3, dir = chain & 1;
    const int e0 = cgp * 32, lt = w >> 1, et = w & 1, dt0 = (w >> 1) * 2;
    const unsigned char* ws = p.ws;
    GlaOff o;
    o.qe = lt * 2048 + lane * 8; o.at = lt * 1024 + lane * 8; o.vt = ((e0 >> 4) + et) * 1024 + lane * 8;
    o.kd = dt0 * 1024 + lane * 8; o.eb = dt0 * 16 + fr; o.o = (lt * 16 + fq * 4) * 1024 + h * 256 + e0 + et * 16 + fr;
    u16* Sl = (u16*)lds;
    u16* O = (u16*)(p.ws + (dir ? WS_OB1 : WS_OF1));
    const int sRd = (et * 16 + fr) * 136 + fq * 8, sWr = (et * 16 + fq * 4) * 136 + dt0 * 16 + fr;
    __syncthreads();
    for (int i = tid; i < 2 * 32 * 136 / 2; i += NTHR) ((unsigned*)Sl)[i] = 0u;
    __syncthreads();
    f32x4_t Sacc[2]; Sacc[0] = (f32x4_t){0.f, 0.f, 0.f, 0.f}; Sacc[1] = Sacc[0];
    GlaFr buf[2];
    gla_load(buf[0], ws, 0, b, h, dir, o); gla_load(buf[1], ws, 1, b, h, dir, o);
    for (int n0 = 0; n0 < NSEG; n0 += 4) {
#pragma unroll
        for (int u = 0; u < 4; ++u) {
            const int n = n0 + u; const int s = u & 1;
            const GlaFr& F = buf[s];
            const u16* Scur = Sl + (n & 1) * (32 * 136); u16* Snxt = Sl + ((n + 1) & 1) * (32 * 136);
            if (n >= 4) {
                const int tt = tile_of(n, b, dir);
                u16* Ou = O + (size_t)(512 + (tt - 8) * 64) * 1024;
                f32x4_t acc = (f32x4_t){0.f, 0.f, 0.f, 0.f};
#pragma unroll
                for (int ks = 0; ks < 4; ++ks) { const bf16x8_t bb = *(const bf16x8_t*)(Scur + sRd + ks * 32); acc = __builtin_amdgcn_mfma_f32_16x16x32_bf16(F.qe[ks], bb, acc, 0, 0, 0); }
#pragma unroll
                for (int ks = 0; ks < 2; ++ks) acc = __builtin_amdgcn_mfma_f32_16x16x32_bf16(F.at[ks], F.vt[ks], acc, 0, 0, 0);
#pragma unroll
                for (int j = 0; j < 4; ++j) Ou[o.o + j * 1024] = f2bf(acc[j]);
            }
#pragma unroll
            for (int i = 0; i < 2; ++i) { f32x4_t nw = (f32x4_t){0.f, 0.f, 0.f, 0.f};
#pragma unroll
                for (int ks = 0; ks < 2; ++ks) nw = __builtin_amdgcn_mfma_f32_16x16x32_bf16(F.vt[ks], F.kd[i][ks], nw, 0, 0, 0);
#pragma unroll
                for (int j = 0; j < 4; ++j) { Sacc[i][j] = F.eb[i] * Sacc[i][j] + nw[j]; Snxt[sWr + j * 136 + i * 16] = f2bf(Sacc[i][j]); } }
            __syncthreads();
            gla_load(buf[s], ws, n + 2, b, h, dir, o);
        }
    }
}
__device__ __forceinline__ void ph_l1_c(const Params& p, unsigned char* lds, int t_lo, int t_hi, int first, int stride, int do_merge) {
    const int tid = tid_fresh(), rt = (tid >> 6) >> 1, chh = (tid >> 6) & 1, fr = tid & 15, fq = (tid & 63) >> 4;
    const u16* PROJ = (const u16*)(p.ws + WS_PROJ); const float* CARRY = (const float*)(p.ws + WS_CARRY); u16* Y = (u16*)(p.ws + WS_H);
    float2* AG = (float2*)lds;
    float* CIN = (float*)(lds + 32768);
    for (int t = t_lo + first; t < t_hi; t += stride) {
        const int tt = t >> 3, g = t & 7, b = rg_batch(tt);
        const int rowbase = 512 + (tt - 8) * 64;
        rg_conv(p, tt, g, lds);
        u16 grv[4][4];
#pragma unroll
        for (int c = 0; c < 4; ++c)
#pragma unroll
            for (int j = 0; j < 4; ++j) grv[c][j] = PROJ[(size_t)(rowbase + rt * 16 + fq * 4 + j) * NP1 + 1024 + g * 128 + (chh * 4 + c) * 16 + fr];
        float av[2][4][4], bx[2][4][4];
#pragma unroll
        for (int z = 0; z < 2; ++z) {
            rg_gates_reg(p, g, z, lds, rt, chh, fr, fq, av[z], bx[z]);
#pragma unroll
            for (int c = 0; c < 4; ++c) AG[(z * 16 + rt * 4 + fq) * 128 + (chh * 4 + c) * 16 + fr] = rg_local(av[z][c], bx[z][c], z);
        }
        __syncthreads();
        if (tid < 256) { const int z = tid >> 7, ch = tid & 127; float h = CARRY[((size_t)(b * 2 + z) * NSEG + rg_tau(tt, z)) * 1024 + g * 128 + ch];
#pragma unroll
            for (int s = 0; s < 16; ++s) { const int gi = z ? 15 - s : s; CIN[(z * 16 + gi) * 128 + ch] = h; const float2 ph = AG[(z * 16 + gi) * 128 + ch]; h = ph.x * h + ph.y; } }
        __syncthreads();
#pragma unroll
        for (int c = 0; c < 4; ++c) { const int chl = (chh * 4 + c) * 16 + fr; float hs[4];
            { float h = CIN[(0 * 16 + rt * 4 + fq) * 128 + chl];
#pragma unroll
                for (int j = 0; j < 4; ++j) { h = av[0][c][j] * h + bx[0][c][j]; hs[j] = h; } }
            { float h = CIN[(1 * 16 + rt * 4 + fq) * 128 + chl];
#pragma unroll
                for (int j = 3; j >= 0; --j) { h = av[1][c][j] * h + bx[1][c][j]; hs[j] += h; } }
#pragma unroll
            for (int j = 0; j < 4; ++j) Y[(size_t)(rowbase + rt * 16 + fq * 4 + j) * 2048 + g * 128 + chl] = f2bf(gelu_tanh(bf2f(grv[c][j])) * hs[j]); }
    }
    const int lane = tid & 63, w = tid >> 6;
    const u16* OF = (const u16*)(p.ws + WS_OF1); const u16* OB = (const u16*)(p.ws + WS_OB1);
    if (do_merge) for (int row = 512 + blockIdx.x * 8 + w; row < MTOT; row += gridDim.x * 8) {
        float o[2][8], ssq[2];
#pragma unroll
        for (int k = 0; k < 2; ++k) { const int col = (k * 64 + lane) * 8; float a[8], bb[8];
            unpack8(*(const uint4*)(OF + (size_t)row * 1024 + col), a); unpack8(*(const uint4*)(OB + (size_t)row * 1024 + col), bb);
            float s = 0.f;
#pragma unroll
            for (int j = 0; j < 8; ++j) { o[k][j] = a[j] + bb[j]; s += o[k][j] * o[k][j]; }
            s = red16(s); s += __shfl_xor(s, 16); ssq[k] = s; }
#pragma unroll
        for (int k = 0; k < 2; ++k) { const int col = (k * 64 + lane) * 8; const float rstd = rsqrtf(ssq[k] * (1.f / 256.f) + 1e-6f);
            float gt[8], r[8]; unpack8(*(const uint4*)(PROJ + (size_t)row * NP1 + 4096 + col), gt);
            const float4 g0 = *(const float4*)(p.gla_norm_g + col), g1 = *(const float4*)(p.gla_norm_g + col + 4); const float gg[8] = {g0.x, g0.y, g0.z, g0.w, g1.x, g1.y, g1.z, g1.w};
#pragma unroll
            for (int j = 0; j < 8; ++j) r[j] = o[k][j] * rstd * gg[j] * siluf_(gt[j]);
            *(uint4*)(Y + (size_t)row * 2048 + 1024 + col) = pack8(r); }
    }
}

#define XB_TMO      128
#define XB_XCNT(j)  (256  + 64 * (j))
#define XB_XSUB(j)  (1280 + 64 * (j))
#define XB_XGEN(j)  (2304 + 64 * (j))
#define XB_TOP      3328
#define XB_TOPGEN   3392
#define XCD_BAR_WORDS 3456
#define XB_SPIN_CAP (1u << 18)
#define XLAS __attribute__((address_space(3)))

__device__ __forceinline__ unsigned xb_ld(unsigned* p)              { return __hip_atomic_load(p, __ATOMIC_RELAXED, __HIP_MEMORY_SCOPE_AGENT); }
__device__ __forceinline__ unsigned xb_add(unsigned* p, unsigned v) { return __hip_atomic_fetch_add(p, v, __ATOMIC_RELAXED, __HIP_MEMORY_SCOPE_AGENT); }
__device__ __forceinline__ unsigned xb_xcc_id() { return (unsigned)__builtin_amdgcn_s_getreg((3 << 11) | 20) & 0xFu; }
#define XB_SPIN(cond, bar) do { unsigned _sp = 0; while (cond) { __builtin_amdgcn_s_sleep(1); \
    if ((++_sp & 255u) == 0u) { if (xb_ld(&(bar)[XB_TMO])) break; if (_sp > XB_SPIN_CAP) { atomicAdd(&(bar)[XB_TMO], 1u); break; } } } } while (0)

struct XcdBarrier {
    unsigned* bar; unsigned x;
    volatile XLAS unsigned* st;
};

__device__ __forceinline__ XcdBarrier xcd_barrier_post(unsigned* bar, volatile XLAS unsigned* st) {
    XcdBarrier b; b.bar = bar; b.x = xb_xcc_id(); b.st = st;
    if (threadIdx.x == 0) (void)xb_add(&bar[XB_XCNT(b.x)], 1u);
    return b;
}
__device__ __forceinline__ void xcd_barrier_complete(unsigned* bar, unsigned x, unsigned& nloc, unsigned& nx) {
    const unsigned G = gridDim.x * gridDim.y * gridDim.z;
    unsigned sum, cnt, mine, sp = 0u;
    for (;;) {
        sum = 0u; cnt = 0u; mine = 0u;
#pragma unroll
        for (unsigned j = 0; j < 16; ++j) { const unsigned c = xb_ld(&bar[XB_XCNT(j)]); sum += c; cnt += (c > 0u) ? 1u : 0u; mine = (j == x) ? c : mine; }
        if (sum == G) break;
        __builtin_amdgcn_s_sleep(1);
        if ((++sp & 255u) == 0u) { if (xb_ld(&bar[XB_TMO])) break; if (sp > XB_SPIN_CAP) { atomicAdd(&bar[XB_TMO], 1u); break; } }
    }
    nloc = mine > 0u ? mine : 1u; nx = cnt > 0u ? cnt : 1u;
}

__device__ __forceinline__ void xcd_barrier(const XcdBarrier& b) {
    asm volatile("s_waitcnt vmcnt(0)" ::: "memory");
    __syncthreads();
    if (threadIdx.x == 0) {
        unsigned* bar = b.bar;
        __builtin_amdgcn_s_waitcnt(0);
        unsigned nloc = b.st[0], nx = b.st[1];
        if (nloc == 0u) { xcd_barrier_complete(bar, b.x, nloc, nx); b.st[0] = nloc; b.st[1] = nx; }
        const unsigned old = xb_add(&bar[XB_XSUB(b.x)], 1u);
        const unsigned gen = old / nloc;
        if (old + 1u == (gen + 1u) * nloc) {
            __builtin_amdgcn_fence(__ATOMIC_RELEASE, "agent");
            asm volatile("s_waitcnt vmcnt(0)" ::: "memory");
            const unsigned og = xb_add(&bar[XB_TOP], 1u);
            const unsigned tg = og / nx;
            if (og + 1u == (tg + 1u) * nx) xb_add(&bar[XB_TOPGEN], 1u);
            else XB_SPIN(xb_ld(&bar[XB_TOPGEN]) == tg, bar);
            __builtin_amdgcn_fence(__ATOMIC_ACQUIRE, "agent");
            xb_add(&bar[XB_XGEN(b.x)], 1u);
            asm volatile("s_waitcnt vmcnt(0)" ::: "memory");
        } else {
            XB_SPIN(xb_ld(&bar[XB_XGEN(b.x)]) == gen, bar);
            __builtin_amdgcn_fence(__ATOMIC_ACQUIRE, "agent");
            asm volatile("s_waitcnt vmcnt(0)" ::: "memory");
        }
    }
    __syncthreads();
}

constexpr int LDS_BYTES = 135168 + 16;
constexpr int L1C_SPLIT = 64 + 2048;

__global__ void __launch_bounds__(NTHR, 2) hybrid_fwd(Params p) {
    extern __shared__ __attribute__((aligned(16))) unsigned char lds[];
    cg::grid_group grid = cg::this_grid();
    float* smf = (float*)lds;
    PG8_LAS unsigned char* ldsg = (PG8_LAS unsigned char*)lds;
    unsigned char* ws = p.ws;
    u16* WT_IN = (u16*)(ws + WS_WT_IN); u16* WT_OUT = (u16*)(ws + WS_WT_OUT); u16* WT_GU = (u16*)(ws + WS_WT_GU); u16* WT_DN = (u16*)(ws + WS_WT_DN);
    u16* H = (u16*)(ws + WS_H); u16* PROJ = (u16*)(ws + WS_PROJ); float* XC = (float*)(ws + WS_XC); float* G = (float*)(ws + WS_G);
    const float* MOD = (const float*)(ws + WS_MOD);
    const int GD = (int)gridDim.x, bid = (int)blockIdx.x;
    const int vb = (GD % 8 == 0) ? (bid % 8) * (GD / 8) + bid / 8 : bid;
    volatile XLAS unsigned* xst = (volatile XLAS unsigned*)((PG8_LAS unsigned char*)lds + 135168);
    if (threadIdx.x < 2) xst[threadIdx.x] = 0u;
    __syncthreads();
    const XcdBarrier xbar = xcd_barrier_post((unsigned*)(ws + WS_BAR), xst);

    ph_adaln_partials(p, smf);
    ph_convert_rg(p);
    ph_convert<1>(p.ab_w_in, 7216, 2048, 7424, WT_IN, smf);
    ph_convert<0>(p.ab_w_out, 2048, 2048, 2048, WT_OUT, smf);
    ph_convert<2>(p.ffn_w_gu, 11264, 2048, 11264, WT_GU, smf);
    ph_convert<0>(p.ffn_w_down, 2048, 5632, 2048, WT_DN, smf);
    grid.sync();
    ph_adaln_reduce(p);
    xcd_barrier(xbar);

    ph_norm(p.ctx, p.x, p.norm_mix_g, MOD, 0, 1, H, 0);
    xcd_barrier(xbar);
    { pg8::Gemm g{H, WT_IN, MTOT, 7424, 2048}; pg8::StaticOrder S; S.init(MTOT, 7424, GD, bid);
      pg8::EpiProj E{PROJ, NP0, 28, G, NG0, NG0, 4}; pg8::gemm_phase<pg8::EpiProj, pg8::StaticOrder>(ldsg, g, S, E); }
    xcd_barrier(xbar);
    ph_l0_prep(p, smf);
    xcd_barrier(xbar);
    ph_l0_prepass(p, lds);
    xcd_barrier(xbar);
    for (int job = vb; job < 256; job += GD) { if (job < 128) mlstm_chunk(p, job, lds); else deltanet_chunk(p, job - 128, lds); }
    xcd_barrier(xbar);
    ph_l0_merge(p);
    xcd_barrier(xbar);
    { pg8::Gemm g{H, WT_OUT, MTOT, 2048, 2048}; pg8::StaticOrder S; S.init(MTOT, 2048, GD, bid);
      pg8::EpiRes E{p.ctx, p.x, XC, p.out, MOD + 2 * 2048, 0}; pg8::gemm_phase<pg8::EpiRes, pg8::StaticOrder>(ldsg, g, S, E); }
    xcd_barrier(xbar);
    ph_norm(XC, p.out, p.norm_ffn_g, MOD, 3, 4, H, 0);
    xcd_barrier(xbar);
    { pg8::Gemm g{H, WT_GU, MTOT, 11264, 2048}; pg8::StaticOrder S; S.init(MTOT, 11264, GD, bid);
      pg8::EpiSwiglu E{PROJ, FH}; pg8::gemm_phase<pg8::EpiSwiglu, pg8::StaticOrder>(ldsg, g, S, E);
    }
    xcd_barrier(xbar);
    { pg8::Gemm g{PROJ, WT_DN, MTOT, 2048, 5632}; pg8::StaticOrder S; S.init(MTOT, 2048, GD, bid);
      pg8::EpiRes E{XC, p.out, XC, p.out, MOD + 5 * 2048, 0}; pg8::gemm_phase<pg8::EpiRes, pg8::StaticOrder>(ldsg, g, S, E); }
    xcd_barrier(xbar);

    const float* MOD1 = MOD + 3 * 12288;
    ph_convert<0>(p.cd_w_in, 5152, 2048, 5376, WT_IN, smf);
    ph_convert<0>(p.cd_w_out, 2048, 2048, 2048, WT_OUT, smf);
    ph_convert<2>(p.ffn_w_gu + (size_t)2048 * 11264, 11264, 2048, 11264, WT_GU, smf);
    ph_convert<0>(p.ffn_w_down + (size_t)5632 * 2048, 2048, 5632, 2048, WT_DN, smf);
    ph_norm(XC, p.out, p.norm_mix_g + 2048, MOD1, 0, 1, H, 0);
    xcd_barrier(xbar);
    { pg8::Gemm g{H, WT_IN, MTOT, 5376, 2048}; pg8::StaticOrder S; S.init(MTOT, 5376, GD, bid);
      pg8::EpiProj E{PROJ, NP1, 20, G, NG1, NG1, 0}; pg8::gemm_phase<pg8::EpiProj, pg8::StaticOrder>(ldsg, g, S, E); }
    xcd_barrier(xbar);
    ph_l1_a(p, lds);
    xcd_barrier(xbar);
    const bool l1_split = (GD >= 200);
    unsigned* rgflag = (unsigned*)(ws + WS_BAR) + 3600;
    for (int job = vb; job < 136; job += GD) {
        if (job < 128) gla_chunk(p, job, lds);
        else { rg_pass_b(p, job - 128);
            __builtin_amdgcn_fence(__ATOMIC_RELEASE, "agent"); asm volatile("s_waitcnt vmcnt(0)" ::: "memory"); __syncthreads();
            if (threadIdx.x == 0) __hip_atomic_fetch_add(rgflag, 1u, __ATOMIC_RELAXED, __HIP_MEMORY_SCOPE_AGENT); }
    }
    if (l1_split && vb >= 136) {
        if (threadIdx.x == 0) { unsigned sp = 0; while (__hip_atomic_load(rgflag, __ATOMIC_RELAXED, __HIP_MEMORY_SCOPE_AGENT) < 8u && ++sp < (1u << 22)) __builtin_amdgcn_s_sleep(4); }
        __syncthreads();
        __builtin_amdgcn_fence(__ATOMIC_ACQUIRE, "agent"); asm volatile("s_waitcnt vmcnt(0)" ::: "memory");
        ph_l1_c(p, lds, 64, L1C_SPLIT, vb - 136, GD - 136, 0);
    }
    xcd_barrier(xbar);
    ph_l1_c(p, lds, l1_split ? L1C_SPLIT : 64, 520 * 8, bid, GD, 1);
    xcd_barrier(xbar);
    { pg8::Gemm g{H + (size_t)512 * 2048, WT_OUT, MLAT, 2048, 2048}; pg8::StaticOrder S; S.init(MLAT, 2048, GD, bid);
      pg8::EpiRes E{XC, p.out, XC, p.out, MOD1 + 2 * 2048, 512}; pg8::gemm_phase<pg8::EpiRes, pg8::StaticOrder>(ldsg, g, S, E); }
    xcd_barrier(xbar);
    ph_norm(XC, p.out, p.norm_ffn_g + 2048, MOD1, 3, 4, H, 512);
    xcd_barrier(xbar);
    { pg8::Gemm g{H + (size_t)512 * 2048, WT_GU, MLAT, 11264, 2048}; pg8::StaticOrder S; S.init(MLAT, 11264, GD, bid);
      pg8::EpiSwiglu E{PROJ, FH}; pg8::gemm_phase<pg8::EpiSwiglu, pg8::StaticOrder>(ldsg, g, S, E);
    }
    xcd_barrier(xbar);
    { pg8::Gemm g{PROJ, WT_DN, MLAT, 2048, 5632}; pg8::StaticOrder S; S.init(MLAT, 2048, GD, bid);
      pg8::EpiRes E{XC, p.out, XC, p.out, MOD1 + 5 * 2048, 512}; pg8::gemm_phase<pg8::EpiRes, pg8::StaticOrder>(ldsg, g, S, E); }
    xcd_barrier(xbar);
    ph_final_norm(p);
}

extern "C" void kernel_launch(void* const* d_in, const int* in_sizes, int n_in, void* d_out, int out_size, void* d_ws, size_t ws_size, hipStream_t stream) {
    static int grid = 0;
    if (grid == 0) {
        if (n_in != 32 || out_size != MLAT * DM || ws_size < WS_END) { fprintf(stderr, "kernel_launch: unexpected shapes (n_in %d out %d ws %zu need %zu)\n", n_in, out_size, ws_size, (size_t)WS_END); grid = -1; return; }
        int dev = 0, cus = 0, per_cu = 0;
        (void)hipGetDevice(&dev);
        (void)hipDeviceGetAttribute(&cus, hipDeviceAttributeMultiprocessorCount, dev);
        if (hipFuncSetAttribute((const void*)hybrid_fwd, hipFuncAttributeMaxDynamicSharedMemorySize, LDS_BYTES) != hipSuccess) { fprintf(stderr, "kernel_launch: hipFuncSetAttribute failed\n"); }
        if (hipOccupancyMaxActiveBlocksPerMultiprocessor(&per_cu, (const void*)hybrid_fwd, NTHR, LDS_BYTES) != hipSuccess || per_cu < 1) { fprintf(stderr, "kernel_launch: occupancy query gave %d\n", per_cu); per_cu = 1; }
        (void)hipGetLastError();
        grid = cus * per_cu;
    }
    if (grid < 0) return;
    Params p{};
    const float** pp = (const float**)&p;
    for (int i = 0; i < 32; ++i) pp[i] = (const float*)d_in[i];
    p.out = (float*)d_out; p.ws = (unsigned char*)d_ws;
    (void)hipMemsetAsync((unsigned char*)d_ws + WS_BAR, 0, 16384, stream);
    void* args[] = {&p};
    hipError_t e = hipLaunchCooperativeKernel((const void*)hybrid_fwd, dim3(grid), dim3(NTHR), args, LDS_BYTES, stream);
    if (e != hipSuccess) fprintf(stderr, "cooperative launch failed: %s (grid %d)\n", hipGetErrorString(e), grid);
}
```
